# Optimizing an MI355X kernel written in HIP

```python
import math
import jax, jax.numpy as jnp
from jax import lax
import numpy as np

D_MODEL = 1024
BATCH = 2
SEQ = 8192
DEPTH = 1

MEM_LEN = 256
NORM_EPS = 1e-6
SSD_HEADS = 8
SSD_HEAD_DIM = 64
SSD_WIDTH = SSD_HEADS * SSD_HEAD_DIM
SSD_GROUPS = 2
SSD_STATE = 128
SSD_CONV = 4
SSD_CHUNK = 128
SSD_CONV_CH = SSD_WIDTH + 2 * SSD_GROUPS * SSD_STATE
MOBA_HEADS = 4
MOBA_HEAD_DIM = 64
MOBA_WIDTH = MOBA_HEADS * MOBA_HEAD_DIM
MOBA_BLOCK = 256
MOBA_TOPK = 3
MOBA_QBLOCK = 128
XATTN_HEADS = 4
XATTN_HEAD_DIM = 64
XATTN_WIDTH = XATTN_HEADS * XATTN_HEAD_DIM
MIX_WIDTH = SSD_WIDTH + MOBA_WIDTH + XATTN_WIDTH
IN_COLS = SSD_WIDTH + SSD_CONV_CH + SSD_HEADS + 3 * MOBA_WIDTH + XATTN_WIDTH
IN_SPLITS = (SSD_WIDTH,
             SSD_WIDTH + SSD_CONV_CH,
             SSD_WIDTH + SSD_CONV_CH + SSD_HEADS,
             SSD_WIDTH + SSD_CONV_CH + SSD_HEADS + MOBA_WIDTH,
             SSD_WIDTH + SSD_CONV_CH + SSD_HEADS + 2 * MOBA_WIDTH,
             SSD_WIDTH + SSD_CONV_CH + SSD_HEADS + 3 * MOBA_WIDTH)
PEER_HEADS = 8
PEER_NKEYS = 128
PEER_EXPERTS = PEER_NKEYS * PEER_NKEYS
PEER_TOPK = 16
PEER_QDIM = 128
PEER_HALF = PEER_QDIM // 2
PEER_CHUNK = 128

kernel_name = 'hybrid_ssd_moba_peer_block'


def rms_norm(x, w):
    xf = x.astype(jnp.float32)
    y = xf * lax.rsqrt(jnp.mean(xf * xf, axis=-1, keepdims=True) + NORM_EPS)
    return (y * w.astype(jnp.float32)).astype(x.dtype)


def alibi_slopes(n):
    return jnp.asarray([2.0 ** (-8.0 * (i + 1) / n) for i in range(n)], dtype=jnp.float32)


def causal_depthwise_conv(u, w, b):
    out = lax.conv_general_dilated(u, w[:, None, :], window_strides=(1,),
                                   padding=[(SSD_CONV - 1, 0)],
                                   dimension_numbers=('NWC', 'WIO', 'NWC'),
                                   feature_group_count=u.shape[-1])
    return out + b


def segsum(a):
    T = a.shape[-1]
    a_rep = jnp.broadcast_to(a[..., :, None], a.shape + (T,))
    a_rep = jnp.where(jnp.tril(jnp.ones((T, T), bool), -1), a_rep, 0.0)
    cs = jnp.cumsum(a_rep, axis=-2)
    return jnp.where(jnp.tril(jnp.ones((T, T), bool), 0), cs, -jnp.inf)


def ssd_chunked(xh, dt, a_coef, bm, cm):
    b, L, h, p = xh.shape
    n = bm.shape[-1]
    nc = L // SSD_CHUNK
    q = SSD_CHUNK
    xdt = (xh * dt[..., None].astype(xh.dtype)).reshape(b, nc, q, h, p)
    bc = bm.reshape(b, nc, q, h, n)
    cc = cm.reshape(b, nc, q, h, n)
    a = (dt * a_coef).reshape(b, nc, q, h).transpose(0, 1, 3, 2)
    a_cs = jnp.cumsum(a, axis=-1)
    decay_in = jnp.exp(segsum(a))
    cb = jnp.einsum('bclhn,bcshn->bchls', cc, bc)
    y_diag = jnp.einsum('bchls,bcshp->bclhp', cb * decay_in, xdt)
    decay_to_end = jnp.exp(a_cs[..., -1:] - a_cs)
    chunk_states = jnp.einsum('bclhn,bchl,bclhp->bchpn', bc, decay_to_end, xdt)
    chunk_decay = jnp.exp(a_cs[..., -1])

    def carry_state(state, inp):
        s_c, d_c = inp
        return state * d_c[..., None, None] + s_c, state

    init = jnp.zeros((b, h, p, n), chunk_states.dtype)
    _, states_in = lax.scan(carry_state, init,
                            (jnp.moveaxis(chunk_states, 1, 0), jnp.moveaxis(chunk_decay, 1, 0)))
    states_in = jnp.moveaxis(states_in, 0, 1)
    y_off = jnp.einsum('bclhn,bchpn,bchl->bclhp', cc, states_in, jnp.exp(a_cs))
    return (y_diag + y_off).reshape(b, L, h, p)


def ssd_mixer(z, xbc, dt_raw, conv_w, conv_b, dt_bias, a_log, d_skip, norm_w):
    b, L, _ = z.shape
    xbc = jax.nn.silu(causal_depthwise_conv(xbc, conv_w, conv_b))
    xs, bm, cm = jnp.split(xbc, [SSD_WIDTH, SSD_WIDTH + SSD_GROUPS * SSD_STATE], axis=-1)
    xh = xs.reshape(b, L, SSD_HEADS, SSD_HEAD_DIM)
    hpg = SSD_HEADS // SSD_GROUPS
    bm = jnp.repeat(bm.reshape(b, L, SSD_GROUPS, SSD_STATE), hpg, axis=2)
    cm = jnp.repeat(cm.reshape(b, L, SSD_GROUPS, SSD_STATE), hpg, axis=2)
    dt = jax.nn.softplus((dt_raw + dt_bias).astype(jnp.float32))
    a_coef = -jnp.exp(a_log.astype(jnp.float32))
    y = ssd_chunked(xh, dt, a_coef, bm, cm) + xh * d_skip[:, None]
    y = y.reshape(b, L, SSD_WIDTH).astype(z.dtype) * jax.nn.silu(z)
    y = rms_norm(y.reshape(b, L, SSD_GROUPS, SSD_WIDTH // SSD_GROUPS),
                 norm_w.reshape(SSD_GROUPS, SSD_WIDTH // SSD_GROUPS))
    return y.reshape(b, L, SSD_WIDTH)


def moba_attention(q, k, v, slopes):
    b, L, h, d = q.shape
    nb = -(-L // MOBA_BLOCK)
    pad = nb * MOBA_BLOCK - L
    scale = 1.0 / math.sqrt(d)
    qt = q.transpose(0, 2, 1, 3)
    kt = jnp.pad(k.transpose(0, 2, 1, 3), ((0, 0), (0, 0), (0, pad), (0, 0)))
    vt = jnp.pad(v.transpose(0, 2, 1, 3), ((0, 0), (0, 0), (0, pad), (0, 0)))
    k_blocks = kt.reshape(b, h, nb, MOBA_BLOCK, d)
    v_blocks = vt.reshape(b, h, nb, MOBA_BLOCK, d)
    k_mean = jnp.mean(k_blocks.astype(jnp.float32), axis=3)
    gate = jnp.einsum('bhtd,bhnd->bhtn', qt.astype(jnp.float32), k_mean)
    q_blk = jnp.arange(L) // MOBA_BLOCK
    past = jnp.arange(nb)[None, :] < q_blk[:, None]
    gate = jnp.where(past, gate, -jnp.inf)
    n_sel = min(MOBA_TOPK, nb)
    _, sel = lax.top_k(gate, n_sel)
    ncq = L // MOBA_QBLOCK
    q_chunks = jnp.moveaxis(qt.reshape(b, h, ncq, MOBA_QBLOCK, d), 2, 0)
    sel_chunks = jnp.moveaxis(sel.reshape(b, h, ncq, MOBA_QBLOCK, n_sel), 2, 0)
    bi = jnp.arange(b)[:, None, None, None]
    hi = jnp.arange(h)[None, :, None, None]

    def attend(args):
        qc, selc, ci = args
        t = ci * MOBA_QBLOCK + jnp.arange(MOBA_QBLOCK)
        own = (ci * MOBA_QBLOCK) // MOBA_BLOCK
        ks = k_blocks[bi, hi, selc]
        vs = v_blocks[bi, hi, selc]
        s_pos = selc[..., None] * MOBA_BLOCK + jnp.arange(MOBA_BLOCK)
        s_sel = jnp.einsum('bhqd,bhqjkd->bhqjk', qc, ks) * scale
        dist_sel = jnp.abs(t[:, None, None] - s_pos).astype(jnp.float32)
        s_sel = s_sel - slopes[:, None, None, None] * dist_sel
        valid = jnp.arange(n_sel) < own
        s_sel = jnp.where(valid[:, None], s_sel, -jnp.inf)
        k_own = lax.dynamic_index_in_dim(k_blocks, own, axis=2, keepdims=False)
        v_own = lax.dynamic_index_in_dim(v_blocks, own, axis=2, keepdims=False)
        own_pos = own * MOBA_BLOCK + jnp.arange(MOBA_BLOCK)
        s_own = jnp.einsum('bhqd,bhkd->bhqk', qc, k_own) * scale
        dist_own = jnp.abs(t[:, None] - own_pos[None, :]).astype(jnp.float32)
        s_own = s_own - slopes[:, None, None] * dist_own
        s_own = jnp.where(own_pos[None, :] <= t[:, None], s_own, -jnp.inf)
        scores = jnp.concatenate(
            [s_sel.reshape(b, h, MOBA_QBLOCK, n_sel * MOBA_BLOCK), s_own], axis=-1).astype(jnp.float32)
        p = jax.nn.softmax(scores, axis=-1).astype(v.dtype)
        p_sel = p[..., :n_sel * MOBA_BLOCK].reshape(b, h, MOBA_QBLOCK, n_sel, MOBA_BLOCK)
        p_own = p[..., n_sel * MOBA_BLOCK:]
        return (jnp.einsum('bhqjk,bhqjkd->bhqd', p_sel, vs)
                + jnp.einsum('bhqk,bhkd->bhqd', p_own, v_own))

    out = lax.map(attend, (q_chunks, sel_chunks, jnp.arange(ncq)))
    out = jnp.moveaxis(out, 0, 2).reshape(b, h, L, d)
    return out.transpose(0, 2, 1, 3)


def memory_cross_attention(q, mem_k, mem_v):
    scale = 1.0 / math.sqrt(q.shape[-1])
    s = jnp.einsum('blhd,bmhd->bhlm', q, mem_k).astype(jnp.float32) * scale
    p = jax.nn.softmax(s, axis=-1).astype(mem_v.dtype)
    return jnp.einsum('bhlm,bmhd->blhd', p, mem_v)


def peer_ffn(xn, w_query, sub_keys_1, sub_keys_2, expert_down, expert_up):
    b, L, _ = xn.shape
    q = jnp.einsum('bld,dk->blk', xn, w_query).reshape(b, L, PEER_HEADS, 2, PEER_HALF)
    s1 = jnp.einsum('blhd,nd->blhn', q[..., 0, :], sub_keys_1)
    s2 = jnp.einsum('blhd,nd->blhn', q[..., 1, :], sub_keys_2)
    v1, i1 = lax.top_k(s1, PEER_TOPK)
    v2, i2 = lax.top_k(s2, PEER_TOPK)
    cand_s = (v1[..., :, None] + v2[..., None, :]).reshape(b, L, PEER_HEADS, PEER_TOPK * PEER_TOPK)
    cand_i = (i1[..., :, None] * PEER_NKEYS + i2[..., None, :]).reshape(b, L, PEER_HEADS, PEER_TOPK * PEER_TOPK)
    top_s, top_pos = lax.top_k(cand_s, PEER_TOPK)
    e_idx = jnp.take_along_axis(cand_i, top_pos, axis=-1)
    gates = jax.nn.softmax(top_s.astype(jnp.float32), axis=-1).astype(xn.dtype)
    nchunk = L // PEER_CHUNK

    def to_chunks(t):
        return jnp.moveaxis(t.reshape((b, nchunk, PEER_CHUNK) + t.shape[2:]), 1, 0)

    def expert_block(args):
        xc, ic, gc = args
        u = expert_down[ic]
        act = jax.nn.gelu(jnp.einsum('bthkd,btd->bthk', u, xc), approximate=False)
        w_up = expert_up[ic]
        return jnp.einsum('bthk,bthkd->btd', gc * act, w_up)

    out = lax.map(expert_block, (to_chunks(xn), to_chunks(e_idx), to_chunks(gates)))
    return jnp.moveaxis(out, 0, 1).reshape(b, L, D_MODEL)


def setup_inputs(seed: int = 0) -> dict:
    key = jax.random.key(seed)
    ks = jax.random.split(key, 24)
    f32 = jnp.float32

    def nrm(k, shape, scale):
        return jax.random.normal(k, shape, f32) * scale

    def gain(k, shape):
        return 1.0 + 0.05 * jax.random.normal(k, shape, f32)

    dt0 = jnp.exp(jax.random.uniform(ks[5], (DEPTH, SSD_HEADS), f32, math.log(1e-3), math.log(1e-1)))
    return {
        'x': nrm(ks[0], (BATCH, SEQ, D_MODEL), 1.0),
        'mem': nrm(ks[1], (BATCH, MEM_LEN, D_MODEL), 1.0),
        'mix_norm_w': gain(ks[2], (DEPTH, D_MODEL)),
        'w_in': nrm(ks[3], (DEPTH, D_MODEL, IN_COLS), D_MODEL ** -0.5),
        'ssd_conv_w': nrm(ks[4], (DEPTH, SSD_CONV, SSD_CONV_CH), 0.5),
        'ssd_conv_b': nrm(ks[6], (DEPTH, SSD_CONV_CH), 0.02),
        'ssd_dt_bias': dt0 + jnp.log(-jnp.expm1(-dt0)),
        'ssd_a_log': jnp.log(jax.random.uniform(ks[7], (DEPTH, SSD_HEADS), f32, 1.0, 16.0)),
        'ssd_d': gain(ks[8], (DEPTH, SSD_HEADS)),
        'ssd_norm_w': gain(ks[9], (DEPTH, SSD_WIDTH)),
        'moba_q_norm_w': gain(ks[10], (DEPTH, MOBA_HEAD_DIM)),
        'moba_k_norm_w': gain(ks[11], (DEPTH, MOBA_HEAD_DIM)),
        'mem_norm_w': gain(ks[12], (DEPTH, D_MODEL)),
        'w_mem_kv': nrm(ks[13], (DEPTH, D_MODEL, 2 * XATTN_WIDTH), D_MODEL ** -0.5),
        'xattn_q_norm_w': gain(ks[14], (DEPTH, XATTN_HEAD_DIM)),
        'xattn_k_norm_w': gain(ks[15], (DEPTH, XATTN_HEAD_DIM)),
        'w_out': nrm(ks[16], (DEPTH, MIX_WIDTH, D_MODEL), MIX_WIDTH ** -0.5),
        'ffn_norm_w': gain(ks[17], (DEPTH, D_MODEL)),
        'peer_w_query': nrm(ks[18], (DEPTH, D_MODEL, PEER_HEADS * PEER_QDIM), D_MODEL ** -0.5),
        'peer_sub_keys_1': nrm(ks[19], (DEPTH, PEER_NKEYS, PEER_HALF), PEER_HALF ** -0.5),
        'peer_sub_keys_2': nrm(ks[20], (DEPTH, PEER_NKEYS, PEER_HALF), PEER_HALF ** -0.5),
        'peer_expert_down': nrm(ks[21], (DEPTH, PEER_EXPERTS, D_MODEL), D_MODEL ** -0.5),
        'peer_expert_up': nrm(ks[22], (DEPTH, PEER_EXPERTS, D_MODEL), PEER_HEADS ** -0.5),
    }


def reference(x, mem, mix_norm_w, w_in, ssd_conv_w, ssd_conv_b, ssd_dt_bias, ssd_a_log, ssd_d,
              ssd_norm_w, moba_q_norm_w, moba_k_norm_w, mem_norm_w, w_mem_kv, xattn_q_norm_w,
              xattn_k_norm_w, w_out, ffn_norm_w, peer_w_query, peer_sub_keys_1, peer_sub_keys_2,
              peer_expert_down, peer_expert_up):
    b, L, _ = x.shape
    slopes = alibi_slopes(MOBA_HEADS)
    h = x
    for l in range(DEPTH):
        xn = rms_norm(h, mix_norm_w[l])
        proj = jnp.einsum('bld,dk->blk', xn, w_in[l])
        z, xbc, dt_raw, mq, mk, mv, xq = jnp.split(proj, list(IN_SPLITS), axis=-1)
        y_ssd = ssd_mixer(z, xbc, dt_raw, ssd_conv_w[l], ssd_conv_b[l], ssd_dt_bias[l],
                          ssd_a_log[l], ssd_d[l], ssd_norm_w[l])
        mq = rms_norm(mq.reshape(b, L, MOBA_HEADS, MOBA_HEAD_DIM), moba_q_norm_w[l])
        mk = rms_norm(mk.reshape(b, L, MOBA_HEADS, MOBA_HEAD_DIM), moba_k_norm_w[l])
        mv = mv.reshape(b, L, MOBA_HEADS, MOBA_HEAD_DIM)
        y_moba = moba_attention(mq, mk, mv, slopes).reshape(b, L, MOBA_WIDTH)
        mem_n = rms_norm(mem, mem_norm_w[l])
        mem_kv = jnp.einsum('bmd,dk->bmk', mem_n, w_mem_kv[l])
        mem_k, mem_v = jnp.split(mem_kv, 2, axis=-1)
        M = mem.shape[1]
        mem_k = rms_norm(mem_k.reshape(b, M, XATTN_HEADS, XATTN_HEAD_DIM), xattn_k_norm_w[l])
        mem_v = mem_v.reshape(b, M, XATTN_HEADS, XATTN_HEAD_DIM)
        xq = rms_norm(xq.reshape(b, L, XATTN_HEADS, XATTN_HEAD_DIM), xattn_q_norm_w[l])
        y_mem = memory_cross_attention(xq, mem_k, mem_v).reshape(b, L, XATTN_WIDTH)
        mixed = jnp.concatenate([y_ssd, y_moba, y_mem], axis=-1)
        h = h + jnp.einsum('blk,kd->bld', mixed, w_out[l])
        hn = rms_norm(h, ffn_norm_w[l])
        h = h + peer_ffn(hn, peer_w_query[l], peer_sub_keys_1[l], peer_sub_keys_2[l],
                         peer_expert_down[l], peer_expert_up[l])
    return h
```

```cpp
#include <hip/hip_runtime.h>
#include <math.h>
#include <stdint.h>

namespace {
constexpr int DM = 1024;
constexpr int NB = 2;
constexpr int SL = 8192;
constexpr int NT = NB * SL;
constexpr int MEM = 256;
constexpr int INC = 2568;
constexpr int OFF_Z = 0, OFF_XBC = 512, OFF_DT = 1536, OFF_MQ = 1544, OFF_MK = 1800, OFF_MV = 2056, OFF_XQ = 2312;
constexpr float EPS = 1e-6f;

__device__ __forceinline__ float silu_f(float x) { return x / (1.f + expf(-x)); }
__device__ __forceinline__ float softplus_f(float x) { return fmaxf(x, 0.f) + log1pf(expf(-fabsf(x))); }
__device__ __forceinline__ float gelu_f(float x) { return 0.5f * x * (1.f + erff(x * 0.70710678118654752f)); }

__device__ __forceinline__ float wave_sum(float v) {
#pragma unroll
  for (int o = 32; o > 0; o >>= 1) v += __shfl_xor(v, o);
  return v;
}
__device__ __forceinline__ float wave_max(float v) {
#pragma unroll
  for (int o = 32; o > 0; o >>= 1) v = fmaxf(v, __shfl_xor(v, o));
  return v;
}

__global__ __launch_bounds__(256) void k_rmsnorm(const float* __restrict__ x, const float* __restrict__ w, float* __restrict__ out) {
  __shared__ float red[4];
  const int row = blockIdx.x, tid = threadIdx.x;
  float4 v = *(const float4*)(x + (size_t)row * DM + tid * 4);
  float ss = v.x * v.x + v.y * v.y + v.z * v.z + v.w * v.w;
  ss = wave_sum(ss);
  if ((tid & 63) == 0) red[tid >> 6] = ss;
  __syncthreads();
  float tot = red[0] + red[1] + red[2] + red[3];
  float r = rsqrtf(tot / DM + EPS);
  float4 ww = *(const float4*)(w + tid * 4);
  float4 o;
  o.x = v.x * r * ww.x; o.y = v.y * r * ww.y; o.z = v.z * r * ww.z; o.w = v.w * r * ww.w;
  *(float4*)(out + (size_t)row * DM + tid * 4) = o;
}

__global__ __launch_bounds__(256) void k_gemm(const float* __restrict__ A, int lda, const float* __restrict__ Bm, int ldb,
                                              float* __restrict__ C, int ldc, const float* __restrict__ R, int ldr,
                                              int M, int N, int K) {
  __shared__ float sA[16][68];
  __shared__ float sB[16][68];
  const int tid = threadIdx.x, tx = tid & 15, ty = tid >> 4;
  const int m0 = blockIdx.y * 64, n0 = blockIdx.x * 64;
  float acc[4][4];
#pragma unroll
  for (int i = 0; i < 4; ++i)
#pragma unroll
    for (int j = 0; j < 4; ++j) acc[i][j] = 0.f;
  for (int k0 = 0; k0 < K; k0 += 16) {
    {
      int r = tid >> 2, c = (tid & 3) * 4;
      float4 v = *(const float4*)(A + (size_t)(m0 + r) * lda + k0 + c);
      sA[c + 0][r] = v.x; sA[c + 1][r] = v.y; sA[c + 2][r] = v.z; sA[c + 3][r] = v.w;
    }
    {
      int r = tid >> 4, c = (tid & 15) * 4;
#pragma unroll
      for (int j = 0; j < 4; ++j) {
        int n = n0 + c + j;
        sB[r][c + j] = (n < N) ? Bm[(size_t)(k0 + r) * ldb + n] : 0.f;
      }
    }
    __syncthreads();
#pragma unroll
    for (int k = 0; k < 16; ++k) {
      float a[4], b[4];
#pragma unroll
      for (int i = 0; i < 4; ++i) a[i] = sA[k][ty * 4 + i];
#pragma unroll
      for (int j = 0; j < 4; ++j) b[j] = sB[k][tx * 4 + j];
#pragma unroll
      for (int i = 0; i < 4; ++i)
#pragma unroll
        for (int j = 0; j < 4; ++j) acc[i][j] = fmaf(a[i], b[j], acc[i][j]);
    }
    __syncthreads();
  }
#pragma unroll
  for (int i = 0; i < 4; ++i) {
    int m = m0 + ty * 4 + i;
#pragma unroll
    for (int j = 0; j < 4; ++j) {
      int n = n0 + tx * 4 + j;
      if (n < N) {
        float v = acc[i][j];
        if (R) v += R[(size_t)m * ldr + n];
        C[(size_t)m * ldc + n] = v;
      }
    }
  }
}

__global__ __launch_bounds__(256) void k_conv(const float* __restrict__ proj, const float* __restrict__ cw, const float* __restrict__ cb,
                                              float* __restrict__ out) {
  size_t i = (size_t)blockIdx.x * 256 + threadIdx.x;
  int c = (int)(i & 1023);
  int t = (int)(i >> 10);
  int l = t & (SL - 1);
  float acc = cb[c];
#pragma unroll
  for (int k = 0; k < 4; ++k) {
    int ll = l - 3 + k;
    if (ll >= 0) acc = fmaf(cw[k * 1024 + c], proj[(size_t)(t - 3 + k) * INC + OFF_XBC + c], acc);
  }
  out[i] = silu_f(acc);
}

__global__ __launch_bounds__(256) void k_dt(const float* __restrict__ proj, const float* __restrict__ dtb, float* __restrict__ dt) {
  int i = blockIdx.x * 256 + threadIdx.x;
  int h = i & 7, t = i >> 3;
  dt[i] = softplus_f(proj[(size_t)t * INC + OFF_DT + h] + dtb[h]);
}

__global__ __launch_bounds__(256) void k_ssd_scan(const float* __restrict__ xbc, const float* __restrict__ dt,
                                                  const float* __restrict__ a_log, const float* __restrict__ dsk,
                                                  float* __restrict__ y) {
  const int blk = blockIdx.x;
  const int pg = blk & 3, h = (blk >> 2) & 7, b = blk >> 5;
  const int tid = threadIdx.x, ng = tid & 15, pl = tid >> 4;
  const int p = pg * 16 + pl;
  const int g = h >> 2;
  const float a_coef = -expf(a_log[h]);
  const float dskip = dsk[h];
  float st[8];
#pragma unroll
  for (int i = 0; i < 8; ++i) st[i] = 0.f;
  for (int l = 0; l < SL; ++l) {
    const size_t t = (size_t)b * SL + l;
    const float* row = xbc + t * 1024;
    const float xv = row[h * 64 + p];
    const float4 b0 = *(const float4*)(row + 512 + g * 128 + ng * 8);
    const float4 b1 = *(const float4*)(row + 512 + g * 128 + ng * 8 + 4);
    const float4 c0 = *(const float4*)(row + 768 + g * 128 + ng * 8);
    const float4 c1 = *(const float4*)(row + 768 + g * 128 + ng * 8 + 4);
    const float dtv = dt[t * 8 + h];
    const float dA = expf(dtv * a_coef);
    const float xd = xv * dtv;
    const float bb[8] = {b0.x, b0.y, b0.z, b0.w, b1.x, b1.y, b1.z, b1.w};
    const float cc[8] = {c0.x, c0.y, c0.z, c0.w, c1.x, c1.y, c1.z, c1.w};
    float yp = 0.f;
#pragma unroll
    for (int i = 0; i < 8; ++i) {
      st[i] = fmaf(st[i], dA, xd * bb[i]);
      yp = fmaf(st[i], cc[i], yp);
    }
    yp += __shfl_xor(yp, 1);
    yp += __shfl_xor(yp, 2);
    yp += __shfl_xor(yp, 4);
    yp += __shfl_xor(yp, 8);
    if (ng == 0) y[t * 1024 + h * 64 + p] = yp + xv * dskip;
  }
}

__global__ __launch_bounds__(256) void k_ssd_post(const float* y, const float* __restrict__ proj, const float* __restrict__ nw,
                                                  float* mixed) {
  __shared__ float red[2][4];
  const int t = blockIdx.x, tid = threadIdx.x;
  float v0 = y[(size_t)t * 1024 + tid] * silu_f(proj[(size_t)t * INC + OFF_Z + tid]);
  float v1 = y[(size_t)t * 1024 + 256 + tid] * silu_f(proj[(size_t)t * INC + OFF_Z + 256 + tid]);
  float s0 = wave_sum(v0 * v0), s1 = wave_sum(v1 * v1);
  if ((tid & 63) == 0) { red[0][tid >> 6] = s0; red[1][tid >> 6] = s1; }
  __syncthreads();
  float t0 = red[0][0] + red[0][1] + red[0][2] + red[0][3];
  float t1 = red[1][0] + red[1][1] + red[1][2] + red[1][3];
  mixed[(size_t)t * DM + tid] = v0 * rsqrtf(t0 / 256.f + EPS) * nw[tid];
  mixed[(size_t)t * DM + 256 + tid] = v1 * rsqrtf(t1 / 256.f + EPS) * nw[256 + tid];
}

__global__ __launch_bounds__(256) void k_headnorm(const float* in, int ldi, int off, const float* __restrict__ w,
                                                  float* out, int ldo, int ooff, int nrows) {
  int wid = (blockIdx.x * 256 + threadIdx.x) >> 6;
  int lane = threadIdx.x & 63;
  if (wid >= nrows * 4) return;
  int row = wid >> 2, hh = wid & 3;
  float v = in[(size_t)row * ldi + off + hh * 64 + lane];
  float ss = wave_sum(v * v);
  out[(size_t)row * ldo + ooff + hh * 64 + lane] = v * rsqrtf(ss / 64.f + EPS) * w[lane];
}

__global__ __launch_bounds__(256) void k_kmean(const float* __restrict__ kn, int ldk, int koff, float* __restrict__ kmean) {
  int i = blockIdx.x * 256 + threadIdx.x;
  int d = i & 63, blk = (i >> 6) & 31, h = (i >> 11) & 3, b = i >> 13;
  float s = 0.f;
  for (int j = 0; j < 256; ++j) s += kn[((size_t)b * SL + blk * 256 + j) * ldk + koff + h * 64 + d];
  kmean[i] = s * (1.f / 256.f);
}

__global__ __launch_bounds__(256) void k_gate(const float* __restrict__ qn, int ldq, int qoff, const float* __restrict__ kmean, int* __restrict__ sel) {
  int i = blockIdx.x * 256 + threadIdx.x;
  int h = i & 3, t = i >> 2;
  int b = t / SL, l = t % SL;
  int own = l >> 8;
  float q[64];
#pragma unroll
  for (int d = 0; d < 64; d += 4) {
    float4 v = *(const float4*)(qn + (size_t)t * ldq + qoff + h * 64 + d);
    q[d] = v.x; q[d + 1] = v.y; q[d + 2] = v.z; q[d + 3] = v.w;
  }
  float v0 = -INFINITY, v1 = -INFINITY, v2 = -INFINITY;
  int i0 = 0, i1 = 1, i2 = 2;
  for (int n = 0; n < own; ++n) {
    const float* km = kmean + ((size_t)(b * 4 + h) * 32 + n) * 64;
    float s = 0.f;
#pragma unroll
    for (int d = 0; d < 64; d += 4) {
      float4 kv = *(const float4*)(km + d);
      s = fmaf(q[d], kv.x, s); s = fmaf(q[d + 1], kv.y, s); s = fmaf(q[d + 2], kv.z, s); s = fmaf(q[d + 3], kv.w, s);
    }
    if (s > v0) { v2 = v1; i2 = i1; v1 = v0; i1 = i0; v0 = s; i0 = n; }
    else if (s > v1) { v2 = v1; i2 = i1; v1 = s; i1 = n; }
    else if (s > v2) { v2 = s; i2 = n; }
  }
  sel[i * 3 + 0] = i0; sel[i * 3 + 1] = i1; sel[i * 3 + 2] = i2;
}

template <int MODE>
__global__ __launch_bounds__(256) void k_attn(const float* __restrict__ qn, int ldq, int qoff, const float* __restrict__ kn, int ldk, int koff,
                                              const float* __restrict__ vv, int ldv, int voff,
                                              const int* __restrict__ sel, float* __restrict__ mixed, int moff) {
  const int wid = (blockIdx.x * 256 + threadIdx.x) >> 6;
  const int lane = threadIdx.x & 63;
  const int h = wid & 3, t = wid >> 2;
  const int b = t / SL, l = t % SL;
  const int own = l >> 8;
  const float slope = exp2f(-8.f * (h + 1) / 4.f);
  float q[64];
#pragma unroll
  for (int d = 0; d < 64; d += 4) {
    float4 v = *(const float4*)(qn + (size_t)t * ldq + qoff + h * 64 + d);
    q[d] = v.x; q[d + 1] = v.y; q[d + 2] = v.z; q[d + 3] = v.w;
  }
  constexpr int NBLK = (MODE == 0) ? 4 : 1;
  float sc[NBLK][4];
  int kbase[NBLK];
  float mx = -INFINITY;
#pragma unroll
  for (int j = 0; j < NBLK; ++j) {
    bool valid;
    int blk;
    if (MODE == 0) {
      if (j < 3) { valid = j < own; blk = sel[(size_t)wid * 3 + j]; if (!valid) blk = 0; }
      else { valid = true; blk = own; }
      kbase[j] = b * SL + blk * 256;
    } else { valid = true; blk = 0; kbase[j] = b * MEM; }
#pragma unroll
    for (int i = 0; i < 4; ++i) {
      int kk = lane + i * 64;
      const float* kr = kn + (size_t)(kbase[j] + kk) * ldk + koff + h * 64;
      float s = 0.f;
#pragma unroll
      for (int d = 0; d < 64; d += 4) {
        float4 kv = *(const float4*)(kr + d);
        s = fmaf(q[d], kv.x, s); s = fmaf(q[d + 1], kv.y, s); s = fmaf(q[d + 2], kv.z, s); s = fmaf(q[d + 3], kv.w, s);
      }
      s *= 0.125f;
      if (MODE == 0) {
        int spos = blk * 256 + kk;
        s -= slope * fabsf((float)(l - spos));
        if (!valid) s = -INFINITY;
        if (j == 3 && spos > l) s = -INFINITY;
      }
      sc[j][i] = s;
      mx = fmaxf(mx, s);
    }
  }
  mx = wave_max(mx);
  float sum = 0.f;
#pragma unroll
  for (int j = 0; j < NBLK; ++j)
#pragma unroll
    for (int i = 0; i < 4; ++i) { float p = expf(sc[j][i] - mx); sc[j][i] = p; sum += p; }
  sum = wave_sum(sum);
  const float inv = 1.f / sum;
  float o[64];
#pragma unroll
  for (int d = 0; d < 64; ++d) o[d] = 0.f;
#pragma unroll
  for (int j = 0; j < NBLK; ++j)
#pragma unroll
    for (int i = 0; i < 4; ++i) {
      int kk = lane + i * 64;
      const float* vr = vv + (size_t)(kbase[j] + kk) * ldv + voff + h * 64;
      float p = sc[j][i];
#pragma unroll
      for (int d = 0; d < 64; d += 4) {
        float4 v4 = *(const float4*)(vr + d);
        o[d] = fmaf(p, v4.x, o[d]); o[d + 1] = fmaf(p, v4.y, o[d + 1]); o[d + 2] = fmaf(p, v4.z, o[d + 2]); o[d + 3] = fmaf(p, v4.w, o[d + 3]);
      }
    }
  float mine = 0.f;
#pragma unroll
  for (int d = 0; d < 64; ++d) {
    float v = wave_sum(o[d]);
    if (lane == d) mine = v;
  }
  mixed[(size_t)t * DM + moff + h * 64 + lane] = mine * inv;
}

__global__ __launch_bounds__(256) void k_peer_route(const float* __restrict__ q, const float* __restrict__ k1, const float* __restrict__ k2,
                                                    int* __restrict__ eidx, float* __restrict__ egate) {
  const int wid = (blockIdx.x * 256 + threadIdx.x) >> 6;
  const int lane = threadIdx.x & 63;
  const float* qr = q + (size_t)wid * 128;
  float s[2][2];
#pragma unroll
  for (int half = 0; half < 2; ++half) {
    const float* keys = half ? k2 : k1;
#pragma unroll
    for (int r = 0; r < 2; ++r) {
      const float* kr = keys + (size_t)(lane + r * 64) * 64;
      float acc = 0.f;
#pragma unroll
      for (int d = 0; d < 64; d += 4) {
        float4 kv = *(const float4*)(kr + d);
        float4 qv = *(const float4*)(qr + half * 64 + d);
        acc = fmaf(qv.x, kv.x, acc); acc = fmaf(qv.y, kv.y, acc); acc = fmaf(qv.z, kv.z, acc); acc = fmaf(qv.w, kv.w, acc);
      }
      s[half][r] = acc;
    }
  }
  float tv[2]; int ti[2];
#pragma unroll
  for (int half = 0; half < 2; ++half) {
    float a0 = s[half][0], a1 = s[half][1];
    float keepv = 0.f; int keepi = 0;
    for (int r = 0; r < 16; ++r) {
      float bv; int bi;
      if (a0 >= a1) { bv = a0; bi = lane; } else { bv = a1; bi = lane + 64; }
#pragma unroll
      for (int o = 32; o > 0; o >>= 1) {
        float ov = __shfl_xor(bv, o); int oi = __shfl_xor(bi, o);
        if (ov > bv || (ov == bv && oi < bi)) { bv = ov; bi = oi; }
      }
      if (lane == r) { keepv = bv; keepi = bi; }
      if (bi == lane) a0 = -INFINITY;
      if (bi == lane + 64) a1 = -INFINITY;
    }
    tv[half] = keepv; ti[half] = keepi;
  }
  float cv[4];
  const int a = lane >> 2;
  const float va = __shfl(tv[0], a);
#pragma unroll
  for (int j = 0; j < 4; ++j) {
    int bb = (lane & 3) * 4 + j;
    cv[j] = va + __shfl(tv[1], bb);
  }
  float topv = 0.f; int topp = 0;
  for (int r = 0; r < 16; ++r) {
    float bv = cv[0]; int bi = lane * 4;
#pragma unroll
    for (int j = 1; j < 4; ++j) if (cv[j] > bv) { bv = cv[j]; bi = lane * 4 + j; }
#pragma unroll
    for (int o = 32; o > 0; o >>= 1) {
      float ov = __shfl_xor(bv, o); int oi = __shfl_xor(bi, o);
      if (ov > bv || (ov == bv && oi < bi)) { bv = ov; bi = oi; }
    }
    if (lane == r) { topv = bv; topp = bi; }
    if ((bi >> 2) == lane) {
#pragma unroll
      for (int j = 0; j < 4; ++j) if ((bi & 3) == j) cv[j] = -INFINITY;
    }
  }
  int pa = topp >> 4, pb = topp & 15;
  int e1 = __shfl(ti[0], pa), e2 = __shfl(ti[1], pb);
  int e = e1 * 128 + e2;
  float m = (lane < 16) ? topv : -INFINITY;
  m = wave_max(m);
  float ex = (lane < 16) ? expf(topv - m) : 0.f;
  float sum = wave_sum(ex);
  if (lane < 16) {
    eidx[(size_t)wid * 16 + lane] = e;
    egate[(size_t)wid * 16 + lane] = ex / sum;
  }
}

__global__ __launch_bounds__(256) void k_peer_experts(const float* __restrict__ hn, const int* __restrict__ eidx, const float* __restrict__ egate,
                                                      const float* __restrict__ down, const float* __restrict__ up,
                                                      float* __restrict__ out  ) {
  __shared__ float red[4][1024];
  const int t = blockIdx.x, tid = threadIdx.x, w = tid >> 6, lane = tid & 63;
  float4 x[4];
#pragma unroll
  for (int i = 0; i < 4; ++i) x[i] = *(const float4*)(hn + (size_t)t * DM + (i * 64 + lane) * 4);
  float4 acc[4];
#pragma unroll
  for (int i = 0; i < 4; ++i) acc[i] = make_float4(0.f, 0.f, 0.f, 0.f);
  for (int k = 0; k < 32; ++k) {
    const int slot = t * 128 + w * 32 + k;
    const int e = eidx[slot];
    const float g = egate[slot];
    const float* dr = down + (size_t)e * DM;
    float dot = 0.f;
#pragma unroll
    for (int i = 0; i < 4; ++i) {
      float4 dv = *(const float4*)(dr + (i * 64 + lane) * 4);
      dot = fmaf(dv.x, x[i].x, dot); dot = fmaf(dv.y, x[i].y, dot); dot = fmaf(dv.z, x[i].z, dot); dot = fmaf(dv.w, x[i].w, dot);
    }
    dot = wave_sum(dot);
    const float coef = g * gelu_f(dot);
    const float* ur = up + (size_t)e * DM;
#pragma unroll
    for (int i = 0; i < 4; ++i) {
      float4 uv = *(const float4*)(ur + (i * 64 + lane) * 4);
      acc[i].x = fmaf(coef, uv.x, acc[i].x); acc[i].y = fmaf(coef, uv.y, acc[i].y);
      acc[i].z = fmaf(coef, uv.z, acc[i].z); acc[i].w = fmaf(coef, uv.w, acc[i].w);
    }
  }
#pragma unroll
  for (int i = 0; i < 4; ++i) *(float4*)(&red[w][(i * 64 + lane) * 4]) = acc[i];
  __syncthreads();
  {
    float4 a = *(float4*)(&red[0][tid * 4]);
    float4 b = *(float4*)(&red[1][tid * 4]);
    float4 c = *(float4*)(&red[2][tid * 4]);
    float4 d = *(float4*)(&red[3][tid * 4]);
    float4 hv = *(float4*)(out + (size_t)t * DM + tid * 4);
    hv.x += (a.x + b.x) + (c.x + d.x); hv.y += (a.y + b.y) + (c.y + d.y);
    hv.z += (a.z + b.z) + (c.z + d.z); hv.w += (a.w + b.w) + (c.w + d.w);
    *(float4*)(out + (size_t)t * DM + tid * 4) = hv;
  }
}
}

extern "C" void kernel_launch(void* const* d_in, const int* in_sizes, int n_in, void* d_out, int out_size, void* d_ws, size_t ws_size,
                              hipStream_t stream) {
  const float* x = (const float*)d_in[0];
  const float* mem = (const float*)d_in[1];
  const float* mix_norm_w = (const float*)d_in[2];
  const float* w_in = (const float*)d_in[3];
  const float* conv_w = (const float*)d_in[4];
  const float* conv_b = (const float*)d_in[5];
  const float* dt_bias = (const float*)d_in[6];
  const float* a_log = (const float*)d_in[7];
  const float* ssd_d = (const float*)d_in[8];
  const float* ssd_norm_w = (const float*)d_in[9];
  const float* mq_norm_w = (const float*)d_in[10];
  const float* mk_norm_w = (const float*)d_in[11];
  const float* mem_norm_w = (const float*)d_in[12];
  const float* w_mem_kv = (const float*)d_in[13];
  const float* xq_norm_w = (const float*)d_in[14];
  const float* xk_norm_w = (const float*)d_in[15];
  const float* w_out = (const float*)d_in[16];
  const float* ffn_norm_w = (const float*)d_in[17];
  const float* w_query = (const float*)d_in[18];
  const float* sk1 = (const float*)d_in[19];
  const float* sk2 = (const float*)d_in[20];
  const float* e_down = (const float*)d_in[21];
  const float* e_up = (const float*)d_in[22];
  float* out = (float*)d_out;

  float* ws = (float*)d_ws;
  size_t o = 0;
  auto take = [&](size_t n) { float* p = ws + o; o += (n + 63) & ~(size_t)63; return p; };
  float* bufA = take((size_t)NT * DM);
  float* proj = take((size_t)NT * INC);
  float* dt = take((size_t)NT * 8);
  float* kmean = take(NB * 4 * 32 * 64);
  int* sel = (int*)take((size_t)NT * 4 * 3);
  float* memn = take((size_t)NB * MEM * DM);
  float* memkv = take((size_t)NB * MEM * 512);
  if (o * sizeof(float) > ws_size) return;
  float* xn = bufA;
  float* mixed = bufA;
  float* xbc = out;

  k_rmsnorm<<<NT, 256, 0, stream>>>(x, mix_norm_w, xn);
  k_gemm<<<dim3((INC + 63) / 64, NT / 64), 256, 0, stream>>>(xn, DM, w_in, INC, proj, INC, nullptr, 0, NT, INC, DM);
  k_conv<<<NT * 1024 / 256, 256, 0, stream>>>(proj, conv_w, conv_b, xbc);
  k_dt<<<NT * 8 / 256, 256, 0, stream>>>(proj, dt_bias, dt);
  k_ssd_scan<<<NB * 8 * 4, 256, 0, stream>>>(xbc, dt, a_log, ssd_d, mixed);
  k_ssd_post<<<NT, 256, 0, stream>>>(mixed, proj, ssd_norm_w, mixed);
  k_headnorm<<<NT, 256, 0, stream>>>(proj, INC, OFF_MQ, mq_norm_w, proj, INC, OFF_MQ, NT);
  k_headnorm<<<NT, 256, 0, stream>>>(proj, INC, OFF_MK, mk_norm_w, proj, INC, OFF_MK, NT);
  k_headnorm<<<NT, 256, 0, stream>>>(proj, INC, OFF_XQ, xq_norm_w, proj, INC, OFF_XQ, NT);
  k_kmean<<<NB * 4 * 32 * 64 / 256, 256, 0, stream>>>(proj, INC, OFF_MK, kmean);
  k_gate<<<NT * 4 / 256, 256, 0, stream>>>(proj, INC, OFF_MQ, kmean, sel);
  k_attn<0><<<NT, 256, 0, stream>>>(proj, INC, OFF_MQ, proj, INC, OFF_MK, proj, INC, OFF_MV, sel, mixed, 512);
  k_rmsnorm<<<NB * MEM, 256, 0, stream>>>(mem, mem_norm_w, memn);
  k_gemm<<<dim3(512 / 64, NB * MEM / 64), 256, 0, stream>>>(memn, DM, w_mem_kv, 512, memkv, 512, nullptr, 0, NB * MEM, 512, DM);
  k_headnorm<<<NB * MEM, 256, 0, stream>>>(memkv, 512, 0, xk_norm_w, memkv, 512, 0, NB * MEM);
  k_attn<1><<<NT, 256, 0, stream>>>(proj, INC, OFF_XQ, memkv, 512, 0, memkv, 512, 256, nullptr, mixed, 768);
  k_gemm<<<dim3(DM / 64, NT / 64), 256, 0, stream>>>(mixed, DM, w_out, DM, out, DM, x, DM, NT, DM, DM);
  float* hn = proj;
  float* q = proj + (size_t)NT * DM;
  int* eidx = (int*)(proj + (size_t)2 * NT * DM);
  float* egate = proj + (size_t)2 * NT * DM + (size_t)NT * 128;
  k_rmsnorm<<<NT, 256, 0, stream>>>(out, ffn_norm_w, hn);
  k_gemm<<<dim3(DM / 64, NT / 64), 256, 0, stream>>>(hn, DM, w_query, DM, q, DM, nullptr, 0, NT, DM, DM);
  k_peer_route<<<NT * 8 / 4, 256, 0, stream>>>(q, sk1, sk2, eidx, egate);
  k_peer_experts<<<NT, 256, 0, stream>>>(hn, eidx, egate, e_down, e_up, out);
}
```

```cpp
#include <hip/hip_runtime.h>
#include <hip/hip_cooperative_groups.h>
#include <cstdio>
namespace cg = cooperative_groups;
#include <math.h>
#include <stdint.h>

namespace {
constexpr int DM = 1024;
constexpr int NB = 2;
constexpr int SL = 8192;
constexpr int NT = NB * SL;
constexpr int MEM = 256;
constexpr int INC = 2568;
constexpr int OFF_Z = 0, OFF_XBC = 512, OFF_DT = 1536, OFF_MQ = 1544, OFF_MK = 1800, OFF_MV = 2056, OFF_XQ = 2312;
constexpr float EPS = 1e-6f;

__device__ __forceinline__ float silu_f(float x) { return x / (1.f + expf(-x)); }
__device__ __forceinline__ float softplus_f(float x) { return fmaxf(x, 0.f) + log1pf(expf(-fabsf(x))); }
__device__ __forceinline__ float gelu_f(float x) { return 0.5f * x * (1.f + erff(x * 0.70710678118654752f)); }

__device__ __forceinline__ float wave_sum(float v) {
#pragma unroll
  for (int o = 32; o > 0; o >>= 1) v += __shfl_xor(v, o);
  return v;
}
__device__ __forceinline__ float wave_max(float v) {
#pragma unroll
  for (int o = 32; o > 0; o >>= 1) v = fmaxf(v, __shfl_xor(v, o));
  return v;
}

__device__ __forceinline__ void k_rmsnorm(const int VB, float* smem, const float* __restrict__ x, const float* __restrict__ w, float* __restrict__ out) {
  float* red = smem;
  const int row = VB, tid = threadIdx.x;
  float4 v = *(const float4*)(x + (size_t)row * DM + tid * 4);
  float ss = v.x * v.x + v.y * v.y + v.z * v.z + v.w * v.w;
  ss = wave_sum(ss);
  if ((tid & 63) == 0) red[tid >> 6] = ss;
  __syncthreads();
  float tot = red[0] + red[1] + red[2] + red[3];
  float r = rsqrtf(tot / DM + EPS);
  float4 ww = *(const float4*)(w + tid * 4);
  float4 o;
  o.x = v.x * r * ww.x; o.y = v.y * r * ww.y; o.z = v.z * r * ww.z; o.w = v.w * r * ww.w;
  *(float4*)(out + (size_t)row * DM + tid * 4) = o;
}

__device__ __forceinline__ void k_gemm(const int VB, float* smem, const float* __restrict__ A, int lda, const float* __restrict__ Bm, int ldb,
                                              float* __restrict__ C, int ldc, const float* __restrict__ R, int ldr,
                                              int M, int N, int K) {
  float (*sA)[68] = (float (*)[68])smem;
  float (*sB)[68] = (float (*)[68])(smem + 16 * 68);
  const int gx = (N + 63) / 64;
  const int tid = threadIdx.x, tx = tid & 15, ty = tid >> 4;
  const int m0 = (VB / gx) * 64, n0 = (VB % gx) * 64;
  float acc[4][4];
#pragma unroll
  for (int i = 0; i < 4; ++i)
#pragma unroll
    for (int j = 0; j < 4; ++j) acc[i][j] = 0.f;
  for (int k0 = 0; k0 < K; k0 += 16) {
    {
      int r = tid >> 2, c = (tid & 3) * 4;
      float4 v = *(const float4*)(A + (size_t)(m0 + r) * lda + k0 + c);
      sA[c + 0][r] = v.x; sA[c + 1][r] = v.y; sA[c + 2][r] = v.z; sA[c + 3][r] = v.w;
    }
    {
      int r = tid >> 4, c = (tid & 15) * 4;
#pragma unroll
      for (int j = 0; j < 4; ++j) {
        int n = n0 + c + j;
        sB[r][c + j] = (n < N) ? Bm[(size_t)(k0 + r) * ldb + n] : 0.f;
      }
    }
    __syncthreads();
#pragma unroll
    for (int k = 0; k < 16; ++k) {
      float a[4], b[4];
#pragma unroll
      for (int i = 0; i < 4; ++i) a[i] = sA[k][ty * 4 + i];
#pragma unroll
      for (int j = 0; j < 4; ++j) b[j] = sB[k][tx * 4 + j];
#pragma unroll
      for (int i = 0; i < 4; ++i)
#pragma unroll
        for (int j = 0; j < 4; ++j) acc[i][j] = fmaf(a[i], b[j], acc[i][j]);
    }
    __syncthreads();
  }
#pragma unroll
  for (int i = 0; i < 4; ++i) {
    int m = m0 + ty * 4 + i;
#pragma unroll
    for (int j = 0; j < 4; ++j) {
      int n = n0 + tx * 4 + j;
      if (n < N) {
        float v = acc[i][j];
        if (R) v += R[(size_t)m * ldr + n];
        C[(size_t)m * ldc + n] = v;
      }
    }
  }
}

__device__ __forceinline__ void k_conv(const int VB, float* smem, const float* __restrict__ proj, const float* __restrict__ cw, const float* __restrict__ cb,
                                              float* __restrict__ out) {
  size_t i = (size_t)VB * 256 + threadIdx.x;
  int c = (int)(i & 1023);
  int t = (int)(i >> 10);
  int l = t & (SL - 1);
  float acc = cb[c];
#pragma unroll
  for (int k = 0; k < 4; ++k) {
    int ll = l - 3 + k;
    if (ll >= 0) acc = fmaf(cw[k * 1024 + c], proj[(size_t)(t - 3 + k) * INC + OFF_XBC + c], acc);
  }
  out[i] = silu_f(acc);
}

__device__ __forceinline__ void k_dt(const int VB, float* smem, const float* __restrict__ proj, const float* __restrict__ dtb, float* __restrict__ dt) {
  int i = VB * 256 + threadIdx.x;
  int h = i & 7, t = i >> 3;
  dt[i] = softplus_f(proj[(size_t)t * INC + OFF_DT + h] + dtb[h]);
}

__device__ __forceinline__ void k_ssd_scan(const int VB, float* smem, const float* __restrict__ xbc, const float* __restrict__ dt,
                                                  const float* __restrict__ a_log, const float* __restrict__ dsk,
                                                  float* __restrict__ y) {
  const int blk = VB;
  const int pg = blk & 3, h = (blk >> 2) & 7, b = blk >> 5;
  const int tid = threadIdx.x, ng = tid & 15, pl = tid >> 4;
  const int p = pg * 16 + pl;
  const int g = h >> 2;
  const float a_coef = -expf(a_log[h]);
  const float dskip = dsk[h];
  float st[8];
#pragma unroll
  for (int i = 0; i < 8; ++i) st[i] = 0.f;
  for (int l = 0; l < SL; ++l) {
    const size_t t = (size_t)b * SL + l;
    const float* row = xbc + t * 1024;
    const float xv = row[h * 64 + p];
    const float4 b0 = *(const float4*)(row + 512 + g * 128 + ng * 8);
    const float4 b1 = *(const float4*)(row + 512 + g * 128 + ng * 8 + 4);
    const float4 c0 = *(const float4*)(row + 768 + g * 128 + ng * 8);
    const float4 c1 = *(const float4*)(row + 768 + g * 128 + ng * 8 + 4);
    const float dtv = dt[t * 8 + h];
    const float dA = expf(dtv * a_coef);
    const float xd = xv * dtv;
    const float bb[8] = {b0.x, b0.y, b0.z, b0.w, b1.x, b1.y, b1.z, b1.w};
    const float cc[8] = {c0.x, c0.y, c0.z, c0.w, c1.x, c1.y, c1.z, c1.w};
    float yp = 0.f;
#pragma unroll
    for (int i = 0; i < 8; ++i) {
      st[i] = fmaf(st[i], dA, xd * bb[i]);
      yp = fmaf(st[i], cc[i], yp);
    }
    yp += __shfl_xor(yp, 1);
    yp += __shfl_xor(yp, 2);
    yp += __shfl_xor(yp, 4);
    yp += __shfl_xor(yp, 8);
    if (ng == 0) y[t * 1024 + h * 64 + p] = yp + xv * dskip;
  }
}

__device__ __forceinline__ void k_ssd_post(const int VB, float* smem, const float* y, const float* __restrict__ proj, const float* __restrict__ nw,
                                                  float* mixed) {
  float (*red)[4] = (float (*)[4])smem;
  const int t = VB, tid = threadIdx.x;
  float v0 = y[(size_t)t * 1024 + tid] * silu_f(proj[(size_t)t * INC + OFF_Z + tid]);
  float v1 = y[(size_t)t * 1024 + 256 + tid] * silu_f(proj[(size_t)t * INC + OFF_Z + 256 + tid]);
  float s0 = wave_sum(v0 * v0), s1 = wave_sum(v1 * v1);
  if ((tid & 63) == 0) { red[0][tid >> 6] = s0; red[1][tid >> 6] = s1; }
  __syncthreads();
  float t0 = red[0][0] + red[0][1] + red[0][2] + red[0][3];
  float t1 = red[1][0] + red[1][1] + red[1][2] + red[1][3];
  mixed[(size_t)t * DM + tid] = v0 * rsqrtf(t0 / 256.f + EPS) * nw[tid];
  mixed[(size_t)t * DM + 256 + tid] = v1 * rsqrtf(t1 / 256.f + EPS) * nw[256 + tid];
}

__device__ __forceinline__ void k_headnorm(const int VB, float* smem, const float* in, int ldi, int off, const float* __restrict__ w,
                                                  float* out, int ldo, int ooff, int nrows) {
  int wid = (VB * 256 + threadIdx.x) >> 6;
  int lane = threadIdx.x & 63;
  if (wid >= nrows * 4) return;
  int row = wid >> 2, hh = wid & 3;
  float v = in[(size_t)row * ldi + off + hh * 64 + lane];
  float ss = wave_sum(v * v);
  out[(size_t)row * ldo + ooff + hh * 64 + lane] = v * rsqrtf(ss / 64.f + EPS) * w[lane];
}

__device__ __forceinline__ void k_kmean(const int VB, float* smem, const float* __restrict__ kn, int ldk, int koff, float* __restrict__ kmean) {
  int i = VB * 256 + threadIdx.x;
  int d = i & 63, blk = (i >> 6) & 31, h = (i >> 11) & 3, b = i >> 13;
  float s = 0.f;
  for (int j = 0; j < 256; ++j) s += kn[((size_t)b * SL + blk * 256 + j) * ldk + koff + h * 64 + d];
  kmean[i] = s * (1.f / 256.f);
}

__device__ __forceinline__ void k_gate(const int VB, float* smem, const float* __restrict__ qn, int ldq, int qoff, const float* __restrict__ kmean, int* __restrict__ sel) {
  int i = VB * 256 + threadIdx.x;
  int h = i & 3, t = i >> 2;
  int b = t / SL, l = t % SL;
  int own = l >> 8;
  float q[64];
#pragma unroll
  for (int d = 0; d < 64; d += 4) {
    float4 v = *(const float4*)(qn + (size_t)t * ldq + qoff + h * 64 + d);
    q[d] = v.x; q[d + 1] = v.y; q[d + 2] = v.z; q[d + 3] = v.w;
  }
  float v0 = -INFINITY, v1 = -INFINITY, v2 = -INFINITY;
  int i0 = 0, i1 = 1, i2 = 2;
  for (int n = 0; n < own; ++n) {
    const float* km = kmean + ((size_t)(b * 4 + h) * 32 + n) * 64;
    float s = 0.f;
#pragma unroll
    for (int d = 0; d < 64; d += 4) {
      float4 kv = *(const float4*)(km + d);
      s = fmaf(q[d], kv.x, s); s = fmaf(q[d + 1], kv.y, s); s = fmaf(q[d + 2], kv.z, s); s = fmaf(q[d + 3], kv.w, s);
    }
    if (s > v0) { v2 = v1; i2 = i1; v1 = v0; i1 = i0; v0 = s; i0 = n; }
    else if (s > v1) { v2 = v1; i2 = i1; v1 = s; i1 = n; }
    else if (s > v2) { v2 = s; i2 = n; }
  }
  sel[i * 3 + 0] = i0; sel[i * 3 + 1] = i1; sel[i * 3 + 2] = i2;
}

template <int MODE>
__device__ __forceinline__ void k_attn(const int VB, float* smem, const float* __restrict__ qn, int ldq, int qoff, const float* __restrict__ kn, int ldk, int koff,
                                              const float* __restrict__ vv, int ldv, int voff,
                                              const int* __restrict__ sel, float* __restrict__ mixed, int moff) {
  const int wid = (VB * 256 + threadIdx.x) >> 6;
  const int lane = threadIdx.x & 63;
  const int h = wid & 3, t = wid >> 2;
  const int b = t / SL, l = t % SL;
  const int own = l >> 8;
  const float slope = exp2f(-8.f * (h + 1) / 4.f);
  float q[64];
#pragma unroll
  for (int d = 0; d < 64; d += 4) {
    float4 v = *(const float4*)(qn + (size_t)t * ldq + qoff + h * 64 + d);
    q[d] = v.x; q[d + 1] = v.y; q[d + 2] = v.z; q[d + 3] = v.w;
  }
  constexpr int NBLK = (MODE == 0) ? 4 : 1;
  float sc[NBLK][4];
  int kbase[NBLK];
  float mx = -INFINITY;
#pragma unroll
  for (int j = 0; j < NBLK; ++j) {
    bool valid;
    int blk;
    if (MODE == 0) {
      if (j < 3) { valid = j < own; blk = sel[(size_t)wid * 3 + j]; if (!valid) blk = 0; }
      else { valid = true; blk = own; }
      kbase[j] = b * SL + blk * 256;
    } else { valid = true; blk = 0; kbase[j] = b * MEM; }
#pragma unroll
    for (int i = 0; i < 4; ++i) {
      int kk = lane + i * 64;
      const float* kr = kn + (size_t)(kbase[j] + kk) * ldk + koff + h * 64;
      float s = 0.f;
#pragma unroll
      for (int d = 0; d < 64; d += 4) {
        float4 kv = *(const float4*)(kr + d);
        s = fmaf(q[d], kv.x, s); s = fmaf(q[d + 1], kv.y, s); s = fmaf(q[d + 2], kv.z, s); s = fmaf(q[d + 3], kv.w, s);
      }
      s *= 0.125f;
      if (MODE == 0) {
        int spos = blk * 256 + kk;
        s -= slope * fabsf((float)(l - spos));
        if (!valid) s = -INFINITY;
        if (j == 3 && spos > l) s = -INFINITY;
      }
      sc[j][i] = s;
      mx = fmaxf(mx, s);
    }
  }
  mx = wave_max(mx);
  float sum = 0.f;
#pragma unroll
  for (int j = 0; j < NBLK; ++j)
#pragma unroll
    for (int i = 0; i < 4; ++i) { float p = expf(sc[j][i] - mx); sc[j][i] = p; sum += p; }
  sum = wave_sum(sum);
  const float inv = 1.f / sum;
  float o[64];
#pragma unroll
  for (int d = 0; d < 64; ++d) o[d] = 0.f;
#pragma unroll
  for (int j = 0; j < NBLK; ++j)
#pragma unroll
    for (int i = 0; i < 4; ++i) {
      int kk = lane + i * 64;
      const float* vr = vv + (size_t)(kbase[j] + kk) * ldv + voff + h * 64;
      float p = sc[j][i];
#pragma unroll
      for (int d = 0; d < 64; d += 4) {
        float4 v4 = *(const float4*)(vr + d);
        o[d] = fmaf(p, v4.x, o[d]); o[d + 1] = fmaf(p, v4.y, o[d + 1]); o[d + 2] = fmaf(p, v4.z, o[d + 2]); o[d + 3] = fmaf(p, v4.w, o[d + 3]);
      }
    }
  float mine = 0.f;
#pragma unroll
  for (int d = 0; d < 64; ++d) {
    float v = wave_sum(o[d]);
    if (lane == d) mine = v;
  }
  mixed[(size_t)t * DM + moff + h * 64 + lane] = mine * inv;
}

__device__ __forceinline__ void k_peer_route(const int VB, float* smem, const float* __restrict__ q, const float* __restrict__ k1, const float* __restrict__ k2,
                                                    int* __restrict__ eidx, float* __restrict__ egate) {
  const int wid = (VB * 256 + threadIdx.x) >> 6;
  const int lane = threadIdx.x & 63;
  const float* qr = q + (size_t)wid * 128;
  float s[2][2];
#pragma unroll
  for (int half = 0; half < 2; ++half) {
    const float* keys = half ? k2 : k1;
#pragma unroll
    for (int r = 0; r < 2; ++r) {
      const float* kr = keys + (size_t)(lane + r * 64) * 64;
      float acc = 0.f;
#pragma unroll
      for (int d = 0; d < 64; d += 4) {
        float4 kv = *(const float4*)(kr + d);
        float4 qv = *(const float4*)(qr + half * 64 + d);
        acc = fmaf(qv.x, kv.x, acc); acc = fmaf(qv.y, kv.y, acc); acc = fmaf(qv.z, kv.z, acc); acc = fmaf(qv.w, kv.w, acc);
      }
      s[half][r] = acc;
    }
  }
  float tv[2]; int ti[2];
#pragma unroll
  for (int half = 0; half < 2; ++half) {
    float a0 = s[half][0], a1 = s[half][1];
    float keepv = 0.f; int keepi = 0;
    for (int r = 0; r < 16; ++r) {
      float bv; int bi;
      if (a0 >= a1) { bv = a0; bi = lane; } else { bv = a1; bi = lane + 64; }
#pragma unroll
      for (int o = 32; o > 0; o >>= 1) {
        float ov = __shfl_xor(bv, o); int oi = __shfl_xor(bi, o);
        if (ov > bv || (ov == bv && oi < bi)) { bv = ov; bi = oi; }
      }
      if (lane == r) { keepv = bv; keepi = bi; }
      if (bi == lane) a0 = -INFINITY;
      if (bi == lane + 64) a1 = -INFINITY;
    }
    tv[half] = keepv; ti[half] = keepi;
  }
  float cv[4];
  const int a = lane >> 2;
  const float va = __shfl(tv[0], a);
#pragma unroll
  for (int j = 0; j < 4; ++j) {
    int bb = (lane & 3) * 4 + j;
    cv[j] = va + __shfl(tv[1], bb);
  }
  float topv = 0.f; int topp = 0;
  for (int r = 0; r < 16; ++r) {
    float bv = cv[0]; int bi = lane * 4;
#pragma unroll
    for (int j = 1; j < 4; ++j) if (cv[j] > bv) { bv = cv[j]; bi = lane * 4 + j; }
#pragma unroll
    for (int o = 32; o > 0; o >>= 1) {
      float ov = __shfl_xor(bv, o); int oi = __shfl_xor(bi, o);
      if (ov > bv || (ov == bv && oi < bi)) { bv = ov; bi = oi; }
    }
    if (lane == r) { topv = bv; topp = bi; }
    if ((bi >> 2) == lane) {
#pragma unroll
      for (int j = 0; j < 4; ++j) if ((bi & 3) == j) cv[j] = -INFINITY;
    }
  }
  int pa = topp >> 4, pb = topp & 15;
  int e1 = __shfl(ti[0], pa), e2 = __shfl(ti[1], pb);
  int e = e1 * 128 + e2;
  float m = (lane < 16) ? topv : -INFINITY;
  m = wave_max(m);
  float ex = (lane < 16) ? expf(topv - m) : 0.f;
  float sum = wave_sum(ex);
  if (lane < 16) {
    eidx[(size_t)wid * 16 + lane] = e;
    egate[(size_t)wid * 16 + lane] = ex / sum;
  }
}

__device__ __forceinline__ void k_peer_experts(const int VB, float* smem, const float* __restrict__ hn, const int* __restrict__ eidx, const float* __restrict__ egate,
                                                      const float* __restrict__ down, const float* __restrict__ up,
                                                      float* __restrict__ out  ) {
  float (*red)[1024] = (float (*)[1024])smem;
  const int t = VB, tid = threadIdx.x, w = tid >> 6, lane = tid & 63;
  float4 x[4];
#pragma unroll
  for (int i = 0; i < 4; ++i) x[i] = *(const float4*)(hn + (size_t)t * DM + (i * 64 + lane) * 4);
  float4 acc[4];
#pragma unroll
  for (int i = 0; i < 4; ++i) acc[i] = make_float4(0.f, 0.f, 0.f, 0.f);
  for (int k = 0; k < 32; ++k) {
    const int slot = t * 128 + w * 32 + k;
    const int e = eidx[slot];
    const float g = egate[slot];
    const float* dr = down + (size_t)e * DM;
    float dot = 0.f;
#pragma unroll
    for (int i = 0; i < 4; ++i) {
      float4 dv = *(const float4*)(dr + (i * 64 + lane) * 4);
      dot = fmaf(dv.x, x[i].x, dot); dot = fmaf(dv.y, x[i].y, dot); dot = fmaf(dv.z, x[i].z, dot); dot = fmaf(dv.w, x[i].w, dot);
    }
    dot = wave_sum(dot);
    const float coef = g * gelu_f(dot);
    const float* ur = up + (size_t)e * DM;
#pragma unroll
    for (int i = 0; i < 4; ++i) {
      float4 uv = *(const float4*)(ur + (i * 64 + lane) * 4);
      acc[i].x = fmaf(coef, uv.x, acc[i].x); acc[i].y = fmaf(coef, uv.y, acc[i].y);
      acc[i].z = fmaf(coef, uv.z, acc[i].z); acc[i].w = fmaf(coef, uv.w, acc[i].w);
    }
  }
#pragma unroll
  for (int i = 0; i < 4; ++i) *(float4*)(&red[w][(i * 64 + lane) * 4]) = acc[i];
  __syncthreads();
  {
    float4 a = *(float4*)(&red[0][tid * 4]);
    float4 b = *(float4*)(&red[1][tid * 4]);
    float4 c = *(float4*)(&red[2][tid * 4]);
    float4 d = *(float4*)(&red[3][tid * 4]);
    float4 hv = *(float4*)(out + (size_t)t * DM + tid * 4);
    hv.x += (a.x + b.x) + (c.x + d.x); hv.y += (a.y + b.y) + (c.y + d.y);
    hv.z += (a.z + b.z) + (c.z + d.z); hv.w += (a.w + b.w) + (c.w + d.w);
    *(float4*)(out + (size_t)t * DM + tid * 4) = hv;
  }
}

struct Params {
  const float *x, *mem, *mix_norm_w, *w_in, *conv_w, *conv_b, *dt_bias, *a_log, *ssd_d, *ssd_norm_w, *mq_norm_w, *mk_norm_w,
      *mem_norm_w, *w_mem_kv, *xq_norm_w, *xk_norm_w, *w_out, *ffn_norm_w, *w_query, *sk1, *sk2, *e_down, *e_up;
  float *out, *bufA, *proj, *dt, *kmean, *memn, *memkv;
  int* sel;
};

#define PHASE(NBLK, CALL)                                                   \
  for (int VB = blockIdx.x; VB < (NBLK); VB += gridDim.x) { CALL; __syncthreads(); }

__global__ __launch_bounds__(256) void fwd_megakernel(Params p) {
  __shared__ __attribute__((aligned(16))) float smem[4096];
  cg::grid_group grid = cg::this_grid();
  float* xn = p.bufA; float* mixed = p.bufA; float* xbc = p.out; float* proj = p.proj; float* out = p.out;
  PHASE(NT, k_rmsnorm(VB, smem, p.x, p.mix_norm_w, xn));
  PHASE(NB * MEM, k_rmsnorm(VB, smem, p.mem, p.mem_norm_w, p.memn));
  grid.sync();
  PHASE(((INC + 63) / 64) * (NT / 64), k_gemm(VB, smem, xn, DM, p.w_in, INC, proj, INC, nullptr, 0, NT, INC, DM));
  PHASE((512 / 64) * (NB * MEM / 64), k_gemm(VB, smem, p.memn, DM, p.w_mem_kv, 512, p.memkv, 512, nullptr, 0, NB * MEM, 512, DM));
  grid.sync();
  PHASE(NT * 1024 / 256, k_conv(VB, smem, proj, p.conv_w, p.conv_b, xbc));
  PHASE(NT * 8 / 256, k_dt(VB, smem, proj, p.dt_bias, p.dt));
  PHASE(NT, k_headnorm(VB, smem, proj, INC, OFF_MQ, p.mq_norm_w, proj, INC, OFF_MQ, NT));
  PHASE(NT, k_headnorm(VB, smem, proj, INC, OFF_MK, p.mk_norm_w, proj, INC, OFF_MK, NT));
  PHASE(NT, k_headnorm(VB, smem, proj, INC, OFF_XQ, p.xq_norm_w, proj, INC, OFF_XQ, NT));
  PHASE(NB * MEM, k_headnorm(VB, smem, p.memkv, 512, 0, p.xk_norm_w, p.memkv, 512, 0, NB * MEM));
  grid.sync();
  PHASE(NB * 8 * 4, k_ssd_scan(VB, smem, xbc, p.dt, p.a_log, p.ssd_d, mixed));
  PHASE(NB * 4 * 32 * 64 / 256, k_kmean(VB, smem, proj, INC, OFF_MK, p.kmean));
  PHASE(NT, k_attn<1>(VB, smem, proj, INC, OFF_XQ, p.memkv, 512, 0, p.memkv, 512, 256, nullptr, mixed, 768));
  grid.sync();
  PHASE(NT, k_ssd_post(VB, smem, mixed, proj, p.ssd_norm_w, mixed));
  PHASE(NT * 4 / 256, k_gate(VB, smem, proj, INC, OFF_MQ, p.kmean, p.sel));
  grid.sync();
  PHASE(NT, k_attn<0>(VB, smem, proj, INC, OFF_MQ, proj, INC, OFF_MK, proj, INC, OFF_MV, p.sel, mixed, 512));
  grid.sync();
  PHASE((DM / 64) * (NT / 64), k_gemm(VB, smem, mixed, DM, p.w_out, DM, out, DM, p.x, DM, NT, DM, DM));
  grid.sync();
  float* hn = proj;
  float* q = proj + (size_t)NT * DM;
  int* eidx = (int*)(proj + (size_t)2 * NT * DM);
  float* egate = proj + (size_t)2 * NT * DM + (size_t)NT * 128;
  PHASE(NT, k_rmsnorm(VB, smem, out, p.ffn_norm_w, hn));
  grid.sync();
  PHASE((DM / 64) * (NT / 64), k_gemm(VB, smem, hn, DM, p.w_query, DM, q, DM, nullptr, 0, NT, DM, DM));
  grid.sync();
  PHASE(NT * 8 / 4, k_peer_route(VB, smem, q, p.sk1, p.sk2, eidx, egate));
  grid.sync();
  PHASE(NT, k_peer_experts(VB, smem, hn, eidx, egate, p.e_down, p.e_up, out));
}
}

extern "C" void kernel_launch(void* const* d_in, const int* in_sizes, int n_in, void* d_out, int out_size, void* d_ws, size_t ws_size,
                              hipStream_t stream) {
  Params p{};
  p.x = (const float*)d_in[0]; p.mem = (const float*)d_in[1]; p.mix_norm_w = (const float*)d_in[2]; p.w_in = (const float*)d_in[3];
  p.conv_w = (const float*)d_in[4]; p.conv_b = (const float*)d_in[5]; p.dt_bias = (const float*)d_in[6]; p.a_log = (const float*)d_in[7];
  p.ssd_d = (const float*)d_in[8]; p.ssd_norm_w = (const float*)d_in[9]; p.mq_norm_w = (const float*)d_in[10]; p.mk_norm_w = (const float*)d_in[11];
  p.mem_norm_w = (const float*)d_in[12]; p.w_mem_kv = (const float*)d_in[13]; p.xq_norm_w = (const float*)d_in[14]; p.xk_norm_w = (const float*)d_in[15];
  p.w_out = (const float*)d_in[16]; p.ffn_norm_w = (const float*)d_in[17]; p.w_query = (const float*)d_in[18]; p.sk1 = (const float*)d_in[19];
  p.sk2 = (const float*)d_in[20]; p.e_down = (const float*)d_in[21]; p.e_up = (const float*)d_in[22];
  p.out = (float*)d_out;
  float* ws = (float*)d_ws;
  size_t o = 0;
  auto take = [&](size_t n) { float* q = ws + o; o += (n + 63) & ~(size_t)63; return q; };
  p.bufA = take((size_t)NT * DM);
  p.proj = take((size_t)NT * INC);
  p.dt = take((size_t)NT * 8);
  p.kmean = take(NB * 4 * 32 * 64);
  p.sel = (int*)take((size_t)NT * 4 * 3);
  p.memn = take((size_t)NB * MEM * DM);
  p.memkv = take((size_t)NB * MEM * 512);
  if (o * sizeof(float) > ws_size) return;
  static int grid_blocks = 0;
  if (!grid_blocks) {
    int dev = 0, cus = 0, per_cu = 0;
    hipGetDevice(&dev);
    hipDeviceGetAttribute(&cus, hipDeviceAttributeMultiprocessorCount, dev);
    hipOccupancyMaxActiveBlocksPerMultiprocessor(&per_cu, fwd_megakernel, 256, 0);
    if (per_cu > 2) per_cu = 2;
    grid_blocks = cus * per_cu;
  }
  void* args[] = {&p};
  hipError_t e = hipLaunchCooperativeKernel((void*)fwd_megakernel, dim3(grid_blocks), dim3(256), args, 0, stream);
  if (e != hipSuccess) fprintf(stderr, "cooperative launch failed: %s (grid %d)\n", hipGetErrorString(e), grid_blocks);
}
```

```cpp
#include <hip/hip_runtime.h>
#include <hip/hip_cooperative_groups.h>
#include <cstdio>
#include <math.h>
#include <stdint.h>
namespace cg = cooperative_groups;

namespace {
typedef unsigned short ushort_t;
typedef __attribute__((ext_vector_type(8))) short bf16x8;
typedef __attribute__((ext_vector_type(16))) float f32x16;

constexpr int DM = 1024;
constexpr int NB = 2;
constexpr int SL = 8192;
constexpr int NT = NB * SL;
constexpr int MEM = 256;
constexpr int INC = 2568;
constexpr int NPROJ = 2560;
constexpr float EPS = 1e-6f;
constexpr int SMEM_BYTES = 65536;

__device__ __forceinline__ float silu_f(float x) { return x / (1.f + expf(-x)); }
__device__ __forceinline__ float softplus_f(float x) { return fmaxf(x, 0.f) + log1pf(expf(-fabsf(x))); }
__device__ __forceinline__ float gelu_f(float x) { return 0.5f * x * (1.f + erff(x * 0.70710678118654752f)); }
__device__ __forceinline__ ushort_t f2bf(float x) {
  unsigned u = __float_as_uint(x);
  u += 0x7fffu + ((u >> 16) & 1u);
  return (ushort_t)(u >> 16);
}
__device__ __forceinline__ float bf2f(ushort_t h) { return __uint_as_float(((unsigned)h) << 16); }
__device__ __forceinline__ float bflo(unsigned w) { return __uint_as_float(w << 16); }
__device__ __forceinline__ float bfhi(unsigned w) { return __uint_as_float(w & 0xffff0000u); }
__device__ __forceinline__ unsigned pack2(float a, float b) { return (unsigned)f2bf(a) | ((unsigned)f2bf(b) << 16); }

__device__ __forceinline__ float wave_sum(float v) {
#pragma unroll
  for (int o = 32; o > 0; o >>= 1) v += __shfl_xor(v, o);
  return v;
}
__device__ __forceinline__ float wave_max(float v) {
#pragma unroll
  for (int o = 32; o > 0; o >>= 1) v = fmaxf(v, __shfl_xor(v, o));
  return v;
}

struct Params {
  const float *x, *mem, *mix_norm_w, *w_in, *conv_w, *conv_b, *dt_bias, *a_log, *ssd_d, *ssd_norm_w, *mq_norm_w, *mk_norm_w,
      *mem_norm_w, *w_mem_kv, *xq_norm_w, *xk_norm_w, *w_out, *ffn_norm_w, *w_query, *sk1, *sk2, *e_down, *e_up;
  float* out;
  ushort_t *xn_b, *w_inT, *w_outT, *w_qT, *w_memT, *memn_b, *zs, *xbc_raw, *mq, *mk, *mv, *xq, *memk_b, *memv_b, *mixed_b, *ed_b, *eu_b;
  float *dt, *kmean, *q, *egate, *ytmp;
  int *sel, *eidx;
};

__device__ __forceinline__ void ph_rmsnorm_bf16(const int row, float* smem, const float* __restrict__ x, const float* __restrict__ w,
                                                ushort_t* __restrict__ outb, const float* __restrict__ w_in, const float* __restrict__ dt_bias,
                                                float* __restrict__ dt) {
  float* red = smem;
  float* red2 = smem + 8;
  const int tid = threadIdx.x;
  float4 v = *(const float4*)(x + (size_t)row * DM + tid * 4);
  float ss = v.x * v.x + v.y * v.y + v.z * v.z + v.w * v.w;
  ss = wave_sum(ss);
  if ((tid & 63) == 0) red[tid >> 6] = ss;
  __syncthreads();
  float tot = red[0] + red[1] + red[2] + red[3];
  float r = rsqrtf(tot / DM + EPS);
  float4 ww = *(const float4*)(w + tid * 4);
  float o0 = v.x * r * ww.x, o1 = v.y * r * ww.y, o2 = v.z * r * ww.z, o3 = v.w * r * ww.w;
  uint2 pk;
  pk.x = pack2(o0, o1);
  pk.y = pack2(o2, o3);
  *(uint2*)(outb + (size_t)row * DM + tid * 4) = pk;
  if (dt) {
    float part[8];
#pragma unroll
    for (int hh = 0; hh < 8; ++hh) part[hh] = 0.f;
    const float xs[4] = {o0, o1, o2, o3};
#pragma unroll
    for (int i = 0; i < 4; ++i) {
      const float* wr = w_in + (size_t)(tid * 4 + i) * INC + 1536;
      float4 a = *(const float4*)(wr);
      float4 b = *(const float4*)(wr + 4);
      part[0] = fmaf(xs[i], a.x, part[0]); part[1] = fmaf(xs[i], a.y, part[1]);
      part[2] = fmaf(xs[i], a.z, part[2]); part[3] = fmaf(xs[i], a.w, part[3]);
      part[4] = fmaf(xs[i], b.x, part[4]); part[5] = fmaf(xs[i], b.y, part[5]);
      part[6] = fmaf(xs[i], b.z, part[6]); part[7] = fmaf(xs[i], b.w, part[7]);
    }
#pragma unroll
    for (int hh = 0; hh < 8; ++hh) {
      float s = wave_sum(part[hh]);
      if ((tid & 63) == 0) red2[(tid >> 6) * 8 + hh] = s;
    }
    __syncthreads();
    if (tid < 8) {
      float s = red2[tid] + red2[8 + tid] + red2[16 + tid] + red2[24 + tid];
      dt[(size_t)row * 8 + tid] = softplus_f(s + dt_bias[tid]);
    }
  }
}

__device__ __forceinline__ void ph_wtrans(const int vb, float* smem, const float* __restrict__ W, const int ldw, ushort_t* __restrict__ Wt,
                                          const int ntiles, const int skip) {
  float (*s)[65] = (float (*)[65])smem;
  const int tid = threadIdx.x;
  const int kt = vb / ntiles, nt = vb % ntiles;
  const int nd0 = nt * 64;
  const int ns0 = (nd0 < 1536) ? nd0 : nd0 + skip;
  {
    const int k = tid >> 2, nc = (tid & 3) * 16;
    const float* src = W + (size_t)(kt * 64 + k) * ldw + ns0 + nc;
#pragma unroll
    for (int j = 0; j < 4; ++j) {
      float4 v = *(const float4*)(src + j * 4);
      s[k][nc + j * 4 + 0] = v.x; s[k][nc + j * 4 + 1] = v.y; s[k][nc + j * 4 + 2] = v.z; s[k][nc + j * 4 + 3] = v.w;
    }
  }
  __syncthreads();
  {
    const int n = tid >> 2, kc = (tid & 3) * 16;
    unsigned pk[8];
#pragma unroll
    for (int j = 0; j < 8; ++j) pk[j] = pack2(s[kc + 2 * j][n], s[kc + 2 * j + 1][n]);
    ushort_t* dst = Wt + (size_t)(nd0 + n) * DM + kt * 64 + kc;
    *(uint4*)(dst) = make_uint4(pk[0], pk[1], pk[2], pk[3]);
    *(uint4*)(dst + 8) = make_uint4(pk[4], pk[5], pk[6], pk[7]);
  }
}

__device__ __forceinline__ void ph_cvt(const int vb, const float* __restrict__ src, ushort_t* __restrict__ dst) {
  const size_t i = ((size_t)vb * 256 + threadIdx.x) * 8;
  float4 a = *(const float4*)(src + i);
  float4 b = *(const float4*)(src + i + 4);
  *(uint4*)(dst + i) = make_uint4(pack2(a.x, a.y), pack2(a.z, a.w), pack2(b.x, b.y), pack2(b.z, b.w));
}

__device__ __forceinline__ int swz(int row, int ch) { return row * 128 + ((ch ^ ((row >> 1) & 7)) << 4); }

__device__ __forceinline__ void gemm_core(const ushort_t* __restrict__ A, const ushort_t* __restrict__ Bt, const int K, const int m0,
                                          const int n0, char* smem, f32x16 (&acc)[2][2]) {
  const int tid = threadIdx.x, lane = tid & 63, wave = tid >> 6;
  const int wm = wave >> 1, wn = wave & 1;
  const int r = lane & 31, h = lane >> 5;
  const int srow = tid >> 3, sch = tid & 7;
  const ushort_t* Ag = A + (size_t)(m0 + srow) * K + sch * 8;
  const ushort_t* Bg = Bt + (size_t)(n0 + srow) * K + sch * 8;
  uint4 ra[4], rb[4];
#pragma unroll
  for (int p = 0; p < 4; ++p) {
    ra[p] = *(const uint4*)(Ag + (size_t)p * 32 * K);
    rb[p] = *(const uint4*)(Bg + (size_t)p * 32 * K);
  }
#pragma unroll
  for (int i = 0; i < 2; ++i)
#pragma unroll
    for (int j = 0; j < 2; ++j)
#pragma unroll
      for (int e = 0; e < 16; ++e) acc[i][j][e] = 0.f;
#pragma unroll
  for (int p = 0; p < 4; ++p) {
    *(uint4*)(smem + swz(srow + p * 32, sch)) = ra[p];
    *(uint4*)(smem + 16384 + swz(srow + p * 32, sch)) = rb[p];
  }
  __syncthreads();
  const int nk = K >> 6;
  const int xr = (r >> 1) & 7;
  const int arow = (wm * 64 + r) * 128, brow = (wn * 64 + r) * 128;
  for (int kt = 0; kt < nk; ++kt) {
    const char* cA = smem + (kt & 1) * 32768;
    const char* cB = cA + 16384;
    if (kt + 1 < nk) {
#pragma unroll
      for (int p = 0; p < 4; ++p) {
        ra[p] = *(const uint4*)(Ag + (size_t)p * 32 * K + (kt + 1) * 64);
        rb[p] = *(const uint4*)(Bg + (size_t)p * 32 * K + (kt + 1) * 64);
      }
    }
#pragma unroll
    for (int ks = 0; ks < 4; ++ks) {
      const int co = ((ks * 2 + h) ^ xr) << 4;
      bf16x8 a0 = *(const bf16x8*)(cA + arow + co);
      bf16x8 a1 = *(const bf16x8*)(cA + arow + 32 * 128 + co);
      bf16x8 b0 = *(const bf16x8*)(cB + brow + co);
      bf16x8 b1 = *(const bf16x8*)(cB + brow + 32 * 128 + co);
      acc[0][0] = __builtin_amdgcn_mfma_f32_32x32x16_bf16(a0, b0, acc[0][0], 0, 0, 0);
      acc[0][1] = __builtin_amdgcn_mfma_f32_32x32x16_bf16(a0, b1, acc[0][1], 0, 0, 0);
      acc[1][0] = __builtin_amdgcn_mfma_f32_32x32x16_bf16(a1, b0, acc[1][0], 0, 0, 0);
      acc[1][1] = __builtin_amdgcn_mfma_f32_32x32x16_bf16(a1, b1, acc[1][1], 0, 0, 0);
    }
    if (kt + 1 < nk) {
      char* nA = smem + ((kt + 1) & 1) * 32768;
#pragma unroll
      for (int p = 0; p < 4; ++p) {
        *(uint4*)(nA + swz(srow + p * 32, sch)) = ra[p];
        *(uint4*)(nA + 16384 + swz(srow + p * 32, sch)) = rb[p];
      }
    }
    __syncthreads();
  }
}

enum { EP_SILU = 0, EP_PLAIN = 1, EP_HEADNORM = 2 };

__device__ __forceinline__ void epi_bf16(const f32x16 (&acc)[2][2], const int mode, ushort_t* __restrict__ dst, const int ld,
                                         const int row0, const int col0, const float* __restrict__ nw) {
  const int lane = threadIdx.x & 63, r = lane & 31, h = lane >> 5;
  float w0 = 1.f, w1 = 1.f;
  if (mode == EP_HEADNORM) { w0 = nw[r]; w1 = nw[32 + r]; }
#pragma unroll
  for (int mi = 0; mi < 2; ++mi) {
#pragma unroll
    for (int e = 0; e < 16; ++e) {
      const int row = row0 + mi * 32 + (e & 3) + 8 * (e >> 2) + 4 * h;
      float v0 = acc[mi][0][e], v1 = acc[mi][1][e];
      if (mode == EP_SILU) { v0 = silu_f(v0); v1 = silu_f(v1); }
      if (mode == EP_HEADNORM) {
        float ss = v0 * v0 + v1 * v1;
        ss += __shfl_xor(ss, 1); ss += __shfl_xor(ss, 2); ss += __shfl_xor(ss, 4); ss += __shfl_xor(ss, 8); ss += __shfl_xor(ss, 16);
        const float rs = rsqrtf(ss * (1.f / 64.f) + EPS);
        v0 = v0 * rs * w0; v1 = v1 * rs * w1;
      }
      dst[(size_t)row * ld + col0 + r] = f2bf(v0);
      dst[(size_t)row * ld + col0 + 32 + r] = f2bf(v1);
    }
  }
}

__device__ __forceinline__ void epi_f32(const f32x16 (&acc)[2][2], float* __restrict__ dst, const int ld, const int row0, const int col0,
                                        const float* __restrict__ resid) {
  const int lane = threadIdx.x & 63, r = lane & 31, h = lane >> 5;
#pragma unroll
  for (int mi = 0; mi < 2; ++mi) {
#pragma unroll
    for (int e = 0; e < 16; ++e) {
      const int row = row0 + mi * 32 + (e & 3) + 8 * (e >> 2) + 4 * h;
#pragma unroll
      for (int ni = 0; ni < 2; ++ni) {
        const size_t idx = (size_t)row * ld + col0 + ni * 32 + r;
        float v = acc[mi][ni][e];
        if (resid) v += resid[idx];
        dst[idx] = v;
      }
    }
  }
}

__device__ __forceinline__ void ph_gemm_proj(const int vb, char* smem, const Params& p) {
  const int nt = vb % 20, mt = vb / 20;
  const int m0 = mt * 128, n0 = nt * 128;
  f32x16 acc[2][2];
  gemm_core(p.xn_b, p.w_inT, DM, m0, n0, smem, acc);
  const int wave = threadIdx.x >> 6, wm = wave >> 1, wn = wave & 1;
  const int row0 = m0 + wm * 64;
  const int c = n0 + wn * 64;
  if (c < 512) epi_bf16(acc, EP_SILU, p.zs, 512, row0, c, nullptr);
  else if (c < 1536) epi_bf16(acc, EP_PLAIN, p.xbc_raw, 1024, row0, c - 512, nullptr);
  else if (c < 1792) epi_bf16(acc, EP_HEADNORM, p.mq, 256, row0, c - 1536, p.mq_norm_w);
  else if (c < 2048) epi_bf16(acc, EP_HEADNORM, p.mk, 256, row0, c - 1792, p.mk_norm_w);
  else if (c < 2304) epi_bf16(acc, EP_PLAIN, p.mv, 256, row0, c - 2048, nullptr);
  else epi_bf16(acc, EP_HEADNORM, p.xq, 256, row0, c - 2304, p.xq_norm_w);
}

__device__ __forceinline__ void ph_gemm_mem(const int vb, char* smem, const Params& p) {
  const int nt = vb % 4, mt = vb / 4;
  const int m0 = mt * 128, n0 = nt * 128;
  f32x16 acc[2][2];
  gemm_core(p.memn_b, p.w_memT, DM, m0, n0, smem, acc);
  const int wave = threadIdx.x >> 6, wm = wave >> 1, wn = wave & 1;
  const int row0 = m0 + wm * 64;
  const int c = n0 + wn * 64;
  if (c < 256) epi_bf16(acc, EP_HEADNORM, p.memk_b, 256, row0, c, p.xk_norm_w);
  else epi_bf16(acc, EP_PLAIN, p.memv_b, 256, row0, c - 256, nullptr);
}

__device__ __forceinline__ void ph_gemm_f32(const int vb, char* smem, const ushort_t* A, const ushort_t* Bt, float* dst, const float* resid) {
  const int nt = vb % 8, mt = vb / 8;
  const int m0 = mt * 128, n0 = nt * 128;
  f32x16 acc[2][2];
  gemm_core(A, Bt, DM, m0, n0, smem, acc);
  const int wave = threadIdx.x >> 6, wm = wave >> 1, wn = wave & 1;
  epi_f32(acc, dst, DM, m0 + wm * 64, n0 + wn * 64, resid);
}

__device__ __forceinline__ void k_conv(const int VB, const ushort_t* __restrict__ raw, const float* __restrict__ cw, const float* __restrict__ cb,
                                       float* __restrict__ out) {
  size_t i = (size_t)VB * 256 + threadIdx.x;
  int c = (int)(i & 1023);
  int t = (int)(i >> 10);
  int l = t & (SL - 1);
  float acc = cb[c];
#pragma unroll
  for (int k = 0; k < 4; ++k) {
    int ll = l - 3 + k;
    if (ll >= 0) acc = fmaf(cw[k * 1024 + c], bf2f(raw[(size_t)(t - 3 + k) * 1024 + c]), acc);
  }
  out[i] = silu_f(acc);
}

__device__ __forceinline__ void k_ssd_scan(const int VB, const float* __restrict__ xbc, const float* __restrict__ dt,
                                           const float* __restrict__ a_log, const float* __restrict__ dsk, float* __restrict__ y) {
  const int blk = VB;
  const int pg = blk & 3, h = (blk >> 2) & 7, b = blk >> 5;
  const int tid = threadIdx.x, ng = tid & 15, pl = tid >> 4;
  const int p = pg * 16 + pl;
  const int g = h >> 2;
  const float a_coef = -expf(a_log[h]);
  const float dskip = dsk[h];
  float st[8];
#pragma unroll
  for (int i = 0; i < 8; ++i) st[i] = 0.f;
  for (int l = 0; l < SL; ++l) {
    const size_t t = (size_t)b * SL + l;
    const float* row = xbc + t * 1024;
    const float xv = row[h * 64 + p];
    const float4 b0 = *(const float4*)(row + 512 + g * 128 + ng * 8);
    const float4 b1 = *(const float4*)(row + 512 + g * 128 + ng * 8 + 4);
    const float4 c0 = *(const float4*)(row + 768 + g * 128 + ng * 8);
    const float4 c1 = *(const float4*)(row + 768 + g * 128 + ng * 8 + 4);
    const float dtv = dt[t * 8 + h];
    const float dA = expf(dtv * a_coef);
    const float xd = xv * dtv;
    const float bb[8] = {b0.x, b0.y, b0.z, b0.w, b1.x, b1.y, b1.z, b1.w};
    const float cc[8] = {c0.x, c0.y, c0.z, c0.w, c1.x, c1.y, c1.z, c1.w};
    float yp = 0.f;
#pragma unroll
    for (int i = 0; i < 8; ++i) {
      st[i] = fmaf(st[i], dA, xd * bb[i]);
      yp = fmaf(st[i], cc[i], yp);
    }
    yp += __shfl_xor(yp, 1);
    yp += __shfl_xor(yp, 2);
    yp += __shfl_xor(yp, 4);
    yp += __shfl_xor(yp, 8);
    if (ng == 0) y[t * 512 + h * 64 + p] = yp + xv * dskip;
  }
}

__device__ __forceinline__ void k_ssd_post(const int VB, float* smem, const float* __restrict__ y, const ushort_t* __restrict__ zs,
                                           const float* __restrict__ nw, ushort_t* __restrict__ mixed) {
  float (*red)[4] = (float (*)[4])smem;
  const int t = VB, tid = threadIdx.x;
  float v0 = y[(size_t)t * 512 + tid] * bf2f(zs[(size_t)t * 512 + tid]);
  float v1 = y[(size_t)t * 512 + 256 + tid] * bf2f(zs[(size_t)t * 512 + 256 + tid]);
  float s0 = wave_sum(v0 * v0), s1 = wave_sum(v1 * v1);
  if ((tid & 63) == 0) { red[0][tid >> 6] = s0; red[1][tid >> 6] = s1; }
  __syncthreads();
  float t0 = red[0][0] + red[0][1] + red[0][2] + red[0][3];
  float t1 = red[1][0] + red[1][1] + red[1][2] + red[1][3];
  mixed[(size_t)t * DM + tid] = f2bf(v0 * rsqrtf(t0 / 256.f + EPS) * nw[tid]);
  mixed[(size_t)t * DM + 256 + tid] = f2bf(v1 * rsqrtf(t1 / 256.f + EPS) * nw[256 + tid]);
}

__device__ __forceinline__ void k_kmean(const int VB, const ushort_t* __restrict__ kn, float* __restrict__ kmean) {
  int i = VB * 256 + threadIdx.x;
  int d = i & 63, blk = (i >> 6) & 31, h = (i >> 11) & 3, b = i >> 13;
  float s = 0.f;
  for (int j = 0; j < 256; ++j) s += bf2f(kn[((size_t)b * SL + blk * 256 + j) * 256 + h * 64 + d]);
  kmean[i] = s * (1.f / 256.f);
}

__device__ __forceinline__ void load_q64(const ushort_t* __restrict__ src, float (&q)[64]) {
#pragma unroll
  for (int d = 0; d < 64; d += 8) {
    uint4 v = *(const uint4*)(src + d);
    q[d] = bflo(v.x); q[d + 1] = bfhi(v.x); q[d + 2] = bflo(v.y); q[d + 3] = bfhi(v.y);
    q[d + 4] = bflo(v.z); q[d + 5] = bfhi(v.z); q[d + 6] = bflo(v.w); q[d + 7] = bfhi(v.w);
  }
}

__device__ __forceinline__ void k_gate(const int VB, const ushort_t* __restrict__ qn, const float* __restrict__ kmean, int* __restrict__ sel) {
  int i = VB * 256 + threadIdx.x;
  int h = i & 3, t = i >> 2;
  int b = t / SL, l = t % SL;
  int own = l >> 8;
  float q[64];
  load_q64(qn + (size_t)t * 256 + h * 64, q);
  float v0 = -INFINITY, v1 = -INFINITY, v2 = -INFINITY;
  int i0 = 0, i1 = 1, i2 = 2;
  for (int n = 0; n < own; ++n) {
    const float* km = kmean + ((size_t)(b * 4 + h) * 32 + n) * 64;
    float s = 0.f;
#pragma unroll
    for (int d = 0; d < 64; d += 4) {
      float4 kv = *(const float4*)(km + d);
      s = fmaf(q[d], kv.x, s); s = fmaf(q[d + 1], kv.y, s); s = fmaf(q[d + 2], kv.z, s); s = fmaf(q[d + 3], kv.w, s);
    }
    if (s > v0) { v2 = v1; i2 = i1; v1 = v0; i1 = i0; v0 = s; i0 = n; }
    else if (s > v1) { v2 = v1; i2 = i1; v1 = s; i1 = n; }
    else if (s > v2) { v2 = s; i2 = n; }
  }
  sel[i * 3 + 0] = i0; sel[i * 3 + 1] = i1; sel[i * 3 + 2] = i2;
}

template <int MODE>
__device__ __forceinline__ void k_attn(const int VB, const ushort_t* __restrict__ qn, const ushort_t* __restrict__ kn, const ushort_t* __restrict__ vv,
                                       const int* __restrict__ sel, ushort_t* __restrict__ mixed, int moff) {
  const int wid = (VB * 256 + threadIdx.x) >> 6;
  const int lane = threadIdx.x & 63;
  const int h = wid & 3, t = wid >> 2;
  const int b = t / SL, l = t % SL;
  const int own = l >> 8;
  const float slope = exp2f(-8.f * (h + 1) / 4.f);
  float q[64];
  load_q64(qn + (size_t)t * 256 + h * 64, q);
  constexpr int NBLK = (MODE == 0) ? 4 : 1;
  float o[64];
#pragma unroll
  for (int d = 0; d < 64; ++d) o[d] = 0.f;
  float mrun = -INFINITY, sum = 0.f;
#pragma unroll 1
  for (int j = 0; j < NBLK; ++j) {
    int blk = 0, kbase;
    if (MODE == 0) {
      if (j < 3) { if (j >= own) continue; blk = sel[(size_t)wid * 3 + j]; }
      else blk = own;
      kbase = b * SL + blk * 256;
    } else kbase = b * MEM;
#pragma unroll 1
    for (int i = 0; i < 4; ++i) {
      const int kk = lane + i * 64;
      const ushort_t* kr = kn + (size_t)(kbase + kk) * 256 + h * 64;
      float s = 0.f;
#pragma unroll
      for (int d = 0; d < 64; d += 8) {
        uint4 kv = *(const uint4*)(kr + d);
        s = fmaf(q[d], bflo(kv.x), s); s = fmaf(q[d + 1], bfhi(kv.x), s); s = fmaf(q[d + 2], bflo(kv.y), s); s = fmaf(q[d + 3], bfhi(kv.y), s);
        s = fmaf(q[d + 4], bflo(kv.z), s); s = fmaf(q[d + 5], bfhi(kv.z), s); s = fmaf(q[d + 6], bflo(kv.w), s); s = fmaf(q[d + 7], bfhi(kv.w), s);
      }
      s *= 0.125f;
      if (MODE == 0) {
        const int spos = blk * 256 + kk;
        s -= slope * fabsf((float)(l - spos));
        if (j == 3 && spos > l) s = -INFINITY;
      }
      const float mnew = fmaxf(mrun, wave_max(s));
      float pe = 0.f;
      if (mnew > -INFINITY) {
        const float f = expf(mrun - mnew);
        sum *= f;
#pragma unroll
        for (int d = 0; d < 64; ++d) o[d] *= f;
        pe = expf(s - mnew);
        mrun = mnew;
      }
      sum += pe;
      const ushort_t* vr = vv + (size_t)(kbase + kk) * 256 + h * 64;
#pragma unroll
      for (int d = 0; d < 64; d += 8) {
        uint4 v4 = *(const uint4*)(vr + d);
        o[d] = fmaf(pe, bflo(v4.x), o[d]); o[d + 1] = fmaf(pe, bfhi(v4.x), o[d + 1]);
        o[d + 2] = fmaf(pe, bflo(v4.y), o[d + 2]); o[d + 3] = fmaf(pe, bfhi(v4.y), o[d + 3]);
        o[d + 4] = fmaf(pe, bflo(v4.z), o[d + 4]); o[d + 5] = fmaf(pe, bfhi(v4.z), o[d + 5]);
        o[d + 6] = fmaf(pe, bflo(v4.w), o[d + 6]); o[d + 7] = fmaf(pe, bfhi(v4.w), o[d + 7]);
      }
    }
  }
  sum = wave_sum(sum);
  const float inv = 1.f / sum;
  float mine = 0.f;
#pragma unroll
  for (int d = 0; d < 64; ++d) {
    float v = wave_sum(o[d]);
    if (lane == d) mine = v;
  }
  mixed[(size_t)t * DM + moff + h * 64 + lane] = f2bf(mine * inv);
}

__device__ __forceinline__ void k_peer_route(const int VB, const float* __restrict__ q, const float* __restrict__ k1, const float* __restrict__ k2,
                                             int* __restrict__ eidx, float* __restrict__ egate) {
  const int wid = (VB * 256 + threadIdx.x) >> 6;
  const int lane = threadIdx.x & 63;
  const float* qr = q + (size_t)wid * 128;
  float s[2][2];
#pragma unroll 1
  for (int half = 0; half < 2; ++half) {
    const float* keys = half ? k2 : k1;
#pragma unroll
    for (int rr = 0; rr < 2; ++rr) {
      const float* kr = keys + (size_t)(lane + rr * 64) * 64;
      float acc = 0.f;
#pragma unroll
      for (int d = 0; d < 64; d += 4) {
        float4 kv = *(const float4*)(kr + d);
        float4 qv = *(const float4*)(qr + half * 64 + d);
        acc = fmaf(qv.x, kv.x, acc); acc = fmaf(qv.y, kv.y, acc); acc = fmaf(qv.z, kv.z, acc); acc = fmaf(qv.w, kv.w, acc);
      }
      if (half == 0) s[0][rr] = acc; else s[1][rr] = acc;
    }
  }
  float tv[2]; int ti[2];
#pragma unroll
  for (int half = 0; half < 2; ++half) {
    float a0 = s[half][0], a1 = s[half][1];
    float keepv = 0.f; int keepi = 0;
    for (int rr = 0; rr < 16; ++rr) {
      float bv; int bi;
      if (a0 >= a1) { bv = a0; bi = lane; } else { bv = a1; bi = lane + 64; }
#pragma unroll
      for (int o = 32; o > 0; o >>= 1) {
        float ov = __shfl_xor(bv, o); int oi = __shfl_xor(bi, o);
        if (ov > bv || (ov == bv && oi < bi)) { bv = ov; bi = oi; }
      }
      if (lane == rr) { keepv = bv; keepi = bi; }
      if (bi == lane) a0 = -INFINITY;
      if (bi == lane + 64) a1 = -INFINITY;
    }
    tv[half] = keepv; ti[half] = keepi;
  }
  float cv[4];
  const int a = lane >> 2;
  const float va = __shfl(tv[0], a);
#pragma unroll
  for (int j = 0; j < 4; ++j) {
    int bb = (lane & 3) * 4 + j;
    cv[j] = va + __shfl(tv[1], bb);
  }
  float topv = 0.f; int topp = 0;
  for (int rr = 0; rr < 16; ++rr) {
    float bv = cv[0]; int bi = lane * 4;
#pragma unroll
    for (int j = 1; j < 4; ++j) if (cv[j] > bv) { bv = cv[j]; bi = lane * 4 + j; }
#pragma unroll
    for (int o = 32; o > 0; o >>= 1) {
      float ov = __shfl_xor(bv, o); int oi = __shfl_xor(bi, o);
      if (ov > bv || (ov == bv && oi < bi)) { bv = ov; bi = oi; }
    }
    if (lane == rr) { topv = bv; topp = bi; }
    if ((bi >> 2) == lane) {
#pragma unroll
      for (int j = 0; j < 4; ++j) if ((bi & 3) == j) cv[j] = -INFINITY;
    }
  }
  int pa = topp >> 4, pb = topp & 15;
  int e1 = __shfl(ti[0], pa), e2 = __shfl(ti[1], pb);
  int e = e1 * 128 + e2;
  float m = (lane < 16) ? topv : -INFINITY;
  m = wave_max(m);
  float ex = (lane < 16) ? expf(topv - m) : 0.f;
  float sum = wave_sum(ex);
  if (lane < 16) {
    eidx[(size_t)wid * 16 + lane] = e;
    egate[(size_t)wid * 16 + lane] = ex / sum;
  }
}

__device__ __forceinline__ void unpack8(const uint4 v, float (&f)[8]) {
  f[0] = bflo(v.x); f[1] = bfhi(v.x); f[2] = bflo(v.y); f[3] = bfhi(v.y);
  f[4] = bflo(v.z); f[5] = bfhi(v.z); f[6] = bflo(v.w); f[7] = bfhi(v.w);
}
__device__ __forceinline__ void k_peer_experts(const int VB, float* smem, const ushort_t* __restrict__ hn, const int* __restrict__ eidx,
                                               const float* __restrict__ egate, const ushort_t* __restrict__ down, const ushort_t* __restrict__ up,
                                               float* __restrict__ out) {
  float (*red)[1024] = (float (*)[1024])smem;
  const int t = VB, tid = threadIdx.x, w = tid >> 6, lane = tid & 63;
  float x0[8], x1[8];
  unpack8(*(const uint4*)(hn + (size_t)t * DM + lane * 8), x0);
  unpack8(*(const uint4*)(hn + (size_t)t * DM + 512 + lane * 8), x1);
  float a0[8], a1[8];
#pragma unroll
  for (int i = 0; i < 8; ++i) { a0[i] = 0.f; a1[i] = 0.f; }
  for (int k = 0; k < 32; ++k) {
    const int slot = t * 128 + w * 32 + k;
    const int e = eidx[slot];
    const float g = egate[slot];
    float d0[8], d1[8];
    unpack8(*(const uint4*)(down + (size_t)e * DM + lane * 8), d0);
    unpack8(*(const uint4*)(down + (size_t)e * DM + 512 + lane * 8), d1);
    float dot = 0.f;
#pragma unroll
    for (int i = 0; i < 8; ++i) { dot = fmaf(d0[i], x0[i], dot); dot = fmaf(d1[i], x1[i], dot); }
    dot = wave_sum(dot);
    const float coef = g * gelu_f(dot);
    float u0[8], u1[8];
    unpack8(*(const uint4*)(up + (size_t)e * DM + lane * 8), u0);
    unpack8(*(const uint4*)(up + (size_t)e * DM + 512 + lane * 8), u1);
#pragma unroll
    for (int i = 0; i < 8; ++i) { a0[i] = fmaf(coef, u0[i], a0[i]); a1[i] = fmaf(coef, u1[i], a1[i]); }
  }
#pragma unroll
  for (int i = 0; i < 8; ++i) { red[w][lane * 8 + i] = a0[i]; red[w][512 + lane * 8 + i] = a1[i]; }
  __syncthreads();
  {
    float4 a = *(float4*)(&red[0][tid * 4]);
    float4 b = *(float4*)(&red[1][tid * 4]);
    float4 c = *(float4*)(&red[2][tid * 4]);
    float4 d = *(float4*)(&red[3][tid * 4]);
    float4 hv = *(float4*)(out + (size_t)t * DM + tid * 4);
    hv.x += (a.x + b.x) + (c.x + d.x); hv.y += (a.y + b.y) + (c.y + d.y);
    hv.z += (a.z + b.z) + (c.z + d.z); hv.w += (a.w + b.w) + (c.w + d.w);
    *(float4*)(out + (size_t)t * DM + tid * 4) = hv;
  }
}

#define PHASE(NBLK, CALL) \
  for (int VB = blockIdx.x; VB < (NBLK); VB += gridDim.x) { CALL; __syncthreads(); }

__global__ __launch_bounds__(256, 2) void fwd_megakernel(Params p) {
  __shared__ __attribute__((aligned(16))) char smem_raw[SMEM_BYTES];
  float* smem = (float*)smem_raw;
  cg::grid_group grid = cg::this_grid();
  PHASE(NT, ph_rmsnorm_bf16(VB, smem, p.x, p.mix_norm_w, p.xn_b, p.w_in, p.dt_bias, p.dt));
  PHASE(NB * MEM, ph_rmsnorm_bf16(VB, smem, p.mem, p.mem_norm_w, p.memn_b, nullptr, nullptr, nullptr));
  PHASE(16 * 40, ph_wtrans(VB, smem, p.w_in, INC, p.w_inT, 40, 8));
  PHASE(16 * 16, ph_wtrans(VB, smem, p.w_out, DM, p.w_outT, 16, 0));
  PHASE(16 * 16, ph_wtrans(VB, smem, p.w_query, DM, p.w_qT, 16, 0));
  PHASE(16 * 8, ph_wtrans(VB, smem, p.w_mem_kv, 512, p.w_memT, 8, 0));
  PHASE(8192, ph_cvt(VB, p.e_down, p.ed_b));
  PHASE(8192, ph_cvt(VB, p.e_up, p.eu_b));
  grid.sync();
  PHASE(20 * (NT / 128), ph_gemm_proj(VB, smem_raw, p));
  PHASE(4 * (NB * MEM / 128), ph_gemm_mem(VB, smem_raw, p));
  grid.sync();
  float* xbc = p.out;
  PHASE(NT * 1024 / 256, k_conv(VB, p.xbc_raw, p.conv_w, p.conv_b, xbc));
  PHASE(NB * 4 * 32 * 64 / 256, k_kmean(VB, p.mk, p.kmean));
  PHASE(NT, k_attn<1>(VB, p.xq, p.memk_b, p.memv_b, nullptr, p.mixed_b, 768));
  grid.sync();
  PHASE(NB * 8 * 4, k_ssd_scan(VB, xbc, p.dt, p.a_log, p.ssd_d, p.ytmp));
  PHASE(NT * 4 / 256, k_gate(VB, p.mq, p.kmean, p.sel));
  grid.sync();
  PHASE(NT, k_ssd_post(VB, smem, p.ytmp, p.zs, p.ssd_norm_w, p.mixed_b));
  PHASE(NT, k_attn<0>(VB, p.mq, p.mk, p.mv, p.sel, p.mixed_b, 512));
  grid.sync();
  PHASE(8 * (NT / 128), ph_gemm_f32(VB, smem_raw, p.mixed_b, p.w_outT, p.out, p.x));
  grid.sync();
  ushort_t* hn_b = p.xn_b;
  PHASE(NT, ph_rmsnorm_bf16(VB, smem, p.out, p.ffn_norm_w, hn_b, nullptr, nullptr, nullptr));
  grid.sync();
  PHASE(8 * (NT / 128), ph_gemm_f32(VB, smem_raw, hn_b, p.w_qT, p.q, nullptr));
  grid.sync();
  PHASE(NT * 8 / 4, k_peer_route(VB, p.q, p.sk1, p.sk2, p.eidx, p.egate));
  grid.sync();
  PHASE(NT, k_peer_experts(VB, smem, hn_b, p.eidx, p.egate, p.ed_b, p.eu_b, p.out));
}
}

extern "C" void kernel_launch(void* const* d_in, const int* in_sizes, int n_in, void* d_out, int out_size, void* d_ws, size_t ws_size,
                              hipStream_t stream) {
  Params p{};
  p.x = (const float*)d_in[0]; p.mem = (const float*)d_in[1]; p.mix_norm_w = (const float*)d_in[2]; p.w_in = (const float*)d_in[3];
  p.conv_w = (const float*)d_in[4]; p.conv_b = (const float*)d_in[5]; p.dt_bias = (const float*)d_in[6]; p.a_log = (const float*)d_in[7];
  p.ssd_d = (const float*)d_in[8]; p.ssd_norm_w = (const float*)d_in[9]; p.mq_norm_w = (const float*)d_in[10]; p.mk_norm_w = (const float*)d_in[11];
  p.mem_norm_w = (const float*)d_in[12]; p.w_mem_kv = (const float*)d_in[13]; p.xq_norm_w = (const float*)d_in[14]; p.xk_norm_w = (const float*)d_in[15];
  p.w_out = (const float*)d_in[16]; p.ffn_norm_w = (const float*)d_in[17]; p.w_query = (const float*)d_in[18]; p.sk1 = (const float*)d_in[19];
  p.sk2 = (const float*)d_in[20]; p.e_down = (const float*)d_in[21]; p.e_up = (const float*)d_in[22];
  p.out = (float*)d_out;
  char* ws = (char*)d_ws;
  size_t o = 0;
  auto take = [&](size_t bytes) { char* q = ws + o; o += (bytes + 255) & ~(size_t)255; return q; };
  p.xn_b = (ushort_t*)take((size_t)NT * DM * 2);
  p.ytmp = (float*)p.xn_b;
  p.w_inT = (ushort_t*)take((size_t)NPROJ * DM * 2);
  p.w_outT = (ushort_t*)take((size_t)DM * DM * 2);
  p.w_qT = (ushort_t*)take((size_t)DM * DM * 2);
  p.w_memT = (ushort_t*)take((size_t)512 * DM * 2);
  p.memn_b = (ushort_t*)take((size_t)NB * MEM * DM * 2);
  p.memk_b = (ushort_t*)take((size_t)NB * MEM * 256 * 2);
  p.memv_b = (ushort_t*)take((size_t)NB * MEM * 256 * 2);
  char* regQ = take((size_t)NT * 2560 * 2);
  p.zs = (ushort_t*)regQ;
  p.xbc_raw = (ushort_t*)(regQ + (size_t)NT * 512 * 2);
  p.mq = (ushort_t*)(regQ + (size_t)NT * 1536 * 2);
  p.mk = (ushort_t*)(regQ + (size_t)NT * 1792 * 2);
  p.mv = (ushort_t*)(regQ + (size_t)NT * 2048 * 2);
  p.xq = (ushort_t*)(regQ + (size_t)NT * 2304 * 2);
  p.q = (float*)regQ;
  p.dt = (float*)take((size_t)NT * 8 * 4);
  p.mixed_b = (ushort_t*)take((size_t)NT * DM * 2);
  p.kmean = (float*)take((size_t)NB * 4 * 32 * 64 * 4);
  p.sel = (int*)take((size_t)NT * 4 * 3 * 4);
  p.eidx = (int*)take((size_t)NT * 128 * 4);
  p.egate = (float*)take((size_t)NT * 128 * 4);
  p.ed_b = (ushort_t*)take((size_t)16384 * DM * 2);
  p.eu_b = (ushort_t*)take((size_t)16384 * DM * 2);
  if (o > ws_size) return;
  static int grid_blocks = 0;
  if (!grid_blocks) {
    int dev = 0, cus = 0, per_cu = 0;
    (void)hipGetDevice(&dev);
    (void)hipDeviceGetAttribute(&cus, hipDeviceAttributeMultiprocessorCount, dev);
    (void)hipOccupancyMaxActiveBlocksPerMultiprocessor(&per_cu, fwd_megakernel, 256, 0);
    if (per_cu > 2) per_cu = 2;
    if (per_cu < 1) per_cu = 1;
    grid_blocks = cus * per_cu;
  }
  void* args[] = {&p};
  hipError_t e = hipLaunchCooperativeKernel((void*)fwd_megakernel, dim3(grid_blocks), dim3(256), args, 0, stream);
  if (e != hipSuccess) fprintf(stderr, "cooperative launch failed: %s (grid %d)\n", hipGetErrorString(e), grid_blocks);
}
```

```cpp
#include <hip/hip_runtime.h>
#include <hip/hip_cooperative_groups.h>
#include <cstdio>
#include <math.h>
#include <stdint.h>
namespace cg = cooperative_groups;

namespace {
typedef unsigned short ushort_t;
typedef __attribute__((ext_vector_type(8))) short bf16x8;
typedef __attribute__((ext_vector_type(16))) float f32x16;

constexpr int DM = 1024;
constexpr int NB = 2;
constexpr int SL = 8192;
constexpr int NT = NB * SL;
constexpr int MEM = 256;
constexpr int INC = 2568;
constexpr int NPROJ = 2560;
constexpr float EPS = 1e-6f;
constexpr int SMEM_BYTES = 73728 + 256;

__device__ __forceinline__ float silu_f(float x) { return x / (1.f + expf(-x)); }
__device__ __forceinline__ float softplus_f(float x) { return fmaxf(x, 0.f) + log1pf(expf(-fabsf(x))); }
__device__ __forceinline__ float gelu_f(float x) { return 0.5f * x * (1.f + erff(x * 0.70710678118654752f)); }
__device__ __forceinline__ ushort_t f2bf(float x) {
  unsigned u = __float_as_uint(x);
  u += 0x7fffu + ((u >> 16) & 1u);
  return (ushort_t)(u >> 16);
}
__device__ __forceinline__ float bf2f(ushort_t h) { return __uint_as_float(((unsigned)h) << 16); }
__device__ __forceinline__ float bflo(unsigned w) { return __uint_as_float(w << 16); }
__device__ __forceinline__ float bfhi(unsigned w) { return __uint_as_float(w & 0xffff0000u); }
__device__ __forceinline__ unsigned pack2(float a, float b) { return (unsigned)f2bf(a) | ((unsigned)f2bf(b) << 16); }

__device__ __forceinline__ void unpack8(const uint4 v, float (&f)[8]) {
  f[0] = bflo(v.x); f[1] = bfhi(v.x); f[2] = bflo(v.y); f[3] = bfhi(v.y);
  f[4] = bflo(v.z); f[5] = bfhi(v.z); f[6] = bflo(v.w); f[7] = bfhi(v.w);
}

__device__ __forceinline__ float wave_sum(float v) {
#pragma unroll
  for (int o = 32; o > 0; o >>= 1) v += __shfl_xor(v, o);
  return v;
}
__device__ __forceinline__ float wave_max(float v) {
#pragma unroll
  for (int o = 32; o > 0; o >>= 1) v = fmaxf(v, __shfl_xor(v, o));
  return v;
}


#define XB_TMO      128
#define XB_XCNT(j)  (256  + 64 * (j))
#define XB_XSUB(j)  (1280 + 64 * (j))
#define XB_XGEN(j)  (2304 + 64 * (j))
#define XB_TOP      3328
#define XB_TOPGEN   3392
#define XCD_BAR_WORDS 3456
#define XB_SPIN_CAP (1u << 20)
#define LAS __attribute__((address_space(3)))
__device__ __forceinline__ unsigned xb_ld(unsigned* p)              { return __hip_atomic_load(p, __ATOMIC_RELAXED, __HIP_MEMORY_SCOPE_AGENT); }
__device__ __forceinline__ unsigned xb_add(unsigned* p, unsigned v) { return __hip_atomic_fetch_add(p, v, __ATOMIC_RELAXED, __HIP_MEMORY_SCOPE_AGENT); }
__device__ __forceinline__ unsigned xb_xcc_id() { return (unsigned)__builtin_amdgcn_s_getreg((3 << 11) | 20) & 0xFu; }
#define XB_SPIN(cond, bar) do { unsigned _sp = 0; while (cond) { __builtin_amdgcn_s_sleep(1); \
    if ((++_sp & 255u) == 0u) { if (xb_ld(&(bar)[XB_TMO])) break; if (_sp > XB_SPIN_CAP) { atomicAdd(&(bar)[XB_TMO], 1u); break; } } } } while (0)
struct XcdBarrier { unsigned* bar; unsigned x; volatile LAS unsigned* st; };
__device__ __forceinline__ XcdBarrier xcd_barrier_post(unsigned* bar, volatile LAS unsigned* st) {
  XcdBarrier b; b.bar = bar; b.x = xb_xcc_id(); b.st = st;
  if (threadIdx.x == 0) (void)xb_add(&bar[XB_XCNT(b.x)], 1u);
  return b;
}
__device__ __forceinline__ void xcd_barrier_complete(unsigned* bar, unsigned x, unsigned& nloc, unsigned& nx) {
  const unsigned G = gridDim.x * gridDim.y * gridDim.z;
  unsigned sum, cnt, mine, sp = 0u;
  for (;;) {
    sum = 0u; cnt = 0u; mine = 0u;
#pragma unroll
    for (unsigned j = 0; j < 16; ++j) { const unsigned c = xb_ld(&bar[XB_XCNT(j)]); sum += c; cnt += (c > 0u) ? 1u : 0u; mine = (j == x) ? c : mine; }
    if (sum == G) break;
    __builtin_amdgcn_s_sleep(1);
    if ((++sp & 255u) == 0u) { if (xb_ld(&bar[XB_TMO])) break; if (sp > XB_SPIN_CAP) { atomicAdd(&bar[XB_TMO], 1u); break; } }
  }
  nloc = mine > 0u ? mine : 1u; nx = cnt > 0u ? cnt : 1u;
}
__device__ __forceinline__ void xcd_barrier(const XcdBarrier& b) {
  asm volatile("s_waitcnt vmcnt(0)" ::: "memory");
  __syncthreads();
  if (threadIdx.x == 0) {
    unsigned* bar = b.bar;
    __builtin_amdgcn_s_waitcnt(0);
    unsigned nloc = b.st[0], nx = b.st[1];
    if (nloc == 0u) { xcd_barrier_complete(bar, b.x, nloc, nx); b.st[0] = nloc; b.st[1] = nx; }
    const unsigned old = xb_add(&bar[XB_XSUB(b.x)], 1u);
    const unsigned gen = old / nloc;
    if (old + 1u == (gen + 1u) * nloc) {
      __builtin_amdgcn_fence(__ATOMIC_RELEASE, "agent");
      asm volatile("s_waitcnt vmcnt(0)" ::: "memory");
      const unsigned og = xb_add(&bar[XB_TOP], 1u);
      const unsigned tg = og / nx;
      if (og + 1u == (tg + 1u) * nx) xb_add(&bar[XB_TOPGEN], 1u);
      else XB_SPIN(xb_ld(&bar[XB_TOPGEN]) == tg, bar);
      __builtin_amdgcn_fence(__ATOMIC_ACQUIRE, "agent");
      xb_add(&bar[XB_XGEN(b.x)], 1u);
      asm volatile("s_waitcnt vmcnt(0)" ::: "memory");
    } else {
      XB_SPIN(xb_ld(&bar[XB_XGEN(b.x)]) == gen, bar);
      __builtin_amdgcn_fence(__ATOMIC_ACQUIRE, "agent");
      asm volatile("s_waitcnt vmcnt(0)" ::: "memory");
    }
  }
  __syncthreads();
}

struct Params {
  const float *x, *mem, *mix_norm_w, *w_in, *conv_w, *conv_b, *dt_bias, *a_log, *ssd_d, *ssd_norm_w, *mq_norm_w, *mk_norm_w,
      *mem_norm_w, *w_mem_kv, *xq_norm_w, *xk_norm_w, *w_out, *ffn_norm_w, *w_query, *sk1, *sk2, *e_down, *e_up;
  float* out;
  ushort_t *xn_b, *w_inT, *w_outT, *w_qT, *w_memT, *memn_b, *zs, *xbc_raw, *mq, *mk, *xq, *memk_b, *mixed_b, *ed_b, *eu_b;
  float *dt, *q, *egate, *acs, *cdec, *states;
  ushort_t *xc, *xT, *sin_b;
  int *eidx, *bcnt, *blist;
  unsigned* bar;
  ushort_t *skh, *skl;
  float *kpart, *pm, *pl;
  ushort_t *vT, *memvT, *pO;
};

__device__ __forceinline__ void ph_rmsnorm_bf16(const int vb, const float* __restrict__ x, const float* __restrict__ w,
                                                ushort_t* __restrict__ outb, const float* __restrict__ w_in, const float* __restrict__ dt_bias,
                                                float* __restrict__ dt) {
  const int lane = threadIdx.x & 63;
  const int row = vb * 4 + (threadIdx.x >> 6);
  const float* xr = x + (size_t)row * DM;
  float4 v[4];
#pragma unroll
  for (int i = 0; i < 4; ++i) v[i] = *(const float4*)(xr + i * 256 + lane * 4);
  float ss = 0.f;
#pragma unroll
  for (int i = 0; i < 4; ++i) ss += v[i].x * v[i].x + v[i].y * v[i].y + v[i].z * v[i].z + v[i].w * v[i].w;
  ss = wave_sum(ss);
  const float r = rsqrtf(ss / DM + EPS);
  float part[8];
#pragma unroll
  for (int hh = 0; hh < 8; ++hh) part[hh] = 0.f;
#pragma unroll
  for (int i = 0; i < 4; ++i) {
    const float4 ww = *(const float4*)(w + i * 256 + lane * 4);
    const float o0 = v[i].x * r * ww.x, o1 = v[i].y * r * ww.y, o2 = v[i].z * r * ww.z, o3 = v[i].w * r * ww.w;
    *(uint2*)(outb + (size_t)row * DM + i * 256 + lane * 4) = make_uint2(pack2(o0, o1), pack2(o2, o3));
    if (dt) {
      const float xs[4] = {o0, o1, o2, o3};
#pragma unroll
      for (int k = 0; k < 4; ++k) {
        const float* wr = w_in + (size_t)(i * 256 + lane * 4 + k) * INC + 1536;
        const float4 a = *(const float4*)(wr);
        const float4 b = *(const float4*)(wr + 4);
        part[0] = fmaf(xs[k], a.x, part[0]); part[1] = fmaf(xs[k], a.y, part[1]);
        part[2] = fmaf(xs[k], a.z, part[2]); part[3] = fmaf(xs[k], a.w, part[3]);
        part[4] = fmaf(xs[k], b.x, part[4]); part[5] = fmaf(xs[k], b.y, part[5]);
        part[6] = fmaf(xs[k], b.z, part[6]); part[7] = fmaf(xs[k], b.w, part[7]);
      }
    }
  }
  if (dt) {
    float mine = 0.f;
#pragma unroll
    for (int hh = 0; hh < 8; ++hh) {
      const float sfull = wave_sum(part[hh]);
      if (lane == hh) mine = sfull;
    }
    if (lane < 8) dt[(size_t)row * 8 + lane] = softplus_f(mine + dt_bias[lane]);
  }
}

__device__ __forceinline__ void ph_wtrans(const int vb, float* smem, const float* __restrict__ W, const int ldw, ushort_t* __restrict__ Wt,
                                          const int ntiles, const int skip) {
  float (*s)[65] = (float (*)[65])smem;
  const int tid = threadIdx.x;
  const int kt = vb / ntiles, nt = vb % ntiles;
  const int nd0 = nt * 64;
  const int ns0 = (nd0 < 1536) ? nd0 : nd0 + skip;
  {
    const int k = tid >> 2, nc = (tid & 3) * 16;
    const float* src = W + (size_t)(kt * 64 + k) * ldw + ns0 + nc;
#pragma unroll
    for (int j = 0; j < 4; ++j) {
      float4 v = *(const float4*)(src + j * 4);
      s[k][nc + j * 4 + 0] = v.x; s[k][nc + j * 4 + 1] = v.y; s[k][nc + j * 4 + 2] = v.z; s[k][nc + j * 4 + 3] = v.w;
    }
  }
  __syncthreads();
  {
    const int n = tid >> 2, kc = (tid & 3) * 16;
    unsigned pk[8];
#pragma unroll
    for (int j = 0; j < 8; ++j) pk[j] = pack2(s[kc + 2 * j][n], s[kc + 2 * j + 1][n]);
    ushort_t* dst = Wt + (size_t)(nd0 + n) * DM + kt * 64 + kc;
    *(uint4*)(dst) = make_uint4(pk[0], pk[1], pk[2], pk[3]);
    *(uint4*)(dst + 8) = make_uint4(pk[4], pk[5], pk[6], pk[7]);
  }
}

__device__ __forceinline__ void ph_cvt(const int vb, const float* __restrict__ src, ushort_t* __restrict__ dst) {
  const size_t base = (size_t)vb * 8192 + threadIdx.x * 8;
  float4 a[4], b[4];
#pragma unroll
  for (int i = 0; i < 4; ++i) {
    a[i] = *(const float4*)(src + base + i * 2048);
    b[i] = *(const float4*)(src + base + i * 2048 + 4);
  }
#pragma unroll
  for (int i = 0; i < 4; ++i)
    *(uint4*)(dst + base + i * 2048) = make_uint4(pack2(a[i].x, a[i].y), pack2(a[i].z, a[i].w), pack2(b[i].x, b[i].y), pack2(b[i].z, b[i].w));
}

__device__ __forceinline__ int swz(int row, int ch) { return row * 128 + ((ch ^ ((row >> 1) & 7)) << 4); }

__device__ __forceinline__ void gemm_core(const ushort_t* __restrict__ A, const ushort_t* __restrict__ Bt, const int K, const int m0,
                                          const int n0, char* smem, f32x16 (&acc)[2][2]) {
  const int tid = threadIdx.x, lane = tid & 63, wave = tid >> 6;
  const int wm = wave >> 1, wn = wave & 1;
  const int r = lane & 31, h = lane >> 5;
  const int srow = tid >> 3, sch = tid & 7;
  const ushort_t* Ag = A + (size_t)(m0 + srow) * K + sch * 8;
  const ushort_t* Bg = Bt + (size_t)(n0 + srow) * K + sch * 8;
  uint4 ra[4], rb[4];
#pragma unroll
  for (int p = 0; p < 4; ++p) {
    ra[p] = *(const uint4*)(Ag + (size_t)p * 32 * K);
    rb[p] = *(const uint4*)(Bg + (size_t)p * 32 * K);
  }
#pragma unroll
  for (int i = 0; i < 2; ++i)
#pragma unroll
    for (int j = 0; j < 2; ++j)
#pragma unroll
      for (int e = 0; e < 16; ++e) acc[i][j][e] = 0.f;
#pragma unroll
  for (int p = 0; p < 4; ++p) {
    *(uint4*)(smem + swz(srow + p * 32, sch)) = ra[p];
    *(uint4*)(smem + 16384 + swz(srow + p * 32, sch)) = rb[p];
  }
  __syncthreads();
  const int nk = K >> 6;
  const int xr = (r >> 1) & 7;
  const int arow = (wm * 64 + r) * 128, brow = (wn * 64 + r) * 128;
  for (int kt = 0; kt < nk; ++kt) {
    const char* cA = smem + (kt & 1) * 32768;
    const char* cB = cA + 16384;
    if (kt + 1 < nk) {
#pragma unroll
      for (int p = 0; p < 4; ++p) {
        ra[p] = *(const uint4*)(Ag + (size_t)p * 32 * K + (kt + 1) * 64);
        rb[p] = *(const uint4*)(Bg + (size_t)p * 32 * K + (kt + 1) * 64);
      }
    }
#pragma unroll
    for (int ks = 0; ks < 4; ++ks) {
      const int co = ((ks * 2 + h) ^ xr) << 4;
      bf16x8 a0 = *(const bf16x8*)(cA + arow + co);
      bf16x8 a1 = *(const bf16x8*)(cA + arow + 32 * 128 + co);
      bf16x8 b0 = *(const bf16x8*)(cB + brow + co);
      bf16x8 b1 = *(const bf16x8*)(cB + brow + 32 * 128 + co);
      acc[0][0] = __builtin_amdgcn_mfma_f32_32x32x16_bf16(a0, b0, acc[0][0], 0, 0, 0);
      acc[0][1] = __builtin_amdgcn_mfma_f32_32x32x16_bf16(a0, b1, acc[0][1], 0, 0, 0);
      acc[1][0] = __builtin_amdgcn_mfma_f32_32x32x16_bf16(a1, b0, acc[1][0], 0, 0, 0);
      acc[1][1] = __builtin_amdgcn_mfma_f32_32x32x16_bf16(a1, b1, acc[1][1], 0, 0, 0);
    }
    if (kt + 1 < nk) {
      char* nA = smem + ((kt + 1) & 1) * 32768;
#pragma unroll
      for (int p = 0; p < 4; ++p) {
        *(uint4*)(nA + swz(srow + p * 32, sch)) = ra[p];
        *(uint4*)(nA + 16384 + swz(srow + p * 32, sch)) = rb[p];
      }
    }
    __syncthreads();
  }
}

enum { EP_SILU = 0, EP_PLAIN = 1, EP_HEADNORM = 2 };

__device__ __forceinline__ void epi_bf16(const f32x16 (&acc)[2][2], const int mode, ushort_t* __restrict__ dst, const int ld,
                                         const int row0, const int col0, const float* __restrict__ nw) {
  const int lane = threadIdx.x & 63, r = lane & 31, h = lane >> 5;
  float w0 = 1.f, w1 = 1.f;
  if (mode == EP_HEADNORM) { w0 = nw[r]; w1 = nw[32 + r]; }
#pragma unroll
  for (int mi = 0; mi < 2; ++mi) {
#pragma unroll
    for (int e = 0; e < 16; ++e) {
      const int row = row0 + mi * 32 + (e & 3) + 8 * (e >> 2) + 4 * h;
      float v0 = acc[mi][0][e], v1 = acc[mi][1][e];
      if (mode == EP_SILU) { v0 = silu_f(v0); v1 = silu_f(v1); }
      if (mode == EP_HEADNORM) {
        float ss = v0 * v0 + v1 * v1;
        ss += __shfl_xor(ss, 1); ss += __shfl_xor(ss, 2); ss += __shfl_xor(ss, 4); ss += __shfl_xor(ss, 8); ss += __shfl_xor(ss, 16);
        const float rs = rsqrtf(ss * (1.f / 64.f) + EPS);
        v0 = v0 * rs * w0; v1 = v1 * rs * w1;
      }
      dst[(size_t)row * ld + col0 + r] = f2bf(v0);
      dst[(size_t)row * ld + col0 + 32 + r] = f2bf(v1);
    }
  }
}

__device__ __forceinline__ void epi_f32(const f32x16 (&acc)[2][2], float* __restrict__ dst, const int ld, const int row0, const int col0,
                                        const float* __restrict__ resid) {
  const int lane = threadIdx.x & 63, r = lane & 31, h = lane >> 5;
#pragma unroll
  for (int mi = 0; mi < 2; ++mi) {
#pragma unroll
    for (int e = 0; e < 16; ++e) {
      const int row = row0 + mi * 32 + (e & 3) + 8 * (e >> 2) + 4 * h;
#pragma unroll
      for (int ni = 0; ni < 2; ++ni) {
        const size_t idx = (size_t)row * ld + col0 + ni * 32 + r;
        float v = acc[mi][ni][e];
        if (resid) v += resid[idx];
        dst[idx] = v;
      }
    }
  }
}


__device__ __forceinline__ void epi_bf16_T(const f32x16 (&acc)[2][2], ushort_t* __restrict__ dstT, const size_t ldT, const int rowpos0) {
  const int lane = threadIdx.x & 63, r = lane & 31, h = lane >> 5;
#pragma unroll
  for (int ni = 0; ni < 2; ++ni) {
    ushort_t* base = dstT + (size_t)(ni * 32 + r) * ldT + rowpos0;
#pragma unroll
    for (int mi = 0; mi < 2; ++mi) {
#pragma unroll
      for (int q4 = 0; q4 < 4; ++q4) {
        const int rp = mi * 32 + 8 * q4 + 4 * h;
        *(uint2*)(base + rp) = make_uint2(pack2(acc[mi][ni][4 * q4 + 0], acc[mi][ni][4 * q4 + 1]),
                                          pack2(acc[mi][ni][4 * q4 + 2], acc[mi][ni][4 * q4 + 3]));
      }
    }
  }
}

__device__ __forceinline__ void epi_bf16_k(const f32x16 (&acc)[2][2], ushort_t* __restrict__ dst, const int ld, const int row0, const int col0,
                                           const float* __restrict__ nw, float* __restrict__ kp  ) {
  const int lane = threadIdx.x & 63, r = lane & 31, h = lane >> 5;
  const float w0 = nw[r], w1 = nw[32 + r];
  float cs0 = 0.f, cs1 = 0.f;
#pragma unroll
  for (int mi = 0; mi < 2; ++mi) {
#pragma unroll
    for (int e = 0; e < 16; ++e) {
      const int row = row0 + mi * 32 + (e & 3) + 8 * (e >> 2) + 4 * h;
      float v0 = acc[mi][0][e], v1 = acc[mi][1][e];
      float ss = v0 * v0 + v1 * v1;
      ss += __shfl_xor(ss, 1); ss += __shfl_xor(ss, 2); ss += __shfl_xor(ss, 4); ss += __shfl_xor(ss, 8); ss += __shfl_xor(ss, 16);
      const float rs = rsqrtf(ss * (1.f / 64.f) + EPS);
      v0 = v0 * rs * w0; v1 = v1 * rs * w1;
      cs0 += v0; cs1 += v1;
      dst[(size_t)row * ld + col0 + r] = f2bf(v0);
      dst[(size_t)row * ld + col0 + 32 + r] = f2bf(v1);
    }
  }
  cs0 += __shfl_xor(cs0, 32);
  cs1 += __shfl_xor(cs1, 32);
  if (h == 0) { kp[r] = cs0; kp[32 + r] = cs1; }
}

__device__ __forceinline__ void ph_gemm_proj(const int vb, char* smem, const Params& p) {
  const int nt = vb % 20, mt = vb / 20;
  const int m0 = mt * 128, n0 = nt * 128;
  f32x16 acc[2][2];
  gemm_core(p.xn_b, p.w_inT, DM, m0, n0, smem, acc);
  const int wave = threadIdx.x >> 6, wm = wave >> 1, wn = wave & 1;
  const int row0 = m0 + wm * 64;
  const int c = n0 + wn * 64;
  if (c < 512) epi_bf16(acc, EP_SILU, p.zs, 512, row0, c, nullptr);
  else if (c < 1536) epi_bf16(acc, EP_PLAIN, p.xbc_raw, 1024, row0, c - 512, nullptr);
  else if (c < 1792) epi_bf16(acc, EP_HEADNORM, p.mq, 256, row0, c - 1536, p.mq_norm_w);
  else if (c < 2048) {
    const int hh = (c - 1792) >> 6, bb = row0 >> 13, lpos = row0 & (SL - 1);
    epi_bf16_k(acc, p.mk, 256, row0, c - 1792, p.mk_norm_w, p.kpart + ((size_t)((bb * 4 + hh) * 32 + (lpos >> 8)) * 4 + ((lpos >> 6) & 3)) * 64);
  } else if (c < 2304) {
    const int hh = (c - 2048) >> 6, bb = row0 >> 13, lpos = row0 & (SL - 1);
    epi_bf16_T(acc, p.vT + (size_t)(bb * 4 + hh) * 64 * SL, SL, lpos);
  }
  else epi_bf16(acc, EP_HEADNORM, p.xq, 256, row0, c - 2304, p.xq_norm_w);
}

__device__ __forceinline__ void ph_gemm_mem(const int vb, char* smem, const Params& p) {
  const int nt = vb % 4, mt = vb / 4;
  const int m0 = mt * 128, n0 = nt * 128;
  f32x16 acc[2][2];
  gemm_core(p.memn_b, p.w_memT, DM, m0, n0, smem, acc);
  const int wave = threadIdx.x >> 6, wm = wave >> 1, wn = wave & 1;
  const int row0 = m0 + wm * 64;
  const int c = n0 + wn * 64;
  if (c < 256) epi_bf16(acc, EP_HEADNORM, p.memk_b, 256, row0, c, p.xk_norm_w);
  else {
    const int hh = (c - 256) >> 6, bb = row0 >> 8, mpos = row0 & 255;
    epi_bf16_T(acc, p.memvT + (size_t)(bb * 4 + hh) * 64 * MEM, MEM, mpos);
  }
}

__device__ __forceinline__ void ph_gemm_f32(const int vb, char* smem, const ushort_t* A, const ushort_t* Bt, float* dst, const float* resid) {
  const int nt = vb % 8, mt = vb / 8;
  const int m0 = mt * 128, n0 = nt * 128;
  f32x16 acc[2][2];
  gemm_core(A, Bt, DM, m0, n0, smem, acc);
  const int wave = threadIdx.x >> 6, wm = wave >> 1, wn = wave & 1;
  epi_f32(acc, dst, DM, m0 + wm * 64, n0 + wn * 64, resid);
}

__device__ __forceinline__ int swz256(int row, int ch) { return row * 272 + (ch << 4); }
__device__ __forceinline__ int crow16(int e, int hl) { return (e & 3) + 8 * (e >> 2) + 4 * hl; }

__device__ __forceinline__ void ph_ssd1(const int vb, char* smem, const Params& p) {
  const int h = vb & 7, c = (vb >> 3) & 63, b = vb >> 9;
  const int g = h >> 2, hq = h & 3;
  int tid = threadIdx.x;
  asm volatile("" : "+v"(tid));
  const int lane = tid & 63, wave = tid >> 6;
  const int t0 = b * SL + c * 128;
  char* s_xw = smem;
  char* s_bt = smem + 17408;
  float* s_acs = (float*)(smem + 52224);
  float* s_w = s_acs + 128;
  float* s_red = s_w + 128;
  const float a_coef = -expf(p.a_log[h]);
  float dtv = 0.f, cs = 0.f;
  if (tid < 128) {
    dtv = p.dt[(size_t)(t0 + tid) * 8 + h];
    cs = dtv * a_coef;
#pragma unroll
    for (int o = 1; o < 64; o <<= 1) {
      float nb = __shfl_up(cs, o);
      if (lane >= o) cs += nb;
    }
    if (lane == 63) s_red[wave] = cs;
  }
  __syncthreads();
  if (tid < 128) {
    if (wave == 1) cs += s_red[0];
    s_acs[tid] = cs;
    p.acs[(size_t)(t0 + tid) * 8 + h] = cs;
  }
  __syncthreads();
  if (tid < 128) {
    const float tot = s_acs[127];
    s_w[tid] = dtv * expf(tot - cs);
    if (tid == 0) p.cdec[(b * 64 + c) * 8 + h] = expf(tot);
  }
  __syncthreads();
  if (tid < 224) {
    const int seg = tid / 28, cg = tid - seg * 28;
    const bool is_x = cg < 8, is_b = (cg >= 8) && (cg < 24);
    int ch0, trow;
    if (is_x) { ch0 = h * 64 + cg * 8; trow = cg * 8; }
    else if (is_b) { ch0 = 512 + g * 128 + (cg - 8) * 8; trow = (cg - 8) * 8; }
    else { ch0 = 768 + g * 128 + hq * 32 + (cg - 24) * 8; trow = 0; }
    const bool wr_nat = is_x || !is_b || (hq == 0);
    char* tbase = is_x ? s_xw : s_bt;
    const int l0 = seg * 16;
    float w0[8], w1[8], w2[8], w3[8], bias[8];
    {
      const float* cw = p.conv_w + ch0;
      float4 a, bq;
      a = *(const float4*)(cw); bq = *(const float4*)(cw + 4);
      w0[0] = a.x; w0[1] = a.y; w0[2] = a.z; w0[3] = a.w; w0[4] = bq.x; w0[5] = bq.y; w0[6] = bq.z; w0[7] = bq.w;
      a = *(const float4*)(cw + 1024); bq = *(const float4*)(cw + 1028);
      w1[0] = a.x; w1[1] = a.y; w1[2] = a.z; w1[3] = a.w; w1[4] = bq.x; w1[5] = bq.y; w1[6] = bq.z; w1[7] = bq.w;
      a = *(const float4*)(cw + 2048); bq = *(const float4*)(cw + 2052);
      w2[0] = a.x; w2[1] = a.y; w2[2] = a.z; w2[3] = a.w; w2[4] = bq.x; w2[5] = bq.y; w2[6] = bq.z; w2[7] = bq.w;
      a = *(const float4*)(cw + 3072); bq = *(const float4*)(cw + 3076);
      w3[0] = a.x; w3[1] = a.y; w3[2] = a.z; w3[3] = a.w; w3[4] = bq.x; w3[5] = bq.y; w3[6] = bq.z; w3[7] = bq.w;
      a = *(const float4*)(p.conv_b + ch0); bq = *(const float4*)(p.conv_b + ch0 + 4);
      bias[0] = a.x; bias[1] = a.y; bias[2] = a.z; bias[3] = a.w; bias[4] = bq.x; bias[5] = bq.y; bias[6] = bq.z; bias[7] = bq.w;
    }
    float r0[8], r1[8], r2[8];
    {
      const int lg = c * 128 + l0;
      const ushort_t* src = p.xbc_raw + (size_t)(t0 + l0) * 1024 + ch0;
      uint4 z4 = make_uint4(0u, 0u, 0u, 0u);
      uint4 u0 = (lg >= 3) ? *(const uint4*)(src - 3 * 1024) : z4;
      uint4 u1 = (lg >= 2) ? *(const uint4*)(src - 2 * 1024) : z4;
      uint4 u2 = (lg >= 1) ? *(const uint4*)(src - 1 * 1024) : z4;
      unpack8(u0, r0); unpack8(u1, r1); unpack8(u2, r2);
    }
    unsigned outp[8][8];
    float lo[8], los[8];
#pragma unroll
    for (int i = 0; i < 16; ++i) {
      float cur[8], val[8];
      unpack8(*(const uint4*)(p.xbc_raw + (size_t)(t0 + l0 + i) * 1024 + ch0), cur);
#pragma unroll
      for (int j = 0; j < 8; ++j) {
        float v = bias[j];
        v = fmaf(w0[j], r0[j], v); v = fmaf(w1[j], r1[j], v); v = fmaf(w2[j], r2[j], v); v = fmaf(w3[j], cur[j], v);
        val[j] = silu_f(v);
        r0[j] = r1[j]; r1[j] = r2[j]; r2[j] = cur[j];
      }
      if (wr_nat) {
        *(uint4*)(p.xc + (size_t)(t0 + l0 + i) * 1024 + ch0) =
            make_uint4(pack2(val[0], val[1]), pack2(val[2], val[3]), pack2(val[4], val[5]), pack2(val[6], val[7]));
      }
      const float scl = is_x ? s_w[l0 + i] : 1.f;
      if ((i & 1) == 0) {
#pragma unroll
        for (int j = 0; j < 8; ++j) { lo[j] = val[j]; los[j] = val[j] * scl; }
      } else {
        const int chunk = seg * 2 + (i >> 3);
#pragma unroll
        for (int j = 0; j < 8; ++j) {
          outp[j][i >> 1] = pack2(lo[j], val[j]);
          if (is_x || is_b) *(unsigned*)(tbase + swz256(trow + j, chunk) + ((i & 7) - 1) * 2) = pack2(los[j], val[j] * scl);
        }
      }
    }
    if (is_x) {
      ushort_t* dst = p.xT + ((size_t)((b * 64 + c) * 8 + h) * 64 + cg * 8) * 128 + l0;
#pragma unroll
      for (int j = 0; j < 8; ++j) {
        *(uint4*)(dst + (size_t)j * 128) = make_uint4(outp[j][0], outp[j][1], outp[j][2], outp[j][3]);
        *(uint4*)(dst + (size_t)j * 128 + 8) = make_uint4(outp[j][4], outp[j][5], outp[j][6], outp[j][7]);
      }
    }
  }
  __syncthreads();
  {
    const int r = lane & 31, hl = lane >> 5;
    f32x16 acc[2];
#pragma unroll
    for (int e = 0; e < 16; ++e) { acc[0][e] = 0.f; acc[1][e] = 0.f; }
#pragma unroll
    for (int ks = 0; ks < 8; ++ks) {
      const bf16x8 bfr = *(const bf16x8*)(s_bt + swz256(32 * wave + r, ks * 2 + hl));
      const bf16x8 a0 = *(const bf16x8*)(s_xw + swz256(r, ks * 2 + hl));
      const bf16x8 a1 = *(const bf16x8*)(s_xw + swz256(32 + r, ks * 2 + hl));
      acc[0] = __builtin_amdgcn_mfma_f32_32x32x16_bf16(a0, bfr, acc[0], 0, 0, 0);
      acc[1] = __builtin_amdgcn_mfma_f32_32x32x16_bf16(a1, bfr, acc[1], 0, 0, 0);
    }
    float* dst = p.states + (size_t)((b * 64 + c) * 8 + h) * 64 * 128;
#pragma unroll
    for (int pt = 0; pt < 2; ++pt)
#pragma unroll
      for (int e = 0; e < 16; ++e) dst[(size_t)(pt * 32 + crow16(e, hl)) * 128 + 32 * wave + r] = acc[pt][e];
  }
}

__device__ __forceinline__ void ph_ssd2(const int vb, const Params& p) {
  const int idx = vb * 256 + threadIdx.x;
  const int pn = idx & 8191, h = (idx >> 13) & 7, b = idx >> 16;
  float st = 0.f;
#pragma unroll 1
  for (int c0 = 0; c0 < 64; c0 += 8) {
    float sv[8], dv[8];
#pragma unroll
    for (int i = 0; i < 8; ++i) {
      const int cc = (b * 64 + c0 + i) * 8 + h;
      sv[i] = p.states[(size_t)cc * 8192 + pn];
      dv[i] = p.cdec[cc];
    }
#pragma unroll
    for (int i = 0; i < 8; ++i) {
      const int cc = (b * 64 + c0 + i) * 8 + h;
      p.sin_b[(size_t)cc * 8192 + pn] = f2bf(st);
      st = fmaf(st, dv[i], sv[i]);
    }
  }
}

__device__ __forceinline__ void ph_ssd3(const int vb, char* smem, const Params& p) {
  const int g = vb & 1, c = (vb >> 1) & 63, b = vb >> 7;
  int tid = threadIdx.x;
  asm volatile("" : "+v"(tid));
  const int lane = tid & 63;
  const int w = __builtin_amdgcn_readfirstlane(tid >> 6);
  const int r = lane & 31, hl = lane >> 5;
  const int t0 = b * SL + c * 128;
  char* s_C = smem;
  char* s_B = smem + 34816;
  char* s_xT = smem + 34816;
  char* s_S = smem + 34816 + 16896;
  float* s_acs = (float*)(smem + 69632);
  float* s_dt = s_acs + 512;
  {
    const int ch = tid & 15, r0 = tid >> 4;
#pragma unroll
    for (int i = 0; i < 8; ++i) {
      const int row = r0 + 16 * i;
      const ushort_t* src = p.xc + (size_t)(t0 + row) * 1024 + g * 128 + ch * 8;
      *(uint4*)(s_B + swz256(row, ch)) = *(const uint4*)(src + 512);
      *(uint4*)(s_C + swz256(row, ch)) = *(const uint4*)(src + 768);
    }
    if (tid < 128) {
#pragma unroll
      for (int hh = 0; hh < 4; ++hh) {
        s_acs[hh * 128 + tid] = p.acs[(size_t)(t0 + tid) * 8 + g * 4 + hh];
        s_dt[hh * 128 + tid] = p.dt[(size_t)(t0 + tid) * 8 + g * 4 + hh];
      }
    }
  }
  __syncthreads();
  bf16x8 cfr[8];
#pragma unroll
  for (int ks = 0; ks < 8; ++ks) cfr[ks] = *(const bf16x8*)(s_C + swz256(32 * w + r, ks * 2 + hl));
  f32x16 gt[4];
#pragma unroll
  for (int st = 0; st < 4; ++st) {
#pragma unroll
    for (int e = 0; e < 16; ++e) gt[st][e] = 0.f;
    if (st <= w) {
#pragma unroll
      for (int ks = 0; ks < 8; ++ks) {
        const bf16x8 a = *(const bf16x8*)(s_B + swz256(32 * st + r, ks * 2 + hl));
        gt[st] = __builtin_amdgcn_mfma_f32_32x32x16_bf16(a, cfr[ks], gt[st], 0, 0, 0);
      }
    }
  }
  __syncthreads();
  float ssq = 0.f;
  const int lane_c = lane;
#pragma unroll 1
  for (int hh = 0; hh < 4; ++hh) {
    int lane_o = lane_c;
    asm volatile("" : "+v"(lane_o));
    const int r = lane_o & 31, hl = lane_o >> 5;
    const int l = 32 * w + r;
    const int hg = g * 4 + hh;
    {
      const int ch = tid & 15, r0 = tid >> 4;
      const size_t base = (size_t)((b * 64 + c) * 8 + hg) * 8192;
#pragma unroll
      for (int i = 0; i < 4; ++i) {
        const int row = r0 + 16 * i;
        const uint4 xv = *(const uint4*)(p.xT + base + (size_t)row * 128 + ch * 8);
        *(uint2*)(s_xT + row * 264 + ch * 16) = make_uint2(xv.x, xv.y);
        *(uint2*)(s_xT + row * 264 + ch * 16 + 8) = make_uint2(xv.z, xv.w);
        *(uint4*)(s_S + swz256(row, ch)) = *(const uint4*)(p.sin_b + base + (size_t)row * 128 + ch * 8);
      }
    }
    __syncthreads();
    const float acs_l = s_acs[hh * 128 + l];
    const float dsk = p.ssd_d[hg];
    f32x16 acc[2];
#pragma unroll
    for (int e = 0; e < 16; ++e) { acc[0][e] = 0.f; acc[1][e] = 0.f; }
#pragma unroll
    for (int ks = 0; ks < 8; ++ks) {
      const bf16x8 a0 = *(const bf16x8*)(s_S + swz256(r, ks * 2 + hl));
      const bf16x8 a1 = *(const bf16x8*)(s_S + swz256(32 + r, ks * 2 + hl));
      acc[0] = __builtin_amdgcn_mfma_f32_32x32x16_bf16(a0, cfr[ks], acc[0], 0, 0, 0);
      acc[1] = __builtin_amdgcn_mfma_f32_32x32x16_bf16(a1, cfr[ks], acc[1], 0, 0, 0);
    }
    {
      const float el = expf(acs_l);
#pragma unroll
      for (int e = 0; e < 16; ++e) { acc[0][e] *= el; acc[1][e] *= el; }
    }
#pragma unroll
    for (int st = 0; st < 4; ++st) {
      asm volatile("" ::: "memory");
      if (st <= w) {
        float m[16];
#pragma unroll
        for (int e = 0; e < 16; ++e) {
          const int sidx = 32 * st + crow16(e, hl);
          float v = gt[st][e] * __expf(acs_l - s_acs[hh * 128 + sidx]) * s_dt[hh * 128 + sidx];
          if (sidx > l) v = 0.f;
          if (sidx == l) v += dsk;
          m[e] = v;
        }
#pragma unroll
        for (int k2 = 0; k2 < 2; ++k2) {
          asm volatile("" ::: "memory");
          bf16x8 mf;
          {
            unsigned u0 = pack2(m[8 * k2 + 0], m[8 * k2 + 1]), u1 = pack2(m[8 * k2 + 2], m[8 * k2 + 3]);
            unsigned u2 = pack2(m[8 * k2 + 4], m[8 * k2 + 5]), u3 = pack2(m[8 * k2 + 6], m[8 * k2 + 7]);
            uint4 uu = make_uint4(u0, u1, u2, u3);
            mf = *(bf16x8*)&uu;
          }
          const int soff = (32 * st + 16 * k2 + 4 * hl) * 2;
#pragma unroll
          for (int pt = 0; pt < 2; ++pt) {
            const char* ap = s_xT + (pt * 32 + r) * 264 + soff;
            uint2 q0 = *(const uint2*)(ap);
            uint2 q1 = *(const uint2*)(ap + 16);
            uint4 qq = make_uint4(q0.x, q0.y, q1.x, q1.y);
            const bf16x8 af = *(bf16x8*)&qq;
            acc[pt] = __builtin_amdgcn_mfma_f32_32x32x16_bf16(af, mf, acc[pt], 0, 0, 0);
          }
        }
      }
    }
#pragma unroll
    for (int pt = 0; pt < 2; ++pt) {
#pragma unroll
      for (int q4 = 0; q4 < 4; ++q4) {
        asm volatile("" ::: "memory");
        const int p0 = pt * 32 + 8 * q4 + 4 * hl;
        const uint2 zz = *(const uint2*)(p.zs + (size_t)(t0 + l) * 512 + hg * 64 + p0);
        const float v0 = acc[pt][4 * q4 + 0] * bflo(zz.x), v1 = acc[pt][4 * q4 + 1] * bfhi(zz.x);
        const float v2 = acc[pt][4 * q4 + 2] * bflo(zz.y), v3 = acc[pt][4 * q4 + 3] * bfhi(zz.y);
        ssq += v0 * v0 + v1 * v1 + v2 * v2 + v3 * v3;
        *(uint2*)(p.mixed_b + (size_t)(t0 + l) * 1024 + hg * 64 + p0) = make_uint2(pack2(v0, v1), pack2(v2, v3));
      }
    }
    __syncthreads();
  }
  const int l = 32 * w + r;
  ssq += __shfl_xor(ssq, 32);
  const float rstd = rsqrtf(ssq * (1.f / 256.f) + EPS);
#pragma unroll 1
  for (int hh = 0; hh < 4; ++hh) {
#pragma unroll
    for (int pt = 0; pt < 2; ++pt) {
#pragma unroll
      for (int q4 = 0; q4 < 4; ++q4) {
        asm volatile("" ::: "memory");
        const int chn = (g * 4 + hh) * 64 + pt * 32 + 8 * q4 + 4 * hl;
        ushort_t* ptr = p.mixed_b + (size_t)(t0 + l) * 1024 + chn;
        const uint2 vv = *(const uint2*)ptr;
        const float4 nw = *(const float4*)(p.ssd_norm_w + chn);
        *(uint2*)ptr = make_uint2(pack2(bflo(vv.x) * rstd * nw.x, bfhi(vv.x) * rstd * nw.y),
                                  pack2(bflo(vv.y) * rstd * nw.z, bfhi(vv.y) * rstd * nw.w));
      }
    }
  }
}

__device__ __forceinline__ void k_gate(const int VB, const Params& p) {
  const int i = VB * 256 + threadIdx.x;
  const int h = i & 3, t = i >> 2;
  const int b = t / SL, l = t % SL;
  const int own = l >> 8;
  float q[64];
  {
    const ushort_t* src = p.mq + (size_t)t * 256 + h * 64;
#pragma unroll
    for (int d = 0; d < 64; d += 8) {
      uint4 v = *(const uint4*)(src + d);
      q[d] = bflo(v.x); q[d + 1] = bfhi(v.x); q[d + 2] = bflo(v.y); q[d + 3] = bfhi(v.y);
      q[d + 4] = bflo(v.z); q[d + 5] = bfhi(v.z); q[d + 6] = bflo(v.w); q[d + 7] = bfhi(v.w);
    }
  }
  float v0 = -INFINITY, v1 = -INFINITY, v2 = -INFINITY;
  int i0 = 0, i1 = 1, i2 = 2;
  for (int n = 0; n < own; ++n) {
    const float* kp = p.kpart + (size_t)((b * 4 + h) * 32 + n) * 256;
    float s = 0.f;
#pragma unroll
    for (int d = 0; d < 64; d += 4) {
      const float4 a = *(const float4*)(kp + d), bq = *(const float4*)(kp + 64 + d);
      const float4 cq = *(const float4*)(kp + 128 + d), dq = *(const float4*)(kp + 192 + d);
      s = fmaf(q[d], (a.x + bq.x) + (cq.x + dq.x), s); s = fmaf(q[d + 1], (a.y + bq.y) + (cq.y + dq.y), s);
      s = fmaf(q[d + 2], (a.z + bq.z) + (cq.z + dq.z), s); s = fmaf(q[d + 3], (a.w + bq.w) + (cq.w + dq.w), s);
    }
    if (s > v0) { v2 = v1; i2 = i1; v1 = v0; i1 = i0; v0 = s; i0 = n; }
    else if (s > v1) { v2 = v1; i2 = i1; v1 = s; i1 = n; }
    else if (s > v2) { v2 = s; i2 = n; }
  }
  const int nsel = own < 3 ? own : 3;
  const int js[3] = {i0, i1, i2};
#pragma unroll
  for (int sl = 0; sl < 3; ++sl) {
    if (sl < nsel) {
      const int bucket = (b * 4 + h) * 32 + js[sl];
      const int pos = atomicAdd(p.bcnt + bucket, 1);
      p.blist[(size_t)bucket * 8192 + pos] = l | (sl << 13);
    }
  }
}

__device__ __forceinline__ void attn_unit(char* smem, const ushort_t* __restrict__ Kp, const int kstride, const ushort_t* __restrict__ VTp,
                                          const size_t vstride, const ushort_t* __restrict__ qrow, const float slope, const int qrel,
                                          const bool causal, const int nst, f32x16 (&o)[2], float& m_out, float& l_out) {
  int tid = threadIdx.x;
  asm volatile("" : "+v"(tid));
  const int lane = tid & 63, r = lane & 31, hl = lane >> 5;
  char* s_K = smem;
  char* s_VT = smem + 18432;
  bf16x8 qf[4];
#pragma unroll
  for (int ks = 0; ks < 4; ++ks) qf[ks] = *(const bf16x8*)(qrow + ks * 16 + hl * 8);
#pragma unroll
  for (int e = 0; e < 16; ++e) { o[0][e] = 0.f; o[1][e] = 0.f; }
  float m = -1e30f, lsum = 0.f;
#pragma unroll 1
  for (int st = 0; st < nst; ++st) {
    {
      const int kr = tid >> 3, kc = tid & 7;
#pragma unroll
      for (int i = 0; i < 4; ++i) {
        const int row = kr + 32 * i;
        *(uint4*)(s_K + row * 144 + kc * 16) = *(const uint4*)(Kp + (size_t)(st * 128 + row) * kstride + kc * 8);
      }
      const int vr = tid >> 4, vc = tid & 15;
#pragma unroll
      for (int i = 0; i < 4; ++i) {
        const int row = vr + 16 * i;
        const uint4 vv = *(const uint4*)(VTp + (size_t)row * vstride + st * 128 + vc * 8);
        *(uint2*)(s_VT + row * 264 + vc * 16) = make_uint2(vv.x, vv.y);
        *(uint2*)(s_VT + row * 264 + vc * 16 + 8) = make_uint2(vv.z, vv.w);
      }
    }
    __syncthreads();
    f32x16 sc[4];
#pragma unroll
    for (int kt = 0; kt < 4; ++kt) {
#pragma unroll
      for (int e = 0; e < 16; ++e) sc[kt][e] = 0.f;
#pragma unroll
      for (int ks = 0; ks < 4; ++ks) {
        const bf16x8 a = *(const bf16x8*)(s_K + (32 * kt + r) * 144 + (2 * ks + hl) * 16);
        sc[kt] = __builtin_amdgcn_mfma_f32_32x32x16_bf16(a, qf[ks], sc[kt], 0, 0, 0);
      }
    }
    float mx = -1e30f;
    const int qk0 = qrel - st * 128 - 4 * hl;
#pragma unroll
    for (int kt = 0; kt < 4; ++kt) {
#pragma unroll
      for (int e = 0; e < 16; ++e) {
        const int dist = qk0 - (32 * kt + (e & 3) + 8 * (e >> 2));
        float v = fmaf(sc[kt][e], 0.125f, -slope * (float)dist);
        if (causal && dist < 0) v = -1e30f;
        sc[kt][e] = v;
        mx = fmaxf(mx, v);
      }
    }
    mx = fmaxf(mx, __shfl_xor(mx, 32));
    const float mnew = fmaxf(m, mx);
    const float alpha = __expf(m - mnew);
    m = mnew;
    lsum *= alpha;
#pragma unroll
    for (int e = 0; e < 16; ++e) { o[0][e] *= alpha; o[1][e] *= alpha; }
#pragma unroll
    for (int kt = 0; kt < 4; ++kt) {
#pragma unroll
      for (int e = 0; e < 16; ++e) {
        const float pe = __expf(sc[kt][e] - mnew);
        sc[kt][e] = pe;
        lsum += pe;
      }
    }
#pragma unroll
    for (int kt = 0; kt < 4; ++kt) {
#pragma unroll
      for (int k2 = 0; k2 < 2; ++k2) {
        uint4 pu = make_uint4(pack2(sc[kt][8 * k2 + 0], sc[kt][8 * k2 + 1]), pack2(sc[kt][8 * k2 + 2], sc[kt][8 * k2 + 3]),
                              pack2(sc[kt][8 * k2 + 4], sc[kt][8 * k2 + 5]), pack2(sc[kt][8 * k2 + 6], sc[kt][8 * k2 + 7]));
        const bf16x8 pf = *(bf16x8*)&pu;
        const int koff = (32 * kt + 16 * k2 + 4 * hl) * 2;
#pragma unroll
        for (int dt = 0; dt < 2; ++dt) {
          const char* ap = s_VT + (dt * 32 + r) * 264 + koff;
          const uint2 q0 = *(const uint2*)(ap);
          const uint2 q1 = *(const uint2*)(ap + 16);
          uint4 qq = make_uint4(q0.x, q0.y, q1.x, q1.y);
          const bf16x8 af = *(bf16x8*)&qq;
          o[dt] = __builtin_amdgcn_mfma_f32_32x32x16_bf16(af, pf, o[dt], 0, 0, 0);
        }
      }
    }
    __syncthreads();
  }
  m_out = m;
  l_out = lsum + __shfl_xor(lsum, 32);
}

__device__ __forceinline__ void ph_attn_unit(const int kind, const int a0, const int a1, char* smem, const Params& p) {
  const int tid = threadIdx.x, lane = tid & 63, wave = tid >> 6, r = lane & 31, hl = lane >> 5;
  f32x16 o[2];
  float m, lt;
  if (kind == 2) {
    const int bh = a0, b = bh >> 2, h = bh & 3;
    const int t = b * SL + a1 * 128 + wave * 32 + r;
    attn_unit(smem, p.memk_b + (size_t)b * MEM * 256 + h * 64, 256, p.memvT + (size_t)bh * 64 * MEM, MEM, p.xq + (size_t)t * 256 + h * 64, 0.f,
              1 << 20, false, 2, o, m, lt);
    const float inv = 1.f / lt;
#pragma unroll
    for (int dt = 0; dt < 2; ++dt)
#pragma unroll
      for (int q4 = 0; q4 < 4; ++q4) {
        const int d = dt * 32 + 8 * q4 + 4 * hl;
        *(uint2*)(p.mixed_b + (size_t)t * DM + 768 + h * 64 + d) =
            make_uint2(pack2(o[dt][4 * q4] * inv, o[dt][4 * q4 + 1] * inv), pack2(o[dt][4 * q4 + 2] * inv, o[dt][4 * q4 + 3] * inv));
      }
    return;
  }
  int bh, l, slot, jblk, nst = 2;
  bool valid = true, causal = false;
  if (kind == 0) {
    bh = a0 >> 5; jblk = a0 & 31;
    const int cnt = p.bcnt[a0];
    int qi = a1 * 128 + wave * 32 + r;
    if (qi >= cnt) { valid = false; qi = 0; }
    const int ent = p.blist[(size_t)a0 * 8192 + qi];
    l = ent & 8191; slot = ent >> 13;
  } else {
    bh = a0 >> 5; jblk = a0 & 31;
    l = jblk * 256 + a1 * 128 + wave * 32 + r; slot = 3; causal = true;
    nst = a1 + 1;
  }
  const int b = bh >> 2, h = bh & 3;
  const int t = b * SL + l;
  const float slope = exp2f(-2.f * (float)(h + 1));
  attn_unit(smem, p.mk + (size_t)(b * SL + jblk * 256) * 256 + h * 64, 256, p.vT + (size_t)bh * 64 * SL + jblk * 256, SL,
            p.mq + (size_t)t * 256 + h * 64, slope, l - jblk * 256, causal, nst, o, m, lt);
  if (valid) {
    const float inv = 1.f / lt;
    const size_t pi = ((size_t)t * 4 + h) * 4 + slot;
#pragma unroll
    for (int dt = 0; dt < 2; ++dt)
#pragma unroll
      for (int q4 = 0; q4 < 4; ++q4) {
        const int d = dt * 32 + 8 * q4 + 4 * hl;
        *(uint2*)(p.pO + pi * 64 + d) =
            make_uint2(pack2(o[dt][4 * q4] * inv, o[dt][4 * q4 + 1] * inv), pack2(o[dt][4 * q4 + 2] * inv, o[dt][4 * q4 + 3] * inv));
      }
    if (hl == 0) { p.pm[pi] = m; p.pl[pi] = lt; }
  }
}

__device__ __forceinline__ void ph_attn_combine(const int VB, const Params& p) {
  const int i = VB * 256 + threadIdx.x;
  const int dq = i & 7, th = i >> 3;
  const int t = th >> 2;
  const int own = (t & (SL - 1)) >> 8;
  const int nsel = own < 3 ? own : 3;
  float mv[4], wv[4];
  float M = p.pm[(size_t)th * 4 + 3];
  mv[3] = M;
#pragma unroll
  for (int sl = 0; sl < 3; ++sl) {
    mv[sl] = (sl < nsel) ? p.pm[(size_t)th * 4 + sl] : -1e30f;
    M = fmaxf(M, mv[sl]);
  }
  float W = 0.f;
#pragma unroll
  for (int sl = 0; sl < 4; ++sl) {
    const bool on = (sl == 3) || (sl < nsel);
    wv[sl] = on ? p.pl[(size_t)th * 4 + sl] * __expf(mv[sl] - M) : 0.f;
    W += wv[sl];
  }
  float acc[8];
#pragma unroll
  for (int k = 0; k < 8; ++k) acc[k] = 0.f;
#pragma unroll
  for (int sl = 0; sl < 4; ++sl) {
    const bool on = (sl == 3) || (sl < nsel);
    if (on) {
      float f[8];
      unpack8(*(const uint4*)(p.pO + ((size_t)th * 4 + sl) * 64 + dq * 8), f);
#pragma unroll
      for (int k = 0; k < 8; ++k) acc[k] = fmaf(wv[sl], f[k], acc[k]);
    }
  }
  const float inv = 1.f / W;
  const int h = th & 3;
  *(uint4*)(p.mixed_b + (size_t)t * DM + 512 + h * 64 + dq * 8) =
      make_uint4(pack2(acc[0] * inv, acc[1] * inv), pack2(acc[2] * inv, acc[3] * inv), pack2(acc[4] * inv, acc[5] * inv), pack2(acc[6] * inv, acc[7] * inv));
}


__device__ __forceinline__ int mkkey(const float f, const int idx, const int mask) {
  int b = __float_as_int(f);
  b = (b & ~mask) | idx;
  return b ^ ((b >> 31) & 0x7fffffff);
}
__device__ __forceinline__ int key2bits(const int k) { return k ^ ((k >> 31) & 0x7fffffff); }
#define CEI(a, b) { const int _mx = max(a, b), _mn = min(a, b); a = _mx; b = _mn; }
template <int N>
__device__ __forceinline__ void bitonic_sort_desc(int (&v)[N]) {
#pragma unroll
  for (int k = 2; k <= N; k <<= 1) {
#pragma unroll
    for (int j = k >> 1; j > 0; j >>= 1) {
#pragma unroll
      for (int i = 0; i < N; ++i) {
        const int l = i ^ j;
        if (l > i) {
          if ((i & k) == 0) { CEI(v[i], v[l]); } else { CEI(v[l], v[i]); }
        }
      }
    }
  }
}
__device__ __forceinline__ void merge16(int (&a)[16], const int (&b)[16]) {
#pragma unroll
  for (int i = 0; i < 16; ++i) a[i] = max(a[i], b[15 - i]);
#pragma unroll
  for (int j = 8; j > 0; j >>= 1) {
#pragma unroll
    for (int i = 0; i < 16; ++i) {
      const int l = i ^ j;
      if (l > i) { CEI(a[i], a[l]); }
    }
  }
}
__device__ __forceinline__ void merge_partner(int (&a)[16], const int xmask) {
  int o[16];
#pragma unroll
  for (int i = 0; i < 16; ++i) o[i] = __shfl_xor(a[i], xmask);
  merge16(a, o);
}
__device__ __forceinline__ bf16x8 pack_hi8(const float (&x)[8], float (&res)[8]) {
  unsigned u[4];
#pragma unroll
  for (int i = 0; i < 4; ++i) {
    const ushort_t h0 = f2bf(x[2 * i]), h1 = f2bf(x[2 * i + 1]);
    res[2 * i] = x[2 * i] - bf2f(h0);
    res[2 * i + 1] = x[2 * i + 1] - bf2f(h1);
    u[i] = (unsigned)h0 | ((unsigned)h1 << 16);
  }
  uint4 uu = make_uint4(u[0], u[1], u[2], u[3]);
  return *(bf16x8*)&uu;
}
__device__ __forceinline__ bf16x8 pack_8(const float (&x)[8]) {
  uint4 uu = make_uint4(pack2(x[0], x[1]), pack2(x[2], x[3]), pack2(x[4], x[5]), pack2(x[6], x[7]));
  return *(bf16x8*)&uu;
}

__device__ __forceinline__ void ph_gemm_route(const int vb, char* smem, const Params& p, const ushort_t* __restrict__ hn_b) {
  const int head = vb & 7, tt = vb >> 3;
  const int m0 = head * 128, n0 = tt * 128;
  f32x16 acc[2][2];
  gemm_core(p.w_qT, hn_b, DM, m0, n0, smem, acc);
  int tid = threadIdx.x;
  asm volatile("" : "+v"(tid));
  const int lane = tid & 63, r = lane & 31, hl = lane >> 5;
  const int wave = tid >> 6, wm = wave >> 1, wn = wave & 1;
  int* s_top = (int*)smem;
  const ushort_t* kh = p.skh + (size_t)wm * 128 * 64;
  const ushort_t* kl = p.skl + (size_t)wm * 128 * 64;
#pragma unroll
  for (int ni = 0; ni < 2; ++ni) {
    asm volatile("" ::: "memory");
    bf16x8 qh[4], ql[4];
#pragma unroll
    for (int mi = 0; mi < 2; ++mi) {
#pragma unroll
      for (int k2 = 0; k2 < 2; ++k2) {
        float x[8], res[8];
#pragma unroll
        for (int j = 0; j < 8; ++j) x[j] = acc[mi][ni][8 * k2 + j];
        qh[mi * 2 + k2] = pack_hi8(x, res);
        ql[mi * 2 + k2] = pack_8(res);
      }
    }
    int g0[16];
#pragma unroll
    for (int kh2 = 0; kh2 < 2; ++kh2) {
      int ga[16], gb[16];
#pragma unroll
      for (int kq = 0; kq < 2; ++kq) {
        const int kt = kh2 * 2 + kq;
        asm volatile("" ::: "memory");
        f32x16 sc;
#pragma unroll
        for (int e = 0; e < 16; ++e) sc[e] = 0.f;
#pragma unroll
        for (int st = 0; st < 4; ++st) {
          const int d0 = (st >> 1) * 32 + 16 * (st & 1) + 4 * hl;
          const size_t ko = (size_t)(kt * 32 + r) * 64 + d0;
          const uint2 h0 = *(const uint2*)(kh + ko), h1 = *(const uint2*)(kh + ko + 8);
          const uint2 l0 = *(const uint2*)(kl + ko), l1 = *(const uint2*)(kl + ko + 8);
          uint4 hq = make_uint4(h0.x, h0.y, h1.x, h1.y), lq = make_uint4(l0.x, l0.y, l1.x, l1.y);
          const bf16x8 ah = *(bf16x8*)&hq, al = *(bf16x8*)&lq;
          sc = __builtin_amdgcn_mfma_f32_32x32x16_bf16(ah, qh[st], sc, 0, 0, 0);
          sc = __builtin_amdgcn_mfma_f32_32x32x16_bf16(ah, ql[st], sc, 0, 0, 0);
          sc = __builtin_amdgcn_mfma_f32_32x32x16_bf16(al, qh[st], sc, 0, 0, 0);
        }
        if (kq == 0) {
#pragma unroll
          for (int e = 0; e < 16; ++e) ga[e] = mkkey(sc[e], kt * 32 + (e & 3) + 8 * (e >> 2) + 4 * hl, 127);
          bitonic_sort_desc<16>(ga);
        } else {
#pragma unroll
          for (int e = 0; e < 16; ++e) gb[e] = mkkey(sc[e], kt * 32 + (e & 3) + 8 * (e >> 2) + 4 * hl, 127);
          bitonic_sort_desc<16>(gb);
        }
      }
      merge16(ga, gb);
      if (kh2 == 0) {
#pragma unroll
        for (int i = 0; i < 16; ++i) g0[i] = ga[i];
      } else {
        merge16(g0, ga);
      }
    }
    merge_partner(g0, 32);
    {
      int* dst = s_top + ((size_t)wm * 128 + wn * 64 + ni * 32 + r) * 16 + hl * 8;
      int4 w0, w1;
      int lo8[8], hi8[8];
#pragma unroll
      for (int i = 0; i < 8; ++i) { lo8[i] = g0[i]; hi8[i] = g0[8 + i]; asm volatile("" : "+v"(lo8[i]), "+v"(hi8[i])); }
      w0 = make_int4(hl ? hi8[0] : lo8[0], hl ? hi8[1] : lo8[1], hl ? hi8[2] : lo8[2], hl ? hi8[3] : lo8[3]);
      w1 = make_int4(hl ? hi8[4] : lo8[4], hl ? hi8[5] : lo8[5], hl ? hi8[6] : lo8[6], hl ? hi8[7] : lo8[7]);
      *(int4*)dst = w0; *(int4*)(dst + 4) = w1;
    }
  }
  __syncthreads();
  {
    const int tok = tid >> 1, sub = tid & 1;
    int k1[16], k2[16];
    {
      const int4* a = (const int4*)(s_top + (size_t)tok * 16);
      const int4* b = (const int4*)(s_top + (size_t)(128 + tok) * 16);
#pragma unroll
      for (int i = 0; i < 4; ++i) {
        const int4 x = a[i], y = b[i];
        k1[4 * i] = x.x; k1[4 * i + 1] = x.y; k1[4 * i + 2] = x.z; k1[4 * i + 3] = x.w;
        k2[4 * i] = y.x; k2[4 * i + 1] = y.y; k2[4 * i + 2] = y.z; k2[4 * i + 3] = y.w;
      }
    }
    float v1f[16], v2f[16];
#pragma unroll
    for (int i = 0; i < 16; ++i) { v1f[i] = __int_as_float(key2bits(k1[i])); v2f[i] = __int_as_float(key2bits(k2[i])); }
    int c[32];
    c[0] = sub ? mkkey(v1f[3] + v2f[3], 51, 255) : mkkey(v1f[0] + v2f[0], 0, 255);
    c[1] = sub ? mkkey(v1f[4] + v2f[0], 64, 255) : mkkey(v1f[0] + v2f[1], 1, 255);
    c[2] = sub ? mkkey(v1f[4] + v2f[1], 65, 255) : mkkey(v1f[0] + v2f[2], 2, 255);
    c[3] = sub ? mkkey(v1f[4] + v2f[2], 66, 255) : mkkey(v1f[0] + v2f[3], 3, 255);
    c[4] = sub ? mkkey(v1f[5] + v2f[0], 80, 255) : mkkey(v1f[0] + v2f[4], 4, 255);
    c[5] = sub ? mkkey(v1f[5] + v2f[1], 81, 255) : mkkey(v1f[0] + v2f[5], 5, 255);
    c[6] = sub ? mkkey(v1f[6] + v2f[0], 96, 255) : mkkey(v1f[0] + v2f[6], 6, 255);
    c[7] = sub ? mkkey(v1f[6] + v2f[1], 97, 255) : mkkey(v1f[0] + v2f[7], 7, 255);
    c[8] = sub ? mkkey(v1f[7] + v2f[0], 112, 255) : mkkey(v1f[0] + v2f[8], 8, 255);
    c[9] = sub ? mkkey(v1f[7] + v2f[1], 113, 255) : mkkey(v1f[0] + v2f[9], 9, 255);
    c[10] = sub ? mkkey(v1f[8] + v2f[0], 128, 255) : mkkey(v1f[0] + v2f[10], 10, 255);
    c[11] = sub ? mkkey(v1f[9] + v2f[0], 144, 255) : mkkey(v1f[0] + v2f[11], 11, 255);
    c[12] = sub ? mkkey(v1f[10] + v2f[0], 160, 255) : mkkey(v1f[0] + v2f[12], 12, 255);
    c[13] = sub ? mkkey(v1f[11] + v2f[0], 176, 255) : mkkey(v1f[0] + v2f[13], 13, 255);
    c[14] = sub ? mkkey(v1f[12] + v2f[0], 192, 255) : mkkey(v1f[0] + v2f[14], 14, 255);
    c[15] = sub ? mkkey(v1f[13] + v2f[0], 208, 255) : mkkey(v1f[0] + v2f[15], 15, 255);
    c[16] = sub ? mkkey(v1f[14] + v2f[0], 224, 255) : mkkey(v1f[1] + v2f[0], 16, 255);
    c[17] = sub ? mkkey(v1f[15] + v2f[0], 240, 255) : mkkey(v1f[1] + v2f[1], 17, 255);
    c[18] = sub ? (int)0x80000000 : mkkey(v1f[1] + v2f[2], 18, 255);
    c[19] = sub ? (int)0x80000000 : mkkey(v1f[1] + v2f[3], 19, 255);
    c[20] = sub ? (int)0x80000000 : mkkey(v1f[1] + v2f[4], 20, 255);
    c[21] = sub ? (int)0x80000000 : mkkey(v1f[1] + v2f[5], 21, 255);
    c[22] = sub ? (int)0x80000000 : mkkey(v1f[1] + v2f[6], 22, 255);
    c[23] = sub ? (int)0x80000000 : mkkey(v1f[1] + v2f[7], 23, 255);
    c[24] = sub ? (int)0x80000000 : mkkey(v1f[2] + v2f[0], 32, 255);
    c[25] = sub ? (int)0x80000000 : mkkey(v1f[2] + v2f[1], 33, 255);
    c[26] = sub ? (int)0x80000000 : mkkey(v1f[2] + v2f[2], 34, 255);
    c[27] = sub ? (int)0x80000000 : mkkey(v1f[2] + v2f[3], 35, 255);
    c[28] = sub ? (int)0x80000000 : mkkey(v1f[2] + v2f[4], 36, 255);
    c[29] = sub ? (int)0x80000000 : mkkey(v1f[3] + v2f[0], 48, 255);
    c[30] = sub ? (int)0x80000000 : mkkey(v1f[3] + v2f[1], 49, 255);
    c[31] = sub ? (int)0x80000000 : mkkey(v1f[3] + v2f[2], 50, 255);
    int h0[16], h1[16];
#pragma unroll
    for (int i = 0; i < 16; ++i) { h0[i] = c[i]; h1[i] = c[16 + i]; }
    bitonic_sort_desc<16>(h0); bitonic_sort_desc<16>(h1);
    merge16(h0, h1);
    merge_partner(h0, 1);
    float sv[16];
#pragma unroll
    for (int i = 0; i < 16; ++i) sv[i] = __int_as_float(key2bits(h0[i]));
    float den = 0.f;
#pragma unroll
    for (int i = 0; i < 16; ++i) den += __expf(sv[i] - sv[0]);
    const float inv = 1.f / den;
    int eo[8]; float go[8];
#pragma unroll
    for (int i = 0; i < 8; ++i) {
      int klo = h0[i], khi = h0[8 + i];
      asm volatile("" : "+v"(klo), "+v"(khi));
      const int kk = sub ? khi : klo;
      const int bits = key2bits(kk);
      const int code = bits & 255;
      const int ia = key2bits(s_top[(size_t)tok * 16 + (code >> 4)]) & 127;
      const int ib = key2bits(s_top[(size_t)(128 + tok) * 16 + (code & 15)]) & 127;
      eo[i] = ia * 128 + ib;
      go[i] = __expf(__int_as_float(bits) - sv[0]) * inv;
    }
    const size_t ob = ((size_t)(n0 + tok) * 8 + head) * 16 + sub * 8;
    *(int4*)(p.eidx + ob) = make_int4(eo[0], eo[1], eo[2], eo[3]);
    *(int4*)(p.eidx + ob + 4) = make_int4(eo[4], eo[5], eo[6], eo[7]);
    *(float4*)(p.egate + ob) = make_float4(go[0], go[1], go[2], go[3]);
    *(float4*)(p.egate + ob + 4) = make_float4(go[4], go[5], go[6], go[7]);
  }
}

__device__ __forceinline__ void ph_subkeys(const Params& p) {
  for (int i = blockIdx.x * 256 + threadIdx.x; i < 2 * 128 * 64; i += gridDim.x * 256) {
    const float v = (i < 8192) ? p.sk1[i] : p.sk2[i - 8192];
    const ushort_t hi = f2bf(v);
    p.skh[i] = hi;
    p.skl[i] = f2bf(v - bf2f(hi));
  }
}

typedef __attribute__((ext_vector_type(2))) __bf16 bf16x2_t;
__device__ __forceinline__ float dot2bf(unsigned a, unsigned b, float c) {
  return __builtin_amdgcn_fdot2_f32_bf16(__builtin_bit_cast(bf16x2_t, a), __builtin_bit_cast(bf16x2_t, b), c, false);
}
__device__ __forceinline__ float dot8(const uint4 a, const uint4 b, float c) {
  c = dot2bf(a.x, b.x, c); c = dot2bf(a.y, b.y, c); c = dot2bf(a.z, b.z, c); c = dot2bf(a.w, b.w, c);
  return c;
}
__device__ __forceinline__ void axpy8(const float cf, const uint4 u, float (&acc)[8]) {
  acc[0] = fmaf(cf, bflo(u.x), acc[0]); acc[1] = fmaf(cf, bfhi(u.x), acc[1]);
  acc[2] = fmaf(cf, bflo(u.y), acc[2]); acc[3] = fmaf(cf, bfhi(u.y), acc[3]);
  acc[4] = fmaf(cf, bflo(u.z), acc[4]); acc[5] = fmaf(cf, bfhi(u.z), acc[5]);
  acc[6] = fmaf(cf, bflo(u.w), acc[6]); acc[7] = fmaf(cf, bfhi(u.w), acc[7]);
}
__device__ __forceinline__ void k_peer_experts(const int VB, const ushort_t* __restrict__ hn, const int* __restrict__ eidx,
                                               const float* __restrict__ egate, const ushort_t* __restrict__ down, const ushort_t* __restrict__ up,
                                               float* __restrict__ out) {
  const int lane = threadIdx.x & 63;
  const int wave = __builtin_amdgcn_readfirstlane(threadIdx.x >> 6);
  const int t = VB * 4 + wave;
  const uint4 xa = *(const uint4*)(hn + (size_t)t * DM + lane * 8);
  const uint4 xb = *(const uint4*)(hn + (size_t)t * DM + 512 + lane * 8);
  float a0[8], a1[8];
#pragma unroll
  for (int i = 0; i < 8; ++i) { a0[i] = 0.f; a1[i] = 0.f; }
  const int* ei = eidx + (size_t)t * 128;
  const float* eg = egate + (size_t)t * 128;
  const int myex = ((lane >> 5) & 1) * 4 + ((lane >> 4) & 1) * 2 + ((lane >> 3) & 1);
  const bool b5 = (lane & 32) != 0, b4 = (lane & 16) != 0, b3 = (lane & 8) != 0;
#pragma unroll 1
  for (int c = 0; c < 16; ++c) {
    int e[8];
#pragma unroll
    for (int i = 0; i < 8; ++i) e[i] = ei[c * 8 + i];
    uint4 d0[8], d1[8], u0[8], u1[8];
#pragma unroll
    for (int i = 0; i < 8; ++i) {
      const ushort_t* dr = down + (size_t)e[i] * DM + lane * 8;
      d0[i] = *(const uint4*)(dr);
      d1[i] = *(const uint4*)(dr + 512);
    }
#pragma unroll
    for (int i = 0; i < 8; ++i) {
      const ushort_t* ur = up + (size_t)e[i] * DM + lane * 8;
      u0[i] = *(const uint4*)(ur);
      u1[i] = *(const uint4*)(ur + 512);
    }
    const float gate = eg[c * 8 + myex];
    float pr[8];
#pragma unroll
    for (int i = 0; i < 8; ++i) pr[i] = dot8(d1[i], xb, dot8(d0[i], xa, 0.f));
    float q4[4];
#pragma unroll
    for (int i = 0; i < 4; ++i) {
      const float snd = b5 ? pr[i] : pr[i + 4];
      const float kp = b5 ? pr[i + 4] : pr[i];
      q4[i] = kp + __shfl_xor(snd, 32);
    }
    float q2[2];
#pragma unroll
    for (int i = 0; i < 2; ++i) {
      const float snd = b4 ? q4[i] : q4[i + 2];
      const float kp = b4 ? q4[i + 2] : q4[i];
      q2[i] = kp + __shfl_xor(snd, 16);
    }
    float q1;
    {
      const float snd = b3 ? q2[0] : q2[1];
      const float kp = b3 ? q2[1] : q2[0];
      q1 = kp + __shfl_xor(snd, 8);
    }
    q1 += __shfl_xor(q1, 4);
    q1 += __shfl_xor(q1, 2);
    q1 += __shfl_xor(q1, 1);
    const float coef = gate * gelu_f(q1);
#pragma unroll
    for (int i = 0; i < 8; ++i) {
      const int src = ((i >> 2) & 1) * 32 + ((i >> 1) & 1) * 16 + (i & 1) * 8;
      const float cf = __int_as_float(__builtin_amdgcn_readlane(__float_as_int(coef), src));
      axpy8(cf, u0[i], a0);
      axpy8(cf, u1[i], a1);
    }
  }
  float* orow = out + (size_t)t * DM;
  {
    float4 h0 = *(float4*)(orow + lane * 8), h1 = *(float4*)(orow + lane * 8 + 4);
    h0.x += a0[0]; h0.y += a0[1]; h0.z += a0[2]; h0.w += a0[3]; h1.x += a0[4]; h1.y += a0[5]; h1.z += a0[6]; h1.w += a0[7];
    *(float4*)(orow + lane * 8) = h0; *(float4*)(orow + lane * 8 + 4) = h1;
    float4 g0 = *(float4*)(orow + 512 + lane * 8), g1 = *(float4*)(orow + 512 + lane * 8 + 4);
    g0.x += a1[0]; g0.y += a1[1]; g0.z += a1[2]; g0.w += a1[3]; g1.x += a1[4]; g1.y += a1[5]; g1.z += a1[6]; g1.w += a1[7];
    *(float4*)(orow + 512 + lane * 8) = g0; *(float4*)(orow + 512 + lane * 8 + 4) = g1;
  }
}

#define PHASE(NBLK, CALL) \
  for (int VB = blockIdx.x; VB < (NBLK); VB += gridDim.x) { CALL; __syncthreads(); }
#define PHASE_NS(NBLK, CALL) \
  for (int VB = blockIdx.x; VB < (NBLK); VB += gridDim.x) { CALL; }

__global__ __launch_bounds__(256, 2) void fwd_megakernel(Params p) {
  __shared__ __attribute__((aligned(16))) char smem_raw[SMEM_BYTES];
  float* smem = (float*)smem_raw;
  cg::grid_group grid = cg::this_grid();
  volatile LAS unsigned* xb_st = (volatile LAS unsigned*)(smem_raw + 73728);
  if (threadIdx.x == 0) { xb_st[0] = 0u; xb_st[1] = 0u; xb_st[2] = 0u; xb_st[3] = 0u; }
  __syncthreads();
  const XcdBarrier xb = xcd_barrier_post(p.bar, xb_st);
  PHASE_NS(NT / 4, ph_rmsnorm_bf16(VB, p.x, p.mix_norm_w, p.xn_b, p.w_in, p.dt_bias, p.dt));
  PHASE_NS(NB * MEM / 4, ph_rmsnorm_bf16(VB, p.mem, p.mem_norm_w, p.memn_b, nullptr, nullptr, nullptr));
  PHASE(16 * 40, ph_wtrans(VB, smem, p.w_in, INC, p.w_inT, 40, 8));
  PHASE(16 * 16, ph_wtrans(VB, smem, p.w_out, DM, p.w_outT, 16, 0));
  PHASE(16 * 16, ph_wtrans(VB, smem, p.w_query, DM, p.w_qT, 16, 0));
  PHASE(16 * 8, ph_wtrans(VB, smem, p.w_mem_kv, 512, p.w_memT, 8, 0));
  if (blockIdx.x == 0) p.bcnt[threadIdx.x] = 0;
  ph_subkeys(p);
  PHASE_NS(2048, ph_cvt(VB, p.e_down, p.ed_b));
  PHASE_NS(2048, ph_cvt(VB, p.e_up, p.eu_b));
  grid.sync();
  PHASE(20 * (NT / 128), ph_gemm_proj(VB, smem_raw, p));
  PHASE(4 * (NB * MEM / 128), ph_gemm_mem(VB, smem_raw, p));
  xcd_barrier(xb);
  PHASE(NB * 64 * 8, ph_ssd1(VB, smem_raw, p));
  PHASE_NS(NT * 4 / 256, k_gate(VB, p));
  PHASE(NB * 4 * 64, ph_attn_unit(2, VB >> 6, VB & 63, smem_raw, p));
  xcd_barrier(xb);
  PHASE_NS(NB * 8 * 64 * 128 / 256, ph_ssd2(VB, p));
  {
    int* s_pref = (int*)(smem_raw + 72192);
    {
      const int tid = threadIdx.x;
      int v = (p.bcnt[tid] + 127) >> 7;
      const int lane = tid & 63;
#pragma unroll
      for (int o = 1; o < 64; o <<= 1) { int nb = __shfl_up(v, o); if (lane >= o) v += nb; }
      int* s_wt = s_pref + 256;
      if (lane == 63) s_wt[tid >> 6] = v;
      __syncthreads();
      int add = 0;
      for (int ww = 0; ww < (tid >> 6); ++ww) add += s_wt[ww];
      s_pref[tid] = v + add;
      __syncthreads();
    }
    const int Ug = s_pref[255];
    for (int u = blockIdx.x; u < Ug + NB * 4 * 32 * 2; u += gridDim.x) {
      if (u < Ug) {
        int lo = 0, hi = 255;
        while (lo < hi) { int mid = (lo + hi) >> 1; if (s_pref[mid] > u) hi = mid; else lo = mid + 1; }
        const int prev = lo ? s_pref[lo - 1] : 0;
        ph_attn_unit(0, lo, u - prev, smem_raw, p);
      } else {
        const int v = u - Ug;
        ph_attn_unit(1, v >> 1, v & 1, smem_raw, p);
      }
      __syncthreads();
    }
  }
  xcd_barrier(xb);
  PHASE(NB * 64 * 2, ph_ssd3(VB, smem_raw, p));
  PHASE_NS(NT * 4 * 8 / 256, ph_attn_combine(VB, p));
  xcd_barrier(xb);
  PHASE(8 * (NT / 128), ph_gemm_f32(VB, smem_raw, p.mixed_b, p.w_outT, p.out, p.x));
  xcd_barrier(xb);
  ushort_t* hn_b = p.xn_b;
  PHASE_NS(NT / 4, ph_rmsnorm_bf16(VB, p.out, p.ffn_norm_w, hn_b, nullptr, nullptr, nullptr));
  xcd_barrier(xb);
  PHASE(8 * (NT / 128), ph_gemm_route(VB, smem_raw, p, hn_b));
  xcd_barrier(xb);
  PHASE_NS(NT / 4, k_peer_experts(VB, hn_b, p.eidx, p.egate, p.ed_b, p.eu_b, p.out));
}
}

extern "C" void kernel_launch(void* const* d_in, const int* in_sizes, int n_in, void* d_out, int out_size, void* d_ws, size_t ws_size,
                              hipStream_t stream) {
  Params p{};
  p.x = (const float*)d_in[0]; p.mem = (const float*)d_in[1]; p.mix_norm_w = (const float*)d_in[2]; p.w_in = (const float*)d_in[3];
  p.conv_w = (const float*)d_in[4]; p.conv_b = (const float*)d_in[5]; p.dt_bias = (const float*)d_in[6]; p.a_log = (const float*)d_in[7];
  p.ssd_d = (const float*)d_in[8]; p.ssd_norm_w = (const float*)d_in[9]; p.mq_norm_w = (const float*)d_in[10]; p.mk_norm_w = (const float*)d_in[11];
  p.mem_norm_w = (const float*)d_in[12]; p.w_mem_kv = (const float*)d_in[13]; p.xq_norm_w = (const float*)d_in[14]; p.xk_norm_w = (const float*)d_in[15];
  p.w_out = (const float*)d_in[16]; p.ffn_norm_w = (const float*)d_in[17]; p.w_query = (const float*)d_in[18]; p.sk1 = (const float*)d_in[19];
  p.sk2 = (const float*)d_in[20]; p.e_down = (const float*)d_in[21]; p.e_up = (const float*)d_in[22];
  p.out = (float*)d_out;
  char* ws = (char*)d_ws;
  size_t o = 0;
  auto take = [&](size_t bytes) { char* q = ws + o; o += (bytes + 255) & ~(size_t)255; return q; };
  p.xn_b = (ushort_t*)take((size_t)NT * DM * 2);
  p.xc = p.xn_b;
  p.w_inT = (ushort_t*)take((size_t)NPROJ * DM * 2);
  p.w_outT = (ushort_t*)take((size_t)DM * DM * 2);
  p.w_qT = (ushort_t*)take((size_t)DM * DM * 2);
  p.w_memT = (ushort_t*)take((size_t)512 * DM * 2);
  p.memn_b = (ushort_t*)take((size_t)NB * MEM * DM * 2);
  p.memk_b = (ushort_t*)take((size_t)NB * MEM * 256 * 2);
  p.memvT = (ushort_t*)take((size_t)NB * MEM * 256 * 2);
  char* regQ = take((size_t)NT * 2560 * 2);
  p.zs = (ushort_t*)regQ;
  p.xbc_raw = (ushort_t*)(regQ + (size_t)NT * 512 * 2);
  p.mq = (ushort_t*)(regQ + (size_t)NT * 1536 * 2);
  p.mk = (ushort_t*)(regQ + (size_t)NT * 1792 * 2);
  p.vT = (ushort_t*)(regQ + (size_t)NT * 2048 * 2);
  p.xq = (ushort_t*)(regQ + (size_t)NT * 2304 * 2);
  p.q = (float*)regQ;
  p.dt = (float*)take((size_t)NT * 8 * 4);
  p.acs = (float*)take((size_t)NT * 8 * 4);
  p.cdec = (float*)take((size_t)NB * 64 * 8 * 4);
  p.states = (float*)d_out;
  p.sin_b = (ushort_t*)((char*)d_out + (size_t)NB * 64 * 8 * 8192 * 4);
  p.xT = (ushort_t*)((char*)d_out + (size_t)NB * 64 * 8 * 8192 * 6);
  p.mixed_b = (ushort_t*)take((size_t)NT * DM * 2);
  p.kpart = (float*)take((size_t)NB * 4 * 32 * 4 * 64 * 4);
  p.bcnt = (int*)take(256 * 4);
  p.blist = (int*)take((size_t)256 * 8192 * 4);
  p.pm = (float*)take((size_t)NT * 16 * 4);
  p.pl = (float*)take((size_t)NT * 16 * 4);
  p.pO = p.xbc_raw;
  p.eidx = (int*)take((size_t)NT * 128 * 4);
  p.egate = (float*)take((size_t)NT * 128 * 4);
  p.ed_b = (ushort_t*)take((size_t)16384 * DM * 2);
  p.eu_b = (ushort_t*)take((size_t)16384 * DM * 2);
  p.bar = (unsigned*)take(XCD_BAR_WORDS * 4);
  p.skh = (ushort_t*)take(2 * 128 * 64 * 2);
  p.skl = (ushort_t*)take(2 * 128 * 64 * 2);
  if (o > ws_size) return;
  (void)hipMemsetAsync(p.bar, 0, XCD_BAR_WORDS * 4, stream);
  static int grid_blocks = 0;
  if (!grid_blocks) {
    int dev = 0, cus = 0, per_cu = 0;
    (void)hipGetDevice(&dev);
    (void)hipDeviceGetAttribute(&cus, hipDeviceAttributeMultiprocessorCount, dev);
    (void)hipOccupancyMaxActiveBlocksPerMultiprocessor(&per_cu, fwd_megakernel, 256, 0);
    if (per_cu > 2) per_cu = 2;
    if (per_cu < 1) per_cu = 1;
    grid_blocks = cus * per_cu;
  }
  void* args[] = {&p};
  hipError_t e = hipLaunchCooperativeKernel((void*)fwd_megakernel, dim3(grid_blocks), dim3(256), args, 0, stream);
  if (e != hipSuccess) fprintf(stderr, "cooperative launch failed: %s (grid %d)\n", hipGetErrorString(e), grid_blocks);
}
```

```cpp
#include <hip/hip_runtime.h>
#include <hip/hip_cooperative_groups.h>
#include <cstdio>
#include <math.h>
#include <stdint.h>
namespace cg = cooperative_groups;

namespace {
typedef unsigned short ushort_t;
typedef __attribute__((ext_vector_type(8))) short bf16x8;
typedef __attribute__((ext_vector_type(16))) float f32x16;

constexpr int DM = 1024;
constexpr int NB = 2;
constexpr int SL = 8192;
constexpr int NT = NB * SL;
constexpr int MEM = 256;
constexpr int INC = 2568;
constexpr int NPROJ = 2560;
constexpr float EPS = 1e-6f;
constexpr int SMEM_BYTES = 73728 + 256;

__device__ __forceinline__ float silu_f(float x) { return x / (1.f + expf(-x)); }
__device__ __forceinline__ float softplus_f(float x) { return fmaxf(x, 0.f) + log1pf(expf(-fabsf(x))); }
__device__ __forceinline__ float gelu_f(float x) { return 0.5f * x * (1.f + erff(x * 0.70710678118654752f)); }
__device__ __forceinline__ ushort_t f2bf(float x) {
  unsigned u = __float_as_uint(x);
  u += 0x7fffu + ((u >> 16) & 1u);
  return (ushort_t)(u >> 16);
}
__device__ __forceinline__ float bf2f(ushort_t h) { return __uint_as_float(((unsigned)h) << 16); }
__device__ __forceinline__ float bflo(unsigned w) { return __uint_as_float(w << 16); }
__device__ __forceinline__ float bfhi(unsigned w) { return __uint_as_float(w & 0xffff0000u); }
__device__ __forceinline__ unsigned pack2(float a, float b) { return (unsigned)f2bf(a) | ((unsigned)f2bf(b) << 16); }

__device__ __forceinline__ void unpack8(const uint4 v, float (&f)[8]) {
  f[0] = bflo(v.x); f[1] = bfhi(v.x); f[2] = bflo(v.y); f[3] = bfhi(v.y);
  f[4] = bflo(v.z); f[5] = bfhi(v.z); f[6] = bflo(v.w); f[7] = bfhi(v.w);
}

__device__ __forceinline__ float wave_sum(float v) {
#pragma unroll
  for (int o = 32; o > 0; o >>= 1) v += __shfl_xor(v, o);
  return v;
}
__device__ __forceinline__ float wave_max(float v) {
#pragma unroll
  for (int o = 32; o > 0; o >>= 1) v = fmaxf(v, __shfl_xor(v, o));
  return v;
}


#define XB_TMO      128
#define XB_XCNT(j)  (256  + 64 * (j))
#define XB_XSUB(j)  (1280 + 64 * (j))
#define XB_XGEN(j)  (2304 + 64 * (j))
#define XB_TOP      3328
#define XB_TOPGEN   3392
#define XCD_BAR_WORDS 3456
#define XB_SPIN_CAP (1u << 20)
#define LAS __attribute__((address_space(3)))
__device__ __forceinline__ unsigned xb_ld(unsigned* p)              { return __hip_atomic_load(p, __ATOMIC_RELAXED, __HIP_MEMORY_SCOPE_AGENT); }
__device__ __forceinline__ unsigned xb_add(unsigned* p, unsigned v) { return __hip_atomic_fetch_add(p, v, __ATOMIC_RELAXED, __HIP_MEMORY_SCOPE_AGENT); }
__device__ __forceinline__ unsigned xb_xcc_id() { return (unsigned)__builtin_amdgcn_s_getreg((3 << 11) | 20) & 0xFu; }
#define XB_SPIN(cond, bar) do { unsigned _sp = 0; while (cond) { __builtin_amdgcn_s_sleep(1); \
    if ((++_sp & 255u) == 0u) { if (xb_ld(&(bar)[XB_TMO])) break; if (_sp > XB_SPIN_CAP) { atomicAdd(&(bar)[XB_TMO], 1u); break; } } } } while (0)
struct XcdBarrier { unsigned* bar; unsigned x; volatile LAS unsigned* st; };
__device__ __forceinline__ XcdBarrier xcd_barrier_post(unsigned* bar, volatile LAS unsigned* st) {
  XcdBarrier b; b.bar = bar; b.x = xb_xcc_id(); b.st = st;
  if (threadIdx.x == 0) (void)xb_add(&bar[XB_XCNT(b.x)], 1u);
  return b;
}
__device__ __forceinline__ void xcd_barrier_complete(unsigned* bar, unsigned x, unsigned& nloc, unsigned& nx) {
  const unsigned G = gridDim.x * gridDim.y * gridDim.z;
  unsigned sum, cnt, mine, sp = 0u;
  for (;;) {
    sum = 0u; cnt = 0u; mine = 0u;
#pragma unroll
    for (unsigned j = 0; j < 16; ++j) { const unsigned c = xb_ld(&bar[XB_XCNT(j)]); sum += c; cnt += (c > 0u) ? 1u : 0u; mine = (j == x) ? c : mine; }
    if (sum == G) break;
    __builtin_amdgcn_s_sleep(1);
    if ((++sp & 255u) == 0u) { if (xb_ld(&bar[XB_TMO])) break; if (sp > XB_SPIN_CAP) { atomicAdd(&bar[XB_TMO], 1u); break; } }
  }
  nloc = mine > 0u ? mine : 1u; nx = cnt > 0u ? cnt : 1u;
}
__device__ __forceinline__ void xcd_barrier(const XcdBarrier& b) {
  asm volatile("s_waitcnt vmcnt(0)" ::: "memory");
  __syncthreads();
  if (threadIdx.x == 0) {
    unsigned* bar = b.bar;
    __builtin_amdgcn_s_waitcnt(0);
    unsigned nloc = b.st[0], nx = b.st[1];
    if (nloc == 0u) { xcd_barrier_complete(bar, b.x, nloc, nx); b.st[0] = nloc; b.st[1] = nx; }
    const unsigned old = xb_add(&bar[XB_XSUB(b.x)], 1u);
    const unsigned gen = old / nloc;
    if (old + 1u == (gen + 1u) * nloc) {
      __builtin_amdgcn_fence(__ATOMIC_RELEASE, "agent");
      asm volatile("s_waitcnt vmcnt(0)" ::: "memory");
      const unsigned og = xb_add(&bar[XB_TOP], 1u);
      const unsigned tg = og / nx;
      if (og + 1u == (tg + 1u) * nx) xb_add(&bar[XB_TOPGEN], 1u);
      else XB_SPIN(xb_ld(&bar[XB_TOPGEN]) == tg, bar);
      __builtin_amdgcn_fence(__ATOMIC_ACQUIRE, "agent");
      xb_add(&bar[XB_XGEN(b.x)], 1u);
      asm volatile("s_waitcnt vmcnt(0)" ::: "memory");
    } else {
      XB_SPIN(xb_ld(&bar[XB_XGEN(b.x)]) == gen, bar);
      __builtin_amdgcn_fence(__ATOMIC_ACQUIRE, "agent");
      asm volatile("s_waitcnt vmcnt(0)" ::: "memory");
    }
  }
  __syncthreads();
}

struct Params {
  const float *x, *mem, *mix_norm_w, *w_in, *conv_w, *conv_b, *dt_bias, *a_log, *ssd_d, *ssd_norm_w, *mq_norm_w, *mk_norm_w,
      *mem_norm_w, *w_mem_kv, *xq_norm_w, *xk_norm_w, *w_out, *ffn_norm_w, *w_query, *sk1, *sk2, *e_down, *e_up;
  float* out;
  ushort_t *xn_b, *w_inT, *w_outT, *w_qT, *w_memT, *memn_b, *zs, *xbc_raw, *mq, *mk, *xq, *memk_b, *mixed_b;
  float *dt, *q, *egate, *acs, *cdec, *states;
  ushort_t *xc, *xT, *sin_b;
  int *eidx, *bcnt, *blist;
  unsigned* bar;
  ushort_t *skh, *skl;
  unsigned char *ed8, *eu8;
  float *ed_s, *eu_s;
  float *kpart, *pm, *pl;
  ushort_t *vT, *memvT, *pO;
};

__device__ __forceinline__ void ph_rmsnorm_bf16(const int vb, const float* __restrict__ x, const float* __restrict__ w,
                                                ushort_t* __restrict__ outb, const float* __restrict__ w_in, const float* __restrict__ dt_bias,
                                                float* __restrict__ dt) {
  const int lane = threadIdx.x & 63;
  const int row = vb * 4 + (threadIdx.x >> 6);
  const float* xr = x + (size_t)row * DM;
  float4 v[4];
#pragma unroll
  for (int i = 0; i < 4; ++i) v[i] = *(const float4*)(xr + i * 256 + lane * 4);
  float ss = 0.f;
#pragma unroll
  for (int i = 0; i < 4; ++i) ss += v[i].x * v[i].x + v[i].y * v[i].y + v[i].z * v[i].z + v[i].w * v[i].w;
  ss = wave_sum(ss);
  const float r = rsqrtf(ss / DM + EPS);
  float part[8];
#pragma unroll
  for (int hh = 0; hh < 8; ++hh) part[hh] = 0.f;
#pragma unroll
  for (int i = 0; i < 4; ++i) {
    const float4 ww = *(const float4*)(w + i * 256 + lane * 4);
    const float o0 = v[i].x * r * ww.x, o1 = v[i].y * r * ww.y, o2 = v[i].z * r * ww.z, o3 = v[i].w * r * ww.w;
    *(uint2*)(outb + (size_t)row * DM + i * 256 + lane * 4) = make_uint2(pack2(o0, o1), pack2(o2, o3));
    if (dt) {
      const float xs[4] = {o0, o1, o2, o3};
#pragma unroll
      for (int k = 0; k < 4; ++k) {
        const float* wr = w_in + (size_t)(i * 256 + lane * 4 + k) * INC + 1536;
        const float4 a = *(const float4*)(wr);
        const float4 b = *(const float4*)(wr + 4);
        part[0] = fmaf(xs[k], a.x, part[0]); part[1] = fmaf(xs[k], a.y, part[1]);
        part[2] = fmaf(xs[k], a.z, part[2]); part[3] = fmaf(xs[k], a.w, part[3]);
        part[4] = fmaf(xs[k], b.x, part[4]); part[5] = fmaf(xs[k], b.y, part[5]);
        part[6] = fmaf(xs[k], b.z, part[6]); part[7] = fmaf(xs[k], b.w, part[7]);
      }
    }
  }
  if (dt) {
    float mine = 0.f;
#pragma unroll
    for (int hh = 0; hh < 8; ++hh) {
      const float sfull = wave_sum(part[hh]);
      if (lane == hh) mine = sfull;
    }
    if (lane < 8) dt[(size_t)row * 8 + lane] = softplus_f(mine + dt_bias[lane]);
  }
}

__device__ __forceinline__ void ph_wtrans(const int vb, float* smem, const float* __restrict__ W, const int ldw, ushort_t* __restrict__ Wt,
                                          const int ntiles, const int skip) {
  float (*s)[65] = (float (*)[65])smem;
  const int tid = threadIdx.x;
  const int kt = vb / ntiles, nt = vb % ntiles;
  const int nd0 = nt * 64;
  const int ns0 = (nd0 < 1536) ? nd0 : nd0 + skip;
  {
    const int k = tid >> 2, nc = (tid & 3) * 16;
    const float* src = W + (size_t)(kt * 64 + k) * ldw + ns0 + nc;
#pragma unroll
    for (int j = 0; j < 4; ++j) {
      float4 v = *(const float4*)(src + j * 4);
      s[k][nc + j * 4 + 0] = v.x; s[k][nc + j * 4 + 1] = v.y; s[k][nc + j * 4 + 2] = v.z; s[k][nc + j * 4 + 3] = v.w;
    }
  }
  __syncthreads();
  {
    const int n = tid >> 2, kc = (tid & 3) * 16;
    unsigned pk[8];
#pragma unroll
    for (int j = 0; j < 8; ++j) pk[j] = pack2(s[kc + 2 * j][n], s[kc + 2 * j + 1][n]);
    ushort_t* dst = Wt + (size_t)(nd0 + n) * DM + kt * 64 + kc;
    *(uint4*)(dst) = make_uint4(pk[0], pk[1], pk[2], pk[3]);
    *(uint4*)(dst + 8) = make_uint4(pk[4], pk[5], pk[6], pk[7]);
  }
}

__device__ __forceinline__ void ph_cvt(const int vb, const float* __restrict__ src, ushort_t* __restrict__ dst) {
  const size_t base = (size_t)vb * 8192 + threadIdx.x * 8;
  float4 a[4], b[4];
#pragma unroll
  for (int i = 0; i < 4; ++i) {
    a[i] = *(const float4*)(src + base + i * 2048);
    b[i] = *(const float4*)(src + base + i * 2048 + 4);
  }
#pragma unroll
  for (int i = 0; i < 4; ++i)
    *(uint4*)(dst + base + i * 2048) = make_uint4(pack2(a[i].x, a[i].y), pack2(a[i].z, a[i].w), pack2(b[i].x, b[i].y), pack2(b[i].z, b[i].w));
}


typedef __attribute__((ext_vector_type(2))) float f32x2_t;
__device__ __forceinline__ void ph_cvt8(const int vb, const float* __restrict__ src, unsigned char* __restrict__ dst, float* __restrict__ inv_scale) {
  const int lane = threadIdx.x & 63;
  const int row = vb * 4 + (threadIdx.x >> 6);
  const float* sr = src + (size_t)row * DM + lane * 16;
  float4 v[4];
#pragma unroll
  for (int i = 0; i < 4; ++i) v[i] = *(const float4*)(sr + i * 4);
  float am = 0.f;
#pragma unroll
  for (int i = 0; i < 4; ++i) am = fmaxf(fmaxf(fmaxf(am, fabsf(v[i].x)), fmaxf(fabsf(v[i].y), fabsf(v[i].z))), fabsf(v[i].w));
  am = wave_max(am);
  const float sc = (am > 0.f) ? 224.f / am : 1.f;
  unsigned w[4];
#pragma unroll
  for (int i = 0; i < 4; ++i) {
    int t = 0;
    t = __builtin_amdgcn_cvt_pk_fp8_f32(v[i].x * sc, v[i].y * sc, t, false);
    t = __builtin_amdgcn_cvt_pk_fp8_f32(v[i].z * sc, v[i].w * sc, t, true);
    w[i] = (unsigned)t;
  }
  *(uint4*)(dst + (size_t)row * DM + lane * 16) = make_uint4(w[0], w[1], w[2], w[3]);
  if (lane == 0) inv_scale[row] = (am > 0.f) ? am * (1.f / 224.f) : 1.f;
}

__device__ __forceinline__ int swz(int row, int ch) { return row * 128 + ((ch ^ ((row >> 1) & 7)) << 4); }

__device__ __forceinline__ void gemm_core(const ushort_t* __restrict__ A, const ushort_t* __restrict__ Bt, const int K, const int m0,
                                          const int n0, char* smem, f32x16 (&acc)[2][2]) {
  const int tid = threadIdx.x, lane = tid & 63, wave = tid >> 6;
  const int wm = wave >> 1, wn = wave & 1;
  const int r = lane & 31, h = lane >> 5;
  const int srow = tid >> 3, sch = tid & 7;
  const ushort_t* Ag = A + (size_t)(m0 + srow) * K + sch * 8;
  const ushort_t* Bg = Bt + (size_t)(n0 + srow) * K + sch * 8;
  uint4 ra[4], rb[4];
#pragma unroll
  for (int p = 0; p < 4; ++p) {
    ra[p] = *(const uint4*)(Ag + (size_t)p * 32 * K);
    rb[p] = *(const uint4*)(Bg + (size_t)p * 32 * K);
  }
#pragma unroll
  for (int i = 0; i < 2; ++i)
#pragma unroll
    for (int j = 0; j < 2; ++j)
#pragma unroll
      for (int e = 0; e < 16; ++e) acc[i][j][e] = 0.f;
#pragma unroll
  for (int p = 0; p < 4; ++p) {
    *(uint4*)(smem + swz(srow + p * 32, sch)) = ra[p];
    *(uint4*)(smem + 16384 + swz(srow + p * 32, sch)) = rb[p];
  }
  __syncthreads();
  const int nk = K >> 6;
  const int xr = (r >> 1) & 7;
  const int arow = (wm * 64 + r) * 128, brow = (wn * 64 + r) * 128;
  for (int kt = 0; kt < nk; ++kt) {
    const char* cA = smem + (kt & 1) * 32768;
    const char* cB = cA + 16384;
    if (kt + 1 < nk) {
#pragma unroll
      for (int p = 0; p < 4; ++p) {
        ra[p] = *(const uint4*)(Ag + (size_t)p * 32 * K + (kt + 1) * 64);
        rb[p] = *(const uint4*)(Bg + (size_t)p * 32 * K + (kt + 1) * 64);
      }
    }
#pragma unroll
    for (int ks = 0; ks < 4; ++ks) {
      const int co = ((ks * 2 + h) ^ xr) << 4;
      bf16x8 a0 = *(const bf16x8*)(cA + arow + co);
      bf16x8 a1 = *(const bf16x8*)(cA + arow + 32 * 128 + co);
      bf16x8 b0 = *(const bf16x8*)(cB + brow + co);
      bf16x8 b1 = *(const bf16x8*)(cB + brow + 32 * 128 + co);
      acc[0][0] = __builtin_amdgcn_mfma_f32_32x32x16_bf16(a0, b0, acc[0][0], 0, 0, 0);
      acc[0][1] = __builtin_amdgcn_mfma_f32_32x32x16_bf16(a0, b1, acc[0][1], 0, 0, 0);
      acc[1][0] = __builtin_amdgcn_mfma_f32_32x32x16_bf16(a1, b0, acc[1][0], 0, 0, 0);
      acc[1][1] = __builtin_amdgcn_mfma_f32_32x32x16_bf16(a1, b1, acc[1][1], 0, 0, 0);
    }
    if (kt + 1 < nk) {
      char* nA = smem + ((kt + 1) & 1) * 32768;
#pragma unroll
      for (int p = 0; p < 4; ++p) {
        *(uint4*)(nA + swz(srow + p * 32, sch)) = ra[p];
        *(uint4*)(nA + 16384 + swz(srow + p * 32, sch)) = rb[p];
      }
    }
    __syncthreads();
  }
}

enum { EP_SILU = 0, EP_PLAIN = 1, EP_HEADNORM = 2 };

__device__ __forceinline__ void epi_bf16(const f32x16 (&acc)[2][2], const int mode, ushort_t* __restrict__ dst, const int ld,
                                         const int row0, const int col0, const float* __restrict__ nw) {
  const int lane = threadIdx.x & 63, r = lane & 31, h = lane >> 5;
  float w0 = 1.f, w1 = 1.f;
  if (mode == EP_HEADNORM) { w0 = nw[r]; w1 = nw[32 + r]; }
#pragma unroll
  for (int mi = 0; mi < 2; ++mi) {
#pragma unroll
    for (int e = 0; e < 16; ++e) {
      const int row = row0 + mi * 32 + (e & 3) + 8 * (e >> 2) + 4 * h;
      float v0 = acc[mi][0][e], v1 = acc[mi][1][e];
      if (mode == EP_SILU) { v0 = silu_f(v0); v1 = silu_f(v1); }
      if (mode == EP_HEADNORM) {
        float ss = v0 * v0 + v1 * v1;
        ss += __shfl_xor(ss, 1); ss += __shfl_xor(ss, 2); ss += __shfl_xor(ss, 4); ss += __shfl_xor(ss, 8); ss += __shfl_xor(ss, 16);
        const float rs = rsqrtf(ss * (1.f / 64.f) + EPS);
        v0 = v0 * rs * w0; v1 = v1 * rs * w1;
      }
      dst[(size_t)row * ld + col0 + r] = f2bf(v0);
      dst[(size_t)row * ld + col0 + 32 + r] = f2bf(v1);
    }
  }
}

__device__ __forceinline__ void epi_f32(const f32x16 (&acc)[2][2], float* __restrict__ dst, const int ld, const int row0, const int col0,
                                        const float* __restrict__ resid) {
  const int lane = threadIdx.x & 63, r = lane & 31, h = lane >> 5;
#pragma unroll
  for (int mi = 0; mi < 2; ++mi) {
#pragma unroll
    for (int e = 0; e < 16; ++e) {
      const int row = row0 + mi * 32 + (e & 3) + 8 * (e >> 2) + 4 * h;
#pragma unroll
      for (int ni = 0; ni < 2; ++ni) {
        const size_t idx = (size_t)row * ld + col0 + ni * 32 + r;
        float v = acc[mi][ni][e];
        if (resid) v += resid[idx];
        dst[idx] = v;
      }
    }
  }
}


__device__ __forceinline__ void epi_bf16_T(const f32x16 (&acc)[2][2], ushort_t* __restrict__ dstT, const size_t ldT, const int rowpos0) {
  const int lane = threadIdx.x & 63, r = lane & 31, h = lane >> 5;
#pragma unroll
  for (int ni = 0; ni < 2; ++ni) {
    ushort_t* base = dstT + (size_t)(ni * 32 + r) * ldT + rowpos0;
#pragma unroll
    for (int mi = 0; mi < 2; ++mi) {
#pragma unroll
      for (int q4 = 0; q4 < 4; ++q4) {
        const int rp = mi * 32 + 8 * q4 + 4 * h;
        *(uint2*)(base + rp) = make_uint2(pack2(acc[mi][ni][4 * q4 + 0], acc[mi][ni][4 * q4 + 1]),
                                          pack2(acc[mi][ni][4 * q4 + 2], acc[mi][ni][4 * q4 + 3]));
      }
    }
  }
}

__device__ __forceinline__ void epi_bf16_k(const f32x16 (&acc)[2][2], ushort_t* __restrict__ dst, const int ld, const int row0, const int col0,
                                           const float* __restrict__ nw, float* __restrict__ kp  ) {
  const int lane = threadIdx.x & 63, r = lane & 31, h = lane >> 5;
  const float w0 = nw[r], w1 = nw[32 + r];
  float cs0 = 0.f, cs1 = 0.f;
#pragma unroll
  for (int mi = 0; mi < 2; ++mi) {
#pragma unroll
    for (int e = 0; e < 16; ++e) {
      const int row = row0 + mi * 32 + (e & 3) + 8 * (e >> 2) + 4 * h;
      float v0 = acc[mi][0][e], v1 = acc[mi][1][e];
      float ss = v0 * v0 + v1 * v1;
      ss += __shfl_xor(ss, 1); ss += __shfl_xor(ss, 2); ss += __shfl_xor(ss, 4); ss += __shfl_xor(ss, 8); ss += __shfl_xor(ss, 16);
      const float rs = rsqrtf(ss * (1.f / 64.f) + EPS);
      v0 = v0 * rs * w0; v1 = v1 * rs * w1;
      cs0 += v0; cs1 += v1;
      dst[(size_t)row * ld + col0 + r] = f2bf(v0);
      dst[(size_t)row * ld + col0 + 32 + r] = f2bf(v1);
    }
  }
  cs0 += __shfl_xor(cs0, 32);
  cs1 += __shfl_xor(cs1, 32);
  if (h == 0) { kp[r] = cs0; kp[32 + r] = cs1; }
}

__device__ __forceinline__ void ph_gemm_proj(const int vb, char* smem, const Params& p) {
  const int nt = vb % 20, mt = vb / 20;
  const int m0 = mt * 128, n0 = nt * 128;
  f32x16 acc[2][2];
  gemm_core(p.xn_b, p.w_inT, DM, m0, n0, smem, acc);
  const int wave = threadIdx.x >> 6, wm = wave >> 1, wn = wave & 1;
  const int row0 = m0 + wm * 64;
  const int c = n0 + wn * 64;
  if (c < 512) epi_bf16(acc, EP_SILU, p.zs, 512, row0, c, nullptr);
  else if (c < 1536) epi_bf16(acc, EP_PLAIN, p.xbc_raw, 1024, row0, c - 512, nullptr);
  else if (c < 1792) epi_bf16(acc, EP_HEADNORM, p.mq, 256, row0, c - 1536, p.mq_norm_w);
  else if (c < 2048) {
    const int hh = (c - 1792) >> 6, bb = row0 >> 13, lpos = row0 & (SL - 1);
    epi_bf16_k(acc, p.mk, 256, row0, c - 1792, p.mk_norm_w, p.kpart + ((size_t)((bb * 4 + hh) * 32 + (lpos >> 8)) * 4 + ((lpos >> 6) & 3)) * 64);
  } else if (c < 2304) {
    const int hh = (c - 2048) >> 6, bb = row0 >> 13, lpos = row0 & (SL - 1);
    epi_bf16_T(acc, p.vT + (size_t)(bb * 4 + hh) * 64 * SL, SL, lpos);
  }
  else epi_bf16(acc, EP_HEADNORM, p.xq, 256, row0, c - 2304, p.xq_norm_w);
}

__device__ __forceinline__ void ph_gemm_mem(const int vb, char* smem, const Params& p) {
  const int nt = vb % 4, mt = vb / 4;
  const int m0 = mt * 128, n0 = nt * 128;
  f32x16 acc[2][2];
  gemm_core(p.memn_b, p.w_memT, DM, m0, n0, smem, acc);
  const int wave = threadIdx.x >> 6, wm = wave >> 1, wn = wave & 1;
  const int row0 = m0 + wm * 64;
  const int c = n0 + wn * 64;
  if (c < 256) epi_bf16(acc, EP_HEADNORM, p.memk_b, 256, row0, c, p.xk_norm_w);
  else {
    const int hh = (c - 256) >> 6, bb = row0 >> 8, mpos = row0 & 255;
    epi_bf16_T(acc, p.memvT + (size_t)(bb * 4 + hh) * 64 * MEM, MEM, mpos);
  }
}

__device__ __forceinline__ void ph_gemm_f32(const int vb, char* smem, const ushort_t* A, const ushort_t* Bt, float* dst, const float* resid) {
  const int nt = vb % 8, mt = vb / 8;
  const int m0 = mt * 128, n0 = nt * 128;
  f32x16 acc[2][2];
  gemm_core(A, Bt, DM, m0, n0, smem, acc);
  const int wave = threadIdx.x >> 6, wm = wave >> 1, wn = wave & 1;
  epi_f32(acc, dst, DM, m0 + wm * 64, n0 + wn * 64, resid);
}

__device__ __forceinline__ int swz256(int row, int ch) { return row * 272 + (ch << 4); }
__device__ __forceinline__ int crow16(int e, int hl) { return (e & 3) + 8 * (e >> 2) + 4 * hl; }

__device__ __forceinline__ void ph_ssd1(const int vb, char* smem, const Params& p) {
  const int h = vb & 7, c = (vb >> 3) & 63, b = vb >> 9;
  const int g = h >> 2, hq = h & 3;
  int tid = threadIdx.x;
  asm volatile("" : "+v"(tid));
  const int lane = tid & 63, wave = tid >> 6;
  const int t0 = b * SL + c * 128;
  char* s_xw = smem;
  char* s_bt = smem + 17408;
  float* s_acs = (float*)(smem + 52224);
  float* s_w = s_acs + 128;
  float* s_red = s_w + 128;
  const float a_coef = -expf(p.a_log[h]);
  float dtv = 0.f, cs = 0.f;
  if (tid < 128) {
    dtv = p.dt[(size_t)(t0 + tid) * 8 + h];
    cs = dtv * a_coef;
#pragma unroll
    for (int o = 1; o < 64; o <<= 1) {
      float nb = __shfl_up(cs, o);
      if (lane >= o) cs += nb;
    }
    if (lane == 63) s_red[wave] = cs;
  }
  __syncthreads();
  if (tid < 128) {
    if (wave == 1) cs += s_red[0];
    s_acs[tid] = cs;
    p.acs[(size_t)(t0 + tid) * 8 + h] = cs;
  }
  __syncthreads();
  if (tid < 128) {
    const float tot = s_acs[127];
    s_w[tid] = dtv * expf(tot - cs);
    if (tid == 0) p.cdec[(b * 64 + c) * 8 + h] = expf(tot);
  }
  __syncthreads();
  if (tid < 224) {
    const int seg = tid / 28, cg = tid - seg * 28;
    const bool is_x = cg < 8, is_b = (cg >= 8) && (cg < 24);
    int ch0, trow;
    if (is_x) { ch0 = h * 64 + cg * 8; trow = cg * 8; }
    else if (is_b) { ch0 = 512 + g * 128 + (cg - 8) * 8; trow = (cg - 8) * 8; }
    else { ch0 = 768 + g * 128 + hq * 32 + (cg - 24) * 8; trow = 0; }
    const bool wr_nat = is_x || !is_b || (hq == 0);
    char* tbase = is_x ? s_xw : s_bt;
    const int l0 = seg * 16;
    float w0[8], w1[8], w2[8], w3[8], bias[8];
    {
      const float* cw = p.conv_w + ch0;
      float4 a, bq;
      a = *(const float4*)(cw); bq = *(const float4*)(cw + 4);
      w0[0] = a.x; w0[1] = a.y; w0[2] = a.z; w0[3] = a.w; w0[4] = bq.x; w0[5] = bq.y; w0[6] = bq.z; w0[7] = bq.w;
      a = *(const float4*)(cw + 1024); bq = *(const float4*)(cw + 1028);
      w1[0] = a.x; w1[1] = a.y; w1[2] = a.z; w1[3] = a.w; w1[4] = bq.x; w1[5] = bq.y; w1[6] = bq.z; w1[7] = bq.w;
      a = *(const float4*)(cw + 2048); bq = *(const float4*)(cw + 2052);
      w2[0] = a.x; w2[1] = a.y; w2[2] = a.z; w2[3] = a.w; w2[4] = bq.x; w2[5] = bq.y; w2[6] = bq.z; w2[7] = bq.w;
      a = *(const float4*)(cw + 3072); bq = *(const float4*)(cw + 3076);
      w3[0] = a.x; w3[1] = a.y; w3[2] = a.z; w3[3] = a.w; w3[4] = bq.x; w3[5] = bq.y; w3[6] = bq.z; w3[7] = bq.w;
      a = *(const float4*)(p.conv_b + ch0); bq = *(const float4*)(p.conv_b + ch0 + 4);
      bias[0] = a.x; bias[1] = a.y; bias[2] = a.z; bias[3] = a.w; bias[4] = bq.x; bias[5] = bq.y; bias[6] = bq.z; bias[7] = bq.w;
    }
    float r0[8], r1[8], r2[8];
    {
      const int lg = c * 128 + l0;
      const ushort_t* src = p.xbc_raw + (size_t)(t0 + l0) * 1024 + ch0;
      uint4 z4 = make_uint4(0u, 0u, 0u, 0u);
      uint4 u0 = (lg >= 3) ? *(const uint4*)(src - 3 * 1024) : z4;
      uint4 u1 = (lg >= 2) ? *(const uint4*)(src - 2 * 1024) : z4;
      uint4 u2 = (lg >= 1) ? *(const uint4*)(src - 1 * 1024) : z4;
      unpack8(u0, r0); unpack8(u1, r1); unpack8(u2, r2);
    }
    unsigned outp[8][8];
    float lo[8], los[8];
#pragma unroll
    for (int i = 0; i < 16; ++i) {
      float cur[8], val[8];
      unpack8(*(const uint4*)(p.xbc_raw + (size_t)(t0 + l0 + i) * 1024 + ch0), cur);
#pragma unroll
      for (int j = 0; j < 8; ++j) {
        float v = bias[j];
        v = fmaf(w0[j], r0[j], v); v = fmaf(w1[j], r1[j], v); v = fmaf(w2[j], r2[j], v); v = fmaf(w3[j], cur[j], v);
        val[j] = silu_f(v);
        r0[j] = r1[j]; r1[j] = r2[j]; r2[j] = cur[j];
      }
      if (wr_nat) {
        *(uint4*)(p.xc + (size_t)(t0 + l0 + i) * 1024 + ch0) =
            make_uint4(pack2(val[0], val[1]), pack2(val[2], val[3]), pack2(val[4], val[5]), pack2(val[6], val[7]));
      }
      const float scl = is_x ? s_w[l0 + i] : 1.f;
      if ((i & 1) == 0) {
#pragma unroll
        for (int j = 0; j < 8; ++j) { lo[j] = val[j]; los[j] = val[j] * scl; }
      } else {
        const int chunk = seg * 2 + (i >> 3);
#pragma unroll
        for (int j = 0; j < 8; ++j) {
          outp[j][i >> 1] = pack2(lo[j], val[j]);
          if (is_x || is_b) *(unsigned*)(tbase + swz256(trow + j, chunk) + ((i & 7) - 1) * 2) = pack2(los[j], val[j] * scl);
        }
      }
    }
    if (is_x) {
      ushort_t* dst = p.xT + ((size_t)((b * 64 + c) * 8 + h) * 64 + cg * 8) * 128 + l0;
#pragma unroll
      for (int j = 0; j < 8; ++j) {
        *(uint4*)(dst + (size_t)j * 128) = make_uint4(outp[j][0], outp[j][1], outp[j][2], outp[j][3]);
        *(uint4*)(dst + (size_t)j * 128 + 8) = make_uint4(outp[j][4], outp[j][5], outp[j][6], outp[j][7]);
      }
    }
  }
  __syncthreads();
  {
    const int r = lane & 31, hl = lane >> 5;
    f32x16 acc[2];
#pragma unroll
    for (int e = 0; e < 16; ++e) { acc[0][e] = 0.f; acc[1][e] = 0.f; }
#pragma unroll
    for (int ks = 0; ks < 8; ++ks) {
      const bf16x8 bfr = *(const bf16x8*)(s_bt + swz256(32 * wave + r, ks * 2 + hl));
      const bf16x8 a0 = *(const bf16x8*)(s_xw + swz256(r, ks * 2 + hl));
      const bf16x8 a1 = *(const bf16x8*)(s_xw + swz256(32 + r, ks * 2 + hl));
      acc[0] = __builtin_amdgcn_mfma_f32_32x32x16_bf16(a0, bfr, acc[0], 0, 0, 0);
      acc[1] = __builtin_amdgcn_mfma_f32_32x32x16_bf16(a1, bfr, acc[1], 0, 0, 0);
    }
    float* dst = p.states + (size_t)((b * 64 + c) * 8 + h) * 64 * 128;
#pragma unroll
    for (int pt = 0; pt < 2; ++pt)
#pragma unroll
      for (int e = 0; e < 16; ++e) dst[(size_t)(pt * 32 + crow16(e, hl)) * 128 + 32 * wave + r] = acc[pt][e];
  }
}

__device__ __forceinline__ void ph_ssd2(const int vb, const Params& p) {
  const int idx = vb * 256 + threadIdx.x;
  const int pn = idx & 8191, h = (idx >> 13) & 7, b = idx >> 16;
  float st = 0.f;
#pragma unroll 1
  for (int c0 = 0; c0 < 64; c0 += 8) {
    float sv[8], dv[8];
#pragma unroll
    for (int i = 0; i < 8; ++i) {
      const int cc = (b * 64 + c0 + i) * 8 + h;
      sv[i] = p.states[(size_t)cc * 8192 + pn];
      dv[i] = p.cdec[cc];
    }
#pragma unroll
    for (int i = 0; i < 8; ++i) {
      const int cc = (b * 64 + c0 + i) * 8 + h;
      p.sin_b[(size_t)cc * 8192 + pn] = f2bf(st);
      st = fmaf(st, dv[i], sv[i]);
    }
  }
}

__device__ __forceinline__ void ph_ssd3(const int vb, char* smem, const Params& p) {
  const int g = vb & 1, c = (vb >> 1) & 63, b = vb >> 7;
  int tid = threadIdx.x;
  asm volatile("" : "+v"(tid));
  const int lane = tid & 63;
  const int w = __builtin_amdgcn_readfirstlane(tid >> 6);
  const int r = lane & 31, hl = lane >> 5;
  const int t0 = b * SL + c * 128;
  char* s_C = smem;
  char* s_B = smem + 34816;
  char* s_xT = smem + 34816;
  char* s_S = smem + 34816 + 16896;
  float* s_acs = (float*)(smem + 69632);
  float* s_dt = s_acs + 512;
  {
    const int ch = tid & 15, r0 = tid >> 4;
#pragma unroll
    for (int i = 0; i < 8; ++i) {
      const int row = r0 + 16 * i;
      const ushort_t* src = p.xc + (size_t)(t0 + row) * 1024 + g * 128 + ch * 8;
      *(uint4*)(s_B + swz256(row, ch)) = *(const uint4*)(src + 512);
      *(uint4*)(s_C + swz256(row, ch)) = *(const uint4*)(src + 768);
    }
    if (tid < 128) {
#pragma unroll
      for (int hh = 0; hh < 4; ++hh) {
        s_acs[hh * 128 + tid] = p.acs[(size_t)(t0 + tid) * 8 + g * 4 + hh];
        s_dt[hh * 128 + tid] = p.dt[(size_t)(t0 + tid) * 8 + g * 4 + hh];
      }
    }
  }
  __syncthreads();
  bf16x8 cfr[8];
#pragma unroll
  for (int ks = 0; ks < 8; ++ks) cfr[ks] = *(const bf16x8*)(s_C + swz256(32 * w + r, ks * 2 + hl));
  f32x16 gt[4];
#pragma unroll
  for (int st = 0; st < 4; ++st) {
#pragma unroll
    for (int e = 0; e < 16; ++e) gt[st][e] = 0.f;
    if (st <= w) {
#pragma unroll
      for (int ks = 0; ks < 8; ++ks) {
        const bf16x8 a = *(const bf16x8*)(s_B + swz256(32 * st + r, ks * 2 + hl));
        gt[st] = __builtin_amdgcn_mfma_f32_32x32x16_bf16(a, cfr[ks], gt[st], 0, 0, 0);
      }
    }
  }
  __syncthreads();
  float ssq = 0.f;
  const int lane_c = lane;
#pragma unroll 1
  for (int hh = 0; hh < 4; ++hh) {
    int lane_o = lane_c;
    asm volatile("" : "+v"(lane_o));
    const int r = lane_o & 31, hl = lane_o >> 5;
    const int l = 32 * w + r;
    const int hg = g * 4 + hh;
    {
      const int ch = tid & 15, r0 = tid >> 4;
      const size_t base = (size_t)((b * 64 + c) * 8 + hg) * 8192;
#pragma unroll
      for (int i = 0; i < 4; ++i) {
        const int row = r0 + 16 * i;
        const uint4 xv = *(const uint4*)(p.xT + base + (size_t)row * 128 + ch * 8);
        *(uint2*)(s_xT + row * 264 + ch * 16) = make_uint2(xv.x, xv.y);
        *(uint2*)(s_xT + row * 264 + ch * 16 + 8) = make_uint2(xv.z, xv.w);
        *(uint4*)(s_S + swz256(row, ch)) = *(const uint4*)(p.sin_b + base + (size_t)row * 128 + ch * 8);
      }
    }
    __syncthreads();
    const float acs_l = s_acs[hh * 128 + l];
    const float dsk = p.ssd_d[hg];
    f32x16 acc[2];
#pragma unroll
    for (int e = 0; e < 16; ++e) { acc[0][e] = 0.f; acc[1][e] = 0.f; }
#pragma unroll
    for (int ks = 0; ks < 8; ++ks) {
      const bf16x8 a0 = *(const bf16x8*)(s_S + swz256(r, ks * 2 + hl));
      const bf16x8 a1 = *(const bf16x8*)(s_S + swz256(32 + r, ks * 2 + hl));
      acc[0] = __builtin_amdgcn_mfma_f32_32x32x16_bf16(a0, cfr[ks], acc[0], 0, 0, 0);
      acc[1] = __builtin_amdgcn_mfma_f32_32x32x16_bf16(a1, cfr[ks], acc[1], 0, 0, 0);
    }
    {
      const float el = expf(acs_l);
#pragma unroll
      for (int e = 0; e < 16; ++e) { acc[0][e] *= el; acc[1][e] *= el; }
    }
#pragma unroll
    for (int st = 0; st < 4; ++st) {
      asm volatile("" ::: "memory");
      if (st <= w) {
        float m[16];
#pragma unroll
        for (int e = 0; e < 16; ++e) {
          const int sidx = 32 * st + crow16(e, hl);
          float v = gt[st][e] * __expf(acs_l - s_acs[hh * 128 + sidx]) * s_dt[hh * 128 + sidx];
          if (sidx > l) v = 0.f;
          if (sidx == l) v += dsk;
          m[e] = v;
        }
#pragma unroll
        for (int k2 = 0; k2 < 2; ++k2) {
          asm volatile("" ::: "memory");
          bf16x8 mf;
          {
            unsigned u0 = pack2(m[8 * k2 + 0], m[8 * k2 + 1]), u1 = pack2(m[8 * k2 + 2], m[8 * k2 + 3]);
            unsigned u2 = pack2(m[8 * k2 + 4], m[8 * k2 + 5]), u3 = pack2(m[8 * k2 + 6], m[8 * k2 + 7]);
            uint4 uu = make_uint4(u0, u1, u2, u3);
            mf = *(bf16x8*)&uu;
          }
          const int soff = (32 * st + 16 * k2 + 4 * hl) * 2;
#pragma unroll
          for (int pt = 0; pt < 2; ++pt) {
            const char* ap = s_xT + (pt * 32 + r) * 264 + soff;
            uint2 q0 = *(const uint2*)(ap);
            uint2 q1 = *(const uint2*)(ap + 16);
            uint4 qq = make_uint4(q0.x, q0.y, q1.x, q1.y);
            const bf16x8 af = *(bf16x8*)&qq;
            acc[pt] = __builtin_amdgcn_mfma_f32_32x32x16_bf16(af, mf, acc[pt], 0, 0, 0);
          }
        }
      }
    }
#pragma unroll
    for (int pt = 0; pt < 2; ++pt) {
#pragma unroll
      for (int q4 = 0; q4 < 4; ++q4) {
        asm volatile("" ::: "memory");
        const int p0 = pt * 32 + 8 * q4 + 4 * hl;
        const uint2 zz = *(const uint2*)(p.zs + (size_t)(t0 + l) * 512 + hg * 64 + p0);
        const float v0 = acc[pt][4 * q4 + 0] * bflo(zz.x), v1 = acc[pt][4 * q4 + 1] * bfhi(zz.x);
        const float v2 = acc[pt][4 * q4 + 2] * bflo(zz.y), v3 = acc[pt][4 * q4 + 3] * bfhi(zz.y);
        ssq += v0 * v0 + v1 * v1 + v2 * v2 + v3 * v3;
        *(uint2*)(p.mixed_b + (size_t)(t0 + l) * 1024 + hg * 64 + p0) = make_uint2(pack2(v0, v1), pack2(v2, v3));
      }
    }
    __syncthreads();
  }
  const int l = 32 * w + r;
  ssq += __shfl_xor(ssq, 32);
  const float rstd = rsqrtf(ssq * (1.f / 256.f) + EPS);
#pragma unroll 1
  for (int hh = 0; hh < 4; ++hh) {
#pragma unroll
    for (int pt = 0; pt < 2; ++pt) {
#pragma unroll
      for (int q4 = 0; q4 < 4; ++q4) {
        asm volatile("" ::: "memory");
        const int chn = (g * 4 + hh) * 64 + pt * 32 + 8 * q4 + 4 * hl;
        ushort_t* ptr = p.mixed_b + (size_t)(t0 + l) * 1024 + chn;
        const uint2 vv = *(const uint2*)ptr;
        const float4 nw = *(const float4*)(p.ssd_norm_w + chn);
        *(uint2*)ptr = make_uint2(pack2(bflo(vv.x) * rstd * nw.x, bfhi(vv.x) * rstd * nw.y),
                                  pack2(bflo(vv.y) * rstd * nw.z, bfhi(vv.y) * rstd * nw.w));
      }
    }
  }
}

__device__ __forceinline__ void k_gate(const int VB, const Params& p) {
  const int i = VB * 256 + threadIdx.x;
  const int h = i & 3, t = i >> 2;
  const int b = t / SL, l = t % SL;
  const int own = l >> 8;
  float q[64];
  {
    const ushort_t* src = p.mq + (size_t)t * 256 + h * 64;
#pragma unroll
    for (int d = 0; d < 64; d += 8) {
      uint4 v = *(const uint4*)(src + d);
      q[d] = bflo(v.x); q[d + 1] = bfhi(v.x); q[d + 2] = bflo(v.y); q[d + 3] = bfhi(v.y);
      q[d + 4] = bflo(v.z); q[d + 5] = bfhi(v.z); q[d + 6] = bflo(v.w); q[d + 7] = bfhi(v.w);
    }
  }
  float v0 = -INFINITY, v1 = -INFINITY, v2 = -INFINITY;
  int i0 = 0, i1 = 1, i2 = 2;
  for (int n = 0; n < own; ++n) {
    const float* kp = p.kpart + (size_t)((b * 4 + h) * 32 + n) * 256;
    float s = 0.f;
#pragma unroll
    for (int d = 0; d < 64; d += 4) {
      const float4 a = *(const float4*)(kp + d), bq = *(const float4*)(kp + 64 + d);
      const float4 cq = *(const float4*)(kp + 128 + d), dq = *(const float4*)(kp + 192 + d);
      s = fmaf(q[d], (a.x + bq.x) + (cq.x + dq.x), s); s = fmaf(q[d + 1], (a.y + bq.y) + (cq.y + dq.y), s);
      s = fmaf(q[d + 2], (a.z + bq.z) + (cq.z + dq.z), s); s = fmaf(q[d + 3], (a.w + bq.w) + (cq.w + dq.w), s);
    }
    if (s > v0) { v2 = v1; i2 = i1; v1 = v0; i1 = i0; v0 = s; i0 = n; }
    else if (s > v1) { v2 = v1; i2 = i1; v1 = s; i1 = n; }
    else if (s > v2) { v2 = s; i2 = n; }
  }
  const int nsel = own < 3 ? own : 3;
  const int js[3] = {i0, i1, i2};
#pragma unroll
  for (int sl = 0; sl < 3; ++sl) {
    if (sl < nsel) {
      const int bucket = (b * 4 + h) * 32 + js[sl];
      const int pos = atomicAdd(p.bcnt + bucket, 1);
      p.blist[(size_t)bucket * 8192 + pos] = l | (sl << 13);
    }
  }
}

__device__ __forceinline__ void attn_unit(char* smem, const ushort_t* __restrict__ Kp, const int kstride, const ushort_t* __restrict__ VTp,
                                          const size_t vstride, const ushort_t* __restrict__ qrow, const float slope, const int qrel,
                                          const bool causal, const int nst, f32x16 (&o)[2], float& m_out, float& l_out) {
  int tid = threadIdx.x;
  asm volatile("" : "+v"(tid));
  const int lane = tid & 63, r = lane & 31, hl = lane >> 5;
  char* s_K = smem;
  char* s_VT = smem + 18432;
  bf16x8 qf[4];
#pragma unroll
  for (int ks = 0; ks < 4; ++ks) qf[ks] = *(const bf16x8*)(qrow + ks * 16 + hl * 8);
#pragma unroll
  for (int e = 0; e < 16; ++e) { o[0][e] = 0.f; o[1][e] = 0.f; }
  float m = -1e30f, lsum = 0.f;
#pragma unroll 1
  for (int st = 0; st < nst; ++st) {
    {
      const int kr = tid >> 3, kc = tid & 7;
#pragma unroll
      for (int i = 0; i < 4; ++i) {
        const int row = kr + 32 * i;
        *(uint4*)(s_K + row * 144 + kc * 16) = *(const uint4*)(Kp + (size_t)(st * 128 + row) * kstride + kc * 8);
      }
      const int vr = tid >> 4, vc = tid & 15;
#pragma unroll
      for (int i = 0; i < 4; ++i) {
        const int row = vr + 16 * i;
        const uint4 vv = *(const uint4*)(VTp + (size_t)row * vstride + st * 128 + vc * 8);
        *(uint2*)(s_VT + row * 264 + vc * 16) = make_uint2(vv.x, vv.y);
        *(uint2*)(s_VT + row * 264 + vc * 16 + 8) = make_uint2(vv.z, vv.w);
      }
    }
    __syncthreads();
    f32x16 sc[4];
#pragma unroll
    for (int kt = 0; kt < 4; ++kt) {
#pragma unroll
      for (int e = 0; e < 16; ++e) sc[kt][e] = 0.f;
#pragma unroll
      for (int ks = 0; ks < 4; ++ks) {
        const bf16x8 a = *(const bf16x8*)(s_K + (32 * kt + r) * 144 + (2 * ks + hl) * 16);
        sc[kt] = __builtin_amdgcn_mfma_f32_32x32x16_bf16(a, qf[ks], sc[kt], 0, 0, 0);
      }
    }
    float mx = -1e30f;
    const int qk0 = qrel - st * 128 - 4 * hl;
#pragma unroll
    for (int kt = 0; kt < 4; ++kt) {
#pragma unroll
      for (int e = 0; e < 16; ++e) {
        const int dist = qk0 - (32 * kt + (e & 3) + 8 * (e >> 2));
        float v = fmaf(sc[kt][e], 0.125f, -slope * (float)dist);
        if (causal && dist < 0) v = -1e30f;
        sc[kt][e] = v;
        mx = fmaxf(mx, v);
      }
    }
    mx = fmaxf(mx, __shfl_xor(mx, 32));
    const float mnew = fmaxf(m, mx);
    const float alpha = __expf(m - mnew);
    m = mnew;
    lsum *= alpha;
#pragma unroll
    for (int e = 0; e < 16; ++e) { o[0][e] *= alpha; o[1][e] *= alpha; }
#pragma unroll
    for (int kt = 0; kt < 4; ++kt) {
#pragma unroll
      for (int e = 0; e < 16; ++e) {
        const float pe = __expf(sc[kt][e] - mnew);
        sc[kt][e] = pe;
        lsum += pe;
      }
    }
#pragma unroll
    for (int kt = 0; kt < 4; ++kt) {
#pragma unroll
      for (int k2 = 0; k2 < 2; ++k2) {
        uint4 pu = make_uint4(pack2(sc[kt][8 * k2 + 0], sc[kt][8 * k2 + 1]), pack2(sc[kt][8 * k2 + 2], sc[kt][8 * k2 + 3]),
                              pack2(sc[kt][8 * k2 + 4], sc[kt][8 * k2 + 5]), pack2(sc[kt][8 * k2 + 6], sc[kt][8 * k2 + 7]));
        const bf16x8 pf = *(bf16x8*)&pu;
        const int koff = (32 * kt + 16 * k2 + 4 * hl) * 2;
#pragma unroll
        for (int dt = 0; dt < 2; ++dt) {
          const char* ap = s_VT + (dt * 32 + r) * 264 + koff;
          const uint2 q0 = *(const uint2*)(ap);
          const uint2 q1 = *(const uint2*)(ap + 16);
          uint4 qq = make_uint4(q0.x, q0.y, q1.x, q1.y);
          const bf16x8 af = *(bf16x8*)&qq;
          o[dt] = __builtin_amdgcn_mfma_f32_32x32x16_bf16(af, pf, o[dt], 0, 0, 0);
        }
      }
    }
    __syncthreads();
  }
  m_out = m;
  l_out = lsum + __shfl_xor(lsum, 32);
}

__device__ __forceinline__ void ph_attn_unit(const int kind, const int a0, const int a1, char* smem, const Params& p) {
  const int tid = threadIdx.x, lane = tid & 63, wave = tid >> 6, r = lane & 31, hl = lane >> 5;
  f32x16 o[2];
  float m, lt;
  if (kind == 2) {
    const int bh = a0, b = bh >> 2, h = bh & 3;
    const int t = b * SL + a1 * 128 + wave * 32 + r;
    attn_unit(smem, p.memk_b + (size_t)b * MEM * 256 + h * 64, 256, p.memvT + (size_t)bh * 64 * MEM, MEM, p.xq + (size_t)t * 256 + h * 64, 0.f,
              1 << 20, false, 2, o, m, lt);
    const float inv = 1.f / lt;
#pragma unroll
    for (int dt = 0; dt < 2; ++dt)
#pragma unroll
      for (int q4 = 0; q4 < 4; ++q4) {
        const int d = dt * 32 + 8 * q4 + 4 * hl;
        *(uint2*)(p.mixed_b + (size_t)t * DM + 768 + h * 64 + d) =
            make_uint2(pack2(o[dt][4 * q4] * inv, o[dt][4 * q4 + 1] * inv), pack2(o[dt][4 * q4 + 2] * inv, o[dt][4 * q4 + 3] * inv));
      }
    return;
  }
  int bh, l, slot, jblk, nst = 2;
  bool valid = true, causal = false;
  if (kind == 0) {
    bh = a0 >> 5; jblk = a0 & 31;
    const int cnt = p.bcnt[a0];
    int qi = a1 * 128 + wave * 32 + r;
    if (qi >= cnt) { valid = false; qi = 0; }
    const int ent = p.blist[(size_t)a0 * 8192 + qi];
    l = ent & 8191; slot = ent >> 13;
  } else {
    bh = a0 >> 5; jblk = a0 & 31;
    l = jblk * 256 + a1 * 128 + wave * 32 + r; slot = 3; causal = true;
    nst = a1 + 1;
  }
  const int b = bh >> 2, h = bh & 3;
  const int t = b * SL + l;
  const float slope = exp2f(-2.f * (float)(h + 1));
  attn_unit(smem, p.mk + (size_t)(b * SL + jblk * 256) * 256 + h * 64, 256, p.vT + (size_t)bh * 64 * SL + jblk * 256, SL,
            p.mq + (size_t)t * 256 + h * 64, slope, l - jblk * 256, causal, nst, o, m, lt);
  if (valid) {
    const float inv = 1.f / lt;
    const size_t pi = ((size_t)t * 4 + h) * 4 + slot;
#pragma unroll
    for (int dt = 0; dt < 2; ++dt)
#pragma unroll
      for (int q4 = 0; q4 < 4; ++q4) {
        const int d = dt * 32 + 8 * q4 + 4 * hl;
        *(uint2*)(p.pO + pi * 64 + d) =
            make_uint2(pack2(o[dt][4 * q4] * inv, o[dt][4 * q4 + 1] * inv), pack2(o[dt][4 * q4 + 2] * inv, o[dt][4 * q4 + 3] * inv));
      }
    if (hl == 0) { p.pm[pi] = m; p.pl[pi] = lt; }
  }
}

__device__ __forceinline__ void ph_attn_combine(const int VB, const Params& p) {
  const int i = VB * 256 + threadIdx.x;
  const int dq = i & 7, th = i >> 3;
  const int t = th >> 2;
  const int own = (t & (SL - 1)) >> 8;
  const int nsel = own < 3 ? own : 3;
  float mv[4], wv[4];
  float M = p.pm[(size_t)th * 4 + 3];
  mv[3] = M;
#pragma unroll
  for (int sl = 0; sl < 3; ++sl) {
    mv[sl] = (sl < nsel) ? p.pm[(size_t)th * 4 + sl] : -1e30f;
    M = fmaxf(M, mv[sl]);
  }
  float W = 0.f;
#pragma unroll
  for (int sl = 0; sl < 4; ++sl) {
    const bool on = (sl == 3) || (sl < nsel);
    wv[sl] = on ? p.pl[(size_t)th * 4 + sl] * __expf(mv[sl] - M) : 0.f;
    W += wv[sl];
  }
  float acc[8];
#pragma unroll
  for (int k = 0; k < 8; ++k) acc[k] = 0.f;
#pragma unroll
  for (int sl = 0; sl < 4; ++sl) {
    const bool on = (sl == 3) || (sl < nsel);
    if (on) {
      float f[8];
      unpack8(*(const uint4*)(p.pO + ((size_t)th * 4 + sl) * 64 + dq * 8), f);
#pragma unroll
      for (int k = 0; k < 8; ++k) acc[k] = fmaf(wv[sl], f[k], acc[k]);
    }
  }
  const float inv = 1.f / W;
  const int h = th & 3;
  *(uint4*)(p.mixed_b + (size_t)t * DM + 512 + h * 64 + dq * 8) =
      make_uint4(pack2(acc[0] * inv, acc[1] * inv), pack2(acc[2] * inv, acc[3] * inv), pack2(acc[4] * inv, acc[5] * inv), pack2(acc[6] * inv, acc[7] * inv));
}


__device__ __forceinline__ int mkkey(const float f, const int idx, const int mask) {
  int b = __float_as_int(f);
  b = (b & ~mask) | idx;
  return b ^ ((b >> 31) & 0x7fffffff);
}
__device__ __forceinline__ int key2bits(const int k) { return k ^ ((k >> 31) & 0x7fffffff); }
#define CEI(a, b) { const int _mx = max(a, b), _mn = min(a, b); a = _mx; b = _mn; }
template <int N>
__device__ __forceinline__ void bitonic_sort_desc(int (&v)[N]) {
#pragma unroll
  for (int k = 2; k <= N; k <<= 1) {
#pragma unroll
    for (int j = k >> 1; j > 0; j >>= 1) {
#pragma unroll
      for (int i = 0; i < N; ++i) {
        const int l = i ^ j;
        if (l > i) {
          if ((i & k) == 0) { CEI(v[i], v[l]); } else { CEI(v[l], v[i]); }
        }
      }
    }
  }
}
__device__ __forceinline__ void merge16(int (&a)[16], const int (&b)[16]) {
#pragma unroll
  for (int i = 0; i < 16; ++i) a[i] = max(a[i], b[15 - i]);
#pragma unroll
  for (int j = 8; j > 0; j >>= 1) {
#pragma unroll
    for (int i = 0; i < 16; ++i) {
      const int l = i ^ j;
      if (l > i) { CEI(a[i], a[l]); }
    }
  }
}
__device__ __forceinline__ void merge_partner(int (&a)[16], const int xmask) {
  int o[16];
#pragma unroll
  for (int i = 0; i < 16; ++i) o[i] = __shfl_xor(a[i], xmask);
  merge16(a, o);
}
__device__ __forceinline__ bf16x8 pack_hi8(const float (&x)[8], float (&res)[8]) {
  unsigned u[4];
#pragma unroll
  for (int i = 0; i < 4; ++i) {
    const ushort_t h0 = f2bf(x[2 * i]), h1 = f2bf(x[2 * i + 1]);
    res[2 * i] = x[2 * i] - bf2f(h0);
    res[2 * i + 1] = x[2 * i + 1] - bf2f(h1);
    u[i] = (unsigned)h0 | ((unsigned)h1 << 16);
  }
  uint4 uu = make_uint4(u[0], u[1], u[2], u[3]);
  return *(bf16x8*)&uu;
}
__device__ __forceinline__ bf16x8 pack_8(const float (&x)[8]) {
  uint4 uu = make_uint4(pack2(x[0], x[1]), pack2(x[2], x[3]), pack2(x[4], x[5]), pack2(x[6], x[7]));
  return *(bf16x8*)&uu;
}

__device__ __forceinline__ void ph_gemm_route(const int vb, char* smem, const Params& p, const ushort_t* __restrict__ hn_b) {
  const int head = vb & 7, tt = vb >> 3;
  const int m0 = head * 128, n0 = tt * 128;
  f32x16 acc[2][2];
  gemm_core(p.w_qT, hn_b, DM, m0, n0, smem, acc);
  int tid = threadIdx.x;
  asm volatile("" : "+v"(tid));
  const int lane = tid & 63, r = lane & 31, hl = lane >> 5;
  const int wave = tid >> 6, wm = wave >> 1, wn = wave & 1;
  int* s_top = (int*)smem;
  const ushort_t* kh = p.skh + (size_t)wm * 128 * 64;
  const ushort_t* kl = p.skl + (size_t)wm * 128 * 64;
#pragma unroll
  for (int ni = 0; ni < 2; ++ni) {
    asm volatile("" ::: "memory");
    bf16x8 qh[4], ql[4];
#pragma unroll
    for (int mi = 0; mi < 2; ++mi) {
#pragma unroll
      for (int k2 = 0; k2 < 2; ++k2) {
        float x[8], res[8];
#pragma unroll
        for (int j = 0; j < 8; ++j) x[j] = acc[mi][ni][8 * k2 + j];
        qh[mi * 2 + k2] = pack_hi8(x, res);
        ql[mi * 2 + k2] = pack_8(res);
      }
    }
    int g0[16];
#pragma unroll
    for (int kh2 = 0; kh2 < 2; ++kh2) {
      int ga[16], gb[16];
#pragma unroll
      for (int kq = 0; kq < 2; ++kq) {
        const int kt = kh2 * 2 + kq;
        asm volatile("" ::: "memory");
        f32x16 sc;
#pragma unroll
        for (int e = 0; e < 16; ++e) sc[e] = 0.f;
#pragma unroll
        for (int st = 0; st < 4; ++st) {
          const int d0 = (st >> 1) * 32 + 16 * (st & 1) + 4 * hl;
          const size_t ko = (size_t)(kt * 32 + r) * 64 + d0;
          const uint2 h0 = *(const uint2*)(kh + ko), h1 = *(const uint2*)(kh + ko + 8);
          const uint2 l0 = *(const uint2*)(kl + ko), l1 = *(const uint2*)(kl + ko + 8);
          uint4 hq = make_uint4(h0.x, h0.y, h1.x, h1.y), lq = make_uint4(l0.x, l0.y, l1.x, l1.y);
          const bf16x8 ah = *(bf16x8*)&hq, al = *(bf16x8*)&lq;
          sc = __builtin_amdgcn_mfma_f32_32x32x16_bf16(ah, qh[st], sc, 0, 0, 0);
          sc = __builtin_amdgcn_mfma_f32_32x32x16_bf16(ah, ql[st], sc, 0, 0, 0);
          sc = __builtin_amdgcn_mfma_f32_32x32x16_bf16(al, qh[st], sc, 0, 0, 0);
        }
        if (kq == 0) {
#pragma unroll
          for (int e = 0; e < 16; ++e) ga[e] = mkkey(sc[e], kt * 32 + (e & 3) + 8 * (e >> 2) + 4 * hl, 127);
          bitonic_sort_desc<16>(ga);
        } else {
#pragma unroll
          for (int e = 0; e < 16; ++e) gb[e] = mkkey(sc[e], kt * 32 + (e & 3) + 8 * (e >> 2) + 4 * hl, 127);
          bitonic_sort_desc<16>(gb);
        }
      }
      merge16(ga, gb);
      if (kh2 == 0) {
#pragma unroll
        for (int i = 0; i < 16; ++i) g0[i] = ga[i];
      } else {
        merge16(g0, ga);
      }
    }
    merge_partner(g0, 32);
    {
      int* dst = s_top + ((size_t)wm * 128 + wn * 64 + ni * 32 + r) * 16 + hl * 8;
      int4 w0, w1;
      int lo8[8], hi8[8];
#pragma unroll
      for (int i = 0; i < 8; ++i) { lo8[i] = g0[i]; hi8[i] = g0[8 + i]; asm volatile("" : "+v"(lo8[i]), "+v"(hi8[i])); }
      w0 = make_int4(hl ? hi8[0] : lo8[0], hl ? hi8[1] : lo8[1], hl ? hi8[2] : lo8[2], hl ? hi8[3] : lo8[3]);
      w1 = make_int4(hl ? hi8[4] : lo8[4], hl ? hi8[5] : lo8[5], hl ? hi8[6] : lo8[6], hl ? hi8[7] : lo8[7]);
      *(int4*)dst = w0; *(int4*)(dst + 4) = w1;
    }
  }
  __syncthreads();
  {
    const int tok = tid >> 1, sub = tid & 1;
    int k1[16], k2[16];
    {
      const int4* a = (const int4*)(s_top + (size_t)tok * 16);
      const int4* b = (const int4*)(s_top + (size_t)(128 + tok) * 16);
#pragma unroll
      for (int i = 0; i < 4; ++i) {
        const int4 x = a[i], y = b[i];
        k1[4 * i] = x.x; k1[4 * i + 1] = x.y; k1[4 * i + 2] = x.z; k1[4 * i + 3] = x.w;
        k2[4 * i] = y.x; k2[4 * i + 1] = y.y; k2[4 * i + 2] = y.z; k2[4 * i + 3] = y.w;
      }
    }
    float v1f[16], v2f[16];
#pragma unroll
    for (int i = 0; i < 16; ++i) { v1f[i] = __int_as_float(key2bits(k1[i])); v2f[i] = __int_as_float(key2bits(k2[i])); }
    int c[32];
    c[0] = sub ? mkkey(v1f[3] + v2f[3], 51, 255) : mkkey(v1f[0] + v2f[0], 0, 255);
    c[1] = sub ? mkkey(v1f[4] + v2f[0], 64, 255) : mkkey(v1f[0] + v2f[1], 1, 255);
    c[2] = sub ? mkkey(v1f[4] + v2f[1], 65, 255) : mkkey(v1f[0] + v2f[2], 2, 255);
    c[3] = sub ? mkkey(v1f[4] + v2f[2], 66, 255) : mkkey(v1f[0] + v2f[3], 3, 255);
    c[4] = sub ? mkkey(v1f[5] + v2f[0], 80, 255) : mkkey(v1f[0] + v2f[4], 4, 255);
    c[5] = sub ? mkkey(v1f[5] + v2f[1], 81, 255) : mkkey(v1f[0] + v2f[5], 5, 255);
    c[6] = sub ? mkkey(v1f[6] + v2f[0], 96, 255) : mkkey(v1f[0] + v2f[6], 6, 255);
    c[7] = sub ? mkkey(v1f[6] + v2f[1], 97, 255) : mkkey(v1f[0] + v2f[7], 7, 255);
    c[8] = sub ? mkkey(v1f[7] + v2f[0], 112, 255) : mkkey(v1f[0] + v2f[8], 8, 255);
    c[9] = sub ? mkkey(v1f[7] + v2f[1], 113, 255) : mkkey(v1f[0] + v2f[9], 9, 255);
    c[10] = sub ? mkkey(v1f[8] + v2f[0], 128, 255) : mkkey(v1f[0] + v2f[10], 10, 255);
    c[11] = sub ? mkkey(v1f[9] + v2f[0], 144, 255) : mkkey(v1f[0] + v2f[11], 11, 255);
    c[12] = sub ? mkkey(v1f[10] + v2f[0], 160, 255) : mkkey(v1f[0] + v2f[12], 12, 255);
    c[13] = sub ? mkkey(v1f[11] + v2f[0], 176, 255) : mkkey(v1f[0] + v2f[13], 13, 255);
    c[14] = sub ? mkkey(v1f[12] + v2f[0], 192, 255) : mkkey(v1f[0] + v2f[14], 14, 255);
    c[15] = sub ? mkkey(v1f[13] + v2f[0], 208, 255) : mkkey(v1f[0] + v2f[15], 15, 255);
    c[16] = sub ? mkkey(v1f[14] + v2f[0], 224, 255) : mkkey(v1f[1] + v2f[0], 16, 255);
    c[17] = sub ? mkkey(v1f[15] + v2f[0], 240, 255) : mkkey(v1f[1] + v2f[1], 17, 255);
    c[18] = sub ? (int)0x80000000 : mkkey(v1f[1] + v2f[2], 18, 255);
    c[19] = sub ? (int)0x80000000 : mkkey(v1f[1] + v2f[3], 19, 255);
    c[20] = sub ? (int)0x80000000 : mkkey(v1f[1] + v2f[4], 20, 255);
    c[21] = sub ? (int)0x80000000 : mkkey(v1f[1] + v2f[5], 21, 255);
    c[22] = sub ? (int)0x80000000 : mkkey(v1f[1] + v2f[6], 22, 255);
    c[23] = sub ? (int)0x80000000 : mkkey(v1f[1] + v2f[7], 23, 255);
    c[24] = sub ? (int)0x80000000 : mkkey(v1f[2] + v2f[0], 32, 255);
    c[25] = sub ? (int)0x80000000 : mkkey(v1f[2] + v2f[1], 33, 255);
    c[26] = sub ? (int)0x80000000 : mkkey(v1f[2] + v2f[2], 34, 255);
    c[27] = sub ? (int)0x80000000 : mkkey(v1f[2] + v2f[3], 35, 255);
    c[28] = sub ? (int)0x80000000 : mkkey(v1f[2] + v2f[4], 36, 255);
    c[29] = sub ? (int)0x80000000 : mkkey(v1f[3] + v2f[0], 48, 255);
    c[30] = sub ? (int)0x80000000 : mkkey(v1f[3] + v2f[1], 49, 255);
    c[31] = sub ? (int)0x80000000 : mkkey(v1f[3] + v2f[2], 50, 255);
    int h0[16], h1[16];
#pragma unroll
    for (int i = 0; i < 16; ++i) { h0[i] = c[i]; h1[i] = c[16 + i]; }
    bitonic_sort_desc<16>(h0); bitonic_sort_desc<16>(h1);
    merge16(h0, h1);
    merge_partner(h0, 1);
    float sv[16];
#pragma unroll
    for (int i = 0; i < 16; ++i) sv[i] = __int_as_float(key2bits(h0[i]));
    float den = 0.f;
#pragma unroll
    for (int i = 0; i < 16; ++i) den += __expf(sv[i] - sv[0]);
    const float inv = 1.f / den;
    int eo[8]; float go[8];
#pragma unroll
    for (int i = 0; i < 8; ++i) {
      int klo = h0[i], khi = h0[8 + i];
      asm volatile("" : "+v"(klo), "+v"(khi));
      const int kk = sub ? khi : klo;
      const int bits = key2bits(kk);
      const int code = bits & 255;
      const int ia = key2bits(s_top[(size_t)tok * 16 + (code >> 4)]) & 127;
      const int ib = key2bits(s_top[(size_t)(128 + tok) * 16 + (code & 15)]) & 127;
      eo[i] = ia * 128 + ib;
      go[i] = __expf(__int_as_float(bits) - sv[0]) * inv;
    }
    const size_t ob = ((size_t)(n0 + tok) * 8 + head) * 16 + sub * 8;
    *(int4*)(p.eidx + ob) = make_int4(eo[0], eo[1], eo[2], eo[3]);
    *(int4*)(p.eidx + ob + 4) = make_int4(eo[4], eo[5], eo[6], eo[7]);
    *(float4*)(p.egate + ob) = make_float4(go[0], go[1], go[2], go[3]);
    *(float4*)(p.egate + ob + 4) = make_float4(go[4], go[5], go[6], go[7]);
  }
}

__device__ __forceinline__ void ph_subkeys(const Params& p) {
  for (int i = blockIdx.x * 256 + threadIdx.x; i < 2 * 128 * 64; i += gridDim.x * 256) {
    const float v = (i < 8192) ? p.sk1[i] : p.sk2[i - 8192];
    const ushort_t hi = f2bf(v);
    p.skh[i] = hi;
    p.skl[i] = f2bf(v - bf2f(hi));
  }
}

__device__ __forceinline__ float dot16_fp8(const uint4 d, const float (&x)[16], float c) {
  const unsigned w[4] = {d.x, d.y, d.z, d.w};
#pragma unroll
  for (int i = 0; i < 4; ++i) {
    const f32x2_t lo = __builtin_amdgcn_cvt_pk_f32_fp8((int)w[i], false);
    const f32x2_t hi = __builtin_amdgcn_cvt_pk_f32_fp8((int)w[i], true);
    c = fmaf(lo.x, x[4 * i], c); c = fmaf(lo.y, x[4 * i + 1], c); c = fmaf(hi.x, x[4 * i + 2], c); c = fmaf(hi.y, x[4 * i + 3], c);
  }
  return c;
}
__device__ __forceinline__ void axpy16_fp8(const float cf, const uint4 u, float (&acc)[16]) {
  const unsigned w[4] = {u.x, u.y, u.z, u.w};
#pragma unroll
  for (int i = 0; i < 4; ++i) {
    const f32x2_t lo = __builtin_amdgcn_cvt_pk_f32_fp8((int)w[i], false);
    const f32x2_t hi = __builtin_amdgcn_cvt_pk_f32_fp8((int)w[i], true);
    acc[4 * i] = fmaf(cf, lo.x, acc[4 * i]); acc[4 * i + 1] = fmaf(cf, lo.y, acc[4 * i + 1]);
    acc[4 * i + 2] = fmaf(cf, hi.x, acc[4 * i + 2]); acc[4 * i + 3] = fmaf(cf, hi.y, acc[4 * i + 3]);
  }
}
__device__ __forceinline__ void k_peer_experts(const int VB, const Params& p, const ushort_t* __restrict__ hn) {
  const int lane = threadIdx.x & 63;
  const int wave = __builtin_amdgcn_readfirstlane(threadIdx.x >> 6);
  const int t = VB * 4 + wave;
  float x[16];
  {
    float f0[8], f1[8];
    unpack8(*(const uint4*)(hn + (size_t)t * DM + lane * 16), f0);
    unpack8(*(const uint4*)(hn + (size_t)t * DM + lane * 16 + 8), f1);
#pragma unroll
    for (int i = 0; i < 8; ++i) { x[i] = f0[i]; x[8 + i] = f1[i]; }
  }
  float acc[16];
#pragma unroll
  for (int i = 0; i < 16; ++i) acc[i] = 0.f;
  const int* ei = p.eidx + (size_t)t * 128;
  const float* eg = p.egate + (size_t)t * 128;
  const int myex = ((lane >> 5) & 1) * 4 + ((lane >> 4) & 1) * 2 + ((lane >> 3) & 1);
  const bool b5 = (lane & 32) != 0, b4 = (lane & 16) != 0, b3 = (lane & 8) != 0;
#pragma unroll 1
  for (int c = 0; c < 16; ++c) {
    int e[8];
#pragma unroll
    for (int i = 0; i < 8; ++i) e[i] = ei[c * 8 + i];
    uint4 d[8], u[8];
#pragma unroll
    for (int i = 0; i < 8; ++i) d[i] = *(const uint4*)(p.ed8 + (size_t)e[i] * DM + lane * 16);
#pragma unroll
    for (int i = 0; i < 8; ++i) u[i] = *(const uint4*)(p.eu8 + (size_t)e[i] * DM + lane * 16);
    const int me = ei[c * 8 + myex];
    const float gate = eg[c * 8 + myex];
    const float sdm = p.ed_s[me], sum = p.eu_s[me];
    float pr[8];
#pragma unroll
    for (int i = 0; i < 8; ++i) pr[i] = dot16_fp8(d[i], x, 0.f);
    float q4[4];
#pragma unroll
    for (int i = 0; i < 4; ++i) {
      const float snd = b5 ? pr[i] : pr[i + 4];
      const float kp = b5 ? pr[i + 4] : pr[i];
      q4[i] = kp + __shfl_xor(snd, 32);
    }
    float q2[2];
#pragma unroll
    for (int i = 0; i < 2; ++i) {
      const float snd = b4 ? q4[i] : q4[i + 2];
      const float kp = b4 ? q4[i + 2] : q4[i];
      q2[i] = kp + __shfl_xor(snd, 16);
    }
    float q1;
    {
      const float snd = b3 ? q2[0] : q2[1];
      const float kp = b3 ? q2[1] : q2[0];
      q1 = kp + __shfl_xor(snd, 8);
    }
    q1 += __shfl_xor(q1, 4);
    q1 += __shfl_xor(q1, 2);
    q1 += __shfl_xor(q1, 1);
    const float coef = gate * gelu_f(q1 * sdm) * sum;
#pragma unroll
    for (int i = 0; i < 8; ++i) {
      const int src = ((i >> 2) & 1) * 32 + ((i >> 1) & 1) * 16 + (i & 1) * 8;
      const float cf = __int_as_float(__builtin_amdgcn_readlane(__float_as_int(coef), src));
      axpy16_fp8(cf, u[i], acc);
    }
  }
  float* orow = p.out + (size_t)t * DM + lane * 16;
#pragma unroll
  for (int i = 0; i < 4; ++i) {
    float4 hv = *(float4*)(orow + i * 4);
    hv.x += acc[4 * i]; hv.y += acc[4 * i + 1]; hv.z += acc[4 * i + 2]; hv.w += acc[4 * i + 3];
    *(float4*)(orow + i * 4) = hv;
  }
}

#define PHASE(NBLK, CALL) \
  for (int VB = blockIdx.x; VB < (NBLK); VB += gridDim.x) { CALL; __syncthreads(); }
#define PHASE_NS(NBLK, CALL) \
  for (int VB = blockIdx.x; VB < (NBLK); VB += gridDim.x) { CALL; }

__global__ __launch_bounds__(256, 2) void fwd_megakernel(Params p) {
  __shared__ __attribute__((aligned(16))) char smem_raw[SMEM_BYTES];
  float* smem = (float*)smem_raw;
  cg::grid_group grid = cg::this_grid();
  volatile LAS unsigned* xb_st = (volatile LAS unsigned*)(smem_raw + 73728);
  if (threadIdx.x == 0) { xb_st[0] = 0u; xb_st[1] = 0u; xb_st[2] = 0u; xb_st[3] = 0u; }
  __syncthreads();
  const XcdBarrier xb = xcd_barrier_post(p.bar, xb_st);
  PHASE_NS(NT / 4, ph_rmsnorm_bf16(VB, p.x, p.mix_norm_w, p.xn_b, p.w_in, p.dt_bias, p.dt));
  PHASE_NS(NB * MEM / 4, ph_rmsnorm_bf16(VB, p.mem, p.mem_norm_w, p.memn_b, nullptr, nullptr, nullptr));
  PHASE(16 * 40, ph_wtrans(VB, smem, p.w_in, INC, p.w_inT, 40, 8));
  PHASE(16 * 16, ph_wtrans(VB, smem, p.w_out, DM, p.w_outT, 16, 0));
  PHASE(16 * 16, ph_wtrans(VB, smem, p.w_query, DM, p.w_qT, 16, 0));
  PHASE(16 * 8, ph_wtrans(VB, smem, p.w_mem_kv, 512, p.w_memT, 8, 0));
  if (blockIdx.x == 0) p.bcnt[threadIdx.x] = 0;
  ph_subkeys(p);
  PHASE_NS(4096, ph_cvt8(VB, p.e_down, p.ed8, p.ed_s));
  PHASE_NS(4096, ph_cvt8(VB, p.e_up, p.eu8, p.eu_s));
  grid.sync();
  PHASE(20 * (NT / 128), ph_gemm_proj(VB, smem_raw, p));
  PHASE(4 * (NB * MEM / 128), ph_gemm_mem(VB, smem_raw, p));
  xcd_barrier(xb);
  PHASE(NB * 64 * 8, ph_ssd1(VB, smem_raw, p));
  PHASE_NS(NT * 4 / 256, k_gate(VB, p));
  PHASE(NB * 4 * 64, ph_attn_unit(2, VB >> 6, VB & 63, smem_raw, p));
  xcd_barrier(xb);
  PHASE_NS(NB * 8 * 64 * 128 / 256, ph_ssd2(VB, p));
  {
    int* s_pref = (int*)(smem_raw + 72192);
    {
      const int tid = threadIdx.x;
      int v = (p.bcnt[tid] + 127) >> 7;
      const int lane = tid & 63;
#pragma unroll
      for (int o = 1; o < 64; o <<= 1) { int nb = __shfl_up(v, o); if (lane >= o) v += nb; }
      int* s_wt = s_pref + 256;
      if (lane == 63) s_wt[tid >> 6] = v;
      __syncthreads();
      int add = 0;
      for (int ww = 0; ww < (tid >> 6); ++ww) add += s_wt[ww];
      s_pref[tid] = v + add;
      __syncthreads();
    }
    const int Ug = s_pref[255];
    for (int u = blockIdx.x; u < Ug + NB * 4 * 32 * 2; u += gridDim.x) {
      if (u < Ug) {
        int lo = 0, hi = 255;
        while (lo < hi) { int mid = (lo + hi) >> 1; if (s_pref[mid] > u) hi = mid; else lo = mid + 1; }
        const int prev = lo ? s_pref[lo - 1] : 0;
        ph_attn_unit(0, lo, u - prev, smem_raw, p);
      } else {
        const int v = u - Ug;
        ph_attn_unit(1, v >> 1, v & 1, smem_raw, p);
      }
      __syncthreads();
    }
  }
  xcd_barrier(xb);
  PHASE(NB * 64 * 2, ph_ssd3(VB, smem_raw, p));
  PHASE_NS(NT * 4 * 8 / 256, ph_attn_combine(VB, p));
  xcd_barrier(xb);
  PHASE(8 * (NT / 128), ph_gemm_f32(VB, smem_raw, p.mixed_b, p.w_outT, p.out, p.x));
  xcd_barrier(xb);
  ushort_t* hn_b = p.xn_b;
  PHASE_NS(NT / 4, ph_rmsnorm_bf16(VB, p.out, p.ffn_norm_w, hn_b, nullptr, nullptr, nullptr));
  xcd_barrier(xb);
  PHASE(8 * (NT / 128), ph_gemm_route(VB, smem_raw, p, hn_b));
  xcd_barrier(xb);
  PHASE_NS(NT / 4, k_peer_experts(VB, p, hn_b));
}
}

extern "C" void kernel_launch(void* const* d_in, const int* in_sizes, int n_in, void* d_out, int out_size, void* d_ws, size_t ws_size,
                              hipStream_t stream) {
  Params p{};
  p.x = (const float*)d_in[0]; p.mem = (const float*)d_in[1]; p.mix_norm_w = (const float*)d_in[2]; p.w_in = (const float*)d_in[3];
  p.conv_w = (const float*)d_in[4]; p.conv_b = (const float*)d_in[5]; p.dt_bias = (const float*)d_in[6]; p.a_log = (const float*)d_in[7];
  p.ssd_d = (const float*)d_in[8]; p.ssd_norm_w = (const float*)d_in[9]; p.mq_norm_w = (const float*)d_in[10]; p.mk_norm_w = (const float*)d_in[11];
  p.mem_norm_w = (const float*)d_in[12]; p.w_mem_kv = (const float*)d_in[13]; p.xq_norm_w = (const float*)d_in[14]; p.xk_norm_w = (const float*)d_in[15];
  p.w_out = (const float*)d_in[16]; p.ffn_norm_w = (const float*)d_in[17]; p.w_query = (const float*)d_in[18]; p.sk1 = (const float*)d_in[19];
  p.sk2 = (const float*)d_in[20]; p.e_down = (const float*)d_in[21]; p.e_up = (const float*)d_in[22];
  p.out = (float*)d_out;
  char* ws = (char*)d_ws;
  size_t o = 0;
  auto take = [&](size_t bytes) { char* q = ws + o; o += (bytes + 255) & ~(size_t)255; return q; };
  p.xn_b = (ushort_t*)take((size_t)NT * DM * 2);
  p.xc = p.xn_b;
  p.w_inT = (ushort_t*)take((size_t)NPROJ * DM * 2);
  p.w_outT = (ushort_t*)take((size_t)DM * DM * 2);
  p.w_qT = (ushort_t*)take((size_t)DM * DM * 2);
  p.w_memT = (ushort_t*)take((size_t)512 * DM * 2);
  p.memn_b = (ushort_t*)take((size_t)NB * MEM * DM * 2);
  p.memk_b = (ushort_t*)take((size_t)NB * MEM * 256 * 2);
  p.memvT = (ushort_t*)take((size_t)NB * MEM * 256 * 2);
  char* regQ = take((size_t)NT * 2560 * 2);
  p.zs = (ushort_t*)regQ;
  p.xbc_raw = (ushort_t*)(regQ + (size_t)NT * 512 * 2);
  p.mq = (ushort_t*)(regQ + (size_t)NT * 1536 * 2);
  p.mk = (ushort_t*)(regQ + (size_t)NT * 1792 * 2);
  p.vT = (ushort_t*)(regQ + (size_t)NT * 2048 * 2);
  p.xq = (ushort_t*)(regQ + (size_t)NT * 2304 * 2);
  p.q = (float*)regQ;
  p.dt = (float*)take((size_t)NT * 8 * 4);
  p.acs = (float*)take((size_t)NT * 8 * 4);
  p.cdec = (float*)take((size_t)NB * 64 * 8 * 4);
  p.states = (float*)d_out;
  p.sin_b = (ushort_t*)((char*)d_out + (size_t)NB * 64 * 8 * 8192 * 4);
  p.xT = (ushort_t*)((char*)d_out + (size_t)NB * 64 * 8 * 8192 * 6);
  p.mixed_b = (ushort_t*)take((size_t)NT * DM * 2);
  p.kpart = (float*)take((size_t)NB * 4 * 32 * 4 * 64 * 4);
  p.bcnt = (int*)take(256 * 4);
  p.blist = (int*)take((size_t)256 * 8192 * 4);
  p.pm = (float*)take((size_t)NT * 16 * 4);
  p.pl = (float*)take((size_t)NT * 16 * 4);
  p.pO = p.xbc_raw;
  p.eidx = (int*)take((size_t)NT * 128 * 4);
  p.egate = (float*)take((size_t)NT * 128 * 4);
  p.ed8 = (unsigned char*)take((size_t)16384 * DM);
  p.eu8 = (unsigned char*)take((size_t)16384 * DM);
  p.ed_s = (float*)take(16384 * 4);
  p.eu_s = (float*)take(16384 * 4);
  p.bar = (unsigned*)take(XCD_BAR_WORDS * 4);
  p.skh = (ushort_t*)take(2 * 128 * 64 * 2);
  p.skl = (ushort_t*)take(2 * 128 * 64 * 2);
  if (o > ws_size) return;
  (void)hipMemsetAsync(p.bar, 0, XCD_BAR_WORDS * 4, stream);
  static int grid_blocks = 0;
  if (!grid_blocks) {
    int dev = 0, cus = 0, per_cu = 0;
    (void)hipGetDevice(&dev);
    (void)hipDeviceGetAttribute(&cus, hipDeviceAttributeMultiprocessorCount, dev);
    (void)hipOccupancyMaxActiveBlocksPerMultiprocessor(&per_cu, fwd_megakernel, 256, 0);
    if (per_cu > 2) per_cu = 2;
    if (per_cu < 1) per_cu = 1;
    grid_blocks = cus * per_cu;
  }
  void* args[] = {&p};
  hipError_t e = hipLaunchCooperativeKernel((void*)fwd_megakernel, dim3(grid_blocks), dim3(256), args, 0, stream);
  if (e != hipSuccess) fprintf(stderr, "cooperative launch failed: %s (grid %d)\n", hipGetErrorString(e), grid_blocks);
}
```

```cpp
#include <hip/hip_runtime.h>
#include <hip/hip_cooperative_groups.h>
#include <cstdio>
#include <math.h>
#include <stdint.h>
namespace cg = cooperative_groups;

namespace {
typedef unsigned short ushort_t;
typedef __attribute__((ext_vector_type(8))) short bf16x8;
typedef __attribute__((ext_vector_type(16))) float f32x16;

constexpr int DM = 1024;
constexpr int NB = 2;
constexpr int SL = 8192;
constexpr int NT = NB * SL;
constexpr int MEM = 256;
constexpr int INC = 2568;
constexpr int NPROJ = 2560;
constexpr float EPS = 1e-6f;
constexpr int SMEM_BYTES = 73728 + 256;

__device__ __forceinline__ float silu_f(float x) { return x / (1.f + expf(-x)); }
__device__ __forceinline__ float softplus_f(float x) { return fmaxf(x, 0.f) + log1pf(expf(-fabsf(x))); }
__device__ __forceinline__ float gelu_f(float x) { return 0.5f * x * (1.f + erff(x * 0.70710678118654752f)); }
__device__ __forceinline__ ushort_t f2bf(float x) {
  unsigned u = __float_as_uint(x);
  u += 0x7fffu + ((u >> 16) & 1u);
  return (ushort_t)(u >> 16);
}
__device__ __forceinline__ float bf2f(ushort_t h) { return __uint_as_float(((unsigned)h) << 16); }
__device__ __forceinline__ float bflo(unsigned w) { return __uint_as_float(w << 16); }
__device__ __forceinline__ float bfhi(unsigned w) { return __uint_as_float(w & 0xffff0000u); }
__device__ __forceinline__ unsigned pack2(float a, float b) { return (unsigned)f2bf(a) | ((unsigned)f2bf(b) << 16); }

__device__ __forceinline__ void unpack8(const uint4 v, float (&f)[8]) {
  f[0] = bflo(v.x); f[1] = bfhi(v.x); f[2] = bflo(v.y); f[3] = bfhi(v.y);
  f[4] = bflo(v.z); f[5] = bfhi(v.z); f[6] = bflo(v.w); f[7] = bfhi(v.w);
}

__device__ __forceinline__ float wave_sum(float v) {
#pragma unroll
  for (int o = 32; o > 0; o >>= 1) v += __shfl_xor(v, o);
  return v;
}
__device__ __forceinline__ float wave_max(float v) {
#pragma unroll
  for (int o = 32; o > 0; o >>= 1) v = fmaxf(v, __shfl_xor(v, o));
  return v;
}


#define XB_TMO      128
#define XB_XCNT(j)  (256  + 64 * (j))
#define XB_XSUB(j)  (1280 + 64 * (j))
#define XB_XGEN(j)  (2304 + 64 * (j))
#define XB_TOP      3328
#define XB_TOPGEN   3392
#define XCD_BAR_WORDS 3456
#define XB_SPIN_CAP (1u << 20)
#define LAS __attribute__((address_space(3)))
__device__ __forceinline__ unsigned xb_ld(unsigned* p)              { return __hip_atomic_load(p, __ATOMIC_RELAXED, __HIP_MEMORY_SCOPE_AGENT); }
__device__ __forceinline__ unsigned xb_add(unsigned* p, unsigned v) { return __hip_atomic_fetch_add(p, v, __ATOMIC_RELAXED, __HIP_MEMORY_SCOPE_AGENT); }
__device__ __forceinline__ unsigned xb_xcc_id() { return (unsigned)__builtin_amdgcn_s_getreg((3 << 11) | 20) & 0xFu; }
#define XB_SPIN(cond, bar) do { unsigned _sp = 0; while (cond) { __builtin_amdgcn_s_sleep(1); \
    if ((++_sp & 255u) == 0u) { if (xb_ld(&(bar)[XB_TMO])) break; if (_sp > XB_SPIN_CAP) { atomicAdd(&(bar)[XB_TMO], 1u); break; } } } } while (0)
struct XcdBarrier { unsigned* bar; unsigned x; volatile LAS unsigned* st; };
__device__ __forceinline__ XcdBarrier xcd_barrier_post(unsigned* bar, volatile LAS unsigned* st) {
  XcdBarrier b; b.bar = bar; b.x = xb_xcc_id(); b.st = st;
  if (threadIdx.x == 0) (void)xb_add(&bar[XB_XCNT(b.x)], 1u);
  return b;
}
__device__ __forceinline__ void xcd_barrier_complete(unsigned* bar, unsigned x, unsigned& nloc, unsigned& nx) {
  const unsigned G = gridDim.x * gridDim.y * gridDim.z;
  unsigned sum, cnt, mine, sp = 0u;
  for (;;) {
    sum = 0u; cnt = 0u; mine = 0u;
#pragma unroll
    for (unsigned j = 0; j < 16; ++j) { const unsigned c = xb_ld(&bar[XB_XCNT(j)]); sum += c; cnt += (c > 0u) ? 1u : 0u; mine = (j == x) ? c : mine; }
    if (sum == G) break;
    __builtin_amdgcn_s_sleep(1);
    if ((++sp & 255u) == 0u) { if (xb_ld(&bar[XB_TMO])) break; if (sp > XB_SPIN_CAP) { atomicAdd(&bar[XB_TMO], 1u); break; } }
  }
  nloc = mine > 0u ? mine : 1u; nx = cnt > 0u ? cnt : 1u;
}
__device__ __forceinline__ void xcd_barrier(const XcdBarrier& b) {
  asm volatile("s_waitcnt vmcnt(0)" ::: "memory");
  __syncthreads();
  if (threadIdx.x == 0) {
    unsigned* bar = b.bar;
    __builtin_amdgcn_s_waitcnt(0);
    unsigned nloc = b.st[0], nx = b.st[1];
    if (nloc == 0u) { xcd_barrier_complete(bar, b.x, nloc, nx); b.st[0] = nloc; b.st[1] = nx; }
    const unsigned old = xb_add(&bar[XB_XSUB(b.x)], 1u);
    const unsigned gen = old / nloc;
    if (old + 1u == (gen + 1u) * nloc) {
      __builtin_amdgcn_fence(__ATOMIC_RELEASE, "agent");
      asm volatile("s_waitcnt vmcnt(0)" ::: "memory");
      const unsigned og = xb_add(&bar[XB_TOP], 1u);
      const unsigned tg = og / nx;
      if (og + 1u == (tg + 1u) * nx) xb_add(&bar[XB_TOPGEN], 1u);
      else XB_SPIN(xb_ld(&bar[XB_TOPGEN]) == tg, bar);
      __builtin_amdgcn_fence(__ATOMIC_ACQUIRE, "agent");
      xb_add(&bar[XB_XGEN(b.x)], 1u);
      asm volatile("s_waitcnt vmcnt(0)" ::: "memory");
    } else {
      XB_SPIN(xb_ld(&bar[XB_XGEN(b.x)]) == gen, bar);
      __builtin_amdgcn_fence(__ATOMIC_ACQUIRE, "agent");
      asm volatile("s_waitcnt vmcnt(0)" ::: "memory");
    }
  }
  __syncthreads();
}

struct Params {
  const float *x, *mem, *mix_norm_w, *w_in, *conv_w, *conv_b, *dt_bias, *a_log, *ssd_d, *ssd_norm_w, *mq_norm_w, *mk_norm_w,
      *mem_norm_w, *w_mem_kv, *xq_norm_w, *xk_norm_w, *w_out, *ffn_norm_w, *w_query, *sk1, *sk2, *e_down, *e_up;
  float* out;
  ushort_t *xn_b, *w_inT, *w_outT, *w_qT, *w_memT, *memn_b, *zs, *xbc_raw, *mq, *mk, *xq, *memk_b, *mixed_b;
  float *dt, *q, *egate, *acs, *cdec, *states;
  ushort_t *xc, *xT, *sin_b;
  int *eidx, *bcnt, *blist;
  unsigned* bar;
  ushort_t *skh, *skl;
  unsigned char *ed8, *eu8;
  float *ed_s, *eu_s;
  float *kpart, *pm, *pl;
  ushort_t *vT, *memvT, *pO;
};

__device__ __forceinline__ void ph_rmsnorm_bf16(const int vb, const float* __restrict__ x, const float* __restrict__ w,
                                                ushort_t* __restrict__ outb, const float* __restrict__ w_in, const float* __restrict__ dt_bias,
                                                float* __restrict__ dt) {
  const int lane = threadIdx.x & 63;
  const int row = vb * 4 + (threadIdx.x >> 6);
  const float* xr = x + (size_t)row * DM;
  float4 v[4];
#pragma unroll
  for (int i = 0; i < 4; ++i) v[i] = *(const float4*)(xr + i * 256 + lane * 4);
  float ss = 0.f;
#pragma unroll
  for (int i = 0; i < 4; ++i) ss += v[i].x * v[i].x + v[i].y * v[i].y + v[i].z * v[i].z + v[i].w * v[i].w;
  ss = wave_sum(ss);
  const float r = rsqrtf(ss / DM + EPS);
  float part[8];
#pragma unroll
  for (int hh = 0; hh < 8; ++hh) part[hh] = 0.f;
#pragma unroll
  for (int i = 0; i < 4; ++i) {
    const float4 ww = *(const float4*)(w + i * 256 + lane * 4);
    const float o0 = v[i].x * r * ww.x, o1 = v[i].y * r * ww.y, o2 = v[i].z * r * ww.z, o3 = v[i].w * r * ww.w;
    *(uint2*)(outb + (size_t)row * DM + i * 256 + lane * 4) = make_uint2(pack2(o0, o1), pack2(o2, o3));
    if (dt) {
      const float xs[4] = {o0, o1, o2, o3};
#pragma unroll
      for (int k = 0; k < 4; ++k) {
        const float* wr = w_in + (size_t)(i * 256 + lane * 4 + k) * INC + 1536;
        const float4 a = *(const float4*)(wr);
        const float4 b = *(const float4*)(wr + 4);
        part[0] = fmaf(xs[k], a.x, part[0]); part[1] = fmaf(xs[k], a.y, part[1]);
        part[2] = fmaf(xs[k], a.z, part[2]); part[3] = fmaf(xs[k], a.w, part[3]);
        part[4] = fmaf(xs[k], b.x, part[4]); part[5] = fmaf(xs[k], b.y, part[5]);
        part[6] = fmaf(xs[k], b.z, part[6]); part[7] = fmaf(xs[k], b.w, part[7]);
      }
    }
  }
  if (dt) {
    float mine = 0.f;
#pragma unroll
    for (int hh = 0; hh < 8; ++hh) {
      const float sfull = wave_sum(part[hh]);
      if (lane == hh) mine = sfull;
    }
    if (lane < 8) dt[(size_t)row * 8 + lane] = softplus_f(mine + dt_bias[lane]);
  }
}

__device__ __forceinline__ void ph_wtrans(const int vb, float* smem, const float* __restrict__ W, const int ldw, ushort_t* __restrict__ Wt,
                                          const int ntiles, const int skip) {
  float (*s)[65] = (float (*)[65])smem;
  const int tid = threadIdx.x;
  const int kt = vb / ntiles, nt = vb % ntiles;
  const int nd0 = nt * 64;
  const int ns0 = (nd0 < 1536) ? nd0 : nd0 + skip;
  {
    const int k = tid >> 2, nc = (tid & 3) * 16;
    const float* src = W + (size_t)(kt * 64 + k) * ldw + ns0 + nc;
#pragma unroll
    for (int j = 0; j < 4; ++j) {
      float4 v = *(const float4*)(src + j * 4);
      s[k][nc + j * 4 + 0] = v.x; s[k][nc + j * 4 + 1] = v.y; s[k][nc + j * 4 + 2] = v.z; s[k][nc + j * 4 + 3] = v.w;
    }
  }
  __syncthreads();
  {
    const int n = tid >> 2, kc = (tid & 3) * 16;
    unsigned pk[8];
#pragma unroll
    for (int j = 0; j < 8; ++j) pk[j] = pack2(s[kc + 2 * j][n], s[kc + 2 * j + 1][n]);
    ushort_t* dst = Wt + (size_t)(nd0 + n) * DM + kt * 64 + kc;
    *(uint4*)(dst) = make_uint4(pk[0], pk[1], pk[2], pk[3]);
    *(uint4*)(dst + 8) = make_uint4(pk[4], pk[5], pk[6], pk[7]);
  }
}

__device__ __forceinline__ void ph_cvt(const int vb, const float* __restrict__ src, ushort_t* __restrict__ dst) {
  const size_t base = (size_t)vb * 8192 + threadIdx.x * 8;
  float4 a[4], b[4];
#pragma unroll
  for (int i = 0; i < 4; ++i) {
    a[i] = *(const float4*)(src + base + i * 2048);
    b[i] = *(const float4*)(src + base + i * 2048 + 4);
  }
#pragma unroll
  for (int i = 0; i < 4; ++i)
    *(uint4*)(dst + base + i * 2048) = make_uint4(pack2(a[i].x, a[i].y), pack2(a[i].z, a[i].w), pack2(b[i].x, b[i].y), pack2(b[i].z, b[i].w));
}


typedef __attribute__((ext_vector_type(2))) float f32x2_t;
__device__ __forceinline__ void ph_cvt8(const int vb, const float* __restrict__ src, unsigned char* __restrict__ dst, float* __restrict__ inv_scale) {
  const int lane = threadIdx.x & 63;
  const int row = vb * 4 + (threadIdx.x >> 6);
  const float* sr = src + (size_t)row * DM + lane * 16;
  float4 v[4];
#pragma unroll
  for (int i = 0; i < 4; ++i) v[i] = *(const float4*)(sr + i * 4);
  float am = 0.f;
#pragma unroll
  for (int i = 0; i < 4; ++i) am = fmaxf(fmaxf(fmaxf(am, fabsf(v[i].x)), fmaxf(fabsf(v[i].y), fabsf(v[i].z))), fabsf(v[i].w));
  am = wave_max(am);
  const float sc = (am > 0.f) ? 224.f / am : 1.f;
  unsigned w[4];
#pragma unroll
  for (int i = 0; i < 4; ++i) {
    int t = 0;
    t = __builtin_amdgcn_cvt_pk_fp8_f32(v[i].x * sc, v[i].y * sc, t, false);
    t = __builtin_amdgcn_cvt_pk_fp8_f32(v[i].z * sc, v[i].w * sc, t, true);
    w[i] = (unsigned)t;
  }
  *(uint4*)(dst + (size_t)row * DM + lane * 16) = make_uint4(w[0], w[1], w[2], w[3]);
  if (lane == 0) inv_scale[row] = (am > 0.f) ? am * (1.f / 224.f) : 1.f;
}

__device__ __forceinline__ int swz(int row, int ch) { return row * 128 + ((ch ^ ((row >> 1) & 7)) << 4); }

__device__ __forceinline__ void gemm_compute(const char* cA, const char* cB, const int arow, const int brow, const int xr, const int h,
                                             f32x16 (&acc)[2][2]) {
#pragma unroll
  for (int ks = 0; ks < 4; ++ks) {
    const int co = ((ks * 2 + h) ^ xr) << 4;
    bf16x8 a0 = *(const bf16x8*)(cA + arow + co);
    bf16x8 a1 = *(const bf16x8*)(cA + arow + 32 * 128 + co);
    bf16x8 b0 = *(const bf16x8*)(cB + brow + co);
    bf16x8 b1 = *(const bf16x8*)(cB + brow + 32 * 128 + co);
    acc[0][0] = __builtin_amdgcn_mfma_f32_32x32x16_bf16(a0, b0, acc[0][0], 0, 0, 0);
    acc[0][1] = __builtin_amdgcn_mfma_f32_32x32x16_bf16(a0, b1, acc[0][1], 0, 0, 0);
    acc[1][0] = __builtin_amdgcn_mfma_f32_32x32x16_bf16(a1, b0, acc[1][0], 0, 0, 0);
    acc[1][1] = __builtin_amdgcn_mfma_f32_32x32x16_bf16(a1, b1, acc[1][1], 0, 0, 0);
  }
}

#define STG_LOAD(P, koff) \
  P##a0 = *(const uint4*)(Ag + (koff)); P##a1 = *(const uint4*)(Ag + rs + (koff)); P##a2 = *(const uint4*)(Ag + 2 * rs + (koff)); P##a3 = *(const uint4*)(Ag + 3 * rs + (koff)); \
  P##b0 = *(const uint4*)(Bg + (koff)); P##b1 = *(const uint4*)(Bg + rs + (koff)); P##b2 = *(const uint4*)(Bg + 2 * rs + (koff)); P##b3 = *(const uint4*)(Bg + 3 * rs + (koff));
#define STG_STORE(P, buf) \
  *(uint4*)((buf) + w0) = P##a0; *(uint4*)((buf) + w1) = P##a1; *(uint4*)((buf) + w2) = P##a2; *(uint4*)((buf) + w3) = P##a3; \
  *(uint4*)((buf) + 16384 + w0) = P##b0; *(uint4*)((buf) + 16384 + w1) = P##b1; *(uint4*)((buf) + 16384 + w2) = P##b2; *(uint4*)((buf) + 16384 + w3) = P##b3;
__device__ __forceinline__ void gemm_core(const ushort_t* __restrict__ A, const ushort_t* __restrict__ Bt, const int K, const int m0,
                                          const int n0, char* smem, f32x16 (&acc)[2][2]) {
  int tid = threadIdx.x;
  asm volatile("" : "+v"(tid));
  const int lane = tid & 63, wave = tid >> 6;
  const int wm = wave >> 1, wn = wave & 1;
  const int r = lane & 31, h = lane >> 5;
  const int srow = tid >> 3, sch = tid & 7;
  const ushort_t* Ag = A + (size_t)(m0 + srow) * K + sch * 8;
  const ushort_t* Bg = Bt + (size_t)(n0 + srow) * K + sch * 8;
  const size_t rs = (size_t)32 * K;
  uint4 Ra0, Ra1, Ra2, Ra3, Rb0, Rb1, Rb2, Rb3;
  uint4 Sa0, Sa1, Sa2, Sa3, Sb0, Sb1, Sb2, Sb3;
  STG_LOAD(R, 0)
#pragma unroll
  for (int i = 0; i < 2; ++i)
#pragma unroll
    for (int j = 0; j < 2; ++j)
#pragma unroll
      for (int e = 0; e < 16; ++e) acc[i][j][e] = 0.f;
  const int w0 = swz(srow, sch), w1 = swz(srow + 32, sch), w2 = swz(srow + 64, sch), w3 = swz(srow + 96, sch);
  char* buf0 = smem;
  char* buf1 = smem + 32768;
  STG_STORE(R, buf0)
  STG_LOAD(R, 64)
  STG_LOAD(S, 128)
  __syncthreads();
  const int nk = K >> 6;
  const int xr = (r >> 1) & 7;
  const int arow = (wm * 64 + r) * 128, brow = (wn * 64 + r) * 128;
#pragma unroll 1
  for (int kt = 0; kt < nk; kt += 2) {
    STG_STORE(R, buf1)
    if (kt + 3 < nk) { STG_LOAD(R, (kt + 3) * 64) }
    gemm_compute(buf0, buf0 + 16384, arow, brow, xr, h, acc);
    __syncthreads();
    if (kt + 2 < nk) { STG_STORE(S, buf0) }
    if (kt + 4 < nk) { STG_LOAD(S, (kt + 4) * 64) }
    gemm_compute(buf1, buf1 + 16384, arow, brow, xr, h, acc);
    __syncthreads();
  }
}

enum { EP_SILU = 0, EP_PLAIN = 1, EP_HEADNORM = 2 };

__device__ __forceinline__ void epi_bf16(const f32x16 (&acc)[2][2], const int mode, ushort_t* __restrict__ dst, const int ld,
                                         const int row0, const int col0, const float* __restrict__ nw) {
  const int lane = threadIdx.x & 63, r = lane & 31, h = lane >> 5;
  float w0 = 1.f, w1 = 1.f;
  if (mode == EP_HEADNORM) { w0 = nw[r]; w1 = nw[32 + r]; }
#pragma unroll
  for (int mi = 0; mi < 2; ++mi) {
#pragma unroll
    for (int e = 0; e < 16; ++e) {
      const int row = row0 + mi * 32 + (e & 3) + 8 * (e >> 2) + 4 * h;
      float v0 = acc[mi][0][e], v1 = acc[mi][1][e];
      if (mode == EP_SILU) { v0 = silu_f(v0); v1 = silu_f(v1); }
      if (mode == EP_HEADNORM) {
        float ss = v0 * v0 + v1 * v1;
        ss += __shfl_xor(ss, 1); ss += __shfl_xor(ss, 2); ss += __shfl_xor(ss, 4); ss += __shfl_xor(ss, 8); ss += __shfl_xor(ss, 16);
        const float rs = rsqrtf(ss * (1.f / 64.f) + EPS);
        v0 = v0 * rs * w0; v1 = v1 * rs * w1;
      }
      dst[(size_t)row * ld + col0 + r] = f2bf(v0);
      dst[(size_t)row * ld + col0 + 32 + r] = f2bf(v1);
    }
  }
}

__device__ __forceinline__ void epi_f32(const f32x16 (&acc)[2][2], float* __restrict__ dst, const int ld, const int row0, const int col0,
                                        const float* __restrict__ resid) {
  const int lane = threadIdx.x & 63, r = lane & 31, h = lane >> 5;
#pragma unroll
  for (int mi = 0; mi < 2; ++mi) {
#pragma unroll
    for (int e = 0; e < 16; ++e) {
      const int row = row0 + mi * 32 + (e & 3) + 8 * (e >> 2) + 4 * h;
#pragma unroll
      for (int ni = 0; ni < 2; ++ni) {
        const size_t idx = (size_t)row * ld + col0 + ni * 32 + r;
        float v = acc[mi][ni][e];
        if (resid) v += resid[idx];
        dst[idx] = v;
      }
    }
  }
}


__device__ __forceinline__ void epi_bf16_T(const f32x16 (&acc)[2][2], ushort_t* __restrict__ dstT, const size_t ldT, const int rowpos0) {
  const int lane = threadIdx.x & 63, r = lane & 31, h = lane >> 5;
#pragma unroll
  for (int ni = 0; ni < 2; ++ni) {
    ushort_t* base = dstT + (size_t)(ni * 32 + r) * ldT + rowpos0;
#pragma unroll
    for (int mi = 0; mi < 2; ++mi) {
#pragma unroll
      for (int q4 = 0; q4 < 4; ++q4) {
        const int rp = mi * 32 + 8 * q4 + 4 * h;
        *(uint2*)(base + rp) = make_uint2(pack2(acc[mi][ni][4 * q4 + 0], acc[mi][ni][4 * q4 + 1]),
                                          pack2(acc[mi][ni][4 * q4 + 2], acc[mi][ni][4 * q4 + 3]));
      }
    }
  }
}

__device__ __forceinline__ void epi_bf16_k(const f32x16 (&acc)[2][2], ushort_t* __restrict__ dst, const int ld, const int row0, const int col0,
                                           const float* __restrict__ nw, float* __restrict__ kp  ) {
  const int lane = threadIdx.x & 63, r = lane & 31, h = lane >> 5;
  const float w0 = nw[r], w1 = nw[32 + r];
  float cs0 = 0.f, cs1 = 0.f;
#pragma unroll
  for (int mi = 0; mi < 2; ++mi) {
#pragma unroll
    for (int e = 0; e < 16; ++e) {
      const int row = row0 + mi * 32 + (e & 3) + 8 * (e >> 2) + 4 * h;
      float v0 = acc[mi][0][e], v1 = acc[mi][1][e];
      float ss = v0 * v0 + v1 * v1;
      ss += __shfl_xor(ss, 1); ss += __shfl_xor(ss, 2); ss += __shfl_xor(ss, 4); ss += __shfl_xor(ss, 8); ss += __shfl_xor(ss, 16);
      const float rs = rsqrtf(ss * (1.f / 64.f) + EPS);
      v0 = v0 * rs * w0; v1 = v1 * rs * w1;
      cs0 += v0; cs1 += v1;
      dst[(size_t)row * ld + col0 + r] = f2bf(v0);
      dst[(size_t)row * ld + col0 + 32 + r] = f2bf(v1);
    }
  }
  cs0 += __shfl_xor(cs0, 32);
  cs1 += __shfl_xor(cs1, 32);
  if (h == 0) { kp[r] = cs0; kp[32 + r] = cs1; }
}

__device__ __forceinline__ void ph_gemm_proj(const int vb, char* smem, const Params& p) {
  const int nt = vb % 20, mt = vb / 20;
  const int m0 = mt * 128, n0 = nt * 128;
  f32x16 acc[2][2];
  gemm_core(p.xn_b, p.w_inT, DM, m0, n0, smem, acc);
  const int wave = threadIdx.x >> 6, wm = wave >> 1, wn = wave & 1;
  const int row0 = m0 + wm * 64;
  const int c = n0 + wn * 64;
  if (c < 512) epi_bf16(acc, EP_SILU, p.zs, 512, row0, c, nullptr);
  else if (c < 1536) epi_bf16(acc, EP_PLAIN, p.xbc_raw, 1024, row0, c - 512, nullptr);
  else if (c < 1792) epi_bf16(acc, EP_HEADNORM, p.mq, 256, row0, c - 1536, p.mq_norm_w);
  else if (c < 2048) {
    const int hh = (c - 1792) >> 6, bb = row0 >> 13, lpos = row0 & (SL - 1);
    epi_bf16_k(acc, p.mk, 256, row0, c - 1792, p.mk_norm_w, p.kpart + ((size_t)((bb * 4 + hh) * 32 + (lpos >> 8)) * 4 + ((lpos >> 6) & 3)) * 64);
  } else if (c < 2304) {
    const int hh = (c - 2048) >> 6, bb = row0 >> 13, lpos = row0 & (SL - 1);
    epi_bf16_T(acc, p.vT + (size_t)(bb * 4 + hh) * 64 * SL, SL, lpos);
  }
  else epi_bf16(acc, EP_HEADNORM, p.xq, 256, row0, c - 2304, p.xq_norm_w);
}

__device__ __forceinline__ void ph_gemm_mem(const int vb, char* smem, const Params& p) {
  const int nt = vb % 4, mt = vb / 4;
  const int m0 = mt * 128, n0 = nt * 128;
  f32x16 acc[2][2];
  gemm_core(p.memn_b, p.w_memT, DM, m0, n0, smem, acc);
  const int wave = threadIdx.x >> 6, wm = wave >> 1, wn = wave & 1;
  const int row0 = m0 + wm * 64;
  const int c = n0 + wn * 64;
  if (c < 256) epi_bf16(acc, EP_HEADNORM, p.memk_b, 256, row0, c, p.xk_norm_w);
  else {
    const int hh = (c - 256) >> 6, bb = row0 >> 8, mpos = row0 & 255;
    epi_bf16_T(acc, p.memvT + (size_t)(bb * 4 + hh) * 64 * MEM, MEM, mpos);
  }
}

__device__ __forceinline__ void ph_gemm_f32(const int vb, char* smem, const ushort_t* A, const ushort_t* Bt, float* dst, const float* resid) {
  const int nt = vb % 8, mt = vb / 8;
  const int m0 = mt * 128, n0 = nt * 128;
  f32x16 acc[2][2];
  gemm_core(A, Bt, DM, m0, n0, smem, acc);
  const int wave = threadIdx.x >> 6, wm = wave >> 1, wn = wave & 1;
  epi_f32(acc, dst, DM, m0 + wm * 64, n0 + wn * 64, resid);
}

__device__ __forceinline__ int swz256(int row, int ch) { return row * 272 + (ch << 4); }
__device__ __forceinline__ int crow16(int e, int hl) { return (e & 3) + 8 * (e >> 2) + 4 * hl; }

__device__ __forceinline__ void ph_ssd1(const int vb, char* smem, const Params& p) {
  const int h = vb & 7, c = (vb >> 3) & 63, b = vb >> 9;
  const int g = h >> 2, hq = h & 3;
  int tid = threadIdx.x;
  asm volatile("" : "+v"(tid));
  const int lane = tid & 63, wave = tid >> 6;
  const int t0 = b * SL + c * 128;
  char* s_xw = smem;
  char* s_bt = smem + 17408;
  float* s_acs = (float*)(smem + 52224);
  float* s_w = s_acs + 128;
  float* s_red = s_w + 128;
  const float a_coef = -expf(p.a_log[h]);
  float dtv = 0.f, cs = 0.f;
  if (tid < 128) {
    dtv = p.dt[(size_t)(t0 + tid) * 8 + h];
    cs = dtv * a_coef;
#pragma unroll
    for (int o = 1; o < 64; o <<= 1) {
      float nb = __shfl_up(cs, o);
      if (lane >= o) cs += nb;
    }
    if (lane == 63) s_red[wave] = cs;
  }
  __syncthreads();
  if (tid < 128) {
    if (wave == 1) cs += s_red[0];
    s_acs[tid] = cs;
    p.acs[(size_t)(t0 + tid) * 8 + h] = cs;
  }
  __syncthreads();
  if (tid < 128) {
    const float tot = s_acs[127];
    s_w[tid] = dtv * expf(tot - cs);
    if (tid == 0) p.cdec[(b * 64 + c) * 8 + h] = expf(tot);
  }
  __syncthreads();
  if (tid < 224) {
    const int seg = tid / 28, cg = tid - seg * 28;
    const bool is_x = cg < 8, is_b = (cg >= 8) && (cg < 24);
    int ch0, trow;
    if (is_x) { ch0 = h * 64 + cg * 8; trow = cg * 8; }
    else if (is_b) { ch0 = 512 + g * 128 + (cg - 8) * 8; trow = (cg - 8) * 8; }
    else { ch0 = 768 + g * 128 + hq * 32 + (cg - 24) * 8; trow = 0; }
    const bool wr_nat = is_x || !is_b || (hq == 0);
    char* tbase = is_x ? s_xw : s_bt;
    const int l0 = seg * 16;
    float w0[8], w1[8], w2[8], w3[8], bias[8];
    {
      const float* cw = p.conv_w + ch0;
      float4 a, bq;
      a = *(const float4*)(cw); bq = *(const float4*)(cw + 4);
      w0[0] = a.x; w0[1] = a.y; w0[2] = a.z; w0[3] = a.w; w0[4] = bq.x; w0[5] = bq.y; w0[6] = bq.z; w0[7] = bq.w;
      a = *(const float4*)(cw + 1024); bq = *(const float4*)(cw + 1028);
      w1[0] = a.x; w1[1] = a.y; w1[2] = a.z; w1[3] = a.w; w1[4] = bq.x; w1[5] = bq.y; w1[6] = bq.z; w1[7] = bq.w;
      a = *(const float4*)(cw + 2048); bq = *(const float4*)(cw + 2052);
      w2[0] = a.x; w2[1] = a.y; w2[2] = a.z; w2[3] = a.w; w2[4] = bq.x; w2[5] = bq.y; w2[6] = bq.z; w2[7] = bq.w;
      a = *(const float4*)(cw + 3072); bq = *(const float4*)(cw + 3076);
      w3[0] = a.x; w3[1] = a.y; w3[2] = a.z; w3[3] = a.w; w3[4] = bq.x; w3[5] = bq.y; w3[6] = bq.z; w3[7] = bq.w;
      a = *(const float4*)(p.conv_b + ch0); bq = *(const float4*)(p.conv_b + ch0 + 4);
      bias[0] = a.x; bias[1] = a.y; bias[2] = a.z; bias[3] = a.w; bias[4] = bq.x; bias[5] = bq.y; bias[6] = bq.z; bias[7] = bq.w;
    }
    float r0[8], r1[8], r2[8];
    {
      const int lg = c * 128 + l0;
      const ushort_t* src = p.xbc_raw + (size_t)(t0 + l0) * 1024 + ch0;
      uint4 z4 = make_uint4(0u, 0u, 0u, 0u);
      uint4 u0 = (lg >= 3) ? *(const uint4*)(src - 3 * 1024) : z4;
      uint4 u1 = (lg >= 2) ? *(const uint4*)(src - 2 * 1024) : z4;
      uint4 u2 = (lg >= 1) ? *(const uint4*)(src - 1 * 1024) : z4;
      unpack8(u0, r0); unpack8(u1, r1); unpack8(u2, r2);
    }
    unsigned outp[8][8];
    float lo[8], los[8];
#pragma unroll
    for (int i = 0; i < 16; ++i) {
      float cur[8], val[8];
      unpack8(*(const uint4*)(p.xbc_raw + (size_t)(t0 + l0 + i) * 1024 + ch0), cur);
#pragma unroll
      for (int j = 0; j < 8; ++j) {
        float v = bias[j];
        v = fmaf(w0[j], r0[j], v); v = fmaf(w1[j], r1[j], v); v = fmaf(w2[j], r2[j], v); v = fmaf(w3[j], cur[j], v);
        val[j] = silu_f(v);
        r0[j] = r1[j]; r1[j] = r2[j]; r2[j] = cur[j];
      }
      if (wr_nat) {
        *(uint4*)(p.xc + (size_t)(t0 + l0 + i) * 1024 + ch0) =
            make_uint4(pack2(val[0], val[1]), pack2(val[2], val[3]), pack2(val[4], val[5]), pack2(val[6], val[7]));
      }
      const float scl = is_x ? s_w[l0 + i] : 1.f;
      if ((i & 1) == 0) {
#pragma unroll
        for (int j = 0; j < 8; ++j) { lo[j] = val[j]; los[j] = val[j] * scl; }
      } else {
        const int chunk = seg * 2 + (i >> 3);
#pragma unroll
        for (int j = 0; j < 8; ++j) {
          outp[j][i >> 1] = pack2(lo[j], val[j]);
          if (is_x || is_b) *(unsigned*)(tbase + swz256(trow + j, chunk) + ((i & 7) - 1) * 2) = pack2(los[j], val[j] * scl);
        }
      }
    }
    if (is_x) {
      ushort_t* dst = p.xT + ((size_t)((b * 64 + c) * 8 + h) * 64 + cg * 8) * 128 + l0;
#pragma unroll
      for (int j = 0; j < 8; ++j) {
        *(uint4*)(dst + (size_t)j * 128) = make_uint4(outp[j][0], outp[j][1], outp[j][2], outp[j][3]);
        *(uint4*)(dst + (size_t)j * 128 + 8) = make_uint4(outp[j][4], outp[j][5], outp[j][6], outp[j][7]);
      }
    }
  }
  __syncthreads();
  {
    const int r = lane & 31, hl = lane >> 5;
    f32x16 acc[2];
#pragma unroll
    for (int e = 0; e < 16; ++e) { acc[0][e] = 0.f; acc[1][e] = 0.f; }
#pragma unroll
    for (int ks = 0; ks < 8; ++ks) {
      const bf16x8 bfr = *(const bf16x8*)(s_bt + swz256(32 * wave + r, ks * 2 + hl));
      const bf16x8 a0 = *(const bf16x8*)(s_xw + swz256(r, ks * 2 + hl));
      const bf16x8 a1 = *(const bf16x8*)(s_xw + swz256(32 + r, ks * 2 + hl));
      acc[0] = __builtin_amdgcn_mfma_f32_32x32x16_bf16(a0, bfr, acc[0], 0, 0, 0);
      acc[1] = __builtin_amdgcn_mfma_f32_32x32x16_bf16(a1, bfr, acc[1], 0, 0, 0);
    }
    float* dst = p.states + (size_t)((b * 64 + c) * 8 + h) * 64 * 128;
#pragma unroll
    for (int pt = 0; pt < 2; ++pt)
#pragma unroll
      for (int e = 0; e < 16; ++e) dst[(size_t)(pt * 32 + crow16(e, hl)) * 128 + 32 * wave + r] = acc[pt][e];
  }
}

__device__ __forceinline__ void ph_ssd2(const int vb, const Params& p) {
  const int idx = vb * 256 + threadIdx.x;
  const int pn = idx & 8191, h = (idx >> 13) & 7, b = idx >> 16;
  float st = 0.f;
#pragma unroll 1
  for (int c0 = 0; c0 < 64; c0 += 8) {
    float sv[8], dv[8];
#pragma unroll
    for (int i = 0; i < 8; ++i) {
      const int cc = (b * 64 + c0 + i) * 8 + h;
      sv[i] = p.states[(size_t)cc * 8192 + pn];
      dv[i] = p.cdec[cc];
    }
#pragma unroll
    for (int i = 0; i < 8; ++i) {
      const int cc = (b * 64 + c0 + i) * 8 + h;
      p.sin_b[(size_t)cc * 8192 + pn] = f2bf(st);
      st = fmaf(st, dv[i], sv[i]);
    }
  }
}

__device__ __forceinline__ void ph_ssd3(const int vb, char* smem, const Params& p) {
  const int g = vb & 1, c = (vb >> 1) & 63, b = vb >> 7;
  int tid = threadIdx.x;
  asm volatile("" : "+v"(tid));
  const int lane = tid & 63;
  const int w = __builtin_amdgcn_readfirstlane(tid >> 6);
  const int r = lane & 31, hl = lane >> 5;
  const int t0 = b * SL + c * 128;
  char* s_C = smem;
  char* s_B = smem + 34816;
  char* s_xT = smem + 34816;
  char* s_S = smem + 34816 + 16896;
  float* s_acs = (float*)(smem + 69632);
  float* s_dt = s_acs + 512;
  {
    const int ch = tid & 15, r0 = tid >> 4;
#pragma unroll
    for (int i = 0; i < 8; ++i) {
      const int row = r0 + 16 * i;
      const ushort_t* src = p.xc + (size_t)(t0 + row) * 1024 + g * 128 + ch * 8;
      *(uint4*)(s_B + swz256(row, ch)) = *(const uint4*)(src + 512);
      *(uint4*)(s_C + swz256(row, ch)) = *(const uint4*)(src + 768);
    }
    if (tid < 128) {
#pragma unroll
      for (int hh = 0; hh < 4; ++hh) {
        s_acs[hh * 128 + tid] = p.acs[(size_t)(t0 + tid) * 8 + g * 4 + hh];
        s_dt[hh * 128 + tid] = p.dt[(size_t)(t0 + tid) * 8 + g * 4 + hh];
      }
    }
  }
  __syncthreads();
  bf16x8 cfr[8];
#pragma unroll
  for (int ks = 0; ks < 8; ++ks) cfr[ks] = *(const bf16x8*)(s_C + swz256(32 * w + r, ks * 2 + hl));
  f32x16 gt[4];
#pragma unroll
  for (int st = 0; st < 4; ++st) {
#pragma unroll
    for (int e = 0; e < 16; ++e) gt[st][e] = 0.f;
    if (st <= w) {
#pragma unroll
      for (int ks = 0; ks < 8; ++ks) {
        const bf16x8 a = *(const bf16x8*)(s_B + swz256(32 * st + r, ks * 2 + hl));
        gt[st] = __builtin_amdgcn_mfma_f32_32x32x16_bf16(a, cfr[ks], gt[st], 0, 0, 0);
      }
    }
  }
  __syncthreads();
  float ssq = 0.f;
  const int lane_c = lane;
#pragma unroll 1
  for (int hh = 0; hh < 4; ++hh) {
    int lane_o = lane_c;
    asm volatile("" : "+v"(lane_o));
    const int r = lane_o & 31, hl = lane_o >> 5;
    const int l = 32 * w + r;
    const int hg = g * 4 + hh;
    {
      const int ch = tid & 15, r0 = tid >> 4;
      const size_t base = (size_t)((b * 64 + c) * 8 + hg) * 8192;
#pragma unroll
      for (int i = 0; i < 4; ++i) {
        const int row = r0 + 16 * i;
        const uint4 xv = *(const uint4*)(p.xT + base + (size_t)row * 128 + ch * 8);
        *(uint2*)(s_xT + row * 264 + ch * 16) = make_uint2(xv.x, xv.y);
        *(uint2*)(s_xT + row * 264 + ch * 16 + 8) = make_uint2(xv.z, xv.w);
        *(uint4*)(s_S + swz256(row, ch)) = *(const uint4*)(p.sin_b + base + (size_t)row * 128 + ch * 8);
      }
    }
    __syncthreads();
    const float acs_l = s_acs[hh * 128 + l];
    const float dsk = p.ssd_d[hg];
    f32x16 acc[2];
#pragma unroll
    for (int e = 0; e < 16; ++e) { acc[0][e] = 0.f; acc[1][e] = 0.f; }
#pragma unroll
    for (int ks = 0; ks < 8; ++ks) {
      const bf16x8 a0 = *(const bf16x8*)(s_S + swz256(r, ks * 2 + hl));
      const bf16x8 a1 = *(const bf16x8*)(s_S + swz256(32 + r, ks * 2 + hl));
      acc[0] = __builtin_amdgcn_mfma_f32_32x32x16_bf16(a0, cfr[ks], acc[0], 0, 0, 0);
      acc[1] = __builtin_amdgcn_mfma_f32_32x32x16_bf16(a1, cfr[ks], acc[1], 0, 0, 0);
    }
    {
      const float el = expf(acs_l);
#pragma unroll
      for (int e = 0; e < 16; ++e) { acc[0][e] *= el; acc[1][e] *= el; }
    }
#pragma unroll
    for (int st = 0; st < 4; ++st) {
      asm volatile("" ::: "memory");
      if (st <= w) {
        float m[16];
#pragma unroll
        for (int e = 0; e < 16; ++e) {
          const int sidx = 32 * st + crow16(e, hl);
          float v = gt[st][e] * __expf(acs_l - s_acs[hh * 128 + sidx]) * s_dt[hh * 128 + sidx];
          if (sidx > l) v = 0.f;
          if (sidx == l) v += dsk;
          m[e] = v;
        }
#pragma unroll
        for (int k2 = 0; k2 < 2; ++k2) {
          asm volatile("" ::: "memory");
          bf16x8 mf;
          {
            unsigned u0 = pack2(m[8 * k2 + 0], m[8 * k2 + 1]), u1 = pack2(m[8 * k2 + 2], m[8 * k2 + 3]);
            unsigned u2 = pack2(m[8 * k2 + 4], m[8 * k2 + 5]), u3 = pack2(m[8 * k2 + 6], m[8 * k2 + 7]);
            uint4 uu = make_uint4(u0, u1, u2, u3);
            mf = *(bf16x8*)&uu;
          }
          const int soff = (32 * st + 16 * k2 + 4 * hl) * 2;
#pragma unroll
          for (int pt = 0; pt < 2; ++pt) {
            const char* ap = s_xT + (pt * 32 + r) * 264 + soff;
            uint2 q0 = *(const uint2*)(ap);
            uint2 q1 = *(const uint2*)(ap + 16);
            uint4 qq = make_uint4(q0.x, q0.y, q1.x, q1.y);
            const bf16x8 af = *(bf16x8*)&qq;
            acc[pt] = __builtin_amdgcn_mfma_f32_32x32x16_bf16(af, mf, acc[pt], 0, 0, 0);
          }
        }
      }
    }
#pragma unroll
    for (int pt = 0; pt < 2; ++pt) {
#pragma unroll
      for (int q4 = 0; q4 < 4; ++q4) {
        asm volatile("" ::: "memory");
        const int p0 = pt * 32 + 8 * q4 + 4 * hl;
        const uint2 zz = *(const uint2*)(p.zs + (size_t)(t0 + l) * 512 + hg * 64 + p0);
        const float v0 = acc[pt][4 * q4 + 0] * bflo(zz.x), v1 = acc[pt][4 * q4 + 1] * bfhi(zz.x);
        const float v2 = acc[pt][4 * q4 + 2] * bflo(zz.y), v3 = acc[pt][4 * q4 + 3] * bfhi(zz.y);
        ssq += v0 * v0 + v1 * v1 + v2 * v2 + v3 * v3;
        *(uint2*)(p.mixed_b + (size_t)(t0 + l) * 1024 + hg * 64 + p0) = make_uint2(pack2(v0, v1), pack2(v2, v3));
      }
    }
    __syncthreads();
  }
  const int l = 32 * w + r;
  ssq += __shfl_xor(ssq, 32);
  const float rstd = rsqrtf(ssq * (1.f / 256.f) + EPS);
#pragma unroll 1
  for (int hh = 0; hh < 4; ++hh) {
#pragma unroll
    for (int pt = 0; pt < 2; ++pt) {
#pragma unroll
      for (int q4 = 0; q4 < 4; ++q4) {
        asm volatile("" ::: "memory");
        const int chn = (g * 4 + hh) * 64 + pt * 32 + 8 * q4 + 4 * hl;
        ushort_t* ptr = p.mixed_b + (size_t)(t0 + l) * 1024 + chn;
        const uint2 vv = *(const uint2*)ptr;
        const float4 nw = *(const float4*)(p.ssd_norm_w + chn);
        *(uint2*)ptr = make_uint2(pack2(bflo(vv.x) * rstd * nw.x, bfhi(vv.x) * rstd * nw.y),
                                  pack2(bflo(vv.y) * rstd * nw.z, bfhi(vv.y) * rstd * nw.w));
      }
    }
  }
}

__device__ __forceinline__ void k_gate(const int VB, char* smem, const Params& p) {
  const int own = VB & 31, bh = VB >> 5;
  if (own == 0) return;
  const int b = bh >> 2, h = bh & 3;
  const int tid = threadIdx.x;
  float* s_km = (float*)smem;
  int* s_cnt = (int*)(smem + 8192);
  int* s_base = s_cnt + 32;
  for (int i = tid; i < own * 64; i += 256) {
    const int n = i >> 6, d = i & 63;
    const float* kp = p.kpart + (size_t)(bh * 32 + n) * 256 + d;
    s_km[i] = (kp[0] + kp[64]) + (kp[128] + kp[192]);
  }
  if (tid < 32) s_cnt[tid] = 0;
  __syncthreads();
  const int l = own * 256 + tid;
  const int t = b * SL + l;
  float q[64];
  {
    const ushort_t* src = p.mq + (size_t)t * 256 + h * 64;
#pragma unroll
    for (int d = 0; d < 64; d += 8) {
      uint4 v = *(const uint4*)(src + d);
      q[d] = bflo(v.x); q[d + 1] = bfhi(v.x); q[d + 2] = bflo(v.y); q[d + 3] = bfhi(v.y);
      q[d + 4] = bflo(v.z); q[d + 5] = bfhi(v.z); q[d + 6] = bflo(v.w); q[d + 7] = bfhi(v.w);
    }
  }
  float v0 = -INFINITY, v1 = -INFINITY, v2 = -INFINITY;
  int i0 = 0, i1 = 1, i2 = 2;
  for (int n = 0; n < own; ++n) {
    const float* km = s_km + n * 64;
    float sa = 0.f, sb = 0.f;
#pragma unroll
    for (int d = 0; d < 64; d += 8) {
      const float4 a = *(const float4*)(km + d), c = *(const float4*)(km + d + 4);
      sa = fmaf(q[d], a.x, sa); sa = fmaf(q[d + 1], a.y, sa); sa = fmaf(q[d + 2], a.z, sa); sa = fmaf(q[d + 3], a.w, sa);
      sb = fmaf(q[d + 4], c.x, sb); sb = fmaf(q[d + 5], c.y, sb); sb = fmaf(q[d + 6], c.z, sb); sb = fmaf(q[d + 7], c.w, sb);
    }
    const float sv = sa + sb;
    if (sv > v0) { v2 = v1; i2 = i1; v1 = v0; i1 = i0; v0 = sv; i0 = n; }
    else if (sv > v1) { v2 = v1; i2 = i1; v1 = sv; i1 = n; }
    else if (sv > v2) { v2 = sv; i2 = n; }
  }
  const int nsel = own < 3 ? own : 3;
  int lp0 = 0, lp1 = 0, lp2 = 0;
  if (0 < nsel) lp0 = atomicAdd(s_cnt + i0, 1);
  if (1 < nsel) lp1 = atomicAdd(s_cnt + i1, 1);
  if (2 < nsel) lp2 = atomicAdd(s_cnt + i2, 1);
  __syncthreads();
  if (tid < own) s_base[tid] = s_cnt[tid] ? atomicAdd(p.bcnt + bh * 32 + tid, s_cnt[tid]) : 0;
  __syncthreads();
  if (0 < nsel) p.blist[(size_t)(bh * 32 + i0) * 8192 + s_base[i0] + lp0] = l | (0 << 13);
  if (1 < nsel) p.blist[(size_t)(bh * 32 + i1) * 8192 + s_base[i1] + lp1] = l | (1 << 13);
  if (2 < nsel) p.blist[(size_t)(bh * 32 + i2) * 8192 + s_base[i2] + lp2] = l | (2 << 13);
}

__device__ __forceinline__ void attn_unit(char* smem, const ushort_t* __restrict__ Kp, const int kstride, const ushort_t* __restrict__ VTp,
                                          const size_t vstride, const ushort_t* __restrict__ qrow, const float slope, const int qrel,
                                          const bool causal, const int nst, f32x16 (&o)[2], float& m_out, float& l_out) {
  int tid = threadIdx.x;
  asm volatile("" : "+v"(tid));
  const int lane = tid & 63, r = lane & 31, hl = lane >> 5;
  char* s_K = smem;
  char* s_VT = smem + 18432;
  bf16x8 qf[4];
#pragma unroll
  for (int ks = 0; ks < 4; ++ks) qf[ks] = *(const bf16x8*)(qrow + ks * 16 + hl * 8);
#pragma unroll
  for (int e = 0; e < 16; ++e) { o[0][e] = 0.f; o[1][e] = 0.f; }
  float m = -1e30f, lsum = 0.f;
#pragma unroll 1
  for (int st = 0; st < nst; ++st) {
    {
      const int kr = tid >> 3, kc = tid & 7;
#pragma unroll
      for (int i = 0; i < 4; ++i) {
        const int row = kr + 32 * i;
        *(uint4*)(s_K + row * 144 + kc * 16) = *(const uint4*)(Kp + (size_t)(st * 128 + row) * kstride + kc * 8);
      }
      const int vr = tid >> 4, vc = tid & 15;
#pragma unroll
      for (int i = 0; i < 4; ++i) {
        const int row = vr + 16 * i;
        const uint4 vv = *(const uint4*)(VTp + (size_t)row * vstride + st * 128 + vc * 8);
        *(uint2*)(s_VT + row * 264 + vc * 16) = make_uint2(vv.x, vv.y);
        *(uint2*)(s_VT + row * 264 + vc * 16 + 8) = make_uint2(vv.z, vv.w);
      }
    }
    __syncthreads();
    f32x16 sc[4];
#pragma unroll
    for (int kt = 0; kt < 4; ++kt) {
#pragma unroll
      for (int e = 0; e < 16; ++e) sc[kt][e] = 0.f;
#pragma unroll
      for (int ks = 0; ks < 4; ++ks) {
        const bf16x8 a = *(const bf16x8*)(s_K + (32 * kt + r) * 144 + (2 * ks + hl) * 16);
        sc[kt] = __builtin_amdgcn_mfma_f32_32x32x16_bf16(a, qf[ks], sc[kt], 0, 0, 0);
      }
    }
    float mx = -1e30f;
    const int qk0 = qrel - st * 128 - 4 * hl;
#pragma unroll
    for (int kt = 0; kt < 4; ++kt) {
#pragma unroll
      for (int e = 0; e < 16; ++e) {
        const int dist = qk0 - (32 * kt + (e & 3) + 8 * (e >> 2));
        float v = fmaf(sc[kt][e], 0.125f, -slope * (float)dist);
        if (causal && dist < 0) v = -1e30f;
        sc[kt][e] = v;
        mx = fmaxf(mx, v);
      }
    }
    mx = fmaxf(mx, __shfl_xor(mx, 32));
    const float mnew = fmaxf(m, mx);
    const float alpha = __expf(m - mnew);
    m = mnew;
    lsum *= alpha;
#pragma unroll
    for (int e = 0; e < 16; ++e) { o[0][e] *= alpha; o[1][e] *= alpha; }
#pragma unroll
    for (int kt = 0; kt < 4; ++kt) {
#pragma unroll
      for (int e = 0; e < 16; ++e) {
        const float pe = __expf(sc[kt][e] - mnew);
        sc[kt][e] = pe;
        lsum += pe;
      }
    }
#pragma unroll
    for (int kt = 0; kt < 4; ++kt) {
#pragma unroll
      for (int k2 = 0; k2 < 2; ++k2) {
        uint4 pu = make_uint4(pack2(sc[kt][8 * k2 + 0], sc[kt][8 * k2 + 1]), pack2(sc[kt][8 * k2 + 2], sc[kt][8 * k2 + 3]),
                              pack2(sc[kt][8 * k2 + 4], sc[kt][8 * k2 + 5]), pack2(sc[kt][8 * k2 + 6], sc[kt][8 * k2 + 7]));
        const bf16x8 pf = *(bf16x8*)&pu;
        const int koff = (32 * kt + 16 * k2 + 4 * hl) * 2;
#pragma unroll
        for (int dt = 0; dt < 2; ++dt) {
          const char* ap = s_VT + (dt * 32 + r) * 264 + koff;
          const uint2 q0 = *(const uint2*)(ap);
          const uint2 q1 = *(const uint2*)(ap + 16);
          uint4 qq = make_uint4(q0.x, q0.y, q1.x, q1.y);
          const bf16x8 af = *(bf16x8*)&qq;
          o[dt] = __builtin_amdgcn_mfma_f32_32x32x16_bf16(af, pf, o[dt], 0, 0, 0);
        }
      }
    }
    __syncthreads();
  }
  m_out = m;
  l_out = lsum + __shfl_xor(lsum, 32);
}

__device__ __forceinline__ void ph_attn_unit(const int kind, const int a0, const int a1, char* smem, const Params& p) {
  const int tid = threadIdx.x, lane = tid & 63, wave = tid >> 6, r = lane & 31, hl = lane >> 5;
  f32x16 o[2];
  float m, lt;
  if (kind == 2) {
    const int bh = a0, b = bh >> 2, h = bh & 3;
    const int t = b * SL + a1 * 128 + wave * 32 + r;
    attn_unit(smem, p.memk_b + (size_t)b * MEM * 256 + h * 64, 256, p.memvT + (size_t)bh * 64 * MEM, MEM, p.xq + (size_t)t * 256 + h * 64, 0.f,
              1 << 20, false, 2, o, m, lt);
    const float inv = 1.f / lt;
#pragma unroll
    for (int dt = 0; dt < 2; ++dt)
#pragma unroll
      for (int q4 = 0; q4 < 4; ++q4) {
        const int d = dt * 32 + 8 * q4 + 4 * hl;
        *(uint2*)(p.mixed_b + (size_t)t * DM + 768 + h * 64 + d) =
            make_uint2(pack2(o[dt][4 * q4] * inv, o[dt][4 * q4 + 1] * inv), pack2(o[dt][4 * q4 + 2] * inv, o[dt][4 * q4 + 3] * inv));
      }
    return;
  }
  int bh, l, slot, jblk, nst = 2;
  bool valid = true, causal = false;
  if (kind == 0) {
    bh = a0 >> 5; jblk = a0 & 31;
    const int cnt = p.bcnt[a0];
    int qi = a1 * 128 + wave * 32 + r;
    if (qi >= cnt) { valid = false; qi = 0; }
    const int ent = p.blist[(size_t)a0 * 8192 + qi];
    l = ent & 8191; slot = ent >> 13;
  } else {
    bh = a0 >> 5; jblk = a0 & 31;
    l = jblk * 256 + a1 * 128 + wave * 32 + r; slot = 3; causal = true;
    nst = a1 + 1;
  }
  const int b = bh >> 2, h = bh & 3;
  const int t = b * SL + l;
  const float slope = exp2f(-2.f * (float)(h + 1));
  attn_unit(smem, p.mk + (size_t)(b * SL + jblk * 256) * 256 + h * 64, 256, p.vT + (size_t)bh * 64 * SL + jblk * 256, SL,
            p.mq + (size_t)t * 256 + h * 64, slope, l - jblk * 256, causal, nst, o, m, lt);
  if (valid) {
    const float inv = 1.f / lt;
    const size_t pi = ((size_t)t * 4 + h) * 4 + slot;
#pragma unroll
    for (int dt = 0; dt < 2; ++dt)
#pragma unroll
      for (int q4 = 0; q4 < 4; ++q4) {
        const int d = dt * 32 + 8 * q4 + 4 * hl;
        *(uint2*)(p.pO + pi * 64 + d) =
            make_uint2(pack2(o[dt][4 * q4] * inv, o[dt][4 * q4 + 1] * inv), pack2(o[dt][4 * q4 + 2] * inv, o[dt][4 * q4 + 3] * inv));
      }
    if (hl == 0) { p.pm[pi] = m; p.pl[pi] = lt; }
  }
}

__device__ __forceinline__ void ph_attn_combine(const int VB, const Params& p) {
  const int i = VB * 256 + threadIdx.x;
  const int dq = i & 7, th = i >> 3;
  const int t = th >> 2;
  const int own = (t & (SL - 1)) >> 8;
  const int nsel = own < 3 ? own : 3;
  float mv[4], wv[4];
  float M = p.pm[(size_t)th * 4 + 3];
  mv[3] = M;
#pragma unroll
  for (int sl = 0; sl < 3; ++sl) {
    mv[sl] = (sl < nsel) ? p.pm[(size_t)th * 4 + sl] : -1e30f;
    M = fmaxf(M, mv[sl]);
  }
  float W = 0.f;
#pragma unroll
  for (int sl = 0; sl < 4; ++sl) {
    const bool on = (sl == 3) || (sl < nsel);
    wv[sl] = on ? p.pl[(size_t)th * 4 + sl] * __expf(mv[sl] - M) : 0.f;
    W += wv[sl];
  }
  float acc[8];
#pragma unroll
  for (int k = 0; k < 8; ++k) acc[k] = 0.f;
#pragma unroll
  for (int sl = 0; sl < 4; ++sl) {
    const bool on = (sl == 3) || (sl < nsel);
    if (on) {
      float f[8];
      unpack8(*(const uint4*)(p.pO + ((size_t)th * 4 + sl) * 64 + dq * 8), f);
#pragma unroll
      for (int k = 0; k < 8; ++k) acc[k] = fmaf(wv[sl], f[k], acc[k]);
    }
  }
  const float inv = 1.f / W;
  const int h = th & 3;
  *(uint4*)(p.mixed_b + (size_t)t * DM + 512 + h * 64 + dq * 8) =
      make_uint4(pack2(acc[0] * inv, acc[1] * inv), pack2(acc[2] * inv, acc[3] * inv), pack2(acc[4] * inv, acc[5] * inv), pack2(acc[6] * inv, acc[7] * inv));
}


__device__ __forceinline__ int mkkey(const float f, const int idx, const int mask) {
  int b = __float_as_int(f);
  b = (b & ~mask) | idx;
  return b ^ ((b >> 31) & 0x7fffffff);
}
__device__ __forceinline__ int key2bits(const int k) { return k ^ ((k >> 31) & 0x7fffffff); }
#define CEI(a, b) { const int _mx = max(a, b), _mn = min(a, b); a = _mx; b = _mn; }
template <int N>
__device__ __forceinline__ void bitonic_sort_desc(int (&v)[N]) {
#pragma unroll
  for (int k = 2; k <= N; k <<= 1) {
#pragma unroll
    for (int j = k >> 1; j > 0; j >>= 1) {
#pragma unroll
      for (int i = 0; i < N; ++i) {
        const int l = i ^ j;
        if (l > i) {
          if ((i & k) == 0) { CEI(v[i], v[l]); } else { CEI(v[l], v[i]); }
        }
      }
    }
  }
}
__device__ __forceinline__ void merge16(int (&a)[16], const int (&b)[16]) {
#pragma unroll
  for (int i = 0; i < 16; ++i) a[i] = max(a[i], b[15 - i]);
#pragma unroll
  for (int j = 8; j > 0; j >>= 1) {
#pragma unroll
    for (int i = 0; i < 16; ++i) {
      const int l = i ^ j;
      if (l > i) { CEI(a[i], a[l]); }
    }
  }
}
__device__ __forceinline__ void merge_partner(int (&a)[16], const int xmask) {
  int o[16];
#pragma unroll
  for (int i = 0; i < 16; ++i) o[i] = __shfl_xor(a[i], xmask);
  merge16(a, o);
}
__device__ __forceinline__ bf16x8 pack_hi8(const float (&x)[8], float (&res)[8]) {
  unsigned u[4];
#pragma unroll
  for (int i = 0; i < 4; ++i) {
    const ushort_t h0 = f2bf(x[2 * i]), h1 = f2bf(x[2 * i + 1]);
    res[2 * i] = x[2 * i] - bf2f(h0);
    res[2 * i + 1] = x[2 * i + 1] - bf2f(h1);
    u[i] = (unsigned)h0 | ((unsigned)h1 << 16);
  }
  uint4 uu = make_uint4(u[0], u[1], u[2], u[3]);
  return *(bf16x8*)&uu;
}
__device__ __forceinline__ bf16x8 pack_8(const float (&x)[8]) {
  uint4 uu = make_uint4(pack2(x[0], x[1]), pack2(x[2], x[3]), pack2(x[4], x[5]), pack2(x[6], x[7]));
  return *(bf16x8*)&uu;
}

__device__ __forceinline__ void ph_gemm_route(const int vb, char* smem, const Params& p, const ushort_t* __restrict__ hn_b) {
  const int head = vb & 7, tt = vb >> 3;
  const int m0 = head * 128, n0 = tt * 128;
  f32x16 acc[2][2];
  gemm_core(p.w_qT, hn_b, DM, m0, n0, smem, acc);
  int tid = threadIdx.x;
  asm volatile("" : "+v"(tid));
  const int lane = tid & 63, r = lane & 31, hl = lane >> 5;
  const int wave = tid >> 6, wm = wave >> 1, wn = wave & 1;
  int* s_top = (int*)(smem + 34816);
  {
    const int row = tid >> 1, part = tid & 1;
#pragma unroll
    for (int hf = 0; hf < 2; ++hf) {
      const ushort_t* src = p.skh + (size_t)(hf * 128 + row) * 64 + part * 32;
      char* dst = smem + (hf * 128 + row) * 136 + part * 64;
#pragma unroll
      for (int c = 0; c < 4; ++c) {
        const uint4 v = *(const uint4*)(src + c * 8);
        *(uint2*)(dst + c * 16) = make_uint2(v.x, v.y);
        *(uint2*)(dst + c * 16 + 8) = make_uint2(v.z, v.w);
      }
    }
  }
  __syncthreads();
  const char* s_keys = smem + wm * 128 * 136;
#pragma unroll
  for (int ni = 0; ni < 2; ++ni) {
    asm volatile("" ::: "memory");
    bf16x8 qh[4], ql[4];
#pragma unroll
    for (int mi = 0; mi < 2; ++mi) {
#pragma unroll
      for (int k2 = 0; k2 < 2; ++k2) {
        float x[8], res[8];
#pragma unroll
        for (int j = 0; j < 8; ++j) x[j] = acc[mi][ni][8 * k2 + j];
        qh[mi * 2 + k2] = pack_hi8(x, res);
        ql[mi * 2 + k2] = pack_8(res);
      }
    }
    int g0[16];
#pragma unroll
    for (int kh2 = 0; kh2 < 2; ++kh2) {
      int ga[16], gb[16];
#pragma unroll
      for (int kq = 0; kq < 2; ++kq) {
        const int kt = kh2 * 2 + kq;
        asm volatile("" ::: "memory");
        f32x16 sc;
#pragma unroll
        for (int e = 0; e < 16; ++e) sc[e] = 0.f;
#pragma unroll
        for (int st = 0; st < 4; ++st) {
          const int d0 = (st >> 1) * 32 + 16 * (st & 1) + 4 * hl;
          const char* kp = s_keys + (kt * 32 + r) * 136 + d0 * 2;
          const uint2 h0 = *(const uint2*)(kp), h1 = *(const uint2*)(kp + 16);
          uint4 hq = make_uint4(h0.x, h0.y, h1.x, h1.y);
          const bf16x8 ah = *(bf16x8*)&hq;
          sc = __builtin_amdgcn_mfma_f32_32x32x16_bf16(ah, qh[st], sc, 0, 0, 0);
          sc = __builtin_amdgcn_mfma_f32_32x32x16_bf16(ah, ql[st], sc, 0, 0, 0);
        }
        if (kq == 0) {
#pragma unroll
          for (int e = 0; e < 16; ++e) ga[e] = mkkey(sc[e], kt * 32 + (e & 3) + 8 * (e >> 2) + 4 * hl, 127);
          bitonic_sort_desc<16>(ga);
        } else {
#pragma unroll
          for (int e = 0; e < 16; ++e) gb[e] = mkkey(sc[e], kt * 32 + (e & 3) + 8 * (e >> 2) + 4 * hl, 127);
          bitonic_sort_desc<16>(gb);
        }
      }
      merge16(ga, gb);
      if (kh2 == 0) {
#pragma unroll
        for (int i = 0; i < 16; ++i) g0[i] = ga[i];
      } else {
        merge16(g0, ga);
      }
    }
    merge_partner(g0, 32);
    {
      int* dst = s_top + ((size_t)wm * 128 + wn * 64 + ni * 32 + r) * 16 + hl * 8;
      int4 w0, w1;
      int lo8[8], hi8[8];
#pragma unroll
      for (int i = 0; i < 8; ++i) { lo8[i] = g0[i]; hi8[i] = g0[8 + i]; asm volatile("" : "+v"(lo8[i]), "+v"(hi8[i])); }
      w0 = make_int4(hl ? hi8[0] : lo8[0], hl ? hi8[1] : lo8[1], hl ? hi8[2] : lo8[2], hl ? hi8[3] : lo8[3]);
      w1 = make_int4(hl ? hi8[4] : lo8[4], hl ? hi8[5] : lo8[5], hl ? hi8[6] : lo8[6], hl ? hi8[7] : lo8[7]);
      *(int4*)dst = w0; *(int4*)(dst + 4) = w1;
    }
  }
  __syncthreads();
  {
    const int tok = tid >> 1, sub = tid & 1;
    int k1[16], k2[16];
    {
      const int4* a = (const int4*)(s_top + (size_t)tok * 16);
      const int4* b = (const int4*)(s_top + (size_t)(128 + tok) * 16);
#pragma unroll
      for (int i = 0; i < 4; ++i) {
        const int4 x = a[i], y = b[i];
        k1[4 * i] = x.x; k1[4 * i + 1] = x.y; k1[4 * i + 2] = x.z; k1[4 * i + 3] = x.w;
        k2[4 * i] = y.x; k2[4 * i + 1] = y.y; k2[4 * i + 2] = y.z; k2[4 * i + 3] = y.w;
      }
    }
    float v1f[16], v2f[16];
#pragma unroll
    for (int i = 0; i < 16; ++i) { v1f[i] = __int_as_float(key2bits(k1[i])); v2f[i] = __int_as_float(key2bits(k2[i])); }
    int c[32];
    c[0] = sub ? mkkey(v1f[3] + v2f[3], 51, 255) : mkkey(v1f[0] + v2f[0], 0, 255);
    c[1] = sub ? mkkey(v1f[4] + v2f[0], 64, 255) : mkkey(v1f[0] + v2f[1], 1, 255);
    c[2] = sub ? mkkey(v1f[4] + v2f[1], 65, 255) : mkkey(v1f[0] + v2f[2], 2, 255);
    c[3] = sub ? mkkey(v1f[4] + v2f[2], 66, 255) : mkkey(v1f[0] + v2f[3], 3, 255);
    c[4] = sub ? mkkey(v1f[5] + v2f[0], 80, 255) : mkkey(v1f[0] + v2f[4], 4, 255);
    c[5] = sub ? mkkey(v1f[5] + v2f[1], 81, 255) : mkkey(v1f[0] + v2f[5], 5, 255);
    c[6] = sub ? mkkey(v1f[6] + v2f[0], 96, 255) : mkkey(v1f[0] + v2f[6], 6, 255);
    c[7] = sub ? mkkey(v1f[6] + v2f[1], 97, 255) : mkkey(v1f[0] + v2f[7], 7, 255);
    c[8] = sub ? mkkey(v1f[7] + v2f[0], 112, 255) : mkkey(v1f[0] + v2f[8], 8, 255);
    c[9] = sub ? mkkey(v1f[7] + v2f[1], 113, 255) : mkkey(v1f[0] + v2f[9], 9, 255);
    c[10] = sub ? mkkey(v1f[8] + v2f[0], 128, 255) : mkkey(v1f[0] + v2f[10], 10, 255);
    c[11] = sub ? mkkey(v1f[9] + v2f[0], 144, 255) : mkkey(v1f[0] + v2f[11], 11, 255);
    c[12] = sub ? mkkey(v1f[10] + v2f[0], 160, 255) : mkkey(v1f[0] + v2f[12], 12, 255);
    c[13] = sub ? mkkey(v1f[11] + v2f[0], 176, 255) : mkkey(v1f[0] + v2f[13], 13, 255);
    c[14] = sub ? mkkey(v1f[12] + v2f[0], 192, 255) : mkkey(v1f[0] + v2f[14], 14, 255);
    c[15] = sub ? mkkey(v1f[13] + v2f[0], 208, 255) : mkkey(v1f[0] + v2f[15], 15, 255);
    c[16] = sub ? mkkey(v1f[14] + v2f[0], 224, 255) : mkkey(v1f[1] + v2f[0], 16, 255);
    c[17] = sub ? mkkey(v1f[15] + v2f[0], 240, 255) : mkkey(v1f[1] + v2f[1], 17, 255);
    c[18] = sub ? (int)0x80000000 : mkkey(v1f[1] + v2f[2], 18, 255);
    c[19] = sub ? (int)0x80000000 : mkkey(v1f[1] + v2f[3], 19, 255);
    c[20] = sub ? (int)0x80000000 : mkkey(v1f[1] + v2f[4], 20, 255);
    c[21] = sub ? (int)0x80000000 : mkkey(v1f[1] + v2f[5], 21, 255);
    c[22] = sub ? (int)0x80000000 : mkkey(v1f[1] + v2f[6], 22, 255);
    c[23] = sub ? (int)0x80000000 : mkkey(v1f[1] + v2f[7], 23, 255);
    c[24] = sub ? (int)0x80000000 : mkkey(v1f[2] + v2f[0], 32, 255);
    c[25] = sub ? (int)0x80000000 : mkkey(v1f[2] + v2f[1], 33, 255);
    c[26] = sub ? (int)0x80000000 : mkkey(v1f[2] + v2f[2], 34, 255);
    c[27] = sub ? (int)0x80000000 : mkkey(v1f[2] + v2f[3], 35, 255);
    c[28] = sub ? (int)0x80000000 : mkkey(v1f[2] + v2f[4], 36, 255);
    c[29] = sub ? (int)0x80000000 : mkkey(v1f[3] + v2f[0], 48, 255);
    c[30] = sub ? (int)0x80000000 : mkkey(v1f[3] + v2f[1], 49, 255);
    c[31] = sub ? (int)0x80000000 : mkkey(v1f[3] + v2f[2], 50, 255);
    int h0[16], h1[16];
#pragma unroll
    for (int i = 0; i < 16; ++i) { h0[i] = c[i]; h1[i] = c[16 + i]; }
    bitonic_sort_desc<16>(h0); bitonic_sort_desc<16>(h1);
    merge16(h0, h1);
    merge_partner(h0, 1);
    float sv[16];
#pragma unroll
    for (int i = 0; i < 16; ++i) sv[i] = __int_as_float(key2bits(h0[i]));
    float den = 0.f;
#pragma unroll
    for (int i = 0; i < 16; ++i) den += __expf(sv[i] - sv[0]);
    const float inv = 1.f / den;
    int eo[8]; float go[8];
#pragma unroll
    for (int i = 0; i < 8; ++i) {
      int klo = h0[i], khi = h0[8 + i];
      asm volatile("" : "+v"(klo), "+v"(khi));
      const int kk = sub ? khi : klo;
      const int bits = key2bits(kk);
      const int code = bits & 255;
      const int ia = key2bits(s_top[(size_t)tok * 16 + (code >> 4)]) & 127;
      const int ib = key2bits(s_top[(size_t)(128 + tok) * 16 + (code & 15)]) & 127;
      eo[i] = ia * 128 + ib;
      go[i] = __expf(__int_as_float(bits) - sv[0]) * inv;
    }
    const size_t ob = ((size_t)(n0 + tok) * 8 + head) * 16 + sub * 8;
    *(int4*)(p.eidx + ob) = make_int4(eo[0], eo[1], eo[2], eo[3]);
    *(int4*)(p.eidx + ob + 4) = make_int4(eo[4], eo[5], eo[6], eo[7]);
    *(float4*)(p.egate + ob) = make_float4(go[0], go[1], go[2], go[3]);
    *(float4*)(p.egate + ob + 4) = make_float4(go[4], go[5], go[6], go[7]);
  }
}

__device__ __forceinline__ void ph_subkeys(const Params& p) {
  for (int i = blockIdx.x * 256 + threadIdx.x; i < 2 * 128 * 64; i += gridDim.x * 256) {
    const float v = (i < 8192) ? p.sk1[i] : p.sk2[i - 8192];
    const ushort_t hi = f2bf(v);
    p.skh[i] = hi;
    p.skl[i] = f2bf(v - bf2f(hi));
  }
}

__device__ __forceinline__ float dot16_fp8(const uint4 d, const float (&x)[16], float c) {
  const unsigned w[4] = {d.x, d.y, d.z, d.w};
#pragma unroll
  for (int i = 0; i < 4; ++i) {
    const f32x2_t lo = __builtin_amdgcn_cvt_pk_f32_fp8((int)w[i], false);
    const f32x2_t hi = __builtin_amdgcn_cvt_pk_f32_fp8((int)w[i], true);
    c = fmaf(lo.x, x[4 * i], c); c = fmaf(lo.y, x[4 * i + 1], c); c = fmaf(hi.x, x[4 * i + 2], c); c = fmaf(hi.y, x[4 * i + 3], c);
  }
  return c;
}
__device__ __forceinline__ void axpy16_fp8(const float cf, const uint4 u, float (&acc)[16]) {
  const unsigned w[4] = {u.x, u.y, u.z, u.w};
#pragma unroll
  for (int i = 0; i < 4; ++i) {
    const f32x2_t lo = __builtin_amdgcn_cvt_pk_f32_fp8((int)w[i], false);
    const f32x2_t hi = __builtin_amdgcn_cvt_pk_f32_fp8((int)w[i], true);
    acc[4 * i] = fmaf(cf, lo.x, acc[4 * i]); acc[4 * i + 1] = fmaf(cf, lo.y, acc[4 * i + 1]);
    acc[4 * i + 2] = fmaf(cf, hi.x, acc[4 * i + 2]); acc[4 * i + 3] = fmaf(cf, hi.y, acc[4 * i + 3]);
  }
}
__device__ __forceinline__ void k_peer_experts(const int VB, const Params& p, const ushort_t* __restrict__ hn) {
  const int lane = threadIdx.x & 63;
  const int wave = __builtin_amdgcn_readfirstlane(threadIdx.x >> 6);
  const int t = VB * 4 + wave;
  float x[16];
  {
    float f0[8], f1[8];
    unpack8(*(const uint4*)(hn + (size_t)t * DM + lane * 16), f0);
    unpack8(*(const uint4*)(hn + (size_t)t * DM + lane * 16 + 8), f1);
#pragma unroll
    for (int i = 0; i < 8; ++i) { x[i] = f0[i]; x[8 + i] = f1[i]; }
  }
  float acc[16];
#pragma unroll
  for (int i = 0; i < 16; ++i) acc[i] = 0.f;
  const int* ei = p.eidx + (size_t)t * 128;
  const float* eg = p.egate + (size_t)t * 128;
  const int myex = ((lane >> 5) & 1) * 4 + ((lane >> 4) & 1) * 2 + ((lane >> 3) & 1);
  const bool b5 = (lane & 32) != 0, b4 = (lane & 16) != 0, b3 = (lane & 8) != 0;
#pragma unroll 1
  for (int c = 0; c < 16; ++c) {
    int e[8];
#pragma unroll
    for (int i = 0; i < 8; ++i) e[i] = ei[c * 8 + i];
    uint4 d[8], u[8];
#pragma unroll
    for (int i = 0; i < 8; ++i) d[i] = *(const uint4*)(p.ed8 + (size_t)e[i] * DM + lane * 16);
#pragma unroll
    for (int i = 0; i < 8; ++i) u[i] = *(const uint4*)(p.eu8 + (size_t)e[i] * DM + lane * 16);
    const int me = ei[c * 8 + myex];
    const float gate = eg[c * 8 + myex];
    const float sdm = p.ed_s[me], sum = p.eu_s[me];
    float pr[8];
#pragma unroll
    for (int i = 0; i < 8; ++i) pr[i] = dot16_fp8(d[i], x, 0.f);
    float q4[4];
#pragma unroll
    for (int i = 0; i < 4; ++i) {
      const float snd = b5 ? pr[i] : pr[i + 4];
      const float kp = b5 ? pr[i + 4] : pr[i];
      q4[i] = kp + __shfl_xor(snd, 32);
    }
    float q2[2];
#pragma unroll
    for (int i = 0; i < 2; ++i) {
      const float snd = b4 ? q4[i] : q4[i + 2];
      const float kp = b4 ? q4[i + 2] : q4[i];
      q2[i] = kp + __shfl_xor(snd, 16);
    }
    float q1;
    {
      const float snd = b3 ? q2[0] : q2[1];
      const float kp = b3 ? q2[1] : q2[0];
      q1 = kp + __shfl_xor(snd, 8);
    }
    q1 += __shfl_xor(q1, 4);
    q1 += __shfl_xor(q1, 2);
    q1 += __shfl_xor(q1, 1);
    const float coef = gate * gelu_f(q1 * sdm) * sum;
#pragma unroll
    for (int i = 0; i < 8; ++i) {
      const int src = ((i >> 2) & 1) * 32 + ((i >> 1) & 1) * 16 + (i & 1) * 8;
      const float cf = __int_as_float(__builtin_amdgcn_readlane(__float_as_int(coef), src));
      axpy16_fp8(cf, u[i], acc);
    }
  }
  float* orow = p.out + (size_t)t * DM + lane * 16;
#pragma unroll
  for (int i = 0; i < 4; ++i) {
    float4 hv = *(float4*)(orow + i * 4);
    hv.x += acc[4 * i]; hv.y += acc[4 * i + 1]; hv.z += acc[4 * i + 2]; hv.w += acc[4 * i + 3];
    *(float4*)(orow + i * 4) = hv;
  }
}

#define PHASE(NBLK, CALL) \
  for (int VB = blockIdx.x; VB < (NBLK); VB += gridDim.x) { CALL; __syncthreads(); }
#define PHASE_NS(NBLK, CALL) \
  for (int VB = blockIdx.x; VB < (NBLK); VB += gridDim.x) { CALL; }
#define PHASE_OFF(OFF, NBLK, CALL) \
  for (int VB = (int)((blockIdx.x + gridDim.x - ((OFF) % gridDim.x)) % gridDim.x); VB < (NBLK); VB += gridDim.x) { CALL; __syncthreads(); }

__global__ __launch_bounds__(256, 2) void fwd_megakernel(Params p) {
  __shared__ __attribute__((aligned(16))) char smem_raw[SMEM_BYTES];
  float* smem = (float*)smem_raw;
  cg::grid_group grid = cg::this_grid();
  volatile LAS unsigned* xb_st = (volatile LAS unsigned*)(smem_raw + 73728);
  if (threadIdx.x == 0) { xb_st[0] = 0u; xb_st[1] = 0u; xb_st[2] = 0u; xb_st[3] = 0u; }
  __syncthreads();
  const XcdBarrier xb = xcd_barrier_post(p.bar, xb_st);
  PHASE_NS(NT / 4, ph_rmsnorm_bf16(VB, p.x, p.mix_norm_w, p.xn_b, p.w_in, p.dt_bias, p.dt));
  PHASE_NS(NB * MEM / 4, ph_rmsnorm_bf16(VB, p.mem, p.mem_norm_w, p.memn_b, nullptr, nullptr, nullptr));
  PHASE(16 * 40, ph_wtrans(VB, smem, p.w_in, INC, p.w_inT, 40, 8));
  PHASE(16 * 16, ph_wtrans(VB, smem, p.w_out, DM, p.w_outT, 16, 0));
  PHASE(16 * 16, ph_wtrans(VB, smem, p.w_query, DM, p.w_qT, 16, 0));
  PHASE(16 * 8, ph_wtrans(VB, smem, p.w_mem_kv, 512, p.w_memT, 8, 0));
  if (blockIdx.x == 0) p.bcnt[threadIdx.x] = 0;
  ph_subkeys(p);
  PHASE_NS(4096, ph_cvt8(VB, p.e_down, p.ed8, p.ed_s));
  PHASE_NS(4096, ph_cvt8(VB, p.e_up, p.eu8, p.eu_s));
  grid.sync();
  PHASE(20 * (NT / 128), ph_gemm_proj(VB, smem_raw, p));
  xcd_barrier(xb);
  PHASE(NB * 64 * 8, ph_ssd1(VB, smem_raw, p));
  PHASE(NB * 4 * 32, k_gate(VB, smem_raw, p));
  PHASE_OFF(256, 4 * (NB * MEM / 128), ph_gemm_mem(VB, smem_raw, p));
  xcd_barrier(xb);
  PHASE_NS(NB * 8 * 64 * 128 / 256, ph_ssd2(VB, p));
  {
    int* s_pref = (int*)(smem_raw + 72192);
    {
      const int tid = threadIdx.x;
      int v = (p.bcnt[tid] + 127) >> 7;
      const int lane = tid & 63;
#pragma unroll
      for (int o = 1; o < 64; o <<= 1) { int nb = __shfl_up(v, o); if (lane >= o) v += nb; }
      int* s_wt = s_pref + 256;
      if (lane == 63) s_wt[tid >> 6] = v;
      __syncthreads();
      int add = 0;
      for (int ww = 0; ww < (tid >> 6); ++ww) add += s_wt[ww];
      s_pref[tid] = v + add;
      __syncthreads();
    }
    const int Ug = s_pref[255];
    for (int u = blockIdx.x; u < Ug + NB * 4 * 32 * 2 + NB * 4 * 64; u += gridDim.x) {
      if (u >= Ug + NB * 4 * 32 * 2) {
        const int v = u - Ug - NB * 4 * 32 * 2;
        ph_attn_unit(2, v >> 6, v & 63, smem_raw, p);
      } else if (u < Ug) {
        int lo = 0, hi = 255;
        while (lo < hi) { int mid = (lo + hi) >> 1; if (s_pref[mid] > u) hi = mid; else lo = mid + 1; }
        const int prev = lo ? s_pref[lo - 1] : 0;
        ph_attn_unit(0, lo, u - prev, smem_raw, p);
      } else {
        const int v = u - Ug;
        ph_attn_unit(1, v >> 1, v & 1, smem_raw, p);
      }
      __syncthreads();
    }
  }
  xcd_barrier(xb);
  PHASE(NB * 64 * 2, ph_ssd3(VB, smem_raw, p));
  if (gridDim.x >= 512) {
    for (int VB = (int)blockIdx.x - 256; VB >= 0 && VB < NT * 4 * 8 / 256; VB += gridDim.x - 256) ph_attn_combine(VB, p);
  } else {
    PHASE_NS(NT * 4 * 8 / 256, ph_attn_combine(VB, p));
  }
  xcd_barrier(xb);
  PHASE(8 * (NT / 128), ph_gemm_f32(VB, smem_raw, p.mixed_b, p.w_outT, p.out, p.x));
  xcd_barrier(xb);
  ushort_t* hn_b = p.xn_b;
  PHASE_NS(NT / 4, ph_rmsnorm_bf16(VB, p.out, p.ffn_norm_w, hn_b, nullptr, nullptr, nullptr));
  xcd_barrier(xb);
  PHASE(8 * (NT / 128), ph_gemm_route(VB, smem_raw, p, hn_b));
  xcd_barrier(xb);
  PHASE_NS(NT / 4, k_peer_experts(VB, p, hn_b));
}
}

extern "C" void kernel_launch(void* const* d_in, const int* in_sizes, int n_in, void* d_out, int out_size, void* d_ws, size_t ws_size,
                              hipStream_t stream) {
  Params p{};
  p.x = (const float*)d_in[0]; p.mem = (const float*)d_in[1]; p.mix_norm_w = (const float*)d_in[2]; p.w_in = (const float*)d_in[3];
  p.conv_w = (const float*)d_in[4]; p.conv_b = (const float*)d_in[5]; p.dt_bias = (const float*)d_in[6]; p.a_log = (const float*)d_in[7];
  p.ssd_d = (const float*)d_in[8]; p.ssd_norm_w = (const float*)d_in[9]; p.mq_norm_w = (const float*)d_in[10]; p.mk_norm_w = (const float*)d_in[11];
  p.mem_norm_w = (const float*)d_in[12]; p.w_mem_kv = (const float*)d_in[13]; p.xq_norm_w = (const float*)d_in[14]; p.xk_norm_w = (const float*)d_in[15];
  p.w_out = (const float*)d_in[16]; p.ffn_norm_w = (const float*)d_in[17]; p.w_query = (const float*)d_in[18]; p.sk1 = (const float*)d_in[19];
  p.sk2 = (const float*)d_in[20]; p.e_down = (const float*)d_in[21]; p.e_up = (const float*)d_in[22];
  p.out = (float*)d_out;
  char* ws = (char*)d_ws;
  size_t o = 0;
  auto take = [&](size_t bytes) { char* q = ws + o; o += (bytes + 255) & ~(size_t)255; return q; };
  p.xn_b = (ushort_t*)take((size_t)NT * DM * 2);
  p.xc = p.xn_b;
  p.w_inT = (ushort_t*)take((size_t)NPROJ * DM * 2);
  p.w_outT = (ushort_t*)take((size_t)DM * DM * 2);
  p.w_qT = (ushort_t*)take((size_t)DM * DM * 2);
  p.w_memT = (ushort_t*)take((size_t)512 * DM * 2);
  p.memn_b = (ushort_t*)take((size_t)NB * MEM * DM * 2);
  p.memk_b = (ushort_t*)take((size_t)NB * MEM * 256 * 2);
  p.memvT = (ushort_t*)take((size_t)NB * MEM * 256 * 2);
  char* regQ = take((size_t)NT * 2560 * 2);
  p.zs = (ushort_t*)regQ;
  p.xbc_raw = (ushort_t*)(regQ + (size_t)NT * 512 * 2);
  p.mq = (ushort_t*)(regQ + (size_t)NT * 1536 * 2);
  p.mk = (ushort_t*)(regQ + (size_t)NT * 1792 * 2);
  p.vT = (ushort_t*)(regQ + (size_t)NT * 2048 * 2);
  p.xq = (ushort_t*)(regQ + (size_t)NT * 2304 * 2);
  p.q = (float*)regQ;
  p.dt = (float*)take((size_t)NT * 8 * 4);
  p.acs = (float*)take((size_t)NT * 8 * 4);
  p.cdec = (float*)take((size_t)NB * 64 * 8 * 4);
  p.states = (float*)d_out;
  p.sin_b = (ushort_t*)((char*)d_out + (size_t)NB * 64 * 8 * 8192 * 4);
  p.xT = (ushort_t*)((char*)d_out + (size_t)NB * 64 * 8 * 8192 * 6);
  p.mixed_b = (ushort_t*)take((size_t)NT * DM * 2);
  p.kpart = (float*)take((size_t)NB * 4 * 32 * 4 * 64 * 4);
  p.bcnt = (int*)take(256 * 4);
  p.blist = (int*)take((size_t)256 * 8192 * 4);
  p.pm = (float*)take((size_t)NT * 16 * 4);
  p.pl = (float*)take((size_t)NT * 16 * 4);
  p.pO = p.xbc_raw;
  p.eidx = (int*)take((size_t)NT * 128 * 4);
  p.egate = (float*)take((size_t)NT * 128 * 4);
  p.ed8 = (unsigned char*)take((size_t)16384 * DM);
  p.eu8 = (unsigned char*)take((size_t)16384 * DM);
  p.ed_s = (float*)take(16384 * 4);
  p.eu_s = (float*)take(16384 * 4);
  p.bar = (unsigned*)take(XCD_BAR_WORDS * 4);
  p.skh = (ushort_t*)take(2 * 128 * 64 * 2);
  p.skl = (ushort_t*)take(2 * 128 * 64 * 2);
  if (o > ws_size) return;
  (void)hipMemsetAsync(p.bar, 0, XCD_BAR_WORDS * 4, stream);
  static int grid_blocks = 0;
  if (!grid_blocks) {
    int dev = 0, cus = 0, per_cu = 0;
    (void)hipGetDevice(&dev);
    (void)hipDeviceGetAttribute(&cus, hipDeviceAttributeMultiprocessorCount, dev);
    (void)hipOccupancyMaxActiveBlocksPerMultiprocessor(&per_cu, fwd_megakernel, 256, 0);
    if (per_cu > 2) per_cu = 2;
    if (per_cu < 1) per_cu = 1;
    grid_blocks = cus * per_cu;
  }
  void* args[] = {&p};
  hipError_t e = hipLaunchCooperativeKernel((void*)fwd_megakernel, dim3(grid_blocks), dim3(256), args, 0, stream);
  if (e != hipSuccess) fprintf(stderr, "cooperative launch failed: %s (grid %d)\n", hipGetErrorString(e), grid_blocks);
}
```

```cpp
#include <hip/hip_runtime.h>
#include <hip/hip_cooperative_groups.h>
#include <cstdio>
#include <math.h>
#include <stdint.h>
namespace cg = cooperative_groups;

#ifndef EX_FP4_DOWN
#define EX_FP4_DOWN 1
#endif
#ifndef EX_FP4_UP
#define EX_FP4_UP 1
#endif
namespace {
typedef unsigned short ushort_t;
typedef __attribute__((ext_vector_type(8))) short bf16x8;
typedef __attribute__((ext_vector_type(16))) float f32x16;

constexpr int DM = 1024;
constexpr int NB = 2;
constexpr int SL = 8192;
constexpr int NT = NB * SL;
constexpr int MEM = 256;
constexpr int INC = 2568;
constexpr int NPROJ = 2560;
constexpr float EPS = 1e-6f;
constexpr int SMEM_BYTES = 73728 + 256;

__device__ __forceinline__ float silu_f(float x) { return x / (1.f + expf(-x)); }
__device__ __forceinline__ float softplus_f(float x) { return fmaxf(x, 0.f) + log1pf(expf(-fabsf(x))); }
__device__ __forceinline__ float gelu_f(float x) { return 0.5f * x * (1.f + erff(x * 0.70710678118654752f)); }
__device__ __forceinline__ ushort_t f2bf(float x) {
  unsigned u = __float_as_uint(x);
  u += 0x7fffu + ((u >> 16) & 1u);
  return (ushort_t)(u >> 16);
}
__device__ __forceinline__ float bf2f(ushort_t h) { return __uint_as_float(((unsigned)h) << 16); }
__device__ __forceinline__ float bflo(unsigned w) { return __uint_as_float(w << 16); }
__device__ __forceinline__ float bfhi(unsigned w) { return __uint_as_float(w & 0xffff0000u); }
__device__ __forceinline__ unsigned pack2(float a, float b) { return (unsigned)f2bf(a) | ((unsigned)f2bf(b) << 16); }

__device__ __forceinline__ void unpack8(const uint4 v, float (&f)[8]) {
  f[0] = bflo(v.x); f[1] = bfhi(v.x); f[2] = bflo(v.y); f[3] = bfhi(v.y);
  f[4] = bflo(v.z); f[5] = bfhi(v.z); f[6] = bflo(v.w); f[7] = bfhi(v.w);
}

__device__ __forceinline__ float wave_sum(float v) {
#pragma unroll
  for (int o = 32; o > 0; o >>= 1) v += __shfl_xor(v, o);
  return v;
}
__device__ __forceinline__ float wave_max(float v) {
#pragma unroll
  for (int o = 32; o > 0; o >>= 1) v = fmaxf(v, __shfl_xor(v, o));
  return v;
}


#define XB_TMO      128
#define XB_XCNT(j)  (256  + 64 * (j))
#define XB_XSUB(j)  (1280 + 64 * (j))
#define XB_XGEN(j)  (2304 + 64 * (j))
#define XB_TOP      3328
#define XB_TOPGEN   3392
#define XCD_BAR_WORDS 3456
#define XB_SPIN_CAP (1u << 20)
#define LAS __attribute__((address_space(3)))
__device__ __forceinline__ unsigned xb_ld(unsigned* p)              { return __hip_atomic_load(p, __ATOMIC_RELAXED, __HIP_MEMORY_SCOPE_AGENT); }
__device__ __forceinline__ unsigned xb_add(unsigned* p, unsigned v) { return __hip_atomic_fetch_add(p, v, __ATOMIC_RELAXED, __HIP_MEMORY_SCOPE_AGENT); }
__device__ __forceinline__ unsigned xb_xcc_id() { return (unsigned)__builtin_amdgcn_s_getreg((3 << 11) | 20) & 0xFu; }
#define XB_SPIN(cond, bar) do { unsigned _sp = 0; while (cond) { __builtin_amdgcn_s_sleep(1); \
    if ((++_sp & 255u) == 0u) { if (xb_ld(&(bar)[XB_TMO])) break; if (_sp > XB_SPIN_CAP) { atomicAdd(&(bar)[XB_TMO], 1u); break; } } } } while (0)
struct XcdBarrier { unsigned* bar; unsigned x; volatile LAS unsigned* st; };
__device__ __forceinline__ XcdBarrier xcd_barrier_post(unsigned* bar, volatile LAS unsigned* st) {
  XcdBarrier b; b.bar = bar; b.x = xb_xcc_id(); b.st = st;
  if (threadIdx.x == 0) (void)xb_add(&bar[XB_XCNT(b.x)], 1u);
  return b;
}
__device__ __forceinline__ void xcd_barrier_complete(unsigned* bar, unsigned x, unsigned& nloc, unsigned& nx) {
  const unsigned G = gridDim.x * gridDim.y * gridDim.z;
  unsigned sum, cnt, mine, sp = 0u;
  for (;;) {
    sum = 0u; cnt = 0u; mine = 0u;
#pragma unroll
    for (unsigned j = 0; j < 16; ++j) { const unsigned c = xb_ld(&bar[XB_XCNT(j)]); sum += c; cnt += (c > 0u) ? 1u : 0u; mine = (j == x) ? c : mine; }
    if (sum == G) break;
    __builtin_amdgcn_s_sleep(1);
    if ((++sp & 255u) == 0u) { if (xb_ld(&bar[XB_TMO])) break; if (sp > XB_SPIN_CAP) { atomicAdd(&bar[XB_TMO], 1u); break; } }
  }
  nloc = mine > 0u ? mine : 1u; nx = cnt > 0u ? cnt : 1u;
}
__device__ __forceinline__ void xcd_barrier(const XcdBarrier& b) {
  asm volatile("s_waitcnt vmcnt(0)" ::: "memory");
  __syncthreads();
  if (threadIdx.x == 0) {
    unsigned* bar = b.bar;
    __builtin_amdgcn_s_waitcnt(0);
    unsigned nloc = b.st[0], nx = b.st[1];
    if (nloc == 0u) { xcd_barrier_complete(bar, b.x, nloc, nx); b.st[0] = nloc; b.st[1] = nx; }
    const unsigned old = xb_add(&bar[XB_XSUB(b.x)], 1u);
    const unsigned gen = old / nloc;
    if (old + 1u == (gen + 1u) * nloc) {
      __builtin_amdgcn_fence(__ATOMIC_RELEASE, "agent");
      asm volatile("s_waitcnt vmcnt(0)" ::: "memory");
      const unsigned og = xb_add(&bar[XB_TOP], 1u);
      const unsigned tg = og / nx;
      if (og + 1u == (tg + 1u) * nx) xb_add(&bar[XB_TOPGEN], 1u);
      else XB_SPIN(xb_ld(&bar[XB_TOPGEN]) == tg, bar);
      __builtin_amdgcn_fence(__ATOMIC_ACQUIRE, "agent");
      xb_add(&bar[XB_XGEN(b.x)], 1u);
      asm volatile("s_waitcnt vmcnt(0)" ::: "memory");
    } else {
      XB_SPIN(xb_ld(&bar[XB_XGEN(b.x)]) == gen, bar);
      __builtin_amdgcn_fence(__ATOMIC_ACQUIRE, "agent");
      asm volatile("s_waitcnt vmcnt(0)" ::: "memory");
    }
  }
  __syncthreads();
}

struct Params {
  const float *x, *mem, *mix_norm_w, *w_in, *conv_w, *conv_b, *dt_bias, *a_log, *ssd_d, *ssd_norm_w, *mq_norm_w, *mk_norm_w,
      *mem_norm_w, *w_mem_kv, *xq_norm_w, *xk_norm_w, *w_out, *ffn_norm_w, *w_query, *sk1, *sk2, *e_down, *e_up;
  float* out;
  ushort_t *xn_b, *w_inT, *w_outT, *w_qT, *w_memT, *memn_b, *zs, *xbc_raw, *mq, *mk, *xq, *memk_b, *mixed_b;
  float *dt, *q, *egate, *acs, *cdec, *states;
  ushort_t *xc, *xT, *sin_b;
  int *eidx, *bcnt, *blist;
  unsigned* bar;
  ushort_t *skh, *skl;
  unsigned char *ed8, *eu8;
  float *ed_s, *eu_s;
  float *kpart, *pm, *pl;
  ushort_t *vT, *memvT, *pO;
};

__device__ __forceinline__ void ph_rmsnorm_bf16(const int vb, const float* __restrict__ x, const float* __restrict__ w,
                                                ushort_t* __restrict__ outb, const float* s_wdt  , const float* __restrict__ dt_bias,
                                                float* __restrict__ dt) {
  const int lane = threadIdx.x & 63;
  const int row0 = vb * 8 + (threadIdx.x >> 6) * 2;
  float4 v[2][4];
#pragma unroll
  for (int rr = 0; rr < 2; ++rr)
#pragma unroll
    for (int i = 0; i < 4; ++i) v[rr][i] = *(const float4*)(x + (size_t)(row0 + rr) * DM + i * 256 + lane * 4);
  float4 ww[4];
#pragma unroll
  for (int i = 0; i < 4; ++i) ww[i] = *(const float4*)(w + i * 256 + lane * 4);
#pragma unroll
  for (int rr = 0; rr < 2; ++rr) {
    const int row = row0 + rr;
    float ss = 0.f;
#pragma unroll
    for (int i = 0; i < 4; ++i) ss += v[rr][i].x * v[rr][i].x + v[rr][i].y * v[rr][i].y + v[rr][i].z * v[rr][i].z + v[rr][i].w * v[rr][i].w;
    ss = wave_sum(ss);
    const float r = rsqrtf(ss / DM + EPS);
    float part[8];
#pragma unroll
    for (int hh = 0; hh < 8; ++hh) part[hh] = 0.f;
#pragma unroll
    for (int i = 0; i < 4; ++i) {
      const float o0 = v[rr][i].x * r * ww[i].x, o1 = v[rr][i].y * r * ww[i].y, o2 = v[rr][i].z * r * ww[i].z, o3 = v[rr][i].w * r * ww[i].w;
      *(uint2*)(outb + (size_t)row * DM + i * 256 + lane * 4) = make_uint2(pack2(o0, o1), pack2(o2, o3));
      if (dt) {
        const float xs[4] = {o0, o1, o2, o3};
#pragma unroll
        for (int hh = 0; hh < 8; ++hh) {
          const float4 wv = *(const float4*)(s_wdt + hh * 1024 + i * 256 + lane * 4);
          part[hh] = fmaf(xs[0], wv.x, part[hh]); part[hh] = fmaf(xs[1], wv.y, part[hh]);
          part[hh] = fmaf(xs[2], wv.z, part[hh]); part[hh] = fmaf(xs[3], wv.w, part[hh]);
        }
      }
    }
    if (dt) {
      float mine = 0.f;
#pragma unroll
      for (int hh = 0; hh < 8; ++hh) {
        const float sfull = wave_sum(part[hh]);
        if (lane == hh) mine = sfull;
      }
      if (lane < 8) dt[(size_t)row * 8 + lane] = softplus_f(mine + dt_bias[lane]);
    }
  }
}

__device__ __forceinline__ void ph_wtrans(const int vb, float* smem, const float* __restrict__ W, const int ldw, ushort_t* __restrict__ Wt,
                                          const int ntiles, const int skip) {
  float (*s)[65] = (float (*)[65])smem;
  const int tid = threadIdx.x;
  const int kt = vb / ntiles, nt = vb % ntiles;
  const int nd0 = nt * 64;
  const int ns0 = (nd0 < 1536) ? nd0 : nd0 + skip;
  {
    const int k = tid >> 2, nc = (tid & 3) * 16;
    const float* src = W + (size_t)(kt * 64 + k) * ldw + ns0 + nc;
#pragma unroll
    for (int j = 0; j < 4; ++j) {
      float4 v = *(const float4*)(src + j * 4);
      s[k][nc + j * 4 + 0] = v.x; s[k][nc + j * 4 + 1] = v.y; s[k][nc + j * 4 + 2] = v.z; s[k][nc + j * 4 + 3] = v.w;
    }
  }
  __syncthreads();
  {
    const int n = tid >> 2, kc = (tid & 3) * 16;
    unsigned pk[8];
#pragma unroll
    for (int j = 0; j < 8; ++j) pk[j] = pack2(s[kc + 2 * j][n], s[kc + 2 * j + 1][n]);
    ushort_t* dst = Wt + (size_t)(nd0 + n) * DM + kt * 64 + kc;
    *(uint4*)(dst) = make_uint4(pk[0], pk[1], pk[2], pk[3]);
    *(uint4*)(dst + 8) = make_uint4(pk[4], pk[5], pk[6], pk[7]);
  }
}

__device__ __forceinline__ void ph_cvt(const int vb, const float* __restrict__ src, ushort_t* __restrict__ dst) {
  const size_t base = (size_t)vb * 8192 + threadIdx.x * 8;
  float4 a[4], b[4];
#pragma unroll
  for (int i = 0; i < 4; ++i) {
    a[i] = *(const float4*)(src + base + i * 2048);
    b[i] = *(const float4*)(src + base + i * 2048 + 4);
  }
#pragma unroll
  for (int i = 0; i < 4; ++i)
    *(uint4*)(dst + base + i * 2048) = make_uint4(pack2(a[i].x, a[i].y), pack2(a[i].z, a[i].w), pack2(b[i].x, b[i].y), pack2(b[i].z, b[i].w));
}


typedef __attribute__((ext_vector_type(2))) float f32x2_t;
__device__ __forceinline__ void ph_cvt8(const int vb, const float* __restrict__ src, unsigned char* __restrict__ dst, float* __restrict__ inv_scale) {
  const int lane = threadIdx.x & 63;
  const int row = vb * 4 + (threadIdx.x >> 6);
  const float* sr = src + (size_t)row * DM + lane * 16;
  float4 v[4];
#pragma unroll
  for (int i = 0; i < 4; ++i) v[i] = *(const float4*)(sr + i * 4);
  float am = 0.f;
#pragma unroll
  for (int i = 0; i < 4; ++i) am = fmaxf(fmaxf(fmaxf(am, fabsf(v[i].x)), fmaxf(fabsf(v[i].y), fabsf(v[i].z))), fabsf(v[i].w));
  am = wave_max(am);
  const float sc = (am > 0.f) ? 224.f / am : 1.f;
  unsigned w[4];
#pragma unroll
  for (int i = 0; i < 4; ++i) {
    int t = 0;
    t = __builtin_amdgcn_cvt_pk_fp8_f32(v[i].x * sc, v[i].y * sc, t, false);
    t = __builtin_amdgcn_cvt_pk_fp8_f32(v[i].z * sc, v[i].w * sc, t, true);
    w[i] = (unsigned)t;
  }
  *(uint4*)(dst + (size_t)row * DM + lane * 16) = make_uint4(w[0], w[1], w[2], w[3]);
  if (lane == 0) inv_scale[row] = (am > 0.f) ? am * (1.f / 224.f) : 1.f;
}

__device__ __forceinline__ void ph_cvt4(const int vb, const float* __restrict__ src, unsigned char* __restrict__ dst, float* __restrict__ inv_scale) {
  const int lane = threadIdx.x & 63;
  const int row = vb * 4 + (threadIdx.x >> 6);
  const float* sr = src + (size_t)row * DM + lane * 16;
  float4 v[4];
#pragma unroll
  for (int i = 0; i < 4; ++i) v[i] = *(const float4*)(sr + i * 4);
  float am = 0.f;
#pragma unroll
  for (int i = 0; i < 4; ++i) am = fmaxf(fmaxf(fmaxf(am, fabsf(v[i].x)), fmaxf(fabsf(v[i].y), fabsf(v[i].z))), fabsf(v[i].w));
  am = wave_max(am);
  const float sc = (am > 0.f) ? 6.f / am : 1.f;
  unsigned w0 = 0u, w1 = 0u;
  w0 = __builtin_amdgcn_cvt_scalef32_pk_fp4_f32(w0, v[0].x * sc, v[0].y * sc, 1.0f, 0);
  w0 = __builtin_amdgcn_cvt_scalef32_pk_fp4_f32(w0, v[0].z * sc, v[0].w * sc, 1.0f, 1);
  w0 = __builtin_amdgcn_cvt_scalef32_pk_fp4_f32(w0, v[1].x * sc, v[1].y * sc, 1.0f, 2);
  w0 = __builtin_amdgcn_cvt_scalef32_pk_fp4_f32(w0, v[1].z * sc, v[1].w * sc, 1.0f, 3);
  w1 = __builtin_amdgcn_cvt_scalef32_pk_fp4_f32(w1, v[2].x * sc, v[2].y * sc, 1.0f, 0);
  w1 = __builtin_amdgcn_cvt_scalef32_pk_fp4_f32(w1, v[2].z * sc, v[2].w * sc, 1.0f, 1);
  w1 = __builtin_amdgcn_cvt_scalef32_pk_fp4_f32(w1, v[3].x * sc, v[3].y * sc, 1.0f, 2);
  w1 = __builtin_amdgcn_cvt_scalef32_pk_fp4_f32(w1, v[3].z * sc, v[3].w * sc, 1.0f, 3);
  *(uint2*)(dst + (size_t)row * (DM / 2) + lane * 8) = make_uint2(w0, w1);
  if (lane == 0) inv_scale[row] = (am > 0.f) ? am * (1.f / 6.f) : 1.f;
}
__device__ __forceinline__ void dec16_fp8(const uint4 d, f32x2_t (&o)[8]) {
  const unsigned w[4] = {d.x, d.y, d.z, d.w};
#pragma unroll
  for (int k = 0; k < 4; ++k) {
    o[2 * k] = __builtin_amdgcn_cvt_pk_f32_fp8((int)w[k], false);
    o[2 * k + 1] = __builtin_amdgcn_cvt_pk_f32_fp8((int)w[k], true);
  }
}
__device__ __forceinline__ void dec16_fp4(const uint2 d, f32x2_t (&o)[8]) {
  o[0] = __builtin_amdgcn_cvt_scalef32_pk_f32_fp4(d.x, 1.0f, 0); o[1] = __builtin_amdgcn_cvt_scalef32_pk_f32_fp4(d.x, 1.0f, 1);
  o[2] = __builtin_amdgcn_cvt_scalef32_pk_f32_fp4(d.x, 1.0f, 2); o[3] = __builtin_amdgcn_cvt_scalef32_pk_f32_fp4(d.x, 1.0f, 3);
  o[4] = __builtin_amdgcn_cvt_scalef32_pk_f32_fp4(d.y, 1.0f, 0); o[5] = __builtin_amdgcn_cvt_scalef32_pk_f32_fp4(d.y, 1.0f, 1);
  o[6] = __builtin_amdgcn_cvt_scalef32_pk_f32_fp4(d.y, 1.0f, 2); o[7] = __builtin_amdgcn_cvt_scalef32_pk_f32_fp4(d.y, 1.0f, 3);
}
#if EX_FP4_DOWN
typedef uint2 drow_t;
#define DROW_BYTES 8
#define DEC_D dec16_fp4
#else
typedef uint4 drow_t;
#define DROW_BYTES 16
#define DEC_D dec16_fp8
#endif
#if EX_FP4_UP
typedef uint2 urow_t;
#define UROW_BYTES 8
#define DEC_U dec16_fp4
#else
typedef uint4 urow_t;
#define UROW_BYTES 16
#define DEC_U dec16_fp8
#endif

__device__ __forceinline__ int swz(int row, int ch) { return row * 128 + ((ch ^ ((row >> 1) & 7)) << 4); }

__device__ __forceinline__ void gemm_compute(const char* cA, const char* cB, const int arow, const int brow, const int xr, const int h,
                                             f32x16 (&acc)[2][2]) {
#pragma unroll
  for (int ks = 0; ks < 4; ++ks) {
    const int co = ((ks * 2 + h) ^ xr) << 4;
    bf16x8 a0 = *(const bf16x8*)(cA + arow + co);
    bf16x8 a1 = *(const bf16x8*)(cA + arow + 32 * 128 + co);
    bf16x8 b0 = *(const bf16x8*)(cB + brow + co);
    bf16x8 b1 = *(const bf16x8*)(cB + brow + 32 * 128 + co);
    acc[0][0] = __builtin_amdgcn_mfma_f32_32x32x16_bf16(a0, b0, acc[0][0], 0, 0, 0);
    acc[0][1] = __builtin_amdgcn_mfma_f32_32x32x16_bf16(a0, b1, acc[0][1], 0, 0, 0);
    acc[1][0] = __builtin_amdgcn_mfma_f32_32x32x16_bf16(a1, b0, acc[1][0], 0, 0, 0);
    acc[1][1] = __builtin_amdgcn_mfma_f32_32x32x16_bf16(a1, b1, acc[1][1], 0, 0, 0);
  }
}

#define STG_LOAD(P, koff) \
  P##a0 = *(const uint4*)(Ag + (koff)); P##a1 = *(const uint4*)(Ag + rs + (koff)); P##a2 = *(const uint4*)(Ag + 2 * rs + (koff)); P##a3 = *(const uint4*)(Ag + 3 * rs + (koff)); \
  P##b0 = *(const uint4*)(Bg + (koff)); P##b1 = *(const uint4*)(Bg + rs + (koff)); P##b2 = *(const uint4*)(Bg + 2 * rs + (koff)); P##b3 = *(const uint4*)(Bg + 3 * rs + (koff));
#define STG_STORE(P, buf) \
  *(uint4*)((buf) + w0) = P##a0; *(uint4*)((buf) + w1) = P##a1; *(uint4*)((buf) + w2) = P##a2; *(uint4*)((buf) + w3) = P##a3; \
  *(uint4*)((buf) + 16384 + w0) = P##b0; *(uint4*)((buf) + 16384 + w1) = P##b1; *(uint4*)((buf) + 16384 + w2) = P##b2; *(uint4*)((buf) + 16384 + w3) = P##b3;
__device__ __forceinline__ void gemm_core(const ushort_t* __restrict__ A, const ushort_t* __restrict__ Bt, const int K, const int m0,
                                          const int n0, char* smem, f32x16 (&acc)[2][2]) {
  int tid = threadIdx.x;
  asm volatile("" : "+v"(tid));
  const int lane = tid & 63, wave = tid >> 6;
  const int wm = wave >> 1, wn = wave & 1;
  const int r = lane & 31, h = lane >> 5;
  const int srow = tid >> 3, sch = tid & 7;
  const ushort_t* Ag = A + (size_t)(m0 + srow) * K + sch * 8;
  const ushort_t* Bg = Bt + (size_t)(n0 + srow) * K + sch * 8;
  const size_t rs = (size_t)32 * K;
  uint4 Ra0, Ra1, Ra2, Ra3, Rb0, Rb1, Rb2, Rb3;
  uint4 Sa0, Sa1, Sa2, Sa3, Sb0, Sb1, Sb2, Sb3;
  STG_LOAD(R, 0)
#pragma unroll
  for (int i = 0; i < 2; ++i)
#pragma unroll
    for (int j = 0; j < 2; ++j)
#pragma unroll
      for (int e = 0; e < 16; ++e) acc[i][j][e] = 0.f;
  const int w0 = swz(srow, sch), w1 = swz(srow + 32, sch), w2 = swz(srow + 64, sch), w3 = swz(srow + 96, sch);
  char* buf0 = smem;
  char* buf1 = smem + 32768;
  STG_STORE(R, buf0)
  STG_LOAD(R, 64)
  STG_LOAD(S, 128)
  __syncthreads();
  const int nk = K >> 6;
  const int xr = (r >> 1) & 7;
  const int arow = (wm * 64 + r) * 128, brow = (wn * 64 + r) * 128;
#pragma unroll 1
  for (int kt = 0; kt < nk; kt += 2) {
    STG_STORE(R, buf1)
    { const int kn = (kt + 3 < nk) ? (kt + 3) : (nk - 1); STG_LOAD(R, kn * 64) }
    gemm_compute(buf0, buf0 + 16384, arow, brow, xr, h, acc);
    __syncthreads();
    STG_STORE(S, buf0)
    { const int kn = (kt + 4 < nk) ? (kt + 4) : (nk - 1); STG_LOAD(S, kn * 64) }
    gemm_compute(buf1, buf1 + 16384, arow, brow, xr, h, acc);
    __syncthreads();
  }
}

enum { EP_SILU = 0, EP_PLAIN = 1, EP_HEADNORM = 2 };

__device__ __forceinline__ void stage_flush_bf16(const char* sw, ushort_t* __restrict__ dst, const size_t ld, const size_t row0, const int col0) {
  const int lane = threadIdx.x & 63;
  const int rr = lane >> 3, ch = lane & 7;
#pragma unroll
  for (int i = 0; i < 8; ++i) {
    const int row = i * 8 + rr;
    const uint4 v = *(const uint4*)(sw + row * 144 + ch * 16);
    *(uint4*)(dst + (row0 + row) * ld + col0 + ch * 8) = v;
  }
}

__device__ __forceinline__ void epi_bf16(char* smem, const f32x16 (&acc)[2][2], const int mode, ushort_t* __restrict__ dst, const int ld,
                                         const int row0, const int col0, const float* __restrict__ nw, float* __restrict__ kp) {
  const int lane = threadIdx.x & 63, r = lane & 31, h = lane >> 5;
  char* sw = smem + (threadIdx.x >> 6) * 9216;
  float w0 = 1.f, w1 = 1.f;
  if (mode == EP_HEADNORM) { w0 = nw[r]; w1 = nw[32 + r]; }
  float cs0 = 0.f, cs1 = 0.f;
#pragma unroll
  for (int mi = 0; mi < 2; ++mi) {
#pragma unroll
    for (int e = 0; e < 16; ++e) {
      const int row = mi * 32 + (e & 3) + 8 * (e >> 2) + 4 * h;
      float v0 = acc[mi][0][e], v1 = acc[mi][1][e];
      if (mode == EP_SILU) { v0 = silu_f(v0); v1 = silu_f(v1); }
      if (mode == EP_HEADNORM) {
        float ss = v0 * v0 + v1 * v1;
        ss += __shfl_xor(ss, 1); ss += __shfl_xor(ss, 2); ss += __shfl_xor(ss, 4); ss += __shfl_xor(ss, 8); ss += __shfl_xor(ss, 16);
        const float rs = rsqrtf(ss * (1.f / 64.f) + EPS);
        v0 = v0 * rs * w0; v1 = v1 * rs * w1;
        cs0 += v0; cs1 += v1;
      }
      *(ushort_t*)(sw + row * 144 + r * 2) = f2bf(v0);
      *(ushort_t*)(sw + row * 144 + 64 + r * 2) = f2bf(v1);
    }
  }
  if (kp) {
    cs0 += __shfl_xor(cs0, 32);
    cs1 += __shfl_xor(cs1, 32);
    if (h == 0) { kp[r] = cs0; kp[32 + r] = cs1; }
  }
  stage_flush_bf16(sw, dst, (size_t)ld, (size_t)row0, col0);
}

__device__ __forceinline__ void epi_bf16_T(char* smem, const f32x16 (&acc)[2][2], ushort_t* __restrict__ dstT, const size_t ldT, const int rowpos0) {
  const int lane = threadIdx.x & 63, r = lane & 31, h = lane >> 5;
  char* sw = smem + (threadIdx.x >> 6) * 9216;
#pragma unroll
  for (int ni = 0; ni < 2; ++ni) {
#pragma unroll
    for (int mi = 0; mi < 2; ++mi) {
#pragma unroll
      for (int q4 = 0; q4 < 4; ++q4) {
        const int rp = mi * 32 + 8 * q4 + 4 * h;
        *(uint2*)(sw + (ni * 32 + r) * 144 + rp * 2) = make_uint2(pack2(acc[mi][ni][4 * q4 + 0], acc[mi][ni][4 * q4 + 1]),
                                                                    pack2(acc[mi][ni][4 * q4 + 2], acc[mi][ni][4 * q4 + 3]));
      }
    }
  }
  stage_flush_bf16(sw, dstT, ldT, 0, rowpos0);
}

__device__ __forceinline__ void epi_f32(char* smem, const f32x16 (&acc)[2][2], float* __restrict__ dst, const int ld, const int row0, const int col0,
                                        const float* __restrict__ resid) {
  const int lane = threadIdx.x & 63, r = lane & 31, h = lane >> 5;
  char* sw = smem + (threadIdx.x >> 6) * 17408;
#pragma unroll
  for (int mi = 0; mi < 2; ++mi) {
#pragma unroll
    for (int e = 0; e < 16; ++e) {
      const int row = mi * 32 + (e & 3) + 8 * (e >> 2) + 4 * h;
      *(float*)(sw + row * 272 + r * 4) = acc[mi][0][e];
      *(float*)(sw + row * 272 + 128 + r * 4) = acc[mi][1][e];
    }
  }
  const int rr = lane >> 4, ch = lane & 15;
#pragma unroll
  for (int hb = 0; hb < 2; ++hb) {
    float4 rv[8];
    if (resid) {
#pragma unroll
      for (int i = 0; i < 8; ++i) rv[i] = *(const float4*)(resid + (size_t)(row0 + (hb * 8 + i) * 4 + rr) * ld + col0 + ch * 4);
    }
#pragma unroll
    for (int i = 0; i < 8; ++i) {
      const int row = (hb * 8 + i) * 4 + rr;
      float4 v = *(const float4*)(sw + row * 272 + ch * 16);
      if (resid) { v.x += rv[i].x; v.y += rv[i].y; v.z += rv[i].z; v.w += rv[i].w; }
      *(float4*)(dst + (size_t)(row0 + row) * ld + col0 + ch * 4) = v;
    }
  }
}

__device__ __forceinline__ void ph_gemm_proj(const int vb, char* smem, const Params& p) {
  const int nt = vb % 20, mt = vb / 20;
  const int m0 = mt * 128, n0 = nt * 128;
  f32x16 acc[2][2];
  gemm_core(p.xn_b, p.w_inT, DM, m0, n0, smem, acc);
  const int wave = threadIdx.x >> 6, wm = wave >> 1, wn = wave & 1;
  const int row0 = m0 + wm * 64;
  const int c = n0 + wn * 64;
  if (c < 512) epi_bf16(smem, acc, EP_SILU, p.zs, 512, row0, c, nullptr, nullptr);
  else if (c < 1536) epi_bf16(smem, acc, EP_PLAIN, p.xbc_raw, 1024, row0, c - 512, nullptr, nullptr);
  else if (c < 1792) epi_bf16(smem, acc, EP_HEADNORM, p.mq, 256, row0, c - 1536, p.mq_norm_w, nullptr);
  else if (c < 2048) {
    const int hh = (c - 1792) >> 6, bb = row0 >> 13, lpos = row0 & (SL - 1);
    epi_bf16(smem, acc, EP_HEADNORM, p.mk, 256, row0, c - 1792, p.mk_norm_w, p.kpart + ((size_t)((bb * 4 + hh) * 32 + (lpos >> 8)) * 4 + ((lpos >> 6) & 3)) * 64);
  } else if (c < 2304) {
    const int hh = (c - 2048) >> 6, bb = row0 >> 13, lpos = row0 & (SL - 1);
    epi_bf16_T(smem, acc, p.vT + (size_t)(bb * 4 + hh) * 64 * SL, SL, lpos);
  }
  else epi_bf16(smem, acc, EP_HEADNORM, p.xq, 256, row0, c - 2304, p.xq_norm_w, nullptr);
}

__device__ __forceinline__ void ph_gemm_mem(const int vb, char* smem, const Params& p) {
  const int nt = vb % 4, mt = vb / 4;
  const int m0 = mt * 128, n0 = nt * 128;
  f32x16 acc[2][2];
  gemm_core(p.memn_b, p.w_memT, DM, m0, n0, smem, acc);
  const int wave = threadIdx.x >> 6, wm = wave >> 1, wn = wave & 1;
  const int row0 = m0 + wm * 64;
  const int c = n0 + wn * 64;
  if (c < 256) epi_bf16(smem, acc, EP_HEADNORM, p.memk_b, 256, row0, c, p.xk_norm_w, nullptr);
  else {
    const int hh = (c - 256) >> 6, bb = row0 >> 8, mpos = row0 & 255;
    epi_bf16_T(smem, acc, p.memvT + (size_t)(bb * 4 + hh) * 64 * MEM, MEM, mpos);
  }
}

__device__ __forceinline__ void ph_gemm_f32(const int vb, char* smem, const ushort_t* A, const ushort_t* Bt, float* dst, const float* resid) {
  const int nt = vb % 8, mt = vb / 8;
  const int m0 = mt * 128, n0 = nt * 128;
  f32x16 acc[2][2];
  gemm_core(A, Bt, DM, m0, n0, smem, acc);
  const int wave = threadIdx.x >> 6, wm = wave >> 1, wn = wave & 1;
  epi_f32(smem, acc, dst, DM, m0 + wm * 64, n0 + wn * 64, resid);
}

__device__ __forceinline__ int swz256(int row, int ch) { return row * 272 + (ch << 4); }
__device__ __forceinline__ int crow16(int e, int hl) { return (e & 3) + 8 * (e >> 2) + 4 * hl; }

__device__ __forceinline__ void ph_ssd1(const int vb, char* smem, const Params& p) {
  const int h = vb & 7, c = (vb >> 3) & 63, b = vb >> 9;
  const int g = h >> 2, hq = h & 3;
  int tid = threadIdx.x;
  asm volatile("" : "+v"(tid));
  const int lane = tid & 63, wave = tid >> 6;
  const int t0 = b * SL + c * 128;
  char* s_xw = smem;
  char* s_bt = smem + 17408;
  float* s_acs = (float*)(smem + 52224);
  float* s_w = s_acs + 128;
  float* s_red = s_w + 128;
  const float a_coef = -expf(p.a_log[h]);
  float dtv = 0.f, cs = 0.f;
  if (tid < 128) {
    dtv = p.dt[(size_t)(t0 + tid) * 8 + h];
    cs = dtv * a_coef;
#pragma unroll
    for (int o = 1; o < 64; o <<= 1) {
      float nb = __shfl_up(cs, o);
      if (lane >= o) cs += nb;
    }
    if (lane == 63) s_red[wave] = cs;
  }
  __syncthreads();
  if (tid < 128) {
    if (wave == 1) cs += s_red[0];
    s_acs[tid] = cs;
    p.acs[(size_t)(t0 + tid) * 8 + h] = cs;
  }
  __syncthreads();
  if (tid < 128) {
    const float tot = s_acs[127];
    s_w[tid] = dtv * expf(tot - cs);
    if (tid == 0) p.cdec[(b * 64 + c) * 8 + h] = expf(tot);
  }
  __syncthreads();
  if (tid < 224) {
    const int seg = tid / 28, cg = tid - seg * 28;
    const bool is_x = cg < 8, is_b = (cg >= 8) && (cg < 24);
    int ch0, trow;
    if (is_x) { ch0 = h * 64 + cg * 8; trow = cg * 8; }
    else if (is_b) { ch0 = 512 + g * 128 + (cg - 8) * 8; trow = (cg - 8) * 8; }
    else { ch0 = 768 + g * 128 + hq * 32 + (cg - 24) * 8; trow = 0; }
    const bool wr_nat = is_x || !is_b || (hq == 0);
    char* tbase = is_x ? s_xw : s_bt;
    const int l0 = seg * 16;
    float w0[8], w1[8], w2[8], w3[8], bias[8];
    {
      const float* cw = p.conv_w + ch0;
      float4 a, bq;
      a = *(const float4*)(cw); bq = *(const float4*)(cw + 4);
      w0[0] = a.x; w0[1] = a.y; w0[2] = a.z; w0[3] = a.w; w0[4] = bq.x; w0[5] = bq.y; w0[6] = bq.z; w0[7] = bq.w;
      a = *(const float4*)(cw + 1024); bq = *(const float4*)(cw + 1028);
      w1[0] = a.x; w1[1] = a.y; w1[2] = a.z; w1[3] = a.w; w1[4] = bq.x; w1[5] = bq.y; w1[6] = bq.z; w1[7] = bq.w;
      a = *(const float4*)(cw + 2048); bq = *(const float4*)(cw + 2052);
      w2[0] = a.x; w2[1] = a.y; w2[2] = a.z; w2[3] = a.w; w2[4] = bq.x; w2[5] = bq.y; w2[6] = bq.z; w2[7] = bq.w;
      a = *(const float4*)(cw + 3072); bq = *(const float4*)(cw + 3076);
      w3[0] = a.x; w3[1] = a.y; w3[2] = a.z; w3[3] = a.w; w3[4] = bq.x; w3[5] = bq.y; w3[6] = bq.z; w3[7] = bq.w;
      a = *(const float4*)(p.conv_b + ch0); bq = *(const float4*)(p.conv_b + ch0 + 4);
      bias[0] = a.x; bias[1] = a.y; bias[2] = a.z; bias[3] = a.w; bias[4] = bq.x; bias[5] = bq.y; bias[6] = bq.z; bias[7] = bq.w;
    }
    float r0[8], r1[8], r2[8];
    {
      const int lg = c * 128 + l0;
      const ushort_t* src = p.xbc_raw + (size_t)(t0 + l0) * 1024 + ch0;
      uint4 z4 = make_uint4(0u, 0u, 0u, 0u);
      uint4 u0 = (lg >= 3) ? *(const uint4*)(src - 3 * 1024) : z4;
      uint4 u1 = (lg >= 2) ? *(const uint4*)(src - 2 * 1024) : z4;
      uint4 u2 = (lg >= 1) ? *(const uint4*)(src - 1 * 1024) : z4;
      unpack8(u0, r0); unpack8(u1, r1); unpack8(u2, r2);
    }
    unsigned outp[8][8];
    float lo[8], los[8];
#pragma unroll
    for (int i = 0; i < 16; ++i) {
      float cur[8], val[8];
      unpack8(*(const uint4*)(p.xbc_raw + (size_t)(t0 + l0 + i) * 1024 + ch0), cur);
#pragma unroll
      for (int j = 0; j < 8; ++j) {
        float v = bias[j];
        v = fmaf(w0[j], r0[j], v); v = fmaf(w1[j], r1[j], v); v = fmaf(w2[j], r2[j], v); v = fmaf(w3[j], cur[j], v);
        val[j] = silu_f(v);
        r0[j] = r1[j]; r1[j] = r2[j]; r2[j] = cur[j];
      }
      if (wr_nat) {
        *(uint4*)(p.xc + (size_t)(t0 + l0 + i) * 1024 + ch0) =
            make_uint4(pack2(val[0], val[1]), pack2(val[2], val[3]), pack2(val[4], val[5]), pack2(val[6], val[7]));
      }
      const float scl = is_x ? s_w[l0 + i] : 1.f;
      if ((i & 1) == 0) {
#pragma unroll
        for (int j = 0; j < 8; ++j) { lo[j] = val[j]; los[j] = val[j] * scl; }
      } else {
        const int chunk = seg * 2 + (i >> 3);
#pragma unroll
        for (int j = 0; j < 8; ++j) {
          outp[j][i >> 1] = pack2(lo[j], val[j]);
          if (is_x || is_b) *(unsigned*)(tbase + swz256(trow + j, chunk) + ((i & 7) - 1) * 2) = pack2(los[j], val[j] * scl);
        }
      }
    }
    if (is_x) {
      ushort_t* dst = p.xT + ((size_t)((b * 64 + c) * 8 + h) * 64 + cg * 8) * 128 + l0;
#pragma unroll
      for (int j = 0; j < 8; ++j) {
        *(uint4*)(dst + (size_t)j * 128) = make_uint4(outp[j][0], outp[j][1], outp[j][2], outp[j][3]);
        *(uint4*)(dst + (size_t)j * 128 + 8) = make_uint4(outp[j][4], outp[j][5], outp[j][6], outp[j][7]);
      }
    }
  }
  __syncthreads();
  {
    const int r = lane & 31, hl = lane >> 5;
    f32x16 acc[2];
#pragma unroll
    for (int e = 0; e < 16; ++e) { acc[0][e] = 0.f; acc[1][e] = 0.f; }
#pragma unroll
    for (int ks = 0; ks < 8; ++ks) {
      const bf16x8 bfr = *(const bf16x8*)(s_bt + swz256(32 * wave + r, ks * 2 + hl));
      const bf16x8 a0 = *(const bf16x8*)(s_xw + swz256(r, ks * 2 + hl));
      const bf16x8 a1 = *(const bf16x8*)(s_xw + swz256(32 + r, ks * 2 + hl));
      acc[0] = __builtin_amdgcn_mfma_f32_32x32x16_bf16(a0, bfr, acc[0], 0, 0, 0);
      acc[1] = __builtin_amdgcn_mfma_f32_32x32x16_bf16(a1, bfr, acc[1], 0, 0, 0);
    }
    float* dst = p.states + (size_t)((b * 64 + c) * 8 + h) * 64 * 128;
#pragma unroll
    for (int pt = 0; pt < 2; ++pt)
#pragma unroll
      for (int e = 0; e < 16; ++e) dst[(size_t)(pt * 32 + crow16(e, hl)) * 128 + 32 * wave + r] = acc[pt][e];
  }
}

__device__ __forceinline__ void ph_ssd2(const int vb, const Params& p) {
  const int idx = vb * 256 + threadIdx.x;
  const int pn = idx & 8191, h = (idx >> 13) & 7, b = idx >> 16;
  float st = 0.f;
#pragma unroll 1
  for (int c0 = 0; c0 < 64; c0 += 8) {
    float sv[8], dv[8];
#pragma unroll
    for (int i = 0; i < 8; ++i) {
      const int cc = (b * 64 + c0 + i) * 8 + h;
      sv[i] = p.states[(size_t)cc * 8192 + pn];
      dv[i] = p.cdec[cc];
    }
#pragma unroll
    for (int i = 0; i < 8; ++i) {
      const int cc = (b * 64 + c0 + i) * 8 + h;
      p.sin_b[(size_t)cc * 8192 + pn] = f2bf(st);
      st = fmaf(st, dv[i], sv[i]);
    }
  }
}

__device__ __forceinline__ void ph_ssd3(const int vb, char* smem, const Params& p) {
  const int g = vb & 1, c = (vb >> 1) & 63, b = vb >> 7;
  int tid = threadIdx.x;
  asm volatile("" : "+v"(tid));
  const int lane = tid & 63;
  const int w = __builtin_amdgcn_readfirstlane(tid >> 6);
  const int r = lane & 31, hl = lane >> 5;
  const int t0 = b * SL + c * 128;
  char* s_C = smem;
  char* s_B = smem + 34816;
  char* s_xT = smem + 34816;
  char* s_S = smem + 34816 + 16896;
  float* s_acs = (float*)(smem + 69632);
  float* s_dt = s_acs + 512;
  {
    const int ch = tid & 15, r0 = tid >> 4;
#pragma unroll
    for (int i = 0; i < 8; ++i) {
      const int row = r0 + 16 * i;
      const ushort_t* src = p.xc + (size_t)(t0 + row) * 1024 + g * 128 + ch * 8;
      *(uint4*)(s_B + swz256(row, ch)) = *(const uint4*)(src + 512);
      *(uint4*)(s_C + swz256(row, ch)) = *(const uint4*)(src + 768);
    }
    if (tid < 128) {
#pragma unroll
      for (int hh = 0; hh < 4; ++hh) {
        s_acs[hh * 128 + tid] = p.acs[(size_t)(t0 + tid) * 8 + g * 4 + hh];
        s_dt[hh * 128 + tid] = p.dt[(size_t)(t0 + tid) * 8 + g * 4 + hh];
      }
    }
  }
  __syncthreads();
  bf16x8 cfr[8];
#pragma unroll
  for (int ks = 0; ks < 8; ++ks) cfr[ks] = *(const bf16x8*)(s_C + swz256(32 * w + r, ks * 2 + hl));
  f32x16 gt[4];
#pragma unroll
  for (int st = 0; st < 4; ++st) {
#pragma unroll
    for (int e = 0; e < 16; ++e) gt[st][e] = 0.f;
    if (st <= w) {
#pragma unroll
      for (int ks = 0; ks < 8; ++ks) {
        const bf16x8 a = *(const bf16x8*)(s_B + swz256(32 * st + r, ks * 2 + hl));
        gt[st] = __builtin_amdgcn_mfma_f32_32x32x16_bf16(a, cfr[ks], gt[st], 0, 0, 0);
      }
    }
  }
  __syncthreads();
  float ssq = 0.f;
  const int lane_c = lane;
#pragma unroll 1
  for (int hh = 0; hh < 4; ++hh) {
    int lane_o = lane_c;
    asm volatile("" : "+v"(lane_o));
    const int r = lane_o & 31, hl = lane_o >> 5;
    const int l = 32 * w + r;
    const int hg = g * 4 + hh;
    {
      const int ch = tid & 15, r0 = tid >> 4;
      const size_t base = (size_t)((b * 64 + c) * 8 + hg) * 8192;
#pragma unroll
      for (int i = 0; i < 4; ++i) {
        const int row = r0 + 16 * i;
        const uint4 xv = *(const uint4*)(p.xT + base + (size_t)row * 128 + ch * 8);
        *(uint2*)(s_xT + row * 264 + ch * 16) = make_uint2(xv.x, xv.y);
        *(uint2*)(s_xT + row * 264 + ch * 16 + 8) = make_uint2(xv.z, xv.w);
        *(uint4*)(s_S + swz256(row, ch)) = *(const uint4*)(p.sin_b + base + (size_t)row * 128 + ch * 8);
      }
    }
    __syncthreads();
    const float acs_l = s_acs[hh * 128 + l];
    const float dsk = p.ssd_d[hg];
    f32x16 acc[2];
#pragma unroll
    for (int e = 0; e < 16; ++e) { acc[0][e] = 0.f; acc[1][e] = 0.f; }
#pragma unroll
    for (int ks = 0; ks < 8; ++ks) {
      const bf16x8 a0 = *(const bf16x8*)(s_S + swz256(r, ks * 2 + hl));
      const bf16x8 a1 = *(const bf16x8*)(s_S + swz256(32 + r, ks * 2 + hl));
      acc[0] = __builtin_amdgcn_mfma_f32_32x32x16_bf16(a0, cfr[ks], acc[0], 0, 0, 0);
      acc[1] = __builtin_amdgcn_mfma_f32_32x32x16_bf16(a1, cfr[ks], acc[1], 0, 0, 0);
    }
    {
      const float el = expf(acs_l);
#pragma unroll
      for (int e = 0; e < 16; ++e) { acc[0][e] *= el; acc[1][e] *= el; }
    }
#pragma unroll
    for (int st = 0; st < 4; ++st) {
      asm volatile("" ::: "memory");
      if (st <= w) {
        float m[16];
#pragma unroll
        for (int e = 0; e < 16; ++e) {
          const int sidx = 32 * st + crow16(e, hl);
          float v = gt[st][e] * __expf(acs_l - s_acs[hh * 128 + sidx]) * s_dt[hh * 128 + sidx];
          if (sidx > l) v = 0.f;
          if (sidx == l) v += dsk;
          m[e] = v;
        }
#pragma unroll
        for (int k2 = 0; k2 < 2; ++k2) {
          asm volatile("" ::: "memory");
          bf16x8 mf;
          {
            unsigned u0 = pack2(m[8 * k2 + 0], m[8 * k2 + 1]), u1 = pack2(m[8 * k2 + 2], m[8 * k2 + 3]);
            unsigned u2 = pack2(m[8 * k2 + 4], m[8 * k2 + 5]), u3 = pack2(m[8 * k2 + 6], m[8 * k2 + 7]);
            uint4 uu = make_uint4(u0, u1, u2, u3);
            mf = *(bf16x8*)&uu;
          }
          const int soff = (32 * st + 16 * k2 + 4 * hl) * 2;
#pragma unroll
          for (int pt = 0; pt < 2; ++pt) {
            const char* ap = s_xT + (pt * 32 + r) * 264 + soff;
            uint2 q0 = *(const uint2*)(ap);
            uint2 q1 = *(const uint2*)(ap + 16);
            uint4 qq = make_uint4(q0.x, q0.y, q1.x, q1.y);
            const bf16x8 af = *(bf16x8*)&qq;
            acc[pt] = __builtin_amdgcn_mfma_f32_32x32x16_bf16(af, mf, acc[pt], 0, 0, 0);
          }
        }
      }
    }
#pragma unroll
    for (int pt = 0; pt < 2; ++pt) {
#pragma unroll
      for (int q4 = 0; q4 < 4; ++q4) {
        asm volatile("" ::: "memory");
        const int p0 = pt * 32 + 8 * q4 + 4 * hl;
        const uint2 zz = *(const uint2*)(p.zs + (size_t)(t0 + l) * 512 + hg * 64 + p0);
        const float v0 = acc[pt][4 * q4 + 0] * bflo(zz.x), v1 = acc[pt][4 * q4 + 1] * bfhi(zz.x);
        const float v2 = acc[pt][4 * q4 + 2] * bflo(zz.y), v3 = acc[pt][4 * q4 + 3] * bfhi(zz.y);
        ssq += v0 * v0 + v1 * v1 + v2 * v2 + v3 * v3;
        *(uint2*)(p.mixed_b + (size_t)(t0 + l) * 1024 + hg * 64 + p0) = make_uint2(pack2(v0, v1), pack2(v2, v3));
      }
    }
    __syncthreads();
  }
  const int l = 32 * w + r;
  ssq += __shfl_xor(ssq, 32);
  const float rstd = rsqrtf(ssq * (1.f / 256.f) + EPS);
#pragma unroll 1
  for (int hh = 0; hh < 4; ++hh) {
#pragma unroll
    for (int pt = 0; pt < 2; ++pt) {
#pragma unroll
      for (int q4 = 0; q4 < 4; ++q4) {
        asm volatile("" ::: "memory");
        const int chn = (g * 4 + hh) * 64 + pt * 32 + 8 * q4 + 4 * hl;
        ushort_t* ptr = p.mixed_b + (size_t)(t0 + l) * 1024 + chn;
        const uint2 vv = *(const uint2*)ptr;
        const float4 nw = *(const float4*)(p.ssd_norm_w + chn);
        *(uint2*)ptr = make_uint2(pack2(bflo(vv.x) * rstd * nw.x, bfhi(vv.x) * rstd * nw.y),
                                  pack2(bflo(vv.y) * rstd * nw.z, bfhi(vv.y) * rstd * nw.w));
      }
    }
  }
}

__device__ __forceinline__ void k_gate(const int VB, char* smem, const Params& p) {
  const int own = VB & 31, bh = VB >> 5;
  if (own == 0) return;
  const int b = bh >> 2, h = bh & 3;
  const int tid = threadIdx.x;
  float* s_km = (float*)smem;
  int* s_cnt = (int*)(smem + 8192);
  int* s_base = s_cnt + 32;
  for (int i = tid; i < own * 64; i += 256) {
    const int n = i >> 6, d = i & 63;
    const float* kp = p.kpart + (size_t)(bh * 32 + n) * 256 + d;
    s_km[i] = (kp[0] + kp[64]) + (kp[128] + kp[192]);
  }
  if (tid < 32) s_cnt[tid] = 0;
  __syncthreads();
  const int l = own * 256 + tid;
  const int t = b * SL + l;
  float q[64];
  {
    const ushort_t* src = p.mq + (size_t)t * 256 + h * 64;
#pragma unroll
    for (int d = 0; d < 64; d += 8) {
      uint4 v = *(const uint4*)(src + d);
      q[d] = bflo(v.x); q[d + 1] = bfhi(v.x); q[d + 2] = bflo(v.y); q[d + 3] = bfhi(v.y);
      q[d + 4] = bflo(v.z); q[d + 5] = bfhi(v.z); q[d + 6] = bflo(v.w); q[d + 7] = bfhi(v.w);
    }
  }
  float v0 = -INFINITY, v1 = -INFINITY, v2 = -INFINITY;
  int i0 = 0, i1 = 1, i2 = 2;
  for (int n = 0; n < own; ++n) {
    const float* km = s_km + n * 64;
    float sa = 0.f, sb = 0.f;
#pragma unroll
    for (int d = 0; d < 64; d += 8) {
      const float4 a = *(const float4*)(km + d), c = *(const float4*)(km + d + 4);
      sa = fmaf(q[d], a.x, sa); sa = fmaf(q[d + 1], a.y, sa); sa = fmaf(q[d + 2], a.z, sa); sa = fmaf(q[d + 3], a.w, sa);
      sb = fmaf(q[d + 4], c.x, sb); sb = fmaf(q[d + 5], c.y, sb); sb = fmaf(q[d + 6], c.z, sb); sb = fmaf(q[d + 7], c.w, sb);
    }
    const float sv = sa + sb;
    if (sv > v0) { v2 = v1; i2 = i1; v1 = v0; i1 = i0; v0 = sv; i0 = n; }
    else if (sv > v1) { v2 = v1; i2 = i1; v1 = sv; i1 = n; }
    else if (sv > v2) { v2 = sv; i2 = n; }
  }
  const int nsel = own < 3 ? own : 3;
  int lp0 = 0, lp1 = 0, lp2 = 0;
  if (0 < nsel) lp0 = atomicAdd(s_cnt + i0, 1);
  if (1 < nsel) lp1 = atomicAdd(s_cnt + i1, 1);
  if (2 < nsel) lp2 = atomicAdd(s_cnt + i2, 1);
  __syncthreads();
  if (tid < own) s_base[tid] = s_cnt[tid] ? atomicAdd(p.bcnt + bh * 32 + tid, s_cnt[tid]) : 0;
  __syncthreads();
  if (0 < nsel) p.blist[(size_t)(bh * 32 + i0) * 8192 + s_base[i0] + lp0] = l | (0 << 13);
  if (1 < nsel) p.blist[(size_t)(bh * 32 + i1) * 8192 + s_base[i1] + lp1] = l | (1 << 13);
  if (2 < nsel) p.blist[(size_t)(bh * 32 + i2) * 8192 + s_base[i2] + lp2] = l | (2 << 13);
}

__device__ __forceinline__ void attn_unit(char* smem, const ushort_t* __restrict__ Kp, const int kstride, const ushort_t* __restrict__ VTp,
                                          const size_t vstride, const ushort_t* __restrict__ qrow, const float slope, const int qrel,
                                          const bool causal, const int nst, f32x16 (&o)[2], float& m_out, float& l_out) {
  int tid = threadIdx.x;
  asm volatile("" : "+v"(tid));
  const int lane = tid & 63, r = lane & 31, hl = lane >> 5;
  char* s_K = smem;
  char* s_VT = smem + 18432;
  bf16x8 qf[4];
#pragma unroll
  for (int ks = 0; ks < 4; ++ks) qf[ks] = *(const bf16x8*)(qrow + ks * 16 + hl * 8);
#pragma unroll
  for (int e = 0; e < 16; ++e) { o[0][e] = 0.f; o[1][e] = 0.f; }
  float m = -1e30f, lsum = 0.f;
#pragma unroll 1
  for (int st = 0; st < nst; ++st) {
    {
      const int kr = tid >> 3, kc = tid & 7;
#pragma unroll
      for (int i = 0; i < 4; ++i) {
        const int row = kr + 32 * i;
        *(uint4*)(s_K + row * 144 + kc * 16) = *(const uint4*)(Kp + (size_t)(st * 128 + row) * kstride + kc * 8);
      }
      const int vr = tid >> 4, vc = tid & 15;
#pragma unroll
      for (int i = 0; i < 4; ++i) {
        const int row = vr + 16 * i;
        const uint4 vv = *(const uint4*)(VTp + (size_t)row * vstride + st * 128 + vc * 8);
        *(uint2*)(s_VT + row * 264 + vc * 16) = make_uint2(vv.x, vv.y);
        *(uint2*)(s_VT + row * 264 + vc * 16 + 8) = make_uint2(vv.z, vv.w);
      }
    }
    __syncthreads();
    f32x16 sc[4];
#pragma unroll
    for (int kt = 0; kt < 4; ++kt) {
#pragma unroll
      for (int e = 0; e < 16; ++e) sc[kt][e] = 0.f;
#pragma unroll
      for (int ks = 0; ks < 4; ++ks) {
        const bf16x8 a = *(const bf16x8*)(s_K + (32 * kt + r) * 144 + (2 * ks + hl) * 16);
        sc[kt] = __builtin_amdgcn_mfma_f32_32x32x16_bf16(a, qf[ks], sc[kt], 0, 0, 0);
      }
    }
    float mx = -1e30f;
    const int qk0 = qrel - st * 128 - 4 * hl;
#pragma unroll
    for (int kt = 0; kt < 4; ++kt) {
#pragma unroll
      for (int e = 0; e < 16; ++e) {
        const int dist = qk0 - (32 * kt + (e & 3) + 8 * (e >> 2));
        float v = fmaf(sc[kt][e], 0.125f, -slope * (float)dist);
        if (causal && dist < 0) v = -1e30f;
        sc[kt][e] = v;
        mx = fmaxf(mx, v);
      }
    }
    mx = fmaxf(mx, __shfl_xor(mx, 32));
    const float mnew = fmaxf(m, mx);
    const float alpha = __expf(m - mnew);
    m = mnew;
    lsum *= alpha;
#pragma unroll
    for (int e = 0; e < 16; ++e) { o[0][e] *= alpha; o[1][e] *= alpha; }
#pragma unroll
    for (int kt = 0; kt < 4; ++kt) {
#pragma unroll
      for (int e = 0; e < 16; ++e) {
        const float pe = __expf(sc[kt][e] - mnew);
        sc[kt][e] = pe;
        lsum += pe;
      }
    }
#pragma unroll
    for (int kt = 0; kt < 4; ++kt) {
#pragma unroll
      for (int k2 = 0; k2 < 2; ++k2) {
        uint4 pu = make_uint4(pack2(sc[kt][8 * k2 + 0], sc[kt][8 * k2 + 1]), pack2(sc[kt][8 * k2 + 2], sc[kt][8 * k2 + 3]),
                              pack2(sc[kt][8 * k2 + 4], sc[kt][8 * k2 + 5]), pack2(sc[kt][8 * k2 + 6], sc[kt][8 * k2 + 7]));
        const bf16x8 pf = *(bf16x8*)&pu;
        const int koff = (32 * kt + 16 * k2 + 4 * hl) * 2;
#pragma unroll
        for (int dt = 0; dt < 2; ++dt) {
          const char* ap = s_VT + (dt * 32 + r) * 264 + koff;
          const uint2 q0 = *(const uint2*)(ap);
          const uint2 q1 = *(const uint2*)(ap + 16);
          uint4 qq = make_uint4(q0.x, q0.y, q1.x, q1.y);
          const bf16x8 af = *(bf16x8*)&qq;
          o[dt] = __builtin_amdgcn_mfma_f32_32x32x16_bf16(af, pf, o[dt], 0, 0, 0);
        }
      }
    }
    __syncthreads();
  }
  m_out = m;
  l_out = lsum + __shfl_xor(lsum, 32);
}

__device__ __forceinline__ void ph_attn_unit(const int kind, const int a0, const int a1, char* smem, const Params& p) {
  const int tid = threadIdx.x, lane = tid & 63, wave = tid >> 6, r = lane & 31, hl = lane >> 5;
  f32x16 o[2];
  float m, lt;
  if (kind == 2) {
    const int bh = a0, b = bh >> 2, h = bh & 3;
    const int t = b * SL + a1 * 128 + wave * 32 + r;
    attn_unit(smem, p.memk_b + (size_t)b * MEM * 256 + h * 64, 256, p.memvT + (size_t)bh * 64 * MEM, MEM, p.xq + (size_t)t * 256 + h * 64, 0.f,
              1 << 20, false, 2, o, m, lt);
    const float inv = 1.f / lt;
#pragma unroll
    for (int dt = 0; dt < 2; ++dt)
#pragma unroll
      for (int q4 = 0; q4 < 4; ++q4) {
        const int d = dt * 32 + 8 * q4 + 4 * hl;
        *(uint2*)(p.mixed_b + (size_t)t * DM + 768 + h * 64 + d) =
            make_uint2(pack2(o[dt][4 * q4] * inv, o[dt][4 * q4 + 1] * inv), pack2(o[dt][4 * q4 + 2] * inv, o[dt][4 * q4 + 3] * inv));
      }
    return;
  }
  int bh, l, slot, jblk, nst = 2;
  bool valid = true, causal = false;
  if (kind == 0) {
    bh = a0 >> 5; jblk = a0 & 31;
    const int cnt = p.bcnt[a0];
    int qi = a1 * 128 + wave * 32 + r;
    if (qi >= cnt) { valid = false; qi = 0; }
    const int ent = p.blist[(size_t)a0 * 8192 + qi];
    l = ent & 8191; slot = ent >> 13;
  } else {
    bh = a0 >> 5; jblk = a0 & 31;
    l = jblk * 256 + a1 * 128 + wave * 32 + r; slot = 3; causal = true;
    nst = a1 + 1;
  }
  const int b = bh >> 2, h = bh & 3;
  const int t = b * SL + l;
  const float slope = exp2f(-2.f * (float)(h + 1));
  attn_unit(smem, p.mk + (size_t)(b * SL + jblk * 256) * 256 + h * 64, 256, p.vT + (size_t)bh * 64 * SL + jblk * 256, SL,
            p.mq + (size_t)t * 256 + h * 64, slope, l - jblk * 256, causal, nst, o, m, lt);
  if (valid) {
    const float inv = 1.f / lt;
    const size_t pi = ((size_t)t * 4 + h) * 4 + slot;
#pragma unroll
    for (int dt = 0; dt < 2; ++dt)
#pragma unroll
      for (int q4 = 0; q4 < 4; ++q4) {
        const int d = dt * 32 + 8 * q4 + 4 * hl;
        *(uint2*)(p.pO + pi * 64 + d) =
            make_uint2(pack2(o[dt][4 * q4] * inv, o[dt][4 * q4 + 1] * inv), pack2(o[dt][4 * q4 + 2] * inv, o[dt][4 * q4 + 3] * inv));
      }
    if (hl == 0) { p.pm[pi] = m; p.pl[pi] = lt; }
  }
}

__device__ __forceinline__ void ph_attn_combine(const int VB, const Params& p) {
  const int i = VB * 256 + threadIdx.x;
  const int dq = i & 7, th = i >> 3;
  const int t = th >> 2;
  const int own = (t & (SL - 1)) >> 8;
  const int nsel = own < 3 ? own : 3;
  float mv[4], wv[4];
  float M = p.pm[(size_t)th * 4 + 3];
  mv[3] = M;
#pragma unroll
  for (int sl = 0; sl < 3; ++sl) {
    mv[sl] = (sl < nsel) ? p.pm[(size_t)th * 4 + sl] : -1e30f;
    M = fmaxf(M, mv[sl]);
  }
  float W = 0.f;
#pragma unroll
  for (int sl = 0; sl < 4; ++sl) {
    const bool on = (sl == 3) || (sl < nsel);
    wv[sl] = on ? p.pl[(size_t)th * 4 + sl] * __expf(mv[sl] - M) : 0.f;
    W += wv[sl];
  }
  float acc[8];
#pragma unroll
  for (int k = 0; k < 8; ++k) acc[k] = 0.f;
#pragma unroll
  for (int sl = 0; sl < 4; ++sl) {
    const bool on = (sl == 3) || (sl < nsel);
    if (on) {
      float f[8];
      unpack8(*(const uint4*)(p.pO + ((size_t)th * 4 + sl) * 64 + dq * 8), f);
#pragma unroll
      for (int k = 0; k < 8; ++k) acc[k] = fmaf(wv[sl], f[k], acc[k]);
    }
  }
  const float inv = 1.f / W;
  const int h = th & 3;
  *(uint4*)(p.mixed_b + (size_t)t * DM + 512 + h * 64 + dq * 8) =
      make_uint4(pack2(acc[0] * inv, acc[1] * inv), pack2(acc[2] * inv, acc[3] * inv), pack2(acc[4] * inv, acc[5] * inv), pack2(acc[6] * inv, acc[7] * inv));
}


__device__ __forceinline__ int mkkey(const float f, const int idx, const int mask) {
  int b = __float_as_int(f);
  b = (b & ~mask) | idx;
  return b ^ ((b >> 31) & 0x7fffffff);
}
__device__ __forceinline__ int key2bits(const int k) { return k ^ ((k >> 31) & 0x7fffffff); }
#define CEI(a, b) { const int _mx = max(a, b), _mn = min(a, b); a = _mx; b = _mn; }
template <int N>
__device__ __forceinline__ void bitonic_sort_desc(int (&v)[N]) {
#pragma unroll
  for (int k = 2; k <= N; k <<= 1) {
#pragma unroll
    for (int j = k >> 1; j > 0; j >>= 1) {
#pragma unroll
      for (int i = 0; i < N; ++i) {
        const int l = i ^ j;
        if (l > i) {
          if ((i & k) == 0) { CEI(v[i], v[l]); } else { CEI(v[l], v[i]); }
        }
      }
    }
  }
}
__device__ __forceinline__ void merge16(int (&a)[16], const int (&b)[16]) {
#pragma unroll
  for (int i = 0; i < 16; ++i) a[i] = max(a[i], b[15 - i]);
#pragma unroll
  for (int j = 8; j > 0; j >>= 1) {
#pragma unroll
    for (int i = 0; i < 16; ++i) {
      const int l = i ^ j;
      if (l > i) { CEI(a[i], a[l]); }
    }
  }
}
__device__ __forceinline__ void merge_partner(int (&a)[16], const int xmask) {
  int o[16];
#pragma unroll
  for (int i = 0; i < 16; ++i) o[i] = __shfl_xor(a[i], xmask);
  merge16(a, o);
}
__device__ __forceinline__ bf16x8 pack_hi8(const float (&x)[8], float (&res)[8]) {
  unsigned u[4];
#pragma unroll
  for (int i = 0; i < 4; ++i) {
    const ushort_t h0 = f2bf(x[2 * i]), h1 = f2bf(x[2 * i + 1]);
    res[2 * i] = x[2 * i] - bf2f(h0);
    res[2 * i + 1] = x[2 * i + 1] - bf2f(h1);
    u[i] = (unsigned)h0 | ((unsigned)h1 << 16);
  }
  uint4 uu = make_uint4(u[0], u[1], u[2], u[3]);
  return *(bf16x8*)&uu;
}
__device__ __forceinline__ bf16x8 pack_8(const float (&x)[8]) {
  uint4 uu = make_uint4(pack2(x[0], x[1]), pack2(x[2], x[3]), pack2(x[4], x[5]), pack2(x[6], x[7]));
  return *(bf16x8*)&uu;
}

__device__ __forceinline__ void ph_gemm_route(const int vb, char* smem, const Params& p, const ushort_t* __restrict__ hn_b) {
  const int head = vb & 7, tt = vb >> 3;
  const int m0 = head * 128, n0 = tt * 128;
  f32x16 acc[2][2];
  gemm_core(p.w_qT, hn_b, DM, m0, n0, smem, acc);
  int tid = threadIdx.x;
  asm volatile("" : "+v"(tid));
  const int lane = tid & 63, r = lane & 31, hl = lane >> 5;
  const int wave = tid >> 6, wm = wave >> 1, wn = wave & 1;
  int* s_top = (int*)(smem + 34816);
  {
    const int row = tid >> 1, part = tid & 1;
#pragma unroll
    for (int hf = 0; hf < 2; ++hf) {
      const ushort_t* src = p.skh + (size_t)(hf * 128 + row) * 64 + part * 32;
      char* dst = smem + (hf * 128 + row) * 136 + part * 64;
#pragma unroll
      for (int c = 0; c < 4; ++c) {
        const uint4 v = *(const uint4*)(src + c * 8);
        *(uint2*)(dst + c * 16) = make_uint2(v.x, v.y);
        *(uint2*)(dst + c * 16 + 8) = make_uint2(v.z, v.w);
      }
    }
  }
  __syncthreads();
  const char* s_keys = smem + wm * 128 * 136;
#pragma unroll
  for (int ni = 0; ni < 2; ++ni) {
    asm volatile("" ::: "memory");
    bf16x8 qh[4], ql[4];
#pragma unroll
    for (int mi = 0; mi < 2; ++mi) {
#pragma unroll
      for (int k2 = 0; k2 < 2; ++k2) {
        float x[8], res[8];
#pragma unroll
        for (int j = 0; j < 8; ++j) x[j] = acc[mi][ni][8 * k2 + j];
        qh[mi * 2 + k2] = pack_hi8(x, res);
        ql[mi * 2 + k2] = pack_8(res);
      }
    }
    int g0[16];
#pragma unroll
    for (int kh2 = 0; kh2 < 2; ++kh2) {
      int ga[16], gb[16];
#pragma unroll
      for (int kq = 0; kq < 2; ++kq) {
        const int kt = kh2 * 2 + kq;
        asm volatile("" ::: "memory");
        f32x16 sc;
#pragma unroll
        for (int e = 0; e < 16; ++e) sc[e] = 0.f;
#pragma unroll
        for (int st = 0; st < 4; ++st) {
          const int d0 = (st >> 1) * 32 + 16 * (st & 1) + 4 * hl;
          const char* kp = s_keys + (kt * 32 + r) * 136 + d0 * 2;
          const uint2 h0 = *(const uint2*)(kp), h1 = *(const uint2*)(kp + 16);
          uint4 hq = make_uint4(h0.x, h0.y, h1.x, h1.y);
          const bf16x8 ah = *(bf16x8*)&hq;
          sc = __builtin_amdgcn_mfma_f32_32x32x16_bf16(ah, qh[st], sc, 0, 0, 0);
          sc = __builtin_amdgcn_mfma_f32_32x32x16_bf16(ah, ql[st], sc, 0, 0, 0);
        }
        if (kq == 0) {
#pragma unroll
          for (int e = 0; e < 16; ++e) ga[e] = mkkey(sc[e], kt * 32 + (e & 3) + 8 * (e >> 2) + 4 * hl, 127);
          bitonic_sort_desc<16>(ga);
        } else {
#pragma unroll
          for (int e = 0; e < 16; ++e) gb[e] = mkkey(sc[e], kt * 32 + (e & 3) + 8 * (e >> 2) + 4 * hl, 127);
          bitonic_sort_desc<16>(gb);
        }
      }
      merge16(ga, gb);
      if (kh2 == 0) {
#pragma unroll
        for (int i = 0; i < 16; ++i) g0[i] = ga[i];
      } else {
        merge16(g0, ga);
      }
    }
    merge_partner(g0, 32);
    {
      int* dst = s_top + ((size_t)wm * 128 + wn * 64 + ni * 32 + r) * 16 + hl * 8;
      int4 w0, w1;
      int lo8[8], hi8[8];
#pragma unroll
      for (int i = 0; i < 8; ++i) { lo8[i] = g0[i]; hi8[i] = g0[8 + i]; asm volatile("" : "+v"(lo8[i]), "+v"(hi8[i])); }
      w0 = make_int4(hl ? hi8[0] : lo8[0], hl ? hi8[1] : lo8[1], hl ? hi8[2] : lo8[2], hl ? hi8[3] : lo8[3]);
      w1 = make_int4(hl ? hi8[4] : lo8[4], hl ? hi8[5] : lo8[5], hl ? hi8[6] : lo8[6], hl ? hi8[7] : lo8[7]);
      *(int4*)dst = w0; *(int4*)(dst + 4) = w1;
    }
  }
  __syncthreads();
  {
    const int tok = tid >> 1, sub = tid & 1;
    int k1[16], k2[16];
    {
      const int4* a = (const int4*)(s_top + (size_t)tok * 16);
      const int4* b = (const int4*)(s_top + (size_t)(128 + tok) * 16);
#pragma unroll
      for (int i = 0; i < 4; ++i) {
        const int4 x = a[i], y = b[i];
        k1[4 * i] = x.x; k1[4 * i + 1] = x.y; k1[4 * i + 2] = x.z; k1[4 * i + 3] = x.w;
        k2[4 * i] = y.x; k2[4 * i + 1] = y.y; k2[4 * i + 2] = y.z; k2[4 * i + 3] = y.w;
      }
    }
    float v1f[16], v2f[16];
#pragma unroll
    for (int i = 0; i < 16; ++i) { v1f[i] = __int_as_float(key2bits(k1[i])); v2f[i] = __int_as_float(key2bits(k2[i])); }
    int c[32];
    c[0] = sub ? mkkey(v1f[3] + v2f[3], 51, 255) : mkkey(v1f[0] + v2f[0], 0, 255);
    c[1] = sub ? mkkey(v1f[4] + v2f[0], 64, 255) : mkkey(v1f[0] + v2f[1], 1, 255);
    c[2] = sub ? mkkey(v1f[4] + v2f[1], 65, 255) : mkkey(v1f[0] + v2f[2], 2, 255);
    c[3] = sub ? mkkey(v1f[4] + v2f[2], 66, 255) : mkkey(v1f[0] + v2f[3], 3, 255);
    c[4] = sub ? mkkey(v1f[5] + v2f[0], 80, 255) : mkkey(v1f[0] + v2f[4], 4, 255);
    c[5] = sub ? mkkey(v1f[5] + v2f[1], 81, 255) : mkkey(v1f[0] + v2f[5], 5, 255);
    c[6] = sub ? mkkey(v1f[6] + v2f[0], 96, 255) : mkkey(v1f[0] + v2f[6], 6, 255);
    c[7] = sub ? mkkey(v1f[6] + v2f[1], 97, 255) : mkkey(v1f[0] + v2f[7], 7, 255);
    c[8] = sub ? mkkey(v1f[7] + v2f[0], 112, 255) : mkkey(v1f[0] + v2f[8], 8, 255);
    c[9] = sub ? mkkey(v1f[7] + v2f[1], 113, 255) : mkkey(v1f[0] + v2f[9], 9, 255);
    c[10] = sub ? mkkey(v1f[8] + v2f[0], 128, 255) : mkkey(v1f[0] + v2f[10], 10, 255);
    c[11] = sub ? mkkey(v1f[9] + v2f[0], 144, 255) : mkkey(v1f[0] + v2f[11], 11, 255);
    c[12] = sub ? mkkey(v1f[10] + v2f[0], 160, 255) : mkkey(v1f[0] + v2f[12], 12, 255);
    c[13] = sub ? mkkey(v1f[11] + v2f[0], 176, 255) : mkkey(v1f[0] + v2f[13], 13, 255);
    c[14] = sub ? mkkey(v1f[12] + v2f[0], 192, 255) : mkkey(v1f[0] + v2f[14], 14, 255);
    c[15] = sub ? mkkey(v1f[13] + v2f[0], 208, 255) : mkkey(v1f[0] + v2f[15], 15, 255);
    c[16] = sub ? mkkey(v1f[14] + v2f[0], 224, 255) : mkkey(v1f[1] + v2f[0], 16, 255);
    c[17] = sub ? mkkey(v1f[15] + v2f[0], 240, 255) : mkkey(v1f[1] + v2f[1], 17, 255);
    c[18] = sub ? (int)0x80000000 : mkkey(v1f[1] + v2f[2], 18, 255);
    c[19] = sub ? (int)0x80000000 : mkkey(v1f[1] + v2f[3], 19, 255);
    c[20] = sub ? (int)0x80000000 : mkkey(v1f[1] + v2f[4], 20, 255);
    c[21] = sub ? (int)0x80000000 : mkkey(v1f[1] + v2f[5], 21, 255);
    c[22] = sub ? (int)0x80000000 : mkkey(v1f[1] + v2f[6], 22, 255);
    c[23] = sub ? (int)0x80000000 : mkkey(v1f[1] + v2f[7], 23, 255);
    c[24] = sub ? (int)0x80000000 : mkkey(v1f[2] + v2f[0], 32, 255);
    c[25] = sub ? (int)0x80000000 : mkkey(v1f[2] + v2f[1], 33, 255);
    c[26] = sub ? (int)0x80000000 : mkkey(v1f[2] + v2f[2], 34, 255);
    c[27] = sub ? (int)0x80000000 : mkkey(v1f[2] + v2f[3], 35, 255);
    c[28] = sub ? (int)0x80000000 : mkkey(v1f[2] + v2f[4], 36, 255);
    c[29] = sub ? (int)0x80000000 : mkkey(v1f[3] + v2f[0], 48, 255);
    c[30] = sub ? (int)0x80000000 : mkkey(v1f[3] + v2f[1], 49, 255);
    c[31] = sub ? (int)0x80000000 : mkkey(v1f[3] + v2f[2], 50, 255);
    int h0[16], h1[16];
#pragma unroll
    for (int i = 0; i < 16; ++i) { h0[i] = c[i]; h1[i] = c[16 + i]; }
    bitonic_sort_desc<16>(h0); bitonic_sort_desc<16>(h1);
    merge16(h0, h1);
    merge_partner(h0, 1);
    float sv[16];
#pragma unroll
    for (int i = 0; i < 16; ++i) sv[i] = __int_as_float(key2bits(h0[i]));
    float den = 0.f;
#pragma unroll
    for (int i = 0; i < 16; ++i) den += __expf(sv[i] - sv[0]);
    const float inv = 1.f / den;
    int eo[8]; float go[8];
#pragma unroll
    for (int i = 0; i < 8; ++i) {
      int klo = h0[i], khi = h0[8 + i];
      asm volatile("" : "+v"(klo), "+v"(khi));
      const int kk = sub ? khi : klo;
      const int bits = key2bits(kk);
      const int code = bits & 255;
      const int ia = key2bits(s_top[(size_t)tok * 16 + (code >> 4)]) & 127;
      const int ib = key2bits(s_top[(size_t)(128 + tok) * 16 + (code & 15)]) & 127;
      eo[i] = ia * 128 + ib;
      go[i] = __expf(__int_as_float(bits) - sv[0]) * inv;
    }
    const size_t ob = ((size_t)(n0 + tok) * 8 + head) * 16 + sub * 8;
    *(int4*)(p.eidx + ob) = make_int4(eo[0], eo[1], eo[2], eo[3]);
    *(int4*)(p.eidx + ob + 4) = make_int4(eo[4], eo[5], eo[6], eo[7]);
    *(float4*)(p.egate + ob) = make_float4(go[0], go[1], go[2], go[3]);
    *(float4*)(p.egate + ob + 4) = make_float4(go[4], go[5], go[6], go[7]);
  }
}

__device__ __forceinline__ void ph_subkeys(const Params& p) {
  for (int i = blockIdx.x * 256 + threadIdx.x; i < 2 * 128 * 64; i += gridDim.x * 256) {
    const float v = (i < 8192) ? p.sk1[i] : p.sk2[i - 8192];
    const ushort_t hi = f2bf(v);
    p.skh[i] = hi;
    p.skl[i] = f2bf(v - bf2f(hi));
  }
}

__device__ __forceinline__ float dot16_fp8(const uint4 d, const float (&x)[16], float c) {
  const unsigned w[4] = {d.x, d.y, d.z, d.w};
#pragma unroll
  for (int i = 0; i < 4; ++i) {
    const f32x2_t lo = __builtin_amdgcn_cvt_pk_f32_fp8((int)w[i], false);
    const f32x2_t hi = __builtin_amdgcn_cvt_pk_f32_fp8((int)w[i], true);
    c = fmaf(lo.x, x[4 * i], c); c = fmaf(lo.y, x[4 * i + 1], c); c = fmaf(hi.x, x[4 * i + 2], c); c = fmaf(hi.y, x[4 * i + 3], c);
  }
  return c;
}
__device__ __forceinline__ void axpy16_fp8(const float cf, const uint4 u, float (&acc)[16]) {
  const unsigned w[4] = {u.x, u.y, u.z, u.w};
#pragma unroll
  for (int i = 0; i < 4; ++i) {
    const f32x2_t lo = __builtin_amdgcn_cvt_pk_f32_fp8((int)w[i], false);
    const f32x2_t hi = __builtin_amdgcn_cvt_pk_f32_fp8((int)w[i], true);
    acc[4 * i] = fmaf(cf, lo.x, acc[4 * i]); acc[4 * i + 1] = fmaf(cf, lo.y, acc[4 * i + 1]);
    acc[4 * i + 2] = fmaf(cf, hi.x, acc[4 * i + 2]); acc[4 * i + 3] = fmaf(cf, hi.y, acc[4 * i + 3]);
  }
}
constexpr int EX_NTOK = 4;
__device__ __forceinline__ void peer_chunk(const Params& p, const int lane, const int myex, const bool b5, const bool b4, const bool b3,
                                           const int (&ce)[8], const float (&cg)[8], const f32x2_t (&x2)[8], f32x2_t (&acc2)[8]) {
  drow_t d[8];
  urow_t u[8];
  float sd[8], su[8];
#pragma unroll
  for (int i = 0; i < 8; ++i) d[i] = *(const drow_t*)(p.ed8 + ((size_t)ce[i] * 64 + lane) * DROW_BYTES);
#pragma unroll
  for (int i = 0; i < 8; ++i) u[i] = *(const urow_t*)(p.eu8 + ((size_t)ce[i] * 64 + lane) * UROW_BYTES);
#pragma unroll
  for (int i = 0; i < 8; ++i) { sd[i] = p.ed_s[ce[i]]; su[i] = p.eu_s[ce[i]] * cg[i]; }
  float pr[8];
#pragma unroll
  for (int i = 0; i < 8; ++i) {
    f32x2_t dd[8];
    DEC_D(d[i], dd);
    f32x2_t a2 = {0.f, 0.f};
#pragma unroll
    for (int k = 0; k < 8; ++k) a2 = dd[k] * x2[k] + a2;
    pr[i] = (a2.x + a2.y) * sd[i];
  }
  float q4[4];
#pragma unroll
  for (int i = 0; i < 4; ++i) {
    const float snd = b5 ? pr[i] : pr[i + 4];
    const float kp = b5 ? pr[i + 4] : pr[i];
    q4[i] = kp + __shfl_xor(snd, 32);
  }
  float q2[2];
#pragma unroll
  for (int i = 0; i < 2; ++i) {
    const float snd = b4 ? q4[i] : q4[i + 2];
    const float kp = b4 ? q4[i + 2] : q4[i];
    q2[i] = kp + __shfl_xor(snd, 16);
  }
  float q1;
  {
    const float snd = b3 ? q2[0] : q2[1];
    const float kp = b3 ? q2[1] : q2[0];
    q1 = kp + __shfl_xor(snd, 8);
  }
  q1 += __shfl_xor(q1, 4);
  q1 += __shfl_xor(q1, 2);
  q1 += __shfl_xor(q1, 1);
  const float act = gelu_f(q1);
#pragma unroll
  for (int i = 0; i < 8; ++i) {
    const int src = ((i >> 2) & 1) * 32 + ((i >> 1) & 1) * 16 + (i & 1) * 8;
    const float cf = __int_as_float(__builtin_amdgcn_readlane(__float_as_int(act), src)) * su[i];
    const f32x2_t cf2 = {cf, cf};
    f32x2_t uu[8];
    DEC_U(u[i], uu);
#pragma unroll
    for (int k = 0; k < 8; ++k) acc2[k] = cf2 * uu[k] + acc2[k];
  }
}

#ifndef EX_SWEEP
#define EX_SWEEP 0
#endif
#if !EX_SWEEP
typedef __attribute__((ext_vector_type(8))) int v8i_t;
typedef __attribute__((ext_vector_type(4))) float f32x4_t;
__device__ __forceinline__ void k_peer_experts(const int VB, char* smem, const Params& p, const ushort_t* __restrict__ hn) {
  const int lane = threadIdx.x & 63;
  const int wave = __builtin_amdgcn_readfirstlane(threadIdx.x >> 6);
  const int t = VB * 4 + wave;
  const int li = lane & 15, g = lane >> 4;
  char* sx = smem + wave * 1024;
  {
    float f0[8], f1[8];
    unpack8(*(const uint4*)(hn + (size_t)t * DM + lane * 16), f0);
    unpack8(*(const uint4*)(hn + (size_t)t * DM + lane * 16 + 8), f1);
    int w0 = 0, w1 = 0, w2 = 0, w3 = 0;
    w0 = __builtin_amdgcn_cvt_pk_fp8_f32(f0[0] * 16.f, f0[1] * 16.f, w0, false); w0 = __builtin_amdgcn_cvt_pk_fp8_f32(f0[2] * 16.f, f0[3] * 16.f, w0, true);
    w1 = __builtin_amdgcn_cvt_pk_fp8_f32(f0[4] * 16.f, f0[5] * 16.f, w1, false); w1 = __builtin_amdgcn_cvt_pk_fp8_f32(f0[6] * 16.f, f0[7] * 16.f, w1, true);
    w2 = __builtin_amdgcn_cvt_pk_fp8_f32(f1[0] * 16.f, f1[1] * 16.f, w2, false); w2 = __builtin_amdgcn_cvt_pk_fp8_f32(f1[2] * 16.f, f1[3] * 16.f, w2, true);
    w3 = __builtin_amdgcn_cvt_pk_fp8_f32(f1[4] * 16.f, f1[5] * 16.f, w3, false); w3 = __builtin_amdgcn_cvt_pk_fp8_f32(f1[6] * 16.f, f1[7] * 16.f, w3, true);
    *(int4*)(sx + lane * 16) = make_int4(w0, w1, w2, w3);
  }
  v8i_t xb[8];
#pragma unroll
  for (int st = 0; st < 8; ++st) {
    const int4 lo = *(const int4*)(sx + st * 128 + g * 16);
    const int4 hi = *(const int4*)(sx + st * 128 + 64 + g * 16);
    xb[st] = v8i_t{lo.x, lo.y, lo.z, lo.w, hi.x, hi.y, hi.z, hi.w};
  }
  f32x2_t acc2[8];
#pragma unroll
  for (int i = 0; i < 8; ++i) acc2[i] = f32x2_t{0.f, 0.f};
  const int* ei = p.eidx + (size_t)t * 128;
  const float* eg = p.egate + (size_t)t * 128;
#pragma unroll 1
  for (int c = 0; c < 8; ++c) {
    const int e_lane = ei[c * 16 + li];
    const unsigned char* arow = p.ed8 + (size_t)e_lane * 512 + g * 16;
    uint4 a[8];
#pragma unroll
    for (int st = 0; st < 8; ++st) a[st] = *(const uint4*)(arow + st * 64);
    urow_t u[16];
#pragma unroll
    for (int i = 0; i < 16; ++i) u[i] = *(const urow_t*)(p.eu8 + ((size_t)ei[c * 16 + i] * 64 + lane) * UROW_BYTES);
    const int4 e4 = *(const int4*)(ei + c * 16 + g * 4);
    const float4 g4 = *(const float4*)(eg + c * 16 + g * 4);
    const float sd0 = p.ed_s[e4.x], sd1 = p.ed_s[e4.y], sd2 = p.ed_s[e4.z], sd3 = p.ed_s[e4.w];
    const float su0 = p.eu_s[e4.x], su1 = p.eu_s[e4.y], su2 = p.eu_s[e4.z], su3 = p.eu_s[e4.w];
    f32x4_t d4 = {0.f, 0.f, 0.f, 0.f};
#pragma unroll
    for (int st = 0; st < 8; ++st) {
      const v8i_t av = v8i_t{(int)a[st].x, (int)a[st].y, (int)a[st].z, (int)a[st].w, 0, 0, 0, 0};
      d4 = __builtin_amdgcn_mfma_scale_f32_16x16x128_f8f6f4(av, xb[st], d4, 4, 0, 0, 0x7f7f7f7f, 0, 0x7f7f7f7f);
    }
    float cv[4];
    cv[0] = gelu_f(d4[0] * sd0 * 0.0625f) * g4.x * su0;
    cv[1] = gelu_f(d4[1] * sd1 * 0.0625f) * g4.y * su1;
    cv[2] = gelu_f(d4[2] * sd2 * 0.0625f) * g4.z * su2;
    cv[3] = gelu_f(d4[3] * sd3 * 0.0625f) * g4.w * su3;
#pragma unroll
    for (int i = 0; i < 16; ++i) {
      const float cf = __int_as_float(__builtin_amdgcn_readlane(__float_as_int(cv[i & 3]), 16 * (i >> 2)));
      const f32x2_t cf2 = {cf, cf};
      f32x2_t uu[8];
      DEC_U(u[i], uu);
#pragma unroll
      for (int k = 0; k < 8; ++k) acc2[k] = cf2 * uu[k] + acc2[k];
    }
  }
  float* orow = p.out + (size_t)t * DM + lane * 16;
#pragma unroll
  for (int i = 0; i < 4; ++i) {
    float4 hv = *(float4*)(orow + i * 4);
    hv.x += acc2[2 * i].x; hv.y += acc2[2 * i].y; hv.z += acc2[2 * i + 1].x; hv.w += acc2[2 * i + 1].y;
    *(float4*)(orow + i * 4) = hv;
  }
}
#define EX_TOK_PER_VB 4
#else
#define EX_TOK_PER_VB (4 * EX_NTOK)
__device__ __forceinline__ void k_peer_experts(const int VB, const Params& p, const ushort_t* __restrict__ hn) {
  const int lane = threadIdx.x & 63;
  const int wave = __builtin_amdgcn_readfirstlane(threadIdx.x >> 6);
  const int t0 = (VB * 4 + wave) * EX_NTOK;
  const int myex = ((lane >> 5) & 1) * 4 + ((lane >> 4) & 1) * 2 + ((lane >> 3) & 1);
  const bool b5 = (lane & 32) != 0, b4 = (lane & 16) != 0, b3 = (lane & 8) != 0;
  f32x2_t x2[EX_NTOK][8], acc2[EX_NTOK][8];
  int e0[EX_NTOK], e1[EX_NTOK];
  float g0[EX_NTOK], g1[EX_NTOK];
#pragma unroll
  for (int k = 0; k < EX_NTOK; ++k) {
    float f0[8], f1[8];
    unpack8(*(const uint4*)(hn + (size_t)(t0 + k) * DM + lane * 16), f0);
    unpack8(*(const uint4*)(hn + (size_t)(t0 + k) * DM + lane * 16 + 8), f1);
#pragma unroll
    for (int i = 0; i < 4; ++i) {
      x2[k][i] = f32x2_t{f0[2 * i], f0[2 * i + 1]};
      x2[k][4 + i] = f32x2_t{f1[2 * i], f1[2 * i + 1]};
    }
#pragma unroll
    for (int i = 0; i < 8; ++i) acc2[k][i] = f32x2_t{0.f, 0.f};
    e0[k] = p.eidx[(size_t)(t0 + k) * 128 + lane];
    e1[k] = p.eidx[(size_t)(t0 + k) * 128 + 64 + lane];
    g0[k] = p.egate[(size_t)(t0 + k) * 128 + lane];
    g1[k] = p.egate[(size_t)(t0 + k) * 128 + 64 + lane];
  }
#pragma unroll 1
  for (int s = 0; s < 16; ++s) {
#pragma unroll
    for (int k = 0; k < EX_NTOK; ++k) {
      unsigned long long m0 = __ballot((e0[k] >> 10) == s);
      unsigned long long m1 = __ballot((e1[k] >> 10) == s);
      while ((m0 | m1) != 0ull) {
        int ce[8];
        float cg[8];
#pragma unroll
        for (int i = 0; i < 8; ++i) {
          int ev = 0;
          float gv = 0.f;
          if (m0 != 0ull) {
            const int ln = __builtin_ctzll(m0);
            m0 &= m0 - 1ull;
            ev = __builtin_amdgcn_readlane(e0[k], ln);
            gv = __int_as_float(__builtin_amdgcn_readlane(__float_as_int(g0[k]), ln));
          } else if (m1 != 0ull) {
            const int ln = __builtin_ctzll(m1);
            m1 &= m1 - 1ull;
            ev = __builtin_amdgcn_readlane(e1[k], ln);
            gv = __int_as_float(__builtin_amdgcn_readlane(__float_as_int(g1[k]), ln));
          }
          ce[i] = ev;
          cg[i] = gv;
        }
        peer_chunk(p, lane, myex, b5, b4, b3, ce, cg, x2[k], acc2[k]);
      }
    }
  }
#pragma unroll
  for (int k = 0; k < EX_NTOK; ++k) {
    float* orow = p.out + (size_t)(t0 + k) * DM + lane * 16;
#pragma unroll
    for (int i = 0; i < 4; ++i) {
      float4 hv = *(float4*)(orow + i * 4);
      hv.x += acc2[k][2 * i].x; hv.y += acc2[k][2 * i].y; hv.z += acc2[k][2 * i + 1].x; hv.w += acc2[k][2 * i + 1].y;
      *(float4*)(orow + i * 4) = hv;
    }
  }
}

#endif

#define PHASE(NBLK, CALL) \
  for (int VB = blockIdx.x; VB < (NBLK); VB += gridDim.x) { CALL; __syncthreads(); }
#define PHASE_NS(NBLK, CALL) \
  for (int VB = blockIdx.x; VB < (NBLK); VB += gridDim.x) { CALL; }
#define PHASE_OFF(OFF, NBLK, CALL) \
  for (int VB = (int)((blockIdx.x + gridDim.x - ((OFF) % gridDim.x)) % gridDim.x); VB < (NBLK); VB += gridDim.x) { CALL; __syncthreads(); }

__global__ __launch_bounds__(256, 2) void fwd_megakernel(Params p) {
  __shared__ __attribute__((aligned(16))) char smem_raw[SMEM_BYTES];
  float* smem = (float*)smem_raw;
  volatile LAS unsigned* xb_st = (volatile LAS unsigned*)(smem_raw + 73728);
  if (threadIdx.x == 0) { xb_st[0] = 0u; xb_st[1] = 0u; xb_st[2] = 0u; xb_st[3] = 0u; }
  __syncthreads();
  const XcdBarrier xb = xcd_barrier_post(p.bar, xb_st);
  {
    for (int k = threadIdx.x; k < DM; k += 256) {
      const float* wr = p.w_in + (size_t)k * INC + 1536;
      const float4 a = *(const float4*)(wr), b = *(const float4*)(wr + 4);
      smem[0 * 1024 + k] = a.x; smem[1 * 1024 + k] = a.y; smem[2 * 1024 + k] = a.z; smem[3 * 1024 + k] = a.w;
      smem[4 * 1024 + k] = b.x; smem[5 * 1024 + k] = b.y; smem[6 * 1024 + k] = b.z; smem[7 * 1024 + k] = b.w;
    }
    __syncthreads();
    PHASE_NS(NT / 8, ph_rmsnorm_bf16(VB, p.x, p.mix_norm_w, p.xn_b, smem, p.dt_bias, p.dt));
    __syncthreads();
  }
  PHASE_NS(NB * MEM / 8, ph_rmsnorm_bf16(VB, p.mem, p.mem_norm_w, p.memn_b, nullptr, nullptr, nullptr));
  PHASE(16 * 40, ph_wtrans(VB, smem, p.w_in, INC, p.w_inT, 40, 8));
  PHASE(16 * 16, ph_wtrans(VB, smem, p.w_out, DM, p.w_outT, 16, 0));
  PHASE(16 * 16, ph_wtrans(VB, smem, p.w_query, DM, p.w_qT, 16, 0));
  PHASE(16 * 8, ph_wtrans(VB, smem, p.w_mem_kv, 512, p.w_memT, 8, 0));
  if (blockIdx.x == 0) p.bcnt[threadIdx.x] = 0;
  ph_subkeys(p);
#if EX_FP4_DOWN
  PHASE_NS(4096, ph_cvt4(VB, p.e_down, p.ed8, p.ed_s));
#else
  PHASE_NS(4096, ph_cvt8(VB, p.e_down, p.ed8, p.ed_s));
#endif
#if EX_FP4_UP
  PHASE_NS(4096, ph_cvt4(VB, p.e_up, p.eu8, p.eu_s));
#else
  PHASE_NS(4096, ph_cvt8(VB, p.e_up, p.eu8, p.eu_s));
#endif
  xcd_barrier(xb);
  PHASE(20 * (NT / 128), ph_gemm_proj(VB, smem_raw, p));
  xcd_barrier(xb);
  PHASE(NB * 64 * 8, ph_ssd1(VB, smem_raw, p));
  PHASE(NB * 4 * 32, k_gate(VB, smem_raw, p));
  PHASE_OFF(256, 4 * (NB * MEM / 128), ph_gemm_mem(VB, smem_raw, p));
  xcd_barrier(xb);
  PHASE_NS(NB * 8 * 64 * 128 / 256, ph_ssd2(VB, p));
  {
    int* s_pref = (int*)(smem_raw + 72192);
    {
      const int tid = threadIdx.x;
      int v = (p.bcnt[tid] + 127) >> 7;
      const int lane = tid & 63;
#pragma unroll
      for (int o = 1; o < 64; o <<= 1) { int nb = __shfl_up(v, o); if (lane >= o) v += nb; }
      int* s_wt = s_pref + 256;
      if (lane == 63) s_wt[tid >> 6] = v;
      __syncthreads();
      int add = 0;
      for (int ww = 0; ww < (tid >> 6); ++ww) add += s_wt[ww];
      s_pref[tid] = v + add;
      __syncthreads();
    }
    const int Ug = s_pref[255];
    for (int u = blockIdx.x; u < Ug + NB * 4 * 32 * 2 + NB * 4 * 64; u += gridDim.x) {
      if (u >= Ug + NB * 4 * 32 * 2) {
        const int v = u - Ug - NB * 4 * 32 * 2;
        ph_attn_unit(2, v >> 6, v & 63, smem_raw, p);
      } else if (u < Ug) {
        int lo = 0, hi = 255;
        while (lo < hi) { int mid = (lo + hi) >> 1; if (s_pref[mid] > u) hi = mid; else lo = mid + 1; }
        const int prev = lo ? s_pref[lo - 1] : 0;
        ph_attn_unit(0, lo, u - prev, smem_raw, p);
      } else {
        const int v = u - Ug;
        ph_attn_unit(1, v >> 1, v & 1, smem_raw, p);
      }
      __syncthreads();
    }
  }
  xcd_barrier(xb);
  PHASE(NB * 64 * 2, ph_ssd3(VB, smem_raw, p));
  if (gridDim.x >= 512) {
    for (int VB = (int)blockIdx.x - 256; VB >= 0 && VB < NT * 4 * 8 / 256; VB += gridDim.x - 256) ph_attn_combine(VB, p);
  } else {
    PHASE_NS(NT * 4 * 8 / 256, ph_attn_combine(VB, p));
  }
  xcd_barrier(xb);
  PHASE(8 * (NT / 128), ph_gemm_f32(VB, smem_raw, p.mixed_b, p.w_outT, p.out, p.x));
  xcd_barrier(xb);
  ushort_t* hn_b = p.xn_b;
  PHASE_NS(NT / 8, ph_rmsnorm_bf16(VB, p.out, p.ffn_norm_w, hn_b, nullptr, nullptr, nullptr));
  xcd_barrier(xb);
  PHASE(8 * (NT / 128), ph_gemm_route(VB, smem_raw, p, hn_b));
  xcd_barrier(xb);
  PHASE_NS(NT / EX_TOK_PER_VB, k_peer_experts(VB, smem_raw, p, hn_b));
}
}

extern "C" void kernel_launch(void* const* d_in, const int* in_sizes, int n_in, void* d_out, int out_size, void* d_ws, size_t ws_size,
                              hipStream_t stream) {
  Params p{};
  p.x = (const float*)d_in[0]; p.mem = (const float*)d_in[1]; p.mix_norm_w = (const float*)d_in[2]; p.w_in = (const float*)d_in[3];
  p.conv_w = (const float*)d_in[4]; p.conv_b = (const float*)d_in[5]; p.dt_bias = (const float*)d_in[6]; p.a_log = (const float*)d_in[7];
  p.ssd_d = (const float*)d_in[8]; p.ssd_norm_w = (const float*)d_in[9]; p.mq_norm_w = (const float*)d_in[10]; p.mk_norm_w = (const float*)d_in[11];
  p.mem_norm_w = (const float*)d_in[12]; p.w_mem_kv = (const float*)d_in[13]; p.xq_norm_w = (const float*)d_in[14]; p.xk_norm_w = (const float*)d_in[15];
  p.w_out = (const float*)d_in[16]; p.ffn_norm_w = (const float*)d_in[17]; p.w_query = (const float*)d_in[18]; p.sk1 = (const float*)d_in[19];
  p.sk2 = (const float*)d_in[20]; p.e_down = (const float*)d_in[21]; p.e_up = (const float*)d_in[22];
  p.out = (float*)d_out;
  char* ws = (char*)d_ws;
  size_t o = 0;
  auto take = [&](size_t bytes) { char* q = ws + o; o += (bytes + 255) & ~(size_t)255; return q; };
  p.xn_b = (ushort_t*)take((size_t)NT * DM * 2);
  p.xc = p.xn_b;
  p.w_inT = (ushort_t*)take((size_t)NPROJ * DM * 2);
  p.w_outT = (ushort_t*)take((size_t)DM * DM * 2);
  p.w_qT = (ushort_t*)take((size_t)DM * DM * 2);
  p.w_memT = (ushort_t*)take((size_t)512 * DM * 2);
  p.memn_b = (ushort_t*)take((size_t)NB * MEM * DM * 2);
  p.memk_b = (ushort_t*)take((size_t)NB * MEM * 256 * 2);
  p.memvT = (ushort_t*)take((size_t)NB * MEM * 256 * 2);
  char* regQ = take((size_t)NT * 2560 * 2);
  p.zs = (ushort_t*)regQ;
  p.xbc_raw = (ushort_t*)(regQ + (size_t)NT * 512 * 2);
  p.mq = (ushort_t*)(regQ + (size_t)NT * 1536 * 2);
  p.mk = (ushort_t*)(regQ + (size_t)NT * 1792 * 2);
  p.vT = (ushort_t*)(regQ + (size_t)NT * 2048 * 2);
  p.xq = (ushort_t*)(regQ + (size_t)NT * 2304 * 2);
  p.q = (float*)regQ;
  p.dt = (float*)take((size_t)NT * 8 * 4);
  p.acs = (float*)take((size_t)NT * 8 * 4);
  p.cdec = (float*)take((size_t)NB * 64 * 8 * 4);
  p.states = (float*)d_out;
  p.sin_b = (ushort_t*)((char*)d_out + (size_t)NB * 64 * 8 * 8192 * 4);
  p.xT = (ushort_t*)((char*)d_out + (size_t)NB * 64 * 8 * 8192 * 6);
  p.mixed_b = (ushort_t*)take((size_t)NT * DM * 2);
  p.kpart = (float*)take((size_t)NB * 4 * 32 * 4 * 64 * 4);
  p.bcnt = (int*)take(256 * 4);
  p.blist = (int*)take((size_t)256 * 8192 * 4);
  p.pm = (float*)take((size_t)NT * 16 * 4);
  p.pl = (float*)take((size_t)NT * 16 * 4);
  p.pO = p.xbc_raw;
  p.eidx = (int*)take((size_t)NT * 128 * 4);
  p.egate = (float*)take((size_t)NT * 128 * 4);
  p.ed8 = (unsigned char*)take((size_t)16384 * DM);
  p.eu8 = (unsigned char*)take((size_t)16384 * DM);
  p.ed_s = (float*)take(16384 * 4);
  p.eu_s = (float*)take(16384 * 4);
  p.bar = (unsigned*)take(XCD_BAR_WORDS * 4);
  p.skh = (ushort_t*)take(2 * 128 * 64 * 2);
  p.skl = (ushort_t*)take(2 * 128 * 64 * 2);
  if (o > ws_size) return;
  (void)hipMemsetAsync(p.bar, 0, XCD_BAR_WORDS * 4, stream);
  static int grid_blocks = 0;
  if (!grid_blocks) {
    int dev = 0, cus = 0, per_cu = 0;
    (void)hipGetDevice(&dev);
    (void)hipDeviceGetAttribute(&cus, hipDeviceAttributeMultiprocessorCount, dev);
    (void)hipOccupancyMaxActiveBlocksPerMultiprocessor(&per_cu, fwd_megakernel, 256, 0);
    if (per_cu > 2) per_cu = 2;
    if (per_cu < 1) per_cu = 1;
    grid_blocks = cus * per_cu;
  }
  void* args[] = {&p};
  hipError_t e = hipLaunchCooperativeKernel((void*)fwd_megakernel, dim3(grid_blocks), dim3(256), args, 0, stream);
  if (e != hipSuccess) fprintf(stderr, "cooperative launch failed: %s (grid %d)\n", hipGetErrorString(e), grid_blocks);
}
```

```cpp
#include <hip/hip_runtime.h>
#include <hip/hip_cooperative_groups.h>
#include <cstdio>
#include <math.h>
#include <stdint.h>
namespace cg = cooperative_groups;

#ifndef EX_FP4_DOWN
#define EX_FP4_DOWN 1
#endif
#ifndef EX_FP4_UP
#define EX_FP4_UP 1
#endif
namespace {
typedef unsigned short ushort_t;
typedef __attribute__((ext_vector_type(8))) short bf16x8;
typedef __attribute__((ext_vector_type(16))) float f32x16;

constexpr int DM = 1024;
constexpr int NB = 2;
constexpr int SL = 8192;
constexpr int NT = NB * SL;
constexpr int MEM = 256;
constexpr int INC = 2568;
constexpr int NPROJ = 2560;
constexpr float EPS = 1e-6f;
constexpr int SMEM_BYTES = 73728 + 256;

__device__ __forceinline__ float silu_f(float x) { return x * __frcp_rn(1.f + __expf(-x)); }
__device__ __forceinline__ float softplus_f(float x) { return fmaxf(x, 0.f) + log1pf(expf(-fabsf(x))); }
__device__ __forceinline__ float gelu_f(float x) { return 0.5f * x * (1.f + erff(x * 0.70710678118654752f)); }
__device__ __forceinline__ float gelu_fast(float x) {
  const float z = fabsf(x) * 0.70710678118654752f;
  const float t = __frcp_rn(fmaf(0.3275911f, z, 1.f));
  float pl = fmaf(1.061405429f, t, -1.453152027f);
  pl = fmaf(pl, t, 1.421413741f);
  pl = fmaf(pl, t, -0.284496736f);
  pl = fmaf(pl, t, 0.254829592f);
  const float er = 1.f - pl * t * __expf(-z * z);
  return 0.5f * x * (1.f + copysignf(er, x));
}
typedef __attribute__((ext_vector_type(2))) __bf16 bf16x2_hw;
typedef __attribute__((ext_vector_type(2))) float f32x2_hw;
__device__ __forceinline__ unsigned pack2(float a, float b) {
  const f32x2_hw v = {a, b};
  return __builtin_bit_cast(unsigned, __builtin_convertvector(v, bf16x2_hw));
}
__device__ __forceinline__ ushort_t f2bf(float x) { return (ushort_t)(pack2(x, 0.f) & 0xffffu); }
__device__ __forceinline__ float bf2f(ushort_t h) { return __uint_as_float(((unsigned)h) << 16); }
__device__ __forceinline__ float bflo(unsigned w) { return __uint_as_float(w << 16); }
__device__ __forceinline__ float bfhi(unsigned w) { return __uint_as_float(w & 0xffff0000u); }

__device__ __forceinline__ void unpack8(const uint4 v, float (&f)[8]) {
  f[0] = bflo(v.x); f[1] = bfhi(v.x); f[2] = bflo(v.y); f[3] = bfhi(v.y);
  f[4] = bflo(v.z); f[5] = bfhi(v.z); f[6] = bflo(v.w); f[7] = bfhi(v.w);
}

__device__ __forceinline__ float wave_sum(float v) {
#pragma unroll
  for (int o = 32; o > 0; o >>= 1) v += __shfl_xor(v, o);
  return v;
}
__device__ __forceinline__ float wave_max(float v) {
#pragma unroll
  for (int o = 32; o > 0; o >>= 1) v = fmaxf(v, __shfl_xor(v, o));
  return v;
}


#define XB_TMO      128
#define XB_XCNT(j)  (256  + 64 * (j))
#define XB_XSUB(j)  (1280 + 64 * (j))
#define XB_XGEN(j)  (2304 + 64 * (j))
#define XB_TOP      3328
#define XB_TOPGEN   3392
#define XCD_BAR_WORDS 3456
#define XB_SPIN_CAP (1u << 20)
#define LAS __attribute__((address_space(3)))
__device__ __forceinline__ unsigned xb_ld(unsigned* p)              { return __hip_atomic_load(p, __ATOMIC_RELAXED, __HIP_MEMORY_SCOPE_AGENT); }
__device__ __forceinline__ unsigned xb_add(unsigned* p, unsigned v) { return __hip_atomic_fetch_add(p, v, __ATOMIC_RELAXED, __HIP_MEMORY_SCOPE_AGENT); }
__device__ __forceinline__ unsigned xb_xcc_id() { return (unsigned)__builtin_amdgcn_s_getreg((3 << 11) | 20) & 0xFu; }
#define XB_SPIN(cond, bar) do { unsigned _sp = 0; while (cond) { __builtin_amdgcn_s_sleep(1); \
    if ((++_sp & 255u) == 0u) { if (xb_ld(&(bar)[XB_TMO])) break; if (_sp > XB_SPIN_CAP) { atomicAdd(&(bar)[XB_TMO], 1u); break; } } } } while (0)
struct XcdBarrier { unsigned* bar; unsigned x; volatile LAS unsigned* st; };
__device__ __forceinline__ XcdBarrier xcd_barrier_post(unsigned* bar, volatile LAS unsigned* st) {
  XcdBarrier b; b.bar = bar; b.x = xb_xcc_id(); b.st = st;
  if (threadIdx.x == 0) (void)xb_add(&bar[XB_XCNT(b.x)], 1u);
  return b;
}
__device__ __forceinline__ void xcd_barrier_complete(unsigned* bar, unsigned x, unsigned& nloc, unsigned& nx) {
  const unsigned G = gridDim.x * gridDim.y * gridDim.z;
  unsigned sum, cnt, mine, sp = 0u;
  for (;;) {
    sum = 0u; cnt = 0u; mine = 0u;
#pragma unroll
    for (unsigned j = 0; j < 16; ++j) { const unsigned c = xb_ld(&bar[XB_XCNT(j)]); sum += c; cnt += (c > 0u) ? 1u : 0u; mine = (j == x) ? c : mine; }
    if (sum == G) break;
    __builtin_amdgcn_s_sleep(1);
    if ((++sp & 255u) == 0u) { if (xb_ld(&bar[XB_TMO])) break; if (sp > XB_SPIN_CAP) { atomicAdd(&bar[XB_TMO], 1u); break; } }
  }
  nloc = mine > 0u ? mine : 1u; nx = cnt > 0u ? cnt : 1u;
}
__device__ __forceinline__ void xcd_barrier(const XcdBarrier& b) {
  asm volatile("s_waitcnt vmcnt(0)" ::: "memory");
  __syncthreads();
  if (threadIdx.x == 0) {
    unsigned* bar = b.bar;
    __builtin_amdgcn_s_waitcnt(0);
    unsigned nloc = b.st[0], nx = b.st[1];
    if (nloc == 0u) { xcd_barrier_complete(bar, b.x, nloc, nx); b.st[0] = nloc; b.st[1] = nx; }
    const unsigned old = xb_add(&bar[XB_XSUB(b.x)], 1u);
    const unsigned gen = old / nloc;
    if (old + 1u == (gen + 1u) * nloc) {
      __builtin_amdgcn_fence(__ATOMIC_RELEASE, "agent");
      asm volatile("s_waitcnt vmcnt(0)" ::: "memory");
      const unsigned og = xb_add(&bar[XB_TOP], 1u);
      const unsigned tg = og / nx;
      if (og + 1u == (tg + 1u) * nx) xb_add(&bar[XB_TOPGEN], 1u);
      else XB_SPIN(xb_ld(&bar[XB_TOPGEN]) == tg, bar);
      __builtin_amdgcn_fence(__ATOMIC_ACQUIRE, "agent");
      xb_add(&bar[XB_XGEN(b.x)], 1u);
      asm volatile("s_waitcnt vmcnt(0)" ::: "memory");
    } else {
      XB_SPIN(xb_ld(&bar[XB_XGEN(b.x)]) == gen, bar);
      __builtin_amdgcn_fence(__ATOMIC_ACQUIRE, "agent");
      asm volatile("s_waitcnt vmcnt(0)" ::: "memory");
    }
  }
  __syncthreads();
}

struct Params {
  const float *x, *mem, *mix_norm_w, *w_in, *conv_w, *conv_b, *dt_bias, *a_log, *ssd_d, *ssd_norm_w, *mq_norm_w, *mk_norm_w,
      *mem_norm_w, *w_mem_kv, *xq_norm_w, *xk_norm_w, *w_out, *ffn_norm_w, *w_query, *sk1, *sk2, *e_down, *e_up;
  float* out;
  ushort_t *xn_b, *w_inT, *w_outT, *w_qT, *w_memT, *memn_b, *zs, *xbc_raw, *mq, *mk, *xq, *memk_b, *mixed_b;
  float *dt, *q, *egate, *acs, *cdec, *states;
  ushort_t *xc, *xT, *sin_b;
  int *eidx, *bcnt, *blist;
  unsigned* bar;
  float* hss;
  ushort_t *skh, *skl;
  unsigned char *ed8, *eu8;
  float *ed_s, *eu_s;
  float *kpart, *pm, *pl;
  ushort_t *vT, *memvT, *pO;
};

__device__ __forceinline__ void ph_rmsnorm_bf16(const int vb, const float* __restrict__ x, const float* __restrict__ w,
                                                ushort_t* __restrict__ outb, const float* s_wdt  , const float* __restrict__ dt_bias,
                                                float* __restrict__ dt) {
  const int lane = threadIdx.x & 63;
  const int row0 = vb * 8 + (threadIdx.x >> 6) * 2;
  float4 v[2][4];
#pragma unroll
  for (int rr = 0; rr < 2; ++rr)
#pragma unroll
    for (int i = 0; i < 4; ++i) v[rr][i] = *(const float4*)(x + (size_t)(row0 + rr) * DM + i * 256 + lane * 4);
  float4 ww[4];
#pragma unroll
  for (int i = 0; i < 4; ++i) ww[i] = *(const float4*)(w + i * 256 + lane * 4);
#pragma unroll
  for (int rr = 0; rr < 2; ++rr) {
    const int row = row0 + rr;
    float ss = 0.f;
#pragma unroll
    for (int i = 0; i < 4; ++i) ss += v[rr][i].x * v[rr][i].x + v[rr][i].y * v[rr][i].y + v[rr][i].z * v[rr][i].z + v[rr][i].w * v[rr][i].w;
    ss = wave_sum(ss);
    const float r = rsqrtf(ss / DM + EPS);
    float part[8];
#pragma unroll
    for (int hh = 0; hh < 8; ++hh) part[hh] = 0.f;
#pragma unroll
    for (int i = 0; i < 4; ++i) {
      const float o0 = v[rr][i].x * r * ww[i].x, o1 = v[rr][i].y * r * ww[i].y, o2 = v[rr][i].z * r * ww[i].z, o3 = v[rr][i].w * r * ww[i].w;
      *(uint2*)(outb + (size_t)row * DM + i * 256 + lane * 4) = make_uint2(pack2(o0, o1), pack2(o2, o3));
      if (dt) {
        const float xs[4] = {o0, o1, o2, o3};
#pragma unroll
        for (int hh = 0; hh < 8; ++hh) {
          const float4 wv = *(const float4*)(s_wdt + hh * 1024 + i * 256 + lane * 4);
          part[hh] = fmaf(xs[0], wv.x, part[hh]); part[hh] = fmaf(xs[1], wv.y, part[hh]);
          part[hh] = fmaf(xs[2], wv.z, part[hh]); part[hh] = fmaf(xs[3], wv.w, part[hh]);
        }
      }
    }
    if (dt) {
      float mine = 0.f;
#pragma unroll
      for (int hh = 0; hh < 8; ++hh) {
        const float sfull = wave_sum(part[hh]);
        if (lane == hh) mine = sfull;
      }
      if (lane < 8) dt[(size_t)row * 8 + lane] = softplus_f(mine + dt_bias[lane]);
    }
  }
}

__device__ __forceinline__ void ph_wtrans(const int vb, float* smem, const float* __restrict__ W, const int ldw, ushort_t* __restrict__ Wt,
                                          const int ntiles, const int skip, const float* __restrict__ rowscale) {
  float (*s)[65] = (float (*)[65])smem;
  const int tid = threadIdx.x;
  const int kt = vb / ntiles, nt = vb % ntiles;
  const int nd0 = nt * 64;
  const int ns0 = (nd0 < 1536) ? nd0 : nd0 + skip;
  {
    const int k = tid >> 2, nc = (tid & 3) * 16;
    const float* src = W + (size_t)(kt * 64 + k) * ldw + ns0 + nc;
    const float rsc = rowscale ? rowscale[kt * 64 + k] : 1.f;
#pragma unroll
    for (int j = 0; j < 4; ++j) {
      float4 v = *(const float4*)(src + j * 4);
      v.x *= rsc; v.y *= rsc; v.z *= rsc; v.w *= rsc;
      s[k][nc + j * 4 + 0] = v.x; s[k][nc + j * 4 + 1] = v.y; s[k][nc + j * 4 + 2] = v.z; s[k][nc + j * 4 + 3] = v.w;
    }
  }
  __syncthreads();
  {
    const int n = tid >> 2, kc = (tid & 3) * 16;
    unsigned pk[8];
#pragma unroll
    for (int j = 0; j < 8; ++j) pk[j] = pack2(s[kc + 2 * j][n], s[kc + 2 * j + 1][n]);
    ushort_t* dst = Wt + (size_t)(nd0 + n) * DM + kt * 64 + kc;
    *(uint4*)(dst) = make_uint4(pk[0], pk[1], pk[2], pk[3]);
    *(uint4*)(dst + 8) = make_uint4(pk[4], pk[5], pk[6], pk[7]);
  }
}

__device__ __forceinline__ void ph_cvt(const int vb, const float* __restrict__ src, ushort_t* __restrict__ dst) {
  const size_t base = (size_t)vb * 8192 + threadIdx.x * 8;
  float4 a[4], b[4];
#pragma unroll
  for (int i = 0; i < 4; ++i) {
    a[i] = *(const float4*)(src + base + i * 2048);
    b[i] = *(const float4*)(src + base + i * 2048 + 4);
  }
#pragma unroll
  for (int i = 0; i < 4; ++i)
    *(uint4*)(dst + base + i * 2048) = make_uint4(pack2(a[i].x, a[i].y), pack2(a[i].z, a[i].w), pack2(b[i].x, b[i].y), pack2(b[i].z, b[i].w));
}


typedef __attribute__((ext_vector_type(2))) float f32x2_t;
__device__ __forceinline__ void ph_cvt8(const int vb, const float* __restrict__ src, unsigned char* __restrict__ dst, float* __restrict__ inv_scale) {
  const int lane = threadIdx.x & 63;
  const int row = vb * 4 + (threadIdx.x >> 6);
  const float* sr = src + (size_t)row * DM + lane * 16;
  float4 v[4];
#pragma unroll
  for (int i = 0; i < 4; ++i) v[i] = *(const float4*)(sr + i * 4);
  float am = 0.f;
#pragma unroll
  for (int i = 0; i < 4; ++i) am = fmaxf(fmaxf(fmaxf(am, fabsf(v[i].x)), fmaxf(fabsf(v[i].y), fabsf(v[i].z))), fabsf(v[i].w));
  am = wave_max(am);
  const float sc = (am > 0.f) ? 224.f / am : 1.f;
  unsigned w[4];
#pragma unroll
  for (int i = 0; i < 4; ++i) {
    int t = 0;
    t = __builtin_amdgcn_cvt_pk_fp8_f32(v[i].x * sc, v[i].y * sc, t, false);
    t = __builtin_amdgcn_cvt_pk_fp8_f32(v[i].z * sc, v[i].w * sc, t, true);
    w[i] = (unsigned)t;
  }
  *(uint4*)(dst + (size_t)row * DM + lane * 16) = make_uint4(w[0], w[1], w[2], w[3]);
  if (lane == 0) inv_scale[row] = (am > 0.f) ? am * (1.f / 224.f) : 1.f;
}

__device__ __forceinline__ void ph_cvt4(const int vb, const float* __restrict__ src, unsigned char* __restrict__ dst, float* __restrict__ inv_scale) {
  const int lane = threadIdx.x & 63;
  const int row = vb * 4 + (threadIdx.x >> 6);
  const float* sr = src + (size_t)row * DM + lane * 16;
  float4 v[4];
#pragma unroll
  for (int i = 0; i < 4; ++i) v[i] = *(const float4*)(sr + i * 4);
  float am = 0.f;
#pragma unroll
  for (int i = 0; i < 4; ++i) am = fmaxf(fmaxf(fmaxf(am, fabsf(v[i].x)), fmaxf(fabsf(v[i].y), fabsf(v[i].z))), fabsf(v[i].w));
  am = wave_max(am);
  const float sc = (am > 0.f) ? 6.f / am : 1.f;
  unsigned w0 = 0u, w1 = 0u;
  w0 = __builtin_amdgcn_cvt_scalef32_pk_fp4_f32(w0, v[0].x * sc, v[0].y * sc, 1.0f, 0);
  w0 = __builtin_amdgcn_cvt_scalef32_pk_fp4_f32(w0, v[0].z * sc, v[0].w * sc, 1.0f, 1);
  w0 = __builtin_amdgcn_cvt_scalef32_pk_fp4_f32(w0, v[1].x * sc, v[1].y * sc, 1.0f, 2);
  w0 = __builtin_amdgcn_cvt_scalef32_pk_fp4_f32(w0, v[1].z * sc, v[1].w * sc, 1.0f, 3);
  w1 = __builtin_amdgcn_cvt_scalef32_pk_fp4_f32(w1, v[2].x * sc, v[2].y * sc, 1.0f, 0);
  w1 = __builtin_amdgcn_cvt_scalef32_pk_fp4_f32(w1, v[2].z * sc, v[2].w * sc, 1.0f, 1);
  w1 = __builtin_amdgcn_cvt_scalef32_pk_fp4_f32(w1, v[3].x * sc, v[3].y * sc, 1.0f, 2);
  w1 = __builtin_amdgcn_cvt_scalef32_pk_fp4_f32(w1, v[3].z * sc, v[3].w * sc, 1.0f, 3);
  *(uint2*)(dst + (size_t)row * (DM / 2) + lane * 8) = make_uint2(w0, w1);
  if (lane == 0) inv_scale[row] = (am > 0.f) ? am * (1.f / 6.f) : 1.f;
}
__device__ __forceinline__ void dec16_fp8(const uint4 d, f32x2_t (&o)[8]) {
  const unsigned w[4] = {d.x, d.y, d.z, d.w};
#pragma unroll
  for (int k = 0; k < 4; ++k) {
    o[2 * k] = __builtin_amdgcn_cvt_pk_f32_fp8((int)w[k], false);
    o[2 * k + 1] = __builtin_amdgcn_cvt_pk_f32_fp8((int)w[k], true);
  }
}
__device__ __forceinline__ void dec16_fp4(const uint2 d, f32x2_t (&o)[8]) {
  o[0] = __builtin_amdgcn_cvt_scalef32_pk_f32_fp4(d.x, 1.0f, 0); o[1] = __builtin_amdgcn_cvt_scalef32_pk_f32_fp4(d.x, 1.0f, 1);
  o[2] = __builtin_amdgcn_cvt_scalef32_pk_f32_fp4(d.x, 1.0f, 2); o[3] = __builtin_amdgcn_cvt_scalef32_pk_f32_fp4(d.x, 1.0f, 3);
  o[4] = __builtin_amdgcn_cvt_scalef32_pk_f32_fp4(d.y, 1.0f, 0); o[5] = __builtin_amdgcn_cvt_scalef32_pk_f32_fp4(d.y, 1.0f, 1);
  o[6] = __builtin_amdgcn_cvt_scalef32_pk_f32_fp4(d.y, 1.0f, 2); o[7] = __builtin_amdgcn_cvt_scalef32_pk_f32_fp4(d.y, 1.0f, 3);
}
#if EX_FP4_DOWN
typedef uint2 drow_t;
#define DROW_BYTES 8
#define DEC_D dec16_fp4
#else
typedef uint4 drow_t;
#define DROW_BYTES 16
#define DEC_D dec16_fp8
#endif
#if EX_FP4_UP
typedef uint2 urow_t;
#define UROW_BYTES 8
#define DEC_U dec16_fp4
#else
typedef uint4 urow_t;
#define UROW_BYTES 16
#define DEC_U dec16_fp8
#endif

__device__ __forceinline__ int swz(int row, int ch) { return row * 128 + ((ch ^ ((row >> 1) & 7)) << 4); }

__device__ __forceinline__ void gemm_compute(const char* cA, const char* cB, const int arow, const int brow, const int xr, const int h,
                                             f32x16 (&acc)[2][2]) {
#pragma unroll
  for (int ks = 0; ks < 4; ++ks) {
    const int co = ((ks * 2 + h) ^ xr) << 4;
    bf16x8 a0 = *(const bf16x8*)(cA + arow + co);
    bf16x8 a1 = *(const bf16x8*)(cA + arow + 32 * 128 + co);
    bf16x8 b0 = *(const bf16x8*)(cB + brow + co);
    bf16x8 b1 = *(const bf16x8*)(cB + brow + 32 * 128 + co);
    acc[0][0] = __builtin_amdgcn_mfma_f32_32x32x16_bf16(a0, b0, acc[0][0], 0, 0, 0);
    acc[0][1] = __builtin_amdgcn_mfma_f32_32x32x16_bf16(a0, b1, acc[0][1], 0, 0, 0);
    acc[1][0] = __builtin_amdgcn_mfma_f32_32x32x16_bf16(a1, b0, acc[1][0], 0, 0, 0);
    acc[1][1] = __builtin_amdgcn_mfma_f32_32x32x16_bf16(a1, b1, acc[1][1], 0, 0, 0);
  }
}

__device__ __forceinline__ void gemm_core(const ushort_t* __restrict__ A, const ushort_t* __restrict__ Bt, const int K, const int m0,
                                          const int n0, char* smem, f32x16 (&acc)[2][2]) {
  int tid = threadIdx.x;
  asm volatile("" : "+v"(tid));
  const int lane = tid & 63;
  const int wave = __builtin_amdgcn_readfirstlane(tid >> 6);
  const int wm = wave >> 1, wn = wave & 1;
  const int r = lane & 31, h = lane >> 5;
  const int srow = wave * 8 + (lane >> 3);
  const int schs = (lane & 7) ^ ((srow >> 1) & 7);
  const ushort_t* Ag = A + (size_t)(m0 + srow) * K + schs * 8;
  const ushort_t* Bg = Bt + (size_t)(n0 + srow) * K + schs * 8;
  const size_t rs = (size_t)32 * K;
  char* wbase = smem + wave * 1024;
#define GLDS_TILE(BUF, koff) { \
    __builtin_amdgcn_global_load_lds((const unsigned*)(Ag + (koff)), (unsigned*)(wbase + (BUF)), 16, 0, 0); \
    __builtin_amdgcn_global_load_lds((const unsigned*)(Ag + rs + (koff)), (unsigned*)(wbase + (BUF) + 4096), 16, 0, 0); \
    __builtin_amdgcn_global_load_lds((const unsigned*)(Ag + 2 * rs + (koff)), (unsigned*)(wbase + (BUF) + 8192), 16, 0, 0); \
    __builtin_amdgcn_global_load_lds((const unsigned*)(Ag + 3 * rs + (koff)), (unsigned*)(wbase + (BUF) + 12288), 16, 0, 0); \
    __builtin_amdgcn_global_load_lds((const unsigned*)(Bg + (koff)), (unsigned*)(wbase + (BUF) + 16384), 16, 0, 0); \
    __builtin_amdgcn_global_load_lds((const unsigned*)(Bg + rs + (koff)), (unsigned*)(wbase + (BUF) + 16384 + 4096), 16, 0, 0); \
    __builtin_amdgcn_global_load_lds((const unsigned*)(Bg + 2 * rs + (koff)), (unsigned*)(wbase + (BUF) + 16384 + 8192), 16, 0, 0); \
    __builtin_amdgcn_global_load_lds((const unsigned*)(Bg + 3 * rs + (koff)), (unsigned*)(wbase + (BUF) + 16384 + 12288), 16, 0, 0); }
  GLDS_TILE(0, 0)
#pragma unroll
  for (int i = 0; i < 2; ++i)
#pragma unroll
    for (int j = 0; j < 2; ++j)
#pragma unroll
      for (int e = 0; e < 16; ++e) acc[i][j][e] = 0.f;
  const int nk = K >> 6;
  const int xr = (r >> 1) & 7;
  const int arow = (wm * 64 + r) * 128, brow = (wn * 64 + r) * 128;
  asm volatile("s_waitcnt vmcnt(0)" ::: "memory");
  __syncthreads();
#pragma unroll 1
  for (int kt = 0; kt < nk; kt += 2) {
    GLDS_TILE(32768, (kt + 1) * 64)
    gemm_compute(smem, smem + 16384, arow, brow, xr, h, acc);
    asm volatile("s_waitcnt vmcnt(0)" ::: "memory");
    __syncthreads();
    if (kt + 2 < nk) { GLDS_TILE(0, (kt + 2) * 64) }
    gemm_compute(smem + 32768, smem + 32768 + 16384, arow, brow, xr, h, acc);
    asm volatile("s_waitcnt vmcnt(0)" ::: "memory");
    __syncthreads();
  }
#undef GLDS_TILE
}

enum { EP_SILU = 0, EP_PLAIN = 1, EP_HEADNORM = 2 };

__device__ __forceinline__ void stage_flush_bf16(const char* sw, ushort_t* __restrict__ dst, const size_t ld, const size_t row0, const int col0) {
  const int lane = threadIdx.x & 63;
  const int rr = lane >> 3, ch = lane & 7;
#pragma unroll
  for (int i = 0; i < 8; ++i) {
    const int row = i * 8 + rr;
    const uint4 v = *(const uint4*)(sw + row * 144 + ch * 16);
    *(uint4*)(dst + (row0 + row) * ld + col0 + ch * 8) = v;
  }
}

__device__ __forceinline__ void epi_bf16(char* smem, const f32x16 (&acc)[2][2], const int mode, ushort_t* __restrict__ dst, const int ld,
                                         const int row0, const int col0, const float* __restrict__ nw, float* __restrict__ kp) {
  const int lane = threadIdx.x & 63, r = lane & 31, h = lane >> 5;
  char* sw = smem + (threadIdx.x >> 6) * 9216;
  float w0 = 1.f, w1 = 1.f;
  if (mode == EP_HEADNORM) { w0 = nw[r]; w1 = nw[32 + r]; }
  float cs0 = 0.f, cs1 = 0.f;
#pragma unroll
  for (int mi = 0; mi < 2; ++mi) {
#pragma unroll
    for (int e = 0; e < 16; ++e) {
      const int row = mi * 32 + (e & 3) + 8 * (e >> 2) + 4 * h;
      float v0 = acc[mi][0][e], v1 = acc[mi][1][e];
      if (mode == EP_SILU) { v0 = silu_f(v0); v1 = silu_f(v1); }
      if (mode == EP_HEADNORM) {
        float ss = v0 * v0 + v1 * v1;
        ss += __shfl_xor(ss, 1); ss += __shfl_xor(ss, 2); ss += __shfl_xor(ss, 4); ss += __shfl_xor(ss, 8); ss += __shfl_xor(ss, 16);
        const float rs = rsqrtf(ss * (1.f / 64.f) + EPS);
        v0 = v0 * rs * w0; v1 = v1 * rs * w1;
        cs0 += v0; cs1 += v1;
      }
      *(ushort_t*)(sw + row * 144 + r * 2) = f2bf(v0);
      *(ushort_t*)(sw + row * 144 + 64 + r * 2) = f2bf(v1);
    }
  }
  if (kp) {
    cs0 += __shfl_xor(cs0, 32);
    cs1 += __shfl_xor(cs1, 32);
    if (h == 0) { kp[r] = cs0; kp[32 + r] = cs1; }
  }
  stage_flush_bf16(sw, dst, (size_t)ld, (size_t)row0, col0);
}

__device__ __forceinline__ void epi_bf16_T(char* smem, const f32x16 (&acc)[2][2], ushort_t* __restrict__ dstT, const size_t ldT, const int rowpos0) {
  const int lane = threadIdx.x & 63, r = lane & 31, h = lane >> 5;
  char* sw = smem + (threadIdx.x >> 6) * 9216;
#pragma unroll
  for (int ni = 0; ni < 2; ++ni) {
#pragma unroll
    for (int mi = 0; mi < 2; ++mi) {
#pragma unroll
      for (int q4 = 0; q4 < 4; ++q4) {
        const int rp = mi * 32 + 8 * q4 + 4 * h;
        *(uint2*)(sw + (ni * 32 + r) * 144 + rp * 2) = make_uint2(pack2(acc[mi][ni][4 * q4 + 0], acc[mi][ni][4 * q4 + 1]),
                                                                    pack2(acc[mi][ni][4 * q4 + 2], acc[mi][ni][4 * q4 + 3]));
      }
    }
  }
  stage_flush_bf16(sw, dstT, ldT, 0, rowpos0);
}

__device__ __forceinline__ void epi_f32(char* smem, const f32x16 (&acc)[2][2], float* __restrict__ dst, const int ld, const int row0, const int col0,
                                        const float* __restrict__ resid, ushort_t* __restrict__ dstb, float* __restrict__ hss) {
  const int lane = threadIdx.x & 63, r = lane & 31, h = lane >> 5;
  char* sw = smem + (threadIdx.x >> 6) * 17408;
#pragma unroll
  for (int mi = 0; mi < 2; ++mi) {
#pragma unroll
    for (int e = 0; e < 16; ++e) {
      const int row = mi * 32 + (e & 3) + 8 * (e >> 2) + 4 * h;
      *(float*)(sw + row * 272 + r * 4) = acc[mi][0][e];
      *(float*)(sw + row * 272 + 128 + r * 4) = acc[mi][1][e];
    }
  }
  const int rr = lane >> 4, ch = lane & 15;
#pragma unroll
  for (int hb = 0; hb < 2; ++hb) {
    float4 rv[8];
    if (resid) {
#pragma unroll
      for (int i = 0; i < 8; ++i) rv[i] = *(const float4*)(resid + (size_t)(row0 + (hb * 8 + i) * 4 + rr) * ld + col0 + ch * 4);
    }
#pragma unroll
    for (int i = 0; i < 8; ++i) {
      const int row = (hb * 8 + i) * 4 + rr;
      float4 v = *(const float4*)(sw + row * 272 + ch * 16);
      if (resid) { v.x += rv[i].x; v.y += rv[i].y; v.z += rv[i].z; v.w += rv[i].w; }
      *(float4*)(dst + (size_t)(row0 + row) * ld + col0 + ch * 4) = v;
      if (dstb) {
        *(uint2*)(dstb + (size_t)(row0 + row) * ld + col0 + ch * 4) = make_uint2(pack2(v.x, v.y), pack2(v.z, v.w));
        float ss = v.x * v.x + v.y * v.y + v.z * v.z + v.w * v.w;
        ss += __shfl_xor(ss, 1); ss += __shfl_xor(ss, 2); ss += __shfl_xor(ss, 4); ss += __shfl_xor(ss, 8);
        if (ch == 0) hss[(size_t)(row0 + row) * 16 + (col0 >> 6)] = ss;
      }
    }
  }
}

__device__ __forceinline__ void ph_gemm_proj(const int vb, char* smem, const Params& p) {
  const int nt = vb % 20, mt = vb / 20;
  const int m0 = mt * 128, n0 = nt * 128;
  f32x16 acc[2][2];
  gemm_core(p.xn_b, p.w_inT, DM, m0, n0, smem, acc);
  const int wave = threadIdx.x >> 6, wm = wave >> 1, wn = wave & 1;
  const int row0 = m0 + wm * 64;
  const int c = n0 + wn * 64;
  if (c < 512) epi_bf16(smem, acc, EP_SILU, p.zs, 512, row0, c, nullptr, nullptr);
  else if (c < 1536) epi_bf16(smem, acc, EP_PLAIN, p.xbc_raw, 1024, row0, c - 512, nullptr, nullptr);
  else if (c < 1792) epi_bf16(smem, acc, EP_HEADNORM, p.mq, 256, row0, c - 1536, p.mq_norm_w, nullptr);
  else if (c < 2048) {
    const int hh = (c - 1792) >> 6, bb = row0 >> 13, lpos = row0 & (SL - 1);
    epi_bf16(smem, acc, EP_HEADNORM, p.mk, 256, row0, c - 1792, p.mk_norm_w, p.kpart + ((size_t)((bb * 4 + hh) * 32 + (lpos >> 8)) * 4 + ((lpos >> 6) & 3)) * 64);
  } else if (c < 2304) {
    const int hh = (c - 2048) >> 6, bb = row0 >> 13, lpos = row0 & (SL - 1);
    epi_bf16_T(smem, acc, p.vT + (size_t)(bb * 4 + hh) * 64 * SL, SL, lpos);
  }
  else epi_bf16(smem, acc, EP_HEADNORM, p.xq, 256, row0, c - 2304, p.xq_norm_w, nullptr);
}

__device__ __forceinline__ void ph_gemm_mem(const int vb, char* smem, const Params& p) {
  const int nt = vb % 4, mt = vb / 4;
  const int m0 = mt * 128, n0 = nt * 128;
  f32x16 acc[2][2];
  gemm_core(p.memn_b, p.w_memT, DM, m0, n0, smem, acc);
  const int wave = threadIdx.x >> 6, wm = wave >> 1, wn = wave & 1;
  const int row0 = m0 + wm * 64;
  const int c = n0 + wn * 64;
  if (c < 256) epi_bf16(smem, acc, EP_HEADNORM, p.memk_b, 256, row0, c, p.xk_norm_w, nullptr);
  else {
    const int hh = (c - 256) >> 6, bb = row0 >> 8, mpos = row0 & 255;
    epi_bf16_T(smem, acc, p.memvT + (size_t)(bb * 4 + hh) * 64 * MEM, MEM, mpos);
  }
}

__device__ __forceinline__ void ph_gemm_f32(const int vb, char* smem, const ushort_t* A, const ushort_t* Bt, float* dst, const float* resid, ushort_t* dstb, float* hss) {
  const int nt = vb % 8, mt = vb / 8;
  const int m0 = mt * 128, n0 = nt * 128;
  f32x16 acc[2][2];
  gemm_core(A, Bt, DM, m0, n0, smem, acc);
  const int wave = threadIdx.x >> 6, wm = wave >> 1, wn = wave & 1;
  epi_f32(smem, acc, dst, DM, m0 + wm * 64, n0 + wn * 64, resid, dstb, hss);
}

__device__ __forceinline__ int swz256(int row, int ch) { return row * 272 + (ch << 4); }
__device__ __forceinline__ int crow16(int e, int hl) { return (e & 3) + 8 * (e >> 2) + 4 * hl; }

__device__ __forceinline__ void ph_ssd1(const int vb, char* smem, const Params& p) {
  const int h = vb & 7, c = (vb >> 3) & 63, b = vb >> 9;
  const int g = h >> 2, hq = h & 3;
  int tid = threadIdx.x;
  asm volatile("" : "+v"(tid));
  const int lane = tid & 63, wave = tid >> 6;
  const int t0 = b * SL + c * 128;
  char* s_xw = smem;
  char* s_bt = smem + 17408;
  float* s_acs = (float*)(smem + 52224);
  float* s_w = s_acs + 128;
  float* s_red = s_w + 128;
  const float a_coef = -expf(p.a_log[h]);
  float dtv = 0.f, cs = 0.f;
  if (tid < 128) {
    dtv = p.dt[(size_t)(t0 + tid) * 8 + h];
    cs = dtv * a_coef;
#pragma unroll
    for (int o = 1; o < 64; o <<= 1) {
      float nb = __shfl_up(cs, o);
      if (lane >= o) cs += nb;
    }
    if (lane == 63) s_red[wave] = cs;
  }
  __syncthreads();
  if (tid < 128) {
    if (wave == 1) cs += s_red[0];
    s_acs[tid] = cs;
    p.acs[(size_t)(t0 + tid) * 8 + h] = cs;
  }
  __syncthreads();
  if (tid < 128) {
    const float tot = s_acs[127];
    s_w[tid] = dtv * expf(tot - cs);
    if (tid == 0) p.cdec[(b * 64 + c) * 8 + h] = expf(tot);
  }
  __syncthreads();
  if (tid < 224) {
    const int seg = tid / 28, cg = tid - seg * 28;
    const bool is_x = cg < 8, is_b = (cg >= 8) && (cg < 24);
    int ch0, trow;
    if (is_x) { ch0 = h * 64 + cg * 8; trow = cg * 8; }
    else if (is_b) { ch0 = 512 + g * 128 + (cg - 8) * 8; trow = (cg - 8) * 8; }
    else { ch0 = 768 + g * 128 + hq * 32 + (cg - 24) * 8; trow = 0; }
    const bool wr_nat = is_x || !is_b || (hq == 0);
    char* tbase = is_x ? s_xw : s_bt;
    const int l0 = seg * 16;
    float w0[8], w1[8], w2[8], w3[8], bias[8];
    {
      const float* cw = p.conv_w + ch0;
      float4 a, bq;
      a = *(const float4*)(cw); bq = *(const float4*)(cw + 4);
      w0[0] = a.x; w0[1] = a.y; w0[2] = a.z; w0[3] = a.w; w0[4] = bq.x; w0[5] = bq.y; w0[6] = bq.z; w0[7] = bq.w;
      a = *(const float4*)(cw + 1024); bq = *(const float4*)(cw + 1028);
      w1[0] = a.x; w1[1] = a.y; w1[2] = a.z; w1[3] = a.w; w1[4] = bq.x; w1[5] = bq.y; w1[6] = bq.z; w1[7] = bq.w;
      a = *(const float4*)(cw + 2048); bq = *(const float4*)(cw + 2052);
      w2[0] = a.x; w2[1] = a.y; w2[2] = a.z; w2[3] = a.w; w2[4] = bq.x; w2[5] = bq.y; w2[6] = bq.z; w2[7] = bq.w;
      a = *(const float4*)(cw + 3072); bq = *(const float4*)(cw + 3076);
      w3[0] = a.x; w3[1] = a.y; w3[2] = a.z; w3[3] = a.w; w3[4] = bq.x; w3[5] = bq.y; w3[6] = bq.z; w3[7] = bq.w;
      a = *(const float4*)(p.conv_b + ch0); bq = *(const float4*)(p.conv_b + ch0 + 4);
      bias[0] = a.x; bias[1] = a.y; bias[2] = a.z; bias[3] = a.w; bias[4] = bq.x; bias[5] = bq.y; bias[6] = bq.z; bias[7] = bq.w;
    }
    float r0[8], r1[8], r2[8];
    {
      const int lg = c * 128 + l0;
      const ushort_t* src = p.xbc_raw + (size_t)(t0 + l0) * 1024 + ch0;
      uint4 z4 = make_uint4(0u, 0u, 0u, 0u);
      uint4 u0 = (lg >= 3) ? *(const uint4*)(src - 3 * 1024) : z4;
      uint4 u1 = (lg >= 2) ? *(const uint4*)(src - 2 * 1024) : z4;
      uint4 u2 = (lg >= 1) ? *(const uint4*)(src - 1 * 1024) : z4;
      unpack8(u0, r0); unpack8(u1, r1); unpack8(u2, r2);
    }
    unsigned outp[8][8];
    float lo[8], los[8];
#pragma unroll
    for (int i = 0; i < 16; ++i) {
      float cur[8], val[8];
      unpack8(*(const uint4*)(p.xbc_raw + (size_t)(t0 + l0 + i) * 1024 + ch0), cur);
#pragma unroll
      for (int j = 0; j < 8; ++j) {
        float v = bias[j];
        v = fmaf(w0[j], r0[j], v); v = fmaf(w1[j], r1[j], v); v = fmaf(w2[j], r2[j], v); v = fmaf(w3[j], cur[j], v);
        val[j] = silu_f(v);
        r0[j] = r1[j]; r1[j] = r2[j]; r2[j] = cur[j];
      }
      if (wr_nat) {
        *(uint4*)(p.xc + (size_t)(t0 + l0 + i) * 1024 + ch0) =
            make_uint4(pack2(val[0], val[1]), pack2(val[2], val[3]), pack2(val[4], val[5]), pack2(val[6], val[7]));
      }
      const float scl = is_x ? s_w[l0 + i] : 1.f;
      if ((i & 1) == 0) {
#pragma unroll
        for (int j = 0; j < 8; ++j) { lo[j] = val[j]; los[j] = val[j] * scl; }
      } else {
        const int chunk = seg * 2 + (i >> 3);
#pragma unroll
        for (int j = 0; j < 8; ++j) {
          outp[j][i >> 1] = pack2(lo[j], val[j]);
          if (is_x || is_b) *(unsigned*)(tbase + swz256(trow + j, chunk) + ((i & 7) - 1) * 2) = pack2(los[j], val[j] * scl);
        }
      }
    }
    if (is_x) {
      ushort_t* dst = p.xT + ((size_t)((b * 64 + c) * 8 + h) * 64 + cg * 8) * 128 + l0;
#pragma unroll
      for (int j = 0; j < 8; ++j) {
        *(uint4*)(dst + (size_t)j * 128) = make_uint4(outp[j][0], outp[j][1], outp[j][2], outp[j][3]);
        *(uint4*)(dst + (size_t)j * 128 + 8) = make_uint4(outp[j][4], outp[j][5], outp[j][6], outp[j][7]);
      }
    }
  }
  __syncthreads();
  {
    const int r = lane & 31, hl = lane >> 5;
    f32x16 acc[2];
#pragma unroll
    for (int e = 0; e < 16; ++e) { acc[0][e] = 0.f; acc[1][e] = 0.f; }
#pragma unroll
    for (int ks = 0; ks < 8; ++ks) {
      const bf16x8 bfr = *(const bf16x8*)(s_bt + swz256(32 * wave + r, ks * 2 + hl));
      const bf16x8 a0 = *(const bf16x8*)(s_xw + swz256(r, ks * 2 + hl));
      const bf16x8 a1 = *(const bf16x8*)(s_xw + swz256(32 + r, ks * 2 + hl));
      acc[0] = __builtin_amdgcn_mfma_f32_32x32x16_bf16(a0, bfr, acc[0], 0, 0, 0);
      acc[1] = __builtin_amdgcn_mfma_f32_32x32x16_bf16(a1, bfr, acc[1], 0, 0, 0);
    }
    float* dst = p.states + (size_t)((b * 64 + c) * 8 + h) * 64 * 128;
#pragma unroll
    for (int pt = 0; pt < 2; ++pt)
#pragma unroll
      for (int e = 0; e < 16; ++e) dst[(size_t)(pt * 32 + crow16(e, hl)) * 128 + 32 * wave + r] = acc[pt][e];
  }
}

__device__ __forceinline__ void ph_ssd2(const int vb, const Params& p) {
  const int idx = vb * 256 + threadIdx.x;
  const int pn = idx & 8191, h = (idx >> 13) & 7, b = idx >> 16;
  float st = 0.f;
#pragma unroll 1
  for (int c0 = 0; c0 < 64; c0 += 8) {
    float sv[8], dv[8];
#pragma unroll
    for (int i = 0; i < 8; ++i) {
      const int cc = (b * 64 + c0 + i) * 8 + h;
      sv[i] = p.states[(size_t)cc * 8192 + pn];
      dv[i] = p.cdec[cc];
    }
#pragma unroll
    for (int i = 0; i < 8; ++i) {
      const int cc = (b * 64 + c0 + i) * 8 + h;
      p.sin_b[(size_t)cc * 8192 + pn] = f2bf(st);
      st = fmaf(st, dv[i], sv[i]);
    }
  }
}

__device__ __forceinline__ void ph_ssd3(const int vb, char* smem, const Params& p) {
  const int g = vb & 1, c = (vb >> 1) & 63, b = vb >> 7;
  int tid = threadIdx.x;
  asm volatile("" : "+v"(tid));
  const int lane = tid & 63;
  const int w = __builtin_amdgcn_readfirstlane(tid >> 6);
  const int r = lane & 31, hl = lane >> 5;
  const int t0 = b * SL + c * 128;
  char* s_C = smem;
  char* s_B = smem + 34816;
  char* s_xT = smem + 34816;
  char* s_S = smem + 34816 + 16896;
  float* s_acs = (float*)(smem + 69632);
  float* s_dt = s_acs + 512;
  {
    const int ch = tid & 15, r0 = tid >> 4;
#pragma unroll
    for (int i = 0; i < 8; ++i) {
      const int row = r0 + 16 * i;
      const ushort_t* src = p.xc + (size_t)(t0 + row) * 1024 + g * 128 + ch * 8;
      *(uint4*)(s_B + swz256(row, ch)) = *(const uint4*)(src + 512);
      *(uint4*)(s_C + swz256(row, ch)) = *(const uint4*)(src + 768);
    }
    if (tid < 128) {
#pragma unroll
      for (int hh = 0; hh < 4; ++hh) {
        s_acs[hh * 128 + tid] = p.acs[(size_t)(t0 + tid) * 8 + g * 4 + hh];
        s_dt[hh * 128 + tid] = p.dt[(size_t)(t0 + tid) * 8 + g * 4 + hh];
      }
    }
  }
  __syncthreads();
  bf16x8 cfr[8];
#pragma unroll
  for (int ks = 0; ks < 8; ++ks) cfr[ks] = *(const bf16x8*)(s_C + swz256(32 * w + r, ks * 2 + hl));
  f32x16 gt[4];
#pragma unroll
  for (int st = 0; st < 4; ++st) {
#pragma unroll
    for (int e = 0; e < 16; ++e) gt[st][e] = 0.f;
    if (st <= w) {
#pragma unroll
      for (int ks = 0; ks < 8; ++ks) {
        const bf16x8 a = *(const bf16x8*)(s_B + swz256(32 * st + r, ks * 2 + hl));
        gt[st] = __builtin_amdgcn_mfma_f32_32x32x16_bf16(a, cfr[ks], gt[st], 0, 0, 0);
      }
    }
  }
  __syncthreads();
  float ssq = 0.f;
  const int lane_c = lane;
#pragma unroll 1
  for (int hh = 0; hh < 4; ++hh) {
    int lane_o = lane_c;
    asm volatile("" : "+v"(lane_o));
    const int r = lane_o & 31, hl = lane_o >> 5;
    const int l = 32 * w + r;
    const int hg = g * 4 + hh;
    {
      const int ch = tid & 15, r0 = tid >> 4;
      const size_t base = (size_t)((b * 64 + c) * 8 + hg) * 8192;
#pragma unroll
      for (int i = 0; i < 4; ++i) {
        const int row = r0 + 16 * i;
        const uint4 xv = *(const uint4*)(p.xT + base + (size_t)row * 128 + ch * 8);
        *(uint2*)(s_xT + row * 264 + ch * 16) = make_uint2(xv.x, xv.y);
        *(uint2*)(s_xT + row * 264 + ch * 16 + 8) = make_uint2(xv.z, xv.w);
        *(uint4*)(s_S + swz256(row, ch)) = *(const uint4*)(p.sin_b + base + (size_t)row * 128 + ch * 8);
      }
    }
    __syncthreads();
    const float acs_l = s_acs[hh * 128 + l];
    const float dsk = p.ssd_d[hg];
    f32x16 acc[2];
#pragma unroll
    for (int e = 0; e < 16; ++e) { acc[0][e] = 0.f; acc[1][e] = 0.f; }
#pragma unroll
    for (int ks = 0; ks < 8; ++ks) {
      const bf16x8 a0 = *(const bf16x8*)(s_S + swz256(r, ks * 2 + hl));
      const bf16x8 a1 = *(const bf16x8*)(s_S + swz256(32 + r, ks * 2 + hl));
      acc[0] = __builtin_amdgcn_mfma_f32_32x32x16_bf16(a0, cfr[ks], acc[0], 0, 0, 0);
      acc[1] = __builtin_amdgcn_mfma_f32_32x32x16_bf16(a1, cfr[ks], acc[1], 0, 0, 0);
    }
    {
      const float el = expf(acs_l);
#pragma unroll
      for (int e = 0; e < 16; ++e) { acc[0][e] *= el; acc[1][e] *= el; }
    }
#pragma unroll
    for (int st = 0; st < 4; ++st) {
      asm volatile("" ::: "memory");
      if (st <= w) {
        float m[16];
#pragma unroll
        for (int e = 0; e < 16; ++e) {
          const int sidx = 32 * st + crow16(e, hl);
          float v = gt[st][e] * __expf(acs_l - s_acs[hh * 128 + sidx]) * s_dt[hh * 128 + sidx];
          if (sidx > l) v = 0.f;
          if (sidx == l) v += dsk;
          m[e] = v;
        }
#pragma unroll
        for (int k2 = 0; k2 < 2; ++k2) {
          asm volatile("" ::: "memory");
          bf16x8 mf;
          {
            unsigned u0 = pack2(m[8 * k2 + 0], m[8 * k2 + 1]), u1 = pack2(m[8 * k2 + 2], m[8 * k2 + 3]);
            unsigned u2 = pack2(m[8 * k2 + 4], m[8 * k2 + 5]), u3 = pack2(m[8 * k2 + 6], m[8 * k2 + 7]);
            uint4 uu = make_uint4(u0, u1, u2, u3);
            mf = *(bf16x8*)&uu;
          }
          const int soff = (32 * st + 16 * k2 + 4 * hl) * 2;
#pragma unroll
          for (int pt = 0; pt < 2; ++pt) {
            const char* ap = s_xT + (pt * 32 + r) * 264 + soff;
            uint2 q0 = *(const uint2*)(ap);
            uint2 q1 = *(const uint2*)(ap + 16);
            uint4 qq = make_uint4(q0.x, q0.y, q1.x, q1.y);
            const bf16x8 af = *(bf16x8*)&qq;
            acc[pt] = __builtin_amdgcn_mfma_f32_32x32x16_bf16(af, mf, acc[pt], 0, 0, 0);
          }
        }
      }
    }
#pragma unroll
    for (int pt = 0; pt < 2; ++pt) {
#pragma unroll
      for (int q4 = 0; q4 < 4; ++q4) {
        asm volatile("" ::: "memory");
        const int p0 = pt * 32 + 8 * q4 + 4 * hl;
        const uint2 zz = *(const uint2*)(p.zs + (size_t)(t0 + l) * 512 + hg * 64 + p0);
        const float v0 = acc[pt][4 * q4 + 0] * bflo(zz.x), v1 = acc[pt][4 * q4 + 1] * bfhi(zz.x);
        const float v2 = acc[pt][4 * q4 + 2] * bflo(zz.y), v3 = acc[pt][4 * q4 + 3] * bfhi(zz.y);
        ssq += v0 * v0 + v1 * v1 + v2 * v2 + v3 * v3;
        *(uint2*)(p.mixed_b + (size_t)(t0 + l) * 1024 + hg * 64 + p0) = make_uint2(pack2(v0, v1), pack2(v2, v3));
      }
    }
    __syncthreads();
  }
  const int l = 32 * w + r;
  ssq += __shfl_xor(ssq, 32);
  const float rstd = rsqrtf(ssq * (1.f / 256.f) + EPS);
#pragma unroll 1
  for (int hh = 0; hh < 4; ++hh) {
#pragma unroll
    for (int pt = 0; pt < 2; ++pt) {
#pragma unroll
      for (int q4 = 0; q4 < 4; ++q4) {
        asm volatile("" ::: "memory");
        const int chn = (g * 4 + hh) * 64 + pt * 32 + 8 * q4 + 4 * hl;
        ushort_t* ptr = p.mixed_b + (size_t)(t0 + l) * 1024 + chn;
        const uint2 vv = *(const uint2*)ptr;
        const float4 nw = *(const float4*)(p.ssd_norm_w + chn);
        *(uint2*)ptr = make_uint2(pack2(bflo(vv.x) * rstd * nw.x, bfhi(vv.x) * rstd * nw.y),
                                  pack2(bflo(vv.y) * rstd * nw.z, bfhi(vv.y) * rstd * nw.w));
      }
    }
  }
}

__device__ __forceinline__ void k_gate(const int VB, char* smem, const Params& p) {
  const int own = VB & 31, bh = VB >> 5;
  if (own == 0) return;
  const int b = bh >> 2, h = bh & 3;
  const int tid = threadIdx.x;
  float* s_km = (float*)smem;
  int* s_cnt = (int*)(smem + 8192);
  int* s_base = s_cnt + 32;
  for (int i = tid; i < own * 64; i += 256) {
    const int n = i >> 6, d = i & 63;
    const float* kp = p.kpart + (size_t)(bh * 32 + n) * 256 + d;
    s_km[i] = (kp[0] + kp[64]) + (kp[128] + kp[192]);
  }
  if (tid < 32) s_cnt[tid] = 0;
  __syncthreads();
  const int l = own * 256 + tid;
  const int t = b * SL + l;
  float q[64];
  {
    const ushort_t* src = p.mq + (size_t)t * 256 + h * 64;
#pragma unroll
    for (int d = 0; d < 64; d += 8) {
      uint4 v = *(const uint4*)(src + d);
      q[d] = bflo(v.x); q[d + 1] = bfhi(v.x); q[d + 2] = bflo(v.y); q[d + 3] = bfhi(v.y);
      q[d + 4] = bflo(v.z); q[d + 5] = bfhi(v.z); q[d + 6] = bflo(v.w); q[d + 7] = bfhi(v.w);
    }
  }
  float v0 = -INFINITY, v1 = -INFINITY, v2 = -INFINITY;
  int i0 = 0, i1 = 1, i2 = 2;
  for (int n = 0; n < own; ++n) {
    const float* km = s_km + n * 64;
    float sa = 0.f, sb = 0.f;
#pragma unroll
    for (int d = 0; d < 64; d += 8) {
      const float4 a = *(const float4*)(km + d), c = *(const float4*)(km + d + 4);
      sa = fmaf(q[d], a.x, sa); sa = fmaf(q[d + 1], a.y, sa); sa = fmaf(q[d + 2], a.z, sa); sa = fmaf(q[d + 3], a.w, sa);
      sb = fmaf(q[d + 4], c.x, sb); sb = fmaf(q[d + 5], c.y, sb); sb = fmaf(q[d + 6], c.z, sb); sb = fmaf(q[d + 7], c.w, sb);
    }
    const float sv = sa + sb;
    if (sv > v0) { v2 = v1; i2 = i1; v1 = v0; i1 = i0; v0 = sv; i0 = n; }
    else if (sv > v1) { v2 = v1; i2 = i1; v1 = sv; i1 = n; }
    else if (sv > v2) { v2 = sv; i2 = n; }
  }
  const int nsel = own < 3 ? own : 3;
  int lp0 = 0, lp1 = 0, lp2 = 0;
  if (0 < nsel) lp0 = atomicAdd(s_cnt + i0, 1);
  if (1 < nsel) lp1 = atomicAdd(s_cnt + i1, 1);
  if (2 < nsel) lp2 = atomicAdd(s_cnt + i2, 1);
  __syncthreads();
  if (tid < own) s_base[tid] = s_cnt[tid] ? atomicAdd(p.bcnt + bh * 32 + tid, s_cnt[tid]) : 0;
  __syncthreads();
  if (0 < nsel) p.blist[(size_t)(bh * 32 + i0) * 8192 + s_base[i0] + lp0] = l | (0 << 13);
  if (1 < nsel) p.blist[(size_t)(bh * 32 + i1) * 8192 + s_base[i1] + lp1] = l | (1 << 13);
  if (2 < nsel) p.blist[(size_t)(bh * 32 + i2) * 8192 + s_base[i2] + lp2] = l | (2 << 13);
}

struct UnitDesc { const ushort_t* Kp; const ushort_t* VTp; int vstride; int kind; int a0; int a1; };
__device__ __forceinline__ UnitDesc unit_desc(const int u, const int Ug, const int* s_pref, const Params& p) {
  UnitDesc d;
  if (u >= Ug + NB * 4 * 32 * 2) {
    const int v = u - Ug - NB * 4 * 32 * 2;
    d.kind = 2; d.a0 = v >> 6; d.a1 = v & 63;
    const int bh = d.a0, b = bh >> 2, h = bh & 3;
    d.Kp = p.memk_b + (size_t)b * MEM * 256 + h * 64;
    d.VTp = p.memvT + (size_t)bh * 64 * MEM;
    d.vstride = MEM;
  } else {
    if (u < Ug) {
      int lo = 0, hi = 255;
      while (lo < hi) { const int mid = (lo + hi) >> 1; if (s_pref[mid] > u) hi = mid; else lo = mid + 1; }
      const int prev = lo ? s_pref[lo - 1] : 0;
      d.kind = 0; d.a0 = lo; d.a1 = u - prev;
    } else {
      const int v = u - Ug;
      d.kind = 1; d.a0 = v >> 1; d.a1 = v & 1;
    }
    const int bh = d.a0 >> 5, jblk = d.a0 & 31, b = bh >> 2, h = bh & 3;
    d.Kp = p.mk + (size_t)(b * SL + jblk * 256) * 256 + h * 64;
    d.VTp = p.vT + (size_t)bh * 64 * SL + jblk * 256;
    d.vstride = SL;
  }
  return d;
}

#define AU_LOAD(P, D, ST) { \
    const ushort_t* kp_ = (D).Kp + (size_t)((ST) * 128 + kr) * 256 + kc * 8; \
    P##k0 = *(const uint4*)(kp_); P##k1 = *(const uint4*)(kp_ + 32 * 256); P##k2 = *(const uint4*)(kp_ + 64 * 256); P##k3 = *(const uint4*)(kp_ + 96 * 256); \
    const ushort_t* vp_ = (D).VTp + (size_t)vr * (D).vstride + (ST) * 128 + vc * 8; \
    P##v0 = *(const uint4*)(vp_); P##v1 = *(const uint4*)(vp_ + (size_t)16 * (D).vstride); \
    P##v2 = *(const uint4*)(vp_ + (size_t)32 * (D).vstride); P##v3 = *(const uint4*)(vp_ + (size_t)48 * (D).vstride); }
#define AU_STORE(P, BUF) { \
    char* sk_ = (BUF) + kr * 144 + kc * 16; \
    *(uint4*)(sk_) = P##k0; *(uint4*)(sk_ + 32 * 144) = P##k1; *(uint4*)(sk_ + 64 * 144) = P##k2; *(uint4*)(sk_ + 96 * 144) = P##k3; \
    char* sv_ = (BUF) + 18432 + vr * 264 + vc * 16; \
    *(uint2*)(sv_) = make_uint2(P##v0.x, P##v0.y); *(uint2*)(sv_ + 8) = make_uint2(P##v0.z, P##v0.w); \
    *(uint2*)(sv_ + 16 * 264) = make_uint2(P##v1.x, P##v1.y); *(uint2*)(sv_ + 16 * 264 + 8) = make_uint2(P##v1.z, P##v1.w); \
    *(uint2*)(sv_ + 32 * 264) = make_uint2(P##v2.x, P##v2.y); *(uint2*)(sv_ + 32 * 264 + 8) = make_uint2(P##v2.z, P##v2.w); \
    *(uint2*)(sv_ + 48 * 264) = make_uint2(P##v3.x, P##v3.y); *(uint2*)(sv_ + 48 * 264 + 8) = make_uint2(P##v3.z, P##v3.w); }

__device__ __forceinline__ void attn_stage(const char* buf, const int st, const bf16x8 (&qf)[4], const float slope, const int qrel, const bool causal,
                                           const int r, const int hl, f32x16 (&o)[2], float& m, float& lsum) {
  const char* s_K = buf;
  const char* s_VT = buf + 18432;
  f32x16 sc[4];
#pragma unroll
  for (int kt = 0; kt < 4; ++kt) {
#pragma unroll
    for (int e = 0; e < 16; ++e) sc[kt][e] = 0.f;
#pragma unroll
    for (int ks = 0; ks < 4; ++ks) {
      const bf16x8 a = *(const bf16x8*)(s_K + (32 * kt + r) * 144 + (2 * ks + hl) * 16);
      sc[kt] = __builtin_amdgcn_mfma_f32_32x32x16_bf16(a, qf[ks], sc[kt], 0, 0, 0);
    }
  }
  float mx = -1e30f;
  const int qk0 = qrel - st * 128 - 4 * hl;
#pragma unroll
  for (int kt = 0; kt < 4; ++kt) {
#pragma unroll
    for (int e = 0; e < 16; ++e) {
      const int dist = qk0 - (32 * kt + (e & 3) + 8 * (e >> 2));
      float v = fmaf(sc[kt][e], 0.125f, -slope * (float)dist);
      if (causal && dist < 0) v = -1e30f;
      sc[kt][e] = v;
      mx = fmaxf(mx, v);
    }
  }
  mx = fmaxf(mx, __shfl_xor(mx, 32));
  const float mnew = fmaxf(m, mx);
  const float alpha = __expf(m - mnew);
  m = mnew;
  lsum *= alpha;
#pragma unroll
  for (int e = 0; e < 16; ++e) { o[0][e] *= alpha; o[1][e] *= alpha; }
#pragma unroll
  for (int kt = 0; kt < 4; ++kt) {
#pragma unroll
    for (int e = 0; e < 16; ++e) {
      const float pe = __expf(sc[kt][e] - mnew);
      sc[kt][e] = pe;
      lsum += pe;
    }
  }
#pragma unroll
  for (int kt = 0; kt < 4; ++kt) {
#pragma unroll
    for (int k2 = 0; k2 < 2; ++k2) {
      uint4 pu = make_uint4(pack2(sc[kt][8 * k2 + 0], sc[kt][8 * k2 + 1]), pack2(sc[kt][8 * k2 + 2], sc[kt][8 * k2 + 3]),
                            pack2(sc[kt][8 * k2 + 4], sc[kt][8 * k2 + 5]), pack2(sc[kt][8 * k2 + 6], sc[kt][8 * k2 + 7]));
      const bf16x8 pf = *(bf16x8*)&pu;
      const int koff = (32 * kt + 16 * k2 + 4 * hl) * 2;
#pragma unroll
      for (int dt = 0; dt < 2; ++dt) {
        const char* ap = s_VT + (dt * 32 + r) * 264 + koff;
        const uint2 q0 = *(const uint2*)(ap);
        const uint2 q1 = *(const uint2*)(ap + 16);
        uint4 qq = make_uint4(q0.x, q0.y, q1.x, q1.y);
        const bf16x8 af = *(bf16x8*)&qq;
        o[dt] = __builtin_amdgcn_mfma_f32_32x32x16_bf16(af, pf, o[dt], 0, 0, 0);
      }
    }
  }
}

__device__ __forceinline__ void ph_attn_units(char* smem, const Params& p, const int Ug, const int* s_pref) {
  const int Utot = Ug + NB * 4 * 32 * 2 + NB * 4 * 64;
  int u = blockIdx.x;
  if (u >= Utot) return;
  int tid = threadIdx.x;
  asm volatile("" : "+v"(tid));
  const int lane = tid & 63, wave = tid >> 6, r = lane & 31, hl = lane >> 5;
  const int kr = tid >> 3, kc = tid & 7, vr = tid >> 4, vc = tid & 15;
  char* buf0 = smem;
  char* buf1 = smem + 35328;
  uint4 Ak0, Ak1, Ak2, Ak3, Av0, Av1, Av2, Av3, Bk0, Bk1, Bk2, Bk3, Bv0, Bv1, Bv2, Bv3;
  UnitDesc D = unit_desc(u, Ug, s_pref, p);
  AU_LOAD(A, D, 0)
  AU_LOAD(B, D, 1)
#pragma unroll 1
  for (; u < Utot; u += gridDim.x) {
    const int un = (u + (int)gridDim.x < Utot) ? u + (int)gridDim.x : u;
    const UnitDesc Dn = unit_desc(un, Ug, s_pref, p);
    int bh, l = 0, slot = 3, jblk = 0;
    bool valid = true, causal = false;
    const ushort_t* qrow;
    float slope = 0.f;
    int qrel = 1 << 20;
    int t;
    if (D.kind == 2) {
      bh = D.a0;
      t = (bh >> 2) * SL + D.a1 * 128 + wave * 32 + r;
      qrow = p.xq + (size_t)t * 256 + (bh & 3) * 64;
    } else {
      bh = D.a0 >> 5; jblk = D.a0 & 31;
      if (D.kind == 0) {
        const int cnt = p.bcnt[D.a0];
        int qi = D.a1 * 128 + wave * 32 + r;
        if (qi >= cnt) { valid = false; qi = 0; }
        const int ent = p.blist[(size_t)D.a0 * 8192 + qi];
        l = ent & 8191; slot = ent >> 13;
      } else {
        l = jblk * 256 + D.a1 * 128 + wave * 32 + r; slot = 3; causal = true;
      }
      t = (bh >> 2) * SL + l;
      qrow = p.mq + (size_t)t * 256 + (bh & 3) * 64;
      slope = exp2f(-2.f * (float)((bh & 3) + 1));
      qrel = l - jblk * 256;
    }
    bf16x8 qf[4];
#pragma unroll
    for (int ks = 0; ks < 4; ++ks) qf[ks] = *(const bf16x8*)(qrow + ks * 16 + hl * 8);
    f32x16 o[2];
#pragma unroll
    for (int e = 0; e < 16; ++e) { o[0][e] = 0.f; o[1][e] = 0.f; }
    float m = -1e30f, lsum = 0.f;
    AU_STORE(A, buf0)
    AU_LOAD(A, Dn, 0)
    __syncthreads();
    attn_stage(buf0, 0, qf, slope, qrel, causal, r, hl, o, m, lsum);
    AU_STORE(B, buf1)
    AU_LOAD(B, Dn, 1)
    __syncthreads();
    attn_stage(buf1, 1, qf, slope, qrel, causal, r, hl, o, m, lsum);
    const float lt = lsum + __shfl_xor(lsum, 32);
    const float inv = 1.f / lt;
    const int h = bh & 3;
    if (D.kind == 2) {
#pragma unroll
      for (int dt = 0; dt < 2; ++dt)
#pragma unroll
        for (int q4 = 0; q4 < 4; ++q4) {
          const int d = dt * 32 + 8 * q4 + 4 * hl;
          *(uint2*)(p.mixed_b + (size_t)t * DM + 768 + h * 64 + d) =
              make_uint2(pack2(o[dt][4 * q4] * inv, o[dt][4 * q4 + 1] * inv), pack2(o[dt][4 * q4 + 2] * inv, o[dt][4 * q4 + 3] * inv));
        }
    } else if (valid) {
      const size_t pi = ((size_t)t * 4 + h) * 4 + slot;
#pragma unroll
      for (int dt = 0; dt < 2; ++dt)
#pragma unroll
        for (int q4 = 0; q4 < 4; ++q4) {
          const int d = dt * 32 + 8 * q4 + 4 * hl;
          *(uint2*)(p.pO + pi * 64 + d) =
              make_uint2(pack2(o[dt][4 * q4] * inv, o[dt][4 * q4 + 1] * inv), pack2(o[dt][4 * q4 + 2] * inv, o[dt][4 * q4 + 3] * inv));
        }
      if (hl == 0) { p.pm[pi] = m; p.pl[pi] = lt; }
    }
    D = Dn;
  }
}

__device__ __forceinline__ void ph_attn_combine(const int VB, const Params& p) {
  const int i = VB * 256 + threadIdx.x;
  const int dq = i & 7, th = i >> 3;
  const int t = th >> 2;
  const int own = (t & (SL - 1)) >> 8;
  const int nsel = own < 3 ? own : 3;
  float mv[4], wv[4];
  float M = p.pm[(size_t)th * 4 + 3];
  mv[3] = M;
#pragma unroll
  for (int sl = 0; sl < 3; ++sl) {
    mv[sl] = (sl < nsel) ? p.pm[(size_t)th * 4 + sl] : -1e30f;
    M = fmaxf(M, mv[sl]);
  }
  float W = 0.f;
#pragma unroll
  for (int sl = 0; sl < 4; ++sl) {
    const bool on = (sl == 3) || (sl < nsel);
    wv[sl] = on ? p.pl[(size_t)th * 4 + sl] * __expf(mv[sl] - M) : 0.f;
    W += wv[sl];
  }
  float acc[8];
#pragma unroll
  for (int k = 0; k < 8; ++k) acc[k] = 0.f;
#pragma unroll
  for (int sl = 0; sl < 4; ++sl) {
    const bool on = (sl == 3) || (sl < nsel);
    if (on) {
      float f[8];
      unpack8(*(const uint4*)(p.pO + ((size_t)th * 4 + sl) * 64 + dq * 8), f);
#pragma unroll
      for (int k = 0; k < 8; ++k) acc[k] = fmaf(wv[sl], f[k], acc[k]);
    }
  }
  const float inv = 1.f / W;
  const int h = th & 3;
  *(uint4*)(p.mixed_b + (size_t)t * DM + 512 + h * 64 + dq * 8) =
      make_uint4(pack2(acc[0] * inv, acc[1] * inv), pack2(acc[2] * inv, acc[3] * inv), pack2(acc[4] * inv, acc[5] * inv), pack2(acc[6] * inv, acc[7] * inv));
}


__device__ __forceinline__ int mkkey(const float f, const int idx, const int mask) {
  int b = __float_as_int(f);
  b = (b & ~mask) | idx;
  return b ^ ((b >> 31) & 0x7fffffff);
}
__device__ __forceinline__ int key2bits(const int k) { return k ^ ((k >> 31) & 0x7fffffff); }
#define CEI(a, b) { const int _mx = max(a, b), _mn = min(a, b); a = _mx; b = _mn; }
template <int N>
__device__ __forceinline__ void bitonic_sort_desc(int (&v)[N]) {
#pragma unroll
  for (int k = 2; k <= N; k <<= 1) {
#pragma unroll
    for (int j = k >> 1; j > 0; j >>= 1) {
#pragma unroll
      for (int i = 0; i < N; ++i) {
        const int l = i ^ j;
        if (l > i) {
          if ((i & k) == 0) { CEI(v[i], v[l]); } else { CEI(v[l], v[i]); }
        }
      }
    }
  }
}
__device__ __forceinline__ void merge16(int (&a)[16], const int (&b)[16]) {
#pragma unroll
  for (int i = 0; i < 16; ++i) a[i] = max(a[i], b[15 - i]);
#pragma unroll
  for (int j = 8; j > 0; j >>= 1) {
#pragma unroll
    for (int i = 0; i < 16; ++i) {
      const int l = i ^ j;
      if (l > i) { CEI(a[i], a[l]); }
    }
  }
}
__device__ __forceinline__ void merge_partner(int (&a)[16], const int xmask) {
  int o[16];
#pragma unroll
  for (int i = 0; i < 16; ++i) o[i] = __shfl_xor(a[i], xmask);
  merge16(a, o);
}
__device__ __forceinline__ bf16x8 pack_hi8(const float (&x)[8], float (&res)[8]) {
  unsigned u[4];
#pragma unroll
  for (int i = 0; i < 4; ++i) {
    const ushort_t h0 = f2bf(x[2 * i]), h1 = f2bf(x[2 * i + 1]);
    res[2 * i] = x[2 * i] - bf2f(h0);
    res[2 * i + 1] = x[2 * i + 1] - bf2f(h1);
    u[i] = (unsigned)h0 | ((unsigned)h1 << 16);
  }
  uint4 uu = make_uint4(u[0], u[1], u[2], u[3]);
  return *(bf16x8*)&uu;
}
__device__ __forceinline__ bf16x8 pack_8(const float (&x)[8]) {
  uint4 uu = make_uint4(pack2(x[0], x[1]), pack2(x[2], x[3]), pack2(x[4], x[5]), pack2(x[6], x[7]));
  return *(bf16x8*)&uu;
}

__device__ __forceinline__ void ph_gemm_route(const int vb, char* smem, const Params& p, const ushort_t* __restrict__ hn_b) {
  const int head = vb & 7, tt = vb >> 3;
  const int m0 = head * 128, n0 = tt * 128;
  f32x16 acc[2][2];
  gemm_core(p.w_qT, hn_b, DM, m0, n0, smem, acc);
  int tid = threadIdx.x;
  asm volatile("" : "+v"(tid));
  const int lane = tid & 63, r = lane & 31, hl = lane >> 5;
  const int wave = tid >> 6, wm = wave >> 1, wn = wave & 1;
  int* s_top = (int*)(smem + 34816);
  float rstd_tok[2];
#pragma unroll
  for (int ni = 0; ni < 2; ++ni) {
    const float4* hp = (const float4*)(p.hss + (size_t)(n0 + wn * 64 + ni * 32 + r) * 16);
    const float4 a = hp[0], b = hp[1], c = hp[2], d = hp[3];
    const float tot = ((a.x + a.y) + (a.z + a.w)) + ((b.x + b.y) + (b.z + b.w)) + ((c.x + c.y) + (c.z + c.w)) + ((d.x + d.y) + (d.z + d.w));
    rstd_tok[ni] = rsqrtf(tot * (1.f / DM) + EPS);
  }
  {
    const int row = tid >> 1, part = tid & 1;
#pragma unroll
    for (int hf = 0; hf < 2; ++hf) {
      const ushort_t* src = p.skh + (size_t)(hf * 128 + row) * 64 + part * 32;
      char* dst = smem + (hf * 128 + row) * 136 + part * 64;
#pragma unroll
      for (int c = 0; c < 4; ++c) {
        const uint4 v = *(const uint4*)(src + c * 8);
        *(uint2*)(dst + c * 16) = make_uint2(v.x, v.y);
        *(uint2*)(dst + c * 16 + 8) = make_uint2(v.z, v.w);
      }
    }
  }
  __syncthreads();
  const char* s_keys = smem + wm * 128 * 136;
#pragma unroll
  for (int ni = 0; ni < 2; ++ni) {
    asm volatile("" ::: "memory");
    bf16x8 qh[4], ql[4];
#pragma unroll
    for (int mi = 0; mi < 2; ++mi) {
#pragma unroll
      for (int k2 = 0; k2 < 2; ++k2) {
        float x[8], res[8];
#pragma unroll
        for (int j = 0; j < 8; ++j) x[j] = acc[mi][ni][8 * k2 + j] * rstd_tok[ni];
        qh[mi * 2 + k2] = pack_hi8(x, res);
        ql[mi * 2 + k2] = pack_8(res);
      }
    }
    int g0[16];
#pragma unroll
    for (int kh2 = 0; kh2 < 2; ++kh2) {
      int ga[16], gb[16];
#pragma unroll
      for (int kq = 0; kq < 2; ++kq) {
        const int kt = kh2 * 2 + kq;
        asm volatile("" ::: "memory");
        f32x16 sc;
#pragma unroll
        for (int e = 0; e < 16; ++e) sc[e] = 0.f;
#pragma unroll
        for (int st = 0; st < 4; ++st) {
          const int d0 = (st >> 1) * 32 + 16 * (st & 1) + 4 * hl;
          const char* kp = s_keys + (kt * 32 + r) * 136 + d0 * 2;
          const uint2 h0 = *(const uint2*)(kp), h1 = *(const uint2*)(kp + 16);
          uint4 hq = make_uint4(h0.x, h0.y, h1.x, h1.y);
          const bf16x8 ah = *(bf16x8*)&hq;
          sc = __builtin_amdgcn_mfma_f32_32x32x16_bf16(ah, qh[st], sc, 0, 0, 0);
          sc = __builtin_amdgcn_mfma_f32_32x32x16_bf16(ah, ql[st], sc, 0, 0, 0);
        }
        if (kq == 0) {
#pragma unroll
          for (int e = 0; e < 16; ++e) ga[e] = mkkey(sc[e], kt * 32 + (e & 3) + 8 * (e >> 2) + 4 * hl, 127);
          bitonic_sort_desc<16>(ga);
        } else {
#pragma unroll
          for (int e = 0; e < 16; ++e) gb[e] = mkkey(sc[e], kt * 32 + (e & 3) + 8 * (e >> 2) + 4 * hl, 127);
          bitonic_sort_desc<16>(gb);
        }
      }
      merge16(ga, gb);
      if (kh2 == 0) {
#pragma unroll
        for (int i = 0; i < 16; ++i) g0[i] = ga[i];
      } else {
        merge16(g0, ga);
      }
    }
    merge_partner(g0, 32);
    {
      int* dst = s_top + ((size_t)wm * 128 + wn * 64 + ni * 32 + r) * 16 + hl * 8;
      int4 w0, w1;
      int lo8[8], hi8[8];
#pragma unroll
      for (int i = 0; i < 8; ++i) { lo8[i] = g0[i]; hi8[i] = g0[8 + i]; asm volatile("" : "+v"(lo8[i]), "+v"(hi8[i])); }
      w0 = make_int4(hl ? hi8[0] : lo8[0], hl ? hi8[1] : lo8[1], hl ? hi8[2] : lo8[2], hl ? hi8[3] : lo8[3]);
      w1 = make_int4(hl ? hi8[4] : lo8[4], hl ? hi8[5] : lo8[5], hl ? hi8[6] : lo8[6], hl ? hi8[7] : lo8[7]);
      *(int4*)dst = w0; *(int4*)(dst + 4) = w1;
    }
  }
  __syncthreads();
  {
    const int tok = tid >> 1, sub = tid & 1;
    int k1[16], k2[16];
    {
      const int4* a = (const int4*)(s_top + (size_t)tok * 16);
      const int4* b = (const int4*)(s_top + (size_t)(128 + tok) * 16);
#pragma unroll
      for (int i = 0; i < 4; ++i) {
        const int4 x = a[i], y = b[i];
        k1[4 * i] = x.x; k1[4 * i + 1] = x.y; k1[4 * i + 2] = x.z; k1[4 * i + 3] = x.w;
        k2[4 * i] = y.x; k2[4 * i + 1] = y.y; k2[4 * i + 2] = y.z; k2[4 * i + 3] = y.w;
      }
    }
    float v1f[16], v2f[16];
#pragma unroll
    for (int i = 0; i < 16; ++i) { v1f[i] = __int_as_float(key2bits(k1[i])); v2f[i] = __int_as_float(key2bits(k2[i])); }
    int c[32];
    c[0] = sub ? mkkey(v1f[3] + v2f[3], 51, 255) : mkkey(v1f[0] + v2f[0], 0, 255);
    c[1] = sub ? mkkey(v1f[4] + v2f[0], 64, 255) : mkkey(v1f[0] + v2f[1], 1, 255);
    c[2] = sub ? mkkey(v1f[4] + v2f[1], 65, 255) : mkkey(v1f[0] + v2f[2], 2, 255);
    c[3] = sub ? mkkey(v1f[4] + v2f[2], 66, 255) : mkkey(v1f[0] + v2f[3], 3, 255);
    c[4] = sub ? mkkey(v1f[5] + v2f[0], 80, 255) : mkkey(v1f[0] + v2f[4], 4, 255);
    c[5] = sub ? mkkey(v1f[5] + v2f[1], 81, 255) : mkkey(v1f[0] + v2f[5], 5, 255);
    c[6] = sub ? mkkey(v1f[6] + v2f[0], 96, 255) : mkkey(v1f[0] + v2f[6], 6, 255);
    c[7] = sub ? mkkey(v1f[6] + v2f[1], 97, 255) : mkkey(v1f[0] + v2f[7], 7, 255);
    c[8] = sub ? mkkey(v1f[7] + v2f[0], 112, 255) : mkkey(v1f[0] + v2f[8], 8, 255);
    c[9] = sub ? mkkey(v1f[7] + v2f[1], 113, 255) : mkkey(v1f[0] + v2f[9], 9, 255);
    c[10] = sub ? mkkey(v1f[8] + v2f[0], 128, 255) : mkkey(v1f[0] + v2f[10], 10, 255);
    c[11] = sub ? mkkey(v1f[9] + v2f[0], 144, 255) : mkkey(v1f[0] + v2f[11], 11, 255);
    c[12] = sub ? mkkey(v1f[10] + v2f[0], 160, 255) : mkkey(v1f[0] + v2f[12], 12, 255);
    c[13] = sub ? mkkey(v1f[11] + v2f[0], 176, 255) : mkkey(v1f[0] + v2f[13], 13, 255);
    c[14] = sub ? mkkey(v1f[12] + v2f[0], 192, 255) : mkkey(v1f[0] + v2f[14], 14, 255);
    c[15] = sub ? mkkey(v1f[13] + v2f[0], 208, 255) : mkkey(v1f[0] + v2f[15], 15, 255);
    c[16] = sub ? mkkey(v1f[14] + v2f[0], 224, 255) : mkkey(v1f[1] + v2f[0], 16, 255);
    c[17] = sub ? mkkey(v1f[15] + v2f[0], 240, 255) : mkkey(v1f[1] + v2f[1], 17, 255);
    c[18] = sub ? (int)0x80000000 : mkkey(v1f[1] + v2f[2], 18, 255);
    c[19] = sub ? (int)0x80000000 : mkkey(v1f[1] + v2f[3], 19, 255);
    c[20] = sub ? (int)0x80000000 : mkkey(v1f[1] + v2f[4], 20, 255);
    c[21] = sub ? (int)0x80000000 : mkkey(v1f[1] + v2f[5], 21, 255);
    c[22] = sub ? (int)0x80000000 : mkkey(v1f[1] + v2f[6], 22, 255);
    c[23] = sub ? (int)0x80000000 : mkkey(v1f[1] + v2f[7], 23, 255);
    c[24] = sub ? (int)0x80000000 : mkkey(v1f[2] + v2f[0], 32, 255);
    c[25] = sub ? (int)0x80000000 : mkkey(v1f[2] + v2f[1], 33, 255);
    c[26] = sub ? (int)0x80000000 : mkkey(v1f[2] + v2f[2], 34, 255);
    c[27] = sub ? (int)0x80000000 : mkkey(v1f[2] + v2f[3], 35, 255);
    c[28] = sub ? (int)0x80000000 : mkkey(v1f[2] + v2f[4], 36, 255);
    c[29] = sub ? (int)0x80000000 : mkkey(v1f[3] + v2f[0], 48, 255);
    c[30] = sub ? (int)0x80000000 : mkkey(v1f[3] + v2f[1], 49, 255);
    c[31] = sub ? (int)0x80000000 : mkkey(v1f[3] + v2f[2], 50, 255);
    int h0[16], h1[16];
#pragma unroll
    for (int i = 0; i < 16; ++i) { h0[i] = c[i]; h1[i] = c[16 + i]; }
    bitonic_sort_desc<16>(h0); bitonic_sort_desc<16>(h1);
    merge16(h0, h1);
    merge_partner(h0, 1);
    float sv[16];
#pragma unroll
    for (int i = 0; i < 16; ++i) sv[i] = __int_as_float(key2bits(h0[i]));
    float den = 0.f;
#pragma unroll
    for (int i = 0; i < 16; ++i) den += __expf(sv[i] - sv[0]);
    const float inv = 1.f / den;
    int eo[8]; float go[8];
#pragma unroll
    for (int i = 0; i < 8; ++i) {
      int klo = h0[i], khi = h0[8 + i];
      asm volatile("" : "+v"(klo), "+v"(khi));
      const int kk = sub ? khi : klo;
      const int bits = key2bits(kk);
      const int code = bits & 255;
      const int ia = key2bits(s_top[(size_t)tok * 16 + (code >> 4)]) & 127;
      const int ib = key2bits(s_top[(size_t)(128 + tok) * 16 + (code & 15)]) & 127;
      eo[i] = ia * 128 + ib;
      go[i] = __expf(__int_as_float(bits) - sv[0]) * inv;
    }
    const size_t ob = ((size_t)(n0 + tok) * 8 + head) * 16 + sub * 8;
    *(int4*)(p.eidx + ob) = make_int4(eo[0], eo[1], eo[2], eo[3]);
    *(int4*)(p.eidx + ob + 4) = make_int4(eo[4], eo[5], eo[6], eo[7]);
    *(float4*)(p.egate + ob) = make_float4(go[0], go[1], go[2], go[3]);
    *(float4*)(p.egate + ob + 4) = make_float4(go[4], go[5], go[6], go[7]);
  }
}

__device__ __forceinline__ void ph_subkeys(const Params& p) {
  for (int i = blockIdx.x * 256 + threadIdx.x; i < 2 * 128 * 64; i += gridDim.x * 256) {
    const float v = (i < 8192) ? p.sk1[i] : p.sk2[i - 8192];
    const ushort_t hi = f2bf(v);
    p.skh[i] = hi;
    p.skl[i] = f2bf(v - bf2f(hi));
  }
}

__device__ __forceinline__ float dot16_fp8(const uint4 d, const float (&x)[16], float c) {
  const unsigned w[4] = {d.x, d.y, d.z, d.w};
#pragma unroll
  for (int i = 0; i < 4; ++i) {
    const f32x2_t lo = __builtin_amdgcn_cvt_pk_f32_fp8((int)w[i], false);
    const f32x2_t hi = __builtin_amdgcn_cvt_pk_f32_fp8((int)w[i], true);
    c = fmaf(lo.x, x[4 * i], c); c = fmaf(lo.y, x[4 * i + 1], c); c = fmaf(hi.x, x[4 * i + 2], c); c = fmaf(hi.y, x[4 * i + 3], c);
  }
  return c;
}
__device__ __forceinline__ void axpy16_fp8(const float cf, const uint4 u, float (&acc)[16]) {
  const unsigned w[4] = {u.x, u.y, u.z, u.w};
#pragma unroll
  for (int i = 0; i < 4; ++i) {
    const f32x2_t lo = __builtin_amdgcn_cvt_pk_f32_fp8((int)w[i], false);
    const f32x2_t hi = __builtin_amdgcn_cvt_pk_f32_fp8((int)w[i], true);
    acc[4 * i] = fmaf(cf, lo.x, acc[4 * i]); acc[4 * i + 1] = fmaf(cf, lo.y, acc[4 * i + 1]);
    acc[4 * i + 2] = fmaf(cf, hi.x, acc[4 * i + 2]); acc[4 * i + 3] = fmaf(cf, hi.y, acc[4 * i + 3]);
  }
}
constexpr int EX_NTOK = 4;
__device__ __forceinline__ void peer_chunk(const Params& p, const int lane, const int myex, const bool b5, const bool b4, const bool b3,
                                           const int (&ce)[8], const float (&cg)[8], const f32x2_t (&x2)[8], f32x2_t (&acc2)[8]) {
  drow_t d[8];
  urow_t u[8];
  float sd[8], su[8];
#pragma unroll
  for (int i = 0; i < 8; ++i) d[i] = *(const drow_t*)(p.ed8 + ((size_t)ce[i] * 64 + lane) * DROW_BYTES);
#pragma unroll
  for (int i = 0; i < 8; ++i) u[i] = *(const urow_t*)(p.eu8 + ((size_t)ce[i] * 64 + lane) * UROW_BYTES);
#pragma unroll
  for (int i = 0; i < 8; ++i) { sd[i] = p.ed_s[ce[i]]; su[i] = p.eu_s[ce[i]] * cg[i]; }
  float pr[8];
#pragma unroll
  for (int i = 0; i < 8; ++i) {
    f32x2_t dd[8];
    DEC_D(d[i], dd);
    f32x2_t a2 = {0.f, 0.f};
#pragma unroll
    for (int k = 0; k < 8; ++k) a2 = dd[k] * x2[k] + a2;
    pr[i] = (a2.x + a2.y) * sd[i];
  }
  float q4[4];
#pragma unroll
  for (int i = 0; i < 4; ++i) {
    const float snd = b5 ? pr[i] : pr[i + 4];
    const float kp = b5 ? pr[i + 4] : pr[i];
    q4[i] = kp + __shfl_xor(snd, 32);
  }
  float q2[2];
#pragma unroll
  for (int i = 0; i < 2; ++i) {
    const float snd = b4 ? q4[i] : q4[i + 2];
    const float kp = b4 ? q4[i + 2] : q4[i];
    q2[i] = kp + __shfl_xor(snd, 16);
  }
  float q1;
  {
    const float snd = b3 ? q2[0] : q2[1];
    const float kp = b3 ? q2[1] : q2[0];
    q1 = kp + __shfl_xor(snd, 8);
  }
  q1 += __shfl_xor(q1, 4);
  q1 += __shfl_xor(q1, 2);
  q1 += __shfl_xor(q1, 1);
  const float act = gelu_f(q1);
#pragma unroll
  for (int i = 0; i < 8; ++i) {
    const int src = ((i >> 2) & 1) * 32 + ((i >> 1) & 1) * 16 + (i & 1) * 8;
    const float cf = __int_as_float(__builtin_amdgcn_readlane(__float_as_int(act), src)) * su[i];
    const f32x2_t cf2 = {cf, cf};
    f32x2_t uu[8];
    DEC_U(u[i], uu);
#pragma unroll
    for (int k = 0; k < 8; ++k) acc2[k] = cf2 * uu[k] + acc2[k];
  }
}

#ifndef EX_SWEEP
#define EX_SWEEP 0
#endif
#if !EX_SWEEP
typedef __attribute__((ext_vector_type(8))) int v8i_t;
typedef __attribute__((ext_vector_type(4))) float f32x4_t;
__device__ __forceinline__ void k_peer_experts(const int VB, char* smem, const Params& p, const ushort_t* __restrict__ hn) {
  const int lane = threadIdx.x & 63;
  const int wave = __builtin_amdgcn_readfirstlane(threadIdx.x >> 6);
  const int t = VB * 4 + wave;
  const int li = lane & 15, g = lane >> 4;
  char* sx = smem + wave * 1024;
  {
    const float* hrow = p.out + (size_t)t * DM + lane * 16;
    const float* wrow = p.ffn_norm_w + lane * 16;
    float4 hv[4], wv[4];
#pragma unroll
    for (int i = 0; i < 4; ++i) { hv[i] = *(const float4*)(hrow + i * 4); wv[i] = *(const float4*)(wrow + i * 4); }
    float ss = 0.f;
#pragma unroll
    for (int i = 0; i < 4; ++i) ss += hv[i].x * hv[i].x + hv[i].y * hv[i].y + hv[i].z * hv[i].z + hv[i].w * hv[i].w;
    ss = wave_sum(ss);
    const float rs = rsqrtf(ss * (1.f / DM) + EPS) * 16.f;
    int wq[4];
#pragma unroll
    for (int i = 0; i < 4; ++i) {
      int w = 0;
      w = __builtin_amdgcn_cvt_pk_fp8_f32(hv[i].x * rs * wv[i].x, hv[i].y * rs * wv[i].y, w, false);
      w = __builtin_amdgcn_cvt_pk_fp8_f32(hv[i].z * rs * wv[i].z, hv[i].w * rs * wv[i].w, w, true);
      wq[i] = w;
    }
    *(int4*)(sx + lane * 16) = make_int4(wq[0], wq[1], wq[2], wq[3]);
  }
  v8i_t xb[8];
#pragma unroll
  for (int st = 0; st < 8; ++st) {
    const int4 lo = *(const int4*)(sx + st * 128 + g * 16);
    const int4 hi = *(const int4*)(sx + st * 128 + 64 + g * 16);
    xb[st] = v8i_t{lo.x, lo.y, lo.z, lo.w, hi.x, hi.y, hi.z, hi.w};
  }
  f32x2_t acc2[8];
#pragma unroll
  for (int i = 0; i < 8; ++i) acc2[i] = f32x2_t{0.f, 0.f};
  const int ev0 = p.eidx[(size_t)t * 128 + lane], ev1 = p.eidx[(size_t)t * 128 + 64 + lane];
  const float sdv0 = p.ed_s[ev0], sdv1 = p.ed_s[ev1];
  const float suv0 = p.eu_s[ev0] * p.egate[(size_t)t * 128 + lane], suv1 = p.eu_s[ev1] * p.egate[(size_t)t * 128 + 64 + lane];
#pragma unroll 1
  for (int c = 0; c < 8; ++c) {
    const bool hi = c >= 4;
    const int eg = hi ? ev1 : ev0;
    const float sdg = hi ? sdv1 : sdv0, sug = hi ? suv1 : suv0;
    const int lbase = (c & 3) * 16;
    const int e_lane = __shfl(eg, lbase + li);
    const unsigned char* arow = p.ed8 + (size_t)e_lane * 512 + g * 16;
    uint4 a[8];
#pragma unroll
    for (int st = 0; st < 8; ++st) a[st] = *(const uint4*)(arow + st * 64);
    urow_t u[16];
#pragma unroll
    for (int i = 0; i < 16; ++i) {
      const int ei_s = __builtin_amdgcn_readlane(eg, lbase + i);
      u[i] = *(const urow_t*)(p.eu8 + ((size_t)ei_s * 64 + lane) * UROW_BYTES);
    }
    const int msel = lbase + 4 * g + (li & 3);
    const float sd_m = __shfl(sdg, msel), su_m = __shfl(sug, msel);
    f32x4_t d4 = {0.f, 0.f, 0.f, 0.f};
#pragma unroll
    for (int st = 0; st < 8; ++st) {
      const v8i_t av = v8i_t{(int)a[st].x, (int)a[st].y, (int)a[st].z, (int)a[st].w, 0, 0, 0, 0};
      d4 = __builtin_amdgcn_mfma_scale_f32_16x16x128_f8f6f4(av, xb[st], d4, 4, 0, 0, 0x7f7f7f7f, 0, 0x7f7f7f7f);
    }
    const int rsel = li & 3;
    const float dsel = rsel == 0 ? d4[0] : rsel == 1 ? d4[1] : rsel == 2 ? d4[2] : d4[3];
    const float cvs = gelu_fast(dsel * sd_m * 0.0625f) * su_m;
#pragma unroll
    for (int i = 0; i < 16; ++i) {
      const float cf = __int_as_float(__builtin_amdgcn_readlane(__float_as_int(cvs), 16 * (i >> 2) + (i & 3)));
      const f32x2_t cf2 = {cf, cf};
      f32x2_t uu[8];
      DEC_U(u[i], uu);
#pragma unroll
      for (int k = 0; k < 8; ++k) acc2[k] = cf2 * uu[k] + acc2[k];
    }
  }
  float* orow = p.out + (size_t)t * DM + lane * 16;
#pragma unroll
  for (int i = 0; i < 4; ++i) {
    float4 hv = *(float4*)(orow + i * 4);
    hv.x += acc2[2 * i].x; hv.y += acc2[2 * i].y; hv.z += acc2[2 * i + 1].x; hv.w += acc2[2 * i + 1].y;
    *(float4*)(orow + i * 4) = hv;
  }
}
#define EX_TOK_PER_VB 4
#else
#define EX_TOK_PER_VB (4 * EX_NTOK)
__device__ __forceinline__ void k_peer_experts(const int VB, const Params& p, const ushort_t* __restrict__ hn) {
  const int lane = threadIdx.x & 63;
  const int wave = __builtin_amdgcn_readfirstlane(threadIdx.x >> 6);
  const int t0 = (VB * 4 + wave) * EX_NTOK;
  const int myex = ((lane >> 5) & 1) * 4 + ((lane >> 4) & 1) * 2 + ((lane >> 3) & 1);
  const bool b5 = (lane & 32) != 0, b4 = (lane & 16) != 0, b3 = (lane & 8) != 0;
  f32x2_t x2[EX_NTOK][8], acc2[EX_NTOK][8];
  int e0[EX_NTOK], e1[EX_NTOK];
  float g0[EX_NTOK], g1[EX_NTOK];
#pragma unroll
  for (int k = 0; k < EX_NTOK; ++k) {
    float f0[8], f1[8];
    unpack8(*(const uint4*)(hn + (size_t)(t0 + k) * DM + lane * 16), f0);
    unpack8(*(const uint4*)(hn + (size_t)(t0 + k) * DM + lane * 16 + 8), f1);
#pragma unroll
    for (int i = 0; i < 4; ++i) {
      x2[k][i] = f32x2_t{f0[2 * i], f0[2 * i + 1]};
      x2[k][4 + i] = f32x2_t{f1[2 * i], f1[2 * i + 1]};
    }
#pragma unroll
    for (int i = 0; i < 8; ++i) acc2[k][i] = f32x2_t{0.f, 0.f};
    e0[k] = p.eidx[(size_t)(t0 + k) * 128 + lane];
    e1[k] = p.eidx[(size_t)(t0 + k) * 128 + 64 + lane];
    g0[k] = p.egate[(size_t)(t0 + k) * 128 + lane];
    g1[k] = p.egate[(size_t)(t0 + k) * 128 + 64 + lane];
  }
#pragma unroll 1
  for (int s = 0; s < 16; ++s) {
#pragma unroll
    for (int k = 0; k < EX_NTOK; ++k) {
      unsigned long long m0 = __ballot((e0[k] >> 10) == s);
      unsigned long long m1 = __ballot((e1[k] >> 10) == s);
      while ((m0 | m1) != 0ull) {
        int ce[8];
        float cg[8];
#pragma unroll
        for (int i = 0; i < 8; ++i) {
          int ev = 0;
          float gv = 0.f;
          if (m0 != 0ull) {
            const int ln = __builtin_ctzll(m0);
            m0 &= m0 - 1ull;
            ev = __builtin_amdgcn_readlane(e0[k], ln);
            gv = __int_as_float(__builtin_amdgcn_readlane(__float_as_int(g0[k]), ln));
          } else if (m1 != 0ull) {
            const int ln = __builtin_ctzll(m1);
            m1 &= m1 - 1ull;
            ev = __builtin_amdgcn_readlane(e1[k], ln);
            gv = __int_as_float(__builtin_amdgcn_readlane(__float_as_int(g1[k]), ln));
          }
          ce[i] = ev;
          cg[i] = gv;
        }
        peer_chunk(p, lane, myex, b5, b4, b3, ce, cg, x2[k], acc2[k]);
      }
    }
  }
#pragma unroll
  for (int k = 0; k < EX_NTOK; ++k) {
    float* orow = p.out + (size_t)(t0 + k) * DM + lane * 16;
#pragma unroll
    for (int i = 0; i < 4; ++i) {
      float4 hv = *(float4*)(orow + i * 4);
      hv.x += acc2[k][2 * i].x; hv.y += acc2[k][2 * i].y; hv.z += acc2[k][2 * i + 1].x; hv.w += acc2[k][2 * i + 1].y;
      *(float4*)(orow + i * 4) = hv;
    }
  }
}

#endif

#define PHASE(NBLK, CALL) \
  for (int VB = blockIdx.x; VB < (NBLK); VB += gridDim.x) { CALL; __syncthreads(); }
#define PHASE_NS(NBLK, CALL) \
  for (int VB = blockIdx.x; VB < (NBLK); VB += gridDim.x) { CALL; }
#define PHASE_OFF(OFF, NBLK, CALL) \
  for (int VB = (int)((blockIdx.x + gridDim.x - ((OFF) % gridDim.x)) % gridDim.x); VB < (NBLK); VB += gridDim.x) { CALL; __syncthreads(); }

__global__ __launch_bounds__(256, 2) void fwd_megakernel(Params p) {
  __shared__ __attribute__((aligned(16))) char smem_raw[SMEM_BYTES];
  float* smem = (float*)smem_raw;
  volatile LAS unsigned* xb_st = (volatile LAS unsigned*)(smem_raw + 73728);
  if (threadIdx.x == 0) { xb_st[0] = 0u; xb_st[1] = 0u; xb_st[2] = 0u; xb_st[3] = 0u; }
  __syncthreads();
  const XcdBarrier xb = xcd_barrier_post(p.bar, xb_st);
  {
    for (int k = threadIdx.x; k < DM; k += 256) {
      const float* wr = p.w_in + (size_t)k * INC + 1536;
      const float4 a = *(const float4*)(wr), b = *(const float4*)(wr + 4);
      smem[0 * 1024 + k] = a.x; smem[1 * 1024 + k] = a.y; smem[2 * 1024 + k] = a.z; smem[3 * 1024 + k] = a.w;
      smem[4 * 1024 + k] = b.x; smem[5 * 1024 + k] = b.y; smem[6 * 1024 + k] = b.z; smem[7 * 1024 + k] = b.w;
    }
    __syncthreads();
    PHASE_NS(NT / 8, ph_rmsnorm_bf16(VB, p.x, p.mix_norm_w, p.xn_b, smem, p.dt_bias, p.dt));
    __syncthreads();
  }
  PHASE_NS(NB * MEM / 8, ph_rmsnorm_bf16(VB, p.mem, p.mem_norm_w, p.memn_b, nullptr, nullptr, nullptr));
  PHASE(16 * 40, ph_wtrans(VB, smem, p.w_in, INC, p.w_inT, 40, 8, nullptr));
  PHASE(16 * 16, ph_wtrans(VB, smem, p.w_out, DM, p.w_outT, 16, 0, nullptr));
  PHASE(16 * 16, ph_wtrans(VB, smem, p.w_query, DM, p.w_qT, 16, 0, p.ffn_norm_w));
  PHASE(16 * 8, ph_wtrans(VB, smem, p.w_mem_kv, 512, p.w_memT, 8, 0, nullptr));
  if (blockIdx.x == 0) p.bcnt[threadIdx.x] = 0;
  ph_subkeys(p);
  xcd_barrier(xb);
  PHASE(20 * (NT / 128), ph_gemm_proj(VB, smem_raw, p));
  xcd_barrier(xb);
  PHASE(NB * 64 * 8, ph_ssd1(VB, smem_raw, p));
  PHASE(NB * 4 * 32, k_gate(VB, smem_raw, p));
  PHASE_OFF(256, 4 * (NB * MEM / 128), ph_gemm_mem(VB, smem_raw, p));
  xcd_barrier(xb);
  PHASE_NS(NB * 8 * 64 * 128 / 256, ph_ssd2(VB, p));
  {
    int* s_pref = (int*)(smem_raw + 72192);
    {
      const int tid = threadIdx.x;
      int v = (p.bcnt[tid] + 127) >> 7;
      const int lane = tid & 63;
#pragma unroll
      for (int o = 1; o < 64; o <<= 1) { int nb = __shfl_up(v, o); if (lane >= o) v += nb; }
      int* s_wt = s_pref + 256;
      if (lane == 63) s_wt[tid >> 6] = v;
      __syncthreads();
      int add = 0;
      for (int ww = 0; ww < (tid >> 6); ++ww) add += s_wt[ww];
      s_pref[tid] = v + add;
      __syncthreads();
    }
    const int Ug = s_pref[255];
    ph_attn_units(smem_raw, p, Ug, s_pref);
    __syncthreads();
  }
  xcd_barrier(xb);
  PHASE(NB * 64 * 2, ph_ssd3(VB, smem_raw, p));
  if (gridDim.x >= 512) {
    for (int VB = (int)blockIdx.x - 256; VB >= 0 && VB < NT * 4 * 8 / 256; VB += gridDim.x - 256) ph_attn_combine(VB, p);
  } else {
    PHASE_NS(NT * 4 * 8 / 256, ph_attn_combine(VB, p));
  }
  xcd_barrier(xb);
  PHASE(8 * (NT / 128), ph_gemm_f32(VB, smem_raw, p.mixed_b, p.w_outT, p.out, p.x, p.xn_b, p.hss));
  xcd_barrier(xb);
  ushort_t* hn_b = p.xn_b;
  {
    int cv = blockIdx.x;
    for (int VB = blockIdx.x; VB < 8 * (NT / 128); VB += gridDim.x) {
      ph_gemm_route(VB, smem_raw, p, hn_b);
      __syncthreads();
      for (int i = 0; i < 8 && cv < 8192; ++i, cv += gridDim.x) {
        if (cv < 4096) {
#if EX_FP4_DOWN
          ph_cvt4(cv, p.e_down, p.ed8, p.ed_s);
#else
          ph_cvt8(cv, p.e_down, p.ed8, p.ed_s);
#endif
        } else {
#if EX_FP4_UP
          ph_cvt4(cv - 4096, p.e_up, p.eu8, p.eu_s);
#else
          ph_cvt8(cv - 4096, p.e_up, p.eu8, p.eu_s);
#endif
        }
      }
    }
    for (; cv < 8192; cv += gridDim.x) {
      if (cv < 4096) {
#if EX_FP4_DOWN
        ph_cvt4(cv, p.e_down, p.ed8, p.ed_s);
#else
        ph_cvt8(cv, p.e_down, p.ed8, p.ed_s);
#endif
      } else {
#if EX_FP4_UP
        ph_cvt4(cv - 4096, p.e_up, p.eu8, p.eu_s);
#else
        ph_cvt8(cv - 4096, p.e_up, p.eu8, p.eu_s);
#endif
      }
    }
  }
  xcd_barrier(xb);
  PHASE_NS(NT / EX_TOK_PER_VB, k_peer_experts(VB, smem_raw, p, hn_b));
}
}

extern "C" void kernel_launch(void* const* d_in, const int* in_sizes, int n_in, void* d_out, int out_size, void* d_ws, size_t ws_size,
                              hipStream_t stream) {
  Params p{};
  p.x = (const float*)d_in[0]; p.mem = (const float*)d_in[1]; p.mix_norm_w = (const float*)d_in[2]; p.w_in = (const float*)d_in[3];
  p.conv_w = (const float*)d_in[4]; p.conv_b = (const float*)d_in[5]; p.dt_bias = (const float*)d_in[6]; p.a_log = (const float*)d_in[7];
  p.ssd_d = (const float*)d_in[8]; p.ssd_norm_w = (const float*)d_in[9]; p.mq_norm_w = (const float*)d_in[10]; p.mk_norm_w = (const float*)d_in[11];
  p.mem_norm_w = (const float*)d_in[12]; p.w_mem_kv = (const float*)d_in[13]; p.xq_norm_w = (const float*)d_in[14]; p.xk_norm_w = (const float*)d_in[15];
  p.w_out = (const float*)d_in[16]; p.ffn_norm_w = (const float*)d_in[17]; p.w_query = (const float*)d_in[18]; p.sk1 = (const float*)d_in[19];
  p.sk2 = (const float*)d_in[20]; p.e_down = (const float*)d_in[21]; p.e_up = (const float*)d_in[22];
  p.out = (float*)d_out;
  char* ws = (char*)d_ws;
  size_t o = 0;
  auto take = [&](size_t bytes) { char* q = ws + o; o += (bytes + 255) & ~(size_t)255; return q; };
  p.xn_b = (ushort_t*)take((size_t)NT * DM * 2);
  p.xc = p.xn_b;
  p.w_inT = (ushort_t*)take((size_t)NPROJ * DM * 2);
  p.w_outT = (ushort_t*)take((size_t)DM * DM * 2);
  p.w_qT = (ushort_t*)take((size_t)DM * DM * 2);
  p.w_memT = (ushort_t*)take((size_t)512 * DM * 2);
  p.memn_b = (ushort_t*)take((size_t)NB * MEM * DM * 2);
  p.memk_b = (ushort_t*)take((size_t)NB * MEM * 256 * 2);
  p.memvT = (ushort_t*)take((size_t)NB * MEM * 256 * 2);
  char* regQ = take((size_t)NT * 2560 * 2);
  p.zs = (ushort_t*)regQ;
  p.xbc_raw = (ushort_t*)(regQ + (size_t)NT * 512 * 2);
  p.mq = (ushort_t*)(regQ + (size_t)NT * 1536 * 2);
  p.mk = (ushort_t*)(regQ + (size_t)NT * 1792 * 2);
  p.vT = (ushort_t*)(regQ + (size_t)NT * 2048 * 2);
  p.xq = (ushort_t*)(regQ + (size_t)NT * 2304 * 2);
  p.q = (float*)regQ;
  p.dt = (float*)take((size_t)NT * 8 * 4);
  p.acs = (float*)take((size_t)NT * 8 * 4);
  p.cdec = (float*)take((size_t)NB * 64 * 8 * 4);
  p.states = (float*)d_out;
  p.sin_b = (ushort_t*)((char*)d_out + (size_t)NB * 64 * 8 * 8192 * 4);
  p.xT = (ushort_t*)((char*)d_out + (size_t)NB * 64 * 8 * 8192 * 6);
  p.mixed_b = (ushort_t*)take((size_t)NT * DM * 2);
  p.kpart = (float*)take((size_t)NB * 4 * 32 * 4 * 64 * 4);
  p.bcnt = (int*)take(256 * 4);
  p.blist = (int*)take((size_t)256 * 8192 * 4);
  p.pm = (float*)take((size_t)NT * 16 * 4);
  p.pl = (float*)take((size_t)NT * 16 * 4);
  p.pO = p.xbc_raw;
  p.eidx = (int*)take((size_t)NT * 128 * 4);
  p.egate = (float*)take((size_t)NT * 128 * 4);
  p.ed8 = (unsigned char*)take((size_t)16384 * DM);
  p.eu8 = (unsigned char*)take((size_t)16384 * DM);
  p.ed_s = (float*)take(16384 * 4);
  p.eu_s = (float*)take(16384 * 4);
  p.bar = (unsigned*)take(XCD_BAR_WORDS * 4);
  p.hss = (float*)take((size_t)NT * 16 * 4);
  p.skh = (ushort_t*)take(2 * 128 * 64 * 2);
  p.skl = (ushort_t*)take(2 * 128 * 64 * 2);
  if (o > ws_size) return;
  (void)hipMemsetAsync(p.bar, 0, XCD_BAR_WORDS * 4, stream);
  static int grid_blocks = 0;
  if (!grid_blocks) {
    int dev = 0, cus = 0, per_cu = 0;
    (void)hipGetDevice(&dev);
    (void)hipDeviceGetAttribute(&cus, hipDeviceAttributeMultiprocessorCount, dev);
    (void)hipOccupancyMaxActiveBlocksPerMultiprocessor(&per_cu, fwd_megakernel, 256, 0);
    if (per_cu > 2) per_cu = 2;
    if (per_cu < 1) per_cu = 1;
    grid_blocks = cus * per_cu;
  }
  void* args[] = {&p};
  hipError_t e = hipLaunchCooperativeKernel((void*)fwd_megakernel, dim3(grid_blocks), dim3(256), args, 0, stream);
  if (e != hipSuccess) fprintf(stderr, "cooperative launch failed: %s (grid %d)\n", hipGetErrorString(e), grid_blocks);
}
```

```cpp
#include <hip/hip_runtime.h>
#include <hip/hip_cooperative_groups.h>
#include <cstdio>
#include <math.h>
#include <stdint.h>
namespace cg = cooperative_groups;

#ifndef EX_FP4_DOWN
#define EX_FP4_DOWN 1
#endif
#ifndef EX_FP4_UP
#define EX_FP4_UP 1
#endif
namespace {
typedef unsigned short ushort_t;
typedef __attribute__((ext_vector_type(8))) short bf16x8;
typedef __attribute__((ext_vector_type(16))) float f32x16;

constexpr int DM = 1024;
constexpr int NB = 2;
constexpr int SL = 8192;
constexpr int NT = NB * SL;
constexpr int MEM = 256;
constexpr int INC = 2568;
constexpr int NPROJ = 2560;
constexpr float EPS = 1e-6f;
constexpr int SMEM_BYTES = 73728 + 256;

__device__ __forceinline__ float silu_f(float x) { return x * __frcp_rn(1.f + __expf(-x)); }
__device__ __forceinline__ float softplus_f(float x) { return fmaxf(x, 0.f) + log1pf(expf(-fabsf(x))); }
__device__ __forceinline__ float gelu_f(float x) { return 0.5f * x * (1.f + erff(x * 0.70710678118654752f)); }
__device__ __forceinline__ float gelu_fast(float x) {
  const float z = fabsf(x) * 0.70710678118654752f;
  const float t = __frcp_rn(fmaf(0.3275911f, z, 1.f));
  float pl = fmaf(1.061405429f, t, -1.453152027f);
  pl = fmaf(pl, t, 1.421413741f);
  pl = fmaf(pl, t, -0.284496736f);
  pl = fmaf(pl, t, 0.254829592f);
  const float er = 1.f - pl * t * __expf(-z * z);
  return 0.5f * x * (1.f + copysignf(er, x));
}
typedef __attribute__((ext_vector_type(2))) __bf16 bf16x2_hw;
typedef __attribute__((ext_vector_type(2))) float f32x2_hw;
__device__ __forceinline__ unsigned pack2(float a, float b) {
  const f32x2_hw v = {a, b};
  return __builtin_bit_cast(unsigned, __builtin_convertvector(v, bf16x2_hw));
}
__device__ __forceinline__ ushort_t f2bf(float x) { return (ushort_t)(pack2(x, 0.f) & 0xffffu); }
__device__ __forceinline__ float bf2f(ushort_t h) { return __uint_as_float(((unsigned)h) << 16); }
__device__ __forceinline__ float bflo(unsigned w) { return __uint_as_float(w << 16); }
__device__ __forceinline__ float bfhi(unsigned w) { return __uint_as_float(w & 0xffff0000u); }

__device__ __forceinline__ void unpack8(const uint4 v, float (&f)[8]) {
  f[0] = bflo(v.x); f[1] = bfhi(v.x); f[2] = bflo(v.y); f[3] = bfhi(v.y);
  f[4] = bflo(v.z); f[5] = bfhi(v.z); f[6] = bflo(v.w); f[7] = bfhi(v.w);
}

__device__ __forceinline__ float wave_sum(float v) {
#pragma unroll
  for (int o = 32; o > 0; o >>= 1) v += __shfl_xor(v, o);
  return v;
}
__device__ __forceinline__ float wave_max(float v) {
#pragma unroll
  for (int o = 32; o > 0; o >>= 1) v = fmaxf(v, __shfl_xor(v, o));
  return v;
}


#define XB_TMO      128
#define XB_XCNT(j)  (256  + 64 * (j))
#define XB_XSUB(j)  (1280 + 64 * (j))
#define XB_XGEN(j)  (2304 + 64 * (j))
#define XB_TOP      3328
#define XB_TOPGEN   3392
#define XCD_BAR_WORDS 3456
#define XB_SPIN_CAP (1u << 20)
#define LAS __attribute__((address_space(3)))
__device__ __forceinline__ unsigned xb_ld(unsigned* p)              { return __hip_atomic_load(p, __ATOMIC_RELAXED, __HIP_MEMORY_SCOPE_AGENT); }
__device__ __forceinline__ unsigned xb_add(unsigned* p, unsigned v) { return __hip_atomic_fetch_add(p, v, __ATOMIC_RELAXED, __HIP_MEMORY_SCOPE_AGENT); }
__device__ __forceinline__ unsigned xb_xcc_id() { return (unsigned)__builtin_amdgcn_s_getreg((3 << 11) | 20) & 0xFu; }
#define XB_SPIN(cond, bar) do { unsigned _sp = 0; while (cond) { __builtin_amdgcn_s_sleep(1); \
    if ((++_sp & 255u) == 0u) { if (xb_ld(&(bar)[XB_TMO])) break; if (_sp > XB_SPIN_CAP) { atomicAdd(&(bar)[XB_TMO], 1u); break; } } } } while (0)
struct XcdBarrier { unsigned* bar; unsigned x; volatile LAS unsigned* st; };
__device__ __forceinline__ XcdBarrier xcd_barrier_post(unsigned* bar, volatile LAS unsigned* st) {
  XcdBarrier b; b.bar = bar; b.x = xb_xcc_id(); b.st = st;
  if (threadIdx.x == 0) (void)xb_add(&bar[XB_XCNT(b.x)], 1u);
  return b;
}
__device__ __forceinline__ void xcd_barrier_complete(unsigned* bar, unsigned x, unsigned& nloc, unsigned& nx) {
  const unsigned G = gridDim.x * gridDim.y * gridDim.z;
  unsigned sum, cnt, mine, sp = 0u;
  for (;;) {
    sum = 0u; cnt = 0u; mine = 0u;
#pragma unroll
    for (unsigned j = 0; j < 16; ++j) { const unsigned c = xb_ld(&bar[XB_XCNT(j)]); sum += c; cnt += (c > 0u) ? 1u : 0u; mine = (j == x) ? c : mine; }
    if (sum == G) break;
    __builtin_amdgcn_s_sleep(1);
    if ((++sp & 255u) == 0u) { if (xb_ld(&bar[XB_TMO])) break; if (sp > XB_SPIN_CAP) { atomicAdd(&bar[XB_TMO], 1u); break; } }
  }
  nloc = mine > 0u ? mine : 1u; nx = cnt > 0u ? cnt : 1u;
}
__device__ __forceinline__ void xcd_barrier(const XcdBarrier& b) {
  asm volatile("s_waitcnt vmcnt(0)" ::: "memory");
  __syncthreads();
  if (threadIdx.x == 0) {
    unsigned* bar = b.bar;
    __builtin_amdgcn_s_waitcnt(0);
    unsigned nloc = b.st[0], nx = b.st[1];
    if (nloc == 0u) { xcd_barrier_complete(bar, b.x, nloc, nx); b.st[0] = nloc; b.st[1] = nx; }
    const unsigned old = xb_add(&bar[XB_XSUB(b.x)], 1u);
    const unsigned gen = old / nloc;
    if (old + 1u == (gen + 1u) * nloc) {
      __builtin_amdgcn_fence(__ATOMIC_RELEASE, "agent");
      asm volatile("s_waitcnt vmcnt(0)" ::: "memory");
      const unsigned og = xb_add(&bar[XB_TOP], 1u);
      const unsigned tg = og / nx;
      if (og + 1u == (tg + 1u) * nx) xb_add(&bar[XB_TOPGEN], 1u);
      else XB_SPIN(xb_ld(&bar[XB_TOPGEN]) == tg, bar);
      __builtin_amdgcn_fence(__ATOMIC_ACQUIRE, "agent");
      xb_add(&bar[XB_XGEN(b.x)], 1u);
      asm volatile("s_waitcnt vmcnt(0)" ::: "memory");
    } else {
      XB_SPIN(xb_ld(&bar[XB_XGEN(b.x)]) == gen, bar);
      __builtin_amdgcn_fence(__ATOMIC_ACQUIRE, "agent");
      asm volatile("s_waitcnt vmcnt(0)" ::: "memory");
    }
  }
  __syncthreads();
}

struct Params {
  const float *x, *mem, *mix_norm_w, *w_in, *conv_w, *conv_b, *dt_bias, *a_log, *ssd_d, *ssd_norm_w, *mq_norm_w, *mk_norm_w,
      *mem_norm_w, *w_mem_kv, *xq_norm_w, *xk_norm_w, *w_out, *ffn_norm_w, *w_query, *sk1, *sk2, *e_down, *e_up;
  float* out;
  ushort_t *xn_b, *w_inT, *w_outT, *w_qT, *w_memT, *memn_b, *zs, *xbc_raw, *mq, *mk, *xq, *memk_b, *mixed_b;
  float *dt, *q, *egate, *acs, *cdec, *states;
  ushort_t *xc, *xT, *sin_b;
  int *eidx, *bcnt, *blist;
  unsigned* bar;
  float* hss;
  ushort_t *skh, *skl;
  unsigned char *ed8, *eu8;
  float *ed_s, *eu_s;
  float *kpart, *pm, *pl;
  ushort_t *vT, *memvT, *pO;
};

__device__ __forceinline__ void ph_rmsnorm_bf16(const int vb, const float* __restrict__ x, const float* __restrict__ w,
                                                ushort_t* __restrict__ outb, const float* s_wdt  , const float* __restrict__ dt_bias,
                                                float* __restrict__ dt) {
  const int lane = threadIdx.x & 63;
  const int row0 = vb * 8 + (threadIdx.x >> 6) * 2;
  float4 v[2][4];
#pragma unroll
  for (int rr = 0; rr < 2; ++rr)
#pragma unroll
    for (int i = 0; i < 4; ++i) v[rr][i] = *(const float4*)(x + (size_t)(row0 + rr) * DM + i * 256 + lane * 4);
  float4 ww[4];
#pragma unroll
  for (int i = 0; i < 4; ++i) ww[i] = *(const float4*)(w + i * 256 + lane * 4);
#pragma unroll
  for (int rr = 0; rr < 2; ++rr) {
    const int row = row0 + rr;
    float ss = 0.f;
#pragma unroll
    for (int i = 0; i < 4; ++i) ss += v[rr][i].x * v[rr][i].x + v[rr][i].y * v[rr][i].y + v[rr][i].z * v[rr][i].z + v[rr][i].w * v[rr][i].w;
    ss = wave_sum(ss);
    const float r = rsqrtf(ss / DM + EPS);
    float part[8];
#pragma unroll
    for (int hh = 0; hh < 8; ++hh) part[hh] = 0.f;
#pragma unroll
    for (int i = 0; i < 4; ++i) {
      const float o0 = v[rr][i].x * r * ww[i].x, o1 = v[rr][i].y * r * ww[i].y, o2 = v[rr][i].z * r * ww[i].z, o3 = v[rr][i].w * r * ww[i].w;
      *(uint2*)(outb + (size_t)row * DM + i * 256 + lane * 4) = make_uint2(pack2(o0, o1), pack2(o2, o3));
      if (dt) {
        const float xs[4] = {o0, o1, o2, o3};
#pragma unroll
        for (int hh = 0; hh < 8; ++hh) {
          const float4 wv = *(const float4*)(s_wdt + hh * 1024 + i * 256 + lane * 4);
          part[hh] = fmaf(xs[0], wv.x, part[hh]); part[hh] = fmaf(xs[1], wv.y, part[hh]);
          part[hh] = fmaf(xs[2], wv.z, part[hh]); part[hh] = fmaf(xs[3], wv.w, part[hh]);
        }
      }
    }
    if (dt) {
      float mine = 0.f;
#pragma unroll
      for (int hh = 0; hh < 8; ++hh) {
        const float sfull = wave_sum(part[hh]);
        if (lane == hh) mine = sfull;
      }
      if (lane < 8) dt[(size_t)row * 8 + lane] = softplus_f(mine + dt_bias[lane]);
    }
  }
}

__device__ __forceinline__ void ph_wtrans(const int vb, float* smem, const float* __restrict__ W, const int ldw, ushort_t* __restrict__ Wt,
                                          const int ntiles, const int skip, const float* __restrict__ rowscale) {
  float (*s)[65] = (float (*)[65])smem;
  const int tid = threadIdx.x;
  const int kt = vb / ntiles, nt = vb % ntiles;
  const int nd0 = nt * 64;
  const int ns0 = (nd0 < 1536) ? nd0 : nd0 + skip;
  {
    const int k = tid >> 2, nc = (tid & 3) * 16;
    const float* src = W + (size_t)(kt * 64 + k) * ldw + ns0 + nc;
    const float rsc = rowscale ? rowscale[kt * 64 + k] : 1.f;
#pragma unroll
    for (int j = 0; j < 4; ++j) {
      float4 v = *(const float4*)(src + j * 4);
      v.x *= rsc; v.y *= rsc; v.z *= rsc; v.w *= rsc;
      s[k][nc + j * 4 + 0] = v.x; s[k][nc + j * 4 + 1] = v.y; s[k][nc + j * 4 + 2] = v.z; s[k][nc + j * 4 + 3] = v.w;
    }
  }
  __syncthreads();
  {
    const int n = tid >> 2, kc = (tid & 3) * 16;
    unsigned pk[8];
#pragma unroll
    for (int j = 0; j < 8; ++j) pk[j] = pack2(s[kc + 2 * j][n], s[kc + 2 * j + 1][n]);
    ushort_t* dst = Wt + (size_t)(nd0 + n) * DM + kt * 64 + kc;
    *(uint4*)(dst) = make_uint4(pk[0], pk[1], pk[2], pk[3]);
    *(uint4*)(dst + 8) = make_uint4(pk[4], pk[5], pk[6], pk[7]);
  }
}

__device__ __forceinline__ void ph_cvt(const int vb, const float* __restrict__ src, ushort_t* __restrict__ dst) {
  const size_t base = (size_t)vb * 8192 + threadIdx.x * 8;
  float4 a[4], b[4];
#pragma unroll
  for (int i = 0; i < 4; ++i) {
    a[i] = *(const float4*)(src + base + i * 2048);
    b[i] = *(const float4*)(src + base + i * 2048 + 4);
  }
#pragma unroll
  for (int i = 0; i < 4; ++i)
    *(uint4*)(dst + base + i * 2048) = make_uint4(pack2(a[i].x, a[i].y), pack2(a[i].z, a[i].w), pack2(b[i].x, b[i].y), pack2(b[i].z, b[i].w));
}


typedef __attribute__((ext_vector_type(2))) float f32x2_t;
__device__ __forceinline__ void ph_cvt8(const int vb, const float* __restrict__ src, unsigned char* __restrict__ dst, float* __restrict__ inv_scale) {
  const int lane = threadIdx.x & 63;
  const int row = vb * 4 + (threadIdx.x >> 6);
  const float* sr = src + (size_t)row * DM + lane * 16;
  float4 v[4];
#pragma unroll
  for (int i = 0; i < 4; ++i) v[i] = *(const float4*)(sr + i * 4);
  float am = 0.f;
#pragma unroll
  for (int i = 0; i < 4; ++i) am = fmaxf(fmaxf(fmaxf(am, fabsf(v[i].x)), fmaxf(fabsf(v[i].y), fabsf(v[i].z))), fabsf(v[i].w));
  am = wave_max(am);
  const float sc = (am > 0.f) ? 224.f / am : 1.f;
  unsigned w[4];
#pragma unroll
  for (int i = 0; i < 4; ++i) {
    int t = 0;
    t = __builtin_amdgcn_cvt_pk_fp8_f32(v[i].x * sc, v[i].y * sc, t, false);
    t = __builtin_amdgcn_cvt_pk_fp8_f32(v[i].z * sc, v[i].w * sc, t, true);
    w[i] = (unsigned)t;
  }
  *(uint4*)(dst + (size_t)row * DM + lane * 16) = make_uint4(w[0], w[1], w[2], w[3]);
  if (lane == 0) inv_scale[row] = (am > 0.f) ? am * (1.f / 224.f) : 1.f;
}

__device__ __forceinline__ void ph_cvt4(const int vb, const float* __restrict__ src, unsigned char* __restrict__ dst, float* __restrict__ inv_scale) {
  const int lane = threadIdx.x & 63;
  const int row = vb * 4 + (threadIdx.x >> 6);
  const float* sr = src + (size_t)row * DM + lane * 16;
  float4 v[4];
#pragma unroll
  for (int i = 0; i < 4; ++i) v[i] = *(const float4*)(sr + i * 4);
  float am = 0.f;
#pragma unroll
  for (int i = 0; i < 4; ++i) am = fmaxf(fmaxf(fmaxf(am, fabsf(v[i].x)), fmaxf(fabsf(v[i].y), fabsf(v[i].z))), fabsf(v[i].w));
  am = wave_max(am);
  const float sc = (am > 0.f) ? 6.f / am : 1.f;
  unsigned w0 = 0u, w1 = 0u;
  w0 = __builtin_amdgcn_cvt_scalef32_pk_fp4_f32(w0, v[0].x * sc, v[0].y * sc, 1.0f, 0);
  w0 = __builtin_amdgcn_cvt_scalef32_pk_fp4_f32(w0, v[0].z * sc, v[0].w * sc, 1.0f, 1);
  w0 = __builtin_amdgcn_cvt_scalef32_pk_fp4_f32(w0, v[1].x * sc, v[1].y * sc, 1.0f, 2);
  w0 = __builtin_amdgcn_cvt_scalef32_pk_fp4_f32(w0, v[1].z * sc, v[1].w * sc, 1.0f, 3);
  w1 = __builtin_amdgcn_cvt_scalef32_pk_fp4_f32(w1, v[2].x * sc, v[2].y * sc, 1.0f, 0);
  w1 = __builtin_amdgcn_cvt_scalef32_pk_fp4_f32(w1, v[2].z * sc, v[2].w * sc, 1.0f, 1);
  w1 = __builtin_amdgcn_cvt_scalef32_pk_fp4_f32(w1, v[3].x * sc, v[3].y * sc, 1.0f, 2);
  w1 = __builtin_amdgcn_cvt_scalef32_pk_fp4_f32(w1, v[3].z * sc, v[3].w * sc, 1.0f, 3);
  *(uint2*)(dst + (size_t)row * (DM / 2) + lane * 8) = make_uint2(w0, w1);
  if (lane == 0) inv_scale[row] = (am > 0.f) ? am * (1.f / 6.f) : 1.f;
}
__device__ __forceinline__ void dec16_fp8(const uint4 d, f32x2_t (&o)[8]) {
  const unsigned w[4] = {d.x, d.y, d.z, d.w};
#pragma unroll
  for (int k = 0; k < 4; ++k) {
    o[2 * k] = __builtin_amdgcn_cvt_pk_f32_fp8((int)w[k], false);
    o[2 * k + 1] = __builtin_amdgcn_cvt_pk_f32_fp8((int)w[k], true);
  }
}
__device__ __forceinline__ void dec16_fp4(const uint2 d, f32x2_t (&o)[8]) {
  o[0] = __builtin_amdgcn_cvt_scalef32_pk_f32_fp4(d.x, 1.0f, 0); o[1] = __builtin_amdgcn_cvt_scalef32_pk_f32_fp4(d.x, 1.0f, 1);
  o[2] = __builtin_amdgcn_cvt_scalef32_pk_f32_fp4(d.x, 1.0f, 2); o[3] = __builtin_amdgcn_cvt_scalef32_pk_f32_fp4(d.x, 1.0f, 3);
  o[4] = __builtin_amdgcn_cvt_scalef32_pk_f32_fp4(d.y, 1.0f, 0); o[5] = __builtin_amdgcn_cvt_scalef32_pk_f32_fp4(d.y, 1.0f, 1);
  o[6] = __builtin_amdgcn_cvt_scalef32_pk_f32_fp4(d.y, 1.0f, 2); o[7] = __builtin_amdgcn_cvt_scalef32_pk_f32_fp4(d.y, 1.0f, 3);
}
#if EX_FP4_DOWN
typedef uint2 drow_t;
#define DROW_BYTES 8
#define DEC_D dec16_fp4
#else
typedef uint4 drow_t;
#define DROW_BYTES 16
#define DEC_D dec16_fp8
#endif
#if EX_FP4_UP
typedef uint2 urow_t;
#define UROW_BYTES 8
#define DEC_U dec16_fp4
#else
typedef uint4 urow_t;
#define UROW_BYTES 16
#define DEC_U dec16_fp8
#endif

__device__ __forceinline__ int swz(int row, int ch) { return row * 128 + ((ch ^ ((row >> 1) & 7)) << 4); }

__device__ __forceinline__ void gemm_compute(const char* cA, const char* cB, const int arow, const int brow, const int xr, const int h,
                                             f32x16 (&acc)[2][2]) {
#pragma unroll
  for (int ks = 0; ks < 4; ++ks) {
    const int co = ((ks * 2 + h) ^ xr) << 4;
    bf16x8 a0 = *(const bf16x8*)(cA + arow + co);
    bf16x8 a1 = *(const bf16x8*)(cA + arow + 32 * 128 + co);
    bf16x8 b0 = *(const bf16x8*)(cB + brow + co);
    bf16x8 b1 = *(const bf16x8*)(cB + brow + 32 * 128 + co);
    acc[0][0] = __builtin_amdgcn_mfma_f32_32x32x16_bf16(a0, b0, acc[0][0], 0, 0, 0);
    acc[0][1] = __builtin_amdgcn_mfma_f32_32x32x16_bf16(a0, b1, acc[0][1], 0, 0, 0);
    acc[1][0] = __builtin_amdgcn_mfma_f32_32x32x16_bf16(a1, b0, acc[1][0], 0, 0, 0);
    acc[1][1] = __builtin_amdgcn_mfma_f32_32x32x16_bf16(a1, b1, acc[1][1], 0, 0, 0);
  }
}

__device__ __forceinline__ void gemm_core(const ushort_t* __restrict__ A, const ushort_t* __restrict__ Bt, const int K, const int m0,
                                          const int n0, char* smem, f32x16 (&acc)[2][2]) {
  int tid = threadIdx.x;
  asm volatile("" : "+v"(tid));
  const int lane = tid & 63;
  const int wave = __builtin_amdgcn_readfirstlane(tid >> 6);
  const int wm = wave >> 1, wn = wave & 1;
  const int r = lane & 31, h = lane >> 5;
  const int srow = wave * 8 + (lane >> 3);
  const int schs = (lane & 7) ^ ((srow >> 1) & 7);
  const ushort_t* Ag = A + (size_t)(m0 + srow) * K + schs * 8;
  const ushort_t* Bg = Bt + (size_t)(n0 + srow) * K + schs * 8;
  const size_t rs = (size_t)32 * K;
  char* wbase = smem + wave * 1024;
#define GLDS_TILE(BUF, koff) { \
    __builtin_amdgcn_global_load_lds((const unsigned*)(Ag + (koff)), (unsigned*)(wbase + (BUF)), 16, 0, 0); \
    __builtin_amdgcn_global_load_lds((const unsigned*)(Ag + rs + (koff)), (unsigned*)(wbase + (BUF) + 4096), 16, 0, 0); \
    __builtin_amdgcn_global_load_lds((const unsigned*)(Ag + 2 * rs + (koff)), (unsigned*)(wbase + (BUF) + 8192), 16, 0, 0); \
    __builtin_amdgcn_global_load_lds((const unsigned*)(Ag + 3 * rs + (koff)), (unsigned*)(wbase + (BUF) + 12288), 16, 0, 0); \
    __builtin_amdgcn_global_load_lds((const unsigned*)(Bg + (koff)), (unsigned*)(wbase + (BUF) + 16384), 16, 0, 0); \
    __builtin_amdgcn_global_load_lds((const unsigned*)(Bg + rs + (koff)), (unsigned*)(wbase + (BUF) + 16384 + 4096), 16, 0, 0); \
    __builtin_amdgcn_global_load_lds((const unsigned*)(Bg + 2 * rs + (koff)), (unsigned*)(wbase + (BUF) + 16384 + 8192), 16, 0, 0); \
    __builtin_amdgcn_global_load_lds((const unsigned*)(Bg + 3 * rs + (koff)), (unsigned*)(wbase + (BUF) + 16384 + 12288), 16, 0, 0); }
  GLDS_TILE(0, 0)
#pragma unroll
  for (int i = 0; i < 2; ++i)
#pragma unroll
    for (int j = 0; j < 2; ++j)
#pragma unroll
      for (int e = 0; e < 16; ++e) acc[i][j][e] = 0.f;
  const int nk = K >> 6;
  const int xr = (r >> 1) & 7;
  const int arow = (wm * 64 + r) * 128, brow = (wn * 64 + r) * 128;
  asm volatile("s_waitcnt vmcnt(0)" ::: "memory");
  __syncthreads();
#pragma unroll 1
  for (int kt = 0; kt < nk; kt += 2) {
    GLDS_TILE(32768, (kt + 1) * 64)
    gemm_compute(smem, smem + 16384, arow, brow, xr, h, acc);
    asm volatile("s_waitcnt vmcnt(0)" ::: "memory");
    __syncthreads();
    if (kt + 2 < nk) { GLDS_TILE(0, (kt + 2) * 64) }
    gemm_compute(smem + 32768, smem + 32768 + 16384, arow, brow, xr, h, acc);
    asm volatile("s_waitcnt vmcnt(0)" ::: "memory");
    __syncthreads();
  }
#undef GLDS_TILE
}

enum { EP_SILU = 0, EP_PLAIN = 1, EP_HEADNORM = 2 };

__device__ __forceinline__ void stage_flush_bf16(const char* sw, ushort_t* __restrict__ dst, const size_t ld, const size_t row0, const int col0) {
  const int lane = threadIdx.x & 63;
  const int rr = lane >> 3, ch = lane & 7;
#pragma unroll
  for (int i = 0; i < 8; ++i) {
    const int row = i * 8 + rr;
    const uint4 v = *(const uint4*)(sw + row * 144 + ch * 16);
    *(uint4*)(dst + (row0 + row) * ld + col0 + ch * 8) = v;
  }
}

__device__ __forceinline__ void epi_bf16(char* smem, const f32x16 (&acc)[2][2], const int mode, ushort_t* __restrict__ dst, const int ld,
                                         const int row0, const int col0, const float* __restrict__ nw, float* __restrict__ kp) {
  const int lane = threadIdx.x & 63, r = lane & 31, h = lane >> 5;
  char* sw = smem + (threadIdx.x >> 6) * 9216;
  float w0 = 1.f, w1 = 1.f;
  if (mode == EP_HEADNORM) { w0 = nw[r]; w1 = nw[32 + r]; }
  float cs0 = 0.f, cs1 = 0.f;
#pragma unroll
  for (int mi = 0; mi < 2; ++mi) {
#pragma unroll
    for (int e = 0; e < 16; ++e) {
      const int row = mi * 32 + (e & 3) + 8 * (e >> 2) + 4 * h;
      float v0 = acc[mi][0][e], v1 = acc[mi][1][e];
      if (mode == EP_SILU) { v0 = silu_f(v0); v1 = silu_f(v1); }
      if (mode == EP_HEADNORM) {
        float ss = v0 * v0 + v1 * v1;
        ss += __shfl_xor(ss, 1); ss += __shfl_xor(ss, 2); ss += __shfl_xor(ss, 4); ss += __shfl_xor(ss, 8); ss += __shfl_xor(ss, 16);
        const float rs = rsqrtf(ss * (1.f / 64.f) + EPS);
        v0 = v0 * rs * w0; v1 = v1 * rs * w1;
        cs0 += v0; cs1 += v1;
      }
      *(ushort_t*)(sw + row * 144 + r * 2) = f2bf(v0);
      *(ushort_t*)(sw + row * 144 + 64 + r * 2) = f2bf(v1);
    }
  }
  if (kp) {
    cs0 += __shfl_xor(cs0, 32);
    cs1 += __shfl_xor(cs1, 32);
    if (h == 0) { kp[r] = cs0; kp[32 + r] = cs1; }
  }
  stage_flush_bf16(sw, dst, (size_t)ld, (size_t)row0, col0);
}

__device__ __forceinline__ void epi_bf16_T(char* smem, const f32x16 (&acc)[2][2], ushort_t* __restrict__ dstT, const size_t ldT, const int rowpos0) {
  const int lane = threadIdx.x & 63, r = lane & 31, h = lane >> 5;
  char* sw = smem + (threadIdx.x >> 6) * 9216;
#pragma unroll
  for (int ni = 0; ni < 2; ++ni) {
#pragma unroll
    for (int mi = 0; mi < 2; ++mi) {
#pragma unroll
      for (int q4 = 0; q4 < 4; ++q4) {
        const int rp = mi * 32 + 8 * q4 + 4 * h;
        *(uint2*)(sw + (ni * 32 + r) * 144 + rp * 2) = make_uint2(pack2(acc[mi][ni][4 * q4 + 0], acc[mi][ni][4 * q4 + 1]),
                                                                    pack2(acc[mi][ni][4 * q4 + 2], acc[mi][ni][4 * q4 + 3]));
      }
    }
  }
  stage_flush_bf16(sw, dstT, ldT, 0, rowpos0);
}

__device__ __forceinline__ void epi_f32(char* smem, const f32x16 (&acc)[2][2], float* __restrict__ dst, const int ld, const int row0, const int col0,
                                        const float* __restrict__ resid, ushort_t* __restrict__ dstb, float* __restrict__ hss) {
  const int lane = threadIdx.x & 63, r = lane & 31, h = lane >> 5;
  char* sw = smem + (threadIdx.x >> 6) * 17408;
#pragma unroll
  for (int mi = 0; mi < 2; ++mi) {
#pragma unroll
    for (int e = 0; e < 16; ++e) {
      const int row = mi * 32 + (e & 3) + 8 * (e >> 2) + 4 * h;
      *(float*)(sw + row * 272 + r * 4) = acc[mi][0][e];
      *(float*)(sw + row * 272 + 128 + r * 4) = acc[mi][1][e];
    }
  }
  const int rr = lane >> 4, ch = lane & 15;
#pragma unroll
  for (int hb = 0; hb < 2; ++hb) {
    float4 rv[8];
    if (resid) {
#pragma unroll
      for (int i = 0; i < 8; ++i) rv[i] = *(const float4*)(resid + (size_t)(row0 + (hb * 8 + i) * 4 + rr) * ld + col0 + ch * 4);
    }
#pragma unroll
    for (int i = 0; i < 8; ++i) {
      const int row = (hb * 8 + i) * 4 + rr;
      float4 v = *(const float4*)(sw + row * 272 + ch * 16);
      if (resid) { v.x += rv[i].x; v.y += rv[i].y; v.z += rv[i].z; v.w += rv[i].w; }
      *(float4*)(dst + (size_t)(row0 + row) * ld + col0 + ch * 4) = v;
      if (dstb) {
        *(uint2*)(dstb + (size_t)(row0 + row) * ld + col0 + ch * 4) = make_uint2(pack2(v.x, v.y), pack2(v.z, v.w));
        float ss = v.x * v.x + v.y * v.y + v.z * v.z + v.w * v.w;
        ss += __shfl_xor(ss, 1); ss += __shfl_xor(ss, 2); ss += __shfl_xor(ss, 4); ss += __shfl_xor(ss, 8);
        if (ch == 0) hss[(size_t)(row0 + row) * 16 + (col0 >> 6)] = ss;
      }
    }
  }
}

__device__ __forceinline__ void ph_gemm_proj(const int vb, char* smem, const Params& p) {
  const int nt = vb % 20, mt = vb / 20;
  const int m0 = mt * 128, n0 = nt * 128;
  f32x16 acc[2][2];
  gemm_core(p.xn_b, p.w_inT, DM, m0, n0, smem, acc);
  const int wave = threadIdx.x >> 6, wm = wave >> 1, wn = wave & 1;
  const int row0 = m0 + wm * 64;
  const int c = n0 + wn * 64;
  if (c < 512) epi_bf16(smem, acc, EP_SILU, p.zs, 512, row0, c, nullptr, nullptr);
  else if (c < 1536) epi_bf16(smem, acc, EP_PLAIN, p.xbc_raw, 1024, row0, c - 512, nullptr, nullptr);
  else if (c < 1792) epi_bf16(smem, acc, EP_HEADNORM, p.mq, 256, row0, c - 1536, p.mq_norm_w, nullptr);
  else if (c < 2048) {
    const int hh = (c - 1792) >> 6, bb = row0 >> 13, lpos = row0 & (SL - 1);
    epi_bf16(smem, acc, EP_HEADNORM, p.mk, 256, row0, c - 1792, p.mk_norm_w, p.kpart + ((size_t)((bb * 4 + hh) * 32 + (lpos >> 8)) * 4 + ((lpos >> 6) & 3)) * 64);
  } else if (c < 2304) {
    const int hh = (c - 2048) >> 6, bb = row0 >> 13, lpos = row0 & (SL - 1);
    epi_bf16_T(smem, acc, p.vT + (size_t)(bb * 4 + hh) * 64 * SL, SL, lpos);
  }
  else epi_bf16(smem, acc, EP_HEADNORM, p.xq, 256, row0, c - 2304, p.xq_norm_w, nullptr);
}

__device__ __forceinline__ void ph_gemm_mem(const int vb, char* smem, const Params& p) {
  const int nt = vb % 4, mt = vb / 4;
  const int m0 = mt * 128, n0 = nt * 128;
  f32x16 acc[2][2];
  gemm_core(p.memn_b, p.w_memT, DM, m0, n0, smem, acc);
  const int wave = threadIdx.x >> 6, wm = wave >> 1, wn = wave & 1;
  const int row0 = m0 + wm * 64;
  const int c = n0 + wn * 64;
  if (c < 256) epi_bf16(smem, acc, EP_HEADNORM, p.memk_b, 256, row0, c, p.xk_norm_w, nullptr);
  else {
    const int hh = (c - 256) >> 6, bb = row0 >> 8, mpos = row0 & 255;
    epi_bf16_T(smem, acc, p.memvT + (size_t)(bb * 4 + hh) * 64 * MEM, MEM, mpos);
  }
}

__device__ __forceinline__ void ph_gemm_f32(const int vb, char* smem, const ushort_t* A, const ushort_t* Bt, float* dst, const float* resid, ushort_t* dstb, float* hss) {
  const int nt = vb % 8, mt = vb / 8;
  const int m0 = mt * 128, n0 = nt * 128;
  f32x16 acc[2][2];
  gemm_core(A, Bt, DM, m0, n0, smem, acc);
  const int wave = threadIdx.x >> 6, wm = wave >> 1, wn = wave & 1;
  epi_f32(smem, acc, dst, DM, m0 + wm * 64, n0 + wn * 64, resid, dstb, hss);
}

__device__ __forceinline__ int swz256(int row, int ch) { return row * 272 + (ch << 4); }
__device__ __forceinline__ int crow16(int e, int hl) { return (e & 3) + 8 * (e >> 2) + 4 * hl; }

__device__ __forceinline__ void ph_ssd1(const int vb, char* smem, const Params& p) {
  const int h = vb & 7, c = (vb >> 3) & 63, b = vb >> 9;
  const int g = h >> 2, hq = h & 3;
  int tid = threadIdx.x;
  asm volatile("" : "+v"(tid));
  const int lane = tid & 63, wave = tid >> 6;
  const int t0 = b * SL + c * 128;
  char* s_xw = smem;
  char* s_bt = smem + 17408;
  float* s_acs = (float*)(smem + 52224);
  float* s_w = s_acs + 128;
  float* s_red = s_w + 128;
  const float a_coef = -expf(p.a_log[h]);
  float dtv = 0.f, cs = 0.f;
  if (tid < 128) {
    dtv = p.dt[(size_t)(t0 + tid) * 8 + h];
    cs = dtv * a_coef;
#pragma unroll
    for (int o = 1; o < 64; o <<= 1) {
      float nb = __shfl_up(cs, o);
      if (lane >= o) cs += nb;
    }
    if (lane == 63) s_red[wave] = cs;
  }
  __syncthreads();
  if (tid < 128) {
    if (wave == 1) cs += s_red[0];
    s_acs[tid] = cs;
    p.acs[(size_t)(t0 + tid) * 8 + h] = cs;
  }
  __syncthreads();
  if (tid < 128) {
    const float tot = s_acs[127];
    s_w[tid] = dtv * expf(tot - cs);
    if (tid == 0) p.cdec[(b * 64 + c) * 8 + h] = expf(tot);
  }
  __syncthreads();
  if (tid < 224) {
    const int seg = tid / 28, cg = tid - seg * 28;
    const bool is_x = cg < 8, is_b = (cg >= 8) && (cg < 24);
    int ch0, trow;
    if (is_x) { ch0 = h * 64 + cg * 8; trow = cg * 8; }
    else if (is_b) { ch0 = 512 + g * 128 + (cg - 8) * 8; trow = (cg - 8) * 8; }
    else { ch0 = 768 + g * 128 + hq * 32 + (cg - 24) * 8; trow = 0; }
    const bool wr_nat = is_x || !is_b || (hq == 0);
    char* tbase = is_x ? s_xw : s_bt;
    const int l0 = seg * 16;
    float w0[8], w1[8], w2[8], w3[8], bias[8];
    {
      const float* cw = p.conv_w + ch0;
      float4 a, bq;
      a = *(const float4*)(cw); bq = *(const float4*)(cw + 4);
      w0[0] = a.x; w0[1] = a.y; w0[2] = a.z; w0[3] = a.w; w0[4] = bq.x; w0[5] = bq.y; w0[6] = bq.z; w0[7] = bq.w;
      a = *(const float4*)(cw + 1024); bq = *(const float4*)(cw + 1028);
      w1[0] = a.x; w1[1] = a.y; w1[2] = a.z; w1[3] = a.w; w1[4] = bq.x; w1[5] = bq.y; w1[6] = bq.z; w1[7] = bq.w;
      a = *(const float4*)(cw + 2048); bq = *(const float4*)(cw + 2052);
      w2[0] = a.x; w2[1] = a.y; w2[2] = a.z; w2[3] = a.w; w2[4] = bq.x; w2[5] = bq.y; w2[6] = bq.z; w2[7] = bq.w;
      a = *(const float4*)(cw + 3072); bq = *(const float4*)(cw + 3076);
      w3[0] = a.x; w3[1] = a.y; w3[2] = a.z; w3[3] = a.w; w3[4] = bq.x; w3[5] = bq.y; w3[6] = bq.z; w3[7] = bq.w;
      a = *(const float4*)(p.conv_b + ch0); bq = *(const float4*)(p.conv_b + ch0 + 4);
      bias[0] = a.x; bias[1] = a.y; bias[2] = a.z; bias[3] = a.w; bias[4] = bq.x; bias[5] = bq.y; bias[6] = bq.z; bias[7] = bq.w;
    }
    float r0[8], r1[8], r2[8];
    {
      const int lg = c * 128 + l0;
      const ushort_t* src = p.xbc_raw + (size_t)(t0 + l0) * 1024 + ch0;
      uint4 z4 = make_uint4(0u, 0u, 0u, 0u);
      uint4 u0 = (lg >= 3) ? *(const uint4*)(src - 3 * 1024) : z4;
      uint4 u1 = (lg >= 2) ? *(const uint4*)(src - 2 * 1024) : z4;
      uint4 u2 = (lg >= 1) ? *(const uint4*)(src - 1 * 1024) : z4;
      unpack8(u0, r0); unpack8(u1, r1); unpack8(u2, r2);
    }
    unsigned outp[8][8];
    float lo[8], los[8];
#pragma unroll
    for (int i = 0; i < 16; ++i) {
      float cur[8], val[8];
      unpack8(*(const uint4*)(p.xbc_raw + (size_t)(t0 + l0 + i) * 1024 + ch0), cur);
#pragma unroll
      for (int j = 0; j < 8; ++j) {
        float v = bias[j];
        v = fmaf(w0[j], r0[j], v); v = fmaf(w1[j], r1[j], v); v = fmaf(w2[j], r2[j], v); v = fmaf(w3[j], cur[j], v);
        val[j] = silu_f(v);
        r0[j] = r1[j]; r1[j] = r2[j]; r2[j] = cur[j];
      }
      if (wr_nat) {
        *(uint4*)(p.xc + (size_t)(t0 + l0 + i) * 1024 + ch0) =
            make_uint4(pack2(val[0], val[1]), pack2(val[2], val[3]), pack2(val[4], val[5]), pack2(val[6], val[7]));
      }
      const float scl = is_x ? s_w[l0 + i] : 1.f;
      if ((i & 1) == 0) {
#pragma unroll
        for (int j = 0; j < 8; ++j) { lo[j] = val[j]; los[j] = val[j] * scl; }
      } else {
        const int chunk = seg * 2 + (i >> 3);
#pragma unroll
        for (int j = 0; j < 8; ++j) {
          outp[j][i >> 1] = pack2(lo[j], val[j]);
          if (is_x || is_b) *(unsigned*)(tbase + swz256(trow + j, chunk) + ((i & 7) - 1) * 2) = pack2(los[j], val[j] * scl);
        }
      }
    }
    if (is_x) {
      ushort_t* dst = p.xT + ((size_t)((b * 64 + c) * 8 + h) * 64 + cg * 8) * 128 + l0;
#pragma unroll
      for (int j = 0; j < 8; ++j) {
        *(uint4*)(dst + (size_t)j * 128) = make_uint4(outp[j][0], outp[j][1], outp[j][2], outp[j][3]);
        *(uint4*)(dst + (size_t)j * 128 + 8) = make_uint4(outp[j][4], outp[j][5], outp[j][6], outp[j][7]);
      }
    }
  }
  __syncthreads();
  {
    const int r = lane & 31, hl = lane >> 5;
    f32x16 acc[2];
#pragma unroll
    for (int e = 0; e < 16; ++e) { acc[0][e] = 0.f; acc[1][e] = 0.f; }
#pragma unroll
    for (int ks = 0; ks < 8; ++ks) {
      const bf16x8 bfr = *(const bf16x8*)(s_bt + swz256(32 * wave + r, ks * 2 + hl));
      const bf16x8 a0 = *(const bf16x8*)(s_xw + swz256(r, ks * 2 + hl));
      const bf16x8 a1 = *(const bf16x8*)(s_xw + swz256(32 + r, ks * 2 + hl));
      acc[0] = __builtin_amdgcn_mfma_f32_32x32x16_bf16(a0, bfr, acc[0], 0, 0, 0);
      acc[1] = __builtin_amdgcn_mfma_f32_32x32x16_bf16(a1, bfr, acc[1], 0, 0, 0);
    }
    float* dst = p.states + (size_t)((b * 64 + c) * 8 + h) * 64 * 128;
#pragma unroll
    for (int pt = 0; pt < 2; ++pt)
#pragma unroll
      for (int e = 0; e < 16; ++e) dst[(size_t)(pt * 32 + crow16(e, hl)) * 128 + 32 * wave + r] = acc[pt][e];
  }
}

__device__ __forceinline__ void ph_ssd2(const int vb, const Params& p) {
  const int idx = vb * 256 + threadIdx.x;
  const int pn = idx & 8191, h = (idx >> 13) & 7, b = idx >> 16;
  float st = 0.f;
#pragma unroll 1
  for (int c0 = 0; c0 < 64; c0 += 8) {
    float sv[8], dv[8];
#pragma unroll
    for (int i = 0; i < 8; ++i) {
      const int cc = (b * 64 + c0 + i) * 8 + h;
      sv[i] = p.states[(size_t)cc * 8192 + pn];
      dv[i] = p.cdec[cc];
    }
#pragma unroll
    for (int i = 0; i < 8; ++i) {
      const int cc = (b * 64 + c0 + i) * 8 + h;
      p.sin_b[(size_t)cc * 8192 + pn] = f2bf(st);
      st = fmaf(st, dv[i], sv[i]);
    }
  }
}

__device__ __forceinline__ void ph_ssd3(const int vb, char* smem, const Params& p) {
  const int g = vb & 1, c = (vb >> 1) & 63, b = vb >> 7;
  int tid = threadIdx.x;
  asm volatile("" : "+v"(tid));
  const int lane = tid & 63;
  const int w = __builtin_amdgcn_readfirstlane(tid >> 6);
  const int r = lane & 31, hl = lane >> 5;
  const int t0 = b * SL + c * 128;
  char* s_C = smem;
  char* s_B = smem + 34816;
  char* s_xT = smem + 34816;
  char* s_S = smem + 34816 + 16896;
  float* s_acs = (float*)(smem + 69632);
  float* s_dt = s_acs + 512;
  {
    const int ch = tid & 15, r0 = tid >> 4;
#pragma unroll
    for (int i = 0; i < 8; ++i) {
      const int row = r0 + 16 * i;
      const ushort_t* src = p.xc + (size_t)(t0 + row) * 1024 + g * 128 + ch * 8;
      *(uint4*)(s_B + swz256(row, ch)) = *(const uint4*)(src + 512);
      *(uint4*)(s_C + swz256(row, ch)) = *(const uint4*)(src + 768);
    }
    if (tid < 128) {
#pragma unroll
      for (int hh = 0; hh < 4; ++hh) {
        s_acs[hh * 128 + tid] = p.acs[(size_t)(t0 + tid) * 8 + g * 4 + hh];
        s_dt[hh * 128 + tid] = p.dt[(size_t)(t0 + tid) * 8 + g * 4 + hh];
      }
    }
  }
  __syncthreads();
  bf16x8 cfr[8];
#pragma unroll
  for (int ks = 0; ks < 8; ++ks) cfr[ks] = *(const bf16x8*)(s_C + swz256(32 * w + r, ks * 2 + hl));
  f32x16 gt[4];
#pragma unroll
  for (int st = 0; st < 4; ++st) {
#pragma unroll
    for (int e = 0; e < 16; ++e) gt[st][e] = 0.f;
    if (st <= w) {
#pragma unroll
      for (int ks = 0; ks < 8; ++ks) {
        const bf16x8 a = *(const bf16x8*)(s_B + swz256(32 * st + r, ks * 2 + hl));
        gt[st] = __builtin_amdgcn_mfma_f32_32x32x16_bf16(a, cfr[ks], gt[st], 0, 0, 0);
      }
    }
  }
  __syncthreads();
  float ssq = 0.f;
  const int lane_c = lane;
#pragma unroll 1
  for (int hh = 0; hh < 4; ++hh) {
    int lane_o = lane_c;
    asm volatile("" : "+v"(lane_o));
    const int r = lane_o & 31, hl = lane_o >> 5;
    const int l = 32 * w + r;
    const int hg = g * 4 + hh;
    {
      const int ch = tid & 15, r0 = tid >> 4;
      const size_t base = (size_t)((b * 64 + c) * 8 + hg) * 8192;
#pragma unroll
      for (int i = 0; i < 4; ++i) {
        const int row = r0 + 16 * i;
        const uint4 xv = *(const uint4*)(p.xT + base + (size_t)row * 128 + ch * 8);
        *(uint2*)(s_xT + row * 264 + ch * 16) = make_uint2(xv.x, xv.y);
        *(uint2*)(s_xT + row * 264 + ch * 16 + 8) = make_uint2(xv.z, xv.w);
        *(uint4*)(s_S + swz256(row, ch)) = *(const uint4*)(p.sin_b + base + (size_t)row * 128 + ch * 8);
      }
    }
    __syncthreads();
    const float acs_l = s_acs[hh * 128 + l];
    const float dsk = p.ssd_d[hg];
    f32x16 acc[2];
#pragma unroll
    for (int e = 0; e < 16; ++e) { acc[0][e] = 0.f; acc[1][e] = 0.f; }
#pragma unroll
    for (int ks = 0; ks < 8; ++ks) {
      const bf16x8 a0 = *(const bf16x8*)(s_S + swz256(r, ks * 2 + hl));
      const bf16x8 a1 = *(const bf16x8*)(s_S + swz256(32 + r, ks * 2 + hl));
      acc[0] = __builtin_amdgcn_mfma_f32_32x32x16_bf16(a0, cfr[ks], acc[0], 0, 0, 0);
      acc[1] = __builtin_amdgcn_mfma_f32_32x32x16_bf16(a1, cfr[ks], acc[1], 0, 0, 0);
    }
    {
      const float el = expf(acs_l);
#pragma unroll
      for (int e = 0; e < 16; ++e) { acc[0][e] *= el; acc[1][e] *= el; }
    }
#pragma unroll
    for (int st = 0; st < 4; ++st) {
      asm volatile("" ::: "memory");
      if (st <= w) {
        float m[16];
#pragma unroll
        for (int e = 0; e < 16; ++e) {
          const int sidx = 32 * st + crow16(e, hl);
          float v = gt[st][e] * __expf(acs_l - s_acs[hh * 128 + sidx]) * s_dt[hh * 128 + sidx];
          if (sidx > l) v = 0.f;
          if (sidx == l) v += dsk;
          m[e] = v;
        }
#pragma unroll
        for (int k2 = 0; k2 < 2; ++k2) {
          asm volatile("" ::: "memory");
          bf16x8 mf;
          {
            unsigned u0 = pack2(m[8 * k2 + 0], m[8 * k2 + 1]), u1 = pack2(m[8 * k2 + 2], m[8 * k2 + 3]);
            unsigned u2 = pack2(m[8 * k2 + 4], m[8 * k2 + 5]), u3 = pack2(m[8 * k2 + 6], m[8 * k2 + 7]);
            uint4 uu = make_uint4(u0, u1, u2, u3);
            mf = *(bf16x8*)&uu;
          }
          const int soff = (32 * st + 16 * k2 + 4 * hl) * 2;
#pragma unroll
          for (int pt = 0; pt < 2; ++pt) {
            const char* ap = s_xT + (pt * 32 + r) * 264 + soff;
            uint2 q0 = *(const uint2*)(ap);
            uint2 q1 = *(const uint2*)(ap + 16);
            uint4 qq = make_uint4(q0.x, q0.y, q1.x, q1.y);
            const bf16x8 af = *(bf16x8*)&qq;
            acc[pt] = __builtin_amdgcn_mfma_f32_32x32x16_bf16(af, mf, acc[pt], 0, 0, 0);
          }
        }
      }
    }
#pragma unroll
    for (int pt = 0; pt < 2; ++pt) {
#pragma unroll
      for (int q4 = 0; q4 < 4; ++q4) {
        asm volatile("" ::: "memory");
        const int p0 = pt * 32 + 8 * q4 + 4 * hl;
        const uint2 zz = *(const uint2*)(p.zs + (size_t)(t0 + l) * 512 + hg * 64 + p0);
        const float v0 = acc[pt][4 * q4 + 0] * bflo(zz.x), v1 = acc[pt][4 * q4 + 1] * bfhi(zz.x);
        const float v2 = acc[pt][4 * q4 + 2] * bflo(zz.y), v3 = acc[pt][4 * q4 + 3] * bfhi(zz.y);
        ssq += v0 * v0 + v1 * v1 + v2 * v2 + v3 * v3;
        *(uint2*)(p.mixed_b + (size_t)(t0 + l) * 1024 + hg * 64 + p0) = make_uint2(pack2(v0, v1), pack2(v2, v3));
      }
    }
    __syncthreads();
  }
  const int l = 32 * w + r;
  ssq += __shfl_xor(ssq, 32);
  const float rstd = rsqrtf(ssq * (1.f / 256.f) + EPS);
#pragma unroll 1
  for (int hh = 0; hh < 4; ++hh) {
#pragma unroll
    for (int pt = 0; pt < 2; ++pt) {
#pragma unroll
      for (int q4 = 0; q4 < 4; ++q4) {
        asm volatile("" ::: "memory");
        const int chn = (g * 4 + hh) * 64 + pt * 32 + 8 * q4 + 4 * hl;
        ushort_t* ptr = p.mixed_b + (size_t)(t0 + l) * 1024 + chn;
        const uint2 vv = *(const uint2*)ptr;
        const float4 nw = *(const float4*)(p.ssd_norm_w + chn);
        *(uint2*)ptr = make_uint2(pack2(bflo(vv.x) * rstd * nw.x, bfhi(vv.x) * rstd * nw.y),
                                  pack2(bflo(vv.y) * rstd * nw.z, bfhi(vv.y) * rstd * nw.w));
      }
    }
  }
}

__device__ __forceinline__ void k_gate(const int VB, char* smem, const Params& p) {
  const int own = VB & 31, bh = VB >> 5;
  if (own == 0) return;
  const int b = bh >> 2, h = bh & 3;
  const int tid = threadIdx.x;
  float* s_km = (float*)smem;
  int* s_cnt = (int*)(smem + 8192);
  int* s_base = s_cnt + 32;
  for (int i = tid; i < own * 64; i += 256) {
    const int n = i >> 6, d = i & 63;
    const float* kp = p.kpart + (size_t)(bh * 32 + n) * 256 + d;
    s_km[i] = (kp[0] + kp[64]) + (kp[128] + kp[192]);
  }
  if (tid < 32) s_cnt[tid] = 0;
  __syncthreads();
  const int l = own * 256 + tid;
  const int t = b * SL + l;
  float q[64];
  {
    const ushort_t* src = p.mq + (size_t)t * 256 + h * 64;
#pragma unroll
    for (int d = 0; d < 64; d += 8) {
      uint4 v = *(const uint4*)(src + d);
      q[d] = bflo(v.x); q[d + 1] = bfhi(v.x); q[d + 2] = bflo(v.y); q[d + 3] = bfhi(v.y);
      q[d + 4] = bflo(v.z); q[d + 5] = bfhi(v.z); q[d + 6] = bflo(v.w); q[d + 7] = bfhi(v.w);
    }
  }
  float v0 = -INFINITY, v1 = -INFINITY, v2 = -INFINITY;
  int i0 = 0, i1 = 1, i2 = 2;
  for (int n = 0; n < own; ++n) {
    const float* km = s_km + n * 64;
    float sa = 0.f, sb = 0.f;
#pragma unroll
    for (int d = 0; d < 64; d += 8) {
      const float4 a = *(const float4*)(km + d), c = *(const float4*)(km + d + 4);
      sa = fmaf(q[d], a.x, sa); sa = fmaf(q[d + 1], a.y, sa); sa = fmaf(q[d + 2], a.z, sa); sa = fmaf(q[d + 3], a.w, sa);
      sb = fmaf(q[d + 4], c.x, sb); sb = fmaf(q[d + 5], c.y, sb); sb = fmaf(q[d + 6], c.z, sb); sb = fmaf(q[d + 7], c.w, sb);
    }
    const float sv = sa + sb;
    if (sv > v0) { v2 = v1; i2 = i1; v1 = v0; i1 = i0; v0 = sv; i0 = n; }
    else if (sv > v1) { v2 = v1; i2 = i1; v1 = sv; i1 = n; }
    else if (sv > v2) { v2 = sv; i2 = n; }
  }
  const int nsel = own < 3 ? own : 3;
  int lp0 = 0, lp1 = 0, lp2 = 0;
  if (0 < nsel) lp0 = atomicAdd(s_cnt + i0, 1);
  if (1 < nsel) lp1 = atomicAdd(s_cnt + i1, 1);
  if (2 < nsel) lp2 = atomicAdd(s_cnt + i2, 1);
  __syncthreads();
  if (tid < own) s_base[tid] = s_cnt[tid] ? atomicAdd(p.bcnt + bh * 32 + tid, s_cnt[tid]) : 0;
  __syncthreads();
  if (0 < nsel) p.blist[(size_t)(bh * 32 + i0) * 8192 + s_base[i0] + lp0] = l | (0 << 13);
  if (1 < nsel) p.blist[(size_t)(bh * 32 + i1) * 8192 + s_base[i1] + lp1] = l | (1 << 13);
  if (2 < nsel) p.blist[(size_t)(bh * 32 + i2) * 8192 + s_base[i2] + lp2] = l | (2 << 13);
}

struct UnitDesc { const ushort_t* Kp; const ushort_t* VTp; int vstride; int kind; int a0; int a1; };
__device__ __forceinline__ UnitDesc unit_desc(const int u, const int Ug, const int* s_pref, const Params& p) {
  UnitDesc d;
  if (u >= Ug + NB * 4 * 32 * 2) {
    const int v = u - Ug - NB * 4 * 32 * 2;
    d.kind = 2; d.a0 = v >> 6; d.a1 = v & 63;
    const int bh = d.a0, b = bh >> 2, h = bh & 3;
    d.Kp = p.memk_b + (size_t)b * MEM * 256 + h * 64;
    d.VTp = p.memvT + (size_t)bh * 64 * MEM;
    d.vstride = MEM;
  } else {
    if (u < Ug) {
      int lo = 0, hi = 255;
      while (lo < hi) { const int mid = (lo + hi) >> 1; if (s_pref[mid] > u) hi = mid; else lo = mid + 1; }
      const int prev = lo ? s_pref[lo - 1] : 0;
      d.kind = 0; d.a0 = lo; d.a1 = u - prev;
    } else {
      const int v = u - Ug;
      d.kind = 1; d.a0 = v >> 1; d.a1 = v & 1;
    }
    const int bh = d.a0 >> 5, jblk = d.a0 & 31, b = bh >> 2, h = bh & 3;
    d.Kp = p.mk + (size_t)(b * SL + jblk * 256) * 256 + h * 64;
    d.VTp = p.vT + (size_t)bh * 64 * SL + jblk * 256;
    d.vstride = SL;
  }
  return d;
}

#define AU_LOAD(P, D, ST) { \
    const ushort_t* kp_ = (D).Kp + (size_t)((ST) * 128 + kr) * 256 + kc * 8; \
    P##k0 = *(const uint4*)(kp_); P##k1 = *(const uint4*)(kp_ + 32 * 256); P##k2 = *(const uint4*)(kp_ + 64 * 256); P##k3 = *(const uint4*)(kp_ + 96 * 256); \
    const ushort_t* vp_ = (D).VTp + (size_t)vr * (D).vstride + (ST) * 128 + vc * 8; \
    P##v0 = *(const uint4*)(vp_); P##v1 = *(const uint4*)(vp_ + (size_t)16 * (D).vstride); \
    P##v2 = *(const uint4*)(vp_ + (size_t)32 * (D).vstride); P##v3 = *(const uint4*)(vp_ + (size_t)48 * (D).vstride); }
#define AU_STORE(P, BUF) { \
    char* sk_ = (BUF) + kr * 144 + kc * 16; \
    *(uint4*)(sk_) = P##k0; *(uint4*)(sk_ + 32 * 144) = P##k1; *(uint4*)(sk_ + 64 * 144) = P##k2; *(uint4*)(sk_ + 96 * 144) = P##k3; \
    char* sv_ = (BUF) + 18432 + vr * 264 + vc * 16; \
    *(uint2*)(sv_) = make_uint2(P##v0.x, P##v0.y); *(uint2*)(sv_ + 8) = make_uint2(P##v0.z, P##v0.w); \
    *(uint2*)(sv_ + 16 * 264) = make_uint2(P##v1.x, P##v1.y); *(uint2*)(sv_ + 16 * 264 + 8) = make_uint2(P##v1.z, P##v1.w); \
    *(uint2*)(sv_ + 32 * 264) = make_uint2(P##v2.x, P##v2.y); *(uint2*)(sv_ + 32 * 264 + 8) = make_uint2(P##v2.z, P##v2.w); \
    *(uint2*)(sv_ + 48 * 264) = make_uint2(P##v3.x, P##v3.y); *(uint2*)(sv_ + 48 * 264 + 8) = make_uint2(P##v3.z, P##v3.w); }

__device__ __forceinline__ void attn_stage(const char* buf, const int st, const bf16x8 (&qf)[4], const float slope, const int qrel, const bool causal,
                                           const int r, const int hl, f32x16 (&o)[2], float& m, float& lsum) {
  const char* s_K = buf;
  const char* s_VT = buf + 18432;
  f32x16 sc[4];
#pragma unroll
  for (int kt = 0; kt < 4; ++kt) {
#pragma unroll
    for (int e = 0; e < 16; ++e) sc[kt][e] = 0.f;
#pragma unroll
    for (int ks = 0; ks < 4; ++ks) {
      const bf16x8 a = *(const bf16x8*)(s_K + (32 * kt + r) * 144 + (2 * ks + hl) * 16);
      sc[kt] = __builtin_amdgcn_mfma_f32_32x32x16_bf16(a, qf[ks], sc[kt], 0, 0, 0);
    }
  }
  float mx = -1e30f;
  const int qk0 = qrel - st * 128 - 4 * hl;
#pragma unroll
  for (int kt = 0; kt < 4; ++kt) {
#pragma unroll
    for (int e = 0; e < 16; ++e) {
      const int dist = qk0 - (32 * kt + (e & 3) + 8 * (e >> 2));
      float v = fmaf(sc[kt][e], 0.125f, -slope * (float)dist);
      if (causal && dist < 0) v = -1e30f;
      sc[kt][e] = v;
      mx = fmaxf(mx, v);
    }
  }
  mx = fmaxf(mx, __shfl_xor(mx, 32));
  const float mnew = fmaxf(m, mx);
  const float alpha = __expf(m - mnew);
  m = mnew;
  lsum *= alpha;
#pragma unroll
  for (int e = 0; e < 16; ++e) { o[0][e] *= alpha; o[1][e] *= alpha; }
#pragma unroll
  for (int kt = 0; kt < 4; ++kt) {
#pragma unroll
    for (int e = 0; e < 16; ++e) {
      const float pe = __expf(sc[kt][e] - mnew);
      sc[kt][e] = pe;
      lsum += pe;
    }
  }
#pragma unroll
  for (int kt = 0; kt < 4; ++kt) {
#pragma unroll
    for (int k2 = 0; k2 < 2; ++k2) {
      uint4 pu = make_uint4(pack2(sc[kt][8 * k2 + 0], sc[kt][8 * k2 + 1]), pack2(sc[kt][8 * k2 + 2], sc[kt][8 * k2 + 3]),
                            pack2(sc[kt][8 * k2 + 4], sc[kt][8 * k2 + 5]), pack2(sc[kt][8 * k2 + 6], sc[kt][8 * k2 + 7]));
      const bf16x8 pf = *(bf16x8*)&pu;
      const int koff = (32 * kt + 16 * k2 + 4 * hl) * 2;
#pragma unroll
      for (int dt = 0; dt < 2; ++dt) {
        const char* ap = s_VT + (dt * 32 + r) * 264 + koff;
        const uint2 q0 = *(const uint2*)(ap);
        const uint2 q1 = *(const uint2*)(ap + 16);
        uint4 qq = make_uint4(q0.x, q0.y, q1.x, q1.y);
        const bf16x8 af = *(bf16x8*)&qq;
        o[dt] = __builtin_amdgcn_mfma_f32_32x32x16_bf16(af, pf, o[dt], 0, 0, 0);
      }
    }
  }
}

__device__ __forceinline__ void ph_attn_units(char* smem, const Params& p, const int Ug, const int* s_pref) {
  const int Utot = Ug + NB * 4 * 32 * 2 + NB * 4 * 64;
  int u = blockIdx.x;
  if (u >= Utot) return;
  int tid = threadIdx.x;
  asm volatile("" : "+v"(tid));
  const int lane = tid & 63, wave = tid >> 6, r = lane & 31, hl = lane >> 5;
  const int kr = tid >> 3, kc = tid & 7, vr = tid >> 4, vc = tid & 15;
  char* buf0 = smem;
  char* buf1 = smem + 35328;
  uint4 Ak0, Ak1, Ak2, Ak3, Av0, Av1, Av2, Av3, Bk0, Bk1, Bk2, Bk3, Bv0, Bv1, Bv2, Bv3;
  UnitDesc D = unit_desc(u, Ug, s_pref, p);
  AU_LOAD(A, D, 0)
  AU_LOAD(B, D, 1)
#pragma unroll 1
  for (; u < Utot; u += gridDim.x) {
    const int un = (u + (int)gridDim.x < Utot) ? u + (int)gridDim.x : u;
    const UnitDesc Dn = unit_desc(un, Ug, s_pref, p);
    int bh, l = 0, slot = 3, jblk = 0;
    bool valid = true, causal = false;
    const ushort_t* qrow;
    float slope = 0.f;
    int qrel = 1 << 20;
    int t;
    if (D.kind == 2) {
      bh = D.a0;
      t = (bh >> 2) * SL + D.a1 * 128 + wave * 32 + r;
      qrow = p.xq + (size_t)t * 256 + (bh & 3) * 64;
    } else {
      bh = D.a0 >> 5; jblk = D.a0 & 31;
      if (D.kind == 0) {
        const int cnt = p.bcnt[D.a0];
        int qi = D.a1 * 128 + wave * 32 + r;
        if (qi >= cnt) { valid = false; qi = 0; }
        const int ent = p.blist[(size_t)D.a0 * 8192 + qi];
        l = ent & 8191; slot = ent >> 13;
      } else {
        l = jblk * 256 + D.a1 * 128 + wave * 32 + r; slot = 3; causal = true;
      }
      t = (bh >> 2) * SL + l;
      qrow = p.mq + (size_t)t * 256 + (bh & 3) * 64;
      slope = exp2f(-2.f * (float)((bh & 3) + 1));
      qrel = l - jblk * 256;
    }
    bf16x8 qf[4];
#pragma unroll
    for (int ks = 0; ks < 4; ++ks) qf[ks] = *(const bf16x8*)(qrow + ks * 16 + hl * 8);
    f32x16 o[2];
#pragma unroll
    for (int e = 0; e < 16; ++e) { o[0][e] = 0.f; o[1][e] = 0.f; }
    float m = -1e30f, lsum = 0.f;
    AU_STORE(A, buf0)
    AU_LOAD(A, Dn, 0)
    __syncthreads();
    attn_stage(buf0, 0, qf, slope, qrel, causal, r, hl, o, m, lsum);
    AU_STORE(B, buf1)
    AU_LOAD(B, Dn, 1)
    __syncthreads();
    attn_stage(buf1, 1, qf, slope, qrel, causal, r, hl, o, m, lsum);
    const float lt = lsum + __shfl_xor(lsum, 32);
    const float inv = 1.f / lt;
    const int h = bh & 3;
    if (D.kind == 2) {
#pragma unroll
      for (int dt = 0; dt < 2; ++dt)
#pragma unroll
        for (int q4 = 0; q4 < 4; ++q4) {
          const int d = dt * 32 + 8 * q4 + 4 * hl;
          *(uint2*)(p.mixed_b + (size_t)t * DM + 768 + h * 64 + d) =
              make_uint2(pack2(o[dt][4 * q4] * inv, o[dt][4 * q4 + 1] * inv), pack2(o[dt][4 * q4 + 2] * inv, o[dt][4 * q4 + 3] * inv));
        }
    } else if (valid) {
      const size_t pi = ((size_t)t * 4 + h) * 4 + slot;
#pragma unroll
      for (int dt = 0; dt < 2; ++dt)
#pragma unroll
        for (int q4 = 0; q4 < 4; ++q4) {
          const int d = dt * 32 + 8 * q4 + 4 * hl;
          *(uint2*)(p.pO + pi * 64 + d) =
              make_uint2(pack2(o[dt][4 * q4] * inv, o[dt][4 * q4 + 1] * inv), pack2(o[dt][4 * q4 + 2] * inv, o[dt][4 * q4 + 3] * inv));
        }
      if (hl == 0) { p.pm[pi] = m; p.pl[pi] = lt; }
    }
    D = Dn;
  }
}

__device__ __forceinline__ void ph_attn_combine(const int VB, const Params& p) {
  const int i = VB * 256 + threadIdx.x;
  const int dq = i & 7, th = i >> 3;
  const int t = th >> 2;
  const int own = (t & (SL - 1)) >> 8;
  const int nsel = own < 3 ? own : 3;
  float mv[4], wv[4];
  float M = p.pm[(size_t)th * 4 + 3];
  mv[3] = M;
#pragma unroll
  for (int sl = 0; sl < 3; ++sl) {
    mv[sl] = (sl < nsel) ? p.pm[(size_t)th * 4 + sl] : -1e30f;
    M = fmaxf(M, mv[sl]);
  }
  float W = 0.f;
#pragma unroll
  for (int sl = 0; sl < 4; ++sl) {
    const bool on = (sl == 3) || (sl < nsel);
    wv[sl] = on ? p.pl[(size_t)th * 4 + sl] * __expf(mv[sl] - M) : 0.f;
    W += wv[sl];
  }
  float acc[8];
#pragma unroll
  for (int k = 0; k < 8; ++k) acc[k] = 0.f;
#pragma unroll
  for (int sl = 0; sl < 4; ++sl) {
    const bool on = (sl == 3) || (sl < nsel);
    if (on) {
      float f[8];
      unpack8(*(const uint4*)(p.pO + ((size_t)th * 4 + sl) * 64 + dq * 8), f);
#pragma unroll
      for (int k = 0; k < 8; ++k) acc[k] = fmaf(wv[sl], f[k], acc[k]);
    }
  }
  const float inv = 1.f / W;
  const int h = th & 3;
  *(uint4*)(p.mixed_b + (size_t)t * DM + 512 + h * 64 + dq * 8) =
      make_uint4(pack2(acc[0] * inv, acc[1] * inv), pack2(acc[2] * inv, acc[3] * inv), pack2(acc[4] * inv, acc[5] * inv), pack2(acc[6] * inv, acc[7] * inv));
}


__device__ __forceinline__ int mkkey(const float f, const int idx, const int mask) {
  int b = __float_as_int(f);
  b = (b & ~mask) | idx;
  return b ^ ((b >> 31) & 0x7fffffff);
}
__device__ __forceinline__ int key2bits(const int k) { return k ^ ((k >> 31) & 0x7fffffff); }
#define CEI(a, b) { const int _mx = max(a, b), _mn = min(a, b); a = _mx; b = _mn; }
template <int N>
__device__ __forceinline__ void bitonic_sort_desc(int (&v)[N]) {
#pragma unroll
  for (int k = 2; k <= N; k <<= 1) {
#pragma unroll
    for (int j = k >> 1; j > 0; j >>= 1) {
#pragma unroll
      for (int i = 0; i < N; ++i) {
        const int l = i ^ j;
        if (l > i) {
          if ((i & k) == 0) { CEI(v[i], v[l]); } else { CEI(v[l], v[i]); }
        }
      }
    }
  }
}
__device__ __forceinline__ void merge16(int (&a)[16], const int (&b)[16]) {
#pragma unroll
  for (int i = 0; i < 16; ++i) a[i] = max(a[i], b[15 - i]);
#pragma unroll
  for (int j = 8; j > 0; j >>= 1) {
#pragma unroll
    for (int i = 0; i < 16; ++i) {
      const int l = i ^ j;
      if (l > i) { CEI(a[i], a[l]); }
    }
  }
}
__device__ __forceinline__ void merge_partner(int (&a)[16], const int xmask) {
  int o[16];
#pragma unroll
  for (int i = 0; i < 16; ++i) o[i] = __shfl_xor(a[i], xmask);
  merge16(a, o);
}
__device__ __forceinline__ bf16x8 pack_hi8(const float (&x)[8], float (&res)[8]) {
  unsigned u[4];
#pragma unroll
  for (int i = 0; i < 4; ++i) {
    const ushort_t h0 = f2bf(x[2 * i]), h1 = f2bf(x[2 * i + 1]);
    res[2 * i] = x[2 * i] - bf2f(h0);
    res[2 * i + 1] = x[2 * i + 1] - bf2f(h1);
    u[i] = (unsigned)h0 | ((unsigned)h1 << 16);
  }
  uint4 uu = make_uint4(u[0], u[1], u[2], u[3]);
  return *(bf16x8*)&uu;
}
__device__ __forceinline__ bf16x8 pack_8(const float (&x)[8]) {
  uint4 uu = make_uint4(pack2(x[0], x[1]), pack2(x[2], x[3]), pack2(x[4], x[5]), pack2(x[6], x[7]));
  return *(bf16x8*)&uu;
}

__device__ __forceinline__ void ph_gemm_route(const int vb, char* smem, const Params& p, const ushort_t* __restrict__ hn_b) {
  const int head = vb & 7, tt = vb >> 3;
  const int m0 = head * 128, n0 = tt * 128;
  f32x16 acc[2][2];
  gemm_core(p.w_qT, hn_b, DM, m0, n0, smem, acc);
  int tid = threadIdx.x;
  asm volatile("" : "+v"(tid));
  const int lane = tid & 63, r = lane & 31, hl = lane >> 5;
  const int wave = tid >> 6, wm = wave >> 1, wn = wave & 1;
  int* s_top = (int*)(smem + 34816);
  float rstd_tok[2];
#pragma unroll
  for (int ni = 0; ni < 2; ++ni) {
    const float4* hp = (const float4*)(p.hss + (size_t)(n0 + wn * 64 + ni * 32 + r) * 16);
    const float4 a = hp[0], b = hp[1], c = hp[2], d = hp[3];
    const float tot = ((a.x + a.y) + (a.z + a.w)) + ((b.x + b.y) + (b.z + b.w)) + ((c.x + c.y) + (c.z + c.w)) + ((d.x + d.y) + (d.z + d.w));
    rstd_tok[ni] = rsqrtf(tot * (1.f / DM) + EPS);
  }
  {
    const int row = tid >> 1, part = tid & 1;
#pragma unroll
    for (int hf = 0; hf < 2; ++hf) {
      const ushort_t* src = p.skh + (size_t)(hf * 128 + row) * 64 + part * 32;
      char* dst = smem + (hf * 128 + row) * 136 + part * 64;
#pragma unroll
      for (int c = 0; c < 4; ++c) {
        const uint4 v = *(const uint4*)(src + c * 8);
        *(uint2*)(dst + c * 16) = make_uint2(v.x, v.y);
        *(uint2*)(dst + c * 16 + 8) = make_uint2(v.z, v.w);
      }
    }
  }
  __syncthreads();
  const char* s_keys = smem + wm * 128 * 136;
#pragma unroll
  for (int ni = 0; ni < 2; ++ni) {
    asm volatile("" ::: "memory");
    bf16x8 qh[4], ql[4];
#pragma unroll
    for (int mi = 0; mi < 2; ++mi) {
#pragma unroll
      for (int k2 = 0; k2 < 2; ++k2) {
        float x[8], res[8];
#pragma unroll
        for (int j = 0; j < 8; ++j) x[j] = acc[mi][ni][8 * k2 + j] * rstd_tok[ni];
        qh[mi * 2 + k2] = pack_hi8(x, res);
        ql[mi * 2 + k2] = pack_8(res);
      }
    }
    int g0[16];
#pragma unroll
    for (int kh2 = 0; kh2 < 2; ++kh2) {
      int ga[16], gb[16];
#pragma unroll
      for (int kq = 0; kq < 2; ++kq) {
        const int kt = kh2 * 2 + kq;
        asm volatile("" ::: "memory");
        f32x16 sc;
#pragma unroll
        for (int e = 0; e < 16; ++e) sc[e] = 0.f;
#pragma unroll
        for (int st = 0; st < 4; ++st) {
          const int d0 = (st >> 1) * 32 + 16 * (st & 1) + 4 * hl;
          const char* kp = s_keys + (kt * 32 + r) * 136 + d0 * 2;
          const uint2 h0 = *(const uint2*)(kp), h1 = *(const uint2*)(kp + 16);
          uint4 hq = make_uint4(h0.x, h0.y, h1.x, h1.y);
          const bf16x8 ah = *(bf16x8*)&hq;
          sc = __builtin_amdgcn_mfma_f32_32x32x16_bf16(ah, qh[st], sc, 0, 0, 0);
          sc = __builtin_amdgcn_mfma_f32_32x32x16_bf16(ah, ql[st], sc, 0, 0, 0);
        }
        if (kq == 0) {
#pragma unroll
          for (int e = 0; e < 16; ++e) ga[e] = mkkey(sc[e], kt * 32 + (e & 3) + 8 * (e >> 2) + 4 * hl, 127);
          bitonic_sort_desc<16>(ga);
        } else {
#pragma unroll
          for (int e = 0; e < 16; ++e) gb[e] = mkkey(sc[e], kt * 32 + (e & 3) + 8 * (e >> 2) + 4 * hl, 127);
          bitonic_sort_desc<16>(gb);
        }
      }
      merge16(ga, gb);
      if (kh2 == 0) {
#pragma unroll
        for (int i = 0; i < 16; ++i) g0[i] = ga[i];
      } else {
        merge16(g0, ga);
      }
    }
    merge_partner(g0, 32);
    {
      int* dst = s_top + ((size_t)wm * 128 + wn * 64 + ni * 32 + r) * 16 + hl * 8;
      int4 w0, w1;
      int lo8[8], hi8[8];
#pragma unroll
      for (int i = 0; i < 8; ++i) { lo8[i] = g0[i]; hi8[i] = g0[8 + i]; asm volatile("" : "+v"(lo8[i]), "+v"(hi8[i])); }
      w0 = make_int4(hl ? hi8[0] : lo8[0], hl ? hi8[1] : lo8[1], hl ? hi8[2] : lo8[2], hl ? hi8[3] : lo8[3]);
      w1 = make_int4(hl ? hi8[4] : lo8[4], hl ? hi8[5] : lo8[5], hl ? hi8[6] : lo8[6], hl ? hi8[7] : lo8[7]);
      *(int4*)dst = w0; *(int4*)(dst + 4) = w1;
    }
  }
  __syncthreads();
  {
    const int tok = tid >> 1, sub = tid & 1;
    int k1[16], k2[16];
    {
      const int4* a = (const int4*)(s_top + (size_t)tok * 16);
      const int4* b = (const int4*)(s_top + (size_t)(128 + tok) * 16);
#pragma unroll
      for (int i = 0; i < 4; ++i) {
        const int4 x = a[i], y = b[i];
        k1[4 * i] = x.x; k1[4 * i + 1] = x.y; k1[4 * i + 2] = x.z; k1[4 * i + 3] = x.w;
        k2[4 * i] = y.x; k2[4 * i + 1] = y.y; k2[4 * i + 2] = y.z; k2[4 * i + 3] = y.w;
      }
    }
    float v1f[16], v2f[16];
#pragma unroll
    for (int i = 0; i < 16; ++i) { v1f[i] = __int_as_float(key2bits(k1[i])); v2f[i] = __int_as_float(key2bits(k2[i])); }
    int c[32];
    c[0] = sub ? mkkey(v1f[3] + v2f[3], 51, 255) : mkkey(v1f[0] + v2f[0], 0, 255);
    c[1] = sub ? mkkey(v1f[4] + v2f[0], 64, 255) : mkkey(v1f[0] + v2f[1], 1, 255);
    c[2] = sub ? mkkey(v1f[4] + v2f[1], 65, 255) : mkkey(v1f[0] + v2f[2], 2, 255);
    c[3] = sub ? mkkey(v1f[4] + v2f[2], 66, 255) : mkkey(v1f[0] + v2f[3], 3, 255);
    c[4] = sub ? mkkey(v1f[5] + v2f[0], 80, 255) : mkkey(v1f[0] + v2f[4], 4, 255);
    c[5] = sub ? mkkey(v1f[5] + v2f[1], 81, 255) : mkkey(v1f[0] + v2f[5], 5, 255);
    c[6] = sub ? mkkey(v1f[6] + v2f[0], 96, 255) : mkkey(v1f[0] + v2f[6], 6, 255);
    c[7] = sub ? mkkey(v1f[6] + v2f[1], 97, 255) : mkkey(v1f[0] + v2f[7], 7, 255);
    c[8] = sub ? mkkey(v1f[7] + v2f[0], 112, 255) : mkkey(v1f[0] + v2f[8], 8, 255);
    c[9] = sub ? mkkey(v1f[7] + v2f[1], 113, 255) : mkkey(v1f[0] + v2f[9], 9, 255);
    c[10] = sub ? mkkey(v1f[8] + v2f[0], 128, 255) : mkkey(v1f[0] + v2f[10], 10, 255);
    c[11] = sub ? mkkey(v1f[9] + v2f[0], 144, 255) : mkkey(v1f[0] + v2f[11], 11, 255);
    c[12] = sub ? mkkey(v1f[10] + v2f[0], 160, 255) : mkkey(v1f[0] + v2f[12], 12, 255);
    c[13] = sub ? mkkey(v1f[11] + v2f[0], 176, 255) : mkkey(v1f[0] + v2f[13], 13, 255);
    c[14] = sub ? mkkey(v1f[12] + v2f[0], 192, 255) : mkkey(v1f[0] + v2f[14], 14, 255);
    c[15] = sub ? mkkey(v1f[13] + v2f[0], 208, 255) : mkkey(v1f[0] + v2f[15], 15, 255);
    c[16] = sub ? mkkey(v1f[14] + v2f[0], 224, 255) : mkkey(v1f[1] + v2f[0], 16, 255);
    c[17] = sub ? mkkey(v1f[15] + v2f[0], 240, 255) : mkkey(v1f[1] + v2f[1], 17, 255);
    c[18] = sub ? (int)0x80000000 : mkkey(v1f[1] + v2f[2], 18, 255);
    c[19] = sub ? (int)0x80000000 : mkkey(v1f[1] + v2f[3], 19, 255);
    c[20] = sub ? (int)0x80000000 : mkkey(v1f[1] + v2f[4], 20, 255);
    c[21] = sub ? (int)0x80000000 : mkkey(v1f[1] + v2f[5], 21, 255);
    c[22] = sub ? (int)0x80000000 : mkkey(v1f[1] + v2f[6], 22, 255);
    c[23] = sub ? (int)0x80000000 : mkkey(v1f[1] + v2f[7], 23, 255);
    c[24] = sub ? (int)0x80000000 : mkkey(v1f[2] + v2f[0], 32, 255);
    c[25] = sub ? (int)0x80000000 : mkkey(v1f[2] + v2f[1], 33, 255);
    c[26] = sub ? (int)0x80000000 : mkkey(v1f[2] + v2f[2], 34, 255);
    c[27] = sub ? (int)0x80000000 : mkkey(v1f[2] + v2f[3], 35, 255);
    c[28] = sub ? (int)0x80000000 : mkkey(v1f[2] + v2f[4], 36, 255);
    c[29] = sub ? (int)0x80000000 : mkkey(v1f[3] + v2f[0], 48, 255);
    c[30] = sub ? (int)0x80000000 : mkkey(v1f[3] + v2f[1], 49, 255);
    c[31] = sub ? (int)0x80000000 : mkkey(v1f[3] + v2f[2], 50, 255);
    int h0[16], h1[16];
#pragma unroll
    for (int i = 0; i < 16; ++i) { h0[i] = c[i]; h1[i] = c[16 + i]; }
    bitonic_sort_desc<16>(h0); bitonic_sort_desc<16>(h1);
    merge16(h0, h1);
    merge_partner(h0, 1);
    float sv[16];
#pragma unroll
    for (int i = 0; i < 16; ++i) sv[i] = __int_as_float(key2bits(h0[i]));
    float den = 0.f;
#pragma unroll
    for (int i = 0; i < 16; ++i) den += __expf(sv[i] - sv[0]);
    const float inv = 1.f / den;
    int eo[8]; float go[8];
#pragma unroll
    for (int i = 0; i < 8; ++i) {
      int klo = h0[i], khi = h0[8 + i];
      asm volatile("" : "+v"(klo), "+v"(khi));
      const int kk = sub ? khi : klo;
      const int bits = key2bits(kk);
      const int code = bits & 255;
      const int ia = key2bits(s_top[(size_t)tok * 16 + (code >> 4)]) & 127;
      const int ib = key2bits(s_top[(size_t)(128 + tok) * 16 + (code & 15)]) & 127;
      eo[i] = ia * 128 + ib;
      go[i] = __expf(__int_as_float(bits) - sv[0]) * inv;
    }
    const size_t ob = ((size_t)(n0 + tok) * 8 + head) * 16 + sub * 8;
    *(int4*)(p.eidx + ob) = make_int4(eo[0], eo[1], eo[2], eo[3]);
    *(int4*)(p.eidx + ob + 4) = make_int4(eo[4], eo[5], eo[6], eo[7]);
    *(float4*)(p.egate + ob) = make_float4(go[0], go[1], go[2], go[3]);
    *(float4*)(p.egate + ob + 4) = make_float4(go[4], go[5], go[6], go[7]);
  }
}

__device__ __forceinline__ void ph_subkeys(const Params& p) {
  for (int i = blockIdx.x * 256 + threadIdx.x; i < 2 * 128 * 64; i += gridDim.x * 256) {
    const float v = (i < 8192) ? p.sk1[i] : p.sk2[i - 8192];
    const ushort_t hi = f2bf(v);
    p.skh[i] = hi;
    p.skl[i] = f2bf(v - bf2f(hi));
  }
}

__device__ __forceinline__ float dot16_fp8(const uint4 d, const float (&x)[16], float c) {
  const unsigned w[4] = {d.x, d.y, d.z, d.w};
#pragma unroll
  for (int i = 0; i < 4; ++i) {
    const f32x2_t lo = __builtin_amdgcn_cvt_pk_f32_fp8((int)w[i], false);
    const f32x2_t hi = __builtin_amdgcn_cvt_pk_f32_fp8((int)w[i], true);
    c = fmaf(lo.x, x[4 * i], c); c = fmaf(lo.y, x[4 * i + 1], c); c = fmaf(hi.x, x[4 * i + 2], c); c = fmaf(hi.y, x[4 * i + 3], c);
  }
  return c;
}
__device__ __forceinline__ void axpy16_fp8(const float cf, const uint4 u, float (&acc)[16]) {
  const unsigned w[4] = {u.x, u.y, u.z, u.w};
#pragma unroll
  for (int i = 0; i < 4; ++i) {
    const f32x2_t lo = __builtin_amdgcn_cvt_pk_f32_fp8((int)w[i], false);
    const f32x2_t hi = __builtin_amdgcn_cvt_pk_f32_fp8((int)w[i], true);
    acc[4 * i] = fmaf(cf, lo.x, acc[4 * i]); acc[4 * i + 1] = fmaf(cf, lo.y, acc[4 * i + 1]);
    acc[4 * i + 2] = fmaf(cf, hi.x, acc[4 * i + 2]); acc[4 * i + 3] = fmaf(cf, hi.y, acc[4 * i + 3]);
  }
}
constexpr int EX_NTOK = 4;
__device__ __forceinline__ void peer_chunk(const Params& p, const int lane, const int myex, const bool b5, const bool b4, const bool b3,
                                           const int (&ce)[8], const float (&cg)[8], const f32x2_t (&x2)[8], f32x2_t (&acc2)[8]) {
  drow_t d[8];
  urow_t u[8];
  float sd[8], su[8];
#pragma unroll
  for (int i = 0; i < 8; ++i) d[i] = *(const drow_t*)(p.ed8 + ((size_t)ce[i] * 64 + lane) * DROW_BYTES);
#pragma unroll
  for (int i = 0; i < 8; ++i) u[i] = *(const urow_t*)(p.eu8 + ((size_t)ce[i] * 64 + lane) * UROW_BYTES);
#pragma unroll
  for (int i = 0; i < 8; ++i) { sd[i] = p.ed_s[ce[i]]; su[i] = p.eu_s[ce[i]] * cg[i]; }
  float pr[8];
#pragma unroll
  for (int i = 0; i < 8; ++i) {
    f32x2_t dd[8];
    DEC_D(d[i], dd);
    f32x2_t a2 = {0.f, 0.f};
#pragma unroll
    for (int k = 0; k < 8; ++k) a2 = dd[k] * x2[k] + a2;
    pr[i] = (a2.x + a2.y) * sd[i];
  }
  float q4[4];
#pragma unroll
  for (int i = 0; i < 4; ++i) {
    const float snd = b5 ? pr[i] : pr[i + 4];
    const float kp = b5 ? pr[i + 4] : pr[i];
    q4[i] = kp + __shfl_xor(snd, 32);
  }
  float q2[2];
#pragma unroll
  for (int i = 0; i < 2; ++i) {
    const float snd = b4 ? q4[i] : q4[i + 2];
    const float kp = b4 ? q4[i + 2] : q4[i];
    q2[i] = kp + __shfl_xor(snd, 16);
  }
  float q1;
  {
    const float snd = b3 ? q2[0] : q2[1];
    const float kp = b3 ? q2[1] : q2[0];
    q1 = kp + __shfl_xor(snd, 8);
  }
  q1 += __shfl_xor(q1, 4);
  q1 += __shfl_xor(q1, 2);
  q1 += __shfl_xor(q1, 1);
  const float act = gelu_f(q1);
#pragma unroll
  for (int i = 0; i < 8; ++i) {
    const int src = ((i >> 2) & 1) * 32 + ((i >> 1) & 1) * 16 + (i & 1) * 8;
    const float cf = __int_as_float(__builtin_amdgcn_readlane(__float_as_int(act), src)) * su[i];
    const f32x2_t cf2 = {cf, cf};
    f32x2_t uu[8];
    DEC_U(u[i], uu);
#pragma unroll
    for (int k = 0; k < 8; ++k) acc2[k] = cf2 * uu[k] + acc2[k];
  }
}

#ifndef EX_SWEEP
#define EX_SWEEP 0
#endif
#if !EX_SWEEP
typedef __attribute__((ext_vector_type(8))) int v8i_t;
typedef __attribute__((ext_vector_type(4))) float f32x4_t;
__device__ __forceinline__ void sort128(int& v0, int& v1, const int lane) {
#pragma unroll
  for (int k = 2; k <= 128; k <<= 1) {
#pragma unroll
    for (int j = k >> 1; j > 0; j >>= 1) {
      if (j == 1) {
        const bool up = ((lane * 2) & k) == 0;
        const int mn = min(v0, v1), mx = max(v0, v1);
        v0 = up ? mn : mx;
        v1 = up ? mx : mn;
      } else {
        const int o0 = __shfl_xor(v0, j >> 1), o1 = __shfl_xor(v1, j >> 1);
        const bool up = ((lane * 2) & k) == 0;
        const bool lower = ((lane * 2) & j) == 0;
        const bool takemin = (up == lower);
        v0 = takemin ? min(v0, o0) : max(v0, o0);
        v1 = takemin ? min(v1, o1) : max(v1, o1);
      }
    }
  }
}
__device__ __forceinline__ void k_peer_experts(const int VB, char* smem, const Params& p, const ushort_t* __restrict__ hn) {
  const int lane = threadIdx.x & 63;
  const int wave = __builtin_amdgcn_readfirstlane(threadIdx.x >> 6);
  const int t = VB * 4 + wave;
  const int li = lane & 15, g = lane >> 4;
  char* sx = smem + wave * 1024;
  {
    const float* hrow = p.out + (size_t)t * DM + lane * 16;
    const float* wrow = p.ffn_norm_w + lane * 16;
    float4 hv[4], wv[4];
#pragma unroll
    for (int i = 0; i < 4; ++i) { hv[i] = *(const float4*)(hrow + i * 4); wv[i] = *(const float4*)(wrow + i * 4); }
    float ss = 0.f;
#pragma unroll
    for (int i = 0; i < 4; ++i) ss += hv[i].x * hv[i].x + hv[i].y * hv[i].y + hv[i].z * hv[i].z + hv[i].w * hv[i].w;
    ss = wave_sum(ss);
    const float rs = rsqrtf(ss * (1.f / DM) + EPS) * 16.f;
    int wq[4];
#pragma unroll
    for (int i = 0; i < 4; ++i) {
      int w = 0;
      w = __builtin_amdgcn_cvt_pk_fp8_f32(hv[i].x * rs * wv[i].x, hv[i].y * rs * wv[i].y, w, false);
      w = __builtin_amdgcn_cvt_pk_fp8_f32(hv[i].z * rs * wv[i].z, hv[i].w * rs * wv[i].w, w, true);
      wq[i] = w;
    }
    *(int4*)(sx + lane * 16) = make_int4(wq[0], wq[1], wq[2], wq[3]);
  }
  v8i_t xb[8];
#pragma unroll
  for (int st = 0; st < 8; ++st) {
    const int4 lo = *(const int4*)(sx + st * 128 + g * 16);
    const int4 hi = *(const int4*)(sx + st * 128 + 64 + g * 16);
    xb[st] = v8i_t{lo.x, lo.y, lo.z, lo.w, hi.x, hi.y, hi.z, hi.w};
  }
  f32x2_t acc2[8];
#pragma unroll
  for (int i = 0; i < 8; ++i) acc2[i] = f32x2_t{0.f, 0.f};
  int kq0, kq1;
  {
    const int2 ev = *(const int2*)(p.eidx + (size_t)t * 128 + lane * 2);
    kq0 = (ev.x << 7) | (lane * 2);
    kq1 = (ev.y << 7) | (lane * 2 + 1);
    sort128(kq0, kq1, lane);
  }
  const int ev0 = kq0 >> 7, ev1 = kq1 >> 7;
  const float sdv0 = p.ed_s[ev0], sdv1 = p.ed_s[ev1];
  const float suv0 = p.eu_s[ev0] * p.egate[(size_t)t * 128 + (kq0 & 127)], suv1 = p.eu_s[ev1] * p.egate[(size_t)t * 128 + (kq1 & 127)];
#pragma unroll 1
  for (int c = 0; c < 8; ++c) {
    const int lbase = c * 8;
    const int ea = __shfl(ev0, lbase + (li >> 1)), eb = __shfl(ev1, lbase + (li >> 1));
    const int e_lane = (li & 1) ? eb : ea;
    const unsigned char* arow = p.ed8 + (size_t)e_lane * 512 + g * 16;
    uint4 a[8];
#pragma unroll
    for (int st = 0; st < 8; ++st) a[st] = *(const uint4*)(arow + st * 64);
    urow_t u[16];
#pragma unroll
    for (int i = 0; i < 16; ++i) {
      const int ei_s = __builtin_amdgcn_readlane((i & 1) ? ev1 : ev0, lbase + (i >> 1));
      u[i] = *(const urow_t*)(p.eu8 + ((size_t)ei_s * 64 + lane) * UROW_BYTES);
    }
    const int mrow = 4 * g + (li & 3);
    const float sda = __shfl(sdv0, lbase + (mrow >> 1)), sdb = __shfl(sdv1, lbase + (mrow >> 1));
    const float sua = __shfl(suv0, lbase + (mrow >> 1)), sub = __shfl(suv1, lbase + (mrow >> 1));
    const float sd_m = (mrow & 1) ? sdb : sda, su_m = (mrow & 1) ? sub : sua;
    f32x4_t d4 = {0.f, 0.f, 0.f, 0.f};
#pragma unroll
    for (int st = 0; st < 8; ++st) {
      const v8i_t av = v8i_t{(int)a[st].x, (int)a[st].y, (int)a[st].z, (int)a[st].w, 0, 0, 0, 0};
      d4 = __builtin_amdgcn_mfma_scale_f32_16x16x128_f8f6f4(av, xb[st], d4, 4, 0, 0, 0x7f7f7f7f, 0, 0x7f7f7f7f);
    }
    const int rsel = li & 3;
    const float dsel = rsel == 0 ? d4[0] : rsel == 1 ? d4[1] : rsel == 2 ? d4[2] : d4[3];
    const float cvs = gelu_fast(dsel * sd_m * 0.0625f) * su_m;
#pragma unroll
    for (int i = 0; i < 16; ++i) {
      const float cf = __int_as_float(__builtin_amdgcn_readlane(__float_as_int(cvs), 16 * (i >> 2) + (i & 3)));
      const f32x2_t cf2 = {cf, cf};
      f32x2_t uu[8];
      DEC_U(u[i], uu);
#pragma unroll
      for (int k = 0; k < 8; ++k) acc2[k] = cf2 * uu[k] + acc2[k];
    }
  }
  float* orow = p.out + (size_t)t * DM + lane * 16;
#pragma unroll
  for (int i = 0; i < 4; ++i) {
    float4 hv = *(float4*)(orow + i * 4);
    hv.x += acc2[2 * i].x; hv.y += acc2[2 * i].y; hv.z += acc2[2 * i + 1].x; hv.w += acc2[2 * i + 1].y;
    *(float4*)(orow + i * 4) = hv;
  }
}
#define EX_TOK_PER_VB 4
#else
#define EX_TOK_PER_VB (4 * EX_NTOK)
__device__ __forceinline__ void k_peer_experts(const int VB, const Params& p, const ushort_t* __restrict__ hn) {
  const int lane = threadIdx.x & 63;
  const int wave = __builtin_amdgcn_readfirstlane(threadIdx.x >> 6);
  const int t0 = (VB * 4 + wave) * EX_NTOK;
  const int myex = ((lane >> 5) & 1) * 4 + ((lane >> 4) & 1) * 2 + ((lane >> 3) & 1);
  const bool b5 = (lane & 32) != 0, b4 = (lane & 16) != 0, b3 = (lane & 8) != 0;
  f32x2_t x2[EX_NTOK][8], acc2[EX_NTOK][8];
  int e0[EX_NTOK], e1[EX_NTOK];
  float g0[EX_NTOK], g1[EX_NTOK];
#pragma unroll
  for (int k = 0; k < EX_NTOK; ++k) {
    float f0[8], f1[8];
    unpack8(*(const uint4*)(hn + (size_t)(t0 + k) * DM + lane * 16), f0);
    unpack8(*(const uint4*)(hn + (size_t)(t0 + k) * DM + lane * 16 + 8), f1);
#pragma unroll
    for (int i = 0; i < 4; ++i) {
      x2[k][i] = f32x2_t{f0[2 * i], f0[2 * i + 1]};
      x2[k][4 + i] = f32x2_t{f1[2 * i], f1[2 * i + 1]};
    }
#pragma unroll
    for (int i = 0; i < 8; ++i) acc2[k][i] = f32x2_t{0.f, 0.f};
    e0[k] = p.eidx[(size_t)(t0 + k) * 128 + lane];
    e1[k] = p.eidx[(size_t)(t0 + k) * 128 + 64 + lane];
    g0[k] = p.egate[(size_t)(t0 + k) * 128 + lane];
    g1[k] = p.egate[(size_t)(t0 + k) * 128 + 64 + lane];
  }
#pragma unroll 1
  for (int s = 0; s < 16; ++s) {
#pragma unroll
    for (int k = 0; k < EX_NTOK; ++k) {
      unsigned long long m0 = __ballot((e0[k] >> 10) == s);
      unsigned long long m1 = __ballot((e1[k] >> 10) == s);
      while ((m0 | m1) != 0ull) {
        int ce[8];
        float cg[8];
#pragma unroll
        for (int i = 0; i < 8; ++i) {
          int ev = 0;
          float gv = 0.f;
          if (m0 != 0ull) {
            const int ln = __builtin_ctzll(m0);
            m0 &= m0 - 1ull;
            ev = __builtin_amdgcn_readlane(e0[k], ln);
            gv = __int_as_float(__builtin_amdgcn_readlane(__float_as_int(g0[k]), ln));
          } else if (m1 != 0ull) {
            const int ln = __builtin_ctzll(m1);
            m1 &= m1 - 1ull;
            ev = __builtin_amdgcn_readlane(e1[k], ln);
            gv = __int_as_float(__builtin_amdgcn_readlane(__float_as_int(g1[k]), ln));
          }
          ce[i] = ev;
          cg[i] = gv;
        }
        peer_chunk(p, lane, myex, b5, b4, b3, ce, cg, x2[k], acc2[k]);
      }
    }
  }
#pragma unroll
  for (int k = 0; k < EX_NTOK; ++k) {
    float* orow = p.out + (size_t)(t0 + k) * DM + lane * 16;
#pragma unroll
    for (int i = 0; i < 4; ++i) {
      float4 hv = *(float4*)(orow + i * 4);
      hv.x += acc2[k][2 * i].x; hv.y += acc2[k][2 * i].y; hv.z += acc2[k][2 * i + 1].x; hv.w += acc2[k][2 * i + 1].y;
      *(float4*)(orow + i * 4) = hv;
    }
  }
}

#endif

#define PHASE(NBLK, CALL) \
  for (int VB = blockIdx.x; VB < (NBLK); VB += gridDim.x) { CALL; __syncthreads(); }
#define PHASE_NS(NBLK, CALL) \
  for (int VB = blockIdx.x; VB < (NBLK); VB += gridDim.x) { CALL; }
#define PHASE_OFF(OFF, NBLK, CALL) \
  for (int VB = (int)((blockIdx.x + gridDim.x - ((OFF) % gridDim.x)) % gridDim.x); VB < (NBLK); VB += gridDim.x) { CALL; __syncthreads(); }

__global__ __launch_bounds__(256, 2) void fwd_megakernel(Params p) {
  __shared__ __attribute__((aligned(16))) char smem_raw[SMEM_BYTES];
  float* smem = (float*)smem_raw;
  volatile LAS unsigned* xb_st = (volatile LAS unsigned*)(smem_raw + 73728);
  if (threadIdx.x == 0) { xb_st[0] = 0u; xb_st[1] = 0u; xb_st[2] = 0u; xb_st[3] = 0u; }
  __syncthreads();
  const XcdBarrier xb = xcd_barrier_post(p.bar, xb_st);
  {
    for (int k = threadIdx.x; k < DM; k += 256) {
      const float* wr = p.w_in + (size_t)k * INC + 1536;
      const float4 a = *(const float4*)(wr), b = *(const float4*)(wr + 4);
      smem[0 * 1024 + k] = a.x; smem[1 * 1024 + k] = a.y; smem[2 * 1024 + k] = a.z; smem[3 * 1024 + k] = a.w;
      smem[4 * 1024 + k] = b.x; smem[5 * 1024 + k] = b.y; smem[6 * 1024 + k] = b.z; smem[7 * 1024 + k] = b.w;
    }
    __syncthreads();
    PHASE_NS(NT / 8, ph_rmsnorm_bf16(VB, p.x, p.mix_norm_w, p.xn_b, smem, p.dt_bias, p.dt));
    __syncthreads();
  }
  PHASE_NS(NB * MEM / 8, ph_rmsnorm_bf16(VB, p.mem, p.mem_norm_w, p.memn_b, nullptr, nullptr, nullptr));
  PHASE(16 * 40, ph_wtrans(VB, smem, p.w_in, INC, p.w_inT, 40, 8, nullptr));
  PHASE(16 * 16, ph_wtrans(VB, smem, p.w_out, DM, p.w_outT, 16, 0, nullptr));
  PHASE(16 * 16, ph_wtrans(VB, smem, p.w_query, DM, p.w_qT, 16, 0, p.ffn_norm_w));
  PHASE(16 * 8, ph_wtrans(VB, smem, p.w_mem_kv, 512, p.w_memT, 8, 0, nullptr));
  if (blockIdx.x == 0) p.bcnt[threadIdx.x] = 0;
  ph_subkeys(p);
  xcd_barrier(xb);
  PHASE(20 * (NT / 128), ph_gemm_proj(VB, smem_raw, p));
  xcd_barrier(xb);
  PHASE(NB * 64 * 8, ph_ssd1(VB, smem_raw, p));
  PHASE(NB * 4 * 32, k_gate(VB, smem_raw, p));
  PHASE_OFF(256, 4 * (NB * MEM / 128), ph_gemm_mem(VB, smem_raw, p));
  xcd_barrier(xb);
  PHASE_NS(NB * 8 * 64 * 128 / 256, ph_ssd2(VB, p));
  {
    int* s_pref = (int*)(smem_raw + 72192);
    {
      const int tid = threadIdx.x;
      int v = (p.bcnt[tid] + 127) >> 7;
      const int lane = tid & 63;
#pragma unroll
      for (int o = 1; o < 64; o <<= 1) { int nb = __shfl_up(v, o); if (lane >= o) v += nb; }
      int* s_wt = s_pref + 256;
      if (lane == 63) s_wt[tid >> 6] = v;
      __syncthreads();
      int add = 0;
      for (int ww = 0; ww < (tid >> 6); ++ww) add += s_wt[ww];
      s_pref[tid] = v + add;
      __syncthreads();
    }
    const int Ug = s_pref[255];
    ph_attn_units(smem_raw, p, Ug, s_pref);
    __syncthreads();
  }
  xcd_barrier(xb);
  PHASE(NB * 64 * 2, ph_ssd3(VB, smem_raw, p));
  if (gridDim.x >= 512) {
    for (int VB = (int)blockIdx.x - 256; VB >= 0 && VB < NT * 4 * 8 / 256; VB += gridDim.x - 256) ph_attn_combine(VB, p);
  } else {
    PHASE_NS(NT * 4 * 8 / 256, ph_attn_combine(VB, p));
  }
  xcd_barrier(xb);
  PHASE(8 * (NT / 128), ph_gemm_f32(VB, smem_raw, p.mixed_b, p.w_outT, p.out, p.x, p.xn_b, p.hss));
  xcd_barrier(xb);
  ushort_t* hn_b = p.xn_b;
  {
    int cv = blockIdx.x;
    for (int VB = blockIdx.x; VB < 8 * (NT / 128); VB += gridDim.x) {
      ph_gemm_route(VB, smem_raw, p, hn_b);
      __syncthreads();
      for (int i = 0; i < 8 && cv < 8192; ++i, cv += gridDim.x) {
        if (cv < 4096) {
#if EX_FP4_DOWN
          ph_cvt4(cv, p.e_down, p.ed8, p.ed_s);
#else
          ph_cvt8(cv, p.e_down, p.ed8, p.ed_s);
#endif
        } else {
#if EX_FP4_UP
          ph_cvt4(cv - 4096, p.e_up, p.eu8, p.eu_s);
#else
          ph_cvt8(cv - 4096, p.e_up, p.eu8, p.eu_s);
#endif
        }
      }
    }
    for (; cv < 8192; cv += gridDim.x) {
      if (cv < 4096) {
#if EX_FP4_DOWN
        ph_cvt4(cv, p.e_down, p.ed8, p.ed_s);
#else
        ph_cvt8(cv, p.e_down, p.ed8, p.ed_s);
#endif
      } else {
#if EX_FP4_UP
        ph_cvt4(cv - 4096, p.e_up, p.eu8, p.eu_s);
#else
        ph_cvt8(cv - 4096, p.e_up, p.eu8, p.eu_s);
#endif
      }
    }
  }
  xcd_barrier(xb);
  PHASE_NS(NT / EX_TOK_PER_VB, k_peer_experts(VB, smem_raw, p, hn_b));
}
}

extern "C" void kernel_launch(void* const* d_in, const int* in_sizes, int n_in, void* d_out, int out_size, void* d_ws, size_t ws_size,
                              hipStream_t stream) {
  Params p{};
  p.x = (const float*)d_in[0]; p.mem = (const float*)d_in[1]; p.mix_norm_w = (const float*)d_in[2]; p.w_in = (const float*)d_in[3];
  p.conv_w = (const float*)d_in[4]; p.conv_b = (const float*)d_in[5]; p.dt_bias = (const float*)d_in[6]; p.a_log = (const float*)d_in[7];
  p.ssd_d = (const float*)d_in[8]; p.ssd_norm_w = (const float*)d_in[9]; p.mq_norm_w = (const float*)d_in[10]; p.mk_norm_w = (const float*)d_in[11];
  p.mem_norm_w = (const float*)d_in[12]; p.w_mem_kv = (const float*)d_in[13]; p.xq_norm_w = (const float*)d_in[14]; p.xk_norm_w = (const float*)d_in[15];
  p.w_out = (const float*)d_in[16]; p.ffn_norm_w = (const float*)d_in[17]; p.w_query = (const float*)d_in[18]; p.sk1 = (const float*)d_in[19];
  p.sk2 = (const float*)d_in[20]; p.e_down = (const float*)d_in[21]; p.e_up = (const float*)d_in[22];
  p.out = (float*)d_out;
  char* ws = (char*)d_ws;
  size_t o = 0;
  auto take = [&](size_t bytes) { char* q = ws + o; o += (bytes + 255) & ~(size_t)255; return q; };
  p.xn_b = (ushort_t*)take((size_t)NT * DM * 2);
  p.xc = p.xn_b;
  p.w_inT = (ushort_t*)take((size_t)NPROJ * DM * 2);
  p.w_outT = (ushort_t*)take((size_t)DM * DM * 2);
  p.w_qT = (ushort_t*)take((size_t)DM * DM * 2);
  p.w_memT = (ushort_t*)take((size_t)512 * DM * 2);
  p.memn_b = (ushort_t*)take((size_t)NB * MEM * DM * 2);
  p.memk_b = (ushort_t*)take((size_t)NB * MEM * 256 * 2);
  p.memvT = (ushort_t*)take((size_t)NB * MEM * 256 * 2);
  char* regQ = take((size_t)NT * 2560 * 2);
  p.zs = (ushort_t*)regQ;
  p.xbc_raw = (ushort_t*)(regQ + (size_t)NT * 512 * 2);
  p.mq = (ushort_t*)(regQ + (size_t)NT * 1536 * 2);
  p.mk = (ushort_t*)(regQ + (size_t)NT * 1792 * 2);
  p.vT = (ushort_t*)(regQ + (size_t)NT * 2048 * 2);
  p.xq = (ushort_t*)(regQ + (size_t)NT * 2304 * 2);
  p.q = (float*)regQ;
  p.dt = (float*)take((size_t)NT * 8 * 4);
  p.acs = (float*)take((size_t)NT * 8 * 4);
  p.cdec = (float*)take((size_t)NB * 64 * 8 * 4);
  p.states = (float*)d_out;
  p.sin_b = (ushort_t*)((char*)d_out + (size_t)NB * 64 * 8 * 8192 * 4);
  p.xT = (ushort_t*)((char*)d_out + (size_t)NB * 64 * 8 * 8192 * 6);
  p.mixed_b = (ushort_t*)take((size_t)NT * DM * 2);
  p.kpart = (float*)take((size_t)NB * 4 * 32 * 4 * 64 * 4);
  p.bcnt = (int*)take(256 * 4);
  p.blist = (int*)take((size_t)256 * 8192 * 4);
  p.pm = (float*)take((size_t)NT * 16 * 4);
  p.pl = (float*)take((size_t)NT * 16 * 4);
  p.pO = p.xbc_raw;
  p.eidx = (int*)take((size_t)NT * 128 * 4);
  p.egate = (float*)take((size_t)NT * 128 * 4);
  p.ed8 = (unsigned char*)take((size_t)16384 * DM);
  p.eu8 = (unsigned char*)take((size_t)16384 * DM);
  p.ed_s = (float*)take(16384 * 4);
  p.eu_s = (float*)take(16384 * 4);
  p.bar = (unsigned*)take(XCD_BAR_WORDS * 4);
  p.hss = (float*)take((size_t)NT * 16 * 4);
  p.skh = (ushort_t*)take(2 * 128 * 64 * 2);
  p.skl = (ushort_t*)take(2 * 128 * 64 * 2);
  if (o > ws_size) return;
  (void)hipMemsetAsync(p.bar, 0, XCD_BAR_WORDS * 4, stream);
  static int grid_blocks = 0;
  if (!grid_blocks) {
    int dev = 0, cus = 0, per_cu = 0;
    (void)hipGetDevice(&dev);
    (void)hipDeviceGetAttribute(&cus, hipDeviceAttributeMultiprocessorCount, dev);
    (void)hipOccupancyMaxActiveBlocksPerMultiprocessor(&per_cu, fwd_megakernel, 256, 0);
    if (per_cu > 2) per_cu = 2;
    if (per_cu < 1) per_cu = 1;
    grid_blocks = cus * per_cu;
  }
  void* args[] = {&p};
  hipError_t e = hipLaunchCooperativeKernel((void*)fwd_megakernel, dim3(grid_blocks), dim3(256), args, 0, stream);
  if (e != hipSuccess) fprintf(stderr, "cooperative launch failed: %s (grid %d)\n", hipGetErrorString(e), grid_blocks);
}
```

```cpp
#include <hip/hip_runtime.h>
#include <hip/hip_cooperative_groups.h>
#include <cstdio>
#include <math.h>
#include <stdint.h>
namespace cg = cooperative_groups;

#ifndef EX_FP4_DOWN
#define EX_FP4_DOWN 1
#endif
#ifndef EX_FP4_UP
#define EX_FP4_UP 1
#endif
namespace {
typedef unsigned short ushort_t;
typedef __attribute__((ext_vector_type(8))) short bf16x8;
typedef __attribute__((ext_vector_type(16))) float f32x16;

constexpr int DM = 1024;
constexpr int NB = 2;
constexpr int SL = 8192;
constexpr int NT = NB * SL;
constexpr int MEM = 256;
constexpr int INC = 2568;
constexpr int NPROJ = 2560;
constexpr float EPS = 1e-6f;
constexpr int SMEM_BYTES = 73728 + 256;

__device__ __forceinline__ float silu_f(float x) { return x * __frcp_rn(1.f + __expf(-x)); }
__device__ __forceinline__ float softplus_f(float x) { return fmaxf(x, 0.f) + log1pf(expf(-fabsf(x))); }
__device__ __forceinline__ float gelu_f(float x) { return 0.5f * x * (1.f + erff(x * 0.70710678118654752f)); }
__device__ __forceinline__ float gelu_fast(float x) {
  const float z = fabsf(x) * 0.70710678118654752f;
  const float t = __frcp_rn(fmaf(0.3275911f, z, 1.f));
  float pl = fmaf(1.061405429f, t, -1.453152027f);
  pl = fmaf(pl, t, 1.421413741f);
  pl = fmaf(pl, t, -0.284496736f);
  pl = fmaf(pl, t, 0.254829592f);
  const float er = 1.f - pl * t * __expf(-z * z);
  return 0.5f * x * (1.f + copysignf(er, x));
}
typedef __attribute__((ext_vector_type(2))) __bf16 bf16x2_hw;
typedef __attribute__((ext_vector_type(2))) float f32x2_hw;
__device__ __forceinline__ unsigned pack2(float a, float b) {
  const f32x2_hw v = {a, b};
  return __builtin_bit_cast(unsigned, __builtin_convertvector(v, bf16x2_hw));
}
__device__ __forceinline__ ushort_t f2bf(float x) { return (ushort_t)(pack2(x, 0.f) & 0xffffu); }
__device__ __forceinline__ float bf2f(ushort_t h) { return __uint_as_float(((unsigned)h) << 16); }
__device__ __forceinline__ float bflo(unsigned w) { return __uint_as_float(w << 16); }
__device__ __forceinline__ float bfhi(unsigned w) { return __uint_as_float(w & 0xffff0000u); }

__device__ __forceinline__ void unpack8(const uint4 v, float (&f)[8]) {
  f[0] = bflo(v.x); f[1] = bfhi(v.x); f[2] = bflo(v.y); f[3] = bfhi(v.y);
  f[4] = bflo(v.z); f[5] = bfhi(v.z); f[6] = bflo(v.w); f[7] = bfhi(v.w);
}

__device__ __forceinline__ float wave_sum(float v) {
#pragma unroll
  for (int o = 32; o > 0; o >>= 1) v += __shfl_xor(v, o);
  return v;
}
__device__ __forceinline__ float wave_max(float v) {
#pragma unroll
  for (int o = 32; o > 0; o >>= 1) v = fmaxf(v, __shfl_xor(v, o));
  return v;
}


#define XB_TMO      128
#define XB_XCNT(j)  (256  + 64 * (j))
#define XB_XSUB(j)  (1280 + 64 * (j))
#define XB_XGEN(j)  (2304 + 64 * (j))
#define XB_TOP      3328
#define XB_TOPGEN   3392
#define XCD_BAR_WORDS 3456
#define XB_SPIN_CAP (1u << 20)
#define LAS __attribute__((address_space(3)))
__device__ __forceinline__ unsigned xb_ld(unsigned* p)              { return __hip_atomic_load(p, __ATOMIC_RELAXED, __HIP_MEMORY_SCOPE_AGENT); }
__device__ __forceinline__ unsigned xb_add(unsigned* p, unsigned v) { return __hip_atomic_fetch_add(p, v, __ATOMIC_RELAXED, __HIP_MEMORY_SCOPE_AGENT); }
__device__ __forceinline__ unsigned xb_xcc_id() { return (unsigned)__builtin_amdgcn_s_getreg((3 << 11) | 20) & 0xFu; }
#define XB_SPIN(cond, bar) do { unsigned _sp = 0; while (cond) { __builtin_amdgcn_s_sleep(1); \
    if ((++_sp & 255u) == 0u) { if (xb_ld(&(bar)[XB_TMO])) break; if (_sp > XB_SPIN_CAP) { atomicAdd(&(bar)[XB_TMO], 1u); break; } } } } while (0)
struct XcdBarrier { unsigned* bar; unsigned x; volatile LAS unsigned* st; };
__device__ __forceinline__ XcdBarrier xcd_barrier_post(unsigned* bar, volatile LAS unsigned* st) {
  XcdBarrier b; b.bar = bar; b.x = xb_xcc_id(); b.st = st;
  if (threadIdx.x == 0) (void)xb_add(&bar[XB_XCNT(b.x)], 1u);
  return b;
}
__device__ __forceinline__ void xcd_barrier_complete(unsigned* bar, unsigned x, unsigned& nloc, unsigned& nx) {
  const unsigned G = gridDim.x * gridDim.y * gridDim.z;
  unsigned sum, cnt, mine, sp = 0u;
  for (;;) {
    sum = 0u; cnt = 0u; mine = 0u;
#pragma unroll
    for (unsigned j = 0; j < 16; ++j) { const unsigned c = xb_ld(&bar[XB_XCNT(j)]); sum += c; cnt += (c > 0u) ? 1u : 0u; mine = (j == x) ? c : mine; }
    if (sum == G) break;
    __builtin_amdgcn_s_sleep(1);
    if ((++sp & 255u) == 0u) { if (xb_ld(&bar[XB_TMO])) break; if (sp > XB_SPIN_CAP) { atomicAdd(&bar[XB_TMO], 1u); break; } }
  }
  nloc = mine > 0u ? mine : 1u; nx = cnt > 0u ? cnt : 1u;
}
__device__ __forceinline__ void xcd_barrier(const XcdBarrier& b) {
  asm volatile("s_waitcnt vmcnt(0)" ::: "memory");
  __syncthreads();
  if (threadIdx.x == 0) {
    unsigned* bar = b.bar;
    __builtin_amdgcn_s_waitcnt(0);
    unsigned nloc = b.st[0], nx = b.st[1];
    if (nloc == 0u) { xcd_barrier_complete(bar, b.x, nloc, nx); b.st[0] = nloc; b.st[1] = nx; }
    const unsigned old = xb_add(&bar[XB_XSUB(b.x)], 1u);
    const unsigned gen = old / nloc;
    if (old + 1u == (gen + 1u) * nloc) {
      __builtin_amdgcn_fence(__ATOMIC_RELEASE, "agent");
      asm volatile("s_waitcnt vmcnt(0)" ::: "memory");
      const unsigned og = xb_add(&bar[XB_TOP], 1u);
      const unsigned tg = og / nx;
      if (og + 1u == (tg + 1u) * nx) xb_add(&bar[XB_TOPGEN], 1u);
      else XB_SPIN(xb_ld(&bar[XB_TOPGEN]) == tg, bar);
      __builtin_amdgcn_fence(__ATOMIC_ACQUIRE, "agent");
      xb_add(&bar[XB_XGEN(b.x)], 1u);
      asm volatile("s_waitcnt vmcnt(0)" ::: "memory");
    } else {
      XB_SPIN(xb_ld(&bar[XB_XGEN(b.x)]) == gen, bar);
      __builtin_amdgcn_fence(__ATOMIC_ACQUIRE, "agent");
      asm volatile("s_waitcnt vmcnt(0)" ::: "memory");
    }
  }
  __syncthreads();
}

struct Params {
  const float *x, *mem, *mix_norm_w, *w_in, *conv_w, *conv_b, *dt_bias, *a_log, *ssd_d, *ssd_norm_w, *mq_norm_w, *mk_norm_w,
      *mem_norm_w, *w_mem_kv, *xq_norm_w, *xk_norm_w, *w_out, *ffn_norm_w, *w_query, *sk1, *sk2, *e_down, *e_up;
  float* out;
  ushort_t *xn_b, *w_inT, *w_outT, *w_qT, *w_memT, *memn_b, *zs, *xbc_raw, *mq, *mk, *xq, *memk_b, *mixed_b;
  float *dt, *q, *egate, *acs, *cdec, *states;
  ushort_t *xc, *xT, *sin_b;
  int *eidx, *bcnt, *blist;
  unsigned* bar;
  float* hss;
  ushort_t *skh, *skl;
  unsigned char *ed8, *eu8;
  float *ed_s, *eu_s;
  float *kpart, *pm, *pl;
  ushort_t *vT, *memvT, *pO;
};

__device__ __forceinline__ void ph_rmsnorm_bf16(const int vb, const float* __restrict__ x, const float* __restrict__ w,
                                                ushort_t* __restrict__ outb, const float* s_wdt  , const float* __restrict__ dt_bias,
                                                float* __restrict__ dt) {
  const int lane = threadIdx.x & 63;
  const int row0 = vb * 8 + (threadIdx.x >> 6) * 2;
  float4 v[2][4];
#pragma unroll
  for (int rr = 0; rr < 2; ++rr)
#pragma unroll
    for (int i = 0; i < 4; ++i) v[rr][i] = *(const float4*)(x + (size_t)(row0 + rr) * DM + i * 256 + lane * 4);
  float4 ww[4];
#pragma unroll
  for (int i = 0; i < 4; ++i) ww[i] = *(const float4*)(w + i * 256 + lane * 4);
#pragma unroll
  for (int rr = 0; rr < 2; ++rr) {
    const int row = row0 + rr;
    float ss = 0.f;
#pragma unroll
    for (int i = 0; i < 4; ++i) ss += v[rr][i].x * v[rr][i].x + v[rr][i].y * v[rr][i].y + v[rr][i].z * v[rr][i].z + v[rr][i].w * v[rr][i].w;
    ss = wave_sum(ss);
    const float r = rsqrtf(ss / DM + EPS);
    float part[8];
#pragma unroll
    for (int hh = 0; hh < 8; ++hh) part[hh] = 0.f;
#pragma unroll
    for (int i = 0; i < 4; ++i) {
      const float o0 = v[rr][i].x * r * ww[i].x, o1 = v[rr][i].y * r * ww[i].y, o2 = v[rr][i].z * r * ww[i].z, o3 = v[rr][i].w * r * ww[i].w;
      *(uint2*)(outb + (size_t)row * DM + i * 256 + lane * 4) = make_uint2(pack2(o0, o1), pack2(o2, o3));
      if (dt) {
        const float xs[4] = {o0, o1, o2, o3};
#pragma unroll
        for (int hh = 0; hh < 8; ++hh) {
          const float4 wv = *(const float4*)(s_wdt + hh * 1024 + i * 256 + lane * 4);
          part[hh] = fmaf(xs[0], wv.x, part[hh]); part[hh] = fmaf(xs[1], wv.y, part[hh]);
          part[hh] = fmaf(xs[2], wv.z, part[hh]); part[hh] = fmaf(xs[3], wv.w, part[hh]);
        }
      }
    }
    if (dt) {
      float mine = 0.f;
#pragma unroll
      for (int hh = 0; hh < 8; ++hh) {
        const float sfull = wave_sum(part[hh]);
        if (lane == hh) mine = sfull;
      }
      if (lane < 8) dt[(size_t)row * 8 + lane] = softplus_f(mine + dt_bias[lane]);
    }
  }
}

__device__ __forceinline__ void ph_wtrans(const int vb, float* smem, const float* __restrict__ W, const int ldw, ushort_t* __restrict__ Wt,
                                          const int ntiles, const int skip, const float* __restrict__ rowscale) {
  float (*s)[65] = (float (*)[65])smem;
  const int tid = threadIdx.x;
  const int kt = vb / ntiles, nt = vb % ntiles;
  const int nd0 = nt * 64;
  const int ns0 = (nd0 < 1536) ? nd0 : nd0 + skip;
  {
    const int k = tid >> 2, nc = (tid & 3) * 16;
    const float* src = W + (size_t)(kt * 64 + k) * ldw + ns0 + nc;
    const float rsc = rowscale ? rowscale[kt * 64 + k] : 1.f;
#pragma unroll
    for (int j = 0; j < 4; ++j) {
      float4 v = *(const float4*)(src + j * 4);
      v.x *= rsc; v.y *= rsc; v.z *= rsc; v.w *= rsc;
      s[k][nc + j * 4 + 0] = v.x; s[k][nc + j * 4 + 1] = v.y; s[k][nc + j * 4 + 2] = v.z; s[k][nc + j * 4 + 3] = v.w;
    }
  }
  __syncthreads();
  {
    const int n = tid >> 2, kc = (tid & 3) * 16;
    unsigned pk[8];
#pragma unroll
    for (int j = 0; j < 8; ++j) pk[j] = pack2(s[kc + 2 * j][n], s[kc + 2 * j + 1][n]);
    ushort_t* dst = Wt + (size_t)(nd0 + n) * DM + kt * 64 + kc;
    *(uint4*)(dst) = make_uint4(pk[0], pk[1], pk[2], pk[3]);
    *(uint4*)(dst + 8) = make_uint4(pk[4], pk[5], pk[6], pk[7]);
  }
}

__device__ __forceinline__ void ph_cvt(const int vb, const float* __restrict__ src, ushort_t* __restrict__ dst) {
  const size_t base = (size_t)vb * 8192 + threadIdx.x * 8;
  float4 a[4], b[4];
#pragma unroll
  for (int i = 0; i < 4; ++i) {
    a[i] = *(const float4*)(src + base + i * 2048);
    b[i] = *(const float4*)(src + base + i * 2048 + 4);
  }
#pragma unroll
  for (int i = 0; i < 4; ++i)
    *(uint4*)(dst + base + i * 2048) = make_uint4(pack2(a[i].x, a[i].y), pack2(a[i].z, a[i].w), pack2(b[i].x, b[i].y), pack2(b[i].z, b[i].w));
}


typedef __attribute__((ext_vector_type(2))) float f32x2_t;
__device__ __forceinline__ void ph_cvt8(const int vb, const float* __restrict__ src, unsigned char* __restrict__ dst, float* __restrict__ inv_scale) {
  const int lane = threadIdx.x & 63;
  const int row = vb * 4 + (threadIdx.x >> 6);
  const float* sr = src + (size_t)row * DM + lane * 16;
  float4 v[4];
#pragma unroll
  for (int i = 0; i < 4; ++i) v[i] = *(const float4*)(sr + i * 4);
  float am = 0.f;
#pragma unroll
  for (int i = 0; i < 4; ++i) am = fmaxf(fmaxf(fmaxf(am, fabsf(v[i].x)), fmaxf(fabsf(v[i].y), fabsf(v[i].z))), fabsf(v[i].w));
  am = wave_max(am);
  const float sc = (am > 0.f) ? 224.f / am : 1.f;
  unsigned w[4];
#pragma unroll
  for (int i = 0; i < 4; ++i) {
    int t = 0;
    t = __builtin_amdgcn_cvt_pk_fp8_f32(v[i].x * sc, v[i].y * sc, t, false);
    t = __builtin_amdgcn_cvt_pk_fp8_f32(v[i].z * sc, v[i].w * sc, t, true);
    w[i] = (unsigned)t;
  }
  *(uint4*)(dst + (size_t)row * DM + lane * 16) = make_uint4(w[0], w[1], w[2], w[3]);
  if (lane == 0) inv_scale[row] = (am > 0.f) ? am * (1.f / 224.f) : 1.f;
}

__device__ __forceinline__ void ph_cvt4(const int vb, const float* __restrict__ src, unsigned char* __restrict__ dst, float* __restrict__ inv_scale) {
  const int lane = threadIdx.x & 63;
  const int row = vb * 4 + (threadIdx.x >> 6);
  const float* sr = src + (size_t)row * DM + lane * 16;
  float4 v[4];
#pragma unroll
  for (int i = 0; i < 4; ++i) v[i] = *(const float4*)(sr + i * 4);
  float am = 0.f;
#pragma unroll
  for (int i = 0; i < 4; ++i) am = fmaxf(fmaxf(fmaxf(am, fabsf(v[i].x)), fmaxf(fabsf(v[i].y), fabsf(v[i].z))), fabsf(v[i].w));
  am = wave_max(am);
  const float sc = (am > 0.f) ? 6.f / am : 1.f;
  unsigned w0 = 0u, w1 = 0u;
  w0 = __builtin_amdgcn_cvt_scalef32_pk_fp4_f32(w0, v[0].x * sc, v[0].y * sc, 1.0f, 0);
  w0 = __builtin_amdgcn_cvt_scalef32_pk_fp4_f32(w0, v[0].z * sc, v[0].w * sc, 1.0f, 1);
  w0 = __builtin_amdgcn_cvt_scalef32_pk_fp4_f32(w0, v[1].x * sc, v[1].y * sc, 1.0f, 2);
  w0 = __builtin_amdgcn_cvt_scalef32_pk_fp4_f32(w0, v[1].z * sc, v[1].w * sc, 1.0f, 3);
  w1 = __builtin_amdgcn_cvt_scalef32_pk_fp4_f32(w1, v[2].x * sc, v[2].y * sc, 1.0f, 0);
  w1 = __builtin_amdgcn_cvt_scalef32_pk_fp4_f32(w1, v[2].z * sc, v[2].w * sc, 1.0f, 1);
  w1 = __builtin_amdgcn_cvt_scalef32_pk_fp4_f32(w1, v[3].x * sc, v[3].y * sc, 1.0f, 2);
  w1 = __builtin_amdgcn_cvt_scalef32_pk_fp4_f32(w1, v[3].z * sc, v[3].w * sc, 1.0f, 3);
  *(uint2*)(dst + (size_t)row * (DM / 2) + lane * 8) = make_uint2(w0, w1);
  if (lane == 0) inv_scale[row] = (am > 0.f) ? am * (1.f / 6.f) : 1.f;
}
__device__ __forceinline__ void dec16_fp8(const uint4 d, f32x2_t (&o)[8]) {
  const unsigned w[4] = {d.x, d.y, d.z, d.w};
#pragma unroll
  for (int k = 0; k < 4; ++k) {
    o[2 * k] = __builtin_amdgcn_cvt_pk_f32_fp8((int)w[k], false);
    o[2 * k + 1] = __builtin_amdgcn_cvt_pk_f32_fp8((int)w[k], true);
  }
}
__device__ __forceinline__ void dec16_fp4(const uint2 d, f32x2_t (&o)[8]) {
  o[0] = __builtin_amdgcn_cvt_scalef32_pk_f32_fp4(d.x, 1.0f, 0); o[1] = __builtin_amdgcn_cvt_scalef32_pk_f32_fp4(d.x, 1.0f, 1);
  o[2] = __builtin_amdgcn_cvt_scalef32_pk_f32_fp4(d.x, 1.0f, 2); o[3] = __builtin_amdgcn_cvt_scalef32_pk_f32_fp4(d.x, 1.0f, 3);
  o[4] = __builtin_amdgcn_cvt_scalef32_pk_f32_fp4(d.y, 1.0f, 0); o[5] = __builtin_amdgcn_cvt_scalef32_pk_f32_fp4(d.y, 1.0f, 1);
  o[6] = __builtin_amdgcn_cvt_scalef32_pk_f32_fp4(d.y, 1.0f, 2); o[7] = __builtin_amdgcn_cvt_scalef32_pk_f32_fp4(d.y, 1.0f, 3);
}
#if EX_FP4_DOWN
typedef uint2 drow_t;
#define DROW_BYTES 8
#define DEC_D dec16_fp4
#else
typedef uint4 drow_t;
#define DROW_BYTES 16
#define DEC_D dec16_fp8
#endif
#if EX_FP4_UP
typedef uint2 urow_t;
#define UROW_BYTES 8
#define DEC_U dec16_fp4
#else
typedef uint4 urow_t;
#define UROW_BYTES 16
#define DEC_U dec16_fp8
#endif

__device__ __forceinline__ int swz(int row, int ch) { return row * 128 + ((ch ^ ((row >> 1) & 7)) << 4); }

__device__ __forceinline__ void gemm_compute(const char* cA, const char* cB, const int arow, const int brow, const int xr, const int h,
                                             f32x16 (&acc)[2][2]) {
#pragma unroll
  for (int ks = 0; ks < 4; ++ks) {
    const int co = ((ks * 2 + h) ^ xr) << 4;
    bf16x8 a0 = *(const bf16x8*)(cA + arow + co);
    bf16x8 a1 = *(const bf16x8*)(cA + arow + 32 * 128 + co);
    bf16x8 b0 = *(const bf16x8*)(cB + brow + co);
    bf16x8 b1 = *(const bf16x8*)(cB + brow + 32 * 128 + co);
    acc[0][0] = __builtin_amdgcn_mfma_f32_32x32x16_bf16(a0, b0, acc[0][0], 0, 0, 0);
    acc[0][1] = __builtin_amdgcn_mfma_f32_32x32x16_bf16(a0, b1, acc[0][1], 0, 0, 0);
    acc[1][0] = __builtin_amdgcn_mfma_f32_32x32x16_bf16(a1, b0, acc[1][0], 0, 0, 0);
    acc[1][1] = __builtin_amdgcn_mfma_f32_32x32x16_bf16(a1, b1, acc[1][1], 0, 0, 0);
  }
}

__device__ __forceinline__ void gemm_core(const ushort_t* __restrict__ A, const ushort_t* __restrict__ Bt, const int K, const int m0,
                                          const int n0, char* smem, f32x16 (&acc)[2][2]) {
  int tid = threadIdx.x;
  asm volatile("" : "+v"(tid));
  const int lane = tid & 63;
  const int wave = __builtin_amdgcn_readfirstlane(tid >> 6);
  const int wm = wave >> 1, wn = wave & 1;
  const int r = lane & 31, h = lane >> 5;
  const int srow = wave * 8 + (lane >> 3);
  const int schs = (lane & 7) ^ ((srow >> 1) & 7);
  const ushort_t* Ag = A + (size_t)(m0 + srow) * K + schs * 8;
  const ushort_t* Bg = Bt + (size_t)(n0 + srow) * K + schs * 8;
  const size_t rs = (size_t)32 * K;
  char* wbase = smem + wave * 1024;
#define GLDS_TILE(BUF, koff) { \
    __builtin_amdgcn_global_load_lds((const unsigned*)(Ag + (koff)), (unsigned*)(wbase + (BUF)), 16, 0, 0); \
    __builtin_amdgcn_global_load_lds((const unsigned*)(Ag + rs + (koff)), (unsigned*)(wbase + (BUF) + 4096), 16, 0, 0); \
    __builtin_amdgcn_global_load_lds((const unsigned*)(Ag + 2 * rs + (koff)), (unsigned*)(wbase + (BUF) + 8192), 16, 0, 0); \
    __builtin_amdgcn_global_load_lds((const unsigned*)(Ag + 3 * rs + (koff)), (unsigned*)(wbase + (BUF) + 12288), 16, 0, 0); \
    __builtin_amdgcn_global_load_lds((const unsigned*)(Bg + (koff)), (unsigned*)(wbase + (BUF) + 16384), 16, 0, 0); \
    __builtin_amdgcn_global_load_lds((const unsigned*)(Bg + rs + (koff)), (unsigned*)(wbase + (BUF) + 16384 + 4096), 16, 0, 0); \
    __builtin_amdgcn_global_load_lds((const unsigned*)(Bg + 2 * rs + (koff)), (unsigned*)(wbase + (BUF) + 16384 + 8192), 16, 0, 0); \
    __builtin_amdgcn_global_load_lds((const unsigned*)(Bg + 3 * rs + (koff)), (unsigned*)(wbase + (BUF) + 16384 + 12288), 16, 0, 0); }
  GLDS_TILE(0, 0)
#pragma unroll
  for (int i = 0; i < 2; ++i)
#pragma unroll
    for (int j = 0; j < 2; ++j)
#pragma unroll
      for (int e = 0; e < 16; ++e) acc[i][j][e] = 0.f;
  const int nk = K >> 6;
  const int xr = (r >> 1) & 7;
  const int arow = (wm * 64 + r) * 128, brow = (wn * 64 + r) * 128;
  asm volatile("s_waitcnt vmcnt(0)" ::: "memory");
  __syncthreads();
#pragma unroll 1
  for (int kt = 0; kt < nk; kt += 2) {
    GLDS_TILE(32768, (kt + 1) * 64)
    gemm_compute(smem, smem + 16384, arow, brow, xr, h, acc);
    asm volatile("s_waitcnt vmcnt(0)" ::: "memory");
    __syncthreads();
    if (kt + 2 < nk) { GLDS_TILE(0, (kt + 2) * 64) }
    gemm_compute(smem + 32768, smem + 32768 + 16384, arow, brow, xr, h, acc);
    asm volatile("s_waitcnt vmcnt(0)" ::: "memory");
    __syncthreads();
  }
#undef GLDS_TILE
}

enum { EP_SILU = 0, EP_PLAIN = 1, EP_HEADNORM = 2 };

__device__ __forceinline__ void stage_flush_bf16(const char* sw, ushort_t* __restrict__ dst, const size_t ld, const size_t row0, const int col0) {
  const int lane = threadIdx.x & 63;
  const int rr = lane >> 3, ch = lane & 7;
#pragma unroll
  for (int i = 0; i < 8; ++i) {
    const int row = i * 8 + rr;
    const uint4 v = *(const uint4*)(sw + row * 144 + ch * 16);
    *(uint4*)(dst + (row0 + row) * ld + col0 + ch * 8) = v;
  }
}

__device__ __forceinline__ void epi_bf16(char* smem, const f32x16 (&acc)[2][2], const int mode, ushort_t* __restrict__ dst, const int ld,
                                         const int row0, const int col0, const float* __restrict__ nw, float* __restrict__ kp) {
  const int lane = threadIdx.x & 63, r = lane & 31, h = lane >> 5;
  char* sw = smem + (threadIdx.x >> 6) * 9216;
  float w0 = 1.f, w1 = 1.f;
  if (mode == EP_HEADNORM) { w0 = nw[r]; w1 = nw[32 + r]; }
  float cs0 = 0.f, cs1 = 0.f;
#pragma unroll
  for (int mi = 0; mi < 2; ++mi) {
#pragma unroll
    for (int e = 0; e < 16; ++e) {
      const int row = mi * 32 + (e & 3) + 8 * (e >> 2) + 4 * h;
      float v0 = acc[mi][0][e], v1 = acc[mi][1][e];
      if (mode == EP_SILU) { v0 = silu_f(v0); v1 = silu_f(v1); }
      if (mode == EP_HEADNORM) {
        float ss = v0 * v0 + v1 * v1;
        ss += __shfl_xor(ss, 1); ss += __shfl_xor(ss, 2); ss += __shfl_xor(ss, 4); ss += __shfl_xor(ss, 8); ss += __shfl_xor(ss, 16);
        const float rs = rsqrtf(ss * (1.f / 64.f) + EPS);
        v0 = v0 * rs * w0; v1 = v1 * rs * w1;
        cs0 += v0; cs1 += v1;
      }
      *(ushort_t*)(sw + row * 144 + r * 2) = f2bf(v0);
      *(ushort_t*)(sw + row * 144 + 64 + r * 2) = f2bf(v1);
    }
  }
  if (kp) {
    cs0 += __shfl_xor(cs0, 32);
    cs1 += __shfl_xor(cs1, 32);
    if (h == 0) { kp[r] = cs0; kp[32 + r] = cs1; }
  }
  stage_flush_bf16(sw, dst, (size_t)ld, (size_t)row0, col0);
}

__device__ __forceinline__ void epi_bf16_T(char* smem, const f32x16 (&acc)[2][2], ushort_t* __restrict__ dstT, const size_t ldT, const int rowpos0) {
  const int lane = threadIdx.x & 63, r = lane & 31, h = lane >> 5;
  char* sw = smem + (threadIdx.x >> 6) * 9216;
#pragma unroll
  for (int ni = 0; ni < 2; ++ni) {
#pragma unroll
    for (int mi = 0; mi < 2; ++mi) {
#pragma unroll
      for (int q4 = 0; q4 < 4; ++q4) {
        const int rp = mi * 32 + 8 * q4 + 4 * h;
        *(uint2*)(sw + (ni * 32 + r) * 144 + rp * 2) = make_uint2(pack2(acc[mi][ni][4 * q4 + 0], acc[mi][ni][4 * q4 + 1]),
                                                                    pack2(acc[mi][ni][4 * q4 + 2], acc[mi][ni][4 * q4 + 3]));
      }
    }
  }
  stage_flush_bf16(sw, dstT, ldT, 0, rowpos0);
}

__device__ __forceinline__ void epi_f32(char* smem, const f32x16 (&acc)[2][2], float* __restrict__ dst, const int ld, const int row0, const int col0,
                                        const float* __restrict__ resid, ushort_t* __restrict__ dstb, float* __restrict__ hss) {
  const int lane = threadIdx.x & 63, r = lane & 31, h = lane >> 5;
  char* sw = smem + (threadIdx.x >> 6) * 17408;
#pragma unroll
  for (int mi = 0; mi < 2; ++mi) {
#pragma unroll
    for (int e = 0; e < 16; ++e) {
      const int row = mi * 32 + (e & 3) + 8 * (e >> 2) + 4 * h;
      *(float*)(sw + row * 272 + r * 4) = acc[mi][0][e];
      *(float*)(sw + row * 272 + 128 + r * 4) = acc[mi][1][e];
    }
  }
  const int rr = lane >> 4, ch = lane & 15;
#pragma unroll
  for (int hb = 0; hb < 2; ++hb) {
    float4 rv[8];
    if (resid) {
#pragma unroll
      for (int i = 0; i < 8; ++i) rv[i] = *(const float4*)(resid + (size_t)(row0 + (hb * 8 + i) * 4 + rr) * ld + col0 + ch * 4);
    }
#pragma unroll
    for (int i = 0; i < 8; ++i) {
      const int row = (hb * 8 + i) * 4 + rr;
      float4 v = *(const float4*)(sw + row * 272 + ch * 16);
      if (resid) { v.x += rv[i].x; v.y += rv[i].y; v.z += rv[i].z; v.w += rv[i].w; }
      *(float4*)(dst + (size_t)(row0 + row) * ld + col0 + ch * 4) = v;
      if (dstb) {
        *(uint2*)(dstb + (size_t)(row0 + row) * ld + col0 + ch * 4) = make_uint2(pack2(v.x, v.y), pack2(v.z, v.w));
        float ss = v.x * v.x + v.y * v.y + v.z * v.z + v.w * v.w;
        ss += __shfl_xor(ss, 1); ss += __shfl_xor(ss, 2); ss += __shfl_xor(ss, 4); ss += __shfl_xor(ss, 8);
        if (ch == 0) hss[(size_t)(row0 + row) * 16 + (col0 >> 6)] = ss;
      }
    }
  }
}

__device__ __forceinline__ void ph_gemm_proj(const int vb, char* smem, const Params& p) {
  const int nt = vb % 20, mt = vb / 20;
  const int m0 = mt * 128, n0 = nt * 128;
  f32x16 acc[2][2];
  gemm_core(p.xn_b, p.w_inT, DM, m0, n0, smem, acc);
  const int wave = threadIdx.x >> 6, wm = wave >> 1, wn = wave & 1;
  const int row0 = m0 + wm * 64;
  const int c = n0 + wn * 64;
  if (c < 512) epi_bf16(smem, acc, EP_SILU, p.zs, 512, row0, c, nullptr, nullptr);
  else if (c < 1536) epi_bf16(smem, acc, EP_PLAIN, p.xbc_raw, 1024, row0, c - 512, nullptr, nullptr);
  else if (c < 1792) epi_bf16(smem, acc, EP_HEADNORM, p.mq, 256, row0, c - 1536, p.mq_norm_w, nullptr);
  else if (c < 2048) {
    const int hh = (c - 1792) >> 6, bb = row0 >> 13, lpos = row0 & (SL - 1);
    epi_bf16(smem, acc, EP_HEADNORM, p.mk, 256, row0, c - 1792, p.mk_norm_w, p.kpart + ((size_t)((bb * 4 + hh) * 32 + (lpos >> 8)) * 4 + ((lpos >> 6) & 3)) * 64);
  } else if (c < 2304) {
    const int hh = (c - 2048) >> 6, bb = row0 >> 13, lpos = row0 & (SL - 1);
    epi_bf16_T(smem, acc, p.vT + (size_t)(bb * 4 + hh) * 64 * SL, SL, lpos);
  }
  else epi_bf16(smem, acc, EP_HEADNORM, p.xq, 256, row0, c - 2304, p.xq_norm_w, nullptr);
}

__device__ __forceinline__ void ph_gemm_mem(const int vb, char* smem, const Params& p) {
  const int nt = vb % 4, mt = vb / 4;
  const int m0 = mt * 128, n0 = nt * 128;
  f32x16 acc[2][2];
  gemm_core(p.memn_b, p.w_memT, DM, m0, n0, smem, acc);
  const int wave = threadIdx.x >> 6, wm = wave >> 1, wn = wave & 1;
  const int row0 = m0 + wm * 64;
  const int c = n0 + wn * 64;
  if (c < 256) epi_bf16(smem, acc, EP_HEADNORM, p.memk_b, 256, row0, c, p.xk_norm_w, nullptr);
  else {
    const int hh = (c - 256) >> 6, bb = row0 >> 8, mpos = row0 & 255;
    epi_bf16_T(smem, acc, p.memvT + (size_t)(bb * 4 + hh) * 64 * MEM, MEM, mpos);
  }
}

__device__ __forceinline__ void ph_gemm_f32(const int vb, char* smem, const ushort_t* A, const ushort_t* Bt, float* dst, const float* resid, ushort_t* dstb, float* hss) {
  const int nt = vb % 8, mt = vb / 8;
  const int m0 = mt * 128, n0 = nt * 128;
  f32x16 acc[2][2];
  gemm_core(A, Bt, DM, m0, n0, smem, acc);
  const int wave = threadIdx.x >> 6, wm = wave >> 1, wn = wave & 1;
  epi_f32(smem, acc, dst, DM, m0 + wm * 64, n0 + wn * 64, resid, dstb, hss);
}

__device__ __forceinline__ int swz256(int row, int ch) { return row * 272 + (ch << 4); }
__device__ __forceinline__ int crow16(int e, int hl) { return (e & 3) + 8 * (e >> 2) + 4 * hl; }

__device__ __forceinline__ void ph_ssd1(const int vb, char* smem, const Params& p) {
  const int h = vb & 7, c = (vb >> 3) & 63, b = vb >> 9;
  const int g = h >> 2, hq = h & 3;
  int tid = threadIdx.x;
  asm volatile("" : "+v"(tid));
  const int lane = tid & 63, wave = tid >> 6;
  const int t0 = b * SL + c * 128;
  char* s_xw = smem;
  char* s_bt = smem + 17408;
  float* s_acs = (float*)(smem + 52224);
  float* s_w = s_acs + 128;
  float* s_red = s_w + 128;
  const float a_coef = -expf(p.a_log[h]);
  float dtv = 0.f, cs = 0.f;
  if (tid < 128) {
    dtv = p.dt[(size_t)(t0 + tid) * 8 + h];
    cs = dtv * a_coef;
#pragma unroll
    for (int o = 1; o < 64; o <<= 1) {
      float nb = __shfl_up(cs, o);
      if (lane >= o) cs += nb;
    }
    if (lane == 63) s_red[wave] = cs;
  }
  __syncthreads();
  if (tid < 128) {
    if (wave == 1) cs += s_red[0];
    s_acs[tid] = cs;
    p.acs[(size_t)(t0 + tid) * 8 + h] = cs;
  }
  __syncthreads();
  if (tid < 128) {
    const float tot = s_acs[127];
    s_w[tid] = dtv * expf(tot - cs);
    if (tid == 0) p.cdec[(b * 64 + c) * 8 + h] = expf(tot);
  }
  __syncthreads();
  if (tid < 224) {
    const int seg = tid / 28, cg = tid - seg * 28;
    const bool is_x = cg < 8, is_b = (cg >= 8) && (cg < 24);
    int ch0, trow;
    if (is_x) { ch0 = h * 64 + cg * 8; trow = cg * 8; }
    else if (is_b) { ch0 = 512 + g * 128 + (cg - 8) * 8; trow = (cg - 8) * 8; }
    else { ch0 = 768 + g * 128 + hq * 32 + (cg - 24) * 8; trow = 0; }
    const bool wr_nat = is_x || !is_b || (hq == 0);
    char* tbase = is_x ? s_xw : s_bt;
    const int l0 = seg * 16;
    float w0[8], w1[8], w2[8], w3[8], bias[8];
    {
      const float* cw = p.conv_w + ch0;
      float4 a, bq;
      a = *(const float4*)(cw); bq = *(const float4*)(cw + 4);
      w0[0] = a.x; w0[1] = a.y; w0[2] = a.z; w0[3] = a.w; w0[4] = bq.x; w0[5] = bq.y; w0[6] = bq.z; w0[7] = bq.w;
      a = *(const float4*)(cw + 1024); bq = *(const float4*)(cw + 1028);
      w1[0] = a.x; w1[1] = a.y; w1[2] = a.z; w1[3] = a.w; w1[4] = bq.x; w1[5] = bq.y; w1[6] = bq.z; w1[7] = bq.w;
      a = *(const float4*)(cw + 2048); bq = *(const float4*)(cw + 2052);
      w2[0] = a.x; w2[1] = a.y; w2[2] = a.z; w2[3] = a.w; w2[4] = bq.x; w2[5] = bq.y; w2[6] = bq.z; w2[7] = bq.w;
      a = *(const float4*)(cw + 3072); bq = *(const float4*)(cw + 3076);
      w3[0] = a.x; w3[1] = a.y; w3[2] = a.z; w3[3] = a.w; w3[4] = bq.x; w3[5] = bq.y; w3[6] = bq.z; w3[7] = bq.w;
      a = *(const float4*)(p.conv_b + ch0); bq = *(const float4*)(p.conv_b + ch0 + 4);
      bias[0] = a.x; bias[1] = a.y; bias[2] = a.z; bias[3] = a.w; bias[4] = bq.x; bias[5] = bq.y; bias[6] = bq.z; bias[7] = bq.w;
    }
    float r0[8], r1[8], r2[8];
    {
      const int lg = c * 128 + l0;
      const ushort_t* src = p.xbc_raw + (size_t)(t0 + l0) * 1024 + ch0;
      uint4 z4 = make_uint4(0u, 0u, 0u, 0u);
      uint4 u0 = (lg >= 3) ? *(const uint4*)(src - 3 * 1024) : z4;
      uint4 u1 = (lg >= 2) ? *(const uint4*)(src - 2 * 1024) : z4;
      uint4 u2 = (lg >= 1) ? *(const uint4*)(src - 1 * 1024) : z4;
      unpack8(u0, r0); unpack8(u1, r1); unpack8(u2, r2);
    }
    unsigned outp[8][8];
    float lo[8], los[8];
#pragma unroll
    for (int i = 0; i < 16; ++i) {
      float cur[8], val[8];
      unpack8(*(const uint4*)(p.xbc_raw + (size_t)(t0 + l0 + i) * 1024 + ch0), cur);
#pragma unroll
      for (int j = 0; j < 8; ++j) {
        float v = bias[j];
        v = fmaf(w0[j], r0[j], v); v = fmaf(w1[j], r1[j], v); v = fmaf(w2[j], r2[j], v); v = fmaf(w3[j], cur[j], v);
        val[j] = silu_f(v);
        r0[j] = r1[j]; r1[j] = r2[j]; r2[j] = cur[j];
      }
      if (wr_nat) {
        *(uint4*)(p.xc + (size_t)(t0 + l0 + i) * 1024 + ch0) =
            make_uint4(pack2(val[0], val[1]), pack2(val[2], val[3]), pack2(val[4], val[5]), pack2(val[6], val[7]));
      }
      const float scl = is_x ? s_w[l0 + i] : 1.f;
      if ((i & 1) == 0) {
#pragma unroll
        for (int j = 0; j < 8; ++j) { lo[j] = val[j]; los[j] = val[j] * scl; }
      } else {
        const int chunk = seg * 2 + (i >> 3);
#pragma unroll
        for (int j = 0; j < 8; ++j) {
          outp[j][i >> 1] = pack2(lo[j], val[j]);
          if (is_x || is_b) *(unsigned*)(tbase + swz256(trow + j, chunk) + ((i & 7) - 1) * 2) = pack2(los[j], val[j] * scl);
        }
      }
    }
    if (is_x) {
      ushort_t* dst = p.xT + ((size_t)((b * 64 + c) * 8 + h) * 64 + cg * 8) * 128 + l0;
#pragma unroll
      for (int j = 0; j < 8; ++j) {
        *(uint4*)(dst + (size_t)j * 128) = make_uint4(outp[j][0], outp[j][1], outp[j][2], outp[j][3]);
        *(uint4*)(dst + (size_t)j * 128 + 8) = make_uint4(outp[j][4], outp[j][5], outp[j][6], outp[j][7]);
      }
    }
  }
  __syncthreads();
  {
    const int r = lane & 31, hl = lane >> 5;
    f32x16 acc[2];
#pragma unroll
    for (int e = 0; e < 16; ++e) { acc[0][e] = 0.f; acc[1][e] = 0.f; }
#pragma unroll
    for (int ks = 0; ks < 8; ++ks) {
      const bf16x8 bfr = *(const bf16x8*)(s_bt + swz256(32 * wave + r, ks * 2 + hl));
      const bf16x8 a0 = *(const bf16x8*)(s_xw + swz256(r, ks * 2 + hl));
      const bf16x8 a1 = *(const bf16x8*)(s_xw + swz256(32 + r, ks * 2 + hl));
      acc[0] = __builtin_amdgcn_mfma_f32_32x32x16_bf16(a0, bfr, acc[0], 0, 0, 0);
      acc[1] = __builtin_amdgcn_mfma_f32_32x32x16_bf16(a1, bfr, acc[1], 0, 0, 0);
    }
    float* dst = p.states + (size_t)((b * 64 + c) * 8 + h) * 64 * 128;
#pragma unroll
    for (int pt = 0; pt < 2; ++pt)
#pragma unroll
      for (int e = 0; e < 16; ++e) dst[(size_t)(pt * 32 + crow16(e, hl)) * 128 + 32 * wave + r] = acc[pt][e];
  }
}

__device__ __forceinline__ void ph_ssd2(const int vb, const Params& p) {
  const int idx = vb * 256 + threadIdx.x;
  const int pn = idx & 8191, h = (idx >> 13) & 7, b = idx >> 16;
  float st = 0.f;
#pragma unroll 1
  for (int c0 = 0; c0 < 64; c0 += 8) {
    float sv[8], dv[8];
#pragma unroll
    for (int i = 0; i < 8; ++i) {
      const int cc = (b * 64 + c0 + i) * 8 + h;
      sv[i] = p.states[(size_t)cc * 8192 + pn];
      dv[i] = p.cdec[cc];
    }
#pragma unroll
    for (int i = 0; i < 8; ++i) {
      const int cc = (b * 64 + c0 + i) * 8 + h;
      p.sin_b[(size_t)cc * 8192 + pn] = f2bf(st);
      st = fmaf(st, dv[i], sv[i]);
    }
  }
}

__device__ __forceinline__ void ph_ssd3(const int vb, char* smem, const Params& p) {
  const int g = vb & 1, c = (vb >> 1) & 63, b = vb >> 7;
  int tid = threadIdx.x;
  asm volatile("" : "+v"(tid));
  const int lane = tid & 63;
  const int w = __builtin_amdgcn_readfirstlane(tid >> 6);
  const int r = lane & 31, hl = lane >> 5;
  const int t0 = b * SL + c * 128;
  char* s_C = smem;
  char* s_B = smem + 34816;
  char* s_xT = smem + 34816;
  char* s_S = smem + 34816 + 16896;
  float* s_acs = (float*)(smem + 69632);
  float* s_dt = s_acs + 512;
  {
    const int ch = tid & 15, r0 = tid >> 4;
#pragma unroll
    for (int i = 0; i < 8; ++i) {
      const int row = r0 + 16 * i;
      const ushort_t* src = p.xc + (size_t)(t0 + row) * 1024 + g * 128 + ch * 8;
      *(uint4*)(s_B + swz256(row, ch)) = *(const uint4*)(src + 512);
      *(uint4*)(s_C + swz256(row, ch)) = *(const uint4*)(src + 768);
    }
    if (tid < 128) {
#pragma unroll
      for (int hh = 0; hh < 4; ++hh) {
        s_acs[hh * 128 + tid] = p.acs[(size_t)(t0 + tid) * 8 + g * 4 + hh];
        s_dt[hh * 128 + tid] = p.dt[(size_t)(t0 + tid) * 8 + g * 4 + hh];
      }
    }
  }
  __syncthreads();
  bf16x8 cfr[8];
#pragma unroll
  for (int ks = 0; ks < 8; ++ks) cfr[ks] = *(const bf16x8*)(s_C + swz256(32 * w + r, ks * 2 + hl));
  f32x16 gt[4];
#pragma unroll
  for (int st = 0; st < 4; ++st) {
#pragma unroll
    for (int e = 0; e < 16; ++e) gt[st][e] = 0.f;
    if (st <= w) {
#pragma unroll
      for (int ks = 0; ks < 8; ++ks) {
        const bf16x8 a = *(const bf16x8*)(s_B + swz256(32 * st + r, ks * 2 + hl));
        gt[st] = __builtin_amdgcn_mfma_f32_32x32x16_bf16(a, cfr[ks], gt[st], 0, 0, 0);
      }
    }
  }
  __syncthreads();
  float ssq = 0.f;
  const int lane_c = lane;
#pragma unroll 1
  for (int hh = 0; hh < 4; ++hh) {
    int lane_o = lane_c;
    asm volatile("" : "+v"(lane_o));
    const int r = lane_o & 31, hl = lane_o >> 5;
    const int l = 32 * w + r;
    const int hg = g * 4 + hh;
    {
      const int ch = tid & 15, r0 = tid >> 4;
      const size_t base = (size_t)((b * 64 + c) * 8 + hg) * 8192;
#pragma unroll
      for (int i = 0; i < 4; ++i) {
        const int row = r0 + 16 * i;
        const uint4 xv = *(const uint4*)(p.xT + base + (size_t)row * 128 + ch * 8);
        *(uint2*)(s_xT + row * 264 + ch * 16) = make_uint2(xv.x, xv.y);
        *(uint2*)(s_xT + row * 264 + ch * 16 + 8) = make_uint2(xv.z, xv.w);
        *(uint4*)(s_S + swz256(row, ch)) = *(const uint4*)(p.sin_b + base + (size_t)row * 128 + ch * 8);
      }
    }
    __syncthreads();
    const float acs_l = s_acs[hh * 128 + l];
    const float dsk = p.ssd_d[hg];
    f32x16 acc[2];
#pragma unroll
    for (int e = 0; e < 16; ++e) { acc[0][e] = 0.f; acc[1][e] = 0.f; }
#pragma unroll
    for (int ks = 0; ks < 8; ++ks) {
      const bf16x8 a0 = *(const bf16x8*)(s_S + swz256(r, ks * 2 + hl));
      const bf16x8 a1 = *(const bf16x8*)(s_S + swz256(32 + r, ks * 2 + hl));
      acc[0] = __builtin_amdgcn_mfma_f32_32x32x16_bf16(a0, cfr[ks], acc[0], 0, 0, 0);
      acc[1] = __builtin_amdgcn_mfma_f32_32x32x16_bf16(a1, cfr[ks], acc[1], 0, 0, 0);
    }
    {
      const float el = expf(acs_l);
#pragma unroll
      for (int e = 0; e < 16; ++e) { acc[0][e] *= el; acc[1][e] *= el; }
    }
#pragma unroll
    for (int st = 0; st < 4; ++st) {
      asm volatile("" ::: "memory");
      if (st <= w) {
        float m[16];
#pragma unroll
        for (int e = 0; e < 16; ++e) {
          const int sidx = 32 * st + crow16(e, hl);
          float v = gt[st][e] * __expf(acs_l - s_acs[hh * 128 + sidx]) * s_dt[hh * 128 + sidx];
          if (sidx > l) v = 0.f;
          if (sidx == l) v += dsk;
          m[e] = v;
        }
#pragma unroll
        for (int k2 = 0; k2 < 2; ++k2) {
          asm volatile("" ::: "memory");
          bf16x8 mf;
          {
            unsigned u0 = pack2(m[8 * k2 + 0], m[8 * k2 + 1]), u1 = pack2(m[8 * k2 + 2], m[8 * k2 + 3]);
            unsigned u2 = pack2(m[8 * k2 + 4], m[8 * k2 + 5]), u3 = pack2(m[8 * k2 + 6], m[8 * k2 + 7]);
            uint4 uu = make_uint4(u0, u1, u2, u3);
            mf = *(bf16x8*)&uu;
          }
          const int soff = (32 * st + 16 * k2 + 4 * hl) * 2;
#pragma unroll
          for (int pt = 0; pt < 2; ++pt) {
            const char* ap = s_xT + (pt * 32 + r) * 264 + soff;
            uint2 q0 = *(const uint2*)(ap);
            uint2 q1 = *(const uint2*)(ap + 16);
            uint4 qq = make_uint4(q0.x, q0.y, q1.x, q1.y);
            const bf16x8 af = *(bf16x8*)&qq;
            acc[pt] = __builtin_amdgcn_mfma_f32_32x32x16_bf16(af, mf, acc[pt], 0, 0, 0);
          }
        }
      }
    }
#pragma unroll
    for (int pt = 0; pt < 2; ++pt) {
#pragma unroll
      for (int q4 = 0; q4 < 4; ++q4) {
        asm volatile("" ::: "memory");
        const int p0 = pt * 32 + 8 * q4 + 4 * hl;
        const uint2 zz = *(const uint2*)(p.zs + (size_t)(t0 + l) * 512 + hg * 64 + p0);
        const float v0 = acc[pt][4 * q4 + 0] * bflo(zz.x), v1 = acc[pt][4 * q4 + 1] * bfhi(zz.x);
        const float v2 = acc[pt][4 * q4 + 2] * bflo(zz.y), v3 = acc[pt][4 * q4 + 3] * bfhi(zz.y);
        ssq += v0 * v0 + v1 * v1 + v2 * v2 + v3 * v3;
        *(uint2*)(p.mixed_b + (size_t)(t0 + l) * 1024 + hg * 64 + p0) = make_uint2(pack2(v0, v1), pack2(v2, v3));
      }
    }
    __syncthreads();
  }
  const int l = 32 * w + r;
  ssq += __shfl_xor(ssq, 32);
  const float rstd = rsqrtf(ssq * (1.f / 256.f) + EPS);
#pragma unroll 1
  for (int hh = 0; hh < 4; ++hh) {
#pragma unroll
    for (int pt = 0; pt < 2; ++pt) {
#pragma unroll
      for (int q4 = 0; q4 < 4; ++q4) {
        asm volatile("" ::: "memory");
        const int chn = (g * 4 + hh) * 64 + pt * 32 + 8 * q4 + 4 * hl;
        ushort_t* ptr = p.mixed_b + (size_t)(t0 + l) * 1024 + chn;
        const uint2 vv = *(const uint2*)ptr;
        const float4 nw = *(const float4*)(p.ssd_norm_w + chn);
        *(uint2*)ptr = make_uint2(pack2(bflo(vv.x) * rstd * nw.x, bfhi(vv.x) * rstd * nw.y),
                                  pack2(bflo(vv.y) * rstd * nw.z, bfhi(vv.y) * rstd * nw.w));
      }
    }
  }
}

__device__ __forceinline__ void k_gate(const int VB, char* smem, const Params& p) {
  const int own = VB & 31, bh = VB >> 5;
  if (own == 0) return;
  const int b = bh >> 2, h = bh & 3;
  const int tid = threadIdx.x;
  float* s_km = (float*)smem;
  int* s_cnt = (int*)(smem + 8192);
  int* s_base = s_cnt + 32;
  for (int i = tid; i < own * 64; i += 256) {
    const int n = i >> 6, d = i & 63;
    const float* kp = p.kpart + (size_t)(bh * 32 + n) * 256 + d;
    s_km[i] = (kp[0] + kp[64]) + (kp[128] + kp[192]);
  }
  if (tid < 32) s_cnt[tid] = 0;
  __syncthreads();
  const int l = own * 256 + tid;
  const int t = b * SL + l;
  float q[64];
  {
    const ushort_t* src = p.mq + (size_t)t * 256 + h * 64;
#pragma unroll
    for (int d = 0; d < 64; d += 8) {
      uint4 v = *(const uint4*)(src + d);
      q[d] = bflo(v.x); q[d + 1] = bfhi(v.x); q[d + 2] = bflo(v.y); q[d + 3] = bfhi(v.y);
      q[d + 4] = bflo(v.z); q[d + 5] = bfhi(v.z); q[d + 6] = bflo(v.w); q[d + 7] = bfhi(v.w);
    }
  }
  float v0 = -INFINITY, v1 = -INFINITY, v2 = -INFINITY;
  int i0 = 0, i1 = 1, i2 = 2;
  for (int n = 0; n < own; ++n) {
    const float* km = s_km + n * 64;
    float sa = 0.f, sb = 0.f;
#pragma unroll
    for (int d = 0; d < 64; d += 8) {
      const float4 a = *(const float4*)(km + d), c = *(const float4*)(km + d + 4);
      sa = fmaf(q[d], a.x, sa); sa = fmaf(q[d + 1], a.y, sa); sa = fmaf(q[d + 2], a.z, sa); sa = fmaf(q[d + 3], a.w, sa);
      sb = fmaf(q[d + 4], c.x, sb); sb = fmaf(q[d + 5], c.y, sb); sb = fmaf(q[d + 6], c.z, sb); sb = fmaf(q[d + 7], c.w, sb);
    }
    const float sv = sa + sb;
    if (sv > v0) { v2 = v1; i2 = i1; v1 = v0; i1 = i0; v0 = sv; i0 = n; }
    else if (sv > v1) { v2 = v1; i2 = i1; v1 = sv; i1 = n; }
    else if (sv > v2) { v2 = sv; i2 = n; }
  }
  const int nsel = own < 3 ? own : 3;
  int lp0 = 0, lp1 = 0, lp2 = 0;
  if (0 < nsel) lp0 = atomicAdd(s_cnt + i0, 1);
  if (1 < nsel) lp1 = atomicAdd(s_cnt + i1, 1);
  if (2 < nsel) lp2 = atomicAdd(s_cnt + i2, 1);
  __syncthreads();
  if (tid < own) s_base[tid] = s_cnt[tid] ? atomicAdd(p.bcnt + bh * 32 + tid, s_cnt[tid]) : 0;
  __syncthreads();
  if (0 < nsel) p.blist[(size_t)(bh * 32 + i0) * 8192 + s_base[i0] + lp0] = l | (0 << 13);
  if (1 < nsel) p.blist[(size_t)(bh * 32 + i1) * 8192 + s_base[i1] + lp1] = l | (1 << 13);
  if (2 < nsel) p.blist[(size_t)(bh * 32 + i2) * 8192 + s_base[i2] + lp2] = l | (2 << 13);
}

struct UnitDesc { const ushort_t* Kp; const ushort_t* VTp; int vstride; int kind; int a0; int a1; };
__device__ __forceinline__ UnitDesc unit_desc(const int u, const int Ug, const int* s_pref, const Params& p) {
  UnitDesc d;
  if (u >= Ug + NB * 4 * 32 * 2) {
    const int v = u - Ug - NB * 4 * 32 * 2;
    d.kind = 2; d.a0 = v >> 6; d.a1 = v & 63;
    const int bh = d.a0, b = bh >> 2, h = bh & 3;
    d.Kp = p.memk_b + (size_t)b * MEM * 256 + h * 64;
    d.VTp = p.memvT + (size_t)bh * 64 * MEM;
    d.vstride = MEM;
  } else {
    if (u < Ug) {
      int lo = 0, hi = 255;
      while (lo < hi) { const int mid = (lo + hi) >> 1; if (s_pref[mid] > u) hi = mid; else lo = mid + 1; }
      const int prev = lo ? s_pref[lo - 1] : 0;
      d.kind = 0; d.a0 = lo; d.a1 = u - prev;
    } else {
      const int v = u - Ug;
      d.kind = 1; d.a0 = v >> 1; d.a1 = v & 1;
    }
    const int bh = d.a0 >> 5, jblk = d.a0 & 31, b = bh >> 2, h = bh & 3;
    d.Kp = p.mk + (size_t)(b * SL + jblk * 256) * 256 + h * 64;
    d.VTp = p.vT + (size_t)bh * 64 * SL + jblk * 256;
    d.vstride = SL;
  }
  return d;
}

#define AU_LOAD(P, D, ST) { \
    const ushort_t* kp_ = (D).Kp + (size_t)((ST) * 128 + kr) * 256 + kc * 8; \
    P##k0 = *(const uint4*)(kp_); P##k1 = *(const uint4*)(kp_ + 32 * 256); P##k2 = *(const uint4*)(kp_ + 64 * 256); P##k3 = *(const uint4*)(kp_ + 96 * 256); \
    const ushort_t* vp_ = (D).VTp + (size_t)vr * (D).vstride + (ST) * 128 + vc * 8; \
    P##v0 = *(const uint4*)(vp_); P##v1 = *(const uint4*)(vp_ + (size_t)16 * (D).vstride); \
    P##v2 = *(const uint4*)(vp_ + (size_t)32 * (D).vstride); P##v3 = *(const uint4*)(vp_ + (size_t)48 * (D).vstride); }
#define AU_STORE(P, BUF) { \
    char* sk_ = (BUF) + kr * 144 + kc * 16; \
    *(uint4*)(sk_) = P##k0; *(uint4*)(sk_ + 32 * 144) = P##k1; *(uint4*)(sk_ + 64 * 144) = P##k2; *(uint4*)(sk_ + 96 * 144) = P##k3; \
    char* sv_ = (BUF) + 18432 + vr * 264 + vc * 16; \
    *(uint2*)(sv_) = make_uint2(P##v0.x, P##v0.y); *(uint2*)(sv_ + 8) = make_uint2(P##v0.z, P##v0.w); \
    *(uint2*)(sv_ + 16 * 264) = make_uint2(P##v1.x, P##v1.y); *(uint2*)(sv_ + 16 * 264 + 8) = make_uint2(P##v1.z, P##v1.w); \
    *(uint2*)(sv_ + 32 * 264) = make_uint2(P##v2.x, P##v2.y); *(uint2*)(sv_ + 32 * 264 + 8) = make_uint2(P##v2.z, P##v2.w); \
    *(uint2*)(sv_ + 48 * 264) = make_uint2(P##v3.x, P##v3.y); *(uint2*)(sv_ + 48 * 264 + 8) = make_uint2(P##v3.z, P##v3.w); }

__device__ __forceinline__ void attn_stage(const char* buf, const int st, const bf16x8 (&qf)[4], const float slope, const int qrel, const bool causal,
                                           const int r, const int hl, f32x16 (&o)[2], float& m, float& lsum) {
  const char* s_K = buf;
  const char* s_VT = buf + 18432;
  f32x16 sc[4];
#pragma unroll
  for (int kt = 0; kt < 4; ++kt) {
#pragma unroll
    for (int e = 0; e < 16; ++e) sc[kt][e] = 0.f;
#pragma unroll
    for (int ks = 0; ks < 4; ++ks) {
      const bf16x8 a = *(const bf16x8*)(s_K + (32 * kt + r) * 144 + (2 * ks + hl) * 16);
      sc[kt] = __builtin_amdgcn_mfma_f32_32x32x16_bf16(a, qf[ks], sc[kt], 0, 0, 0);
    }
  }
  float mx = -1e30f;
  const int qk0 = qrel - st * 128 - 4 * hl;
  const float slope2 = slope;
  const float bb = -slope2 * (float)qk0;
#pragma unroll
  for (int kt = 0; kt < 4; ++kt) {
#pragma unroll
    for (int e = 0; e < 16; ++e) {
      const int ce = 32 * kt + (e & 3) + 8 * (e >> 2);
      float v = fmaf(sc[kt][e], 0.18033688011112042f, fmaf(slope2, (float)ce, bb));
      if (causal && ce > qk0) v = -1e30f;
      sc[kt][e] = v;
      mx = fmaxf(mx, v);
    }
  }
  mx = fmaxf(mx, __shfl_xor(mx, 32));
  const float mnew = fmaxf(m, mx);
  const float alpha = __builtin_amdgcn_exp2f(m - mnew);
  m = mnew;
  lsum *= alpha;
#pragma unroll
  for (int e = 0; e < 16; ++e) { o[0][e] *= alpha; o[1][e] *= alpha; }
#pragma unroll
  for (int kt = 0; kt < 4; ++kt) {
#pragma unroll
    for (int e = 0; e < 16; ++e) {
      const float pe = __builtin_amdgcn_exp2f(sc[kt][e] - mnew);
      sc[kt][e] = pe;
      lsum += pe;
    }
  }
#pragma unroll
  for (int kt = 0; kt < 4; ++kt) {
#pragma unroll
    for (int k2 = 0; k2 < 2; ++k2) {
      uint4 pu = make_uint4(pack2(sc[kt][8 * k2 + 0], sc[kt][8 * k2 + 1]), pack2(sc[kt][8 * k2 + 2], sc[kt][8 * k2 + 3]),
                            pack2(sc[kt][8 * k2 + 4], sc[kt][8 * k2 + 5]), pack2(sc[kt][8 * k2 + 6], sc[kt][8 * k2 + 7]));
      const bf16x8 pf = *(bf16x8*)&pu;
      const int koff = (32 * kt + 16 * k2 + 4 * hl) * 2;
#pragma unroll
      for (int dt = 0; dt < 2; ++dt) {
        const char* ap = s_VT + (dt * 32 + r) * 264 + koff;
        const uint2 q0 = *(const uint2*)(ap);
        const uint2 q1 = *(const uint2*)(ap + 16);
        uint4 qq = make_uint4(q0.x, q0.y, q1.x, q1.y);
        const bf16x8 af = *(bf16x8*)&qq;
        o[dt] = __builtin_amdgcn_mfma_f32_32x32x16_bf16(af, pf, o[dt], 0, 0, 0);
      }
    }
  }
}

__device__ __forceinline__ void ph_attn_units(char* smem, const Params& p, const int Ug, const int* s_pref) {
  const int Utot = Ug + NB * 4 * 32 * 2 + NB * 4 * 64;
  int u = blockIdx.x;
  if (u >= Utot) return;
  int tid = threadIdx.x;
  asm volatile("" : "+v"(tid));
  const int lane = tid & 63, wave = tid >> 6, r = lane & 31, hl = lane >> 5;
  const int kr = tid >> 3, kc = tid & 7, vr = tid >> 4, vc = tid & 15;
  char* buf0 = smem;
  char* buf1 = smem + 35328;
  uint4 Ak0, Ak1, Ak2, Ak3, Av0, Av1, Av2, Av3, Bk0, Bk1, Bk2, Bk3, Bv0, Bv1, Bv2, Bv3;
  UnitDesc D = unit_desc(u, Ug, s_pref, p);
  AU_LOAD(A, D, 0)
  AU_LOAD(B, D, 1)
#pragma unroll 1
  for (; u < Utot; u += gridDim.x) {
    const int un = (u + (int)gridDim.x < Utot) ? u + (int)gridDim.x : u;
    const UnitDesc Dn = unit_desc(un, Ug, s_pref, p);
    int bh, l = 0, slot = 3, jblk = 0;
    bool valid = true, causal = false;
    const ushort_t* qrow;
    float slope = 0.f;
    int qrel = 1 << 20;
    int t;
    if (D.kind == 2) {
      bh = D.a0;
      t = (bh >> 2) * SL + D.a1 * 128 + wave * 32 + r;
      qrow = p.xq + (size_t)t * 256 + (bh & 3) * 64;
    } else {
      bh = D.a0 >> 5; jblk = D.a0 & 31;
      if (D.kind == 0) {
        const int cnt = p.bcnt[D.a0];
        int qi = D.a1 * 128 + wave * 32 + r;
        if (qi >= cnt) { valid = false; qi = 0; }
        const int ent = p.blist[(size_t)D.a0 * 8192 + qi];
        l = ent & 8191; slot = ent >> 13;
      } else {
        l = jblk * 256 + D.a1 * 128 + wave * 32 + r; slot = 3; causal = true;
      }
      t = (bh >> 2) * SL + l;
      qrow = p.mq + (size_t)t * 256 + (bh & 3) * 64;
      slope = exp2f(-2.f * (float)((bh & 3) + 1)) * 1.4426950408889634f;
      qrel = l - jblk * 256;
    }
    bf16x8 qf[4];
#pragma unroll
    for (int ks = 0; ks < 4; ++ks) qf[ks] = *(const bf16x8*)(qrow + ks * 16 + hl * 8);
    f32x16 o[2];
#pragma unroll
    for (int e = 0; e < 16; ++e) { o[0][e] = 0.f; o[1][e] = 0.f; }
    float m = -1e30f, lsum = 0.f;
    AU_STORE(A, buf0)
    AU_LOAD(A, Dn, 0)
    __syncthreads();
    attn_stage(buf0, 0, qf, slope, qrel, causal, r, hl, o, m, lsum);
    AU_STORE(B, buf1)
    AU_LOAD(B, Dn, 1)
    __syncthreads();
    attn_stage(buf1, 1, qf, slope, qrel, causal, r, hl, o, m, lsum);
    const float lt = lsum + __shfl_xor(lsum, 32);
    const float inv = 1.f / lt;
    const int h = bh & 3;
    if (D.kind == 2) {
#pragma unroll
      for (int dt = 0; dt < 2; ++dt)
#pragma unroll
        for (int q4 = 0; q4 < 4; ++q4) {
          const int d = dt * 32 + 8 * q4 + 4 * hl;
          *(uint2*)(p.mixed_b + (size_t)t * DM + 768 + h * 64 + d) =
              make_uint2(pack2(o[dt][4 * q4] * inv, o[dt][4 * q4 + 1] * inv), pack2(o[dt][4 * q4 + 2] * inv, o[dt][4 * q4 + 3] * inv));
        }
    } else if (valid) {
      const size_t pi = ((size_t)t * 4 + h) * 4 + slot;
#pragma unroll
      for (int dt = 0; dt < 2; ++dt)
#pragma unroll
        for (int q4 = 0; q4 < 4; ++q4) {
          const int d = dt * 32 + 8 * q4 + 4 * hl;
          *(uint2*)(p.pO + pi * 64 + d) =
              make_uint2(pack2(o[dt][4 * q4] * inv, o[dt][4 * q4 + 1] * inv), pack2(o[dt][4 * q4 + 2] * inv, o[dt][4 * q4 + 3] * inv));
        }
      if (hl == 0) { p.pm[pi] = m; p.pl[pi] = lt; }
    }
    D = Dn;
  }
}

__device__ __forceinline__ void ph_attn_combine(const int VB, const Params& p) {
  const int i = VB * 256 + threadIdx.x;
  const int dq = i & 7, th = i >> 3;
  const int t = th >> 2;
  const int own = (t & (SL - 1)) >> 8;
  const int nsel = own < 3 ? own : 3;
  float mv[4], wv[4];
  float M = p.pm[(size_t)th * 4 + 3];
  mv[3] = M;
#pragma unroll
  for (int sl = 0; sl < 3; ++sl) {
    mv[sl] = (sl < nsel) ? p.pm[(size_t)th * 4 + sl] : -1e30f;
    M = fmaxf(M, mv[sl]);
  }
  float W = 0.f;
#pragma unroll
  for (int sl = 0; sl < 4; ++sl) {
    const bool on = (sl == 3) || (sl < nsel);
    wv[sl] = on ? p.pl[(size_t)th * 4 + sl] * __builtin_amdgcn_exp2f(mv[sl] - M) : 0.f;
    W += wv[sl];
  }
  float acc[8];
#pragma unroll
  for (int k = 0; k < 8; ++k) acc[k] = 0.f;
#pragma unroll
  for (int sl = 0; sl < 4; ++sl) {
    const bool on = (sl == 3) || (sl < nsel);
    if (on) {
      float f[8];
      unpack8(*(const uint4*)(p.pO + ((size_t)th * 4 + sl) * 64 + dq * 8), f);
#pragma unroll
      for (int k = 0; k < 8; ++k) acc[k] = fmaf(wv[sl], f[k], acc[k]);
    }
  }
  const float inv = 1.f / W;
  const int h = th & 3;
  *(uint4*)(p.mixed_b + (size_t)t * DM + 512 + h * 64 + dq * 8) =
      make_uint4(pack2(acc[0] * inv, acc[1] * inv), pack2(acc[2] * inv, acc[3] * inv), pack2(acc[4] * inv, acc[5] * inv), pack2(acc[6] * inv, acc[7] * inv));
}


__device__ __forceinline__ int mkkey(const float f, const int idx, const int mask) {
  int b = __float_as_int(f);
  b = (b & ~mask) | idx;
  return b ^ ((b >> 31) & 0x7fffffff);
}
__device__ __forceinline__ int key2bits(const int k) { return k ^ ((k >> 31) & 0x7fffffff); }
#define CEI(a, b) { const int _mx = max(a, b), _mn = min(a, b); a = _mx; b = _mn; }
template <int N>
__device__ __forceinline__ void bitonic_sort_desc(int (&v)[N]) {
#pragma unroll
  for (int k = 2; k <= N; k <<= 1) {
#pragma unroll
    for (int j = k >> 1; j > 0; j >>= 1) {
#pragma unroll
      for (int i = 0; i < N; ++i) {
        const int l = i ^ j;
        if (l > i) {
          if ((i & k) == 0) { CEI(v[i], v[l]); } else { CEI(v[l], v[i]); }
        }
      }
    }
  }
}
__device__ __forceinline__ void merge16(int (&a)[16], const int (&b)[16]) {
#pragma unroll
  for (int i = 0; i < 16; ++i) a[i] = max(a[i], b[15 - i]);
#pragma unroll
  for (int j = 8; j > 0; j >>= 1) {
#pragma unroll
    for (int i = 0; i < 16; ++i) {
      const int l = i ^ j;
      if (l > i) { CEI(a[i], a[l]); }
    }
  }
}
__device__ __forceinline__ void merge_partner(int (&a)[16], const int xmask) {
  int o[16];
#pragma unroll
  for (int i = 0; i < 16; ++i) o[i] = __shfl_xor(a[i], xmask);
  merge16(a, o);
}
__device__ __forceinline__ bf16x8 pack_hi8(const float (&x)[8], float (&res)[8]) {
  unsigned u[4];
#pragma unroll
  for (int i = 0; i < 4; ++i) {
    const ushort_t h0 = f2bf(x[2 * i]), h1 = f2bf(x[2 * i + 1]);
    res[2 * i] = x[2 * i] - bf2f(h0);
    res[2 * i + 1] = x[2 * i + 1] - bf2f(h1);
    u[i] = (unsigned)h0 | ((unsigned)h1 << 16);
  }
  uint4 uu = make_uint4(u[0], u[1], u[2], u[3]);
  return *(bf16x8*)&uu;
}
__device__ __forceinline__ bf16x8 pack_8(const float (&x)[8]) {
  uint4 uu = make_uint4(pack2(x[0], x[1]), pack2(x[2], x[3]), pack2(x[4], x[5]), pack2(x[6], x[7]));
  return *(bf16x8*)&uu;
}

__device__ __forceinline__ void ph_gemm_route(const int vb, char* smem, const Params& p, const ushort_t* __restrict__ hn_b) {
  const int head = vb & 7, tt = vb >> 3;
  const int m0 = head * 128, n0 = tt * 128;
  f32x16 acc[2][2];
  gemm_core(p.w_qT, hn_b, DM, m0, n0, smem, acc);
  int tid = threadIdx.x;
  asm volatile("" : "+v"(tid));
  const int lane = tid & 63, r = lane & 31, hl = lane >> 5;
  const int wave = tid >> 6, wm = wave >> 1, wn = wave & 1;
  int* s_top = (int*)(smem + 34816);
  float rstd_tok[2];
#pragma unroll
  for (int ni = 0; ni < 2; ++ni) {
    const float4* hp = (const float4*)(p.hss + (size_t)(n0 + wn * 64 + ni * 32 + r) * 16);
    const float4 a = hp[0], b = hp[1], c = hp[2], d = hp[3];
    const float tot = ((a.x + a.y) + (a.z + a.w)) + ((b.x + b.y) + (b.z + b.w)) + ((c.x + c.y) + (c.z + c.w)) + ((d.x + d.y) + (d.z + d.w));
    rstd_tok[ni] = rsqrtf(tot * (1.f / DM) + EPS);
  }
  {
    const int row = tid >> 1, part = tid & 1;
#pragma unroll
    for (int hf = 0; hf < 2; ++hf) {
      const ushort_t* src = p.skh + (size_t)(hf * 128 + row) * 64 + part * 32;
      char* dst = smem + (hf * 128 + row) * 136 + part * 64;
#pragma unroll
      for (int c = 0; c < 4; ++c) {
        const uint4 v = *(const uint4*)(src + c * 8);
        *(uint2*)(dst + c * 16) = make_uint2(v.x, v.y);
        *(uint2*)(dst + c * 16 + 8) = make_uint2(v.z, v.w);
      }
    }
  }
  __syncthreads();
  const char* s_keys = smem + wm * 128 * 136;
#pragma unroll
  for (int ni = 0; ni < 2; ++ni) {
    asm volatile("" ::: "memory");
    bf16x8 qh[4], ql[4];
#pragma unroll
    for (int mi = 0; mi < 2; ++mi) {
#pragma unroll
      for (int k2 = 0; k2 < 2; ++k2) {
        float x[8], res[8];
#pragma unroll
        for (int j = 0; j < 8; ++j) x[j] = acc[mi][ni][8 * k2 + j] * rstd_tok[ni];
        qh[mi * 2 + k2] = pack_hi8(x, res);
        ql[mi * 2 + k2] = pack_8(res);
      }
    }
    int g0[16];
#pragma unroll
    for (int kh2 = 0; kh2 < 2; ++kh2) {
      int ga[16], gb[16];
#pragma unroll
      for (int kq = 0; kq < 2; ++kq) {
        const int kt = kh2 * 2 + kq;
        asm volatile("" ::: "memory");
        f32x16 sc;
#pragma unroll
        for (int e = 0; e < 16; ++e) sc[e] = 0.f;
#pragma unroll
        for (int st = 0; st < 4; ++st) {
          const int d0 = (st >> 1) * 32 + 16 * (st & 1) + 4 * hl;
          const char* kp = s_keys + (kt * 32 + r) * 136 + d0 * 2;
          const uint2 h0 = *(const uint2*)(kp), h1 = *(const uint2*)(kp + 16);
          uint4 hq = make_uint4(h0.x, h0.y, h1.x, h1.y);
          const bf16x8 ah = *(bf16x8*)&hq;
          sc = __builtin_amdgcn_mfma_f32_32x32x16_bf16(ah, qh[st], sc, 0, 0, 0);
          sc = __builtin_amdgcn_mfma_f32_32x32x16_bf16(ah, ql[st], sc, 0, 0, 0);
        }
        if (kq == 0) {
#pragma unroll
          for (int e = 0; e < 16; ++e) ga[e] = mkkey(sc[e], kt * 32 + (e & 3) + 8 * (e >> 2) + 4 * hl, 127);
          bitonic_sort_desc<16>(ga);
        } else {
#pragma unroll
          for (int e = 0; e < 16; ++e) gb[e] = mkkey(sc[e], kt * 32 + (e & 3) + 8 * (e >> 2) + 4 * hl, 127);
          bitonic_sort_desc<16>(gb);
        }
      }
      merge16(ga, gb);
      if (kh2 == 0) {
#pragma unroll
        for (int i = 0; i < 16; ++i) g0[i] = ga[i];
      } else {
        merge16(g0, ga);
      }
    }
    merge_partner(g0, 32);
    {
      int* dst = s_top + ((size_t)wm * 128 + wn * 64 + ni * 32 + r) * 16 + hl * 8;
      int4 w0, w1;
      int lo8[8], hi8[8];
#pragma unroll
      for (int i = 0; i < 8; ++i) { lo8[i] = g0[i]; hi8[i] = g0[8 + i]; asm volatile("" : "+v"(lo8[i]), "+v"(hi8[i])); }
      w0 = make_int4(hl ? hi8[0] : lo8[0], hl ? hi8[1] : lo8[1], hl ? hi8[2] : lo8[2], hl ? hi8[3] : lo8[3]);
      w1 = make_int4(hl ? hi8[4] : lo8[4], hl ? hi8[5] : lo8[5], hl ? hi8[6] : lo8[6], hl ? hi8[7] : lo8[7]);
      *(int4*)dst = w0; *(int4*)(dst + 4) = w1;
    }
  }
  __syncthreads();
  {
    const int tok = tid >> 1, sub = tid & 1;
    int k1[16], k2[16];
    {
      const int4* a = (const int4*)(s_top + (size_t)tok * 16);
      const int4* b = (const int4*)(s_top + (size_t)(128 + tok) * 16);
#pragma unroll
      for (int i = 0; i < 4; ++i) {
        const int4 x = a[i], y = b[i];
        k1[4 * i] = x.x; k1[4 * i + 1] = x.y; k1[4 * i + 2] = x.z; k1[4 * i + 3] = x.w;
        k2[4 * i] = y.x; k2[4 * i + 1] = y.y; k2[4 * i + 2] = y.z; k2[4 * i + 3] = y.w;
      }
    }
    float v1f[16], v2f[16];
#pragma unroll
    for (int i = 0; i < 16; ++i) { v1f[i] = __int_as_float(key2bits(k1[i])); v2f[i] = __int_as_float(key2bits(k2[i])); }
    int c[32];
    c[0] = sub ? mkkey(v1f[3] + v2f[3], 51, 255) : mkkey(v1f[0] + v2f[0], 0, 255);
    c[1] = sub ? mkkey(v1f[4] + v2f[0], 64, 255) : mkkey(v1f[0] + v2f[1], 1, 255);
    c[2] = sub ? mkkey(v1f[4] + v2f[1], 65, 255) : mkkey(v1f[0] + v2f[2], 2, 255);
    c[3] = sub ? mkkey(v1f[4] + v2f[2], 66, 255) : mkkey(v1f[0] + v2f[3], 3, 255);
    c[4] = sub ? mkkey(v1f[5] + v2f[0], 80, 255) : mkkey(v1f[0] + v2f[4], 4, 255);
    c[5] = sub ? mkkey(v1f[5] + v2f[1], 81, 255) : mkkey(v1f[0] + v2f[5], 5, 255);
    c[6] = sub ? mkkey(v1f[6] + v2f[0], 96, 255) : mkkey(v1f[0] + v2f[6], 6, 255);
    c[7] = sub ? mkkey(v1f[6] + v2f[1], 97, 255) : mkkey(v1f[0] + v2f[7], 7, 255);
    c[8] = sub ? mkkey(v1f[7] + v2f[0], 112, 255) : mkkey(v1f[0] + v2f[8], 8, 255);
    c[9] = sub ? mkkey(v1f[7] + v2f[1], 113, 255) : mkkey(v1f[0] + v2f[9], 9, 255);
    c[10] = sub ? mkkey(v1f[8] + v2f[0], 128, 255) : mkkey(v1f[0] + v2f[10], 10, 255);
    c[11] = sub ? mkkey(v1f[9] + v2f[0], 144, 255) : mkkey(v1f[0] + v2f[11], 11, 255);
    c[12] = sub ? mkkey(v1f[10] + v2f[0], 160, 255) : mkkey(v1f[0] + v2f[12], 12, 255);
    c[13] = sub ? mkkey(v1f[11] + v2f[0], 176, 255) : mkkey(v1f[0] + v2f[13], 13, 255);
    c[14] = sub ? mkkey(v1f[12] + v2f[0], 192, 255) : mkkey(v1f[0] + v2f[14], 14, 255);
    c[15] = sub ? mkkey(v1f[13] + v2f[0], 208, 255) : mkkey(v1f[0] + v2f[15], 15, 255);
    c[16] = sub ? mkkey(v1f[14] + v2f[0], 224, 255) : mkkey(v1f[1] + v2f[0], 16, 255);
    c[17] = sub ? mkkey(v1f[15] + v2f[0], 240, 255) : mkkey(v1f[1] + v2f[1], 17, 255);
    c[18] = sub ? (int)0x80000000 : mkkey(v1f[1] + v2f[2], 18, 255);
    c[19] = sub ? (int)0x80000000 : mkkey(v1f[1] + v2f[3], 19, 255);
    c[20] = sub ? (int)0x80000000 : mkkey(v1f[1] + v2f[4], 20, 255);
    c[21] = sub ? (int)0x80000000 : mkkey(v1f[1] + v2f[5], 21, 255);
    c[22] = sub ? (int)0x80000000 : mkkey(v1f[1] + v2f[6], 22, 255);
    c[23] = sub ? (int)0x80000000 : mkkey(v1f[1] + v2f[7], 23, 255);
    c[24] = sub ? (int)0x80000000 : mkkey(v1f[2] + v2f[0], 32, 255);
    c[25] = sub ? (int)0x80000000 : mkkey(v1f[2] + v2f[1], 33, 255);
    c[26] = sub ? (int)0x80000000 : mkkey(v1f[2] + v2f[2], 34, 255);
    c[27] = sub ? (int)0x80000000 : mkkey(v1f[2] + v2f[3], 35, 255);
    c[28] = sub ? (int)0x80000000 : mkkey(v1f[2] + v2f[4], 36, 255);
    c[29] = sub ? (int)0x80000000 : mkkey(v1f[3] + v2f[0], 48, 255);
    c[30] = sub ? (int)0x80000000 : mkkey(v1f[3] + v2f[1], 49, 255);
    c[31] = sub ? (int)0x80000000 : mkkey(v1f[3] + v2f[2], 50, 255);
    int h0[16], h1[16];
#pragma unroll
    for (int i = 0; i < 16; ++i) { h0[i] = c[i]; h1[i] = c[16 + i]; }
    bitonic_sort_desc<16>(h0); bitonic_sort_desc<16>(h1);
    merge16(h0, h1);
    merge_partner(h0, 1);
    float sv[16];
#pragma unroll
    for (int i = 0; i < 16; ++i) sv[i] = __int_as_float(key2bits(h0[i]));
    float den = 0.f;
#pragma unroll
    for (int i = 0; i < 16; ++i) den += __expf(sv[i] - sv[0]);
    const float inv = 1.f / den;
    int eo[8]; float go[8];
#pragma unroll
    for (int i = 0; i < 8; ++i) {
      int klo = h0[i], khi = h0[8 + i];
      asm volatile("" : "+v"(klo), "+v"(khi));
      const int kk = sub ? khi : klo;
      const int bits = key2bits(kk);
      const int code = bits & 255;
      const int ia = key2bits(s_top[(size_t)tok * 16 + (code >> 4)]) & 127;
      const int ib = key2bits(s_top[(size_t)(128 + tok) * 16 + (code & 15)]) & 127;
      eo[i] = ia * 128 + ib;
      go[i] = __expf(__int_as_float(bits) - sv[0]) * inv;
    }
    const size_t ob = ((size_t)(n0 + tok) * 8 + head) * 16 + sub * 8;
    *(int4*)(p.eidx + ob) = make_int4(eo[0], eo[1], eo[2], eo[3]);
    *(int4*)(p.eidx + ob + 4) = make_int4(eo[4], eo[5], eo[6], eo[7]);
    *(float4*)(p.egate + ob) = make_float4(go[0], go[1], go[2], go[3]);
    *(float4*)(p.egate + ob + 4) = make_float4(go[4], go[5], go[6], go[7]);
  }
}

__device__ __forceinline__ void ph_subkeys(const Params& p) {
  for (int i = blockIdx.x * 256 + threadIdx.x; i < 2 * 128 * 64; i += gridDim.x * 256) {
    const float v = (i < 8192) ? p.sk1[i] : p.sk2[i - 8192];
    const ushort_t hi = f2bf(v);
    p.skh[i] = hi;
    p.skl[i] = f2bf(v - bf2f(hi));
  }
}

__device__ __forceinline__ float dot16_fp8(const uint4 d, const float (&x)[16], float c) {
  const unsigned w[4] = {d.x, d.y, d.z, d.w};
#pragma unroll
  for (int i = 0; i < 4; ++i) {
    const f32x2_t lo = __builtin_amdgcn_cvt_pk_f32_fp8((int)w[i], false);
    const f32x2_t hi = __builtin_amdgcn_cvt_pk_f32_fp8((int)w[i], true);
    c = fmaf(lo.x, x[4 * i], c); c = fmaf(lo.y, x[4 * i + 1], c); c = fmaf(hi.x, x[4 * i + 2], c); c = fmaf(hi.y, x[4 * i + 3], c);
  }
  return c;
}
__device__ __forceinline__ void axpy16_fp8(const float cf, const uint4 u, float (&acc)[16]) {
  const unsigned w[4] = {u.x, u.y, u.z, u.w};
#pragma unroll
  for (int i = 0; i < 4; ++i) {
    const f32x2_t lo = __builtin_amdgcn_cvt_pk_f32_fp8((int)w[i], false);
    const f32x2_t hi = __builtin_amdgcn_cvt_pk_f32_fp8((int)w[i], true);
    acc[4 * i] = fmaf(cf, lo.x, acc[4 * i]); acc[4 * i + 1] = fmaf(cf, lo.y, acc[4 * i + 1]);
    acc[4 * i + 2] = fmaf(cf, hi.x, acc[4 * i + 2]); acc[4 * i + 3] = fmaf(cf, hi.y, acc[4 * i + 3]);
  }
}
constexpr int EX_NTOK = 4;
__device__ __forceinline__ void peer_chunk(const Params& p, const int lane, const int myex, const bool b5, const bool b4, const bool b3,
                                           const int (&ce)[8], const float (&cg)[8], const f32x2_t (&x2)[8], f32x2_t (&acc2)[8]) {
  drow_t d[8];
  urow_t u[8];
  float sd[8], su[8];
#pragma unroll
  for (int i = 0; i < 8; ++i) d[i] = *(const drow_t*)(p.ed8 + ((size_t)ce[i] * 64 + lane) * DROW_BYTES);
#pragma unroll
  for (int i = 0; i < 8; ++i) u[i] = *(const urow_t*)(p.eu8 + ((size_t)ce[i] * 64 + lane) * UROW_BYTES);
#pragma unroll
  for (int i = 0; i < 8; ++i) { sd[i] = p.ed_s[ce[i]]; su[i] = p.eu_s[ce[i]] * cg[i]; }
  float pr[8];
#pragma unroll
  for (int i = 0; i < 8; ++i) {
    f32x2_t dd[8];
    DEC_D(d[i], dd);
    f32x2_t a2 = {0.f, 0.f};
#pragma unroll
    for (int k = 0; k < 8; ++k) a2 = dd[k] * x2[k] + a2;
    pr[i] = (a2.x + a2.y) * sd[i];
  }
  float q4[4];
#pragma unroll
  for (int i = 0; i < 4; ++i) {
    const float snd = b5 ? pr[i] : pr[i + 4];
    const float kp = b5 ? pr[i + 4] : pr[i];
    q4[i] = kp + __shfl_xor(snd, 32);
  }
  float q2[2];
#pragma unroll
  for (int i = 0; i < 2; ++i) {
    const float snd = b4 ? q4[i] : q4[i + 2];
    const float kp = b4 ? q4[i + 2] : q4[i];
    q2[i] = kp + __shfl_xor(snd, 16);
  }
  float q1;
  {
    const float snd = b3 ? q2[0] : q2[1];
    const float kp = b3 ? q2[1] : q2[0];
    q1 = kp + __shfl_xor(snd, 8);
  }
  q1 += __shfl_xor(q1, 4);
  q1 += __shfl_xor(q1, 2);
  q1 += __shfl_xor(q1, 1);
  const float act = gelu_f(q1);
#pragma unroll
  for (int i = 0; i < 8; ++i) {
    const int src = ((i >> 2) & 1) * 32 + ((i >> 1) & 1) * 16 + (i & 1) * 8;
    const float cf = __int_as_float(__builtin_amdgcn_readlane(__float_as_int(act), src)) * su[i];
    const f32x2_t cf2 = {cf, cf};
    f32x2_t uu[8];
    DEC_U(u[i], uu);
#pragma unroll
    for (int k = 0; k < 8; ++k) acc2[k] = cf2 * uu[k] + acc2[k];
  }
}

#ifndef EX_SWEEP
#define EX_SWEEP 0
#endif
#if !EX_SWEEP
typedef __attribute__((ext_vector_type(8))) int v8i_t;
typedef __attribute__((ext_vector_type(4))) float f32x4_t;
__device__ __forceinline__ void sort128(int& v0, int& v1, const int lane) {
#pragma unroll
  for (int k = 2; k <= 128; k <<= 1) {
#pragma unroll
    for (int j = k >> 1; j > 0; j >>= 1) {
      if (j == 1) {
        const bool up = ((lane * 2) & k) == 0;
        const int mn = min(v0, v1), mx = max(v0, v1);
        v0 = up ? mn : mx;
        v1 = up ? mx : mn;
      } else {
        const int o0 = __shfl_xor(v0, j >> 1), o1 = __shfl_xor(v1, j >> 1);
        const bool up = ((lane * 2) & k) == 0;
        const bool lower = ((lane * 2) & j) == 0;
        const bool takemin = (up == lower);
        v0 = takemin ? min(v0, o0) : max(v0, o0);
        v1 = takemin ? min(v1, o1) : max(v1, o1);
      }
    }
  }
}
__device__ __forceinline__ void k_peer_experts(const int VB, char* smem, const Params& p, const ushort_t* __restrict__ hn) {
  const int lane = threadIdx.x & 63;
  const int wave = __builtin_amdgcn_readfirstlane(threadIdx.x >> 6);
  const int t = VB * 4 + wave;
  const int li = lane & 15, g = lane >> 4;
  char* sx = smem + wave * 1024;
  {
    const float* hrow = p.out + (size_t)t * DM + lane * 16;
    const float* wrow = p.ffn_norm_w + lane * 16;
    float4 hv[4], wv[4];
#pragma unroll
    for (int i = 0; i < 4; ++i) { hv[i] = *(const float4*)(hrow + i * 4); wv[i] = *(const float4*)(wrow + i * 4); }
    float ss = 0.f;
#pragma unroll
    for (int i = 0; i < 4; ++i) ss += hv[i].x * hv[i].x + hv[i].y * hv[i].y + hv[i].z * hv[i].z + hv[i].w * hv[i].w;
    ss = wave_sum(ss);
    const float rs = rsqrtf(ss * (1.f / DM) + EPS) * 16.f;
    int wq[4];
#pragma unroll
    for (int i = 0; i < 4; ++i) {
      int w = 0;
      w = __builtin_amdgcn_cvt_pk_fp8_f32(hv[i].x * rs * wv[i].x, hv[i].y * rs * wv[i].y, w, false);
      w = __builtin_amdgcn_cvt_pk_fp8_f32(hv[i].z * rs * wv[i].z, hv[i].w * rs * wv[i].w, w, true);
      wq[i] = w;
    }
    *(int4*)(sx + lane * 16) = make_int4(wq[0], wq[1], wq[2], wq[3]);
  }
  v8i_t xb[8];
#pragma unroll
  for (int st = 0; st < 8; ++st) {
    const int4 lo = *(const int4*)(sx + st * 128 + g * 16);
    const int4 hi = *(const int4*)(sx + st * 128 + 64 + g * 16);
    xb[st] = v8i_t{lo.x, lo.y, lo.z, lo.w, hi.x, hi.y, hi.z, hi.w};
  }
  f32x2_t acc2[8];
#pragma unroll
  for (int i = 0; i < 8; ++i) acc2[i] = f32x2_t{0.f, 0.f};
  int kq0, kq1;
  {
    const int2 ev = *(const int2*)(p.eidx + (size_t)t * 128 + lane * 2);
    kq0 = (ev.x << 7) | (lane * 2);
    kq1 = (ev.y << 7) | (lane * 2 + 1);
    sort128(kq0, kq1, lane);
  }
  const int ev0 = kq0 >> 7, ev1 = kq1 >> 7;
  const float sdv0 = p.ed_s[ev0], sdv1 = p.ed_s[ev1];
  const float suv0 = p.eu_s[ev0] * p.egate[(size_t)t * 128 + (kq0 & 127)], suv1 = p.eu_s[ev1] * p.egate[(size_t)t * 128 + (kq1 & 127)];
#pragma unroll 1
  for (int c = 0; c < 8; ++c) {
    const int lbase = c * 8;
    const int ea = __shfl(ev0, lbase + (li >> 1)), eb = __shfl(ev1, lbase + (li >> 1));
    const int e_lane = (li & 1) ? eb : ea;
    const unsigned char* arow = p.ed8 + (size_t)e_lane * 512 + g * 16;
    uint4 a[8];
#pragma unroll
    for (int st = 0; st < 8; ++st) a[st] = *(const uint4*)(arow + st * 64);
    urow_t u[16];
#pragma unroll
    for (int i = 0; i < 16; ++i) {
      const int ei_s = __builtin_amdgcn_readlane((i & 1) ? ev1 : ev0, lbase + (i >> 1));
      u[i] = *(const urow_t*)(p.eu8 + ((size_t)ei_s * 64 + lane) * UROW_BYTES);
    }
    const int mrow = 4 * g + (li & 3);
    const float sda = __shfl(sdv0, lbase + (mrow >> 1)), sdb = __shfl(sdv1, lbase + (mrow >> 1));
    const float sua = __shfl(suv0, lbase + (mrow >> 1)), sub = __shfl(suv1, lbase + (mrow >> 1));
    const float sd_m = (mrow & 1) ? sdb : sda, su_m = (mrow & 1) ? sub : sua;
    f32x4_t d4 = {0.f, 0.f, 0.f, 0.f};
#pragma unroll
    for (int st = 0; st < 8; ++st) {
      const v8i_t av = v8i_t{(int)a[st].x, (int)a[st].y, (int)a[st].z, (int)a[st].w, 0, 0, 0, 0};
      d4 = __builtin_amdgcn_mfma_scale_f32_16x16x128_f8f6f4(av, xb[st], d4, 4, 0, 0, 0x7f7f7f7f, 0, 0x7f7f7f7f);
    }
    const int rsel = li & 3;
    const float dsel = rsel == 0 ? d4[0] : rsel == 1 ? d4[1] : rsel == 2 ? d4[2] : d4[3];
    const float cvs = gelu_fast(dsel * sd_m * 0.0625f) * su_m;
#pragma unroll
    for (int i = 0; i < 16; ++i) {
      const float cf = __int_as_float(__builtin_amdgcn_readlane(__float_as_int(cvs), 16 * (i >> 2) + (i & 3)));
      const f32x2_t cf2 = {cf, cf};
      f32x2_t uu[8];
      DEC_U(u[i], uu);
#pragma unroll
      for (int k = 0; k < 8; ++k) acc2[k] = cf2 * uu[k] + acc2[k];
    }
  }
  float* orow = p.out + (size_t)t * DM + lane * 16;
#pragma unroll
  for (int i = 0; i < 4; ++i) {
    float4 hv = *(float4*)(orow + i * 4);
    hv.x += acc2[2 * i].x; hv.y += acc2[2 * i].y; hv.z += acc2[2 * i + 1].x; hv.w += acc2[2 * i + 1].y;
    *(float4*)(orow + i * 4) = hv;
  }
}
#define EX_TOK_PER_VB 4
#else
#define EX_TOK_PER_VB (4 * EX_NTOK)
__device__ __forceinline__ void k_peer_experts(const int VB, const Params& p, const ushort_t* __restrict__ hn) {
  const int lane = threadIdx.x & 63;
  const int wave = __builtin_amdgcn_readfirstlane(threadIdx.x >> 6);
  const int t0 = (VB * 4 + wave) * EX_NTOK;
  const int myex = ((lane >> 5) & 1) * 4 + ((lane >> 4) & 1) * 2 + ((lane >> 3) & 1);
  const bool b5 = (lane & 32) != 0, b4 = (lane & 16) != 0, b3 = (lane & 8) != 0;
  f32x2_t x2[EX_NTOK][8], acc2[EX_NTOK][8];
  int e0[EX_NTOK], e1[EX_NTOK];
  float g0[EX_NTOK], g1[EX_NTOK];
#pragma unroll
  for (int k = 0; k < EX_NTOK; ++k) {
    float f0[8], f1[8];
    unpack8(*(const uint4*)(hn + (size_t)(t0 + k) * DM + lane * 16), f0);
    unpack8(*(const uint4*)(hn + (size_t)(t0 + k) * DM + lane * 16 + 8), f1);
#pragma unroll
    for (int i = 0; i < 4; ++i) {
      x2[k][i] = f32x2_t{f0[2 * i], f0[2 * i + 1]};
      x2[k][4 + i] = f32x2_t{f1[2 * i], f1[2 * i + 1]};
    }
#pragma unroll
    for (int i = 0; i < 8; ++i) acc2[k][i] = f32x2_t{0.f, 0.f};
    e0[k] = p.eidx[(size_t)(t0 + k) * 128 + lane];
    e1[k] = p.eidx[(size_t)(t0 + k) * 128 + 64 + lane];
    g0[k] = p.egate[(size_t)(t0 + k) * 128 + lane];
    g1[k] = p.egate[(size_t)(t0 + k) * 128 + 64 + lane];
  }
#pragma unroll 1
  for (int s = 0; s < 16; ++s) {
#pragma unroll
    for (int k = 0; k < EX_NTOK; ++k) {
      unsigned long long m0 = __ballot((e0[k] >> 10) == s);
      unsigned long long m1 = __ballot((e1[k] >> 10) == s);
      while ((m0 | m1) != 0ull) {
        int ce[8];
        float cg[8];
#pragma unroll
        for (int i = 0; i < 8; ++i) {
          int ev = 0;
          float gv = 0.f;
          if (m0 != 0ull) {
            const int ln = __builtin_ctzll(m0);
            m0 &= m0 - 1ull;
            ev = __builtin_amdgcn_readlane(e0[k], ln);
            gv = __int_as_float(__builtin_amdgcn_readlane(__float_as_int(g0[k]), ln));
          } else if (m1 != 0ull) {
            const int ln = __builtin_ctzll(m1);
            m1 &= m1 - 1ull;
            ev = __builtin_amdgcn_readlane(e1[k], ln);
            gv = __int_as_float(__builtin_amdgcn_readlane(__float_as_int(g1[k]), ln));
          }
          ce[i] = ev;
          cg[i] = gv;
        }
        peer_chunk(p, lane, myex, b5, b4, b3, ce, cg, x2[k], acc2[k]);
      }
    }
  }
#pragma unroll
  for (int k = 0; k < EX_NTOK; ++k) {
    float* orow = p.out + (size_t)(t0 + k) * DM + lane * 16;
#pragma unroll
    for (int i = 0; i < 4; ++i) {
      float4 hv = *(float4*)(orow + i * 4);
      hv.x += acc2[k][2 * i].x; hv.y += acc2[k][2 * i].y; hv.z += acc2[k][2 * i + 1].x; hv.w += acc2[k][2 * i + 1].y;
      *(float4*)(orow + i * 4) = hv;
    }
  }
}

#endif

#define PHASE(NBLK, CALL) \
  for (int VB = blockIdx.x; VB < (NBLK); VB += gridDim.x) { CALL; __syncthreads(); }
#define PHASE_NS(NBLK, CALL) \
  for (int VB = blockIdx.x; VB < (NBLK); VB += gridDim.x) { CALL; }
#define PHASE_OFF(OFF, NBLK, CALL) \
  for (int VB = (int)((blockIdx.x + gridDim.x - ((OFF) % gridDim.x)) % gridDim.x); VB < (NBLK); VB += gridDim.x) { CALL; __syncthreads(); }

__global__ __launch_bounds__(256, 2) void fwd_megakernel(Params p) {
  __shared__ __attribute__((aligned(16))) char smem_raw[SMEM_BYTES];
  float* smem = (float*)smem_raw;
  volatile LAS unsigned* xb_st = (volatile LAS unsigned*)(smem_raw + 73728);
  if (threadIdx.x == 0) { xb_st[0] = 0u; xb_st[1] = 0u; xb_st[2] = 0u; xb_st[3] = 0u; }
  __syncthreads();
  const XcdBarrier xb = xcd_barrier_post(p.bar, xb_st);
  {
    for (int k = threadIdx.x; k < DM; k += 256) {
      const float* wr = p.w_in + (size_t)k * INC + 1536;
      const float4 a = *(const float4*)(wr), b = *(const float4*)(wr + 4);
      smem[0 * 1024 + k] = a.x; smem[1 * 1024 + k] = a.y; smem[2 * 1024 + k] = a.z; smem[3 * 1024 + k] = a.w;
      smem[4 * 1024 + k] = b.x; smem[5 * 1024 + k] = b.y; smem[6 * 1024 + k] = b.z; smem[7 * 1024 + k] = b.w;
    }
    __syncthreads();
    PHASE_NS(NT / 8, ph_rmsnorm_bf16(VB, p.x, p.mix_norm_w, p.xn_b, smem, p.dt_bias, p.dt));
    __syncthreads();
  }
  PHASE_NS(NB * MEM / 8, ph_rmsnorm_bf16(VB, p.mem, p.mem_norm_w, p.memn_b, nullptr, nullptr, nullptr));
  PHASE(16 * 40, ph_wtrans(VB, smem, p.w_in, INC, p.w_inT, 40, 8, nullptr));
  PHASE(16 * 16, ph_wtrans(VB, smem, p.w_out, DM, p.w_outT, 16, 0, nullptr));
  PHASE(16 * 16, ph_wtrans(VB, smem, p.w_query, DM, p.w_qT, 16, 0, p.ffn_norm_w));
  PHASE(16 * 8, ph_wtrans(VB, smem, p.w_mem_kv, 512, p.w_memT, 8, 0, nullptr));
  if (blockIdx.x == 0) p.bcnt[threadIdx.x] = 0;
  ph_subkeys(p);
  xcd_barrier(xb);
  PHASE(20 * (NT / 128), ph_gemm_proj(VB, smem_raw, p));
  xcd_barrier(xb);
  PHASE(NB * 64 * 8, ph_ssd1(VB, smem_raw, p));
  PHASE(NB * 4 * 32, k_gate(VB, smem_raw, p));
  PHASE_OFF(256, 4 * (NB * MEM / 128), ph_gemm_mem(VB, smem_raw, p));
  xcd_barrier(xb);
  PHASE_NS(NB * 8 * 64 * 128 / 256, ph_ssd2(VB, p));
  {
    int* s_pref = (int*)(smem_raw + 72192);
    {
      const int tid = threadIdx.x;
      int v = (p.bcnt[tid] + 127) >> 7;
      const int lane = tid & 63;
#pragma unroll
      for (int o = 1; o < 64; o <<= 1) { int nb = __shfl_up(v, o); if (lane >= o) v += nb; }
      int* s_wt = s_pref + 256;
      if (lane == 63) s_wt[tid >> 6] = v;
      __syncthreads();
      int add = 0;
      for (int ww = 0; ww < (tid >> 6); ++ww) add += s_wt[ww];
      s_pref[tid] = v + add;
      __syncthreads();
    }
    const int Ug = s_pref[255];
    ph_attn_units(smem_raw, p, Ug, s_pref);
    __syncthreads();
  }
  xcd_barrier(xb);
  PHASE(NB * 64 * 2, ph_ssd3(VB, smem_raw, p));
  if (gridDim.x >= 512) {
    for (int VB = (int)blockIdx.x - 256; VB >= 0 && VB < NT * 4 * 8 / 256; VB += gridDim.x - 256) ph_attn_combine(VB, p);
  } else {
    PHASE_NS(NT * 4 * 8 / 256, ph_attn_combine(VB, p));
  }
  xcd_barrier(xb);
  PHASE(8 * (NT / 128), ph_gemm_f32(VB, smem_raw, p.mixed_b, p.w_outT, p.out, p.x, p.xn_b, p.hss));
  xcd_barrier(xb);
  ushort_t* hn_b = p.xn_b;
  {
    int cv = blockIdx.x;
    for (int VB = blockIdx.x; VB < 8 * (NT / 128); VB += gridDim.x) {
      ph_gemm_route(VB, smem_raw, p, hn_b);
      __syncthreads();
      for (int i = 0; i < 8 && cv < 8192; ++i, cv += gridDim.x) {
        if (cv < 4096) {
#if EX_FP4_DOWN
          ph_cvt4(cv, p.e_down, p.ed8, p.ed_s);
#else
          ph_cvt8(cv, p.e_down, p.ed8, p.ed_s);
#endif
        } else {
#if EX_FP4_UP
          ph_cvt4(cv - 4096, p.e_up, p.eu8, p.eu_s);
#else
          ph_cvt8(cv - 4096, p.e_up, p.eu8, p.eu_s);
#endif
        }
      }
    }
    for (; cv < 8192; cv += gridDim.x) {
      if (cv < 4096) {
#if EX_FP4_DOWN
        ph_cvt4(cv, p.e_down, p.ed8, p.ed_s);
#else
        ph_cvt8(cv, p.e_down, p.ed8, p.ed_s);
#endif
      } else {
#if EX_FP4_UP
        ph_cvt4(cv - 4096, p.e_up, p.eu8, p.eu_s);
#else
        ph_cvt8(cv - 4096, p.e_up, p.eu8, p.eu_s);
#endif
      }
    }
  }
  xcd_barrier(xb);
  PHASE_NS(NT / EX_TOK_PER_VB, k_peer_experts(VB, smem_raw, p, hn_b));
}
}

extern "C" void kernel_launch(void* const* d_in, const int* in_sizes, int n_in, void* d_out, int out_size, void* d_ws, size_t ws_size,
                              hipStream_t stream) {
  Params p{};
  p.x = (const float*)d_in[0]; p.mem = (const float*)d_in[1]; p.mix_norm_w = (const float*)d_in[2]; p.w_in = (const float*)d_in[3];
  p.conv_w = (const float*)d_in[4]; p.conv_b = (const float*)d_in[5]; p.dt_bias = (const float*)d_in[6]; p.a_log = (const float*)d_in[7];
  p.ssd_d = (const float*)d_in[8]; p.ssd_norm_w = (const float*)d_in[9]; p.mq_norm_w = (const float*)d_in[10]; p.mk_norm_w = (const float*)d_in[11];
  p.mem_norm_w = (const float*)d_in[12]; p.w_mem_kv = (const float*)d_in[13]; p.xq_norm_w = (const float*)d_in[14]; p.xk_norm_w = (const float*)d_in[15];
  p.w_out = (const float*)d_in[16]; p.ffn_norm_w = (const float*)d_in[17]; p.w_query = (const float*)d_in[18]; p.sk1 = (const float*)d_in[19];
  p.sk2 = (const float*)d_in[20]; p.e_down = (const float*)d_in[21]; p.e_up = (const float*)d_in[22];
  p.out = (float*)d_out;
  char* ws = (char*)d_ws;
  size_t o = 0;
  auto take = [&](size_t bytes) { char* q = ws + o; o += (bytes + 255) & ~(size_t)255; return q; };
  p.xn_b = (ushort_t*)take((size_t)NT * DM * 2);
  p.xc = p.xn_b;
  p.w_inT = (ushort_t*)take((size_t)NPROJ * DM * 2);
  p.w_outT = (ushort_t*)take((size_t)DM * DM * 2);
  p.w_qT = (ushort_t*)take((size_t)DM * DM * 2);
  p.w_memT = (ushort_t*)take((size_t)512 * DM * 2);
  p.memn_b = (ushort_t*)take((size_t)NB * MEM * DM * 2);
  p.memk_b = (ushort_t*)take((size_t)NB * MEM * 256 * 2);
  p.memvT = (ushort_t*)take((size_t)NB * MEM * 256 * 2);
  char* regQ = take((size_t)NT * 2560 * 2);
  p.zs = (ushort_t*)regQ;
  p.xbc_raw = (ushort_t*)(regQ + (size_t)NT * 512 * 2);
  p.mq = (ushort_t*)(regQ + (size_t)NT * 1536 * 2);
  p.mk = (ushort_t*)(regQ + (size_t)NT * 1792 * 2);
  p.vT = (ushort_t*)(regQ + (size_t)NT * 2048 * 2);
  p.xq = (ushort_t*)(regQ + (size_t)NT * 2304 * 2);
  p.q = (float*)regQ;
  p.dt = (float*)take((size_t)NT * 8 * 4);
  p.acs = (float*)take((size_t)NT * 8 * 4);
  p.cdec = (float*)take((size_t)NB * 64 * 8 * 4);
  p.states = (float*)d_out;
  p.sin_b = (ushort_t*)((char*)d_out + (size_t)NB * 64 * 8 * 8192 * 4);
  p.xT = (ushort_t*)((char*)d_out + (size_t)NB * 64 * 8 * 8192 * 6);
  p.mixed_b = (ushort_t*)take((size_t)NT * DM * 2);
  p.kpart = (float*)take((size_t)NB * 4 * 32 * 4 * 64 * 4);
  p.bcnt = (int*)take(256 * 4);
  p.blist = (int*)take((size_t)256 * 8192 * 4);
  p.pm = (float*)take((size_t)NT * 16 * 4);
  p.pl = (float*)take((size_t)NT * 16 * 4);
  p.pO = p.xbc_raw;
  p.eidx = (int*)take((size_t)NT * 128 * 4);
  p.egate = (float*)take((size_t)NT * 128 * 4);
  p.ed8 = (unsigned char*)take((size_t)16384 * DM);
  p.eu8 = (unsigned char*)take((size_t)16384 * DM);
  p.ed_s = (float*)take(16384 * 4);
  p.eu_s = (float*)take(16384 * 4);
  p.bar = (unsigned*)take(XCD_BAR_WORDS * 4);
  p.hss = (float*)take((size_t)NT * 16 * 4);
  p.skh = (ushort_t*)take(2 * 128 * 64 * 2);
  p.skl = (ushort_t*)take(2 * 128 * 64 * 2);
  if (o > ws_size) return;
  (void)hipMemsetAsync(p.bar, 0, XCD_BAR_WORDS * 4, stream);
  static int grid_blocks = 0;
  if (!grid_blocks) {
    int dev = 0, cus = 0, per_cu = 0;
    (void)hipGetDevice(&dev);
    (void)hipDeviceGetAttribute(&cus, hipDeviceAttributeMultiprocessorCount, dev);
    (void)hipOccupancyMaxActiveBlocksPerMultiprocessor(&per_cu, fwd_megakernel, 256, 0);
    if (per_cu > 2) per_cu = 2;
    if (per_cu < 1) per_cu = 1;
    grid_blocks = cus * per_cu;
  }
  void* args[] = {&p};
  hipError_t e = hipLaunchCooperativeKernel((void*)fwd_megakernel, dim3(grid_blocks), dim3(256), args, 0, stream);
  if (e != hipSuccess) fprintf(stderr, "cooperative launch failed: %s (grid %d)\n", hipGetErrorString(e), grid_blocks);
}
```

```cpp
#include <hip/hip_runtime.h>
#include <hip/hip_cooperative_groups.h>
#include <cstdio>
#include <math.h>
#include <stdint.h>
namespace cg = cooperative_groups;

#ifndef EX_FP4_DOWN
#define EX_FP4_DOWN 1
#endif
#ifndef EX_FP4_UP
#define EX_FP4_UP 1
#endif
namespace {
typedef unsigned short ushort_t;
typedef __attribute__((ext_vector_type(8))) short bf16x8;
typedef __attribute__((ext_vector_type(16))) float f32x16;

constexpr int DM = 1024;
constexpr int NB = 2;
constexpr int SL = 8192;
constexpr int NT = NB * SL;
constexpr int MEM = 256;
constexpr int INC = 2568;
constexpr int NPROJ = 2560;
constexpr float EPS = 1e-6f;
constexpr int SMEM_BYTES = 73728 + 256;

typedef __attribute__((ext_vector_type(4))) float f32x4_nt;
__device__ __forceinline__ float4 ld_nt4(const float* ptr) {
  const f32x4_nt v = __builtin_nontemporal_load((const f32x4_nt*)ptr);
  return make_float4(v.x, v.y, v.z, v.w);
}
__device__ __forceinline__ float silu_f(float x) { return x * __frcp_rn(1.f + __expf(-x)); }
__device__ __forceinline__ float softplus_f(float x) { return fmaxf(x, 0.f) + log1pf(expf(-fabsf(x))); }
__device__ __forceinline__ float gelu_f(float x) { return 0.5f * x * (1.f + erff(x * 0.70710678118654752f)); }
__device__ __forceinline__ float gelu_fast(float x) {
  const float z = fabsf(x) * 0.70710678118654752f;
  const float t = __frcp_rn(fmaf(0.3275911f, z, 1.f));
  float pl = fmaf(1.061405429f, t, -1.453152027f);
  pl = fmaf(pl, t, 1.421413741f);
  pl = fmaf(pl, t, -0.284496736f);
  pl = fmaf(pl, t, 0.254829592f);
  const float er = 1.f - pl * t * __expf(-z * z);
  return 0.5f * x * (1.f + copysignf(er, x));
}
typedef __attribute__((ext_vector_type(2))) __bf16 bf16x2_hw;
typedef __attribute__((ext_vector_type(2))) float f32x2_hw;
__device__ __forceinline__ unsigned pack2(float a, float b) {
  const f32x2_hw v = {a, b};
  return __builtin_bit_cast(unsigned, __builtin_convertvector(v, bf16x2_hw));
}
__device__ __forceinline__ ushort_t f2bf(float x) { return (ushort_t)(pack2(x, 0.f) & 0xffffu); }
__device__ __forceinline__ float bf2f(ushort_t h) { return __uint_as_float(((unsigned)h) << 16); }
__device__ __forceinline__ float bflo(unsigned w) { return __uint_as_float(w << 16); }
__device__ __forceinline__ float bfhi(unsigned w) { return __uint_as_float(w & 0xffff0000u); }

__device__ __forceinline__ void unpack8(const uint4 v, float (&f)[8]) {
  f[0] = bflo(v.x); f[1] = bfhi(v.x); f[2] = bflo(v.y); f[3] = bfhi(v.y);
  f[4] = bflo(v.z); f[5] = bfhi(v.z); f[6] = bflo(v.w); f[7] = bfhi(v.w);
}

__device__ __forceinline__ float wave_sum(float v) {
#pragma unroll
  for (int o = 32; o > 0; o >>= 1) v += __shfl_xor(v, o);
  return v;
}
__device__ __forceinline__ float wave_max(float v) {
#pragma unroll
  for (int o = 32; o > 0; o >>= 1) v = fmaxf(v, __shfl_xor(v, o));
  return v;
}


#define XB_TMO      128
#define XB_XCNT(j)  (256  + 64 * (j))
#define XB_XSUB(j)  (1280 + 64 * (j))
#define XB_XGEN(j)  (2304 + 64 * (j))
#define XB_TOP      3328
#define XB_TOPGEN   3392
#define XCD_BAR_WORDS 3456
#define XB_SPIN_CAP (1u << 20)
#define LAS __attribute__((address_space(3)))
__device__ __forceinline__ unsigned xb_ld(unsigned* p)              { return __hip_atomic_load(p, __ATOMIC_RELAXED, __HIP_MEMORY_SCOPE_AGENT); }
__device__ __forceinline__ unsigned xb_add(unsigned* p, unsigned v) { return __hip_atomic_fetch_add(p, v, __ATOMIC_RELAXED, __HIP_MEMORY_SCOPE_AGENT); }
__device__ __forceinline__ unsigned xb_xcc_id() { return (unsigned)__builtin_amdgcn_s_getreg((3 << 11) | 20) & 0xFu; }
#define XB_SPIN(cond, bar) do { unsigned _sp = 0; while (cond) { __builtin_amdgcn_s_sleep(1); \
    if ((++_sp & 255u) == 0u) { if (xb_ld(&(bar)[XB_TMO])) break; if (_sp > XB_SPIN_CAP) { atomicAdd(&(bar)[XB_TMO], 1u); break; } } } } while (0)
struct XcdBarrier { unsigned* bar; unsigned x; volatile LAS unsigned* st; };
__device__ __forceinline__ XcdBarrier xcd_barrier_post(unsigned* bar, volatile LAS unsigned* st) {
  XcdBarrier b; b.bar = bar; b.x = xb_xcc_id(); b.st = st;
  if (threadIdx.x == 0) (void)xb_add(&bar[XB_XCNT(b.x)], 1u);
  return b;
}
__device__ __forceinline__ void xcd_barrier_complete(unsigned* bar, unsigned x, unsigned& nloc, unsigned& nx) {
  const unsigned G = gridDim.x * gridDim.y * gridDim.z;
  unsigned sum, cnt, mine, sp = 0u;
  for (;;) {
    sum = 0u; cnt = 0u; mine = 0u;
#pragma unroll
    for (unsigned j = 0; j < 16; ++j) { const unsigned c = xb_ld(&bar[XB_XCNT(j)]); sum += c; cnt += (c > 0u) ? 1u : 0u; mine = (j == x) ? c : mine; }
    if (sum == G) break;
    __builtin_amdgcn_s_sleep(1);
    if ((++sp & 255u) == 0u) { if (xb_ld(&bar[XB_TMO])) break; if (sp > XB_SPIN_CAP) { atomicAdd(&bar[XB_TMO], 1u); break; } }
  }
  nloc = mine > 0u ? mine : 1u; nx = cnt > 0u ? cnt : 1u;
}
__device__ __forceinline__ void xcd_barrier(const XcdBarrier& b) {
  asm volatile("s_waitcnt vmcnt(0)" ::: "memory");
  __syncthreads();
  if (threadIdx.x == 0) {
    unsigned* bar = b.bar;
    __builtin_amdgcn_s_waitcnt(0);
    unsigned nloc = b.st[0], nx = b.st[1];
    if (nloc == 0u) { xcd_barrier_complete(bar, b.x, nloc, nx); b.st[0] = nloc; b.st[1] = nx; }
    const unsigned old = xb_add(&bar[XB_XSUB(b.x)], 1u);
    const unsigned gen = old / nloc;
    if (old + 1u == (gen + 1u) * nloc) {
      __builtin_amdgcn_fence(__ATOMIC_RELEASE, "agent");
      asm volatile("s_waitcnt vmcnt(0)" ::: "memory");
      const unsigned og = xb_add(&bar[XB_TOP], 1u);
      const unsigned tg = og / nx;
      if (og + 1u == (tg + 1u) * nx) xb_add(&bar[XB_TOPGEN], 1u);
      else XB_SPIN(xb_ld(&bar[XB_TOPGEN]) == tg, bar);
      __builtin_amdgcn_fence(__ATOMIC_ACQUIRE, "agent");
      xb_add(&bar[XB_XGEN(b.x)], 1u);
      asm volatile("s_waitcnt vmcnt(0)" ::: "memory");
    } else {
      XB_SPIN(xb_ld(&bar[XB_XGEN(b.x)]) == gen, bar);
      __builtin_amdgcn_fence(__ATOMIC_ACQUIRE, "agent");
      asm volatile("s_waitcnt vmcnt(0)" ::: "memory");
    }
  }
  __syncthreads();
}

struct Params {
  const float *x, *mem, *mix_norm_w, *w_in, *conv_w, *conv_b, *dt_bias, *a_log, *ssd_d, *ssd_norm_w, *mq_norm_w, *mk_norm_w,
      *mem_norm_w, *w_mem_kv, *xq_norm_w, *xk_norm_w, *w_out, *ffn_norm_w, *w_query, *sk1, *sk2, *e_down, *e_up;
  float* out;
  ushort_t *xn_b, *w_inT, *w_outT, *w_qT, *w_memT, *memn_b, *zs, *xbc_raw, *mq, *mk, *xq, *memk_b, *mixed_b;
  float *dt, *q, *egate, *acs, *cdec, *states;
  ushort_t *xc, *xT, *sin_b;
  int *eidx, *bcnt, *blist;
  unsigned* bar;
  float* hss;
  ushort_t *skh, *skl;
  unsigned char *ed8, *eu8;
  float *ed_s, *eu_s;
  float *kpart, *pm, *pl;
  ushort_t *vT, *memvT, *pO;
};

__device__ __forceinline__ void ph_rmsnorm_bf16(const int vb, const float* __restrict__ x, const float* __restrict__ w,
                                                ushort_t* __restrict__ outb, const float* s_wdt  , const float* __restrict__ dt_bias,
                                                float* __restrict__ dt) {
  const int lane = threadIdx.x & 63;
  const int row0 = vb * 8 + (threadIdx.x >> 6) * 2;
  float4 v[2][4];
#pragma unroll
  for (int rr = 0; rr < 2; ++rr)
#pragma unroll
    for (int i = 0; i < 4; ++i) v[rr][i] = ld_nt4(x + (size_t)(row0 + rr) * DM + i * 256 + lane * 4);
  float4 ww[4];
#pragma unroll
  for (int i = 0; i < 4; ++i) ww[i] = *(const float4*)(w + i * 256 + lane * 4);
#pragma unroll
  for (int rr = 0; rr < 2; ++rr) {
    const int row = row0 + rr;
    float ss = 0.f;
#pragma unroll
    for (int i = 0; i < 4; ++i) ss += v[rr][i].x * v[rr][i].x + v[rr][i].y * v[rr][i].y + v[rr][i].z * v[rr][i].z + v[rr][i].w * v[rr][i].w;
    ss = wave_sum(ss);
    const float r = rsqrtf(ss / DM + EPS);
    float part[8];
#pragma unroll
    for (int hh = 0; hh < 8; ++hh) part[hh] = 0.f;
#pragma unroll
    for (int i = 0; i < 4; ++i) {
      const float o0 = v[rr][i].x * r * ww[i].x, o1 = v[rr][i].y * r * ww[i].y, o2 = v[rr][i].z * r * ww[i].z, o3 = v[rr][i].w * r * ww[i].w;
      *(uint2*)(outb + (size_t)row * DM + i * 256 + lane * 4) = make_uint2(pack2(o0, o1), pack2(o2, o3));
      if (dt) {
        const float xs[4] = {o0, o1, o2, o3};
#pragma unroll
        for (int hh = 0; hh < 8; ++hh) {
          const float4 wv = *(const float4*)(s_wdt + hh * 1024 + i * 256 + lane * 4);
          part[hh] = fmaf(xs[0], wv.x, part[hh]); part[hh] = fmaf(xs[1], wv.y, part[hh]);
          part[hh] = fmaf(xs[2], wv.z, part[hh]); part[hh] = fmaf(xs[3], wv.w, part[hh]);
        }
      }
    }
    if (dt) {
      float mine = 0.f;
#pragma unroll
      for (int hh = 0; hh < 8; ++hh) {
        const float sfull = wave_sum(part[hh]);
        if (lane == hh) mine = sfull;
      }
      if (lane < 8) dt[(size_t)row * 8 + lane] = softplus_f(mine + dt_bias[lane]);
    }
  }
}

__device__ __forceinline__ void ph_wtrans(const int vb, float* smem, const float* __restrict__ W, const int ldw, ushort_t* __restrict__ Wt,
                                          const int ntiles, const int skip, const float* __restrict__ rowscale) {
  float (*s)[65] = (float (*)[65])smem;
  const int tid = threadIdx.x;
  const int kt = vb / ntiles, nt = vb % ntiles;
  const int nd0 = nt * 64;
  const int ns0 = (nd0 < 1536) ? nd0 : nd0 + skip;
  {
    const int k = tid >> 2, nc = (tid & 3) * 16;
    const float* src = W + (size_t)(kt * 64 + k) * ldw + ns0 + nc;
    const float rsc = rowscale ? rowscale[kt * 64 + k] : 1.f;
#pragma unroll
    for (int j = 0; j < 4; ++j) {
      float4 v = *(const float4*)(src + j * 4);
      v.x *= rsc; v.y *= rsc; v.z *= rsc; v.w *= rsc;
      s[k][nc + j * 4 + 0] = v.x; s[k][nc + j * 4 + 1] = v.y; s[k][nc + j * 4 + 2] = v.z; s[k][nc + j * 4 + 3] = v.w;
    }
  }
  __syncthreads();
  {
    const int n = tid >> 2, kc = (tid & 3) * 16;
    unsigned pk[8];
#pragma unroll
    for (int j = 0; j < 8; ++j) pk[j] = pack2(s[kc + 2 * j][n], s[kc + 2 * j + 1][n]);
    ushort_t* dst = Wt + (size_t)(nd0 + n) * DM + kt * 64 + kc;
    *(uint4*)(dst) = make_uint4(pk[0], pk[1], pk[2], pk[3]);
    *(uint4*)(dst + 8) = make_uint4(pk[4], pk[5], pk[6], pk[7]);
  }
}

__device__ __forceinline__ void ph_cvt(const int vb, const float* __restrict__ src, ushort_t* __restrict__ dst) {
  const size_t base = (size_t)vb * 8192 + threadIdx.x * 8;
  float4 a[4], b[4];
#pragma unroll
  for (int i = 0; i < 4; ++i) {
    a[i] = *(const float4*)(src + base + i * 2048);
    b[i] = *(const float4*)(src + base + i * 2048 + 4);
  }
#pragma unroll
  for (int i = 0; i < 4; ++i)
    *(uint4*)(dst + base + i * 2048) = make_uint4(pack2(a[i].x, a[i].y), pack2(a[i].z, a[i].w), pack2(b[i].x, b[i].y), pack2(b[i].z, b[i].w));
}


typedef __attribute__((ext_vector_type(2))) float f32x2_t;
__device__ __forceinline__ void ph_cvt8(const int vb, const float* __restrict__ src, unsigned char* __restrict__ dst, float* __restrict__ inv_scale) {
  const int lane = threadIdx.x & 63;
  const int row = vb * 4 + (threadIdx.x >> 6);
  const float* sr = src + (size_t)row * DM + lane * 16;
  float4 v[4];
#pragma unroll
  for (int i = 0; i < 4; ++i) v[i] = ld_nt4(sr + i * 4);
  float am = 0.f;
#pragma unroll
  for (int i = 0; i < 4; ++i) am = fmaxf(fmaxf(fmaxf(am, fabsf(v[i].x)), fmaxf(fabsf(v[i].y), fabsf(v[i].z))), fabsf(v[i].w));
  am = wave_max(am);
  const float sc = (am > 0.f) ? 224.f / am : 1.f;
  unsigned w[4];
#pragma unroll
  for (int i = 0; i < 4; ++i) {
    int t = 0;
    t = __builtin_amdgcn_cvt_pk_fp8_f32(v[i].x * sc, v[i].y * sc, t, false);
    t = __builtin_amdgcn_cvt_pk_fp8_f32(v[i].z * sc, v[i].w * sc, t, true);
    w[i] = (unsigned)t;
  }
  *(uint4*)(dst + (size_t)row * DM + lane * 16) = make_uint4(w[0], w[1], w[2], w[3]);
  if (lane == 0) inv_scale[row] = (am > 0.f) ? am * (1.f / 224.f) : 1.f;
}

__device__ __forceinline__ void ph_cvt4(const int vb, const float* __restrict__ src, unsigned char* __restrict__ dst, float* __restrict__ inv_scale) {
  const int lane = threadIdx.x & 63;
  const int row = vb * 4 + (threadIdx.x >> 6);
  const float* sr = src + (size_t)row * DM + lane * 16;
  float4 v[4];
#pragma unroll
  for (int i = 0; i < 4; ++i) v[i] = ld_nt4(sr + i * 4);
  float am = 0.f;
#pragma unroll
  for (int i = 0; i < 4; ++i) am = fmaxf(fmaxf(fmaxf(am, fabsf(v[i].x)), fmaxf(fabsf(v[i].y), fabsf(v[i].z))), fabsf(v[i].w));
  am = wave_max(am);
  const float sc = (am > 0.f) ? 6.f / am : 1.f;
  unsigned w0 = 0u, w1 = 0u;
  w0 = __builtin_amdgcn_cvt_scalef32_pk_fp4_f32(w0, v[0].x * sc, v[0].y * sc, 1.0f, 0);
  w0 = __builtin_amdgcn_cvt_scalef32_pk_fp4_f32(w0, v[0].z * sc, v[0].w * sc, 1.0f, 1);
  w0 = __builtin_amdgcn_cvt_scalef32_pk_fp4_f32(w0, v[1].x * sc, v[1].y * sc, 1.0f, 2);
  w0 = __builtin_amdgcn_cvt_scalef32_pk_fp4_f32(w0, v[1].z * sc, v[1].w * sc, 1.0f, 3);
  w1 = __builtin_amdgcn_cvt_scalef32_pk_fp4_f32(w1, v[2].x * sc, v[2].y * sc, 1.0f, 0);
  w1 = __builtin_amdgcn_cvt_scalef32_pk_fp4_f32(w1, v[2].z * sc, v[2].w * sc, 1.0f, 1);
  w1 = __builtin_amdgcn_cvt_scalef32_pk_fp4_f32(w1, v[3].x * sc, v[3].y * sc, 1.0f, 2);
  w1 = __builtin_amdgcn_cvt_scalef32_pk_fp4_f32(w1, v[3].z * sc, v[3].w * sc, 1.0f, 3);
  *(uint2*)(dst + (size_t)row * (DM / 2) + lane * 8) = make_uint2(w0, w1);
  if (lane == 0) inv_scale[row] = (am > 0.f) ? am * (1.f / 6.f) : 1.f;
}
__device__ __forceinline__ void dec16_fp8(const uint4 d, f32x2_t (&o)[8]) {
  const unsigned w[4] = {d.x, d.y, d.z, d.w};
#pragma unroll
  for (int k = 0; k < 4; ++k) {
    o[2 * k] = __builtin_amdgcn_cvt_pk_f32_fp8((int)w[k], false);
    o[2 * k + 1] = __builtin_amdgcn_cvt_pk_f32_fp8((int)w[k], true);
  }
}
__device__ __forceinline__ void dec16_fp4(const uint2 d, f32x2_t (&o)[8]) {
  o[0] = __builtin_amdgcn_cvt_scalef32_pk_f32_fp4(d.x, 1.0f, 0); o[1] = __builtin_amdgcn_cvt_scalef32_pk_f32_fp4(d.x, 1.0f, 1);
  o[2] = __builtin_amdgcn_cvt_scalef32_pk_f32_fp4(d.x, 1.0f, 2); o[3] = __builtin_amdgcn_cvt_scalef32_pk_f32_fp4(d.x, 1.0f, 3);
  o[4] = __builtin_amdgcn_cvt_scalef32_pk_f32_fp4(d.y, 1.0f, 0); o[5] = __builtin_amdgcn_cvt_scalef32_pk_f32_fp4(d.y, 1.0f, 1);
  o[6] = __builtin_amdgcn_cvt_scalef32_pk_f32_fp4(d.y, 1.0f, 2); o[7] = __builtin_amdgcn_cvt_scalef32_pk_f32_fp4(d.y, 1.0f, 3);
}
#if EX_FP4_DOWN
typedef uint2 drow_t;
#define DROW_BYTES 8
#define DEC_D dec16_fp4
#else
typedef uint4 drow_t;
#define DROW_BYTES 16
#define DEC_D dec16_fp8
#endif
#if EX_FP4_UP
typedef uint2 urow_t;
#define UROW_BYTES 8
#define DEC_U dec16_fp4
#else
typedef uint4 urow_t;
#define UROW_BYTES 16
#define DEC_U dec16_fp8
#endif

__device__ __forceinline__ int swz(int row, int ch) { return row * 128 + ((ch ^ ((row >> 1) & 7)) << 4); }

__device__ __forceinline__ void gemm_compute(const char* cA, const char* cB, const int arow, const int brow, const int xr, const int h,
                                             f32x16 (&acc)[2][2]) {
#pragma unroll
  for (int ks = 0; ks < 4; ++ks) {
    const int co = ((ks * 2 + h) ^ xr) << 4;
    bf16x8 a0 = *(const bf16x8*)(cA + arow + co);
    bf16x8 a1 = *(const bf16x8*)(cA + arow + 32 * 128 + co);
    bf16x8 b0 = *(const bf16x8*)(cB + brow + co);
    bf16x8 b1 = *(const bf16x8*)(cB + brow + 32 * 128 + co);
    acc[0][0] = __builtin_amdgcn_mfma_f32_32x32x16_bf16(a0, b0, acc[0][0], 0, 0, 0);
    acc[0][1] = __builtin_amdgcn_mfma_f32_32x32x16_bf16(a0, b1, acc[0][1], 0, 0, 0);
    acc[1][0] = __builtin_amdgcn_mfma_f32_32x32x16_bf16(a1, b0, acc[1][0], 0, 0, 0);
    acc[1][1] = __builtin_amdgcn_mfma_f32_32x32x16_bf16(a1, b1, acc[1][1], 0, 0, 0);
  }
}

__device__ __forceinline__ void gemm_core(const ushort_t* __restrict__ A, const ushort_t* __restrict__ Bt, const int K, const int m0,
                                          const int n0, char* smem, f32x16 (&acc)[2][2]) {
  int tid = threadIdx.x;
  asm volatile("" : "+v"(tid));
  const int lane = tid & 63;
  const int wave = __builtin_amdgcn_readfirstlane(tid >> 6);
  const int wm = wave >> 1, wn = wave & 1;
  const int r = lane & 31, h = lane >> 5;
  const int srow = wave * 8 + (lane >> 3);
  const int schs = (lane & 7) ^ ((srow >> 1) & 7);
  const ushort_t* Ag = A + (size_t)(m0 + srow) * K + schs * 8;
  const ushort_t* Bg = Bt + (size_t)(n0 + srow) * K + schs * 8;
  const size_t rs = (size_t)32 * K;
  char* wbase = smem + wave * 1024;
#define GLDS_TILE(BUF, koff) { \
    __builtin_amdgcn_global_load_lds((const unsigned*)(Ag + (koff)), (unsigned*)(wbase + (BUF)), 16, 0, 0); \
    __builtin_amdgcn_global_load_lds((const unsigned*)(Ag + rs + (koff)), (unsigned*)(wbase + (BUF) + 4096), 16, 0, 0); \
    __builtin_amdgcn_global_load_lds((const unsigned*)(Ag + 2 * rs + (koff)), (unsigned*)(wbase + (BUF) + 8192), 16, 0, 0); \
    __builtin_amdgcn_global_load_lds((const unsigned*)(Ag + 3 * rs + (koff)), (unsigned*)(wbase + (BUF) + 12288), 16, 0, 0); \
    __builtin_amdgcn_global_load_lds((const unsigned*)(Bg + (koff)), (unsigned*)(wbase + (BUF) + 16384), 16, 0, 0); \
    __builtin_amdgcn_global_load_lds((const unsigned*)(Bg + rs + (koff)), (unsigned*)(wbase + (BUF) + 16384 + 4096), 16, 0, 0); \
    __builtin_amdgcn_global_load_lds((const unsigned*)(Bg + 2 * rs + (koff)), (unsigned*)(wbase + (BUF) + 16384 + 8192), 16, 0, 0); \
    __builtin_amdgcn_global_load_lds((const unsigned*)(Bg + 3 * rs + (koff)), (unsigned*)(wbase + (BUF) + 16384 + 12288), 16, 0, 0); }
  GLDS_TILE(0, 0)
#pragma unroll
  for (int i = 0; i < 2; ++i)
#pragma unroll
    for (int j = 0; j < 2; ++j)
#pragma unroll
      for (int e = 0; e < 16; ++e) acc[i][j][e] = 0.f;
  const int nk = K >> 6;
  const int xr = (r >> 1) & 7;
  const int arow = (wm * 64 + r) * 128, brow = (wn * 64 + r) * 128;
  asm volatile("s_waitcnt vmcnt(0)" ::: "memory");
  __syncthreads();
#pragma unroll 1
  for (int kt = 0; kt < nk; kt += 2) {
    GLDS_TILE(32768, (kt + 1) * 64)
    gemm_compute(smem, smem + 16384, arow, brow, xr, h, acc);
    asm volatile("s_waitcnt vmcnt(0)" ::: "memory");
    __syncthreads();
    if (kt + 2 < nk) { GLDS_TILE(0, (kt + 2) * 64) }
    gemm_compute(smem + 32768, smem + 32768 + 16384, arow, brow, xr, h, acc);
    asm volatile("s_waitcnt vmcnt(0)" ::: "memory");
    __syncthreads();
  }
#undef GLDS_TILE
}

enum { EP_SILU = 0, EP_PLAIN = 1, EP_HEADNORM = 2 };

__device__ __forceinline__ void stage_flush_bf16(const char* sw, ushort_t* __restrict__ dst, const size_t ld, const size_t row0, const int col0) {
  const int lane = threadIdx.x & 63;
  const int rr = lane >> 3, ch = lane & 7;
#pragma unroll
  for (int i = 0; i < 8; ++i) {
    const int row = i * 8 + rr;
    const uint4 v = *(const uint4*)(sw + row * 144 + ch * 16);
    *(uint4*)(dst + (row0 + row) * ld + col0 + ch * 8) = v;
  }
}

__device__ __forceinline__ void epi_bf16(char* smem, const f32x16 (&acc)[2][2], const int mode, ushort_t* __restrict__ dst, const int ld,
                                         const int row0, const int col0, const float* __restrict__ nw, float* __restrict__ kp) {
  const int lane = threadIdx.x & 63, r = lane & 31, h = lane >> 5;
  char* sw = smem + (threadIdx.x >> 6) * 9216;
  float w0 = 1.f, w1 = 1.f;
  if (mode == EP_HEADNORM) { w0 = nw[r]; w1 = nw[32 + r]; }
  float cs0 = 0.f, cs1 = 0.f;
#pragma unroll
  for (int mi = 0; mi < 2; ++mi) {
#pragma unroll
    for (int e = 0; e < 16; ++e) {
      const int row = mi * 32 + (e & 3) + 8 * (e >> 2) + 4 * h;
      float v0 = acc[mi][0][e], v1 = acc[mi][1][e];
      if (mode == EP_SILU) { v0 = silu_f(v0); v1 = silu_f(v1); }
      if (mode == EP_HEADNORM) {
        float ss = v0 * v0 + v1 * v1;
        ss += __shfl_xor(ss, 1); ss += __shfl_xor(ss, 2); ss += __shfl_xor(ss, 4); ss += __shfl_xor(ss, 8); ss += __shfl_xor(ss, 16);
        const float rs = rsqrtf(ss * (1.f / 64.f) + EPS);
        v0 = v0 * rs * w0; v1 = v1 * rs * w1;
        cs0 += v0; cs1 += v1;
      }
      *(ushort_t*)(sw + row * 144 + r * 2) = f2bf(v0);
      *(ushort_t*)(sw + row * 144 + 64 + r * 2) = f2bf(v1);
    }
  }
  if (kp) {
    cs0 += __shfl_xor(cs0, 32);
    cs1 += __shfl_xor(cs1, 32);
    if (h == 0) { kp[r] = cs0; kp[32 + r] = cs1; }
  }
  stage_flush_bf16(sw, dst, (size_t)ld, (size_t)row0, col0);
}

__device__ __forceinline__ void epi_bf16_T(char* smem, const f32x16 (&acc)[2][2], ushort_t* __restrict__ dstT, const size_t ldT, const int rowpos0) {
  const int lane = threadIdx.x & 63, r = lane & 31, h = lane >> 5;
  char* sw = smem + (threadIdx.x >> 6) * 9216;
#pragma unroll
  for (int ni = 0; ni < 2; ++ni) {
#pragma unroll
    for (int mi = 0; mi < 2; ++mi) {
#pragma unroll
      for (int q4 = 0; q4 < 4; ++q4) {
        const int rp = mi * 32 + 8 * q4 + 4 * h;
        *(uint2*)(sw + (ni * 32 + r) * 144 + rp * 2) = make_uint2(pack2(acc[mi][ni][4 * q4 + 0], acc[mi][ni][4 * q4 + 1]),
                                                                    pack2(acc[mi][ni][4 * q4 + 2], acc[mi][ni][4 * q4 + 3]));
      }
    }
  }
  stage_flush_bf16(sw, dstT, ldT, 0, rowpos0);
}

__device__ __forceinline__ void epi_f32(char* smem, const f32x16 (&acc)[2][2], float* __restrict__ dst, const int ld, const int row0, const int col0,
                                        const float* __restrict__ resid, ushort_t* __restrict__ dstb, float* __restrict__ hss) {
  const int lane = threadIdx.x & 63, r = lane & 31, h = lane >> 5;
  char* sw = smem + (threadIdx.x >> 6) * 17408;
#pragma unroll
  for (int mi = 0; mi < 2; ++mi) {
#pragma unroll
    for (int e = 0; e < 16; ++e) {
      const int row = mi * 32 + (e & 3) + 8 * (e >> 2) + 4 * h;
      *(float*)(sw + row * 272 + r * 4) = acc[mi][0][e];
      *(float*)(sw + row * 272 + 128 + r * 4) = acc[mi][1][e];
    }
  }
  const int rr = lane >> 4, ch = lane & 15;
#pragma unroll
  for (int hb = 0; hb < 2; ++hb) {
    float4 rv[8];
    if (resid) {
#pragma unroll
      for (int i = 0; i < 8; ++i) rv[i] = ld_nt4(resid + (size_t)(row0 + (hb * 8 + i) * 4 + rr) * ld + col0 + ch * 4);
    }
#pragma unroll
    for (int i = 0; i < 8; ++i) {
      const int row = (hb * 8 + i) * 4 + rr;
      float4 v = *(const float4*)(sw + row * 272 + ch * 16);
      if (resid) { v.x += rv[i].x; v.y += rv[i].y; v.z += rv[i].z; v.w += rv[i].w; }
      *(float4*)(dst + (size_t)(row0 + row) * ld + col0 + ch * 4) = v;
      if (dstb) {
        *(uint2*)(dstb + (size_t)(row0 + row) * ld + col0 + ch * 4) = make_uint2(pack2(v.x, v.y), pack2(v.z, v.w));
        float ss = v.x * v.x + v.y * v.y + v.z * v.z + v.w * v.w;
        ss += __shfl_xor(ss, 1); ss += __shfl_xor(ss, 2); ss += __shfl_xor(ss, 4); ss += __shfl_xor(ss, 8);
        if (ch == 0) hss[(size_t)(row0 + row) * 16 + (col0 >> 6)] = ss;
      }
    }
  }
}

__device__ __forceinline__ void ph_gemm_proj(const int vb, char* smem, const Params& p) {
  const int nt = vb % 20, mt = vb / 20;
  const int m0 = mt * 128, n0 = nt * 128;
  f32x16 acc[2][2];
  gemm_core(p.xn_b, p.w_inT, DM, m0, n0, smem, acc);
  const int wave = threadIdx.x >> 6, wm = wave >> 1, wn = wave & 1;
  const int row0 = m0 + wm * 64;
  const int c = n0 + wn * 64;
  if (c < 512) epi_bf16(smem, acc, EP_SILU, p.zs, 512, row0, c, nullptr, nullptr);
  else if (c < 1536) epi_bf16(smem, acc, EP_PLAIN, p.xbc_raw, 1024, row0, c - 512, nullptr, nullptr);
  else if (c < 1792) epi_bf16(smem, acc, EP_HEADNORM, p.mq, 256, row0, c - 1536, p.mq_norm_w, nullptr);
  else if (c < 2048) {
    const int hh = (c - 1792) >> 6, bb = row0 >> 13, lpos = row0 & (SL - 1);
    epi_bf16(smem, acc, EP_HEADNORM, p.mk, 256, row0, c - 1792, p.mk_norm_w, p.kpart + ((size_t)((bb * 4 + hh) * 32 + (lpos >> 8)) * 4 + ((lpos >> 6) & 3)) * 64);
  } else if (c < 2304) {
    const int hh = (c - 2048) >> 6, bb = row0 >> 13, lpos = row0 & (SL - 1);
    epi_bf16_T(smem, acc, p.vT + (size_t)(bb * 4 + hh) * 64 * SL, SL, lpos);
  }
  else epi_bf16(smem, acc, EP_HEADNORM, p.xq, 256, row0, c - 2304, p.xq_norm_w, nullptr);
}

__device__ __forceinline__ void ph_gemm_mem(const int vb, char* smem, const Params& p) {
  const int nt = vb % 4, mt = vb / 4;
  const int m0 = mt * 128, n0 = nt * 128;
  f32x16 acc[2][2];
  gemm_core(p.memn_b, p.w_memT, DM, m0, n0, smem, acc);
  const int wave = threadIdx.x >> 6, wm = wave >> 1, wn = wave & 1;
  const int row0 = m0 + wm * 64;
  const int c = n0 + wn * 64;
  if (c < 256) epi_bf16(smem, acc, EP_HEADNORM, p.memk_b, 256, row0, c, p.xk_norm_w, nullptr);
  else {
    const int hh = (c - 256) >> 6, bb = row0 >> 8, mpos = row0 & 255;
    epi_bf16_T(smem, acc, p.memvT + (size_t)(bb * 4 + hh) * 64 * MEM, MEM, mpos);
  }
}

__device__ __forceinline__ void ph_gemm_f32(const int vb, char* smem, const ushort_t* A, const ushort_t* Bt, float* dst, const float* resid, ushort_t* dstb, float* hss) {
  const int nt = vb % 8, mt = vb / 8;
  const int m0 = mt * 128, n0 = nt * 128;
  f32x16 acc[2][2];
  gemm_core(A, Bt, DM, m0, n0, smem, acc);
  const int wave = threadIdx.x >> 6, wm = wave >> 1, wn = wave & 1;
  epi_f32(smem, acc, dst, DM, m0 + wm * 64, n0 + wn * 64, resid, dstb, hss);
}

__device__ __forceinline__ int swz256(int row, int ch) { return row * 272 + (ch << 4); }
__device__ __forceinline__ int crow16(int e, int hl) { return (e & 3) + 8 * (e >> 2) + 4 * hl; }

__device__ __forceinline__ void ph_ssd1(const int vb, char* smem, const Params& p) {
  const int h = vb & 7, c = (vb >> 3) & 63, b = vb >> 9;
  const int g = h >> 2, hq = h & 3;
  int tid = threadIdx.x;
  asm volatile("" : "+v"(tid));
  const int lane = tid & 63, wave = tid >> 6;
  const int t0 = b * SL + c * 128;
  char* s_xw = smem;
  char* s_bt = smem + 17408;
  float* s_acs = (float*)(smem + 52224);
  float* s_w = s_acs + 128;
  float* s_red = s_w + 128;
  const float a_coef = -expf(p.a_log[h]);
  float dtv = 0.f, cs = 0.f;
  if (tid < 128) {
    dtv = p.dt[(size_t)(t0 + tid) * 8 + h];
    cs = dtv * a_coef;
#pragma unroll
    for (int o = 1; o < 64; o <<= 1) {
      float nb = __shfl_up(cs, o);
      if (lane >= o) cs += nb;
    }
    if (lane == 63) s_red[wave] = cs;
  }
  __syncthreads();
  if (tid < 128) {
    if (wave == 1) cs += s_red[0];
    s_acs[tid] = cs;
    p.acs[(size_t)(t0 + tid) * 8 + h] = cs;
  }
  __syncthreads();
  if (tid < 128) {
    const float tot = s_acs[127];
    s_w[tid] = dtv * expf(tot - cs);
    if (tid == 0) p.cdec[(b * 64 + c) * 8 + h] = expf(tot);
  }
  __syncthreads();
  if (tid < 224) {
    const int seg = tid / 28, cg = tid - seg * 28;
    const bool is_x = cg < 8, is_b = (cg >= 8) && (cg < 24);
    int ch0, trow;
    if (is_x) { ch0 = h * 64 + cg * 8; trow = cg * 8; }
    else if (is_b) { ch0 = 512 + g * 128 + (cg - 8) * 8; trow = (cg - 8) * 8; }
    else { ch0 = 768 + g * 128 + hq * 32 + (cg - 24) * 8; trow = 0; }
    const bool wr_nat = is_x || !is_b || (hq == 0);
    char* tbase = is_x ? s_xw : s_bt;
    const int l0 = seg * 16;
    float w0[8], w1[8], w2[8], w3[8], bias[8];
    {
      const float* cw = p.conv_w + ch0;
      float4 a, bq;
      a = *(const float4*)(cw); bq = *(const float4*)(cw + 4);
      w0[0] = a.x; w0[1] = a.y; w0[2] = a.z; w0[3] = a.w; w0[4] = bq.x; w0[5] = bq.y; w0[6] = bq.z; w0[7] = bq.w;
      a = *(const float4*)(cw + 1024); bq = *(const float4*)(cw + 1028);
      w1[0] = a.x; w1[1] = a.y; w1[2] = a.z; w1[3] = a.w; w1[4] = bq.x; w1[5] = bq.y; w1[6] = bq.z; w1[7] = bq.w;
      a = *(const float4*)(cw + 2048); bq = *(const float4*)(cw + 2052);
      w2[0] = a.x; w2[1] = a.y; w2[2] = a.z; w2[3] = a.w; w2[4] = bq.x; w2[5] = bq.y; w2[6] = bq.z; w2[7] = bq.w;
      a = *(const float4*)(cw + 3072); bq = *(const float4*)(cw + 3076);
      w3[0] = a.x; w3[1] = a.y; w3[2] = a.z; w3[3] = a.w; w3[4] = bq.x; w3[5] = bq.y; w3[6] = bq.z; w3[7] = bq.w;
      a = *(const float4*)(p.conv_b + ch0); bq = *(const float4*)(p.conv_b + ch0 + 4);
      bias[0] = a.x; bias[1] = a.y; bias[2] = a.z; bias[3] = a.w; bias[4] = bq.x; bias[5] = bq.y; bias[6] = bq.z; bias[7] = bq.w;
    }
    float r0[8], r1[8], r2[8];
    {
      const int lg = c * 128 + l0;
      const ushort_t* src = p.xbc_raw + (size_t)(t0 + l0) * 1024 + ch0;
      uint4 z4 = make_uint4(0u, 0u, 0u, 0u);
      uint4 u0 = (lg >= 3) ? *(const uint4*)(src - 3 * 1024) : z4;
      uint4 u1 = (lg >= 2) ? *(const uint4*)(src - 2 * 1024) : z4;
      uint4 u2 = (lg >= 1) ? *(const uint4*)(src - 1 * 1024) : z4;
      unpack8(u0, r0); unpack8(u1, r1); unpack8(u2, r2);
    }
    unsigned outp[8][8];
    float lo[8], los[8];
#pragma unroll
    for (int i = 0; i < 16; ++i) {
      float cur[8], val[8];
      unpack8(*(const uint4*)(p.xbc_raw + (size_t)(t0 + l0 + i) * 1024 + ch0), cur);
#pragma unroll
      for (int j = 0; j < 8; ++j) {
        float v = bias[j];
        v = fmaf(w0[j], r0[j], v); v = fmaf(w1[j], r1[j], v); v = fmaf(w2[j], r2[j], v); v = fmaf(w3[j], cur[j], v);
        val[j] = silu_f(v);
        r0[j] = r1[j]; r1[j] = r2[j]; r2[j] = cur[j];
      }
      if (wr_nat) {
        *(uint4*)(p.xc + (size_t)(t0 + l0 + i) * 1024 + ch0) =
            make_uint4(pack2(val[0], val[1]), pack2(val[2], val[3]), pack2(val[4], val[5]), pack2(val[6], val[7]));
      }
      const float scl = is_x ? s_w[l0 + i] : 1.f;
      if ((i & 1) == 0) {
#pragma unroll
        for (int j = 0; j < 8; ++j) { lo[j] = val[j]; los[j] = val[j] * scl; }
      } else {
        const int chunk = seg * 2 + (i >> 3);
#pragma unroll
        for (int j = 0; j < 8; ++j) {
          outp[j][i >> 1] = pack2(lo[j], val[j]);
          if (is_x || is_b) *(unsigned*)(tbase + swz256(trow + j, chunk) + ((i & 7) - 1) * 2) = pack2(los[j], val[j] * scl);
        }
      }
    }
    if (is_x) {
      ushort_t* dst = p.xT + ((size_t)((b * 64 + c) * 8 + h) * 64 + cg * 8) * 128 + l0;
#pragma unroll
      for (int j = 0; j < 8; ++j) {
        *(uint4*)(dst + (size_t)j * 128) = make_uint4(outp[j][0], outp[j][1], outp[j][2], outp[j][3]);
        *(uint4*)(dst + (size_t)j * 128 + 8) = make_uint4(outp[j][4], outp[j][5], outp[j][6], outp[j][7]);
      }
    }
  }
  __syncthreads();
  {
    const int r = lane & 31, hl = lane >> 5;
    f32x16 acc[2];
#pragma unroll
    for (int e = 0; e < 16; ++e) { acc[0][e] = 0.f; acc[1][e] = 0.f; }
#pragma unroll
    for (int ks = 0; ks < 8; ++ks) {
      const bf16x8 bfr = *(const bf16x8*)(s_bt + swz256(32 * wave + r, ks * 2 + hl));
      const bf16x8 a0 = *(const bf16x8*)(s_xw + swz256(r, ks * 2 + hl));
      const bf16x8 a1 = *(const bf16x8*)(s_xw + swz256(32 + r, ks * 2 + hl));
      acc[0] = __builtin_amdgcn_mfma_f32_32x32x16_bf16(a0, bfr, acc[0], 0, 0, 0);
      acc[1] = __builtin_amdgcn_mfma_f32_32x32x16_bf16(a1, bfr, acc[1], 0, 0, 0);
    }
    float* dst = p.states + (size_t)((b * 64 + c) * 8 + h) * 64 * 128;
#pragma unroll
    for (int pt = 0; pt < 2; ++pt)
#pragma unroll
      for (int e = 0; e < 16; ++e) dst[(size_t)(pt * 32 + crow16(e, hl)) * 128 + 32 * wave + r] = acc[pt][e];
  }
}

__device__ __forceinline__ void ph_ssd2(const int vb, const Params& p) {
  const int idx = vb * 256 + threadIdx.x;
  const int pn = idx & 8191, h = (idx >> 13) & 7, b = idx >> 16;
  float st = 0.f;
#pragma unroll 1
  for (int c0 = 0; c0 < 64; c0 += 8) {
    float sv[8], dv[8];
#pragma unroll
    for (int i = 0; i < 8; ++i) {
      const int cc = (b * 64 + c0 + i) * 8 + h;
      sv[i] = p.states[(size_t)cc * 8192 + pn];
      dv[i] = p.cdec[cc];
    }
#pragma unroll
    for (int i = 0; i < 8; ++i) {
      const int cc = (b * 64 + c0 + i) * 8 + h;
      p.sin_b[(size_t)cc * 8192 + pn] = f2bf(st);
      st = fmaf(st, dv[i], sv[i]);
    }
  }
}

__device__ __forceinline__ void ph_ssd3(const int vb, char* smem, const Params& p) {
  const int g = vb & 1, c = (vb >> 1) & 63, b = vb >> 7;
  int tid = threadIdx.x;
  asm volatile("" : "+v"(tid));
  const int lane = tid & 63;
  const int w = __builtin_amdgcn_readfirstlane(tid >> 6);
  const int r = lane & 31, hl = lane >> 5;
  const int t0 = b * SL + c * 128;
  char* s_C = smem;
  char* s_B = smem + 34816;
  char* s_xT = smem + 34816;
  char* s_S = smem + 34816 + 16896;
  float* s_acs = (float*)(smem + 69632);
  float* s_dt = s_acs + 512;
  {
    const int ch = tid & 15, r0 = tid >> 4;
#pragma unroll
    for (int i = 0; i < 8; ++i) {
      const int row = r0 + 16 * i;
      const ushort_t* src = p.xc + (size_t)(t0 + row) * 1024 + g * 128 + ch * 8;
      *(uint4*)(s_B + swz256(row, ch)) = *(const uint4*)(src + 512);
      *(uint4*)(s_C + swz256(row, ch)) = *(const uint4*)(src + 768);
    }
    if (tid < 128) {
#pragma unroll
      for (int hh = 0; hh < 4; ++hh) {
        s_acs[hh * 128 + tid] = p.acs[(size_t)(t0 + tid) * 8 + g * 4 + hh];
        s_dt[hh * 128 + tid] = p.dt[(size_t)(t0 + tid) * 8 + g * 4 + hh];
      }
    }
  }
  __syncthreads();
  bf16x8 cfr[8];
#pragma unroll
  for (int ks = 0; ks < 8; ++ks) cfr[ks] = *(const bf16x8*)(s_C + swz256(32 * w + r, ks * 2 + hl));
  f32x16 gt[4];
#pragma unroll
  for (int st = 0; st < 4; ++st) {
#pragma unroll
    for (int e = 0; e < 16; ++e) gt[st][e] = 0.f;
    if (st <= w) {
#pragma unroll
      for (int ks = 0; ks < 8; ++ks) {
        const bf16x8 a = *(const bf16x8*)(s_B + swz256(32 * st + r, ks * 2 + hl));
        gt[st] = __builtin_amdgcn_mfma_f32_32x32x16_bf16(a, cfr[ks], gt[st], 0, 0, 0);
      }
    }
  }
  __syncthreads();
  float ssq = 0.f;
  const int lane_c = lane;
#pragma unroll 1
  for (int hh = 0; hh < 4; ++hh) {
    int lane_o = lane_c;
    asm volatile("" : "+v"(lane_o));
    const int r = lane_o & 31, hl = lane_o >> 5;
    const int l = 32 * w + r;
    const int hg = g * 4 + hh;
    {
      const int ch = tid & 15, r0 = tid >> 4;
      const size_t base = (size_t)((b * 64 + c) * 8 + hg) * 8192;
#pragma unroll
      for (int i = 0; i < 4; ++i) {
        const int row = r0 + 16 * i;
        const uint4 xv = *(const uint4*)(p.xT + base + (size_t)row * 128 + ch * 8);
        *(uint2*)(s_xT + row * 264 + ch * 16) = make_uint2(xv.x, xv.y);
        *(uint2*)(s_xT + row * 264 + ch * 16 + 8) = make_uint2(xv.z, xv.w);
        *(uint4*)(s_S + swz256(row, ch)) = *(const uint4*)(p.sin_b + base + (size_t)row * 128 + ch * 8);
      }
    }
    __syncthreads();
    const float acs_l = s_acs[hh * 128 + l];
    const float dsk = p.ssd_d[hg];
    f32x16 acc[2];
#pragma unroll
    for (int e = 0; e < 16; ++e) { acc[0][e] = 0.f; acc[1][e] = 0.f; }
#pragma unroll
    for (int ks = 0; ks < 8; ++ks) {
      const bf16x8 a0 = *(const bf16x8*)(s_S + swz256(r, ks * 2 + hl));
      const bf16x8 a1 = *(const bf16x8*)(s_S + swz256(32 + r, ks * 2 + hl));
      acc[0] = __builtin_amdgcn_mfma_f32_32x32x16_bf16(a0, cfr[ks], acc[0], 0, 0, 0);
      acc[1] = __builtin_amdgcn_mfma_f32_32x32x16_bf16(a1, cfr[ks], acc[1], 0, 0, 0);
    }
    {
      const float el = expf(acs_l);
#pragma unroll
      for (int e = 0; e < 16; ++e) { acc[0][e] *= el; acc[1][e] *= el; }
    }
#pragma unroll
    for (int st = 0; st < 4; ++st) {
      asm volatile("" ::: "memory");
      if (st <= w) {
        float m[16];
#pragma unroll
        for (int e = 0; e < 16; ++e) {
          const int sidx = 32 * st + crow16(e, hl);
          float v = gt[st][e] * __expf(acs_l - s_acs[hh * 128 + sidx]) * s_dt[hh * 128 + sidx];
          if (sidx > l) v = 0.f;
          if (sidx == l) v += dsk;
          m[e] = v;
        }
#pragma unroll
        for (int k2 = 0; k2 < 2; ++k2) {
          asm volatile("" ::: "memory");
          bf16x8 mf;
          {
            unsigned u0 = pack2(m[8 * k2 + 0], m[8 * k2 + 1]), u1 = pack2(m[8 * k2 + 2], m[8 * k2 + 3]);
            unsigned u2 = pack2(m[8 * k2 + 4], m[8 * k2 + 5]), u3 = pack2(m[8 * k2 + 6], m[8 * k2 + 7]);
            uint4 uu = make_uint4(u0, u1, u2, u3);
            mf = *(bf16x8*)&uu;
          }
          const int soff = (32 * st + 16 * k2 + 4 * hl) * 2;
#pragma unroll
          for (int pt = 0; pt < 2; ++pt) {
            const char* ap = s_xT + (pt * 32 + r) * 264 + soff;
            uint2 q0 = *(const uint2*)(ap);
            uint2 q1 = *(const uint2*)(ap + 16);
            uint4 qq = make_uint4(q0.x, q0.y, q1.x, q1.y);
            const bf16x8 af = *(bf16x8*)&qq;
            acc[pt] = __builtin_amdgcn_mfma_f32_32x32x16_bf16(af, mf, acc[pt], 0, 0, 0);
          }
        }
      }
    }
#pragma unroll
    for (int pt = 0; pt < 2; ++pt) {
#pragma unroll
      for (int q4 = 0; q4 < 4; ++q4) {
        asm volatile("" ::: "memory");
        const int p0 = pt * 32 + 8 * q4 + 4 * hl;
        const uint2 zz = *(const uint2*)(p.zs + (size_t)(t0 + l) * 512 + hg * 64 + p0);
        const float v0 = acc[pt][4 * q4 + 0] * bflo(zz.x), v1 = acc[pt][4 * q4 + 1] * bfhi(zz.x);
        const float v2 = acc[pt][4 * q4 + 2] * bflo(zz.y), v3 = acc[pt][4 * q4 + 3] * bfhi(zz.y);
        ssq += v0 * v0 + v1 * v1 + v2 * v2 + v3 * v3;
        *(uint2*)(p.mixed_b + (size_t)(t0 + l) * 1024 + hg * 64 + p0) = make_uint2(pack2(v0, v1), pack2(v2, v3));
      }
    }
    __syncthreads();
  }
  const int l = 32 * w + r;
  ssq += __shfl_xor(ssq, 32);
  const float rstd = rsqrtf(ssq * (1.f / 256.f) + EPS);
#pragma unroll 1
  for (int hh = 0; hh < 4; ++hh) {
#pragma unroll
    for (int pt = 0; pt < 2; ++pt) {
#pragma unroll
      for (int q4 = 0; q4 < 4; ++q4) {
        asm volatile("" ::: "memory");
        const int chn = (g * 4 + hh) * 64 + pt * 32 + 8 * q4 + 4 * hl;
        ushort_t* ptr = p.mixed_b + (size_t)(t0 + l) * 1024 + chn;
        const uint2 vv = *(const uint2*)ptr;
        const float4 nw = *(const float4*)(p.ssd_norm_w + chn);
        *(uint2*)ptr = make_uint2(pack2(bflo(vv.x) * rstd * nw.x, bfhi(vv.x) * rstd * nw.y),
                                  pack2(bflo(vv.y) * rstd * nw.z, bfhi(vv.y) * rstd * nw.w));
      }
    }
  }
}

__device__ __forceinline__ void k_gate(const int VB, char* smem, const Params& p) {
  const int own = VB & 31, bh = VB >> 5;
  if (own == 0) return;
  const int b = bh >> 2, h = bh & 3;
  const int tid = threadIdx.x;
  float* s_km = (float*)smem;
  int* s_cnt = (int*)(smem + 8192);
  int* s_base = s_cnt + 32;
  for (int i = tid; i < own * 64; i += 256) {
    const int n = i >> 6, d = i & 63;
    const float* kp = p.kpart + (size_t)(bh * 32 + n) * 256 + d;
    s_km[i] = (kp[0] + kp[64]) + (kp[128] + kp[192]);
  }
  if (tid < 32) s_cnt[tid] = 0;
  __syncthreads();
  const int l = own * 256 + tid;
  const int t = b * SL + l;
  float q[64];
  {
    const ushort_t* src = p.mq + (size_t)t * 256 + h * 64;
#pragma unroll
    for (int d = 0; d < 64; d += 8) {
      uint4 v = *(const uint4*)(src + d);
      q[d] = bflo(v.x); q[d + 1] = bfhi(v.x); q[d + 2] = bflo(v.y); q[d + 3] = bfhi(v.y);
      q[d + 4] = bflo(v.z); q[d + 5] = bfhi(v.z); q[d + 6] = bflo(v.w); q[d + 7] = bfhi(v.w);
    }
  }
  float v0 = -INFINITY, v1 = -INFINITY, v2 = -INFINITY;
  int i0 = 0, i1 = 1, i2 = 2;
  for (int n = 0; n < own; ++n) {
    const float* km = s_km + n * 64;
    float sa = 0.f, sb = 0.f;
#pragma unroll
    for (int d = 0; d < 64; d += 8) {
      const float4 a = *(const float4*)(km + d), c = *(const float4*)(km + d + 4);
      sa = fmaf(q[d], a.x, sa); sa = fmaf(q[d + 1], a.y, sa); sa = fmaf(q[d + 2], a.z, sa); sa = fmaf(q[d + 3], a.w, sa);
      sb = fmaf(q[d + 4], c.x, sb); sb = fmaf(q[d + 5], c.y, sb); sb = fmaf(q[d + 6], c.z, sb); sb = fmaf(q[d + 7], c.w, sb);
    }
    const float sv = sa + sb;
    if (sv > v0) { v2 = v1; i2 = i1; v1 = v0; i1 = i0; v0 = sv; i0 = n; }
    else if (sv > v1) { v2 = v1; i2 = i1; v1 = sv; i1 = n; }
    else if (sv > v2) { v2 = sv; i2 = n; }
  }
  const int nsel = own < 3 ? own : 3;
  int lp0 = 0, lp1 = 0, lp2 = 0;
  if (0 < nsel) lp0 = atomicAdd(s_cnt + i0, 1);
  if (1 < nsel) lp1 = atomicAdd(s_cnt + i1, 1);
  if (2 < nsel) lp2 = atomicAdd(s_cnt + i2, 1);
  __syncthreads();
  if (tid < own) s_base[tid] = s_cnt[tid] ? atomicAdd(p.bcnt + bh * 32 + tid, s_cnt[tid]) : 0;
  __syncthreads();
  if (0 < nsel) p.blist[(size_t)(bh * 32 + i0) * 8192 + s_base[i0] + lp0] = l | (0 << 13);
  if (1 < nsel) p.blist[(size_t)(bh * 32 + i1) * 8192 + s_base[i1] + lp1] = l | (1 << 13);
  if (2 < nsel) p.blist[(size_t)(bh * 32 + i2) * 8192 + s_base[i2] + lp2] = l | (2 << 13);
}

struct UnitDesc { const ushort_t* Kp; const ushort_t* VTp; int vstride; int kind; int a0; int a1; };
__device__ __forceinline__ UnitDesc unit_desc(const int u, const int Ug, const int* s_pref, const Params& p) {
  UnitDesc d;
  if (u >= Ug + NB * 4 * 32 * 2) {
    const int v = u - Ug - NB * 4 * 32 * 2;
    d.kind = 2; d.a0 = v >> 6; d.a1 = v & 63;
    const int bh = d.a0, b = bh >> 2, h = bh & 3;
    d.Kp = p.memk_b + (size_t)b * MEM * 256 + h * 64;
    d.VTp = p.memvT + (size_t)bh * 64 * MEM;
    d.vstride = MEM;
  } else {
    if (u < Ug) {
      int lo = 0, hi = 255;
      while (lo < hi) { const int mid = (lo + hi) >> 1; if (s_pref[mid] > u) hi = mid; else lo = mid + 1; }
      const int prev = lo ? s_pref[lo - 1] : 0;
      d.kind = 0; d.a0 = lo; d.a1 = u - prev;
    } else {
      const int v = u - Ug;
      d.kind = 1; d.a0 = v >> 1; d.a1 = v & 1;
    }
    const int bh = d.a0 >> 5, jblk = d.a0 & 31, b = bh >> 2, h = bh & 3;
    d.Kp = p.mk + (size_t)(b * SL + jblk * 256) * 256 + h * 64;
    d.VTp = p.vT + (size_t)bh * 64 * SL + jblk * 256;
    d.vstride = SL;
  }
  return d;
}

#define AU_LOAD(P, D, ST) { \
    const ushort_t* kp_ = (D).Kp + (size_t)((ST) * 128 + kr) * 256 + kc * 8; \
    P##k0 = *(const uint4*)(kp_); P##k1 = *(const uint4*)(kp_ + 32 * 256); P##k2 = *(const uint4*)(kp_ + 64 * 256); P##k3 = *(const uint4*)(kp_ + 96 * 256); \
    const ushort_t* vp_ = (D).VTp + (size_t)vr * (D).vstride + (ST) * 128 + vc * 8; \
    P##v0 = *(const uint4*)(vp_); P##v1 = *(const uint4*)(vp_ + (size_t)16 * (D).vstride); \
    P##v2 = *(const uint4*)(vp_ + (size_t)32 * (D).vstride); P##v3 = *(const uint4*)(vp_ + (size_t)48 * (D).vstride); }
#define AU_STORE(P, BUF) { \
    char* sk_ = (BUF) + kr * 144 + kc * 16; \
    *(uint4*)(sk_) = P##k0; *(uint4*)(sk_ + 32 * 144) = P##k1; *(uint4*)(sk_ + 64 * 144) = P##k2; *(uint4*)(sk_ + 96 * 144) = P##k3; \
    char* sv_ = (BUF) + 18432 + vr * 264 + vc * 16; \
    *(uint2*)(sv_) = make_uint2(P##v0.x, P##v0.y); *(uint2*)(sv_ + 8) = make_uint2(P##v0.z, P##v0.w); \
    *(uint2*)(sv_ + 16 * 264) = make_uint2(P##v1.x, P##v1.y); *(uint2*)(sv_ + 16 * 264 + 8) = make_uint2(P##v1.z, P##v1.w); \
    *(uint2*)(sv_ + 32 * 264) = make_uint2(P##v2.x, P##v2.y); *(uint2*)(sv_ + 32 * 264 + 8) = make_uint2(P##v2.z, P##v2.w); \
    *(uint2*)(sv_ + 48 * 264) = make_uint2(P##v3.x, P##v3.y); *(uint2*)(sv_ + 48 * 264 + 8) = make_uint2(P##v3.z, P##v3.w); }

__device__ __forceinline__ void attn_stage(const char* buf, const int st, const bf16x8 (&qf)[4], const float slope, const int qrel, const bool causal,
                                           const int r, const int hl, f32x16 (&o)[2], float& m, float& lsum) {
  const char* s_K = buf;
  const char* s_VT = buf + 18432;
  f32x16 sc[4];
#pragma unroll
  for (int kt = 0; kt < 4; ++kt) {
#pragma unroll
    for (int e = 0; e < 16; ++e) sc[kt][e] = 0.f;
#pragma unroll
    for (int ks = 0; ks < 4; ++ks) {
      const bf16x8 a = *(const bf16x8*)(s_K + (32 * kt + r) * 144 + (2 * ks + hl) * 16);
      sc[kt] = __builtin_amdgcn_mfma_f32_32x32x16_bf16(a, qf[ks], sc[kt], 0, 0, 0);
    }
  }
  float mx = -1e30f;
  const int qk0 = qrel - st * 128 - 4 * hl;
  const float slope2 = slope;
  const float bb = -slope2 * (float)qk0;
#pragma unroll
  for (int kt = 0; kt < 4; ++kt) {
#pragma unroll
    for (int e = 0; e < 16; ++e) {
      const int ce = 32 * kt + (e & 3) + 8 * (e >> 2);
      float v = fmaf(sc[kt][e], 0.18033688011112042f, fmaf(slope2, (float)ce, bb));
      if (causal && ce > qk0) v = -1e30f;
      sc[kt][e] = v;
      mx = fmaxf(mx, v);
    }
  }
  mx = fmaxf(mx, __shfl_xor(mx, 32));
  const float mnew = fmaxf(m, mx);
  const float alpha = __builtin_amdgcn_exp2f(m - mnew);
  m = mnew;
  lsum *= alpha;
#pragma unroll
  for (int e = 0; e < 16; ++e) { o[0][e] *= alpha; o[1][e] *= alpha; }
#pragma unroll
  for (int kt = 0; kt < 4; ++kt) {
#pragma unroll
    for (int e = 0; e < 16; ++e) {
      const float pe = __builtin_amdgcn_exp2f(sc[kt][e] - mnew);
      sc[kt][e] = pe;
      lsum += pe;
    }
  }
#pragma unroll
  for (int kt = 0; kt < 4; ++kt) {
#pragma unroll
    for (int k2 = 0; k2 < 2; ++k2) {
      uint4 pu = make_uint4(pack2(sc[kt][8 * k2 + 0], sc[kt][8 * k2 + 1]), pack2(sc[kt][8 * k2 + 2], sc[kt][8 * k2 + 3]),
                            pack2(sc[kt][8 * k2 + 4], sc[kt][8 * k2 + 5]), pack2(sc[kt][8 * k2 + 6], sc[kt][8 * k2 + 7]));
      const bf16x8 pf = *(bf16x8*)&pu;
      const int koff = (32 * kt + 16 * k2 + 4 * hl) * 2;
#pragma unroll
      for (int dt = 0; dt < 2; ++dt) {
        const char* ap = s_VT + (dt * 32 + r) * 264 + koff;
        const uint2 q0 = *(const uint2*)(ap);
        const uint2 q1 = *(const uint2*)(ap + 16);
        uint4 qq = make_uint4(q0.x, q0.y, q1.x, q1.y);
        const bf16x8 af = *(bf16x8*)&qq;
        o[dt] = __builtin_amdgcn_mfma_f32_32x32x16_bf16(af, pf, o[dt], 0, 0, 0);
      }
    }
  }
}

__device__ __forceinline__ void ph_attn_units(char* smem, const Params& p, const int Ug, const int* s_pref) {
  const int Utot = Ug + NB * 4 * 32 * 2 + NB * 4 * 64;
  int u = blockIdx.x;
  if (u >= Utot) return;
  int tid = threadIdx.x;
  asm volatile("" : "+v"(tid));
  const int lane = tid & 63, wave = tid >> 6, r = lane & 31, hl = lane >> 5;
  const int kr = tid >> 3, kc = tid & 7, vr = tid >> 4, vc = tid & 15;
  char* buf0 = smem;
  char* buf1 = smem + 35328;
  uint4 Ak0, Ak1, Ak2, Ak3, Av0, Av1, Av2, Av3, Bk0, Bk1, Bk2, Bk3, Bv0, Bv1, Bv2, Bv3;
  UnitDesc D = unit_desc(u, Ug, s_pref, p);
  AU_LOAD(A, D, 0)
  AU_LOAD(B, D, 1)
#pragma unroll 1
  for (; u < Utot; u += gridDim.x) {
    const int un = (u + (int)gridDim.x < Utot) ? u + (int)gridDim.x : u;
    const UnitDesc Dn = unit_desc(un, Ug, s_pref, p);
    int bh, l = 0, slot = 3, jblk = 0;
    bool valid = true, causal = false;
    const ushort_t* qrow;
    float slope = 0.f;
    int qrel = 1 << 20;
    int t;
    if (D.kind == 2) {
      bh = D.a0;
      t = (bh >> 2) * SL + D.a1 * 128 + wave * 32 + r;
      qrow = p.xq + (size_t)t * 256 + (bh & 3) * 64;
    } else {
      bh = D.a0 >> 5; jblk = D.a0 & 31;
      if (D.kind == 0) {
        const int cnt = p.bcnt[D.a0];
        int qi = D.a1 * 128 + wave * 32 + r;
        if (qi >= cnt) { valid = false; qi = 0; }
        const int ent = p.blist[(size_t)D.a0 * 8192 + qi];
        l = ent & 8191; slot = ent >> 13;
      } else {
        l = jblk * 256 + D.a1 * 128 + wave * 32 + r; slot = 3; causal = true;
      }
      t = (bh >> 2) * SL + l;
      qrow = p.mq + (size_t)t * 256 + (bh & 3) * 64;
      slope = exp2f(-2.f * (float)((bh & 3) + 1)) * 1.4426950408889634f;
      qrel = l - jblk * 256;
    }
    bf16x8 qf[4];
#pragma unroll
    for (int ks = 0; ks < 4; ++ks) qf[ks] = *(const bf16x8*)(qrow + ks * 16 + hl * 8);
    f32x16 o[2];
#pragma unroll
    for (int e = 0; e < 16; ++e) { o[0][e] = 0.f; o[1][e] = 0.f; }
    float m = -1e30f, lsum = 0.f;
    AU_STORE(A, buf0)
    AU_LOAD(A, Dn, 0)
    __syncthreads();
    attn_stage(buf0, 0, qf, slope, qrel, causal, r, hl, o, m, lsum);
    AU_STORE(B, buf1)
    AU_LOAD(B, Dn, 1)
    __syncthreads();
    attn_stage(buf1, 1, qf, slope, qrel, causal, r, hl, o, m, lsum);
    const float lt = lsum + __shfl_xor(lsum, 32);
    const float inv = 1.f / lt;
    const int h = bh & 3;
    if (D.kind == 2) {
#pragma unroll
      for (int dt = 0; dt < 2; ++dt)
#pragma unroll
        for (int q4 = 0; q4 < 4; ++q4) {
          const int d = dt * 32 + 8 * q4 + 4 * hl;
          *(uint2*)(p.mixed_b + (size_t)t * DM + 768 + h * 64 + d) =
              make_uint2(pack2(o[dt][4 * q4] * inv, o[dt][4 * q4 + 1] * inv), pack2(o[dt][4 * q4 + 2] * inv, o[dt][4 * q4 + 3] * inv));
        }
    } else if (valid) {
      const size_t pi = ((size_t)t * 4 + h) * 4 + slot;
#pragma unroll
      for (int dt = 0; dt < 2; ++dt)
#pragma unroll
        for (int q4 = 0; q4 < 4; ++q4) {
          const int d = dt * 32 + 8 * q4 + 4 * hl;
          *(uint2*)(p.pO + pi * 64 + d) =
              make_uint2(pack2(o[dt][4 * q4] * inv, o[dt][4 * q4 + 1] * inv), pack2(o[dt][4 * q4 + 2] * inv, o[dt][4 * q4 + 3] * inv));
        }
      if (hl == 0) { p.pm[pi] = m; p.pl[pi] = lt; }
    }
    D = Dn;
  }
}

__device__ __forceinline__ void ph_attn_combine(const int VB, const Params& p) {
  const int i = VB * 256 + threadIdx.x;
  const int dq = i & 7, th = i >> 3;
  const int t = th >> 2;
  const int own = (t & (SL - 1)) >> 8;
  const int nsel = own < 3 ? own : 3;
  float mv[4], wv[4];
  float M = p.pm[(size_t)th * 4 + 3];
  mv[3] = M;
#pragma unroll
  for (int sl = 0; sl < 3; ++sl) {
    mv[sl] = (sl < nsel) ? p.pm[(size_t)th * 4 + sl] : -1e30f;
    M = fmaxf(M, mv[sl]);
  }
  float W = 0.f;
#pragma unroll
  for (int sl = 0; sl < 4; ++sl) {
    const bool on = (sl == 3) || (sl < nsel);
    wv[sl] = on ? p.pl[(size_t)th * 4 + sl] * __builtin_amdgcn_exp2f(mv[sl] - M) : 0.f;
    W += wv[sl];
  }
  float acc[8];
#pragma unroll
  for (int k = 0; k < 8; ++k) acc[k] = 0.f;
#pragma unroll
  for (int sl = 0; sl < 4; ++sl) {
    const bool on = (sl == 3) || (sl < nsel);
    if (on) {
      float f[8];
      unpack8(*(const uint4*)(p.pO + ((size_t)th * 4 + sl) * 64 + dq * 8), f);
#pragma unroll
      for (int k = 0; k < 8; ++k) acc[k] = fmaf(wv[sl], f[k], acc[k]);
    }
  }
  const float inv = 1.f / W;
  const int h = th & 3;
  *(uint4*)(p.mixed_b + (size_t)t * DM + 512 + h * 64 + dq * 8) =
      make_uint4(pack2(acc[0] * inv, acc[1] * inv), pack2(acc[2] * inv, acc[3] * inv), pack2(acc[4] * inv, acc[5] * inv), pack2(acc[6] * inv, acc[7] * inv));
}


__device__ __forceinline__ int mkkey(const float f, const int idx, const int mask) {
  int b = __float_as_int(f);
  b = (b & ~mask) | idx;
  return b ^ ((b >> 31) & 0x7fffffff);
}
__device__ __forceinline__ int key2bits(const int k) { return k ^ ((k >> 31) & 0x7fffffff); }
#define CEI(a, b) { const int _mx = max(a, b), _mn = min(a, b); a = _mx; b = _mn; }
template <int N>
__device__ __forceinline__ void bitonic_sort_desc(int (&v)[N]) {
#pragma unroll
  for (int k = 2; k <= N; k <<= 1) {
#pragma unroll
    for (int j = k >> 1; j > 0; j >>= 1) {
#pragma unroll
      for (int i = 0; i < N; ++i) {
        const int l = i ^ j;
        if (l > i) {
          if ((i & k) == 0) { CEI(v[i], v[l]); } else { CEI(v[l], v[i]); }
        }
      }
    }
  }
}
__device__ __forceinline__ void merge16(int (&a)[16], const int (&b)[16]) {
#pragma unroll
  for (int i = 0; i < 16; ++i) a[i] = max(a[i], b[15 - i]);
#pragma unroll
  for (int j = 8; j > 0; j >>= 1) {
#pragma unroll
    for (int i = 0; i < 16; ++i) {
      const int l = i ^ j;
      if (l > i) { CEI(a[i], a[l]); }
    }
  }
}
__device__ __forceinline__ void merge_partner(int (&a)[16], const int xmask) {
  int o[16];
#pragma unroll
  for (int i = 0; i < 16; ++i) o[i] = __shfl_xor(a[i], xmask);
  merge16(a, o);
}
__device__ __forceinline__ bf16x8 pack_hi8(const float (&x)[8], float (&res)[8]) {
  unsigned u[4];
#pragma unroll
  for (int i = 0; i < 4; ++i) {
    const ushort_t h0 = f2bf(x[2 * i]), h1 = f2bf(x[2 * i + 1]);
    res[2 * i] = x[2 * i] - bf2f(h0);
    res[2 * i + 1] = x[2 * i + 1] - bf2f(h1);
    u[i] = (unsigned)h0 | ((unsigned)h1 << 16);
  }
  uint4 uu = make_uint4(u[0], u[1], u[2], u[3]);
  return *(bf16x8*)&uu;
}
__device__ __forceinline__ bf16x8 pack_8(const float (&x)[8]) {
  uint4 uu = make_uint4(pack2(x[0], x[1]), pack2(x[2], x[3]), pack2(x[4], x[5]), pack2(x[6], x[7]));
  return *(bf16x8*)&uu;
}

__device__ __forceinline__ void ph_gemm_route(const int vb, char* smem, const Params& p, const ushort_t* __restrict__ hn_b) {
  const int head = vb & 7, tt = vb >> 3;
  const int m0 = head * 128, n0 = tt * 128;
  f32x16 acc[2][2];
  gemm_core(p.w_qT, hn_b, DM, m0, n0, smem, acc);
  int tid = threadIdx.x;
  asm volatile("" : "+v"(tid));
  const int lane = tid & 63, r = lane & 31, hl = lane >> 5;
  const int wave = tid >> 6, wm = wave >> 1, wn = wave & 1;
  int* s_top = (int*)(smem + 34816);
  float rstd_tok[2];
#pragma unroll
  for (int ni = 0; ni < 2; ++ni) {
    const float4* hp = (const float4*)(p.hss + (size_t)(n0 + wn * 64 + ni * 32 + r) * 16);
    const float4 a = hp[0], b = hp[1], c = hp[2], d = hp[3];
    const float tot = ((a.x + a.y) + (a.z + a.w)) + ((b.x + b.y) + (b.z + b.w)) + ((c.x + c.y) + (c.z + c.w)) + ((d.x + d.y) + (d.z + d.w));
    rstd_tok[ni] = rsqrtf(tot * (1.f / DM) + EPS);
  }
  {
    const int row = tid >> 1, part = tid & 1;
#pragma unroll
    for (int hf = 0; hf < 2; ++hf) {
      const ushort_t* src = p.skh + (size_t)(hf * 128 + row) * 64 + part * 32;
      char* dst = smem + (hf * 128 + row) * 136 + part * 64;
#pragma unroll
      for (int c = 0; c < 4; ++c) {
        const uint4 v = *(const uint4*)(src + c * 8);
        *(uint2*)(dst + c * 16) = make_uint2(v.x, v.y);
        *(uint2*)(dst + c * 16 + 8) = make_uint2(v.z, v.w);
      }
    }
  }
  __syncthreads();
  const char* s_keys = smem + wm * 128 * 136;
#pragma unroll
  for (int ni = 0; ni < 2; ++ni) {
    asm volatile("" ::: "memory");
    bf16x8 qh[4], ql[4];
#pragma unroll
    for (int mi = 0; mi < 2; ++mi) {
#pragma unroll
      for (int k2 = 0; k2 < 2; ++k2) {
        float x[8], res[8];
#pragma unroll
        for (int j = 0; j < 8; ++j) x[j] = acc[mi][ni][8 * k2 + j] * rstd_tok[ni];
        qh[mi * 2 + k2] = pack_hi8(x, res);
        ql[mi * 2 + k2] = pack_8(res);
      }
    }
    int g0[16];
#pragma unroll
    for (int kh2 = 0; kh2 < 2; ++kh2) {
      int ga[16], gb[16];
#pragma unroll
      for (int kq = 0; kq < 2; ++kq) {
        const int kt = kh2 * 2 + kq;
        asm volatile("" ::: "memory");
        f32x16 sc;
#pragma unroll
        for (int e = 0; e < 16; ++e) sc[e] = 0.f;
#pragma unroll
        for (int st = 0; st < 4; ++st) {
          const int d0 = (st >> 1) * 32 + 16 * (st & 1) + 4 * hl;
          const char* kp = s_keys + (kt * 32 + r) * 136 + d0 * 2;
          const uint2 h0 = *(const uint2*)(kp), h1 = *(const uint2*)(kp + 16);
          uint4 hq = make_uint4(h0.x, h0.y, h1.x, h1.y);
          const bf16x8 ah = *(bf16x8*)&hq;
          sc = __builtin_amdgcn_mfma_f32_32x32x16_bf16(ah, qh[st], sc, 0, 0, 0);
          sc = __builtin_amdgcn_mfma_f32_32x32x16_bf16(ah, ql[st], sc, 0, 0, 0);
        }
        if (kq == 0) {
#pragma unroll
          for (int e = 0; e < 16; ++e) ga[e] = mkkey(sc[e], kt * 32 + (e & 3) + 8 * (e >> 2) + 4 * hl, 127);
          bitonic_sort_desc<16>(ga);
        } else {
#pragma unroll
          for (int e = 0; e < 16; ++e) gb[e] = mkkey(sc[e], kt * 32 + (e & 3) + 8 * (e >> 2) + 4 * hl, 127);
          bitonic_sort_desc<16>(gb);
        }
      }
      merge16(ga, gb);
      if (kh2 == 0) {
#pragma unroll
        for (int i = 0; i < 16; ++i) g0[i] = ga[i];
      } else {
        merge16(g0, ga);
      }
    }
    merge_partner(g0, 32);
    {
      int* dst = s_top + ((size_t)wm * 128 + wn * 64 + ni * 32 + r) * 16 + hl * 8;
      int4 w0, w1;
      int lo8[8], hi8[8];
#pragma unroll
      for (int i = 0; i < 8; ++i) { lo8[i] = g0[i]; hi8[i] = g0[8 + i]; asm volatile("" : "+v"(lo8[i]), "+v"(hi8[i])); }
      w0 = make_int4(hl ? hi8[0] : lo8[0], hl ? hi8[1] : lo8[1], hl ? hi8[2] : lo8[2], hl ? hi8[3] : lo8[3]);
      w1 = make_int4(hl ? hi8[4] : lo8[4], hl ? hi8[5] : lo8[5], hl ? hi8[6] : lo8[6], hl ? hi8[7] : lo8[7]);
      *(int4*)dst = w0; *(int4*)(dst + 4) = w1;
    }
  }
  __syncthreads();
  {
    const int tok = tid >> 1, sub = tid & 1;
    int k1[16], k2[16];
    {
      const int4* a = (const int4*)(s_top + (size_t)tok * 16);
      const int4* b = (const int4*)(s_top + (size_t)(128 + tok) * 16);
#pragma unroll
      for (int i = 0; i < 4; ++i) {
        const int4 x = a[i], y = b[i];
        k1[4 * i] = x.x; k1[4 * i + 1] = x.y; k1[4 * i + 2] = x.z; k1[4 * i + 3] = x.w;
        k2[4 * i] = y.x; k2[4 * i + 1] = y.y; k2[4 * i + 2] = y.z; k2[4 * i + 3] = y.w;
      }
    }
    float v1f[16], v2f[16];
#pragma unroll
    for (int i = 0; i < 16; ++i) { v1f[i] = __int_as_float(key2bits(k1[i])); v2f[i] = __int_as_float(key2bits(k2[i])); }
    int c[32];
    c[0] = sub ? mkkey(v1f[3] + v2f[3], 51, 255) : mkkey(v1f[0] + v2f[0], 0, 255);
    c[1] = sub ? mkkey(v1f[4] + v2f[0], 64, 255) : mkkey(v1f[0] + v2f[1], 1, 255);
    c[2] = sub ? mkkey(v1f[4] + v2f[1], 65, 255) : mkkey(v1f[0] + v2f[2], 2, 255);
    c[3] = sub ? mkkey(v1f[4] + v2f[2], 66, 255) : mkkey(v1f[0] + v2f[3], 3, 255);
    c[4] = sub ? mkkey(v1f[5] + v2f[0], 80, 255) : mkkey(v1f[0] + v2f[4], 4, 255);
    c[5] = sub ? mkkey(v1f[5] + v2f[1], 81, 255) : mkkey(v1f[0] + v2f[5], 5, 255);
    c[6] = sub ? mkkey(v1f[6] + v2f[0], 96, 255) : mkkey(v1f[0] + v2f[6], 6, 255);
    c[7] = sub ? mkkey(v1f[6] + v2f[1], 97, 255) : mkkey(v1f[0] + v2f[7], 7, 255);
    c[8] = sub ? mkkey(v1f[7] + v2f[0], 112, 255) : mkkey(v1f[0] + v2f[8], 8, 255);
    c[9] = sub ? mkkey(v1f[7] + v2f[1], 113, 255) : mkkey(v1f[0] + v2f[9], 9, 255);
    c[10] = sub ? mkkey(v1f[8] + v2f[0], 128, 255) : mkkey(v1f[0] + v2f[10], 10, 255);
    c[11] = sub ? mkkey(v1f[9] + v2f[0], 144, 255) : mkkey(v1f[0] + v2f[11], 11, 255);
    c[12] = sub ? mkkey(v1f[10] + v2f[0], 160, 255) : mkkey(v1f[0] + v2f[12], 12, 255);
    c[13] = sub ? mkkey(v1f[11] + v2f[0], 176, 255) : mkkey(v1f[0] + v2f[13], 13, 255);
    c[14] = sub ? mkkey(v1f[12] + v2f[0], 192, 255) : mkkey(v1f[0] + v2f[14], 14, 255);
    c[15] = sub ? mkkey(v1f[13] + v2f[0], 208, 255) : mkkey(v1f[0] + v2f[15], 15, 255);
    c[16] = sub ? mkkey(v1f[14] + v2f[0], 224, 255) : mkkey(v1f[1] + v2f[0], 16, 255);
    c[17] = sub ? mkkey(v1f[15] + v2f[0], 240, 255) : mkkey(v1f[1] + v2f[1], 17, 255);
    c[18] = sub ? (int)0x80000000 : mkkey(v1f[1] + v2f[2], 18, 255);
    c[19] = sub ? (int)0x80000000 : mkkey(v1f[1] + v2f[3], 19, 255);
    c[20] = sub ? (int)0x80000000 : mkkey(v1f[1] + v2f[4], 20, 255);
    c[21] = sub ? (int)0x80000000 : mkkey(v1f[1] + v2f[5], 21, 255);
    c[22] = sub ? (int)0x80000000 : mkkey(v1f[1] + v2f[6], 22, 255);
    c[23] = sub ? (int)0x80000000 : mkkey(v1f[1] + v2f[7], 23, 255);
    c[24] = sub ? (int)0x80000000 : mkkey(v1f[2] + v2f[0], 32, 255);
    c[25] = sub ? (int)0x80000000 : mkkey(v1f[2] + v2f[1], 33, 255);
    c[26] = sub ? (int)0x80000000 : mkkey(v1f[2] + v2f[2], 34, 255);
    c[27] = sub ? (int)0x80000000 : mkkey(v1f[2] + v2f[3], 35, 255);
    c[28] = sub ? (int)0x80000000 : mkkey(v1f[2] + v2f[4], 36, 255);
    c[29] = sub ? (int)0x80000000 : mkkey(v1f[3] + v2f[0], 48, 255);
    c[30] = sub ? (int)0x80000000 : mkkey(v1f[3] + v2f[1], 49, 255);
    c[31] = sub ? (int)0x80000000 : mkkey(v1f[3] + v2f[2], 50, 255);
    int h0[16], h1[16];
#pragma unroll
    for (int i = 0; i < 16; ++i) { h0[i] = c[i]; h1[i] = c[16 + i]; }
    bitonic_sort_desc<16>(h0); bitonic_sort_desc<16>(h1);
    merge16(h0, h1);
    merge_partner(h0, 1);
    float sv[16];
#pragma unroll
    for (int i = 0; i < 16; ++i) sv[i] = __int_as_float(key2bits(h0[i]));
    float den = 0.f;
#pragma unroll
    for (int i = 0; i < 16; ++i) den += __expf(sv[i] - sv[0]);
    const float inv = 1.f / den;
    int eo[8]; float go[8];
#pragma unroll
    for (int i = 0; i < 8; ++i) {
      int klo = h0[i], khi = h0[8 + i];
      asm volatile("" : "+v"(klo), "+v"(khi));
      const int kk = sub ? khi : klo;
      const int bits = key2bits(kk);
      const int code = bits & 255;
      const int ia = key2bits(s_top[(size_t)tok * 16 + (code >> 4)]) & 127;
      const int ib = key2bits(s_top[(size_t)(128 + tok) * 16 + (code & 15)]) & 127;
      eo[i] = ia * 128 + ib;
      go[i] = __expf(__int_as_float(bits) - sv[0]) * inv;
    }
    const size_t ob = ((size_t)(n0 + tok) * 8 + head) * 16 + sub * 8;
    *(int4*)(p.eidx + ob) = make_int4(eo[0], eo[1], eo[2], eo[3]);
    *(int4*)(p.eidx + ob + 4) = make_int4(eo[4], eo[5], eo[6], eo[7]);
    *(float4*)(p.egate + ob) = make_float4(go[0], go[1], go[2], go[3]);
    *(float4*)(p.egate + ob + 4) = make_float4(go[4], go[5], go[6], go[7]);
  }
}

__device__ __forceinline__ void ph_subkeys(const Params& p) {
  for (int i = blockIdx.x * 256 + threadIdx.x; i < 2 * 128 * 64; i += gridDim.x * 256) {
    const float v = (i < 8192) ? p.sk1[i] : p.sk2[i - 8192];
    const ushort_t hi = f2bf(v);
    p.skh[i] = hi;
    p.skl[i] = f2bf(v - bf2f(hi));
  }
}

__device__ __forceinline__ float dot16_fp8(const uint4 d, const float (&x)[16], float c) {
  const unsigned w[4] = {d.x, d.y, d.z, d.w};
#pragma unroll
  for (int i = 0; i < 4; ++i) {
    const f32x2_t lo = __builtin_amdgcn_cvt_pk_f32_fp8((int)w[i], false);
    const f32x2_t hi = __builtin_amdgcn_cvt_pk_f32_fp8((int)w[i], true);
    c = fmaf(lo.x, x[4 * i], c); c = fmaf(lo.y, x[4 * i + 1], c); c = fmaf(hi.x, x[4 * i + 2], c); c = fmaf(hi.y, x[4 * i + 3], c);
  }
  return c;
}
__device__ __forceinline__ void axpy16_fp8(const float cf, const uint4 u, float (&acc)[16]) {
  const unsigned w[4] = {u.x, u.y, u.z, u.w};
#pragma unroll
  for (int i = 0; i < 4; ++i) {
    const f32x2_t lo = __builtin_amdgcn_cvt_pk_f32_fp8((int)w[i], false);
    const f32x2_t hi = __builtin_amdgcn_cvt_pk_f32_fp8((int)w[i], true);
    acc[4 * i] = fmaf(cf, lo.x, acc[4 * i]); acc[4 * i + 1] = fmaf(cf, lo.y, acc[4 * i + 1]);
    acc[4 * i + 2] = fmaf(cf, hi.x, acc[4 * i + 2]); acc[4 * i + 3] = fmaf(cf, hi.y, acc[4 * i + 3]);
  }
}
constexpr int EX_NTOK = 4;
__device__ __forceinline__ void peer_chunk(const Params& p, const int lane, const int myex, const bool b5, const bool b4, const bool b3,
                                           const int (&ce)[8], const float (&cg)[8], const f32x2_t (&x2)[8], f32x2_t (&acc2)[8]) {
  drow_t d[8];
  urow_t u[8];
  float sd[8], su[8];
#pragma unroll
  for (int i = 0; i < 8; ++i) d[i] = *(const drow_t*)(p.ed8 + ((size_t)ce[i] * 64 + lane) * DROW_BYTES);
#pragma unroll
  for (int i = 0; i < 8; ++i) u[i] = *(const urow_t*)(p.eu8 + ((size_t)ce[i] * 64 + lane) * UROW_BYTES);
#pragma unroll
  for (int i = 0; i < 8; ++i) { sd[i] = p.ed_s[ce[i]]; su[i] = p.eu_s[ce[i]] * cg[i]; }
  float pr[8];
#pragma unroll
  for (int i = 0; i < 8; ++i) {
    f32x2_t dd[8];
    DEC_D(d[i], dd);
    f32x2_t a2 = {0.f, 0.f};
#pragma unroll
    for (int k = 0; k < 8; ++k) a2 = dd[k] * x2[k] + a2;
    pr[i] = (a2.x + a2.y) * sd[i];
  }
  float q4[4];
#pragma unroll
  for (int i = 0; i < 4; ++i) {
    const float snd = b5 ? pr[i] : pr[i + 4];
    const float kp = b5 ? pr[i + 4] : pr[i];
    q4[i] = kp + __shfl_xor(snd, 32);
  }
  float q2[2];
#pragma unroll
  for (int i = 0; i < 2; ++i) {
    const float snd = b4 ? q4[i] : q4[i + 2];
    const float kp = b4 ? q4[i + 2] : q4[i];
    q2[i] = kp + __shfl_xor(snd, 16);
  }
  float q1;
  {
    const float snd = b3 ? q2[0] : q2[1];
    const float kp = b3 ? q2[1] : q2[0];
    q1 = kp + __shfl_xor(snd, 8);
  }
  q1 += __shfl_xor(q1, 4);
  q1 += __shfl_xor(q1, 2);
  q1 += __shfl_xor(q1, 1);
  const float act = gelu_f(q1);
#pragma unroll
  for (int i = 0; i < 8; ++i) {
    const int src = ((i >> 2) & 1) * 32 + ((i >> 1) & 1) * 16 + (i & 1) * 8;
    const float cf = __int_as_float(__builtin_amdgcn_readlane(__float_as_int(act), src)) * su[i];
    const f32x2_t cf2 = {cf, cf};
    f32x2_t uu[8];
    DEC_U(u[i], uu);
#pragma unroll
    for (int k = 0; k < 8; ++k) acc2[k] = cf2 * uu[k] + acc2[k];
  }
}

#ifndef EX_SWEEP
#define EX_SWEEP 0
#endif
#if !EX_SWEEP
typedef __attribute__((ext_vector_type(8))) int v8i_t;
typedef __attribute__((ext_vector_type(4))) float f32x4_t;
__device__ __forceinline__ void sort128(int& v0, int& v1, const int lane) {
#pragma unroll
  for (int k = 2; k <= 128; k <<= 1) {
#pragma unroll
    for (int j = k >> 1; j > 0; j >>= 1) {
      if (j == 1) {
        const bool up = ((lane * 2) & k) == 0;
        const int mn = min(v0, v1), mx = max(v0, v1);
        v0 = up ? mn : mx;
        v1 = up ? mx : mn;
      } else {
        const int o0 = __shfl_xor(v0, j >> 1), o1 = __shfl_xor(v1, j >> 1);
        const bool up = ((lane * 2) & k) == 0;
        const bool lower = ((lane * 2) & j) == 0;
        const bool takemin = (up == lower);
        v0 = takemin ? min(v0, o0) : max(v0, o0);
        v1 = takemin ? min(v1, o1) : max(v1, o1);
      }
    }
  }
}
__device__ __forceinline__ void k_peer_experts(const int VB, char* smem, const Params& p, const ushort_t* __restrict__ hn) {
  const int lane = threadIdx.x & 63;
  const int wave = __builtin_amdgcn_readfirstlane(threadIdx.x >> 6);
  const int t = VB * 4 + wave;
  const int li = lane & 15, g = lane >> 4;
  char* sx = smem + wave * 1024;
  {
    const float* hrow = p.out + (size_t)t * DM + lane * 16;
    const float* wrow = p.ffn_norm_w + lane * 16;
    float4 hv[4], wv[4];
#pragma unroll
    for (int i = 0; i < 4; ++i) { hv[i] = *(const float4*)(hrow + i * 4); wv[i] = *(const float4*)(wrow + i * 4); }
    float ss = 0.f;
#pragma unroll
    for (int i = 0; i < 4; ++i) ss += hv[i].x * hv[i].x + hv[i].y * hv[i].y + hv[i].z * hv[i].z + hv[i].w * hv[i].w;
    ss = wave_sum(ss);
    const float rs = rsqrtf(ss * (1.f / DM) + EPS) * 16.f;
    int wq[4];
#pragma unroll
    for (int i = 0; i < 4; ++i) {
      int w = 0;
      w = __builtin_amdgcn_cvt_pk_fp8_f32(hv[i].x * rs * wv[i].x, hv[i].y * rs * wv[i].y, w, false);
      w = __builtin_amdgcn_cvt_pk_fp8_f32(hv[i].z * rs * wv[i].z, hv[i].w * rs * wv[i].w, w, true);
      wq[i] = w;
    }
    *(int4*)(sx + lane * 16) = make_int4(wq[0], wq[1], wq[2], wq[3]);
  }
  v8i_t xb[8];
#pragma unroll
  for (int st = 0; st < 8; ++st) {
    const int4 lo = *(const int4*)(sx + st * 128 + g * 16);
    const int4 hi = *(const int4*)(sx + st * 128 + 64 + g * 16);
    xb[st] = v8i_t{lo.x, lo.y, lo.z, lo.w, hi.x, hi.y, hi.z, hi.w};
  }
  f32x2_t acc2[8];
#pragma unroll
  for (int i = 0; i < 8; ++i) acc2[i] = f32x2_t{0.f, 0.f};
  int kq0, kq1;
  {
    const int2 ev = *(const int2*)(p.eidx + (size_t)t * 128 + lane * 2);
    kq0 = (ev.x << 7) | (lane * 2);
    kq1 = (ev.y << 7) | (lane * 2 + 1);
    sort128(kq0, kq1, lane);
  }
  const int ev0 = kq0 >> 7, ev1 = kq1 >> 7;
  const float sdv0 = p.ed_s[ev0], sdv1 = p.ed_s[ev1];
  const float suv0 = p.eu_s[ev0] * p.egate[(size_t)t * 128 + (kq0 & 127)], suv1 = p.eu_s[ev1] * p.egate[(size_t)t * 128 + (kq1 & 127)];
#pragma unroll 1
  for (int c = 0; c < 8; ++c) {
    const int lbase = c * 8;
    const int ea = __shfl(ev0, lbase + (li >> 1)), eb = __shfl(ev1, lbase + (li >> 1));
    const int e_lane = (li & 1) ? eb : ea;
    const unsigned char* arow = p.ed8 + (size_t)e_lane * 512 + g * 16;
    uint4 a[8];
#pragma unroll
    for (int st = 0; st < 8; ++st) a[st] = *(const uint4*)(arow + st * 64);
    urow_t u[16];
#pragma unroll
    for (int i = 0; i < 16; ++i) {
      const int ei_s = __builtin_amdgcn_readlane((i & 1) ? ev1 : ev0, lbase + (i >> 1));
      u[i] = *(const urow_t*)(p.eu8 + ((size_t)ei_s * 64 + lane) * UROW_BYTES);
    }
    const int mrow = 4 * g + (li & 3);
    const float sda = __shfl(sdv0, lbase + (mrow >> 1)), sdb = __shfl(sdv1, lbase + (mrow >> 1));
    const float sua = __shfl(suv0, lbase + (mrow >> 1)), sub = __shfl(suv1, lbase + (mrow >> 1));
    const float sd_m = (mrow & 1) ? sdb : sda, su_m = (mrow & 1) ? sub : sua;
    f32x4_t d4 = {0.f, 0.f, 0.f, 0.f};
#pragma unroll
    for (int st = 0; st < 8; ++st) {
      const v8i_t av = v8i_t{(int)a[st].x, (int)a[st].y, (int)a[st].z, (int)a[st].w, 0, 0, 0, 0};
      d4 = __builtin_amdgcn_mfma_scale_f32_16x16x128_f8f6f4(av, xb[st], d4, 4, 0, 0, 0x7f7f7f7f, 0, 0x7f7f7f7f);
    }
    const int rsel = li & 3;
    const float dsel = rsel == 0 ? d4[0] : rsel == 1 ? d4[1] : rsel == 2 ? d4[2] : d4[3];
    const float cvs = gelu_fast(dsel * sd_m * 0.0625f) * su_m;
#pragma unroll
    for (int i = 0; i < 16; ++i) {
      const float cf = __int_as_float(__builtin_amdgcn_readlane(__float_as_int(cvs), 16 * (i >> 2) + (i & 3)));
      const f32x2_t cf2 = {cf, cf};
      f32x2_t uu[8];
      DEC_U(u[i], uu);
#pragma unroll
      for (int k = 0; k < 8; ++k) acc2[k] = cf2 * uu[k] + acc2[k];
    }
  }
  float* orow = p.out + (size_t)t * DM + lane * 16;
#pragma unroll
  for (int i = 0; i < 4; ++i) {
    float4 hv = *(float4*)(orow + i * 4);
    hv.x += acc2[2 * i].x; hv.y += acc2[2 * i].y; hv.z += acc2[2 * i + 1].x; hv.w += acc2[2 * i + 1].y;
    *(float4*)(orow + i * 4) = hv;
  }
}
#define EX_TOK_PER_VB 4
#else
#define EX_TOK_PER_VB (4 * EX_NTOK)
__device__ __forceinline__ void k_peer_experts(const int VB, const Params& p, const ushort_t* __restrict__ hn) {
  const int lane = threadIdx.x & 63;
  const int wave = __builtin_amdgcn_readfirstlane(threadIdx.x >> 6);
  const int t0 = (VB * 4 + wave) * EX_NTOK;
  const int myex = ((lane >> 5) & 1) * 4 + ((lane >> 4) & 1) * 2 + ((lane >> 3) & 1);
  const bool b5 = (lane & 32) != 0, b4 = (lane & 16) != 0, b3 = (lane & 8) != 0;
  f32x2_t x2[EX_NTOK][8], acc2[EX_NTOK][8];
  int e0[EX_NTOK], e1[EX_NTOK];
  float g0[EX_NTOK], g1[EX_NTOK];
#pragma unroll
  for (int k = 0; k < EX_NTOK; ++k) {
    float f0[8], f1[8];
    unpack8(*(const uint4*)(hn + (size_t)(t0 + k) * DM + lane * 16), f0);
    unpack8(*(const uint4*)(hn + (size_t)(t0 + k) * DM + lane * 16 + 8), f1);
#pragma unroll
    for (int i = 0; i < 4; ++i) {
      x2[k][i] = f32x2_t{f0[2 * i], f0[2 * i + 1]};
      x2[k][4 + i] = f32x2_t{f1[2 * i], f1[2 * i + 1]};
    }
#pragma unroll
    for (int i = 0; i < 8; ++i) acc2[k][i] = f32x2_t{0.f, 0.f};
    e0[k] = p.eidx[(size_t)(t0 + k) * 128 + lane];
    e1[k] = p.eidx[(size_t)(t0 + k) * 128 + 64 + lane];
    g0[k] = p.egate[(size_t)(t0 + k) * 128 + lane];
    g1[k] = p.egate[(size_t)(t0 + k) * 128 + 64 + lane];
  }
#pragma unroll 1
  for (int s = 0; s < 16; ++s) {
#pragma unroll
    for (int k = 0; k < EX_NTOK; ++k) {
      unsigned long long m0 = __ballot((e0[k] >> 10) == s);
      unsigned long long m1 = __ballot((e1[k] >> 10) == s);
      while ((m0 | m1) != 0ull) {
        int ce[8];
        float cg[8];
#pragma unroll
        for (int i = 0; i < 8; ++i) {
          int ev = 0;
          float gv = 0.f;
          if (m0 != 0ull) {
            const int ln = __builtin_ctzll(m0);
            m0 &= m0 - 1ull;
            ev = __builtin_amdgcn_readlane(e0[k], ln);
            gv = __int_as_float(__builtin_amdgcn_readlane(__float_as_int(g0[k]), ln));
          } else if (m1 != 0ull) {
            const int ln = __builtin_ctzll(m1);
            m1 &= m1 - 1ull;
            ev = __builtin_amdgcn_readlane(e1[k], ln);
            gv = __int_as_float(__builtin_amdgcn_readlane(__float_as_int(g1[k]), ln));
          }
          ce[i] = ev;
          cg[i] = gv;
        }
        peer_chunk(p, lane, myex, b5, b4, b3, ce, cg, x2[k], acc2[k]);
      }
    }
  }
#pragma unroll
  for (int k = 0; k < EX_NTOK; ++k) {
    float* orow = p.out + (size_t)(t0 + k) * DM + lane * 16;
#pragma unroll
    for (int i = 0; i < 4; ++i) {
      float4 hv = *(float4*)(orow + i * 4);
      hv.x += acc2[k][2 * i].x; hv.y += acc2[k][2 * i].y; hv.z += acc2[k][2 * i + 1].x; hv.w += acc2[k][2 * i + 1].y;
      *(float4*)(orow + i * 4) = hv;
    }
  }
}

#endif

#define PHASE(NBLK, CALL) \
  for (int VB = blockIdx.x; VB < (NBLK); VB += gridDim.x) { CALL; __syncthreads(); }
#define PHASE_NS(NBLK, CALL) \
  for (int VB = blockIdx.x; VB < (NBLK); VB += gridDim.x) { CALL; }
#define PHASE_OFF(OFF, NBLK, CALL) \
  for (int VB = (int)((blockIdx.x + gridDim.x - ((OFF) % gridDim.x)) % gridDim.x); VB < (NBLK); VB += gridDim.x) { CALL; __syncthreads(); }

__global__ __launch_bounds__(256, 2) void fwd_megakernel(Params p) {
  __shared__ __attribute__((aligned(16))) char smem_raw[SMEM_BYTES];
  float* smem = (float*)smem_raw;
  volatile LAS unsigned* xb_st = (volatile LAS unsigned*)(smem_raw + 73728);
  if (threadIdx.x == 0) { xb_st[0] = 0u; xb_st[1] = 0u; xb_st[2] = 0u; xb_st[3] = 0u; }
  __syncthreads();
  const XcdBarrier xb = xcd_barrier_post(p.bar, xb_st);
  {
    for (int k = threadIdx.x; k < DM; k += 256) {
      const float* wr = p.w_in + (size_t)k * INC + 1536;
      const float4 a = *(const float4*)(wr), b = *(const float4*)(wr + 4);
      smem[0 * 1024 + k] = a.x; smem[1 * 1024 + k] = a.y; smem[2 * 1024 + k] = a.z; smem[3 * 1024 + k] = a.w;
      smem[4 * 1024 + k] = b.x; smem[5 * 1024 + k] = b.y; smem[6 * 1024 + k] = b.z; smem[7 * 1024 + k] = b.w;
    }
    __syncthreads();
    PHASE_NS(NT / 8, ph_rmsnorm_bf16(VB, p.x, p.mix_norm_w, p.xn_b, smem, p.dt_bias, p.dt));
    __syncthreads();
  }
  PHASE_NS(NB * MEM / 8, ph_rmsnorm_bf16(VB, p.mem, p.mem_norm_w, p.memn_b, nullptr, nullptr, nullptr));
  PHASE(16 * 40, ph_wtrans(VB, smem, p.w_in, INC, p.w_inT, 40, 8, nullptr));
  PHASE(16 * 16, ph_wtrans(VB, smem, p.w_out, DM, p.w_outT, 16, 0, nullptr));
  PHASE(16 * 16, ph_wtrans(VB, smem, p.w_query, DM, p.w_qT, 16, 0, p.ffn_norm_w));
  PHASE(16 * 8, ph_wtrans(VB, smem, p.w_mem_kv, 512, p.w_memT, 8, 0, nullptr));
  if (blockIdx.x == 0) p.bcnt[threadIdx.x] = 0;
  ph_subkeys(p);
  xcd_barrier(xb);
  PHASE(20 * (NT / 128), ph_gemm_proj(VB, smem_raw, p));
  xcd_barrier(xb);
  PHASE(NB * 64 * 8, ph_ssd1(VB, smem_raw, p));
  PHASE(NB * 4 * 32, k_gate(VB, smem_raw, p));
  PHASE_OFF(256, 4 * (NB * MEM / 128), ph_gemm_mem(VB, smem_raw, p));
  xcd_barrier(xb);
  PHASE_NS(NB * 8 * 64 * 128 / 256, ph_ssd2(VB, p));
  {
    int* s_pref = (int*)(smem_raw + 72192);
    {
      const int tid = threadIdx.x;
      int v = (p.bcnt[tid] + 127) >> 7;
      const int lane = tid & 63;
#pragma unroll
      for (int o = 1; o < 64; o <<= 1) { int nb = __shfl_up(v, o); if (lane >= o) v += nb; }
      int* s_wt = s_pref + 256;
      if (lane == 63) s_wt[tid >> 6] = v;
      __syncthreads();
      int add = 0;
      for (int ww = 0; ww < (tid >> 6); ++ww) add += s_wt[ww];
      s_pref[tid] = v + add;
      __syncthreads();
    }
    const int Ug = s_pref[255];
    ph_attn_units(smem_raw, p, Ug, s_pref);
    __syncthreads();
  }
  xcd_barrier(xb);
  PHASE(NB * 64 * 2, ph_ssd3(VB, smem_raw, p));
  if (gridDim.x >= 512) {
    for (int VB = (int)blockIdx.x - 256; VB >= 0 && VB < NT * 4 * 8 / 256; VB += gridDim.x - 256) ph_attn_combine(VB, p);
  } else {
    PHASE_NS(NT * 4 * 8 / 256, ph_attn_combine(VB, p));
  }
  xcd_barrier(xb);
  PHASE(8 * (NT / 128), ph_gemm_f32(VB, smem_raw, p.mixed_b, p.w_outT, p.out, p.x, p.xn_b, p.hss));
  xcd_barrier(xb);
  ushort_t* hn_b = p.xn_b;
  {
    int cv = blockIdx.x;
    for (int VB = blockIdx.x; VB < 8 * (NT / 128); VB += gridDim.x) {
      ph_gemm_route(VB, smem_raw, p, hn_b);
      __syncthreads();
      for (int i = 0; i < 8 && cv < 8192; ++i, cv += gridDim.x) {
        if (cv < 4096) {
#if EX_FP4_DOWN
          ph_cvt4(cv, p.e_down, p.ed8, p.ed_s);
#else
          ph_cvt8(cv, p.e_down, p.ed8, p.ed_s);
#endif
        } else {
#if EX_FP4_UP
          ph_cvt4(cv - 4096, p.e_up, p.eu8, p.eu_s);
#else
          ph_cvt8(cv - 4096, p.e_up, p.eu8, p.eu_s);
#endif
        }
      }
    }
    for (; cv < 8192; cv += gridDim.x) {
      if (cv < 4096) {
#if EX_FP4_DOWN
        ph_cvt4(cv, p.e_down, p.ed8, p.ed_s);
#else
        ph_cvt8(cv, p.e_down, p.ed8, p.ed_s);
#endif
      } else {
#if EX_FP4_UP
        ph_cvt4(cv - 4096, p.e_up, p.eu8, p.eu_s);
#else
        ph_cvt8(cv - 4096, p.e_up, p.eu8, p.eu_s);
#endif
      }
    }
  }
  xcd_barrier(xb);
  PHASE_NS(NT / EX_TOK_PER_VB, k_peer_experts(VB, smem_raw, p, hn_b));
}
}

extern "C" void kernel_launch(void* const* d_in, const int* in_sizes, int n_in, void* d_out, int out_size, void* d_ws, size_t ws_size,
                              hipStream_t stream) {
  Params p{};
  p.x = (const float*)d_in[0]; p.mem = (const float*)d_in[1]; p.mix_norm_w = (const float*)d_in[2]; p.w_in = (const float*)d_in[3];
  p.conv_w = (const float*)d_in[4]; p.conv_b = (const float*)d_in[5]; p.dt_bias = (const float*)d_in[6]; p.a_log = (const float*)d_in[7];
  p.ssd_d = (const float*)d_in[8]; p.ssd_norm_w = (const float*)d_in[9]; p.mq_norm_w = (const float*)d_in[10]; p.mk_norm_w = (const float*)d_in[11];
  p.mem_norm_w = (const float*)d_in[12]; p.w_mem_kv = (const float*)d_in[13]; p.xq_norm_w = (const float*)d_in[14]; p.xk_norm_w = (const float*)d_in[15];
  p.w_out = (const float*)d_in[16]; p.ffn_norm_w = (const float*)d_in[17]; p.w_query = (const float*)d_in[18]; p.sk1 = (const float*)d_in[19];
  p.sk2 = (const float*)d_in[20]; p.e_down = (const float*)d_in[21]; p.e_up = (const float*)d_in[22];
  p.out = (float*)d_out;
  char* ws = (char*)d_ws;
  size_t o = 0;
  auto take = [&](size_t bytes) { char* q = ws + o; o += (bytes + 255) & ~(size_t)255; return q; };
  p.xn_b = (ushort_t*)take((size_t)NT * DM * 2);
  p.xc = p.xn_b;
  p.w_inT = (ushort_t*)take((size_t)NPROJ * DM * 2);
  p.w_outT = (ushort_t*)take((size_t)DM * DM * 2);
  p.w_qT = (ushort_t*)take((size_t)DM * DM * 2);
  p.w_memT = (ushort_t*)take((size_t)512 * DM * 2);
  p.memn_b = (ushort_t*)take((size_t)NB * MEM * DM * 2);
  p.memk_b = (ushort_t*)take((size_t)NB * MEM * 256 * 2);
  p.memvT = (ushort_t*)take((size_t)NB * MEM * 256 * 2);
  char* regQ = take((size_t)NT * 2560 * 2);
  p.zs = (ushort_t*)regQ;
  p.xbc_raw = (ushort_t*)(regQ + (size_t)NT * 512 * 2);
  p.mq = (ushort_t*)(regQ + (size_t)NT * 1536 * 2);
  p.mk = (ushort_t*)(regQ + (size_t)NT * 1792 * 2);
  p.vT = (ushort_t*)(regQ + (size_t)NT * 2048 * 2);
  p.xq = (ushort_t*)(regQ + (size_t)NT * 2304 * 2);
  p.q = (float*)regQ;
  p.dt = (float*)take((size_t)NT * 8 * 4);
  p.acs = (float*)take((size_t)NT * 8 * 4);
  p.cdec = (float*)take((size_t)NB * 64 * 8 * 4);
  p.states = (float*)d_out;
  p.sin_b = (ushort_t*)((char*)d_out + (size_t)NB * 64 * 8 * 8192 * 4);
  p.xT = (ushort_t*)((char*)d_out + (size_t)NB * 64 * 8 * 8192 * 6);
  p.mixed_b = (ushort_t*)take((size_t)NT * DM * 2);
  p.kpart = (float*)take((size_t)NB * 4 * 32 * 4 * 64 * 4);
  p.bcnt = (int*)take(256 * 4);
  p.blist = (int*)take((size_t)256 * 8192 * 4);
  p.pm = (float*)take((size_t)NT * 16 * 4);
  p.pl = (float*)take((size_t)NT * 16 * 4);
  p.pO = p.xbc_raw;
  p.eidx = (int*)take((size_t)NT * 128 * 4);
  p.egate = (float*)take((size_t)NT * 128 * 4);
  p.ed8 = (unsigned char*)take((size_t)16384 * DM);
  p.eu8 = (unsigned char*)take((size_t)16384 * DM);
  p.ed_s = (float*)take(16384 * 4);
  p.eu_s = (float*)take(16384 * 4);
  p.bar = (unsigned*)take(XCD_BAR_WORDS * 4);
  p.hss = (float*)take((size_t)NT * 16 * 4);
  p.skh = (ushort_t*)take(2 * 128 * 64 * 2);
  p.skl = (ushort_t*)take(2 * 128 * 64 * 2);
  if (o > ws_size) return;
  (void)hipMemsetAsync(p.bar, 0, XCD_BAR_WORDS * 4, stream);
  static int grid_blocks = 0;
  if (!grid_blocks) {
    int dev = 0, cus = 0, per_cu = 0;
    (void)hipGetDevice(&dev);
    (void)hipDeviceGetAttribute(&cus, hipDeviceAttributeMultiprocessorCount, dev);
    (void)hipOccupancyMaxActiveBlocksPerMultiprocessor(&per_cu, fwd_megakernel, 256, 0);
    if (per_cu > 2) per_cu = 2;
    if (per_cu < 1) per_cu = 1;
    grid_blocks = cus * per_cu;
  }
  void* args[] = {&p};
  hipError_t e = hipLaunchCooperativeKernel((void*)fwd_megakernel, dim3(grid_blocks), dim3(256), args, 0, stream);
  if (e != hipSuccess) fprintf(stderr, "cooperative launch failed: %s (grid %d)\n", hipGetErrorString(e), grid_blocks);
}
```

```cpp
#include <hip/hip_runtime.h>
#include <hip/hip_cooperative_groups.h>
#include <cstdio>
#include <math.h>
#include <stdint.h>
namespace cg = cooperative_groups;

#ifndef EX_FP4_DOWN
#define EX_FP4_DOWN 1
#endif
#ifndef EX_FP4_UP
#define EX_FP4_UP 1
#endif
namespace {
typedef unsigned short ushort_t;
typedef __attribute__((ext_vector_type(8))) short bf16x8;
typedef __attribute__((ext_vector_type(16))) float f32x16;

constexpr int DM = 1024;
constexpr int NB = 2;
constexpr int SL = 8192;
constexpr int NT = NB * SL;
constexpr int MEM = 256;
constexpr int INC = 2568;
constexpr int NPROJ = 2560;
constexpr float EPS = 1e-6f;
constexpr int SMEM_BYTES = 73728 + 256;

typedef __attribute__((ext_vector_type(4))) float f32x4_nt;
__device__ __forceinline__ float4 ld_nt4(const float* ptr) {
  const f32x4_nt v = __builtin_nontemporal_load((const f32x4_nt*)ptr);
  return make_float4(v.x, v.y, v.z, v.w);
}
__device__ __forceinline__ float silu_f(float x) { return x * __frcp_rn(1.f + __expf(-x)); }
__device__ __forceinline__ float softplus_f(float x) { return fmaxf(x, 0.f) + log1pf(expf(-fabsf(x))); }
__device__ __forceinline__ float gelu_f(float x) { return 0.5f * x * (1.f + erff(x * 0.70710678118654752f)); }
__device__ __forceinline__ float gelu_fast(float x) {
  const float z = fabsf(x) * 0.70710678118654752f;
  const float t = __frcp_rn(fmaf(0.3275911f, z, 1.f));
  float pl = fmaf(1.061405429f, t, -1.453152027f);
  pl = fmaf(pl, t, 1.421413741f);
  pl = fmaf(pl, t, -0.284496736f);
  pl = fmaf(pl, t, 0.254829592f);
  const float er = 1.f - pl * t * __expf(-z * z);
  return 0.5f * x * (1.f + copysignf(er, x));
}
typedef __attribute__((ext_vector_type(2))) __bf16 bf16x2_hw;
typedef __attribute__((ext_vector_type(2))) float f32x2_hw;
__device__ __forceinline__ unsigned pack2(float a, float b) {
  const f32x2_hw v = {a, b};
  return __builtin_bit_cast(unsigned, __builtin_convertvector(v, bf16x2_hw));
}
__device__ __forceinline__ ushort_t f2bf(float x) { return (ushort_t)(pack2(x, 0.f) & 0xffffu); }
__device__ __forceinline__ float bf2f(ushort_t h) { return __uint_as_float(((unsigned)h) << 16); }
__device__ __forceinline__ float bflo(unsigned w) { return __uint_as_float(w << 16); }
__device__ __forceinline__ float bfhi(unsigned w) { return __uint_as_float(w & 0xffff0000u); }

__device__ __forceinline__ void unpack8(const uint4 v, float (&f)[8]) {
  f[0] = bflo(v.x); f[1] = bfhi(v.x); f[2] = bflo(v.y); f[3] = bfhi(v.y);
  f[4] = bflo(v.z); f[5] = bfhi(v.z); f[6] = bflo(v.w); f[7] = bfhi(v.w);
}

__device__ __forceinline__ float wave_sum(float v) {
#pragma unroll
  for (int o = 32; o > 0; o >>= 1) v += __shfl_xor(v, o);
  return v;
}
__device__ __forceinline__ float wave_max(float v) {
#pragma unroll
  for (int o = 32; o > 0; o >>= 1) v = fmaxf(v, __shfl_xor(v, o));
  return v;
}


#define XB_TMO      128
#define XB_XCNT(j)  (256  + 64 * (j))
#define XB_XSUB(j)  (1280 + 64 * (j))
#define XB_XGEN(j)  (2304 + 64 * (j))
#define XB_TOP      3328
#define XB_TOPGEN   3392
#define XCD_BAR_WORDS 3456
#define XB_SPIN_CAP (1u << 20)
#define LAS __attribute__((address_space(3)))
__device__ __forceinline__ unsigned xb_ld(unsigned* p)              { return __hip_atomic_load(p, __ATOMIC_RELAXED, __HIP_MEMORY_SCOPE_AGENT); }
__device__ __forceinline__ unsigned xb_add(unsigned* p, unsigned v) { return __hip_atomic_fetch_add(p, v, __ATOMIC_RELAXED, __HIP_MEMORY_SCOPE_AGENT); }
__device__ __forceinline__ unsigned xb_xcc_id() { return (unsigned)__builtin_amdgcn_s_getreg((3 << 11) | 20) & 0xFu; }
#define XB_SPIN(cond, bar) do { unsigned _sp = 0; while (cond) { __builtin_amdgcn_s_sleep(1); \
    if ((++_sp & 255u) == 0u) { if (xb_ld(&(bar)[XB_TMO])) break; if (_sp > XB_SPIN_CAP) { atomicAdd(&(bar)[XB_TMO], 1u); break; } } } } while (0)
struct XcdBarrier { unsigned* bar; unsigned x; volatile LAS unsigned* st; };
__device__ __forceinline__ XcdBarrier xcd_barrier_post(unsigned* bar, volatile LAS unsigned* st) {
  XcdBarrier b; b.bar = bar; b.x = xb_xcc_id(); b.st = st;
  if (threadIdx.x == 0) (void)xb_add(&bar[XB_XCNT(b.x)], 1u);
  return b;
}
__device__ __forceinline__ void xcd_barrier_complete(unsigned* bar, unsigned x, unsigned& nloc, unsigned& nx) {
  const unsigned G = gridDim.x * gridDim.y * gridDim.z;
  unsigned sum, cnt, mine, sp = 0u;
  for (;;) {
    sum = 0u; cnt = 0u; mine = 0u;
#pragma unroll
    for (unsigned j = 0; j < 16; ++j) { const unsigned c = xb_ld(&bar[XB_XCNT(j)]); sum += c; cnt += (c > 0u) ? 1u : 0u; mine = (j == x) ? c : mine; }
    if (sum == G) break;
    __builtin_amdgcn_s_sleep(1);
    if ((++sp & 255u) == 0u) { if (xb_ld(&bar[XB_TMO])) break; if (sp > XB_SPIN_CAP) { atomicAdd(&bar[XB_TMO], 1u); break; } }
  }
  nloc = mine > 0u ? mine : 1u; nx = cnt > 0u ? cnt : 1u;
}
__device__ __forceinline__ void xcd_barrier(const XcdBarrier& b) {
  asm volatile("s_waitcnt vmcnt(0)" ::: "memory");
  __syncthreads();
  if (threadIdx.x == 0) {
    unsigned* bar = b.bar;
    __builtin_amdgcn_s_waitcnt(0);
    unsigned nloc = b.st[0], nx = b.st[1];
    if (nloc == 0u) { xcd_barrier_complete(bar, b.x, nloc, nx); b.st[0] = nloc; b.st[1] = nx; }
    const unsigned old = xb_add(&bar[XB_XSUB(b.x)], 1u);
    const unsigned gen = old / nloc;
    if (old + 1u == (gen + 1u) * nloc) {
      __builtin_amdgcn_fence(__ATOMIC_RELEASE, "agent");
      asm volatile("s_waitcnt vmcnt(0)" ::: "memory");
      const unsigned og = xb_add(&bar[XB_TOP], 1u);
      const unsigned tg = og / nx;
      if (og + 1u == (tg + 1u) * nx) xb_add(&bar[XB_TOPGEN], 1u);
      else XB_SPIN(xb_ld(&bar[XB_TOPGEN]) == tg, bar);
      __builtin_amdgcn_fence(__ATOMIC_ACQUIRE, "agent");
      xb_add(&bar[XB_XGEN(b.x)], 1u);
      asm volatile("s_waitcnt vmcnt(0)" ::: "memory");
    } else {
      XB_SPIN(xb_ld(&bar[XB_XGEN(b.x)]) == gen, bar);
      __builtin_amdgcn_fence(__ATOMIC_ACQUIRE, "agent");
      asm volatile("s_waitcnt vmcnt(0)" ::: "memory");
    }
  }
  __syncthreads();
}

struct Params {
  const float *x, *mem, *mix_norm_w, *w_in, *conv_w, *conv_b, *dt_bias, *a_log, *ssd_d, *ssd_norm_w, *mq_norm_w, *mk_norm_w,
      *mem_norm_w, *w_mem_kv, *xq_norm_w, *xk_norm_w, *w_out, *ffn_norm_w, *w_query, *sk1, *sk2, *e_down, *e_up;
  float* out;
  ushort_t *xn_b, *w_inT, *w_outT, *w_qT, *w_memT, *memn_b, *zs, *xbc_raw, *mq, *mk, *xq, *memk_b, *mixed_b;
  float *dt, *q, *egate, *acs, *cdec, *states;
  ushort_t *xc, *xT, *sin_b;
  int *eidx, *bcnt, *blist;
  unsigned* bar;
  float* hss;
  ushort_t *skh, *skl;
  unsigned char *ed8, *eu8;
  float *ed_s, *eu_s;
  float *kpart, *pm, *pl;
  ushort_t *vT, *memvT, *pO;
};

__device__ __forceinline__ void ph_rmsnorm_bf16(const int vb, const float* __restrict__ x, const float* __restrict__ w,
                                                ushort_t* __restrict__ outb, const float* s_wdt  , const float* __restrict__ dt_bias,
                                                float* __restrict__ dt) {
  const int lane = threadIdx.x & 63;
  const int row0 = vb * 8 + (threadIdx.x >> 6) * 2;
  float4 v[2][4];
#pragma unroll
  for (int rr = 0; rr < 2; ++rr)
#pragma unroll
    for (int i = 0; i < 4; ++i) v[rr][i] = ld_nt4(x + (size_t)(row0 + rr) * DM + i * 256 + lane * 4);
  float4 ww[4];
#pragma unroll
  for (int i = 0; i < 4; ++i) ww[i] = *(const float4*)(w + i * 256 + lane * 4);
#pragma unroll
  for (int rr = 0; rr < 2; ++rr) {
    const int row = row0 + rr;
    float ss = 0.f;
#pragma unroll
    for (int i = 0; i < 4; ++i) ss += v[rr][i].x * v[rr][i].x + v[rr][i].y * v[rr][i].y + v[rr][i].z * v[rr][i].z + v[rr][i].w * v[rr][i].w;
    ss = wave_sum(ss);
    const float r = rsqrtf(ss / DM + EPS);
    float part[8];
#pragma unroll
    for (int hh = 0; hh < 8; ++hh) part[hh] = 0.f;
#pragma unroll
    for (int i = 0; i < 4; ++i) {
      const float o0 = v[rr][i].x * r * ww[i].x, o1 = v[rr][i].y * r * ww[i].y, o2 = v[rr][i].z * r * ww[i].z, o3 = v[rr][i].w * r * ww[i].w;
      *(uint2*)(outb + (size_t)row * DM + i * 256 + lane * 4) = make_uint2(pack2(o0, o1), pack2(o2, o3));
      if (dt) {
        const float xs[4] = {o0, o1, o2, o3};
#pragma unroll
        for (int hh = 0; hh < 8; ++hh) {
          const float4 wv = *(const float4*)(s_wdt + hh * 1024 + i * 256 + lane * 4);
          part[hh] = fmaf(xs[0], wv.x, part[hh]); part[hh] = fmaf(xs[1], wv.y, part[hh]);
          part[hh] = fmaf(xs[2], wv.z, part[hh]); part[hh] = fmaf(xs[3], wv.w, part[hh]);
        }
      }
    }
    if (dt) {
      float mine = 0.f;
#pragma unroll
      for (int hh = 0; hh < 8; ++hh) {
        const float sfull = wave_sum(part[hh]);
        if (lane == hh) mine = sfull;
      }
      if (lane < 8) dt[(size_t)row * 8 + lane] = softplus_f(mine + dt_bias[lane]);
    }
  }
}

__device__ __forceinline__ void ph_wtrans(const int vb, float* smem, const float* __restrict__ W, const int ldw, ushort_t* __restrict__ Wt,
                                          const int ntiles, const int skip, const float* __restrict__ rowscale) {
  float (*s)[65] = (float (*)[65])smem;
  const int tid = threadIdx.x;
  const int kt = vb / ntiles, nt = vb % ntiles;
  const int nd0 = nt * 64;
  const int ns0 = (nd0 < 1536) ? nd0 : nd0 + skip;
  {
    const int k = tid >> 2, nc = (tid & 3) * 16;
    const float* src = W + (size_t)(kt * 64 + k) * ldw + ns0 + nc;
    const float rsc = rowscale ? rowscale[kt * 64 + k] : 1.f;
#pragma unroll
    for (int j = 0; j < 4; ++j) {
      float4 v = *(const float4*)(src + j * 4);
      v.x *= rsc; v.y *= rsc; v.z *= rsc; v.w *= rsc;
      s[k][nc + j * 4 + 0] = v.x; s[k][nc + j * 4 + 1] = v.y; s[k][nc + j * 4 + 2] = v.z; s[k][nc + j * 4 + 3] = v.w;
    }
  }
  __syncthreads();
  {
    const int n = tid >> 2, kc = (tid & 3) * 16;
    unsigned pk[8];
#pragma unroll
    for (int j = 0; j < 8; ++j) pk[j] = pack2(s[kc + 2 * j][n], s[kc + 2 * j + 1][n]);
    ushort_t* dst = Wt + (size_t)(nd0 + n) * DM + kt * 64 + kc;
    *(uint4*)(dst) = make_uint4(pk[0], pk[1], pk[2], pk[3]);
    *(uint4*)(dst + 8) = make_uint4(pk[4], pk[5], pk[6], pk[7]);
  }
}

__device__ __forceinline__ void ph_cvt(const int vb, const float* __restrict__ src, ushort_t* __restrict__ dst) {
  const size_t base = (size_t)vb * 8192 + threadIdx.x * 8;
  float4 a[4], b[4];
#pragma unroll
  for (int i = 0; i < 4; ++i) {
    a[i] = *(const float4*)(src + base + i * 2048);
    b[i] = *(const float4*)(src + base + i * 2048 + 4);
  }
#pragma unroll
  for (int i = 0; i < 4; ++i)
    *(uint4*)(dst + base + i * 2048) = make_uint4(pack2(a[i].x, a[i].y), pack2(a[i].z, a[i].w), pack2(b[i].x, b[i].y), pack2(b[i].z, b[i].w));
}


typedef __attribute__((ext_vector_type(2))) float f32x2_t;
__device__ __forceinline__ void ph_cvt8(const int vb, const float* __restrict__ src, unsigned char* __restrict__ dst, float* __restrict__ inv_scale) {
  const int lane = threadIdx.x & 63;
  const int row = vb * 4 + (threadIdx.x >> 6);
  const float* sr = src + (size_t)row * DM + lane * 16;
  float4 v[4];
#pragma unroll
  for (int i = 0; i < 4; ++i) v[i] = ld_nt4(sr + i * 4);
  float am = 0.f;
#pragma unroll
  for (int i = 0; i < 4; ++i) am = fmaxf(fmaxf(fmaxf(am, fabsf(v[i].x)), fmaxf(fabsf(v[i].y), fabsf(v[i].z))), fabsf(v[i].w));
  am = wave_max(am);
  const float sc = (am > 0.f) ? 224.f / am : 1.f;
  unsigned w[4];
#pragma unroll
  for (int i = 0; i < 4; ++i) {
    int t = 0;
    t = __builtin_amdgcn_cvt_pk_fp8_f32(v[i].x * sc, v[i].y * sc, t, false);
    t = __builtin_amdgcn_cvt_pk_fp8_f32(v[i].z * sc, v[i].w * sc, t, true);
    w[i] = (unsigned)t;
  }
  *(uint4*)(dst + (size_t)row * DM + lane * 16) = make_uint4(w[0], w[1], w[2], w[3]);
  if (lane == 0) inv_scale[row] = (am > 0.f) ? am * (1.f / 224.f) : 1.f;
}

__device__ __forceinline__ void ph_cvt4(const int vb, const float* __restrict__ src, unsigned char* __restrict__ dst, float* __restrict__ inv_scale) {
  const int lane = threadIdx.x & 63;
  const int row = vb * 4 + (threadIdx.x >> 6);
  const float* sr = src + (size_t)row * DM + lane * 16;
  float4 v[4];
#pragma unroll
  for (int i = 0; i < 4; ++i) v[i] = ld_nt4(sr + i * 4);
  float am = 0.f;
#pragma unroll
  for (int i = 0; i < 4; ++i) am = fmaxf(fmaxf(fmaxf(am, fabsf(v[i].x)), fmaxf(fabsf(v[i].y), fabsf(v[i].z))), fabsf(v[i].w));
  am = wave_max(am);
  const float sc = (am > 0.f) ? 6.f / am : 1.f;
  unsigned w0 = 0u, w1 = 0u;
  w0 = __builtin_amdgcn_cvt_scalef32_pk_fp4_f32(w0, v[0].x * sc, v[0].y * sc, 1.0f, 0);
  w0 = __builtin_amdgcn_cvt_scalef32_pk_fp4_f32(w0, v[0].z * sc, v[0].w * sc, 1.0f, 1);
  w0 = __builtin_amdgcn_cvt_scalef32_pk_fp4_f32(w0, v[1].x * sc, v[1].y * sc, 1.0f, 2);
  w0 = __builtin_amdgcn_cvt_scalef32_pk_fp4_f32(w0, v[1].z * sc, v[1].w * sc, 1.0f, 3);
  w1 = __builtin_amdgcn_cvt_scalef32_pk_fp4_f32(w1, v[2].x * sc, v[2].y * sc, 1.0f, 0);
  w1 = __builtin_amdgcn_cvt_scalef32_pk_fp4_f32(w1, v[2].z * sc, v[2].w * sc, 1.0f, 1);
  w1 = __builtin_amdgcn_cvt_scalef32_pk_fp4_f32(w1, v[3].x * sc, v[3].y * sc, 1.0f, 2);
  w1 = __builtin_amdgcn_cvt_scalef32_pk_fp4_f32(w1, v[3].z * sc, v[3].w * sc, 1.0f, 3);
  *(uint2*)(dst + (size_t)row * (DM / 2) + lane * 8) = make_uint2(w0, w1);
  if (lane == 0) inv_scale[row] = (am > 0.f) ? am * (1.f / 6.f) : 1.f;
}
__device__ __forceinline__ void dec16_fp8(const uint4 d, f32x2_t (&o)[8]) {
  const unsigned w[4] = {d.x, d.y, d.z, d.w};
#pragma unroll
  for (int k = 0; k < 4; ++k) {
    o[2 * k] = __builtin_amdgcn_cvt_pk_f32_fp8((int)w[k], false);
    o[2 * k + 1] = __builtin_amdgcn_cvt_pk_f32_fp8((int)w[k], true);
  }
}
__device__ __forceinline__ void dec16_fp4(const uint2 d, f32x2_t (&o)[8]) {
  o[0] = __builtin_amdgcn_cvt_scalef32_pk_f32_fp4(d.x, 1.0f, 0); o[1] = __builtin_amdgcn_cvt_scalef32_pk_f32_fp4(d.x, 1.0f, 1);
  o[2] = __builtin_amdgcn_cvt_scalef32_pk_f32_fp4(d.x, 1.0f, 2); o[3] = __builtin_amdgcn_cvt_scalef32_pk_f32_fp4(d.x, 1.0f, 3);
  o[4] = __builtin_amdgcn_cvt_scalef32_pk_f32_fp4(d.y, 1.0f, 0); o[5] = __builtin_amdgcn_cvt_scalef32_pk_f32_fp4(d.y, 1.0f, 1);
  o[6] = __builtin_amdgcn_cvt_scalef32_pk_f32_fp4(d.y, 1.0f, 2); o[7] = __builtin_amdgcn_cvt_scalef32_pk_f32_fp4(d.y, 1.0f, 3);
}
#if EX_FP4_DOWN
typedef uint2 drow_t;
#define DROW_BYTES 8
#define DEC_D dec16_fp4
#else
typedef uint4 drow_t;
#define DROW_BYTES 16
#define DEC_D dec16_fp8
#endif
#if EX_FP4_UP
typedef uint2 urow_t;
#define UROW_BYTES 8
#define DEC_U dec16_fp4
#else
typedef uint4 urow_t;
#define UROW_BYTES 16
#define DEC_U dec16_fp8
#endif

__device__ __forceinline__ int swz(int row, int ch) { return row * 128 + ((ch ^ ((row >> 1) & 7)) << 4); }

__device__ __forceinline__ void gemm_compute(const char* cA, const char* cB, const int arow, const int brow, const int xr, const int h,
                                             f32x16 (&acc)[2][2]) {
#pragma unroll
  for (int ks = 0; ks < 4; ++ks) {
    const int co = ((ks * 2 + h) ^ xr) << 4;
    bf16x8 a0 = *(const bf16x8*)(cA + arow + co);
    bf16x8 a1 = *(const bf16x8*)(cA + arow + 32 * 128 + co);
    bf16x8 b0 = *(const bf16x8*)(cB + brow + co);
    bf16x8 b1 = *(const bf16x8*)(cB + brow + 32 * 128 + co);
    acc[0][0] = __builtin_amdgcn_mfma_f32_32x32x16_bf16(a0, b0, acc[0][0], 0, 0, 0);
    acc[0][1] = __builtin_amdgcn_mfma_f32_32x32x16_bf16(a0, b1, acc[0][1], 0, 0, 0);
    acc[1][0] = __builtin_amdgcn_mfma_f32_32x32x16_bf16(a1, b0, acc[1][0], 0, 0, 0);
    acc[1][1] = __builtin_amdgcn_mfma_f32_32x32x16_bf16(a1, b1, acc[1][1], 0, 0, 0);
  }
}

__device__ __forceinline__ void gemm_core(const ushort_t* __restrict__ A, const ushort_t* __restrict__ Bt, const int K, const int m0,
                                          const int n0, char* smem, f32x16 (&acc)[2][2]) {
  int tid = threadIdx.x;
  asm volatile("" : "+v"(tid));
  const int lane = tid & 63;
  const int wave = __builtin_amdgcn_readfirstlane(tid >> 6);
  const int wm = wave >> 1, wn = wave & 1;
  const int r = lane & 31, h = lane >> 5;
  const int srow = wave * 8 + (lane >> 3);
  const int schs = (lane & 7) ^ ((srow >> 1) & 7);
  const ushort_t* Ag = A + (size_t)(m0 + srow) * K + schs * 8;
  const ushort_t* Bg = Bt + (size_t)(n0 + srow) * K + schs * 8;
  const size_t rs = (size_t)32 * K;
  char* wbase = smem + wave * 1024;
#define GLDS_TILE(BUF, koff) { \
    __builtin_amdgcn_global_load_lds((const unsigned*)(Ag + (koff)), (unsigned*)(wbase + (BUF)), 16, 0, 0); \
    __builtin_amdgcn_global_load_lds((const unsigned*)(Ag + rs + (koff)), (unsigned*)(wbase + (BUF) + 4096), 16, 0, 0); \
    __builtin_amdgcn_global_load_lds((const unsigned*)(Ag + 2 * rs + (koff)), (unsigned*)(wbase + (BUF) + 8192), 16, 0, 0); \
    __builtin_amdgcn_global_load_lds((const unsigned*)(Ag + 3 * rs + (koff)), (unsigned*)(wbase + (BUF) + 12288), 16, 0, 0); \
    __builtin_amdgcn_global_load_lds((const unsigned*)(Bg + (koff)), (unsigned*)(wbase + (BUF) + 16384), 16, 0, 0); \
    __builtin_amdgcn_global_load_lds((const unsigned*)(Bg + rs + (koff)), (unsigned*)(wbase + (BUF) + 16384 + 4096), 16, 0, 0); \
    __builtin_amdgcn_global_load_lds((const unsigned*)(Bg + 2 * rs + (koff)), (unsigned*)(wbase + (BUF) + 16384 + 8192), 16, 0, 0); \
    __builtin_amdgcn_global_load_lds((const unsigned*)(Bg + 3 * rs + (koff)), (unsigned*)(wbase + (BUF) + 16384 + 12288), 16, 0, 0); }
  GLDS_TILE(0, 0)
#pragma unroll
  for (int i = 0; i < 2; ++i)
#pragma unroll
    for (int j = 0; j < 2; ++j)
#pragma unroll
      for (int e = 0; e < 16; ++e) acc[i][j][e] = 0.f;
  const int nk = K >> 6;
  const int xr = (r >> 1) & 7;
  const int arow = (wm * 64 + r) * 128, brow = (wn * 64 + r) * 128;
  asm volatile("s_waitcnt vmcnt(0)" ::: "memory");
  __syncthreads();
#pragma unroll 1
  for (int kt = 0; kt < nk; kt += 2) {
    GLDS_TILE(32768, (kt + 1) * 64)
    gemm_compute(smem, smem + 16384, arow, brow, xr, h, acc);
    asm volatile("s_waitcnt vmcnt(0)" ::: "memory");
    __syncthreads();
    if (kt + 2 < nk) { GLDS_TILE(0, (kt + 2) * 64) }
    gemm_compute(smem + 32768, smem + 32768 + 16384, arow, brow, xr, h, acc);
    asm volatile("s_waitcnt vmcnt(0)" ::: "memory");
    __syncthreads();
  }
#undef GLDS_TILE
}

enum { EP_SILU = 0, EP_PLAIN = 1, EP_HEADNORM = 2 };

__device__ __forceinline__ void stage_flush_bf16(const char* sw, ushort_t* __restrict__ dst, const size_t ld, const size_t row0, const int col0) {
  const int lane = threadIdx.x & 63;
  const int rr = lane >> 3, ch = lane & 7;
#pragma unroll
  for (int i = 0; i < 8; ++i) {
    const int row = i * 8 + rr;
    const uint4 v = *(const uint4*)(sw + row * 144 + ch * 16);
    *(uint4*)(dst + (row0 + row) * ld + col0 + ch * 8) = v;
  }
}

__device__ __forceinline__ void epi_bf16(char* smem, const f32x16 (&acc)[2][2], const int mode, ushort_t* __restrict__ dst, const int ld,
                                         const int row0, const int col0, const float* __restrict__ nw, float* __restrict__ kp) {
  const int lane = threadIdx.x & 63, r = lane & 31, h = lane >> 5;
  char* sw = smem + (threadIdx.x >> 6) * 9216;
  float w0 = 1.f, w1 = 1.f;
  if (mode == EP_HEADNORM) { w0 = nw[r]; w1 = nw[32 + r]; }
  float cs0 = 0.f, cs1 = 0.f;
#pragma unroll
  for (int mi = 0; mi < 2; ++mi) {
#pragma unroll
    for (int e = 0; e < 16; ++e) {
      const int row = mi * 32 + (e & 3) + 8 * (e >> 2) + 4 * h;
      float v0 = acc[mi][0][e], v1 = acc[mi][1][e];
      if (mode == EP_SILU) { v0 = silu_f(v0); v1 = silu_f(v1); }
      if (mode == EP_HEADNORM) {
        float ss = v0 * v0 + v1 * v1;
        ss += __shfl_xor(ss, 1); ss += __shfl_xor(ss, 2); ss += __shfl_xor(ss, 4); ss += __shfl_xor(ss, 8); ss += __shfl_xor(ss, 16);
        const float rs = rsqrtf(ss * (1.f / 64.f) + EPS);
        v0 = v0 * rs * w0; v1 = v1 * rs * w1;
        cs0 += v0; cs1 += v1;
      }
      *(ushort_t*)(sw + row * 144 + r * 2) = f2bf(v0);
      *(ushort_t*)(sw + row * 144 + 64 + r * 2) = f2bf(v1);
    }
  }
  if (kp) {
    cs0 += __shfl_xor(cs0, 32);
    cs1 += __shfl_xor(cs1, 32);
    if (h == 0) { kp[r] = cs0; kp[32 + r] = cs1; }
  }
  stage_flush_bf16(sw, dst, (size_t)ld, (size_t)row0, col0);
}

__device__ __forceinline__ void epi_bf16_T(char* smem, const f32x16 (&acc)[2][2], ushort_t* __restrict__ dstT, const size_t ldT, const int rowpos0) {
  const int lane = threadIdx.x & 63, r = lane & 31, h = lane >> 5;
  char* sw = smem + (threadIdx.x >> 6) * 9216;
#pragma unroll
  for (int ni = 0; ni < 2; ++ni) {
#pragma unroll
    for (int mi = 0; mi < 2; ++mi) {
#pragma unroll
      for (int q4 = 0; q4 < 4; ++q4) {
        const int rp = mi * 32 + 8 * q4 + 4 * h;
        *(uint2*)(sw + (ni * 32 + r) * 144 + rp * 2) = make_uint2(pack2(acc[mi][ni][4 * q4 + 0], acc[mi][ni][4 * q4 + 1]),
                                                                    pack2(acc[mi][ni][4 * q4 + 2], acc[mi][ni][4 * q4 + 3]));
      }
    }
  }
  stage_flush_bf16(sw, dstT, ldT, 0, rowpos0);
}

__device__ __forceinline__ void epi_f32(char* smem, const f32x16 (&acc)[2][2], float* __restrict__ dst, const int ld, const int row0, const int col0,
                                        const float* __restrict__ resid, ushort_t* __restrict__ dstb, float* __restrict__ hss) {
  const int lane = threadIdx.x & 63, r = lane & 31, h = lane >> 5;
  char* sw = smem + (threadIdx.x >> 6) * 17408;
#pragma unroll
  for (int mi = 0; mi < 2; ++mi) {
#pragma unroll
    for (int e = 0; e < 16; ++e) {
      const int row = mi * 32 + (e & 3) + 8 * (e >> 2) + 4 * h;
      *(float*)(sw + row * 272 + r * 4) = acc[mi][0][e];
      *(float*)(sw + row * 272 + 128 + r * 4) = acc[mi][1][e];
    }
  }
  const int rr = lane >> 4, ch = lane & 15;
#pragma unroll
  for (int hb = 0; hb < 2; ++hb) {
    float4 rv[8];
    if (resid) {
#pragma unroll
      for (int i = 0; i < 8; ++i) rv[i] = ld_nt4(resid + (size_t)(row0 + (hb * 8 + i) * 4 + rr) * ld + col0 + ch * 4);
    }
#pragma unroll
    for (int i = 0; i < 8; ++i) {
      const int row = (hb * 8 + i) * 4 + rr;
      float4 v = *(const float4*)(sw + row * 272 + ch * 16);
      if (resid) { v.x += rv[i].x; v.y += rv[i].y; v.z += rv[i].z; v.w += rv[i].w; }
      *(float4*)(dst + (size_t)(row0 + row) * ld + col0 + ch * 4) = v;
      if (dstb) {
        *(uint2*)(dstb + (size_t)(row0 + row) * ld + col0 + ch * 4) = make_uint2(pack2(v.x, v.y), pack2(v.z, v.w));
        float ss = v.x * v.x + v.y * v.y + v.z * v.z + v.w * v.w;
        ss += __shfl_xor(ss, 1); ss += __shfl_xor(ss, 2); ss += __shfl_xor(ss, 4); ss += __shfl_xor(ss, 8);
        if (ch == 0) hss[(size_t)(row0 + row) * 16 + (col0 >> 6)] = ss;
      }
    }
  }
}

__device__ __forceinline__ void ph_gemm_proj(const int vb, char* smem, const Params& p) {
  const int nt = vb % 20, mt = vb / 20;
  const int m0 = mt * 128, n0 = nt * 128;
  f32x16 acc[2][2];
  gemm_core(p.xn_b, p.w_inT, DM, m0, n0, smem, acc);
  const int wave = threadIdx.x >> 6, wm = wave >> 1, wn = wave & 1;
  const int row0 = m0 + wm * 64;
  const int c = n0 + wn * 64;
  if (c < 512) epi_bf16(smem, acc, EP_SILU, p.zs, 512, row0, c, nullptr, nullptr);
  else if (c < 1536) epi_bf16(smem, acc, EP_PLAIN, p.xbc_raw, 1024, row0, c - 512, nullptr, nullptr);
  else if (c < 1792) epi_bf16(smem, acc, EP_HEADNORM, p.mq, 256, row0, c - 1536, p.mq_norm_w, nullptr);
  else if (c < 2048) {
    const int hh = (c - 1792) >> 6, bb = row0 >> 13, lpos = row0 & (SL - 1);
    epi_bf16(smem, acc, EP_HEADNORM, p.mk, 256, row0, c - 1792, p.mk_norm_w, p.kpart + ((size_t)((bb * 4 + hh) * 32 + (lpos >> 8)) * 4 + ((lpos >> 6) & 3)) * 64);
  } else if (c < 2304) {
    const int hh = (c - 2048) >> 6, bb = row0 >> 13, lpos = row0 & (SL - 1);
    epi_bf16_T(smem, acc, p.vT + (size_t)(bb * 4 + hh) * 64 * SL, SL, lpos);
  }
  else epi_bf16(smem, acc, EP_HEADNORM, p.xq, 256, row0, c - 2304, p.xq_norm_w, nullptr);
}

__device__ __forceinline__ void ph_gemm_mem(const int vb, char* smem, const Params& p) {
  const int nt = vb % 4, mt = vb / 4;
  const int m0 = mt * 128, n0 = nt * 128;
  f32x16 acc[2][2];
  gemm_core(p.memn_b, p.w_memT, DM, m0, n0, smem, acc);
  const int wave = threadIdx.x >> 6, wm = wave >> 1, wn = wave & 1;
  const int row0 = m0 + wm * 64;
  const int c = n0 + wn * 64;
  if (c < 256) epi_bf16(smem, acc, EP_HEADNORM, p.memk_b, 256, row0, c, p.xk_norm_w, nullptr);
  else {
    const int hh = (c - 256) >> 6, bb = row0 >> 8, mpos = row0 & 255;
    epi_bf16_T(smem, acc, p.memvT + (size_t)(bb * 4 + hh) * 64 * MEM, MEM, mpos);
  }
}

__device__ __forceinline__ void ph_gemm_f32(const int vb, char* smem, const ushort_t* A, const ushort_t* Bt, float* dst, const float* resid, ushort_t* dstb, float* hss) {
  const int nt = vb % 8, mt = vb / 8;
  const int m0 = mt * 128, n0 = nt * 128;
  f32x16 acc[2][2];
  gemm_core(A, Bt, DM, m0, n0, smem, acc);
  const int wave = threadIdx.x >> 6, wm = wave >> 1, wn = wave & 1;
  epi_f32(smem, acc, dst, DM, m0 + wm * 64, n0 + wn * 64, resid, dstb, hss);
}

__device__ __forceinline__ int swz256(int row, int ch) { return row * 272 + (ch << 4); }
__device__ __forceinline__ int crow16(int e, int hl) { return (e & 3) + 8 * (e >> 2) + 4 * hl; }

__device__ __forceinline__ void ph_ssd1(const int vb, char* smem, const Params& p) {
  const int h = vb & 7, c = (vb >> 3) & 63, b = vb >> 9;
  const int g = h >> 2, hq = h & 3;
  int tid = threadIdx.x;
  asm volatile("" : "+v"(tid));
  const int lane = tid & 63, wave = tid >> 6;
  const int t0 = b * SL + c * 128;
  char* s_xw = smem;
  char* s_bt = smem + 17408;
  float* s_acs = (float*)(smem + 52224);
  float* s_w = s_acs + 128;
  float* s_red = s_w + 128;
  const float a_coef = -expf(p.a_log[h]);
  float dtv = 0.f, cs = 0.f;
  if (tid < 128) {
    dtv = p.dt[(size_t)(t0 + tid) * 8 + h];
    cs = dtv * a_coef;
#pragma unroll
    for (int o = 1; o < 64; o <<= 1) {
      float nb = __shfl_up(cs, o);
      if (lane >= o) cs += nb;
    }
    if (lane == 63) s_red[wave] = cs;
  }
  __syncthreads();
  if (tid < 128) {
    if (wave == 1) cs += s_red[0];
    s_acs[tid] = cs;
    p.acs[(size_t)(t0 + tid) * 8 + h] = cs;
  }
  __syncthreads();
  if (tid < 128) {
    const float tot = s_acs[127];
    s_w[tid] = dtv * expf(tot - cs);
    if (tid == 0) p.cdec[(b * 64 + c) * 8 + h] = expf(tot);
  }
  __syncthreads();
  if (tid < 224) {
    const int seg = tid / 28, cg = tid - seg * 28;
    const bool is_x = cg < 8, is_b = (cg >= 8) && (cg < 24);
    int ch0, trow;
    if (is_x) { ch0 = h * 64 + cg * 8; trow = cg * 8; }
    else if (is_b) { ch0 = 512 + g * 128 + (cg - 8) * 8; trow = (cg - 8) * 8; }
    else { ch0 = 768 + g * 128 + hq * 32 + (cg - 24) * 8; trow = 0; }
    const bool wr_nat = is_x || !is_b || (hq == 0);
    char* tbase = is_x ? s_xw : s_bt;
    const int l0 = seg * 16;
    float w0[8], w1[8], w2[8], w3[8], bias[8];
    {
      const float* cw = p.conv_w + ch0;
      float4 a, bq;
      a = *(const float4*)(cw); bq = *(const float4*)(cw + 4);
      w0[0] = a.x; w0[1] = a.y; w0[2] = a.z; w0[3] = a.w; w0[4] = bq.x; w0[5] = bq.y; w0[6] = bq.z; w0[7] = bq.w;
      a = *(const float4*)(cw + 1024); bq = *(const float4*)(cw + 1028);
      w1[0] = a.x; w1[1] = a.y; w1[2] = a.z; w1[3] = a.w; w1[4] = bq.x; w1[5] = bq.y; w1[6] = bq.z; w1[7] = bq.w;
      a = *(const float4*)(cw + 2048); bq = *(const float4*)(cw + 2052);
      w2[0] = a.x; w2[1] = a.y; w2[2] = a.z; w2[3] = a.w; w2[4] = bq.x; w2[5] = bq.y; w2[6] = bq.z; w2[7] = bq.w;
      a = *(const float4*)(cw + 3072); bq = *(const float4*)(cw + 3076);
      w3[0] = a.x; w3[1] = a.y; w3[2] = a.z; w3[3] = a.w; w3[4] = bq.x; w3[5] = bq.y; w3[6] = bq.z; w3[7] = bq.w;
      a = *(const float4*)(p.conv_b + ch0); bq = *(const float4*)(p.conv_b + ch0 + 4);
      bias[0] = a.x; bias[1] = a.y; bias[2] = a.z; bias[3] = a.w; bias[4] = bq.x; bias[5] = bq.y; bias[6] = bq.z; bias[7] = bq.w;
    }
    float r0[8], r1[8], r2[8];
    {
      const int lg = c * 128 + l0;
      const ushort_t* src = p.xbc_raw + (size_t)(t0 + l0) * 1024 + ch0;
      uint4 z4 = make_uint4(0u, 0u, 0u, 0u);
      uint4 u0 = (lg >= 3) ? *(const uint4*)(src - 3 * 1024) : z4;
      uint4 u1 = (lg >= 2) ? *(const uint4*)(src - 2 * 1024) : z4;
      uint4 u2 = (lg >= 1) ? *(const uint4*)(src - 1 * 1024) : z4;
      unpack8(u0, r0); unpack8(u1, r1); unpack8(u2, r2);
    }
    unsigned outp[8][8];
    float lo[8], los[8];
#pragma unroll
    for (int i = 0; i < 16; ++i) {
      float cur[8], val[8];
      unpack8(*(const uint4*)(p.xbc_raw + (size_t)(t0 + l0 + i) * 1024 + ch0), cur);
#pragma unroll
      for (int j = 0; j < 8; ++j) {
        float v = bias[j];
        v = fmaf(w0[j], r0[j], v); v = fmaf(w1[j], r1[j], v); v = fmaf(w2[j], r2[j], v); v = fmaf(w3[j], cur[j], v);
        val[j] = silu_f(v);
        r0[j] = r1[j]; r1[j] = r2[j]; r2[j] = cur[j];
      }
      if (wr_nat) {
        *(uint4*)(p.xc + (size_t)(t0 + l0 + i) * 1024 + ch0) =
            make_uint4(pack2(val[0], val[1]), pack2(val[2], val[3]), pack2(val[4], val[5]), pack2(val[6], val[7]));
      }
      const float scl = is_x ? s_w[l0 + i] : 1.f;
      if ((i & 1) == 0) {
#pragma unroll
        for (int j = 0; j < 8; ++j) { lo[j] = val[j]; los[j] = val[j] * scl; }
      } else {
        const int chunk = seg * 2 + (i >> 3);
#pragma unroll
        for (int j = 0; j < 8; ++j) {
          outp[j][i >> 1] = pack2(lo[j], val[j]);
          if (is_x || is_b) *(unsigned*)(tbase + swz256(trow + j, chunk) + ((i & 7) - 1) * 2) = pack2(los[j], val[j] * scl);
        }
      }
    }
    if (is_x) {
      ushort_t* dst = p.xT + ((size_t)((b * 64 + c) * 8 + h) * 64 + cg * 8) * 128 + l0;
#pragma unroll
      for (int j = 0; j < 8; ++j) {
        *(uint4*)(dst + (size_t)j * 128) = make_uint4(outp[j][0], outp[j][1], outp[j][2], outp[j][3]);
        *(uint4*)(dst + (size_t)j * 128 + 8) = make_uint4(outp[j][4], outp[j][5], outp[j][6], outp[j][7]);
      }
    }
  }
  __syncthreads();
  {
    const int r = lane & 31, hl = lane >> 5;
    f32x16 acc[2];
#pragma unroll
    for (int e = 0; e < 16; ++e) { acc[0][e] = 0.f; acc[1][e] = 0.f; }
#pragma unroll
    for (int ks = 0; ks < 8; ++ks) {
      const bf16x8 bfr = *(const bf16x8*)(s_bt + swz256(32 * wave + r, ks * 2 + hl));
      const bf16x8 a0 = *(const bf16x8*)(s_xw + swz256(r, ks * 2 + hl));
      const bf16x8 a1 = *(const bf16x8*)(s_xw + swz256(32 + r, ks * 2 + hl));
      acc[0] = __builtin_amdgcn_mfma_f32_32x32x16_bf16(a0, bfr, acc[0], 0, 0, 0);
      acc[1] = __builtin_amdgcn_mfma_f32_32x32x16_bf16(a1, bfr, acc[1], 0, 0, 0);
    }
    float* dst = p.states + (size_t)((b * 64 + c) * 8 + h) * 64 * 128;
#pragma unroll
    for (int pt = 0; pt < 2; ++pt)
#pragma unroll
      for (int e = 0; e < 16; ++e) dst[(size_t)(pt * 32 + crow16(e, hl)) * 128 + 32 * wave + r] = acc[pt][e];
  }
}

__device__ __forceinline__ void ph_ssd2(const int vb, const Params& p) {
  const int idx = vb * 256 + threadIdx.x;
  const int pn = idx & 8191, h = (idx >> 13) & 7, b = idx >> 16;
  float st = 0.f;
#pragma unroll 1
  for (int c0 = 0; c0 < 64; c0 += 8) {
    float sv[8], dv[8];
#pragma unroll
    for (int i = 0; i < 8; ++i) {
      const int cc = (b * 64 + c0 + i) * 8 + h;
      sv[i] = p.states[(size_t)cc * 8192 + pn];
      dv[i] = p.cdec[cc];
    }
#pragma unroll
    for (int i = 0; i < 8; ++i) {
      const int cc = (b * 64 + c0 + i) * 8 + h;
      p.sin_b[(size_t)cc * 8192 + pn] = f2bf(st);
      st = fmaf(st, dv[i], sv[i]);
    }
  }
}

__device__ __forceinline__ void ph_ssd3(const int vb, char* smem, const Params& p) {
  const int g = vb & 1, c = (vb >> 1) & 63, b = vb >> 7;
  int tid = threadIdx.x;
  asm volatile("" : "+v"(tid));
  const int lane = tid & 63;
  const int w = __builtin_amdgcn_readfirstlane(tid >> 6);
  const int r = lane & 31, hl = lane >> 5;
  const int t0 = b * SL + c * 128;
  char* s_C = smem;
  char* s_B = smem + 34816;
  char* s_xT = smem + 34816;
  char* s_S = smem + 34816 + 16896;
  float* s_acs = (float*)(smem + 69632);
  float* s_dt = s_acs + 512;
  {
    const int ch = tid & 15, r0 = tid >> 4;
#pragma unroll
    for (int i = 0; i < 8; ++i) {
      const int row = r0 + 16 * i;
      const ushort_t* src = p.xc + (size_t)(t0 + row) * 1024 + g * 128 + ch * 8;
      *(uint4*)(s_B + swz256(row, ch)) = *(const uint4*)(src + 512);
      *(uint4*)(s_C + swz256(row, ch)) = *(const uint4*)(src + 768);
    }
    if (tid < 128) {
#pragma unroll
      for (int hh = 0; hh < 4; ++hh) {
        s_acs[hh * 128 + tid] = p.acs[(size_t)(t0 + tid) * 8 + g * 4 + hh];
        s_dt[hh * 128 + tid] = p.dt[(size_t)(t0 + tid) * 8 + g * 4 + hh];
      }
    }
  }
  __syncthreads();
  bf16x8 cfr[8];
#pragma unroll
  for (int ks = 0; ks < 8; ++ks) cfr[ks] = *(const bf16x8*)(s_C + swz256(32 * w + r, ks * 2 + hl));
  f32x16 gt[4];
#pragma unroll
  for (int st = 0; st < 4; ++st) {
#pragma unroll
    for (int e = 0; e < 16; ++e) gt[st][e] = 0.f;
    if (st <= w) {
#pragma unroll
      for (int ks = 0; ks < 8; ++ks) {
        const bf16x8 a = *(const bf16x8*)(s_B + swz256(32 * st + r, ks * 2 + hl));
        gt[st] = __builtin_amdgcn_mfma_f32_32x32x16_bf16(a, cfr[ks], gt[st], 0, 0, 0);
      }
    }
  }
  __syncthreads();
  float ssq = 0.f;
  const int lane_c = lane;
  uint4 PX0, PX1, PX2, PX3, PS0, PS1, PS2, PS3;
  {
    const int ch = tid & 15, r0 = tid >> 4;
    const size_t base = (size_t)((b * 64 + c) * 8 + g * 4) * 8192 + (size_t)r0 * 128 + ch * 8;
    PX0 = *(const uint4*)(p.xT + base); PX1 = *(const uint4*)(p.xT + base + 16 * 128);
    PX2 = *(const uint4*)(p.xT + base + 32 * 128); PX3 = *(const uint4*)(p.xT + base + 48 * 128);
    PS0 = *(const uint4*)(p.sin_b + base); PS1 = *(const uint4*)(p.sin_b + base + 16 * 128);
    PS2 = *(const uint4*)(p.sin_b + base + 32 * 128); PS3 = *(const uint4*)(p.sin_b + base + 48 * 128);
  }
#pragma unroll 1
  for (int hh = 0; hh < 4; ++hh) {
    int lane_o = lane_c;
    asm volatile("" : "+v"(lane_o));
    const int r = lane_o & 31, hl = lane_o >> 5;
    const int l = 32 * w + r;
    const int hg = g * 4 + hh;
    {
      const int ch = tid & 15, r0 = tid >> 4;
      *(uint2*)(s_xT + (r0) * 264 + ch * 16) = make_uint2(PX0.x, PX0.y); *(uint2*)(s_xT + (r0) * 264 + ch * 16 + 8) = make_uint2(PX0.z, PX0.w);
      *(uint2*)(s_xT + (r0 + 16) * 264 + ch * 16) = make_uint2(PX1.x, PX1.y); *(uint2*)(s_xT + (r0 + 16) * 264 + ch * 16 + 8) = make_uint2(PX1.z, PX1.w);
      *(uint2*)(s_xT + (r0 + 32) * 264 + ch * 16) = make_uint2(PX2.x, PX2.y); *(uint2*)(s_xT + (r0 + 32) * 264 + ch * 16 + 8) = make_uint2(PX2.z, PX2.w);
      *(uint2*)(s_xT + (r0 + 48) * 264 + ch * 16) = make_uint2(PX3.x, PX3.y); *(uint2*)(s_xT + (r0 + 48) * 264 + ch * 16 + 8) = make_uint2(PX3.z, PX3.w);
      *(uint4*)(s_S + swz256(r0, ch)) = PS0; *(uint4*)(s_S + swz256(r0 + 16, ch)) = PS1;
      *(uint4*)(s_S + swz256(r0 + 32, ch)) = PS2; *(uint4*)(s_S + swz256(r0 + 48, ch)) = PS3;
      const int hn = (hh < 3) ? hg + 1 : hg;
      const size_t base = (size_t)((b * 64 + c) * 8 + hn) * 8192 + (size_t)r0 * 128 + ch * 8;
      PX0 = *(const uint4*)(p.xT + base); PX1 = *(const uint4*)(p.xT + base + 16 * 128);
      PX2 = *(const uint4*)(p.xT + base + 32 * 128); PX3 = *(const uint4*)(p.xT + base + 48 * 128);
      PS0 = *(const uint4*)(p.sin_b + base); PS1 = *(const uint4*)(p.sin_b + base + 16 * 128);
      PS2 = *(const uint4*)(p.sin_b + base + 32 * 128); PS3 = *(const uint4*)(p.sin_b + base + 48 * 128);
    }
    __syncthreads();
    const float acs_l = s_acs[hh * 128 + l];
    const float dsk = p.ssd_d[hg];
    f32x16 acc[2];
#pragma unroll
    for (int e = 0; e < 16; ++e) { acc[0][e] = 0.f; acc[1][e] = 0.f; }
#pragma unroll
    for (int ks = 0; ks < 8; ++ks) {
      const bf16x8 a0 = *(const bf16x8*)(s_S + swz256(r, ks * 2 + hl));
      const bf16x8 a1 = *(const bf16x8*)(s_S + swz256(32 + r, ks * 2 + hl));
      acc[0] = __builtin_amdgcn_mfma_f32_32x32x16_bf16(a0, cfr[ks], acc[0], 0, 0, 0);
      acc[1] = __builtin_amdgcn_mfma_f32_32x32x16_bf16(a1, cfr[ks], acc[1], 0, 0, 0);
    }
    {
      const float el = expf(acs_l);
#pragma unroll
      for (int e = 0; e < 16; ++e) { acc[0][e] *= el; acc[1][e] *= el; }
    }
#pragma unroll
    for (int st = 0; st < 4; ++st) {
      asm volatile("" ::: "memory");
      if (st <= w) {
        float m[16];
#pragma unroll
        for (int e = 0; e < 16; ++e) {
          const int sidx = 32 * st + crow16(e, hl);
          float v = gt[st][e] * __expf(acs_l - s_acs[hh * 128 + sidx]) * s_dt[hh * 128 + sidx];
          if (sidx > l) v = 0.f;
          if (sidx == l) v += dsk;
          m[e] = v;
        }
#pragma unroll
        for (int k2 = 0; k2 < 2; ++k2) {
          asm volatile("" ::: "memory");
          bf16x8 mf;
          {
            unsigned u0 = pack2(m[8 * k2 + 0], m[8 * k2 + 1]), u1 = pack2(m[8 * k2 + 2], m[8 * k2 + 3]);
            unsigned u2 = pack2(m[8 * k2 + 4], m[8 * k2 + 5]), u3 = pack2(m[8 * k2 + 6], m[8 * k2 + 7]);
            uint4 uu = make_uint4(u0, u1, u2, u3);
            mf = *(bf16x8*)&uu;
          }
          const int soff = (32 * st + 16 * k2 + 4 * hl) * 2;
#pragma unroll
          for (int pt = 0; pt < 2; ++pt) {
            const char* ap = s_xT + (pt * 32 + r) * 264 + soff;
            uint2 q0 = *(const uint2*)(ap);
            uint2 q1 = *(const uint2*)(ap + 16);
            uint4 qq = make_uint4(q0.x, q0.y, q1.x, q1.y);
            const bf16x8 af = *(bf16x8*)&qq;
            acc[pt] = __builtin_amdgcn_mfma_f32_32x32x16_bf16(af, mf, acc[pt], 0, 0, 0);
          }
        }
      }
    }
#pragma unroll
    for (int pt = 0; pt < 2; ++pt) {
#pragma unroll
      for (int q4 = 0; q4 < 4; ++q4) {
        asm volatile("" ::: "memory");
        const int p0 = pt * 32 + 8 * q4 + 4 * hl;
        const uint2 zz = *(const uint2*)(p.zs + (size_t)(t0 + l) * 512 + hg * 64 + p0);
        const float v0 = acc[pt][4 * q4 + 0] * bflo(zz.x), v1 = acc[pt][4 * q4 + 1] * bfhi(zz.x);
        const float v2 = acc[pt][4 * q4 + 2] * bflo(zz.y), v3 = acc[pt][4 * q4 + 3] * bfhi(zz.y);
        ssq += v0 * v0 + v1 * v1 + v2 * v2 + v3 * v3;
        *(uint2*)(p.mixed_b + (size_t)(t0 + l) * 1024 + hg * 64 + p0) = make_uint2(pack2(v0, v1), pack2(v2, v3));
      }
    }
    __syncthreads();
  }
  const int l = 32 * w + r;
  ssq += __shfl_xor(ssq, 32);
  const float rstd = rsqrtf(ssq * (1.f / 256.f) + EPS);
#pragma unroll 1
  for (int hh = 0; hh < 4; ++hh) {
#pragma unroll
    for (int pt = 0; pt < 2; ++pt) {
#pragma unroll
      for (int q4 = 0; q4 < 4; ++q4) {
        asm volatile("" ::: "memory");
        const int chn = (g * 4 + hh) * 64 + pt * 32 + 8 * q4 + 4 * hl;
        ushort_t* ptr = p.mixed_b + (size_t)(t0 + l) * 1024 + chn;
        const uint2 vv = *(const uint2*)ptr;
        const float4 nw = *(const float4*)(p.ssd_norm_w + chn);
        *(uint2*)ptr = make_uint2(pack2(bflo(vv.x) * rstd * nw.x, bfhi(vv.x) * rstd * nw.y),
                                  pack2(bflo(vv.y) * rstd * nw.z, bfhi(vv.y) * rstd * nw.w));
      }
    }
  }
}

__device__ __forceinline__ void k_gate(const int VB, char* smem, const Params& p) {
  const int own = VB & 31, bh = VB >> 5;
  if (own == 0) return;
  const int b = bh >> 2, h = bh & 3;
  const int tid = threadIdx.x;
  float* s_km = (float*)smem;
  int* s_cnt = (int*)(smem + 8192);
  int* s_base = s_cnt + 32;
  for (int i = tid; i < own * 64; i += 256) {
    const int n = i >> 6, d = i & 63;
    const float* kp = p.kpart + (size_t)(bh * 32 + n) * 256 + d;
    s_km[i] = (kp[0] + kp[64]) + (kp[128] + kp[192]);
  }
  if (tid < 32) s_cnt[tid] = 0;
  __syncthreads();
  const int l = own * 256 + tid;
  const int t = b * SL + l;
  float q[64];
  {
    const ushort_t* src = p.mq + (size_t)t * 256 + h * 64;
#pragma unroll
    for (int d = 0; d < 64; d += 8) {
      uint4 v = *(const uint4*)(src + d);
      q[d] = bflo(v.x); q[d + 1] = bfhi(v.x); q[d + 2] = bflo(v.y); q[d + 3] = bfhi(v.y);
      q[d + 4] = bflo(v.z); q[d + 5] = bfhi(v.z); q[d + 6] = bflo(v.w); q[d + 7] = bfhi(v.w);
    }
  }
  float v0 = -INFINITY, v1 = -INFINITY, v2 = -INFINITY;
  int i0 = 0, i1 = 1, i2 = 2;
  for (int n = 0; n < own; ++n) {
    const float* km = s_km + n * 64;
    float sa = 0.f, sb = 0.f;
#pragma unroll
    for (int d = 0; d < 64; d += 8) {
      const float4 a = *(const float4*)(km + d), c = *(const float4*)(km + d + 4);
      sa = fmaf(q[d], a.x, sa); sa = fmaf(q[d + 1], a.y, sa); sa = fmaf(q[d + 2], a.z, sa); sa = fmaf(q[d + 3], a.w, sa);
      sb = fmaf(q[d + 4], c.x, sb); sb = fmaf(q[d + 5], c.y, sb); sb = fmaf(q[d + 6], c.z, sb); sb = fmaf(q[d + 7], c.w, sb);
    }
    const float sv = sa + sb;
    if (sv > v0) { v2 = v1; i2 = i1; v1 = v0; i1 = i0; v0 = sv; i0 = n; }
    else if (sv > v1) { v2 = v1; i2 = i1; v1 = sv; i1 = n; }
    else if (sv > v2) { v2 = sv; i2 = n; }
  }
  const int nsel = own < 3 ? own : 3;
  int lp0 = 0, lp1 = 0, lp2 = 0;
  if (0 < nsel) lp0 = atomicAdd(s_cnt + i0, 1);
  if (1 < nsel) lp1 = atomicAdd(s_cnt + i1, 1);
  if (2 < nsel) lp2 = atomicAdd(s_cnt + i2, 1);
  __syncthreads();
  if (tid < own) s_base[tid] = s_cnt[tid] ? atomicAdd(p.bcnt + bh * 32 + tid, s_cnt[tid]) : 0;
  __syncthreads();
  if (0 < nsel) p.blist[(size_t)(bh * 32 + i0) * 8192 + s_base[i0] + lp0] = l | (0 << 13);
  if (1 < nsel) p.blist[(size_t)(bh * 32 + i1) * 8192 + s_base[i1] + lp1] = l | (1 << 13);
  if (2 < nsel) p.blist[(size_t)(bh * 32 + i2) * 8192 + s_base[i2] + lp2] = l | (2 << 13);
}

struct UnitDesc { const ushort_t* Kp; const ushort_t* VTp; int vstride; int kind; int a0; int a1; };
__device__ __forceinline__ UnitDesc unit_desc(const int u, const int Ug, const int* s_pref, const Params& p) {
  UnitDesc d;
  if (u >= Ug + NB * 4 * 32 * 2) {
    const int v = u - Ug - NB * 4 * 32 * 2;
    d.kind = 2; d.a0 = v >> 6; d.a1 = v & 63;
    const int bh = d.a0, b = bh >> 2, h = bh & 3;
    d.Kp = p.memk_b + (size_t)b * MEM * 256 + h * 64;
    d.VTp = p.memvT + (size_t)bh * 64 * MEM;
    d.vstride = MEM;
  } else {
    if (u < Ug) {
      int lo = 0, hi = 255;
      while (lo < hi) { const int mid = (lo + hi) >> 1; if (s_pref[mid] > u) hi = mid; else lo = mid + 1; }
      const int prev = lo ? s_pref[lo - 1] : 0;
      d.kind = 0; d.a0 = lo; d.a1 = u - prev;
    } else {
      const int v = u - Ug;
      d.kind = 1; d.a0 = v >> 1; d.a1 = v & 1;
    }
    const int bh = d.a0 >> 5, jblk = d.a0 & 31, b = bh >> 2, h = bh & 3;
    d.Kp = p.mk + (size_t)(b * SL + jblk * 256) * 256 + h * 64;
    d.VTp = p.vT + (size_t)bh * 64 * SL + jblk * 256;
    d.vstride = SL;
  }
  return d;
}

#define AU_LOAD(P, D, ST) { \
    const ushort_t* kp_ = (D).Kp + (size_t)((ST) * 128 + kr) * 256 + kc * 8; \
    P##k0 = *(const uint4*)(kp_); P##k1 = *(const uint4*)(kp_ + 32 * 256); P##k2 = *(const uint4*)(kp_ + 64 * 256); P##k3 = *(const uint4*)(kp_ + 96 * 256); \
    const ushort_t* vp_ = (D).VTp + (size_t)vr * (D).vstride + (ST) * 128 + vc * 8; \
    P##v0 = *(const uint4*)(vp_); P##v1 = *(const uint4*)(vp_ + (size_t)16 * (D).vstride); \
    P##v2 = *(const uint4*)(vp_ + (size_t)32 * (D).vstride); P##v3 = *(const uint4*)(vp_ + (size_t)48 * (D).vstride); }
#define AU_STORE(P, BUF) { \
    char* sk_ = (BUF) + kr * 144 + kc * 16; \
    *(uint4*)(sk_) = P##k0; *(uint4*)(sk_ + 32 * 144) = P##k1; *(uint4*)(sk_ + 64 * 144) = P##k2; *(uint4*)(sk_ + 96 * 144) = P##k3; \
    char* sv_ = (BUF) + 18432 + vr * 264 + vc * 16; \
    *(uint2*)(sv_) = make_uint2(P##v0.x, P##v0.y); *(uint2*)(sv_ + 8) = make_uint2(P##v0.z, P##v0.w); \
    *(uint2*)(sv_ + 16 * 264) = make_uint2(P##v1.x, P##v1.y); *(uint2*)(sv_ + 16 * 264 + 8) = make_uint2(P##v1.z, P##v1.w); \
    *(uint2*)(sv_ + 32 * 264) = make_uint2(P##v2.x, P##v2.y); *(uint2*)(sv_ + 32 * 264 + 8) = make_uint2(P##v2.z, P##v2.w); \
    *(uint2*)(sv_ + 48 * 264) = make_uint2(P##v3.x, P##v3.y); *(uint2*)(sv_ + 48 * 264 + 8) = make_uint2(P##v3.z, P##v3.w); }

__device__ __forceinline__ void attn_stage(const char* buf, const int st, const bf16x8 (&qf)[4], const float slope, const int qrel, const bool causal,
                                           const int r, const int hl, f32x16 (&o)[2], float& m, float& lsum) {
  const char* s_K = buf;
  const char* s_VT = buf + 18432;
  f32x16 sc[4];
#pragma unroll
  for (int kt = 0; kt < 4; ++kt) {
#pragma unroll
    for (int e = 0; e < 16; ++e) sc[kt][e] = 0.f;
#pragma unroll
    for (int ks = 0; ks < 4; ++ks) {
      const bf16x8 a = *(const bf16x8*)(s_K + (32 * kt + r) * 144 + (2 * ks + hl) * 16);
      sc[kt] = __builtin_amdgcn_mfma_f32_32x32x16_bf16(a, qf[ks], sc[kt], 0, 0, 0);
    }
  }
  float mx = -1e30f;
  const int qk0 = qrel - st * 128 - 4 * hl;
  const float slope2 = slope;
  const float bb = -slope2 * (float)qk0;
#pragma unroll
  for (int kt = 0; kt < 4; ++kt) {
#pragma unroll
    for (int e = 0; e < 16; ++e) {
      const int ce = 32 * kt + (e & 3) + 8 * (e >> 2);
      float v = fmaf(sc[kt][e], 0.18033688011112042f, fmaf(slope2, (float)ce, bb));
      if (causal && ce > qk0) v = -1e30f;
      sc[kt][e] = v;
      mx = fmaxf(mx, v);
    }
  }
  mx = fmaxf(mx, __shfl_xor(mx, 32));
  const float mnew = fmaxf(m, mx);
  const float alpha = __builtin_amdgcn_exp2f(m - mnew);
  m = mnew;
  lsum *= alpha;
#pragma unroll
  for (int e = 0; e < 16; ++e) { o[0][e] *= alpha; o[1][e] *= alpha; }
#pragma unroll
  for (int kt = 0; kt < 4; ++kt) {
#pragma unroll
    for (int e = 0; e < 16; ++e) {
      const float pe = __builtin_amdgcn_exp2f(sc[kt][e] - mnew);
      sc[kt][e] = pe;
      lsum += pe;
    }
  }
#pragma unroll
  for (int kt = 0; kt < 4; ++kt) {
#pragma unroll
    for (int k2 = 0; k2 < 2; ++k2) {
      uint4 pu = make_uint4(pack2(sc[kt][8 * k2 + 0], sc[kt][8 * k2 + 1]), pack2(sc[kt][8 * k2 + 2], sc[kt][8 * k2 + 3]),
                            pack2(sc[kt][8 * k2 + 4], sc[kt][8 * k2 + 5]), pack2(sc[kt][8 * k2 + 6], sc[kt][8 * k2 + 7]));
      const bf16x8 pf = *(bf16x8*)&pu;
      const int koff = (32 * kt + 16 * k2 + 4 * hl) * 2;
#pragma unroll
      for (int dt = 0; dt < 2; ++dt) {
        const char* ap = s_VT + (dt * 32 + r) * 264 + koff;
        const uint2 q0 = *(const uint2*)(ap);
        const uint2 q1 = *(const uint2*)(ap + 16);
        uint4 qq = make_uint4(q0.x, q0.y, q1.x, q1.y);
        const bf16x8 af = *(bf16x8*)&qq;
        o[dt] = __builtin_amdgcn_mfma_f32_32x32x16_bf16(af, pf, o[dt], 0, 0, 0);
      }
    }
  }
}

__device__ __forceinline__ void ph_attn_units(char* smem, const Params& p, const int Ug, const int* s_pref) {
  const int Utot = Ug + NB * 4 * 32 * 2 + NB * 4 * 64;
  int u = blockIdx.x;
  if (u >= Utot) return;
  int tid = threadIdx.x;
  asm volatile("" : "+v"(tid));
  const int lane = tid & 63, wave = tid >> 6, r = lane & 31, hl = lane >> 5;
  const int kr = tid >> 3, kc = tid & 7, vr = tid >> 4, vc = tid & 15;
  char* buf0 = smem;
  char* buf1 = smem + 35328;
  uint4 Ak0, Ak1, Ak2, Ak3, Av0, Av1, Av2, Av3, Bk0, Bk1, Bk2, Bk3, Bv0, Bv1, Bv2, Bv3;
  UnitDesc D = unit_desc(u, Ug, s_pref, p);
  AU_LOAD(A, D, 0)
  AU_LOAD(B, D, 1)
#pragma unroll 1
  for (; u < Utot; u += gridDim.x) {
    const int un = (u + (int)gridDim.x < Utot) ? u + (int)gridDim.x : u;
    const UnitDesc Dn = unit_desc(un, Ug, s_pref, p);
    int bh, l = 0, slot = 3, jblk = 0;
    bool valid = true, causal = false;
    const ushort_t* qrow;
    float slope = 0.f;
    int qrel = 1 << 20;
    int t;
    if (D.kind == 2) {
      bh = D.a0;
      t = (bh >> 2) * SL + D.a1 * 128 + wave * 32 + r;
      qrow = p.xq + (size_t)t * 256 + (bh & 3) * 64;
    } else {
      bh = D.a0 >> 5; jblk = D.a0 & 31;
      if (D.kind == 0) {
        const int cnt = p.bcnt[D.a0];
        int qi = D.a1 * 128 + wave * 32 + r;
        if (qi >= cnt) { valid = false; qi = 0; }
        const int ent = p.blist[(size_t)D.a0 * 8192 + qi];
        l = ent & 8191; slot = ent >> 13;
      } else {
        l = jblk * 256 + D.a1 * 128 + wave * 32 + r; slot = 3; causal = true;
      }
      t = (bh >> 2) * SL + l;
      qrow = p.mq + (size_t)t * 256 + (bh & 3) * 64;
      slope = exp2f(-2.f * (float)((bh & 3) + 1)) * 1.4426950408889634f;
      qrel = l - jblk * 256;
    }
    bf16x8 qf[4];
#pragma unroll
    for (int ks = 0; ks < 4; ++ks) qf[ks] = *(const bf16x8*)(qrow + ks * 16 + hl * 8);
    f32x16 o[2];
#pragma unroll
    for (int e = 0; e < 16; ++e) { o[0][e] = 0.f; o[1][e] = 0.f; }
    float m = -1e30f, lsum = 0.f;
    AU_STORE(A, buf0)
    AU_LOAD(A, Dn, 0)
    __syncthreads();
    attn_stage(buf0, 0, qf, slope, qrel, causal, r, hl, o, m, lsum);
    AU_STORE(B, buf1)
    AU_LOAD(B, Dn, 1)
    __syncthreads();
    attn_stage(buf1, 1, qf, slope, qrel, causal, r, hl, o, m, lsum);
    const float lt = lsum + __shfl_xor(lsum, 32);
    const float inv = 1.f / lt;
    const int h = bh & 3;
    if (D.kind == 2) {
#pragma unroll
      for (int dt = 0; dt < 2; ++dt)
#pragma unroll
        for (int q4 = 0; q4 < 4; ++q4) {
          const int d = dt * 32 + 8 * q4 + 4 * hl;
          *(uint2*)(p.mixed_b + (size_t)t * DM + 768 + h * 64 + d) =
              make_uint2(pack2(o[dt][4 * q4] * inv, o[dt][4 * q4 + 1] * inv), pack2(o[dt][4 * q4 + 2] * inv, o[dt][4 * q4 + 3] * inv));
        }
    } else if (valid) {
      const size_t pi = ((size_t)t * 4 + h) * 4 + slot;
#pragma unroll
      for (int dt = 0; dt < 2; ++dt)
#pragma unroll
        for (int q4 = 0; q4 < 4; ++q4) {
          const int d = dt * 32 + 8 * q4 + 4 * hl;
          *(uint2*)(p.pO + pi * 64 + d) =
              make_uint2(pack2(o[dt][4 * q4] * inv, o[dt][4 * q4 + 1] * inv), pack2(o[dt][4 * q4 + 2] * inv, o[dt][4 * q4 + 3] * inv));
        }
      if (hl == 0) { p.pm[pi] = m; p.pl[pi] = lt; }
    }
    D = Dn;
  }
}

__device__ __forceinline__ void ph_attn_combine(const int VB, const Params& p) {
  const int i = VB * 256 + threadIdx.x;
  const int dq = i & 7, th = i >> 3;
  const int t = th >> 2;
  const int own = (t & (SL - 1)) >> 8;
  const int nsel = own < 3 ? own : 3;
  float mv[4], wv[4];
  float M = p.pm[(size_t)th * 4 + 3];
  mv[3] = M;
#pragma unroll
  for (int sl = 0; sl < 3; ++sl) {
    mv[sl] = (sl < nsel) ? p.pm[(size_t)th * 4 + sl] : -1e30f;
    M = fmaxf(M, mv[sl]);
  }
  float W = 0.f;
#pragma unroll
  for (int sl = 0; sl < 4; ++sl) {
    const bool on = (sl == 3) || (sl < nsel);
    wv[sl] = on ? p.pl[(size_t)th * 4 + sl] * __builtin_amdgcn_exp2f(mv[sl] - M) : 0.f;
    W += wv[sl];
  }
  float acc[8];
#pragma unroll
  for (int k = 0; k < 8; ++k) acc[k] = 0.f;
#pragma unroll
  for (int sl = 0; sl < 4; ++sl) {
    const bool on = (sl == 3) || (sl < nsel);
    if (on) {
      float f[8];
      unpack8(*(const uint4*)(p.pO + ((size_t)th * 4 + sl) * 64 + dq * 8), f);
#pragma unroll
      for (int k = 0; k < 8; ++k) acc[k] = fmaf(wv[sl], f[k], acc[k]);
    }
  }
  const float inv = 1.f / W;
  const int h = th & 3;
  *(uint4*)(p.mixed_b + (size_t)t * DM + 512 + h * 64 + dq * 8) =
      make_uint4(pack2(acc[0] * inv, acc[1] * inv), pack2(acc[2] * inv, acc[3] * inv), pack2(acc[4] * inv, acc[5] * inv), pack2(acc[6] * inv, acc[7] * inv));
}


__device__ __forceinline__ int mkkey(const float f, const int idx, const int mask) {
  int b = __float_as_int(f);
  b = (b & ~mask) | idx;
  return b ^ ((b >> 31) & 0x7fffffff);
}
__device__ __forceinline__ int key2bits(const int k) { return k ^ ((k >> 31) & 0x7fffffff); }
#define CEI(a, b) { const int _mx = max(a, b), _mn = min(a, b); a = _mx; b = _mn; }
template <int N>
__device__ __forceinline__ void bitonic_sort_desc(int (&v)[N]) {
#pragma unroll
  for (int k = 2; k <= N; k <<= 1) {
#pragma unroll
    for (int j = k >> 1; j > 0; j >>= 1) {
#pragma unroll
      for (int i = 0; i < N; ++i) {
        const int l = i ^ j;
        if (l > i) {
          if ((i & k) == 0) { CEI(v[i], v[l]); } else { CEI(v[l], v[i]); }
        }
      }
    }
  }
}
__device__ __forceinline__ void merge16(int (&a)[16], const int (&b)[16]) {
#pragma unroll
  for (int i = 0; i < 16; ++i) a[i] = max(a[i], b[15 - i]);
#pragma unroll
  for (int j = 8; j > 0; j >>= 1) {
#pragma unroll
    for (int i = 0; i < 16; ++i) {
      const int l = i ^ j;
      if (l > i) { CEI(a[i], a[l]); }
    }
  }
}
__device__ __forceinline__ void merge_partner(int (&a)[16], const int xmask) {
  int o[16];
#pragma unroll
  for (int i = 0; i < 16; ++i) o[i] = __shfl_xor(a[i], xmask);
  merge16(a, o);
}
__device__ __forceinline__ bf16x8 pack_hi8(const float (&x)[8], float (&res)[8]) {
  unsigned u[4];
#pragma unroll
  for (int i = 0; i < 4; ++i) {
    const ushort_t h0 = f2bf(x[2 * i]), h1 = f2bf(x[2 * i + 1]);
    res[2 * i] = x[2 * i] - bf2f(h0);
    res[2 * i + 1] = x[2 * i + 1] - bf2f(h1);
    u[i] = (unsigned)h0 | ((unsigned)h1 << 16);
  }
  uint4 uu = make_uint4(u[0], u[1], u[2], u[3]);
  return *(bf16x8*)&uu;
}
__device__ __forceinline__ bf16x8 pack_8(const float (&x)[8]) {
  uint4 uu = make_uint4(pack2(x[0], x[1]), pack2(x[2], x[3]), pack2(x[4], x[5]), pack2(x[6], x[7]));
  return *(bf16x8*)&uu;
}

__device__ __forceinline__ void ph_gemm_route(const int vb, char* smem, const Params& p, const ushort_t* __restrict__ hn_b) {
  const int head = vb & 7, tt = vb >> 3;
  const int m0 = head * 128, n0 = tt * 128;
  f32x16 acc[2][2];
  gemm_core(p.w_qT, hn_b, DM, m0, n0, smem, acc);
  int tid = threadIdx.x;
  asm volatile("" : "+v"(tid));
  const int lane = tid & 63, r = lane & 31, hl = lane >> 5;
  const int wave = tid >> 6, wm = wave >> 1, wn = wave & 1;
  int* s_top = (int*)(smem + 34816);
  float rstd_tok[2];
#pragma unroll
  for (int ni = 0; ni < 2; ++ni) {
    const float4* hp = (const float4*)(p.hss + (size_t)(n0 + wn * 64 + ni * 32 + r) * 16);
    const float4 a = hp[0], b = hp[1], c = hp[2], d = hp[3];
    const float tot = ((a.x + a.y) + (a.z + a.w)) + ((b.x + b.y) + (b.z + b.w)) + ((c.x + c.y) + (c.z + c.w)) + ((d.x + d.y) + (d.z + d.w));
    rstd_tok[ni] = rsqrtf(tot * (1.f / DM) + EPS);
  }
  {
    const int row = tid >> 1, part = tid & 1;
#pragma unroll
    for (int hf = 0; hf < 2; ++hf) {
      const ushort_t* src = p.skh + (size_t)(hf * 128 + row) * 64 + part * 32;
      char* dst = smem + (hf * 128 + row) * 136 + part * 64;
#pragma unroll
      for (int c = 0; c < 4; ++c) {
        const uint4 v = *(const uint4*)(src + c * 8);
        *(uint2*)(dst + c * 16) = make_uint2(v.x, v.y);
        *(uint2*)(dst + c * 16 + 8) = make_uint2(v.z, v.w);
      }
    }
  }
  __syncthreads();
  const char* s_keys = smem + wm * 128 * 136;
#pragma unroll
  for (int ni = 0; ni < 2; ++ni) {
    asm volatile("" ::: "memory");
    bf16x8 qh[4], ql[4];
#pragma unroll
    for (int mi = 0; mi < 2; ++mi) {
#pragma unroll
      for (int k2 = 0; k2 < 2; ++k2) {
        float x[8], res[8];
#pragma unroll
        for (int j = 0; j < 8; ++j) x[j] = acc[mi][ni][8 * k2 + j] * rstd_tok[ni];
        qh[mi * 2 + k2] = pack_hi8(x, res);
        ql[mi * 2 + k2] = pack_8(res);
      }
    }
    int g0[16];
#pragma unroll
    for (int kh2 = 0; kh2 < 2; ++kh2) {
      int ga[16], gb[16];
#pragma unroll
      for (int kq = 0; kq < 2; ++kq) {
        const int kt = kh2 * 2 + kq;
        asm volatile("" ::: "memory");
        f32x16 sc;
#pragma unroll
        for (int e = 0; e < 16; ++e) sc[e] = 0.f;
#pragma unroll
        for (int st = 0; st < 4; ++st) {
          const int d0 = (st >> 1) * 32 + 16 * (st & 1) + 4 * hl;
          const char* kp = s_keys + (kt * 32 + r) * 136 + d0 * 2;
          const uint2 h0 = *(const uint2*)(kp), h1 = *(const uint2*)(kp + 16);
          uint4 hq = make_uint4(h0.x, h0.y, h1.x, h1.y);
          const bf16x8 ah = *(bf16x8*)&hq;
          sc = __builtin_amdgcn_mfma_f32_32x32x16_bf16(ah, qh[st], sc, 0, 0, 0);
          sc = __builtin_amdgcn_mfma_f32_32x32x16_bf16(ah, ql[st], sc, 0, 0, 0);
        }
        if (kq == 0) {
#pragma unroll
          for (int e = 0; e < 16; ++e) ga[e] = mkkey(sc[e], kt * 32 + (e & 3) + 8 * (e >> 2) + 4 * hl, 127);
          bitonic_sort_desc<16>(ga);
        } else {
#pragma unroll
          for (int e = 0; e < 16; ++e) gb[e] = mkkey(sc[e], kt * 32 + (e & 3) + 8 * (e >> 2) + 4 * hl, 127);
          bitonic_sort_desc<16>(gb);
        }
      }
      merge16(ga, gb);
      if (kh2 == 0) {
#pragma unroll
        for (int i = 0; i < 16; ++i) g0[i] = ga[i];
      } else {
        merge16(g0, ga);
      }
    }
    merge_partner(g0, 32);
    {
      int* dst = s_top + ((size_t)wm * 128 + wn * 64 + ni * 32 + r) * 16 + hl * 8;
      int4 w0, w1;
      int lo8[8], hi8[8];
#pragma unroll
      for (int i = 0; i < 8; ++i) { lo8[i] = g0[i]; hi8[i] = g0[8 + i]; asm volatile("" : "+v"(lo8[i]), "+v"(hi8[i])); }
      w0 = make_int4(hl ? hi8[0] : lo8[0], hl ? hi8[1] : lo8[1], hl ? hi8[2] : lo8[2], hl ? hi8[3] : lo8[3]);
      w1 = make_int4(hl ? hi8[4] : lo8[4], hl ? hi8[5] : lo8[5], hl ? hi8[6] : lo8[6], hl ? hi8[7] : lo8[7]);
      *(int4*)dst = w0; *(int4*)(dst + 4) = w1;
    }
  }
  __syncthreads();
  {
    const int tok = tid >> 1, sub = tid & 1;
    int k1[16], k2[16];
    {
      const int4* a = (const int4*)(s_top + (size_t)tok * 16);
      const int4* b = (const int4*)(s_top + (size_t)(128 + tok) * 16);
#pragma unroll
      for (int i = 0; i < 4; ++i) {
        const int4 x = a[i], y = b[i];
        k1[4 * i] = x.x; k1[4 * i + 1] = x.y; k1[4 * i + 2] = x.z; k1[4 * i + 3] = x.w;
        k2[4 * i] = y.x; k2[4 * i + 1] = y.y; k2[4 * i + 2] = y.z; k2[4 * i + 3] = y.w;
      }
    }
    float v1f[16], v2f[16];
#pragma unroll
    for (int i = 0; i < 16; ++i) { v1f[i] = __int_as_float(key2bits(k1[i])); v2f[i] = __int_as_float(key2bits(k2[i])); }
    int c[32];
    c[0] = sub ? mkkey(v1f[3] + v2f[3], 51, 255) : mkkey(v1f[0] + v2f[0], 0, 255);
    c[1] = sub ? mkkey(v1f[4] + v2f[0], 64, 255) : mkkey(v1f[0] + v2f[1], 1, 255);
    c[2] = sub ? mkkey(v1f[4] + v2f[1], 65, 255) : mkkey(v1f[0] + v2f[2], 2, 255);
    c[3] = sub ? mkkey(v1f[4] + v2f[2], 66, 255) : mkkey(v1f[0] + v2f[3], 3, 255);
    c[4] = sub ? mkkey(v1f[5] + v2f[0], 80, 255) : mkkey(v1f[0] + v2f[4], 4, 255);
    c[5] = sub ? mkkey(v1f[5] + v2f[1], 81, 255) : mkkey(v1f[0] + v2f[5], 5, 255);
    c[6] = sub ? mkkey(v1f[6] + v2f[0], 96, 255) : mkkey(v1f[0] + v2f[6], 6, 255);
    c[7] = sub ? mkkey(v1f[6] + v2f[1], 97, 255) : mkkey(v1f[0] + v2f[7], 7, 255);
    c[8] = sub ? mkkey(v1f[7] + v2f[0], 112, 255) : mkkey(v1f[0] + v2f[8], 8, 255);
    c[9] = sub ? mkkey(v1f[7] + v2f[1], 113, 255) : mkkey(v1f[0] + v2f[9], 9, 255);
    c[10] = sub ? mkkey(v1f[8] + v2f[0], 128, 255) : mkkey(v1f[0] + v2f[10], 10, 255);
    c[11] = sub ? mkkey(v1f[9] + v2f[0], 144, 255) : mkkey(v1f[0] + v2f[11], 11, 255);
    c[12] = sub ? mkkey(v1f[10] + v2f[0], 160, 255) : mkkey(v1f[0] + v2f[12], 12, 255);
    c[13] = sub ? mkkey(v1f[11] + v2f[0], 176, 255) : mkkey(v1f[0] + v2f[13], 13, 255);
    c[14] = sub ? mkkey(v1f[12] + v2f[0], 192, 255) : mkkey(v1f[0] + v2f[14], 14, 255);
    c[15] = sub ? mkkey(v1f[13] + v2f[0], 208, 255) : mkkey(v1f[0] + v2f[15], 15, 255);
    c[16] = sub ? mkkey(v1f[14] + v2f[0], 224, 255) : mkkey(v1f[1] + v2f[0], 16, 255);
    c[17] = sub ? mkkey(v1f[15] + v2f[0], 240, 255) : mkkey(v1f[1] + v2f[1], 17, 255);
    c[18] = sub ? (int)0x80000000 : mkkey(v1f[1] + v2f[2], 18, 255);
    c[19] = sub ? (int)0x80000000 : mkkey(v1f[1] + v2f[3], 19, 255);
    c[20] = sub ? (int)0x80000000 : mkkey(v1f[1] + v2f[4], 20, 255);
    c[21] = sub ? (int)0x80000000 : mkkey(v1f[1] + v2f[5], 21, 255);
    c[22] = sub ? (int)0x80000000 : mkkey(v1f[1] + v2f[6], 22, 255);
    c[23] = sub ? (int)0x80000000 : mkkey(v1f[1] + v2f[7], 23, 255);
    c[24] = sub ? (int)0x80000000 : mkkey(v1f[2] + v2f[0], 32, 255);
    c[25] = sub ? (int)0x80000000 : mkkey(v1f[2] + v2f[1], 33, 255);
    c[26] = sub ? (int)0x80000000 : mkkey(v1f[2] + v2f[2], 34, 255);
    c[27] = sub ? (int)0x80000000 : mkkey(v1f[2] + v2f[3], 35, 255);
    c[28] = sub ? (int)0x80000000 : mkkey(v1f[2] + v2f[4], 36, 255);
    c[29] = sub ? (int)0x80000000 : mkkey(v1f[3] + v2f[0], 48, 255);
    c[30] = sub ? (int)0x80000000 : mkkey(v1f[3] + v2f[1], 49, 255);
    c[31] = sub ? (int)0x80000000 : mkkey(v1f[3] + v2f[2], 50, 255);
    int h0[16], h1[16];
#pragma unroll
    for (int i = 0; i < 16; ++i) { h0[i] = c[i]; h1[i] = c[16 + i]; }
    bitonic_sort_desc<16>(h0); bitonic_sort_desc<16>(h1);
    merge16(h0, h1);
    merge_partner(h0, 1);
    float sv[16];
#pragma unroll
    for (int i = 0; i < 16; ++i) sv[i] = __int_as_float(key2bits(h0[i]));
    float den = 0.f;
#pragma unroll
    for (int i = 0; i < 16; ++i) den += __expf(sv[i] - sv[0]);
    const float inv = 1.f / den;
    int eo[8]; float go[8];
#pragma unroll
    for (int i = 0; i < 8; ++i) {
      int klo = h0[i], khi = h0[8 + i];
      asm volatile("" : "+v"(klo), "+v"(khi));
      const int kk = sub ? khi : klo;
      const int bits = key2bits(kk);
      const int code = bits & 255;
      const int ia = key2bits(s_top[(size_t)tok * 16 + (code >> 4)]) & 127;
      const int ib = key2bits(s_top[(size_t)(128 + tok) * 16 + (code & 15)]) & 127;
      eo[i] = ia * 128 + ib;
      go[i] = __expf(__int_as_float(bits) - sv[0]) * inv;
    }
    const size_t ob = ((size_t)(n0 + tok) * 8 + head) * 16 + sub * 8;
    *(int4*)(p.eidx + ob) = make_int4(eo[0], eo[1], eo[2], eo[3]);
    *(int4*)(p.eidx + ob + 4) = make_int4(eo[4], eo[5], eo[6], eo[7]);
    *(float4*)(p.egate + ob) = make_float4(go[0], go[1], go[2], go[3]);
    *(float4*)(p.egate + ob + 4) = make_float4(go[4], go[5], go[6], go[7]);
  }
}

__device__ __forceinline__ void ph_subkeys(const Params& p) {
  for (int i = blockIdx.x * 256 + threadIdx.x; i < 2 * 128 * 64; i += gridDim.x * 256) {
    const float v = (i < 8192) ? p.sk1[i] : p.sk2[i - 8192];
    const ushort_t hi = f2bf(v);
    p.skh[i] = hi;
    p.skl[i] = f2bf(v - bf2f(hi));
  }
}

__device__ __forceinline__ float dot16_fp8(const uint4 d, const float (&x)[16], float c) {
  const unsigned w[4] = {d.x, d.y, d.z, d.w};
#pragma unroll
  for (int i = 0; i < 4; ++i) {
    const f32x2_t lo = __builtin_amdgcn_cvt_pk_f32_fp8((int)w[i], false);
    const f32x2_t hi = __builtin_amdgcn_cvt_pk_f32_fp8((int)w[i], true);
    c = fmaf(lo.x, x[4 * i], c); c = fmaf(lo.y, x[4 * i + 1], c); c = fmaf(hi.x, x[4 * i + 2], c); c = fmaf(hi.y, x[4 * i + 3], c);
  }
  return c;
}
__device__ __forceinline__ void axpy16_fp8(const float cf, const uint4 u, float (&acc)[16]) {
  const unsigned w[4] = {u.x, u.y, u.z, u.w};
#pragma unroll
  for (int i = 0; i < 4; ++i) {
    const f32x2_t lo = __builtin_amdgcn_cvt_pk_f32_fp8((int)w[i], false);
    const f32x2_t hi = __builtin_amdgcn_cvt_pk_f32_fp8((int)w[i], true);
    acc[4 * i] = fmaf(cf, lo.x, acc[4 * i]); acc[4 * i + 1] = fmaf(cf, lo.y, acc[4 * i + 1]);
    acc[4 * i + 2] = fmaf(cf, hi.x, acc[4 * i + 2]); acc[4 * i + 3] = fmaf(cf, hi.y, acc[4 * i + 3]);
  }
}
constexpr int EX_NTOK = 4;
__device__ __forceinline__ void peer_chunk(const Params& p, const int lane, const int myex, const bool b5, const bool b4, const bool b3,
                                           const int (&ce)[8], const float (&cg)[8], const f32x2_t (&x2)[8], f32x2_t (&acc2)[8]) {
  drow_t d[8];
  urow_t u[8];
  float sd[8], su[8];
#pragma unroll
  for (int i = 0; i < 8; ++i) d[i] = *(const drow_t*)(p.ed8 + ((size_t)ce[i] * 64 + lane) * DROW_BYTES);
#pragma unroll
  for (int i = 0; i < 8; ++i) u[i] = *(const urow_t*)(p.eu8 + ((size_t)ce[i] * 64 + lane) * UROW_BYTES);
#pragma unroll
  for (int i = 0; i < 8; ++i) { sd[i] = p.ed_s[ce[i]]; su[i] = p.eu_s[ce[i]] * cg[i]; }
  float pr[8];
#pragma unroll
  for (int i = 0; i < 8; ++i) {
    f32x2_t dd[8];
    DEC_D(d[i], dd);
    f32x2_t a2 = {0.f, 0.f};
#pragma unroll
    for (int k = 0; k < 8; ++k) a2 = dd[k] * x2[k] + a2;
    pr[i] = (a2.x + a2.y) * sd[i];
  }
  float q4[4];
#pragma unroll
  for (int i = 0; i < 4; ++i) {
    const float snd = b5 ? pr[i] : pr[i + 4];
    const float kp = b5 ? pr[i + 4] : pr[i];
    q4[i] = kp + __shfl_xor(snd, 32);
  }
  float q2[2];
#pragma unroll
  for (int i = 0; i < 2; ++i) {
    const float snd = b4 ? q4[i] : q4[i + 2];
    const float kp = b4 ? q4[i + 2] : q4[i];
    q2[i] = kp + __shfl_xor(snd, 16);
  }
  float q1;
  {
    const float snd = b3 ? q2[0] : q2[1];
    const float kp = b3 ? q2[1] : q2[0];
    q1 = kp + __shfl_xor(snd, 8);
  }
  q1 += __shfl_xor(q1, 4);
  q1 += __shfl_xor(q1, 2);
  q1 += __shfl_xor(q1, 1);
  const float act = gelu_f(q1);
#pragma unroll
  for (int i = 0; i < 8; ++i) {
    const int src = ((i >> 2) & 1) * 32 + ((i >> 1) & 1) * 16 + (i & 1) * 8;
    const float cf = __int_as_float(__builtin_amdgcn_readlane(__float_as_int(act), src)) * su[i];
    const f32x2_t cf2 = {cf, cf};
    f32x2_t uu[8];
    DEC_U(u[i], uu);
#pragma unroll
    for (int k = 0; k < 8; ++k) acc2[k] = cf2 * uu[k] + acc2[k];
  }
}

#ifndef EX_SWEEP
#define EX_SWEEP 0
#endif
#if !EX_SWEEP
typedef __attribute__((ext_vector_type(8))) int v8i_t;
typedef __attribute__((ext_vector_type(4))) float f32x4_t;
__device__ __forceinline__ void sort128(int& v0, int& v1, const int lane) {
#pragma unroll
  for (int k = 2; k <= 128; k <<= 1) {
#pragma unroll
    for (int j = k >> 1; j > 0; j >>= 1) {
      if (j == 1) {
        const bool up = ((lane * 2) & k) == 0;
        const int mn = min(v0, v1), mx = max(v0, v1);
        v0 = up ? mn : mx;
        v1 = up ? mx : mn;
      } else {
        const int o0 = __shfl_xor(v0, j >> 1), o1 = __shfl_xor(v1, j >> 1);
        const bool up = ((lane * 2) & k) == 0;
        const bool lower = ((lane * 2) & j) == 0;
        const bool takemin = (up == lower);
        v0 = takemin ? min(v0, o0) : max(v0, o0);
        v1 = takemin ? min(v1, o1) : max(v1, o1);
      }
    }
  }
}
__device__ __forceinline__ void k_peer_experts(const int VB, char* smem, const Params& p, const ushort_t* __restrict__ hn) {
  const int lane = threadIdx.x & 63;
  const int wave = __builtin_amdgcn_readfirstlane(threadIdx.x >> 6);
  const int t = VB * 4 + wave;
  const int li = lane & 15, g = lane >> 4;
  char* sx = smem + wave * 1024;
  {
    const float* hrow = p.out + (size_t)t * DM + lane * 16;
    const float* wrow = p.ffn_norm_w + lane * 16;
    float4 hv[4], wv[4];
#pragma unroll
    for (int i = 0; i < 4; ++i) { hv[i] = *(const float4*)(hrow + i * 4); wv[i] = *(const float4*)(wrow + i * 4); }
    float ss = 0.f;
#pragma unroll
    for (int i = 0; i < 4; ++i) ss += hv[i].x * hv[i].x + hv[i].y * hv[i].y + hv[i].z * hv[i].z + hv[i].w * hv[i].w;
    ss = wave_sum(ss);
    const float rs = rsqrtf(ss * (1.f / DM) + EPS) * 16.f;
    int wq[4];
#pragma unroll
    for (int i = 0; i < 4; ++i) {
      int w = 0;
      w = __builtin_amdgcn_cvt_pk_fp8_f32(hv[i].x * rs * wv[i].x, hv[i].y * rs * wv[i].y, w, false);
      w = __builtin_amdgcn_cvt_pk_fp8_f32(hv[i].z * rs * wv[i].z, hv[i].w * rs * wv[i].w, w, true);
      wq[i] = w;
    }
    *(int4*)(sx + lane * 16) = make_int4(wq[0], wq[1], wq[2], wq[3]);
  }
  v8i_t xb[8];
#pragma unroll
  for (int st = 0; st < 8; ++st) {
    const int4 lo = *(const int4*)(sx + st * 128 + g * 16);
    const int4 hi = *(const int4*)(sx + st * 128 + 64 + g * 16);
    xb[st] = v8i_t{lo.x, lo.y, lo.z, lo.w, hi.x, hi.y, hi.z, hi.w};
  }
  f32x2_t acc2[8];
#pragma unroll
  for (int i = 0; i < 8; ++i) acc2[i] = f32x2_t{0.f, 0.f};
  int kq0, kq1;
  {
    const int2 ev = *(const int2*)(p.eidx + (size_t)t * 128 + lane * 2);
    kq0 = (ev.x << 7) | (lane * 2);
    kq1 = (ev.y << 7) | (lane * 2 + 1);
    sort128(kq0, kq1, lane);
  }
  const int ev0 = kq0 >> 7, ev1 = kq1 >> 7;
  const float sdv0 = p.ed_s[ev0], sdv1 = p.ed_s[ev1];
  const float suv0 = p.eu_s[ev0] * p.egate[(size_t)t * 128 + (kq0 & 127)], suv1 = p.eu_s[ev1] * p.egate[(size_t)t * 128 + (kq1 & 127)];
#pragma unroll 1
  for (int c = 0; c < 8; ++c) {
    const int lbase = c * 8;
    const int ea = __shfl(ev0, lbase + (li >> 1)), eb = __shfl(ev1, lbase + (li >> 1));
    const int e_lane = (li & 1) ? eb : ea;
    const unsigned char* arow = p.ed8 + (size_t)e_lane * 512 + g * 16;
    uint4 a[8];
#pragma unroll
    for (int st = 0; st < 8; ++st) a[st] = *(const uint4*)(arow + st * 64);
    urow_t u[16];
#pragma unroll
    for (int i = 0; i < 16; ++i) {
      const int ei_s = __builtin_amdgcn_readlane((i & 1) ? ev1 : ev0, lbase + (i >> 1));
      u[i] = *(const urow_t*)(p.eu8 + ((size_t)ei_s * 64 + lane) * UROW_BYTES);
    }
    const int mrow = 4 * g + (li & 3);
    const float sda = __shfl(sdv0, lbase + (mrow >> 1)), sdb = __shfl(sdv1, lbase + (mrow >> 1));
    const float sua = __shfl(suv0, lbase + (mrow >> 1)), sub = __shfl(suv1, lbase + (mrow >> 1));
    const float sd_m = (mrow & 1) ? sdb : sda, su_m = (mrow & 1) ? sub : sua;
    f32x4_t d4 = {0.f, 0.f, 0.f, 0.f};
#pragma unroll
    for (int st = 0; st < 8; ++st) {
      const v8i_t av = v8i_t{(int)a[st].x, (int)a[st].y, (int)a[st].z, (int)a[st].w, 0, 0, 0, 0};
      d4 = __builtin_amdgcn_mfma_scale_f32_16x16x128_f8f6f4(av, xb[st], d4, 4, 0, 0, 0x7f7f7f7f, 0, 0x7f7f7f7f);
    }
    const int rsel = li & 3;
    const float dsel = rsel == 0 ? d4[0] : rsel == 1 ? d4[1] : rsel == 2 ? d4[2] : d4[3];
    const float cvs = gelu_fast(dsel * sd_m * 0.0625f) * su_m;
#pragma unroll
    for (int i = 0; i < 16; ++i) {
      const float cf = __int_as_float(__builtin_amdgcn_readlane(__float_as_int(cvs), 16 * (i >> 2) + (i & 3)));
      const f32x2_t cf2 = {cf, cf};
      f32x2_t uu[8];
      DEC_U(u[i], uu);
#pragma unroll
      for (int k = 0; k < 8; ++k) acc2[k] = cf2 * uu[k] + acc2[k];
    }
  }
  float* orow = p.out + (size_t)t * DM + lane * 16;
#pragma unroll
  for (int i = 0; i < 4; ++i) {
    float4 hv = *(float4*)(orow + i * 4);
    hv.x += acc2[2 * i].x; hv.y += acc2[2 * i].y; hv.z += acc2[2 * i + 1].x; hv.w += acc2[2 * i + 1].y;
    *(float4*)(orow + i * 4) = hv;
  }
}
#define EX_TOK_PER_VB 4
#else
#define EX_TOK_PER_VB (4 * EX_NTOK)
__device__ __forceinline__ void k_peer_experts(const int VB, const Params& p, const ushort_t* __restrict__ hn) {
  const int lane = threadIdx.x & 63;
  const int wave = __builtin_amdgcn_readfirstlane(threadIdx.x >> 6);
  const int t0 = (VB * 4 + wave) * EX_NTOK;
  const int myex = ((lane >> 5) & 1) * 4 + ((lane >> 4) & 1) * 2 + ((lane >> 3) & 1);
  const bool b5 = (lane & 32) != 0, b4 = (lane & 16) != 0, b3 = (lane & 8) != 0;
  f32x2_t x2[EX_NTOK][8], acc2[EX_NTOK][8];
  int e0[EX_NTOK], e1[EX_NTOK];
  float g0[EX_NTOK], g1[EX_NTOK];
#pragma unroll
  for (int k = 0; k < EX_NTOK; ++k) {
    float f0[8], f1[8];
    unpack8(*(const uint4*)(hn + (size_t)(t0 + k) * DM + lane * 16), f0);
    unpack8(*(const uint4*)(hn + (size_t)(t0 + k) * DM + lane * 16 + 8), f1);
#pragma unroll
    for (int i = 0; i < 4; ++i) {
      x2[k][i] = f32x2_t{f0[2 * i], f0[2 * i + 1]};
      x2[k][4 + i] = f32x2_t{f1[2 * i], f1[2 * i + 1]};
    }
#pragma unroll
    for (int i = 0; i < 8; ++i) acc2[k][i] = f32x2_t{0.f, 0.f};
    e0[k] = p.eidx[(size_t)(t0 + k) * 128 + lane];
    e1[k] = p.eidx[(size_t)(t0 + k) * 128 + 64 + lane];
    g0[k] = p.egate[(size_t)(t0 + k) * 128 + lane];
    g1[k] = p.egate[(size_t)(t0 + k) * 128 + 64 + lane];
  }
#pragma unroll 1
  for (int s = 0; s < 16; ++s) {
#pragma unroll
    for (int k = 0; k < EX_NTOK; ++k) {
      unsigned long long m0 = __ballot((e0[k] >> 10) == s);
      unsigned long long m1 = __ballot((e1[k] >> 10) == s);
      while ((m0 | m1) != 0ull) {
        int ce[8];
        float cg[8];
#pragma unroll
        for (int i = 0; i < 8; ++i) {
          int ev = 0;
          float gv = 0.f;
          if (m0 != 0ull) {
            const int ln = __builtin_ctzll(m0);
            m0 &= m0 - 1ull;
            ev = __builtin_amdgcn_readlane(e0[k], ln);
            gv = __int_as_float(__builtin_amdgcn_readlane(__float_as_int(g0[k]), ln));
          } else if (m1 != 0ull) {
            const int ln = __builtin_ctzll(m1);
            m1 &= m1 - 1ull;
            ev = __builtin_amdgcn_readlane(e1[k], ln);
            gv = __int_as_float(__builtin_amdgcn_readlane(__float_as_int(g1[k]), ln));
          }
          ce[i] = ev;
          cg[i] = gv;
        }
        peer_chunk(p, lane, myex, b5, b4, b3, ce, cg, x2[k], acc2[k]);
      }
    }
  }
#pragma unroll
  for (int k = 0; k < EX_NTOK; ++k) {
    float* orow = p.out + (size_t)(t0 + k) * DM + lane * 16;
#pragma unroll
    for (int i = 0; i < 4; ++i) {
      float4 hv = *(float4*)(orow + i * 4);
      hv.x += acc2[k][2 * i].x; hv.y += acc2[k][2 * i].y; hv.z += acc2[k][2 * i + 1].x; hv.w += acc2[k][2 * i + 1].y;
      *(float4*)(orow + i * 4) = hv;
    }
  }
}

#endif

#define PHASE(NBLK, CALL) \
  for (int VB = blockIdx.x; VB < (NBLK); VB += gridDim.x) { CALL; __syncthreads(); }
#define PHASE_NS(NBLK, CALL) \
  for (int VB = blockIdx.x; VB < (NBLK); VB += gridDim.x) { CALL; }
#define PHASE_OFF(OFF, NBLK, CALL) \
  for (int VB = (int)((blockIdx.x + gridDim.x - ((OFF) % gridDim.x)) % gridDim.x); VB < (NBLK); VB += gridDim.x) { CALL; __syncthreads(); }

__global__ __launch_bounds__(256, 2) void fwd_megakernel(Params p) {
  __shared__ __attribute__((aligned(16))) char smem_raw[SMEM_BYTES];
  float* smem = (float*)smem_raw;
  volatile LAS unsigned* xb_st = (volatile LAS unsigned*)(smem_raw + 73728);
  if (threadIdx.x == 0) { xb_st[0] = 0u; xb_st[1] = 0u; xb_st[2] = 0u; xb_st[3] = 0u; }
  __syncthreads();
  const XcdBarrier xb = xcd_barrier_post(p.bar, xb_st);
  {
    for (int k = threadIdx.x; k < DM; k += 256) {
      const float* wr = p.w_in + (size_t)k * INC + 1536;
      const float4 a = *(const float4*)(wr), b = *(const float4*)(wr + 4);
      smem[0 * 1024 + k] = a.x; smem[1 * 1024 + k] = a.y; smem[2 * 1024 + k] = a.z; smem[3 * 1024 + k] = a.w;
      smem[4 * 1024 + k] = b.x; smem[5 * 1024 + k] = b.y; smem[6 * 1024 + k] = b.z; smem[7 * 1024 + k] = b.w;
    }
    __syncthreads();
    PHASE_NS(NT / 8, ph_rmsnorm_bf16(VB, p.x, p.mix_norm_w, p.xn_b, smem, p.dt_bias, p.dt));
    __syncthreads();
  }
  PHASE_NS(NB * MEM / 8, ph_rmsnorm_bf16(VB, p.mem, p.mem_norm_w, p.memn_b, nullptr, nullptr, nullptr));
  PHASE(16 * 40, ph_wtrans(VB, smem, p.w_in, INC, p.w_inT, 40, 8, nullptr));
  PHASE(16 * 16, ph_wtrans(VB, smem, p.w_out, DM, p.w_outT, 16, 0, nullptr));
  PHASE(16 * 16, ph_wtrans(VB, smem, p.w_query, DM, p.w_qT, 16, 0, p.ffn_norm_w));
  PHASE(16 * 8, ph_wtrans(VB, smem, p.w_mem_kv, 512, p.w_memT, 8, 0, nullptr));
  if (blockIdx.x == 0) p.bcnt[threadIdx.x] = 0;
  ph_subkeys(p);
  xcd_barrier(xb);
  PHASE(20 * (NT / 128), ph_gemm_proj(VB, smem_raw, p));
  xcd_barrier(xb);
  PHASE(NB * 64 * 8, ph_ssd1(VB, smem_raw, p));
  PHASE(NB * 4 * 32, k_gate(VB, smem_raw, p));
  PHASE_OFF(256, 4 * (NB * MEM / 128), ph_gemm_mem(VB, smem_raw, p));
  xcd_barrier(xb);
  PHASE_NS(NB * 8 * 64 * 128 / 256, ph_ssd2(VB, p));
  {
    int* s_pref = (int*)(smem_raw + 72192);
    {
      const int tid = threadIdx.x;
      int v = (p.bcnt[tid] + 127) >> 7;
      const int lane = tid & 63;
#pragma unroll
      for (int o = 1; o < 64; o <<= 1) { int nb = __shfl_up(v, o); if (lane >= o) v += nb; }
      int* s_wt = s_pref + 256;
      if (lane == 63) s_wt[tid >> 6] = v;
      __syncthreads();
      int add = 0;
      for (int ww = 0; ww < (tid >> 6); ++ww) add += s_wt[ww];
      s_pref[tid] = v + add;
      __syncthreads();
    }
    const int Ug = s_pref[255];
    ph_attn_units(smem_raw, p, Ug, s_pref);
    __syncthreads();
  }
  xcd_barrier(xb);
  PHASE(NB * 64 * 2, ph_ssd3(VB, smem_raw, p));
  if (gridDim.x >= 512) {
    for (int VB = (int)blockIdx.x - 256; VB >= 0 && VB < NT * 4 * 8 / 256; VB += gridDim.x - 256) ph_attn_combine(VB, p);
  } else {
    PHASE_NS(NT * 4 * 8 / 256, ph_attn_combine(VB, p));
  }
  xcd_barrier(xb);
  PHASE(8 * (NT / 128), ph_gemm_f32(VB, smem_raw, p.mixed_b, p.w_outT, p.out, p.x, p.xn_b, p.hss));
  xcd_barrier(xb);
  ushort_t* hn_b = p.xn_b;
  {
    int cv = blockIdx.x;
    for (int VB = blockIdx.x; VB < 8 * (NT / 128); VB += gridDim.x) {
      ph_gemm_route(VB, smem_raw, p, hn_b);
      __syncthreads();
      for (int i = 0; i < 8 && cv < 8192; ++i, cv += gridDim.x) {
        if (cv < 4096) {
#if EX_FP4_DOWN
          ph_cvt4(cv, p.e_down, p.ed8, p.ed_s);
#else
          ph_cvt8(cv, p.e_down, p.ed8, p.ed_s);
#endif
        } else {
#if EX_FP4_UP
          ph_cvt4(cv - 4096, p.e_up, p.eu8, p.eu_s);
#else
          ph_cvt8(cv - 4096, p.e_up, p.eu8, p.eu_s);
#endif
        }
      }
    }
    for (; cv < 8192; cv += gridDim.x) {
      if (cv < 4096) {
#if EX_FP4_DOWN
        ph_cvt4(cv, p.e_down, p.ed8, p.ed_s);
#else
        ph_cvt8(cv, p.e_down, p.ed8, p.ed_s);
#endif
      } else {
#if EX_FP4_UP
        ph_cvt4(cv - 4096, p.e_up, p.eu8, p.eu_s);
#else
        ph_cvt8(cv - 4096, p.e_up, p.eu8, p.eu_s);
#endif
      }
    }
  }
  xcd_barrier(xb);
  PHASE_NS(NT / EX_TOK_PER_VB, k_peer_experts(VB, smem_raw, p, hn_b));
}
}

extern "C" void kernel_launch(void* const* d_in, const int* in_sizes, int n_in, void* d_out, int out_size, void* d_ws, size_t ws_size,
                              hipStream_t stream) {
  Params p{};
  p.x = (const float*)d_in[0]; p.mem = (const float*)d_in[1]; p.mix_norm_w = (const float*)d_in[2]; p.w_in = (const float*)d_in[3];
  p.conv_w = (const float*)d_in[4]; p.conv_b = (const float*)d_in[5]; p.dt_bias = (const float*)d_in[6]; p.a_log = (const float*)d_in[7];
  p.ssd_d = (const float*)d_in[8]; p.ssd_norm_w = (const float*)d_in[9]; p.mq_norm_w = (const float*)d_in[10]; p.mk_norm_w = (const float*)d_in[11];
  p.mem_norm_w = (const float*)d_in[12]; p.w_mem_kv = (const float*)d_in[13]; p.xq_norm_w = (const float*)d_in[14]; p.xk_norm_w = (const float*)d_in[15];
  p.w_out = (const float*)d_in[16]; p.ffn_norm_w = (const float*)d_in[17]; p.w_query = (const float*)d_in[18]; p.sk1 = (const float*)d_in[19];
  p.sk2 = (const float*)d_in[20]; p.e_down = (const float*)d_in[21]; p.e_up = (const float*)d_in[22];
  p.out = (float*)d_out;
  char* ws = (char*)d_ws;
  size_t o = 0;
  auto take = [&](size_t bytes) { char* q = ws + o; o += (bytes + 255) & ~(size_t)255; return q; };
  p.xn_b = (ushort_t*)take((size_t)NT * DM * 2);
  p.xc = p.xn_b;
  p.w_inT = (ushort_t*)take((size_t)NPROJ * DM * 2);
  p.w_outT = (ushort_t*)take((size_t)DM * DM * 2);
  p.w_qT = (ushort_t*)take((size_t)DM * DM * 2);
  p.w_memT = (ushort_t*)take((size_t)512 * DM * 2);
  p.memn_b = (ushort_t*)take((size_t)NB * MEM * DM * 2);
  p.memk_b = (ushort_t*)take((size_t)NB * MEM * 256 * 2);
  p.memvT = (ushort_t*)take((size_t)NB * MEM * 256 * 2);
  char* regQ = take((size_t)NT * 2560 * 2);
  p.zs = (ushort_t*)regQ;
  p.xbc_raw = (ushort_t*)(regQ + (size_t)NT * 512 * 2);
  p.mq = (ushort_t*)(regQ + (size_t)NT * 1536 * 2);
  p.mk = (ushort_t*)(regQ + (size_t)NT * 1792 * 2);
  p.vT = (ushort_t*)(regQ + (size_t)NT * 2048 * 2);
  p.xq = (ushort_t*)(regQ + (size_t)NT * 2304 * 2);
  p.q = (float*)regQ;
  p.dt = (float*)take((size_t)NT * 8 * 4);
  p.acs = (float*)take((size_t)NT * 8 * 4);
  p.cdec = (float*)take((size_t)NB * 64 * 8 * 4);
  p.states = (float*)d_out;
  p.sin_b = (ushort_t*)((char*)d_out + (size_t)NB * 64 * 8 * 8192 * 4);
  p.xT = (ushort_t*)((char*)d_out + (size_t)NB * 64 * 8 * 8192 * 6);
  p.mixed_b = (ushort_t*)take((size_t)NT * DM * 2);
  p.kpart = (float*)take((size_t)NB * 4 * 32 * 4 * 64 * 4);
  p.bcnt = (int*)take(256 * 4);
  p.blist = (int*)take((size_t)256 * 8192 * 4);
  p.pm = (float*)take((size_t)NT * 16 * 4);
  p.pl = (float*)take((size_t)NT * 16 * 4);
  p.pO = p.xbc_raw;
  p.eidx = (int*)take((size_t)NT * 128 * 4);
  p.egate = (float*)take((size_t)NT * 128 * 4);
  p.ed8 = (unsigned char*)take((size_t)16384 * DM);
  p.eu8 = (unsigned char*)take((size_t)16384 * DM);
  p.ed_s = (float*)take(16384 * 4);
  p.eu_s = (float*)take(16384 * 4);
  p.bar = (unsigned*)take(XCD_BAR_WORDS * 4);
  p.hss = (float*)take((size_t)NT * 16 * 4);
  p.skh = (ushort_t*)take(2 * 128 * 64 * 2);
  p.skl = (ushort_t*)take(2 * 128 * 64 * 2);
  if (o > ws_size) return;
  (void)hipMemsetAsync(p.bar, 0, XCD_BAR_WORDS * 4, stream);
  static int grid_blocks = 0;
  if (!grid_blocks) {
    int dev = 0, cus = 0, per_cu = 0;
    (void)hipGetDevice(&dev);
    (void)hipDeviceGetAttribute(&cus, hipDeviceAttributeMultiprocessorCount, dev);
    (void)hipOccupancyMaxActiveBlocksPerMultiprocessor(&per_cu, fwd_megakernel, 256, 0);
    if (per_cu > 2) per_cu = 2;
    if (per_cu < 1) per_cu = 1;
    grid_blocks = cus * per_cu;
  }
  void* args[] = {&p};
  hipError_t e = hipLaunchCooperativeKernel((void*)fwd_megakernel, dim3(grid_blocks), dim3(256), args, 0, stream);
  if (e != hipSuccess) fprintf(stderr, "cooperative launch failed: %s (grid %d)\n", hipGetErrorString(e), grid_blocks);
}
```

```cpp
#include <hip/hip_runtime.h>
#include <hip/hip_cooperative_groups.h>
#include <cstdio>
#include <math.h>
#include <stdint.h>
namespace cg = cooperative_groups;

#ifndef EX_FP4_DOWN
#define EX_FP4_DOWN 1
#endif
#ifndef EX_FP4_UP
#define EX_FP4_UP 1
#endif
namespace {
typedef unsigned short ushort_t;
typedef __attribute__((ext_vector_type(8))) short bf16x8;
typedef __attribute__((ext_vector_type(16))) float f32x16;

constexpr int DM = 1024;
constexpr int NB = 2;
constexpr int SL = 8192;
constexpr int NT = NB * SL;
constexpr int MEM = 256;
constexpr int INC = 2568;
constexpr int NPROJ = 2560;
constexpr float EPS = 1e-6f;
constexpr int SMEM_BYTES = 73728 + 256;

typedef __attribute__((ext_vector_type(4))) float f32x4_nt;
__device__ __forceinline__ float4 ld_nt4(const float* ptr) {
  const f32x4_nt v = __builtin_nontemporal_load((const f32x4_nt*)ptr);
  return make_float4(v.x, v.y, v.z, v.w);
}
__device__ __forceinline__ float silu_f(float x) { return x * __frcp_rn(1.f + __expf(-x)); }
__device__ __forceinline__ float softplus_f(float x) { return fmaxf(x, 0.f) + log1pf(expf(-fabsf(x))); }
__device__ __forceinline__ float gelu_f(float x) { return 0.5f * x * (1.f + erff(x * 0.70710678118654752f)); }
__device__ __forceinline__ float gelu_fast(float x) {
  const float z = fabsf(x) * 0.70710678118654752f;
  const float t = __frcp_rn(fmaf(0.3275911f, z, 1.f));
  float pl = fmaf(1.061405429f, t, -1.453152027f);
  pl = fmaf(pl, t, 1.421413741f);
  pl = fmaf(pl, t, -0.284496736f);
  pl = fmaf(pl, t, 0.254829592f);
  const float er = 1.f - pl * t * __expf(-z * z);
  return 0.5f * x * (1.f + copysignf(er, x));
}
typedef __attribute__((ext_vector_type(2))) __bf16 bf16x2_hw;
typedef __attribute__((ext_vector_type(2))) float f32x2_hw;
__device__ __forceinline__ unsigned pack2(float a, float b) {
  const f32x2_hw v = {a, b};
  return __builtin_bit_cast(unsigned, __builtin_convertvector(v, bf16x2_hw));
}
__device__ __forceinline__ ushort_t f2bf(float x) { return (ushort_t)(pack2(x, 0.f) & 0xffffu); }
__device__ __forceinline__ float bf2f(ushort_t h) { return __uint_as_float(((unsigned)h) << 16); }
__device__ __forceinline__ float bflo(unsigned w) { return __uint_as_float(w << 16); }
__device__ __forceinline__ float bfhi(unsigned w) { return __uint_as_float(w & 0xffff0000u); }

__device__ __forceinline__ void unpack8(const uint4 v, float (&f)[8]) {
  f[0] = bflo(v.x); f[1] = bfhi(v.x); f[2] = bflo(v.y); f[3] = bfhi(v.y);
  f[4] = bflo(v.z); f[5] = bfhi(v.z); f[6] = bflo(v.w); f[7] = bfhi(v.w);
}

__device__ __forceinline__ float wave_sum(float v) {
#pragma unroll
  for (int o = 32; o > 0; o >>= 1) v += __shfl_xor(v, o);
  return v;
}
__device__ __forceinline__ float wave_max(float v) {
#pragma unroll
  for (int o = 32; o > 0; o >>= 1) v = fmaxf(v, __shfl_xor(v, o));
  return v;
}


#define XB_TMO      128
#define XB_XCNT(j)  (256  + 64 * (j))
#define XB_XSUB(j)  (1280 + 64 * (j))
#define XB_XGEN(j)  (2304 + 64 * (j))
#define XB_TOP      3328
#define XB_TOPGEN   3392
#define XCD_BAR_WORDS 3456
#define XB_SPIN_CAP (1u << 20)
#define LAS __attribute__((address_space(3)))
__device__ __forceinline__ unsigned xb_ld(unsigned* p)              { return __hip_atomic_load(p, __ATOMIC_RELAXED, __HIP_MEMORY_SCOPE_AGENT); }
__device__ __forceinline__ unsigned xb_add(unsigned* p, unsigned v) { return __hip_atomic_fetch_add(p, v, __ATOMIC_RELAXED, __HIP_MEMORY_SCOPE_AGENT); }
__device__ __forceinline__ unsigned xb_xcc_id() { return (unsigned)__builtin_amdgcn_s_getreg((3 << 11) | 20) & 0xFu; }
#define XB_SPIN(cond, bar) do { unsigned _sp = 0; while (cond) { __builtin_amdgcn_s_sleep(1); \
    if ((++_sp & 255u) == 0u) { if (xb_ld(&(bar)[XB_TMO])) break; if (_sp > XB_SPIN_CAP) { atomicAdd(&(bar)[XB_TMO], 1u); break; } } } } while (0)
struct XcdBarrier { unsigned* bar; unsigned x; volatile LAS unsigned* st; };
__device__ __forceinline__ XcdBarrier xcd_barrier_post(unsigned* bar, volatile LAS unsigned* st) {
  XcdBarrier b; b.bar = bar; b.x = xb_xcc_id(); b.st = st;
  if (threadIdx.x == 0) (void)xb_add(&bar[XB_XCNT(b.x)], 1u);
  return b;
}
__device__ __forceinline__ void xcd_barrier_complete(unsigned* bar, unsigned x, unsigned& nloc, unsigned& nx) {
  const unsigned G = gridDim.x * gridDim.y * gridDim.z;
  unsigned sum, cnt, mine, sp = 0u;
  for (;;) {
    sum = 0u; cnt = 0u; mine = 0u;
#pragma unroll
    for (unsigned j = 0; j < 16; ++j) { const unsigned c = xb_ld(&bar[XB_XCNT(j)]); sum += c; cnt += (c > 0u) ? 1u : 0u; mine = (j == x) ? c : mine; }
    if (sum == G) break;
    __builtin_amdgcn_s_sleep(1);
    if ((++sp & 255u) == 0u) { if (xb_ld(&bar[XB_TMO])) break; if (sp > XB_SPIN_CAP) { atomicAdd(&bar[XB_TMO], 1u); break; } }
  }
  nloc = mine > 0u ? mine : 1u; nx = cnt > 0u ? cnt : 1u;
}
__device__ __forceinline__ void xcd_barrier(const XcdBarrier& b) {
  asm volatile("s_waitcnt vmcnt(0)" ::: "memory");
  __syncthreads();
  if (threadIdx.x == 0) {
    unsigned* bar = b.bar;
    __builtin_amdgcn_s_waitcnt(0);
    unsigned nloc = b.st[0], nx = b.st[1];
    if (nloc == 0u) { xcd_barrier_complete(bar, b.x, nloc, nx); b.st[0] = nloc; b.st[1] = nx; }
    const unsigned old = xb_add(&bar[XB_XSUB(b.x)], 1u);
    const unsigned gen = old / nloc;
    if (old + 1u == (gen + 1u) * nloc) {
      __builtin_amdgcn_fence(__ATOMIC_RELEASE, "agent");
      asm volatile("s_waitcnt vmcnt(0)" ::: "memory");
      const unsigned og = xb_add(&bar[XB_TOP], 1u);
      const unsigned tg = og / nx;
      if (og + 1u == (tg + 1u) * nx) xb_add(&bar[XB_TOPGEN], 1u);
      else XB_SPIN(xb_ld(&bar[XB_TOPGEN]) == tg, bar);
      __builtin_amdgcn_fence(__ATOMIC_ACQUIRE, "agent");
      xb_add(&bar[XB_XGEN(b.x)], 1u);
      asm volatile("s_waitcnt vmcnt(0)" ::: "memory");
    } else {
      XB_SPIN(xb_ld(&bar[XB_XGEN(b.x)]) == gen, bar);
      __builtin_amdgcn_fence(__ATOMIC_ACQUIRE, "agent");
      asm volatile("s_waitcnt vmcnt(0)" ::: "memory");
    }
  }
  __syncthreads();
}

struct Params {
  const float *x, *mem, *mix_norm_w, *w_in, *conv_w, *conv_b, *dt_bias, *a_log, *ssd_d, *ssd_norm_w, *mq_norm_w, *mk_norm_w,
      *mem_norm_w, *w_mem_kv, *xq_norm_w, *xk_norm_w, *w_out, *ffn_norm_w, *w_query, *sk1, *sk2, *e_down, *e_up;
  float* out;
  ushort_t *xn_b, *w_inT, *w_outT, *w_qT, *w_memT, *memn_b, *zs, *xbc_raw, *mq, *mk, *xq, *memk_b, *mixed_b;
  float *dt, *q, *egate, *acs, *cdec, *states, *wdec;
  ushort_t *xc, *xT, *sin_b;
  int *eidx, *bcnt, *blist;
  unsigned* bar;
  float* hss;
  ushort_t *skh, *skl;
  unsigned char *ed8, *eu8;
  float *ed_s, *eu_s;
  float *kpart, *pm, *pl;
  ushort_t *vT, *memvT, *pO;
};

__device__ __forceinline__ void ph_rmsnorm_bf16(const int vb, const float* __restrict__ x, const float* __restrict__ w,
                                                ushort_t* __restrict__ outb, const float* s_wdt  , const float* __restrict__ dt_bias,
                                                float* __restrict__ dt) {
  const int lane = threadIdx.x & 63;
  const int row0 = vb * 8 + (threadIdx.x >> 6) * 2;
  float4 v[2][4];
#pragma unroll
  for (int rr = 0; rr < 2; ++rr)
#pragma unroll
    for (int i = 0; i < 4; ++i) v[rr][i] = ld_nt4(x + (size_t)(row0 + rr) * DM + i * 256 + lane * 4);
  float4 ww[4];
#pragma unroll
  for (int i = 0; i < 4; ++i) ww[i] = *(const float4*)(w + i * 256 + lane * 4);
#pragma unroll
  for (int rr = 0; rr < 2; ++rr) {
    const int row = row0 + rr;
    float ss = 0.f;
#pragma unroll
    for (int i = 0; i < 4; ++i) ss += v[rr][i].x * v[rr][i].x + v[rr][i].y * v[rr][i].y + v[rr][i].z * v[rr][i].z + v[rr][i].w * v[rr][i].w;
    ss = wave_sum(ss);
    const float r = rsqrtf(ss / DM + EPS);
    float part[8];
#pragma unroll
    for (int hh = 0; hh < 8; ++hh) part[hh] = 0.f;
#pragma unroll
    for (int i = 0; i < 4; ++i) {
      const float o0 = v[rr][i].x * r * ww[i].x, o1 = v[rr][i].y * r * ww[i].y, o2 = v[rr][i].z * r * ww[i].z, o3 = v[rr][i].w * r * ww[i].w;
      *(uint2*)(outb + (size_t)row * DM + i * 256 + lane * 4) = make_uint2(pack2(o0, o1), pack2(o2, o3));
      if (dt) {
        const float xs[4] = {o0, o1, o2, o3};
#pragma unroll
        for (int hh = 0; hh < 8; ++hh) {
          const float4 wv = *(const float4*)(s_wdt + hh * 1024 + i * 256 + lane * 4);
          part[hh] = fmaf(xs[0], wv.x, part[hh]); part[hh] = fmaf(xs[1], wv.y, part[hh]);
          part[hh] = fmaf(xs[2], wv.z, part[hh]); part[hh] = fmaf(xs[3], wv.w, part[hh]);
        }
      }
    }
    if (dt) {
      float mine = 0.f;
#pragma unroll
      for (int hh = 0; hh < 8; ++hh) {
        const float sfull = wave_sum(part[hh]);
        if (lane == hh) mine = sfull;
      }
      if (lane < 8) dt[(size_t)row * 8 + lane] = softplus_f(mine + dt_bias[lane]);
    }
  }
}

__device__ __forceinline__ void ph_wtrans(const int vb, float* smem, const float* __restrict__ W, const int ldw, ushort_t* __restrict__ Wt,
                                          const int ntiles, const int skip, const float* __restrict__ rowscale) {
  float (*s)[65] = (float (*)[65])smem;
  const int tid = threadIdx.x;
  const int kt = vb / ntiles, nt = vb % ntiles;
  const int nd0 = nt * 64;
  const int ns0 = (nd0 < 1536) ? nd0 : nd0 + skip;
  {
    const int k = tid >> 2, nc = (tid & 3) * 16;
    const float* src = W + (size_t)(kt * 64 + k) * ldw + ns0 + nc;
    const float rsc = rowscale ? rowscale[kt * 64 + k] : 1.f;
#pragma unroll
    for (int j = 0; j < 4; ++j) {
      float4 v = *(const float4*)(src + j * 4);
      v.x *= rsc; v.y *= rsc; v.z *= rsc; v.w *= rsc;
      s[k][nc + j * 4 + 0] = v.x; s[k][nc + j * 4 + 1] = v.y; s[k][nc + j * 4 + 2] = v.z; s[k][nc + j * 4 + 3] = v.w;
    }
  }
  __syncthreads();
  {
    const int n = tid >> 2, kc = (tid & 3) * 16;
    unsigned pk[8];
#pragma unroll
    for (int j = 0; j < 8; ++j) pk[j] = pack2(s[kc + 2 * j][n], s[kc + 2 * j + 1][n]);
    ushort_t* dst = Wt + (size_t)(nd0 + n) * DM + kt * 64 + kc;
    *(uint4*)(dst) = make_uint4(pk[0], pk[1], pk[2], pk[3]);
    *(uint4*)(dst + 8) = make_uint4(pk[4], pk[5], pk[6], pk[7]);
  }
}

__device__ __forceinline__ void ph_cvt(const int vb, const float* __restrict__ src, ushort_t* __restrict__ dst) {
  const size_t base = (size_t)vb * 8192 + threadIdx.x * 8;
  float4 a[4], b[4];
#pragma unroll
  for (int i = 0; i < 4; ++i) {
    a[i] = *(const float4*)(src + base + i * 2048);
    b[i] = *(const float4*)(src + base + i * 2048 + 4);
  }
#pragma unroll
  for (int i = 0; i < 4; ++i)
    *(uint4*)(dst + base + i * 2048) = make_uint4(pack2(a[i].x, a[i].y), pack2(a[i].z, a[i].w), pack2(b[i].x, b[i].y), pack2(b[i].z, b[i].w));
}


typedef __attribute__((ext_vector_type(2))) float f32x2_t;
__device__ __forceinline__ void ph_cvt8(const int vb, const float* __restrict__ src, unsigned char* __restrict__ dst, float* __restrict__ inv_scale) {
  const int lane = threadIdx.x & 63;
  const int row = vb * 4 + (threadIdx.x >> 6);
  const float* sr = src + (size_t)row * DM + lane * 16;
  float4 v[4];
#pragma unroll
  for (int i = 0; i < 4; ++i) v[i] = ld_nt4(sr + i * 4);
  float am = 0.f;
#pragma unroll
  for (int i = 0; i < 4; ++i) am = fmaxf(fmaxf(fmaxf(am, fabsf(v[i].x)), fmaxf(fabsf(v[i].y), fabsf(v[i].z))), fabsf(v[i].w));
  am = wave_max(am);
  const float sc = (am > 0.f) ? 224.f / am : 1.f;
  unsigned w[4];
#pragma unroll
  for (int i = 0; i < 4; ++i) {
    int t = 0;
    t = __builtin_amdgcn_cvt_pk_fp8_f32(v[i].x * sc, v[i].y * sc, t, false);
    t = __builtin_amdgcn_cvt_pk_fp8_f32(v[i].z * sc, v[i].w * sc, t, true);
    w[i] = (unsigned)t;
  }
  *(uint4*)(dst + (size_t)row * DM + lane * 16) = make_uint4(w[0], w[1], w[2], w[3]);
  if (lane == 0) inv_scale[row] = (am > 0.f) ? am * (1.f / 224.f) : 1.f;
}

__device__ __forceinline__ void ph_cvt4(const int vb, const float* __restrict__ src, unsigned char* __restrict__ dst, float* __restrict__ inv_scale) {
  const int lane = threadIdx.x & 63;
  const int row = vb * 4 + (threadIdx.x >> 6);
  const float* sr = src + (size_t)row * DM + lane * 16;
  float4 v[4];
#pragma unroll
  for (int i = 0; i < 4; ++i) v[i] = ld_nt4(sr + i * 4);
  float am = 0.f;
#pragma unroll
  for (int i = 0; i < 4; ++i) am = fmaxf(fmaxf(fmaxf(am, fabsf(v[i].x)), fmaxf(fabsf(v[i].y), fabsf(v[i].z))), fabsf(v[i].w));
  am = wave_max(am);
  const float sc = (am > 0.f) ? 6.f / am : 1.f;
  unsigned w0 = 0u, w1 = 0u;
  w0 = __builtin_amdgcn_cvt_scalef32_pk_fp4_f32(w0, v[0].x * sc, v[0].y * sc, 1.0f, 0);
  w0 = __builtin_amdgcn_cvt_scalef32_pk_fp4_f32(w0, v[0].z * sc, v[0].w * sc, 1.0f, 1);
  w0 = __builtin_amdgcn_cvt_scalef32_pk_fp4_f32(w0, v[1].x * sc, v[1].y * sc, 1.0f, 2);
  w0 = __builtin_amdgcn_cvt_scalef32_pk_fp4_f32(w0, v[1].z * sc, v[1].w * sc, 1.0f, 3);
  w1 = __builtin_amdgcn_cvt_scalef32_pk_fp4_f32(w1, v[2].x * sc, v[2].y * sc, 1.0f, 0);
  w1 = __builtin_amdgcn_cvt_scalef32_pk_fp4_f32(w1, v[2].z * sc, v[2].w * sc, 1.0f, 1);
  w1 = __builtin_amdgcn_cvt_scalef32_pk_fp4_f32(w1, v[3].x * sc, v[3].y * sc, 1.0f, 2);
  w1 = __builtin_amdgcn_cvt_scalef32_pk_fp4_f32(w1, v[3].z * sc, v[3].w * sc, 1.0f, 3);
  *(uint2*)(dst + (size_t)row * (DM / 2) + lane * 8) = make_uint2(w0, w1);
  if (lane == 0) inv_scale[row] = (am > 0.f) ? am * (1.f / 6.f) : 1.f;
}
__device__ __forceinline__ void dec16_fp8(const uint4 d, f32x2_t (&o)[8]) {
  const unsigned w[4] = {d.x, d.y, d.z, d.w};
#pragma unroll
  for (int k = 0; k < 4; ++k) {
    o[2 * k] = __builtin_amdgcn_cvt_pk_f32_fp8((int)w[k], false);
    o[2 * k + 1] = __builtin_amdgcn_cvt_pk_f32_fp8((int)w[k], true);
  }
}
__device__ __forceinline__ void dec16_fp4(const uint2 d, f32x2_t (&o)[8]) {
  o[0] = __builtin_amdgcn_cvt_scalef32_pk_f32_fp4(d.x, 1.0f, 0); o[1] = __builtin_amdgcn_cvt_scalef32_pk_f32_fp4(d.x, 1.0f, 1);
  o[2] = __builtin_amdgcn_cvt_scalef32_pk_f32_fp4(d.x, 1.0f, 2); o[3] = __builtin_amdgcn_cvt_scalef32_pk_f32_fp4(d.x, 1.0f, 3);
  o[4] = __builtin_amdgcn_cvt_scalef32_pk_f32_fp4(d.y, 1.0f, 0); o[5] = __builtin_amdgcn_cvt_scalef32_pk_f32_fp4(d.y, 1.0f, 1);
  o[6] = __builtin_amdgcn_cvt_scalef32_pk_f32_fp4(d.y, 1.0f, 2); o[7] = __builtin_amdgcn_cvt_scalef32_pk_f32_fp4(d.y, 1.0f, 3);
}
#if EX_FP4_DOWN
typedef uint2 drow_t;
#define DROW_BYTES 8
#define DEC_D dec16_fp4
#else
typedef uint4 drow_t;
#define DROW_BYTES 16
#define DEC_D dec16_fp8
#endif
#if EX_FP4_UP
typedef uint2 urow_t;
#define UROW_BYTES 8
#define DEC_U dec16_fp4
#else
typedef uint4 urow_t;
#define UROW_BYTES 16
#define DEC_U dec16_fp8
#endif

__device__ __forceinline__ int swz(int row, int ch) { return row * 128 + ((ch ^ ((row >> 1) & 7)) << 4); }

__device__ __forceinline__ void gemm_compute(const char* cA, const char* cB, const int arow, const int brow, const int xr, const int h,
                                             f32x16 (&acc)[2][2]) {
#pragma unroll
  for (int ks = 0; ks < 4; ++ks) {
    const int co = ((ks * 2 + h) ^ xr) << 4;
    bf16x8 a0 = *(const bf16x8*)(cA + arow + co);
    bf16x8 a1 = *(const bf16x8*)(cA + arow + 32 * 128 + co);
    bf16x8 b0 = *(const bf16x8*)(cB + brow + co);
    bf16x8 b1 = *(const bf16x8*)(cB + brow + 32 * 128 + co);
    acc[0][0] = __builtin_amdgcn_mfma_f32_32x32x16_bf16(a0, b0, acc[0][0], 0, 0, 0);
    acc[0][1] = __builtin_amdgcn_mfma_f32_32x32x16_bf16(a0, b1, acc[0][1], 0, 0, 0);
    acc[1][0] = __builtin_amdgcn_mfma_f32_32x32x16_bf16(a1, b0, acc[1][0], 0, 0, 0);
    acc[1][1] = __builtin_amdgcn_mfma_f32_32x32x16_bf16(a1, b1, acc[1][1], 0, 0, 0);
  }
}

__device__ __forceinline__ void gemm_core(const ushort_t* __restrict__ A, const ushort_t* __restrict__ Bt, const int K, const int m0,
                                          const int n0, char* smem, f32x16 (&acc)[2][2]) {
  int tid = threadIdx.x;
  asm volatile("" : "+v"(tid));
  const int lane = tid & 63;
  const int wave = __builtin_amdgcn_readfirstlane(tid >> 6);
  const int wm = wave >> 1, wn = wave & 1;
  const int r = lane & 31, h = lane >> 5;
  const int srow = wave * 8 + (lane >> 3);
  const int schs = (lane & 7) ^ ((srow >> 1) & 7);
  const ushort_t* Ag = A + (size_t)(m0 + srow) * K + schs * 8;
  const ushort_t* Bg = Bt + (size_t)(n0 + srow) * K + schs * 8;
  const size_t rs = (size_t)32 * K;
  char* wbase = smem + wave * 1024;
#define GLDS_TILE(BUF, koff) { \
    __builtin_amdgcn_global_load_lds((const unsigned*)(Ag + (koff)), (unsigned*)(wbase + (BUF)), 16, 0, 0); \
    __builtin_amdgcn_global_load_lds((const unsigned*)(Ag + rs + (koff)), (unsigned*)(wbase + (BUF) + 4096), 16, 0, 0); \
    __builtin_amdgcn_global_load_lds((const unsigned*)(Ag + 2 * rs + (koff)), (unsigned*)(wbase + (BUF) + 8192), 16, 0, 0); \
    __builtin_amdgcn_global_load_lds((const unsigned*)(Ag + 3 * rs + (koff)), (unsigned*)(wbase + (BUF) + 12288), 16, 0, 0); \
    __builtin_amdgcn_global_load_lds((const unsigned*)(Bg + (koff)), (unsigned*)(wbase + (BUF) + 16384), 16, 0, 0); \
    __builtin_amdgcn_global_load_lds((const unsigned*)(Bg + rs + (koff)), (unsigned*)(wbase + (BUF) + 16384 + 4096), 16, 0, 0); \
    __builtin_amdgcn_global_load_lds((const unsigned*)(Bg + 2 * rs + (koff)), (unsigned*)(wbase + (BUF) + 16384 + 8192), 16, 0, 0); \
    __builtin_amdgcn_global_load_lds((const unsigned*)(Bg + 3 * rs + (koff)), (unsigned*)(wbase + (BUF) + 16384 + 12288), 16, 0, 0); }
  GLDS_TILE(0, 0)
#pragma unroll
  for (int i = 0; i < 2; ++i)
#pragma unroll
    for (int j = 0; j < 2; ++j)
#pragma unroll
      for (int e = 0; e < 16; ++e) acc[i][j][e] = 0.f;
  const int nk = K >> 6;
  const int xr = (r >> 1) & 7;
  const int arow = (wm * 64 + r) * 128, brow = (wn * 64 + r) * 128;
  asm volatile("s_waitcnt vmcnt(0)" ::: "memory");
  __syncthreads();
#pragma unroll 1
  for (int kt = 0; kt < nk; kt += 2) {
    GLDS_TILE(32768, (kt + 1) * 64)
    gemm_compute(smem, smem + 16384, arow, brow, xr, h, acc);
    asm volatile("s_waitcnt vmcnt(0)" ::: "memory");
    __syncthreads();
    if (kt + 2 < nk) { GLDS_TILE(0, (kt + 2) * 64) }
    gemm_compute(smem + 32768, smem + 32768 + 16384, arow, brow, xr, h, acc);
    asm volatile("s_waitcnt vmcnt(0)" ::: "memory");
    __syncthreads();
  }
#undef GLDS_TILE
}

enum { EP_SILU = 0, EP_PLAIN = 1, EP_HEADNORM = 2 };

__device__ __forceinline__ void stage_flush_bf16(const char* sw, ushort_t* __restrict__ dst, const size_t ld, const size_t row0, const int col0) {
  const int lane = threadIdx.x & 63;
  const int rr = lane >> 3, ch = lane & 7;
#pragma unroll
  for (int i = 0; i < 8; ++i) {
    const int row = i * 8 + rr;
    const uint4 v = *(const uint4*)(sw + row * 144 + ch * 16);
    *(uint4*)(dst + (row0 + row) * ld + col0 + ch * 8) = v;
  }
}

__device__ __forceinline__ void epi_bf16(char* smem, const f32x16 (&acc)[2][2], const int mode, ushort_t* __restrict__ dst, const int ld,
                                         const int row0, const int col0, const float* __restrict__ nw, float* __restrict__ kp) {
  const int lane = threadIdx.x & 63, r = lane & 31, h = lane >> 5;
  char* sw = smem + (threadIdx.x >> 6) * 9216;
  float w0 = 1.f, w1 = 1.f;
  if (mode == EP_HEADNORM) { w0 = nw[r]; w1 = nw[32 + r]; }
  float cs0 = 0.f, cs1 = 0.f;
#pragma unroll
  for (int mi = 0; mi < 2; ++mi) {
#pragma unroll
    for (int e = 0; e < 16; ++e) {
      const int row = mi * 32 + (e & 3) + 8 * (e >> 2) + 4 * h;
      float v0 = acc[mi][0][e], v1 = acc[mi][1][e];
      if (mode == EP_SILU) { v0 = silu_f(v0); v1 = silu_f(v1); }
      if (mode == EP_HEADNORM) {
        float ss = v0 * v0 + v1 * v1;
        ss += __shfl_xor(ss, 1); ss += __shfl_xor(ss, 2); ss += __shfl_xor(ss, 4); ss += __shfl_xor(ss, 8); ss += __shfl_xor(ss, 16);
        const float rs = rsqrtf(ss * (1.f / 64.f) + EPS);
        v0 = v0 * rs * w0; v1 = v1 * rs * w1;
        cs0 += v0; cs1 += v1;
      }
      *(ushort_t*)(sw + row * 144 + r * 2) = f2bf(v0);
      *(ushort_t*)(sw + row * 144 + 64 + r * 2) = f2bf(v1);
    }
  }
  if (kp) {
    cs0 += __shfl_xor(cs0, 32);
    cs1 += __shfl_xor(cs1, 32);
    if (h == 0) { kp[r] = cs0; kp[32 + r] = cs1; }
  }
  stage_flush_bf16(sw, dst, (size_t)ld, (size_t)row0, col0);
}

__device__ __forceinline__ void epi_bf16_T(char* smem, const f32x16 (&acc)[2][2], ushort_t* __restrict__ dstT, const size_t ldT, const int rowpos0) {
  const int lane = threadIdx.x & 63, r = lane & 31, h = lane >> 5;
  char* sw = smem + (threadIdx.x >> 6) * 9216;
#pragma unroll
  for (int ni = 0; ni < 2; ++ni) {
#pragma unroll
    for (int mi = 0; mi < 2; ++mi) {
#pragma unroll
      for (int q4 = 0; q4 < 4; ++q4) {
        const int rp = mi * 32 + 8 * q4 + 4 * h;
        *(uint2*)(sw + (ni * 32 + r) * 144 + rp * 2) = make_uint2(pack2(acc[mi][ni][4 * q4 + 0], acc[mi][ni][4 * q4 + 1]),
                                                                    pack2(acc[mi][ni][4 * q4 + 2], acc[mi][ni][4 * q4 + 3]));
      }
    }
  }
  stage_flush_bf16(sw, dstT, ldT, 0, rowpos0);
}

__device__ __forceinline__ void epi_f32(char* smem, const f32x16 (&acc)[2][2], float* __restrict__ dst, const int ld, const int row0, const int col0,
                                        const float* __restrict__ resid, ushort_t* __restrict__ dstb, float* __restrict__ hss) {
  const int lane = threadIdx.x & 63, r = lane & 31, h = lane >> 5;
  char* sw = smem + (threadIdx.x >> 6) * 17408;
#pragma unroll
  for (int mi = 0; mi < 2; ++mi) {
#pragma unroll
    for (int e = 0; e < 16; ++e) {
      const int row = mi * 32 + (e & 3) + 8 * (e >> 2) + 4 * h;
      *(float*)(sw + row * 272 + r * 4) = acc[mi][0][e];
      *(float*)(sw + row * 272 + 128 + r * 4) = acc[mi][1][e];
    }
  }
  const int rr = lane >> 4, ch = lane & 15;
#pragma unroll
  for (int hb = 0; hb < 2; ++hb) {
    float4 rv[8];
    if (resid) {
#pragma unroll
      for (int i = 0; i < 8; ++i) rv[i] = ld_nt4(resid + (size_t)(row0 + (hb * 8 + i) * 4 + rr) * ld + col0 + ch * 4);
    }
#pragma unroll
    for (int i = 0; i < 8; ++i) {
      const int row = (hb * 8 + i) * 4 + rr;
      float4 v = *(const float4*)(sw + row * 272 + ch * 16);
      if (resid) { v.x += rv[i].x; v.y += rv[i].y; v.z += rv[i].z; v.w += rv[i].w; }
      *(float4*)(dst + (size_t)(row0 + row) * ld + col0 + ch * 4) = v;
      if (dstb) {
        *(uint2*)(dstb + (size_t)(row0 + row) * ld + col0 + ch * 4) = make_uint2(pack2(v.x, v.y), pack2(v.z, v.w));
        float ss = v.x * v.x + v.y * v.y + v.z * v.z + v.w * v.w;
        ss += __shfl_xor(ss, 1); ss += __shfl_xor(ss, 2); ss += __shfl_xor(ss, 4); ss += __shfl_xor(ss, 8);
        if (ch == 0) hss[(size_t)(row0 + row) * 16 + (col0 >> 6)] = ss;
      }
    }
  }
}

__device__ __forceinline__ void ph_gemm_proj(const int vb, char* smem, const Params& p) {
  const int nt = vb % 20, mt = vb / 20;
  const int m0 = mt * 128, n0 = nt * 128;
  f32x16 acc[2][2];
  gemm_core(p.xn_b, p.w_inT, DM, m0, n0, smem, acc);
  const int wave = threadIdx.x >> 6, wm = wave >> 1, wn = wave & 1;
  const int row0 = m0 + wm * 64;
  const int c = n0 + wn * 64;
  if (c < 512) epi_bf16(smem, acc, EP_SILU, p.zs, 512, row0, c, nullptr, nullptr);
  else if (c < 1536) epi_bf16(smem, acc, EP_PLAIN, p.xbc_raw, 1024, row0, c - 512, nullptr, nullptr);
  else if (c < 1792) epi_bf16(smem, acc, EP_HEADNORM, p.mq, 256, row0, c - 1536, p.mq_norm_w, nullptr);
  else if (c < 2048) {
    const int hh = (c - 1792) >> 6, bb = row0 >> 13, lpos = row0 & (SL - 1);
    epi_bf16(smem, acc, EP_HEADNORM, p.mk, 256, row0, c - 1792, p.mk_norm_w, p.kpart + ((size_t)((bb * 4 + hh) * 32 + (lpos >> 8)) * 4 + ((lpos >> 6) & 3)) * 64);
  } else if (c < 2304) {
    const int hh = (c - 2048) >> 6, bb = row0 >> 13, lpos = row0 & (SL - 1);
    epi_bf16_T(smem, acc, p.vT + (size_t)(bb * 4 + hh) * 64 * SL, SL, lpos);
  }
  else epi_bf16(smem, acc, EP_HEADNORM, p.xq, 256, row0, c - 2304, p.xq_norm_w, nullptr);
}

__device__ __forceinline__ void ph_gemm_mem(const int vb, char* smem, const Params& p) {
  const int nt = vb % 4, mt = vb / 4;
  const int m0 = mt * 128, n0 = nt * 128;
  f32x16 acc[2][2];
  gemm_core(p.memn_b, p.w_memT, DM, m0, n0, smem, acc);
  const int wave = threadIdx.x >> 6, wm = wave >> 1, wn = wave & 1;
  const int row0 = m0 + wm * 64;
  const int c = n0 + wn * 64;
  if (c < 256) epi_bf16(smem, acc, EP_HEADNORM, p.memk_b, 256, row0, c, p.xk_norm_w, nullptr);
  else {
    const int hh = (c - 256) >> 6, bb = row0 >> 8, mpos = row0 & 255;
    epi_bf16_T(smem, acc, p.memvT + (size_t)(bb * 4 + hh) * 64 * MEM, MEM, mpos);
  }
}

__device__ __forceinline__ void ph_gemm_f32(const int vb, char* smem, const ushort_t* A, const ushort_t* Bt, float* dst, const float* resid, ushort_t* dstb, float* hss) {
  const int nt = vb % 8, mt = vb / 8;
  const int m0 = mt * 128, n0 = nt * 128;
  f32x16 acc[2][2];
  gemm_core(A, Bt, DM, m0, n0, smem, acc);
  const int wave = threadIdx.x >> 6, wm = wave >> 1, wn = wave & 1;
  epi_f32(smem, acc, dst, DM, m0 + wm * 64, n0 + wn * 64, resid, dstb, hss);
}

__device__ __forceinline__ int swz256(int row, int ch) { return row * 272 + (ch << 4); }
__device__ __forceinline__ int crow16(int e, int hl) { return (e & 3) + 8 * (e >> 2) + 4 * hl; }

__device__ __forceinline__ void ph_acs(const int vb, const Params& p) {
  const int lane = threadIdx.x & 63;
  const int item = vb * 4 + (threadIdx.x >> 6);
  const int h = item & 7, bc = item >> 3;
  const int t0 = bc * 128;
  const float a_coef = -expf(p.a_log[h]);
  const float d0 = p.dt[(size_t)(t0 + lane) * 8 + h], d1 = p.dt[(size_t)(t0 + 64 + lane) * 8 + h];
  float c0 = d0 * a_coef, c1 = d1 * a_coef;
#pragma unroll
  for (int o = 1; o < 64; o <<= 1) {
    const float n0 = __shfl_up(c0, o), n1 = __shfl_up(c1, o);
    if (lane >= o) { c0 += n0; c1 += n1; }
  }
  c1 += __shfl(c0, 63);
  const float tot = __shfl(c1, 63);
  p.acs[(size_t)(t0 + lane) * 8 + h] = c0;
  p.acs[(size_t)(t0 + 64 + lane) * 8 + h] = c1;
  p.wdec[(size_t)(t0 + lane) * 8 + h] = d0 * expf(tot - c0);
  p.wdec[(size_t)(t0 + 64 + lane) * 8 + h] = d1 * expf(tot - c1);
  if (lane == 0) p.cdec[item] = expf(tot);
}

__device__ __forceinline__ void ph_ssd1(const int vb, char* smem, const Params& p) {
  const int h = vb & 7, c = (vb >> 3) & 63, b = vb >> 9;
  const int g = h >> 2, hq = h & 3;
  int tid = threadIdx.x;
  asm volatile("" : "+v"(tid));
  const int lane = tid & 63, wave = tid >> 6;
  const int t0 = b * SL + c * 128;
  char* s_xw = smem;
  char* s_bt = smem + 17408;
  float* s_acs = (float*)(smem + 52224);
  float* s_w = s_acs + 128;
  float* s_red = s_w + 128;
  if (tid < 128) s_w[tid] = p.wdec[(size_t)(t0 + tid) * 8 + h];
  __syncthreads();
  if (tid < 224) {
    const int seg = tid / 28, cg = tid - seg * 28;
    const bool is_x = cg < 8, is_b = (cg >= 8) && (cg < 24);
    int ch0, trow;
    if (is_x) { ch0 = h * 64 + cg * 8; trow = cg * 8; }
    else if (is_b) { ch0 = 512 + g * 128 + (cg - 8) * 8; trow = (cg - 8) * 8; }
    else { ch0 = 768 + g * 128 + hq * 32 + (cg - 24) * 8; trow = 0; }
    const bool wr_nat = is_x || !is_b || (hq == 0);
    char* tbase = is_x ? s_xw : s_bt;
    const int l0 = seg * 16;
    float w0[8], w1[8], w2[8], w3[8], bias[8];
    {
      const float* cw = p.conv_w + ch0;
      float4 a, bq;
      a = *(const float4*)(cw); bq = *(const float4*)(cw + 4);
      w0[0] = a.x; w0[1] = a.y; w0[2] = a.z; w0[3] = a.w; w0[4] = bq.x; w0[5] = bq.y; w0[6] = bq.z; w0[7] = bq.w;
      a = *(const float4*)(cw + 1024); bq = *(const float4*)(cw + 1028);
      w1[0] = a.x; w1[1] = a.y; w1[2] = a.z; w1[3] = a.w; w1[4] = bq.x; w1[5] = bq.y; w1[6] = bq.z; w1[7] = bq.w;
      a = *(const float4*)(cw + 2048); bq = *(const float4*)(cw + 2052);
      w2[0] = a.x; w2[1] = a.y; w2[2] = a.z; w2[3] = a.w; w2[4] = bq.x; w2[5] = bq.y; w2[6] = bq.z; w2[7] = bq.w;
      a = *(const float4*)(cw + 3072); bq = *(const float4*)(cw + 3076);
      w3[0] = a.x; w3[1] = a.y; w3[2] = a.z; w3[3] = a.w; w3[4] = bq.x; w3[5] = bq.y; w3[6] = bq.z; w3[7] = bq.w;
      a = *(const float4*)(p.conv_b + ch0); bq = *(const float4*)(p.conv_b + ch0 + 4);
      bias[0] = a.x; bias[1] = a.y; bias[2] = a.z; bias[3] = a.w; bias[4] = bq.x; bias[5] = bq.y; bias[6] = bq.z; bias[7] = bq.w;
    }
    float r0[8], r1[8], r2[8];
    {
      const int lg = c * 128 + l0;
      const ushort_t* src = p.xbc_raw + (size_t)(t0 + l0) * 1024 + ch0;
      uint4 z4 = make_uint4(0u, 0u, 0u, 0u);
      uint4 u0 = (lg >= 3) ? *(const uint4*)(src - 3 * 1024) : z4;
      uint4 u1 = (lg >= 2) ? *(const uint4*)(src - 2 * 1024) : z4;
      uint4 u2 = (lg >= 1) ? *(const uint4*)(src - 1 * 1024) : z4;
      unpack8(u0, r0); unpack8(u1, r1); unpack8(u2, r2);
    }
    unsigned outp[8][8];
    float lo[8], los[8];
#pragma unroll
    for (int i = 0; i < 16; ++i) {
      float cur[8], val[8];
      unpack8(*(const uint4*)(p.xbc_raw + (size_t)(t0 + l0 + i) * 1024 + ch0), cur);
#pragma unroll
      for (int j = 0; j < 8; ++j) {
        float v = bias[j];
        v = fmaf(w0[j], r0[j], v); v = fmaf(w1[j], r1[j], v); v = fmaf(w2[j], r2[j], v); v = fmaf(w3[j], cur[j], v);
        val[j] = silu_f(v);
        r0[j] = r1[j]; r1[j] = r2[j]; r2[j] = cur[j];
      }
      if (wr_nat) {
        *(uint4*)(p.xc + (size_t)(t0 + l0 + i) * 1024 + ch0) =
            make_uint4(pack2(val[0], val[1]), pack2(val[2], val[3]), pack2(val[4], val[5]), pack2(val[6], val[7]));
      }
      const float scl = is_x ? s_w[l0 + i] : 1.f;
      if ((i & 1) == 0) {
#pragma unroll
        for (int j = 0; j < 8; ++j) { lo[j] = val[j]; los[j] = val[j] * scl; }
      } else {
        const int chunk = seg * 2 + (i >> 3);
#pragma unroll
        for (int j = 0; j < 8; ++j) {
          outp[j][i >> 1] = pack2(lo[j], val[j]);
          if (is_x || is_b) *(unsigned*)(tbase + swz256(trow + j, chunk) + ((i & 7) - 1) * 2) = pack2(los[j], val[j] * scl);
        }
      }
    }
    if (is_x) {
      ushort_t* dst = p.xT + ((size_t)((b * 64 + c) * 8 + h) * 64 + cg * 8) * 128 + l0;
#pragma unroll
      for (int j = 0; j < 8; ++j) {
        *(uint4*)(dst + (size_t)j * 128) = make_uint4(outp[j][0], outp[j][1], outp[j][2], outp[j][3]);
        *(uint4*)(dst + (size_t)j * 128 + 8) = make_uint4(outp[j][4], outp[j][5], outp[j][6], outp[j][7]);
      }
    }
  }
  __syncthreads();
  {
    const int r = lane & 31, hl = lane >> 5;
    f32x16 acc[2];
#pragma unroll
    for (int e = 0; e < 16; ++e) { acc[0][e] = 0.f; acc[1][e] = 0.f; }
#pragma unroll
    for (int ks = 0; ks < 8; ++ks) {
      const bf16x8 bfr = *(const bf16x8*)(s_bt + swz256(32 * wave + r, ks * 2 + hl));
      const bf16x8 a0 = *(const bf16x8*)(s_xw + swz256(r, ks * 2 + hl));
      const bf16x8 a1 = *(const bf16x8*)(s_xw + swz256(32 + r, ks * 2 + hl));
      acc[0] = __builtin_amdgcn_mfma_f32_32x32x16_bf16(a0, bfr, acc[0], 0, 0, 0);
      acc[1] = __builtin_amdgcn_mfma_f32_32x32x16_bf16(a1, bfr, acc[1], 0, 0, 0);
    }
    float* dst = p.states + (size_t)((b * 64 + c) * 8 + h) * 64 * 128;
#pragma unroll
    for (int pt = 0; pt < 2; ++pt)
#pragma unroll
      for (int e = 0; e < 16; ++e) dst[(size_t)(pt * 32 + crow16(e, hl)) * 128 + 32 * wave + r] = acc[pt][e];
  }
}

__device__ __forceinline__ void ph_ssd2(const int vb, const Params& p) {
  const int idx = vb * 256 + threadIdx.x;
  const int pn = idx & 8191, h = (idx >> 13) & 7, b = idx >> 16;
  float st = 0.f;
#pragma unroll 1
  for (int c0 = 0; c0 < 64; c0 += 8) {
    float sv[8], dv[8];
#pragma unroll
    for (int i = 0; i < 8; ++i) {
      const int cc = (b * 64 + c0 + i) * 8 + h;
      sv[i] = p.states[(size_t)cc * 8192 + pn];
      dv[i] = p.cdec[cc];
    }
#pragma unroll
    for (int i = 0; i < 8; ++i) {
      const int cc = (b * 64 + c0 + i) * 8 + h;
      p.sin_b[(size_t)cc * 8192 + pn] = f2bf(st);
      st = fmaf(st, dv[i], sv[i]);
    }
  }
}

__device__ __forceinline__ void ph_ssd3(const int vb, char* smem, const Params& p) {
  const int g = vb & 1, c = (vb >> 1) & 63, b = vb >> 7;
  int tid = threadIdx.x;
  asm volatile("" : "+v"(tid));
  const int lane = tid & 63;
  const int w = __builtin_amdgcn_readfirstlane(tid >> 6);
  const int r = lane & 31, hl = lane >> 5;
  const int t0 = b * SL + c * 128;
  char* s_C = smem;
  char* s_B = smem + 34816;
  char* s_xT = smem + 34816;
  char* s_S = smem + 34816 + 16896;
  float* s_acs = (float*)(smem + 69632);
  float* s_dt = s_acs + 512;
  {
    const int ch = tid & 15, r0 = tid >> 4;
#pragma unroll
    for (int i = 0; i < 8; ++i) {
      const int row = r0 + 16 * i;
      const ushort_t* src = p.xc + (size_t)(t0 + row) * 1024 + g * 128 + ch * 8;
      *(uint4*)(s_B + swz256(row, ch)) = *(const uint4*)(src + 512);
      *(uint4*)(s_C + swz256(row, ch)) = *(const uint4*)(src + 768);
    }
    if (tid < 128) {
#pragma unroll
      for (int hh = 0; hh < 4; ++hh) {
        s_acs[hh * 128 + tid] = p.acs[(size_t)(t0 + tid) * 8 + g * 4 + hh];
        s_dt[hh * 128 + tid] = p.dt[(size_t)(t0 + tid) * 8 + g * 4 + hh];
      }
    }
  }
  __syncthreads();
  bf16x8 cfr[8];
#pragma unroll
  for (int ks = 0; ks < 8; ++ks) cfr[ks] = *(const bf16x8*)(s_C + swz256(32 * w + r, ks * 2 + hl));
  f32x16 gt[4];
#pragma unroll
  for (int st = 0; st < 4; ++st) {
#pragma unroll
    for (int e = 0; e < 16; ++e) gt[st][e] = 0.f;
    if (st <= w) {
#pragma unroll
      for (int ks = 0; ks < 8; ++ks) {
        const bf16x8 a = *(const bf16x8*)(s_B + swz256(32 * st + r, ks * 2 + hl));
        gt[st] = __builtin_amdgcn_mfma_f32_32x32x16_bf16(a, cfr[ks], gt[st], 0, 0, 0);
      }
    }
  }
  __syncthreads();
  float ssq = 0.f;
  const int lane_c = lane;
  uint4 PX0, PX1, PX2, PX3, PS0, PS1, PS2, PS3;
  {
    const int ch = tid & 15, r0 = tid >> 4;
    const size_t base = (size_t)((b * 64 + c) * 8 + g * 4) * 8192 + (size_t)r0 * 128 + ch * 8;
    PX0 = *(const uint4*)(p.xT + base); PX1 = *(const uint4*)(p.xT + base + 16 * 128);
    PX2 = *(const uint4*)(p.xT + base + 32 * 128); PX3 = *(const uint4*)(p.xT + base + 48 * 128);
    PS0 = *(const uint4*)(p.sin_b + base); PS1 = *(const uint4*)(p.sin_b + base + 16 * 128);
    PS2 = *(const uint4*)(p.sin_b + base + 32 * 128); PS3 = *(const uint4*)(p.sin_b + base + 48 * 128);
  }
#pragma unroll 1
  for (int hh = 0; hh < 4; ++hh) {
    int lane_o = lane_c;
    asm volatile("" : "+v"(lane_o));
    const int r = lane_o & 31, hl = lane_o >> 5;
    const int l = 32 * w + r;
    const int hg = g * 4 + hh;
    {
      const int ch = tid & 15, r0 = tid >> 4;
      *(uint2*)(s_xT + (r0) * 264 + ch * 16) = make_uint2(PX0.x, PX0.y); *(uint2*)(s_xT + (r0) * 264 + ch * 16 + 8) = make_uint2(PX0.z, PX0.w);
      *(uint2*)(s_xT + (r0 + 16) * 264 + ch * 16) = make_uint2(PX1.x, PX1.y); *(uint2*)(s_xT + (r0 + 16) * 264 + ch * 16 + 8) = make_uint2(PX1.z, PX1.w);
      *(uint2*)(s_xT + (r0 + 32) * 264 + ch * 16) = make_uint2(PX2.x, PX2.y); *(uint2*)(s_xT + (r0 + 32) * 264 + ch * 16 + 8) = make_uint2(PX2.z, PX2.w);
      *(uint2*)(s_xT + (r0 + 48) * 264 + ch * 16) = make_uint2(PX3.x, PX3.y); *(uint2*)(s_xT + (r0 + 48) * 264 + ch * 16 + 8) = make_uint2(PX3.z, PX3.w);
      *(uint4*)(s_S + swz256(r0, ch)) = PS0; *(uint4*)(s_S + swz256(r0 + 16, ch)) = PS1;
      *(uint4*)(s_S + swz256(r0 + 32, ch)) = PS2; *(uint4*)(s_S + swz256(r0 + 48, ch)) = PS3;
      const int hn = (hh < 3) ? hg + 1 : hg;
      const size_t base = (size_t)((b * 64 + c) * 8 + hn) * 8192 + (size_t)r0 * 128 + ch * 8;
      PX0 = *(const uint4*)(p.xT + base); PX1 = *(const uint4*)(p.xT + base + 16 * 128);
      PX2 = *(const uint4*)(p.xT + base + 32 * 128); PX3 = *(const uint4*)(p.xT + base + 48 * 128);
      PS0 = *(const uint4*)(p.sin_b + base); PS1 = *(const uint4*)(p.sin_b + base + 16 * 128);
      PS2 = *(const uint4*)(p.sin_b + base + 32 * 128); PS3 = *(const uint4*)(p.sin_b + base + 48 * 128);
    }
    __syncthreads();
    const float acs_l = s_acs[hh * 128 + l];
    const float dsk = p.ssd_d[hg];
    f32x16 acc[2];
#pragma unroll
    for (int e = 0; e < 16; ++e) { acc[0][e] = 0.f; acc[1][e] = 0.f; }
#pragma unroll
    for (int ks = 0; ks < 8; ++ks) {
      const bf16x8 a0 = *(const bf16x8*)(s_S + swz256(r, ks * 2 + hl));
      const bf16x8 a1 = *(const bf16x8*)(s_S + swz256(32 + r, ks * 2 + hl));
      acc[0] = __builtin_amdgcn_mfma_f32_32x32x16_bf16(a0, cfr[ks], acc[0], 0, 0, 0);
      acc[1] = __builtin_amdgcn_mfma_f32_32x32x16_bf16(a1, cfr[ks], acc[1], 0, 0, 0);
    }
    {
      const float el = expf(acs_l);
#pragma unroll
      for (int e = 0; e < 16; ++e) { acc[0][e] *= el; acc[1][e] *= el; }
    }
#pragma unroll
    for (int st = 0; st < 4; ++st) {
      asm volatile("" ::: "memory");
      if (st <= w) {
        float m[16];
#pragma unroll
        for (int e = 0; e < 16; ++e) {
          const int sidx = 32 * st + crow16(e, hl);
          float v = gt[st][e] * __expf(acs_l - s_acs[hh * 128 + sidx]) * s_dt[hh * 128 + sidx];
          if (sidx > l) v = 0.f;
          if (sidx == l) v += dsk;
          m[e] = v;
        }
#pragma unroll
        for (int k2 = 0; k2 < 2; ++k2) {
          asm volatile("" ::: "memory");
          bf16x8 mf;
          {
            unsigned u0 = pack2(m[8 * k2 + 0], m[8 * k2 + 1]), u1 = pack2(m[8 * k2 + 2], m[8 * k2 + 3]);
            unsigned u2 = pack2(m[8 * k2 + 4], m[8 * k2 + 5]), u3 = pack2(m[8 * k2 + 6], m[8 * k2 + 7]);
            uint4 uu = make_uint4(u0, u1, u2, u3);
            mf = *(bf16x8*)&uu;
          }
          const int soff = (32 * st + 16 * k2 + 4 * hl) * 2;
#pragma unroll
          for (int pt = 0; pt < 2; ++pt) {
            const char* ap = s_xT + (pt * 32 + r) * 264 + soff;
            uint2 q0 = *(const uint2*)(ap);
            uint2 q1 = *(const uint2*)(ap + 16);
            uint4 qq = make_uint4(q0.x, q0.y, q1.x, q1.y);
            const bf16x8 af = *(bf16x8*)&qq;
            acc[pt] = __builtin_amdgcn_mfma_f32_32x32x16_bf16(af, mf, acc[pt], 0, 0, 0);
          }
        }
      }
    }
#pragma unroll
    for (int pt = 0; pt < 2; ++pt) {
#pragma unroll
      for (int q4 = 0; q4 < 4; ++q4) {
        asm volatile("" ::: "memory");
        const int p0 = pt * 32 + 8 * q4 + 4 * hl;
        const uint2 zz = *(const uint2*)(p.zs + (size_t)(t0 + l) * 512 + hg * 64 + p0);
        const float v0 = acc[pt][4 * q4 + 0] * bflo(zz.x), v1 = acc[pt][4 * q4 + 1] * bfhi(zz.x);
        const float v2 = acc[pt][4 * q4 + 2] * bflo(zz.y), v3 = acc[pt][4 * q4 + 3] * bfhi(zz.y);
        ssq += v0 * v0 + v1 * v1 + v2 * v2 + v3 * v3;
        *(uint2*)(p.mixed_b + (size_t)(t0 + l) * 1024 + hg * 64 + p0) = make_uint2(pack2(v0, v1), pack2(v2, v3));
      }
    }
    __syncthreads();
  }
  const int l = 32 * w + r;
  ssq += __shfl_xor(ssq, 32);
  const float rstd = rsqrtf(ssq * (1.f / 256.f) + EPS);
#pragma unroll 1
  for (int hh = 0; hh < 4; ++hh) {
#pragma unroll
    for (int pt = 0; pt < 2; ++pt) {
#pragma unroll
      for (int q4 = 0; q4 < 4; ++q4) {
        asm volatile("" ::: "memory");
        const int chn = (g * 4 + hh) * 64 + pt * 32 + 8 * q4 + 4 * hl;
        ushort_t* ptr = p.mixed_b + (size_t)(t0 + l) * 1024 + chn;
        const uint2 vv = *(const uint2*)ptr;
        const float4 nw = *(const float4*)(p.ssd_norm_w + chn);
        *(uint2*)ptr = make_uint2(pack2(bflo(vv.x) * rstd * nw.x, bfhi(vv.x) * rstd * nw.y),
                                  pack2(bflo(vv.y) * rstd * nw.z, bfhi(vv.y) * rstd * nw.w));
      }
    }
  }
}

__device__ __forceinline__ void k_gate(const int VB, char* smem, const Params& p) {
  const int own = VB & 31, bh = VB >> 5;
  if (own == 0) return;
  const int b = bh >> 2, h = bh & 3;
  const int tid = threadIdx.x;
  float* s_km = (float*)smem;
  int* s_cnt = (int*)(smem + 8192);
  int* s_base = s_cnt + 32;
  for (int i = tid; i < own * 64; i += 256) {
    const int n = i >> 6, d = i & 63;
    const float* kp = p.kpart + (size_t)(bh * 32 + n) * 256 + d;
    s_km[i] = (kp[0] + kp[64]) + (kp[128] + kp[192]);
  }
  if (tid < 32) s_cnt[tid] = 0;
  __syncthreads();
  const int l = own * 256 + tid;
  const int t = b * SL + l;
  float q[64];
  {
    const ushort_t* src = p.mq + (size_t)t * 256 + h * 64;
#pragma unroll
    for (int d = 0; d < 64; d += 8) {
      uint4 v = *(const uint4*)(src + d);
      q[d] = bflo(v.x); q[d + 1] = bfhi(v.x); q[d + 2] = bflo(v.y); q[d + 3] = bfhi(v.y);
      q[d + 4] = bflo(v.z); q[d + 5] = bfhi(v.z); q[d + 6] = bflo(v.w); q[d + 7] = bfhi(v.w);
    }
  }
  float v0 = -INFINITY, v1 = -INFINITY, v2 = -INFINITY;
  int i0 = 0, i1 = 1, i2 = 2;
  for (int n = 0; n < own; ++n) {
    const float* km = s_km + n * 64;
    float sa = 0.f, sb = 0.f;
#pragma unroll
    for (int d = 0; d < 64; d += 8) {
      const float4 a = *(const float4*)(km + d), c = *(const float4*)(km + d + 4);
      sa = fmaf(q[d], a.x, sa); sa = fmaf(q[d + 1], a.y, sa); sa = fmaf(q[d + 2], a.z, sa); sa = fmaf(q[d + 3], a.w, sa);
      sb = fmaf(q[d + 4], c.x, sb); sb = fmaf(q[d + 5], c.y, sb); sb = fmaf(q[d + 6], c.z, sb); sb = fmaf(q[d + 7], c.w, sb);
    }
    const float sv = sa + sb;
    if (sv > v0) { v2 = v1; i2 = i1; v1 = v0; i1 = i0; v0 = sv; i0 = n; }
    else if (sv > v1) { v2 = v1; i2 = i1; v1 = sv; i1 = n; }
    else if (sv > v2) { v2 = sv; i2 = n; }
  }
  const int nsel = own < 3 ? own : 3;
  int lp0 = 0, lp1 = 0, lp2 = 0;
  if (0 < nsel) lp0 = atomicAdd(s_cnt + i0, 1);
  if (1 < nsel) lp1 = atomicAdd(s_cnt + i1, 1);
  if (2 < nsel) lp2 = atomicAdd(s_cnt + i2, 1);
  __syncthreads();
  if (tid < own) s_base[tid] = s_cnt[tid] ? atomicAdd(p.bcnt + bh * 32 + tid, s_cnt[tid]) : 0;
  __syncthreads();
  if (0 < nsel) p.blist[(size_t)(bh * 32 + i0) * 8192 + s_base[i0] + lp0] = l | (0 << 13);
  if (1 < nsel) p.blist[(size_t)(bh * 32 + i1) * 8192 + s_base[i1] + lp1] = l | (1 << 13);
  if (2 < nsel) p.blist[(size_t)(bh * 32 + i2) * 8192 + s_base[i2] + lp2] = l | (2 << 13);
}

struct UnitDesc { const ushort_t* Kp; const ushort_t* VTp; int vstride; int kind; int a0; int a1; };
__device__ __forceinline__ UnitDesc unit_desc(const int u, const int Ug, const int* s_pref, const Params& p) {
  UnitDesc d;
  if (u >= Ug + NB * 4 * 32 * 2) {
    const int v = u - Ug - NB * 4 * 32 * 2;
    d.kind = 2; d.a0 = v >> 6; d.a1 = v & 63;
    const int bh = d.a0, b = bh >> 2, h = bh & 3;
    d.Kp = p.memk_b + (size_t)b * MEM * 256 + h * 64;
    d.VTp = p.memvT + (size_t)bh * 64 * MEM;
    d.vstride = MEM;
  } else {
    if (u < Ug) {
      int lo = 0, hi = 255;
      while (lo < hi) { const int mid = (lo + hi) >> 1; if (s_pref[mid] > u) hi = mid; else lo = mid + 1; }
      const int prev = lo ? s_pref[lo - 1] : 0;
      d.kind = 0; d.a0 = lo; d.a1 = u - prev;
    } else {
      const int v = u - Ug;
      d.kind = 1; d.a0 = v >> 1; d.a1 = v & 1;
    }
    const int bh = d.a0 >> 5, jblk = d.a0 & 31, b = bh >> 2, h = bh & 3;
    d.Kp = p.mk + (size_t)(b * SL + jblk * 256) * 256 + h * 64;
    d.VTp = p.vT + (size_t)bh * 64 * SL + jblk * 256;
    d.vstride = SL;
  }
  return d;
}

#define AU_LOAD(P, D, ST) { \
    const ushort_t* kp_ = (D).Kp + (size_t)((ST) * 128 + kr) * 256 + kc * 8; \
    P##k0 = *(const uint4*)(kp_); P##k1 = *(const uint4*)(kp_ + 32 * 256); P##k2 = *(const uint4*)(kp_ + 64 * 256); P##k3 = *(const uint4*)(kp_ + 96 * 256); \
    const ushort_t* vp_ = (D).VTp + (size_t)vr * (D).vstride + (ST) * 128 + vc * 8; \
    P##v0 = *(const uint4*)(vp_); P##v1 = *(const uint4*)(vp_ + (size_t)16 * (D).vstride); \
    P##v2 = *(const uint4*)(vp_ + (size_t)32 * (D).vstride); P##v3 = *(const uint4*)(vp_ + (size_t)48 * (D).vstride); }
#define AU_STORE(P, BUF) { \
    char* sk_ = (BUF) + kr * 144 + kc * 16; \
    *(uint4*)(sk_) = P##k0; *(uint4*)(sk_ + 32 * 144) = P##k1; *(uint4*)(sk_ + 64 * 144) = P##k2; *(uint4*)(sk_ + 96 * 144) = P##k3; \
    char* sv_ = (BUF) + 18432 + vr * 264 + vc * 16; \
    *(uint2*)(sv_) = make_uint2(P##v0.x, P##v0.y); *(uint2*)(sv_ + 8) = make_uint2(P##v0.z, P##v0.w); \
    *(uint2*)(sv_ + 16 * 264) = make_uint2(P##v1.x, P##v1.y); *(uint2*)(sv_ + 16 * 264 + 8) = make_uint2(P##v1.z, P##v1.w); \
    *(uint2*)(sv_ + 32 * 264) = make_uint2(P##v2.x, P##v2.y); *(uint2*)(sv_ + 32 * 264 + 8) = make_uint2(P##v2.z, P##v2.w); \
    *(uint2*)(sv_ + 48 * 264) = make_uint2(P##v3.x, P##v3.y); *(uint2*)(sv_ + 48 * 264 + 8) = make_uint2(P##v3.z, P##v3.w); }

__device__ __forceinline__ void attn_stage(const char* buf, const int st, const bf16x8 (&qf)[4], const float slope, const int qrel, const bool causal,
                                           const int r, const int hl, f32x16 (&o)[2], float& m, float& lsum) {
  const char* s_K = buf;
  const char* s_VT = buf + 18432;
  f32x16 sc[4];
#pragma unroll
  for (int kt = 0; kt < 4; ++kt) {
#pragma unroll
    for (int e = 0; e < 16; ++e) sc[kt][e] = 0.f;
#pragma unroll
    for (int ks = 0; ks < 4; ++ks) {
      const bf16x8 a = *(const bf16x8*)(s_K + (32 * kt + r) * 144 + (2 * ks + hl) * 16);
      sc[kt] = __builtin_amdgcn_mfma_f32_32x32x16_bf16(a, qf[ks], sc[kt], 0, 0, 0);
    }
  }
  float mx = -1e30f;
  const int qk0 = qrel - st * 128 - 4 * hl;
  const float slope2 = slope;
  const float bb = -slope2 * (float)qk0;
#pragma unroll
  for (int kt = 0; kt < 4; ++kt) {
#pragma unroll
    for (int e = 0; e < 16; ++e) {
      const int ce = 32 * kt + (e & 3) + 8 * (e >> 2);
      float v = fmaf(sc[kt][e], 0.18033688011112042f, fmaf(slope2, (float)ce, bb));
      if (causal && ce > qk0) v = -1e30f;
      sc[kt][e] = v;
      mx = fmaxf(mx, v);
    }
  }
  mx = fmaxf(mx, __shfl_xor(mx, 32));
  const float mnew = fmaxf(m, mx);
  const float alpha = __builtin_amdgcn_exp2f(m - mnew);
  m = mnew;
  lsum *= alpha;
#pragma unroll
  for (int e = 0; e < 16; ++e) { o[0][e] *= alpha; o[1][e] *= alpha; }
#pragma unroll
  for (int kt = 0; kt < 4; ++kt) {
#pragma unroll
    for (int e = 0; e < 16; ++e) {
      const float pe = __builtin_amdgcn_exp2f(sc[kt][e] - mnew);
      sc[kt][e] = pe;
      lsum += pe;
    }
  }
#pragma unroll
  for (int kt = 0; kt < 4; ++kt) {
#pragma unroll
    for (int k2 = 0; k2 < 2; ++k2) {
      uint4 pu = make_uint4(pack2(sc[kt][8 * k2 + 0], sc[kt][8 * k2 + 1]), pack2(sc[kt][8 * k2 + 2], sc[kt][8 * k2 + 3]),
                            pack2(sc[kt][8 * k2 + 4], sc[kt][8 * k2 + 5]), pack2(sc[kt][8 * k2 + 6], sc[kt][8 * k2 + 7]));
      const bf16x8 pf = *(bf16x8*)&pu;
      const int koff = (32 * kt + 16 * k2 + 4 * hl) * 2;
#pragma unroll
      for (int dt = 0; dt < 2; ++dt) {
        const char* ap = s_VT + (dt * 32 + r) * 264 + koff;
        const uint2 q0 = *(const uint2*)(ap);
        const uint2 q1 = *(const uint2*)(ap + 16);
        uint4 qq = make_uint4(q0.x, q0.y, q1.x, q1.y);
        const bf16x8 af = *(bf16x8*)&qq;
        o[dt] = __builtin_amdgcn_mfma_f32_32x32x16_bf16(af, pf, o[dt], 0, 0, 0);
      }
    }
  }
}

__device__ __forceinline__ void ph_attn_units(char* smem, const Params& p, const int Ug, const int* s_pref) {
  const int Utot = Ug + NB * 4 * 32 * 2 + NB * 4 * 64;
  int u = blockIdx.x;
  if (u >= Utot) return;
  int tid = threadIdx.x;
  asm volatile("" : "+v"(tid));
  const int lane = tid & 63, wave = tid >> 6, r = lane & 31, hl = lane >> 5;
  const int kr = tid >> 3, kc = tid & 7, vr = tid >> 4, vc = tid & 15;
  char* buf0 = smem;
  char* buf1 = smem + 35328;
  uint4 Ak0, Ak1, Ak2, Ak3, Av0, Av1, Av2, Av3, Bk0, Bk1, Bk2, Bk3, Bv0, Bv1, Bv2, Bv3;
  UnitDesc D = unit_desc(u, Ug, s_pref, p);
  AU_LOAD(A, D, 0)
  AU_LOAD(B, D, 1)
#pragma unroll 1
  for (; u < Utot; u += gridDim.x) {
    const int un = (u + (int)gridDim.x < Utot) ? u + (int)gridDim.x : u;
    const UnitDesc Dn = unit_desc(un, Ug, s_pref, p);
    int bh, l = 0, slot = 3, jblk = 0;
    bool valid = true, causal = false;
    const ushort_t* qrow;
    float slope = 0.f;
    int qrel = 1 << 20;
    int t;
    if (D.kind == 2) {
      bh = D.a0;
      t = (bh >> 2) * SL + D.a1 * 128 + wave * 32 + r;
      qrow = p.xq + (size_t)t * 256 + (bh & 3) * 64;
    } else {
      bh = D.a0 >> 5; jblk = D.a0 & 31;
      if (D.kind == 0) {
        const int cnt = p.bcnt[D.a0];
        int qi = D.a1 * 128 + wave * 32 + r;
        if (qi >= cnt) { valid = false; qi = 0; }
        const int ent = p.blist[(size_t)D.a0 * 8192 + qi];
        l = ent & 8191; slot = ent >> 13;
      } else {
        l = jblk * 256 + D.a1 * 128 + wave * 32 + r; slot = 3; causal = true;
      }
      t = (bh >> 2) * SL + l;
      qrow = p.mq + (size_t)t * 256 + (bh & 3) * 64;
      slope = exp2f(-2.f * (float)((bh & 3) + 1)) * 1.4426950408889634f;
      qrel = l - jblk * 256;
    }
    bf16x8 qf[4];
#pragma unroll
    for (int ks = 0; ks < 4; ++ks) qf[ks] = *(const bf16x8*)(qrow + ks * 16 + hl * 8);
    f32x16 o[2];
#pragma unroll
    for (int e = 0; e < 16; ++e) { o[0][e] = 0.f; o[1][e] = 0.f; }
    float m = -1e30f, lsum = 0.f;
    AU_STORE(A, buf0)
    AU_LOAD(A, Dn, 0)
    __syncthreads();
    attn_stage(buf0, 0, qf, slope, qrel, causal, r, hl, o, m, lsum);
    AU_STORE(B, buf1)
    AU_LOAD(B, Dn, 1)
    __syncthreads();
    attn_stage(buf1, 1, qf, slope, qrel, causal, r, hl, o, m, lsum);
    const float lt = lsum + __shfl_xor(lsum, 32);
    const float inv = 1.f / lt;
    const int h = bh & 3;
    if (D.kind == 2) {
#pragma unroll
      for (int dt = 0; dt < 2; ++dt)
#pragma unroll
        for (int q4 = 0; q4 < 4; ++q4) {
          const int d = dt * 32 + 8 * q4 + 4 * hl;
          *(uint2*)(p.mixed_b + (size_t)t * DM + 768 + h * 64 + d) =
              make_uint2(pack2(o[dt][4 * q4] * inv, o[dt][4 * q4 + 1] * inv), pack2(o[dt][4 * q4 + 2] * inv, o[dt][4 * q4 + 3] * inv));
        }
    } else if (valid) {
      const size_t pi = ((size_t)t * 4 + h) * 4 + slot;
#pragma unroll
      for (int dt = 0; dt < 2; ++dt)
#pragma unroll
        for (int q4 = 0; q4 < 4; ++q4) {
          const int d = dt * 32 + 8 * q4 + 4 * hl;
          *(uint2*)(p.pO + pi * 64 + d) =
              make_uint2(pack2(o[dt][4 * q4] * inv, o[dt][4 * q4 + 1] * inv), pack2(o[dt][4 * q4 + 2] * inv, o[dt][4 * q4 + 3] * inv));
        }
      if (hl == 0) { p.pm[pi] = m; p.pl[pi] = lt; }
    }
    D = Dn;
  }
}

__device__ __forceinline__ void ph_attn_combine(const int VB, const Params& p) {
  const int i = VB * 256 + threadIdx.x;
  const int dq = i & 7, th = i >> 3;
  const int t = th >> 2;
  const int own = (t & (SL - 1)) >> 8;
  const int nsel = own < 3 ? own : 3;
  float mv[4], wv[4];
  float M = p.pm[(size_t)th * 4 + 3];
  mv[3] = M;
#pragma unroll
  for (int sl = 0; sl < 3; ++sl) {
    mv[sl] = (sl < nsel) ? p.pm[(size_t)th * 4 + sl] : -1e30f;
    M = fmaxf(M, mv[sl]);
  }
  float W = 0.f;
#pragma unroll
  for (int sl = 0; sl < 4; ++sl) {
    const bool on = (sl == 3) || (sl < nsel);
    wv[sl] = on ? p.pl[(size_t)th * 4 + sl] * __builtin_amdgcn_exp2f(mv[sl] - M) : 0.f;
    W += wv[sl];
  }
  float acc[8];
#pragma unroll
  for (int k = 0; k < 8; ++k) acc[k] = 0.f;
#pragma unroll
  for (int sl = 0; sl < 4; ++sl) {
    const bool on = (sl == 3) || (sl < nsel);
    if (on) {
      float f[8];
      unpack8(*(const uint4*)(p.pO + ((size_t)th * 4 + sl) * 64 + dq * 8), f);
#pragma unroll
      for (int k = 0; k < 8; ++k) acc[k] = fmaf(wv[sl], f[k], acc[k]);
    }
  }
  const float inv = 1.f / W;
  const int h = th & 3;
  *(uint4*)(p.mixed_b + (size_t)t * DM + 512 + h * 64 + dq * 8) =
      make_uint4(pack2(acc[0] * inv, acc[1] * inv), pack2(acc[2] * inv, acc[3] * inv), pack2(acc[4] * inv, acc[5] * inv), pack2(acc[6] * inv, acc[7] * inv));
}


__device__ __forceinline__ int mkkey(const float f, const int idx, const int mask) {
  int b = __float_as_int(f);
  b = (b & ~mask) | idx;
  return b ^ ((b >> 31) & 0x7fffffff);
}
__device__ __forceinline__ int key2bits(const int k) { return k ^ ((k >> 31) & 0x7fffffff); }
#define CEI(a, b) { const int _mx = max(a, b), _mn = min(a, b); a = _mx; b = _mn; }
template <int N>
__device__ __forceinline__ void bitonic_sort_desc(int (&v)[N]) {
#pragma unroll
  for (int k = 2; k <= N; k <<= 1) {
#pragma unroll
    for (int j = k >> 1; j > 0; j >>= 1) {
#pragma unroll
      for (int i = 0; i < N; ++i) {
        const int l = i ^ j;
        if (l > i) {
          if ((i & k) == 0) { CEI(v[i], v[l]); } else { CEI(v[l], v[i]); }
        }
      }
    }
  }
}
__device__ __forceinline__ void merge16(int (&a)[16], const int (&b)[16]) {
#pragma unroll
  for (int i = 0; i < 16; ++i) a[i] = max(a[i], b[15 - i]);
#pragma unroll
  for (int j = 8; j > 0; j >>= 1) {
#pragma unroll
    for (int i = 0; i < 16; ++i) {
      const int l = i ^ j;
      if (l > i) { CEI(a[i], a[l]); }
    }
  }
}
__device__ __forceinline__ void merge_partner(int (&a)[16], const int xmask) {
  int o[16];
#pragma unroll
  for (int i = 0; i < 16; ++i) o[i] = __shfl_xor(a[i], xmask);
  merge16(a, o);
}
__device__ __forceinline__ bf16x8 pack_hi8(const float (&x)[8], float (&res)[8]) {
  unsigned u[4];
#pragma unroll
  for (int i = 0; i < 4; ++i) {
    const ushort_t h0 = f2bf(x[2 * i]), h1 = f2bf(x[2 * i + 1]);
    res[2 * i] = x[2 * i] - bf2f(h0);
    res[2 * i + 1] = x[2 * i + 1] - bf2f(h1);
    u[i] = (unsigned)h0 | ((unsigned)h1 << 16);
  }
  uint4 uu = make_uint4(u[0], u[1], u[2], u[3]);
  return *(bf16x8*)&uu;
}
__device__ __forceinline__ bf16x8 pack_8(const float (&x)[8]) {
  uint4 uu = make_uint4(pack2(x[0], x[1]), pack2(x[2], x[3]), pack2(x[4], x[5]), pack2(x[6], x[7]));
  return *(bf16x8*)&uu;
}

__device__ __forceinline__ void ph_gemm_route(const int vb, char* smem, const Params& p, const ushort_t* __restrict__ hn_b) {
  const int head = vb & 7, tt = vb >> 3;
  const int m0 = head * 128, n0 = tt * 128;
  f32x16 acc[2][2];
  gemm_core(p.w_qT, hn_b, DM, m0, n0, smem, acc);
  int tid = threadIdx.x;
  asm volatile("" : "+v"(tid));
  const int lane = tid & 63, r = lane & 31, hl = lane >> 5;
  const int wave = tid >> 6, wm = wave >> 1, wn = wave & 1;
  int* s_top = (int*)(smem + 34816);
  float rstd_tok[2];
#pragma unroll
  for (int ni = 0; ni < 2; ++ni) {
    const float4* hp = (const float4*)(p.hss + (size_t)(n0 + wn * 64 + ni * 32 + r) * 16);
    const float4 a = hp[0], b = hp[1], c = hp[2], d = hp[3];
    const float tot = ((a.x + a.y) + (a.z + a.w)) + ((b.x + b.y) + (b.z + b.w)) + ((c.x + c.y) + (c.z + c.w)) + ((d.x + d.y) + (d.z + d.w));
    rstd_tok[ni] = rsqrtf(tot * (1.f / DM) + EPS);
  }
  {
    const int row = tid >> 1, part = tid & 1;
#pragma unroll
    for (int hf = 0; hf < 2; ++hf) {
      const ushort_t* src = p.skh + (size_t)(hf * 128 + row) * 64 + part * 32;
      char* dst = smem + (hf * 128 + row) * 136 + part * 64;
#pragma unroll
      for (int c = 0; c < 4; ++c) {
        const uint4 v = *(const uint4*)(src + c * 8);
        *(uint2*)(dst + c * 16) = make_uint2(v.x, v.y);
        *(uint2*)(dst + c * 16 + 8) = make_uint2(v.z, v.w);
      }
    }
  }
  __syncthreads();
  const char* s_keys = smem + wm * 128 * 136;
#pragma unroll
  for (int ni = 0; ni < 2; ++ni) {
    asm volatile("" ::: "memory");
    bf16x8 qh[4], ql[4];
#pragma unroll
    for (int mi = 0; mi < 2; ++mi) {
#pragma unroll
      for (int k2 = 0; k2 < 2; ++k2) {
        float x[8], res[8];
#pragma unroll
        for (int j = 0; j < 8; ++j) x[j] = acc[mi][ni][8 * k2 + j] * rstd_tok[ni];
        qh[mi * 2 + k2] = pack_hi8(x, res);
        ql[mi * 2 + k2] = pack_8(res);
      }
    }
    int g0[16];
#pragma unroll
    for (int kh2 = 0; kh2 < 2; ++kh2) {
      int ga[16], gb[16];
#pragma unroll
      for (int kq = 0; kq < 2; ++kq) {
        const int kt = kh2 * 2 + kq;
        asm volatile("" ::: "memory");
        f32x16 sc;
#pragma unroll
        for (int e = 0; e < 16; ++e) sc[e] = 0.f;
#pragma unroll
        for (int st = 0; st < 4; ++st) {
          const int d0 = (st >> 1) * 32 + 16 * (st & 1) + 4 * hl;
          const char* kp = s_keys + (kt * 32 + r) * 136 + d0 * 2;
          const uint2 h0 = *(const uint2*)(kp), h1 = *(const uint2*)(kp + 16);
          uint4 hq = make_uint4(h0.x, h0.y, h1.x, h1.y);
          const bf16x8 ah = *(bf16x8*)&hq;
          sc = __builtin_amdgcn_mfma_f32_32x32x16_bf16(ah, qh[st], sc, 0, 0, 0);
          sc = __builtin_amdgcn_mfma_f32_32x32x16_bf16(ah, ql[st], sc, 0, 0, 0);
        }
        if (kq == 0) {
#pragma unroll
          for (int e = 0; e < 16; ++e) ga[e] = mkkey(sc[e], kt * 32 + (e & 3) + 8 * (e >> 2) + 4 * hl, 127);
          bitonic_sort_desc<16>(ga);
        } else {
#pragma unroll
          for (int e = 0; e < 16; ++e) gb[e] = mkkey(sc[e], kt * 32 + (e & 3) + 8 * (e >> 2) + 4 * hl, 127);
          bitonic_sort_desc<16>(gb);
        }
      }
      merge16(ga, gb);
      if (kh2 == 0) {
#pragma unroll
        for (int i = 0; i < 16; ++i) g0[i] = ga[i];
      } else {
        merge16(g0, ga);
      }
    }
    merge_partner(g0, 32);
    {
      int* dst = s_top + ((size_t)wm * 128 + wn * 64 + ni * 32 + r) * 16 + hl * 8;
      int4 w0, w1;
      int lo8[8], hi8[8];
#pragma unroll
      for (int i = 0; i < 8; ++i) { lo8[i] = g0[i]; hi8[i] = g0[8 + i]; asm volatile("" : "+v"(lo8[i]), "+v"(hi8[i])); }
      w0 = make_int4(hl ? hi8[0] : lo8[0], hl ? hi8[1] : lo8[1], hl ? hi8[2] : lo8[2], hl ? hi8[3] : lo8[3]);
      w1 = make_int4(hl ? hi8[4] : lo8[4], hl ? hi8[5] : lo8[5], hl ? hi8[6] : lo8[6], hl ? hi8[7] : lo8[7]);
      *(int4*)dst = w0; *(int4*)(dst + 4) = w1;
    }
  }
  __syncthreads();
  {
    const int tok = tid >> 1, sub = tid & 1;
    int k1[16], k2[16];
    {
      const int4* a = (const int4*)(s_top + (size_t)tok * 16);
      const int4* b = (const int4*)(s_top + (size_t)(128 + tok) * 16);
#pragma unroll
      for (int i = 0; i < 4; ++i) {
        const int4 x = a[i], y = b[i];
        k1[4 * i] = x.x; k1[4 * i + 1] = x.y; k1[4 * i + 2] = x.z; k1[4 * i + 3] = x.w;
        k2[4 * i] = y.x; k2[4 * i + 1] = y.y; k2[4 * i + 2] = y.z; k2[4 * i + 3] = y.w;
      }
    }
    float v1f[16], v2f[16];
#pragma unroll
    for (int i = 0; i < 16; ++i) { v1f[i] = __int_as_float(key2bits(k1[i])); v2f[i] = __int_as_float(key2bits(k2[i])); }
    int c[32];
    c[0] = sub ? mkkey(v1f[3] + v2f[3], 51, 255) : mkkey(v1f[0] + v2f[0], 0, 255);
    c[1] = sub ? mkkey(v1f[4] + v2f[0], 64, 255) : mkkey(v1f[0] + v2f[1], 1, 255);
    c[2] = sub ? mkkey(v1f[4] + v2f[1], 65, 255) : mkkey(v1f[0] + v2f[2], 2, 255);
    c[3] = sub ? mkkey(v1f[4] + v2f[2], 66, 255) : mkkey(v1f[0] + v2f[3], 3, 255);
    c[4] = sub ? mkkey(v1f[5] + v2f[0], 80, 255) : mkkey(v1f[0] + v2f[4], 4, 255);
    c[5] = sub ? mkkey(v1f[5] + v2f[1], 81, 255) : mkkey(v1f[0] + v2f[5], 5, 255);
    c[6] = sub ? mkkey(v1f[6] + v2f[0], 96, 255) : mkkey(v1f[0] + v2f[6], 6, 255);
    c[7] = sub ? mkkey(v1f[6] + v2f[1], 97, 255) : mkkey(v1f[0] + v2f[7], 7, 255);
    c[8] = sub ? mkkey(v1f[7] + v2f[0], 112, 255) : mkkey(v1f[0] + v2f[8], 8, 255);
    c[9] = sub ? mkkey(v1f[7] + v2f[1], 113, 255) : mkkey(v1f[0] + v2f[9], 9, 255);
    c[10] = sub ? mkkey(v1f[8] + v2f[0], 128, 255) : mkkey(v1f[0] + v2f[10], 10, 255);
    c[11] = sub ? mkkey(v1f[9] + v2f[0], 144, 255) : mkkey(v1f[0] + v2f[11], 11, 255);
    c[12] = sub ? mkkey(v1f[10] + v2f[0], 160, 255) : mkkey(v1f[0] + v2f[12], 12, 255);
    c[13] = sub ? mkkey(v1f[11] + v2f[0], 176, 255) : mkkey(v1f[0] + v2f[13], 13, 255);
    c[14] = sub ? mkkey(v1f[12] + v2f[0], 192, 255) : mkkey(v1f[0] + v2f[14], 14, 255);
    c[15] = sub ? mkkey(v1f[13] + v2f[0], 208, 255) : mkkey(v1f[0] + v2f[15], 15, 255);
    c[16] = sub ? mkkey(v1f[14] + v2f[0], 224, 255) : mkkey(v1f[1] + v2f[0], 16, 255);
    c[17] = sub ? mkkey(v1f[15] + v2f[0], 240, 255) : mkkey(v1f[1] + v2f[1], 17, 255);
    c[18] = sub ? (int)0x80000000 : mkkey(v1f[1] + v2f[2], 18, 255);
    c[19] = sub ? (int)0x80000000 : mkkey(v1f[1] + v2f[3], 19, 255);
    c[20] = sub ? (int)0x80000000 : mkkey(v1f[1] + v2f[4], 20, 255);
    c[21] = sub ? (int)0x80000000 : mkkey(v1f[1] + v2f[5], 21, 255);
    c[22] = sub ? (int)0x80000000 : mkkey(v1f[1] + v2f[6], 22, 255);
    c[23] = sub ? (int)0x80000000 : mkkey(v1f[1] + v2f[7], 23, 255);
    c[24] = sub ? (int)0x80000000 : mkkey(v1f[2] + v2f[0], 32, 255);
    c[25] = sub ? (int)0x80000000 : mkkey(v1f[2] + v2f[1], 33, 255);
    c[26] = sub ? (int)0x80000000 : mkkey(v1f[2] + v2f[2], 34, 255);
    c[27] = sub ? (int)0x80000000 : mkkey(v1f[2] + v2f[3], 35, 255);
    c[28] = sub ? (int)0x80000000 : mkkey(v1f[2] + v2f[4], 36, 255);
    c[29] = sub ? (int)0x80000000 : mkkey(v1f[3] + v2f[0], 48, 255);
    c[30] = sub ? (int)0x80000000 : mkkey(v1f[3] + v2f[1], 49, 255);
    c[31] = sub ? (int)0x80000000 : mkkey(v1f[3] + v2f[2], 50, 255);
    int h0[16], h1[16];
#pragma unroll
    for (int i = 0; i < 16; ++i) { h0[i] = c[i]; h1[i] = c[16 + i]; }
    bitonic_sort_desc<16>(h0); bitonic_sort_desc<16>(h1);
    merge16(h0, h1);
    merge_partner(h0, 1);
    float sv[16];
#pragma unroll
    for (int i = 0; i < 16; ++i) sv[i] = __int_as_float(key2bits(h0[i]));
    float den = 0.f;
#pragma unroll
    for (int i = 0; i < 16; ++i) den += __expf(sv[i] - sv[0]);
    const float inv = 1.f / den;
    int eo[8]; float go[8];
#pragma unroll
    for (int i = 0; i < 8; ++i) {
      int klo = h0[i], khi = h0[8 + i];
      asm volatile("" : "+v"(klo), "+v"(khi));
      const int kk = sub ? khi : klo;
      const int bits = key2bits(kk);
      const int code = bits & 255;
      const int ia = key2bits(s_top[(size_t)tok * 16 + (code >> 4)]) & 127;
      const int ib = key2bits(s_top[(size_t)(128 + tok) * 16 + (code & 15)]) & 127;
      eo[i] = ia * 128 + ib;
      go[i] = __expf(__int_as_float(bits) - sv[0]) * inv;
    }
    const size_t ob = ((size_t)(n0 + tok) * 8 + head) * 16 + sub * 8;
    *(int4*)(p.eidx + ob) = make_int4(eo[0], eo[1], eo[2], eo[3]);
    *(int4*)(p.eidx + ob + 4) = make_int4(eo[4], eo[5], eo[6], eo[7]);
    *(float4*)(p.egate + ob) = make_float4(go[0], go[1], go[2], go[3]);
    *(float4*)(p.egate + ob + 4) = make_float4(go[4], go[5], go[6], go[7]);
  }
}

__device__ __forceinline__ void ph_subkeys(const Params& p) {
  for (int i = blockIdx.x * 256 + threadIdx.x; i < 2 * 128 * 64; i += gridDim.x * 256) {
    const float v = (i < 8192) ? p.sk1[i] : p.sk2[i - 8192];
    const ushort_t hi = f2bf(v);
    p.skh[i] = hi;
    p.skl[i] = f2bf(v - bf2f(hi));
  }
}

__device__ __forceinline__ float dot16_fp8(const uint4 d, const float (&x)[16], float c) {
  const unsigned w[4] = {d.x, d.y, d.z, d.w};
#pragma unroll
  for (int i = 0; i < 4; ++i) {
    const f32x2_t lo = __builtin_amdgcn_cvt_pk_f32_fp8((int)w[i], false);
    const f32x2_t hi = __builtin_amdgcn_cvt_pk_f32_fp8((int)w[i], true);
    c = fmaf(lo.x, x[4 * i], c); c = fmaf(lo.y, x[4 * i + 1], c); c = fmaf(hi.x, x[4 * i + 2], c); c = fmaf(hi.y, x[4 * i + 3], c);
  }
  return c;
}
__device__ __forceinline__ void axpy16_fp8(const float cf, const uint4 u, float (&acc)[16]) {
  const unsigned w[4] = {u.x, u.y, u.z, u.w};
#pragma unroll
  for (int i = 0; i < 4; ++i) {
    const f32x2_t lo = __builtin_amdgcn_cvt_pk_f32_fp8((int)w[i], false);
    const f32x2_t hi = __builtin_amdgcn_cvt_pk_f32_fp8((int)w[i], true);
    acc[4 * i] = fmaf(cf, lo.x, acc[4 * i]); acc[4 * i + 1] = fmaf(cf, lo.y, acc[4 * i + 1]);
    acc[4 * i + 2] = fmaf(cf, hi.x, acc[4 * i + 2]); acc[4 * i + 3] = fmaf(cf, hi.y, acc[4 * i + 3]);
  }
}
constexpr int EX_NTOK = 4;
__device__ __forceinline__ void peer_chunk(const Params& p, const int lane, const int myex, const bool b5, const bool b4, const bool b3,
                                           const int (&ce)[8], const float (&cg)[8], const f32x2_t (&x2)[8], f32x2_t (&acc2)[8]) {
  drow_t d[8];
  urow_t u[8];
  float sd[8], su[8];
#pragma unroll
  for (int i = 0; i < 8; ++i) d[i] = *(const drow_t*)(p.ed8 + ((size_t)ce[i] * 64 + lane) * DROW_BYTES);
#pragma unroll
  for (int i = 0; i < 8; ++i) u[i] = *(const urow_t*)(p.eu8 + ((size_t)ce[i] * 64 + lane) * UROW_BYTES);
#pragma unroll
  for (int i = 0; i < 8; ++i) { sd[i] = p.ed_s[ce[i]]; su[i] = p.eu_s[ce[i]] * cg[i]; }
  float pr[8];
#pragma unroll
  for (int i = 0; i < 8; ++i) {
    f32x2_t dd[8];
    DEC_D(d[i], dd);
    f32x2_t a2 = {0.f, 0.f};
#pragma unroll
    for (int k = 0; k < 8; ++k) a2 = dd[k] * x2[k] + a2;
    pr[i] = (a2.x + a2.y) * sd[i];
  }
  float q4[4];
#pragma unroll
  for (int i = 0; i < 4; ++i) {
    const float snd = b5 ? pr[i] : pr[i + 4];
    const float kp = b5 ? pr[i + 4] : pr[i];
    q4[i] = kp + __shfl_xor(snd, 32);
  }
  float q2[2];
#pragma unroll
  for (int i = 0; i < 2; ++i) {
    const float snd = b4 ? q4[i] : q4[i + 2];
    const float kp = b4 ? q4[i + 2] : q4[i];
    q2[i] = kp + __shfl_xor(snd, 16);
  }
  float q1;
  {
    const float snd = b3 ? q2[0] : q2[1];
    const float kp = b3 ? q2[1] : q2[0];
    q1 = kp + __shfl_xor(snd, 8);
  }
  q1 += __shfl_xor(q1, 4);
  q1 += __shfl_xor(q1, 2);
  q1 += __shfl_xor(q1, 1);
  const float act = gelu_f(q1);
#pragma unroll
  for (int i = 0; i < 8; ++i) {
    const int src = ((i >> 2) & 1) * 32 + ((i >> 1) & 1) * 16 + (i & 1) * 8;
    const float cf = __int_as_float(__builtin_amdgcn_readlane(__float_as_int(act), src)) * su[i];
    const f32x2_t cf2 = {cf, cf};
    f32x2_t uu[8];
    DEC_U(u[i], uu);
#pragma unroll
    for (int k = 0; k < 8; ++k) acc2[k] = cf2 * uu[k] + acc2[k];
  }
}

#ifndef EX_SWEEP
#define EX_SWEEP 0
#endif
#if !EX_SWEEP
typedef __attribute__((ext_vector_type(8))) int v8i_t;
typedef __attribute__((ext_vector_type(4))) float f32x4_t;
__device__ __forceinline__ void sort128(int& v0, int& v1, const int lane) {
#pragma unroll
  for (int k = 2; k <= 128; k <<= 1) {
#pragma unroll
    for (int j = k >> 1; j > 0; j >>= 1) {
      if (j == 1) {
        const bool up = ((lane * 2) & k) == 0;
        const int mn = min(v0, v1), mx = max(v0, v1);
        v0 = up ? mn : mx;
        v1 = up ? mx : mn;
      } else {
        const int o0 = __shfl_xor(v0, j >> 1), o1 = __shfl_xor(v1, j >> 1);
        const bool up = ((lane * 2) & k) == 0;
        const bool lower = ((lane * 2) & j) == 0;
        const bool takemin = (up == lower);
        v0 = takemin ? min(v0, o0) : max(v0, o0);
        v1 = takemin ? min(v1, o1) : max(v1, o1);
      }
    }
  }
}
__device__ __forceinline__ void k_peer_experts(const int VB, char* smem, const Params& p, const ushort_t* __restrict__ hn) {
  const int lane = threadIdx.x & 63;
  const int wave = __builtin_amdgcn_readfirstlane(threadIdx.x >> 6);
  const int t = VB * 4 + wave;
  const int li = lane & 15, g = lane >> 4;
  char* sx = smem + wave * 1024;
  {
    const float* hrow = p.out + (size_t)t * DM + lane * 16;
    const float* wrow = p.ffn_norm_w + lane * 16;
    float4 hv[4], wv[4];
#pragma unroll
    for (int i = 0; i < 4; ++i) { hv[i] = *(const float4*)(hrow + i * 4); wv[i] = *(const float4*)(wrow + i * 4); }
    float ss = 0.f;
#pragma unroll
    for (int i = 0; i < 4; ++i) ss += hv[i].x * hv[i].x + hv[i].y * hv[i].y + hv[i].z * hv[i].z + hv[i].w * hv[i].w;
    ss = wave_sum(ss);
    const float rs = rsqrtf(ss * (1.f / DM) + EPS) * 16.f;
    int wq[4];
#pragma unroll
    for (int i = 0; i < 4; ++i) {
      int w = 0;
      w = __builtin_amdgcn_cvt_pk_fp8_f32(hv[i].x * rs * wv[i].x, hv[i].y * rs * wv[i].y, w, false);
      w = __builtin_amdgcn_cvt_pk_fp8_f32(hv[i].z * rs * wv[i].z, hv[i].w * rs * wv[i].w, w, true);
      wq[i] = w;
    }
    *(int4*)(sx + lane * 16) = make_int4(wq[0], wq[1], wq[2], wq[3]);
  }
  v8i_t xb[8];
#pragma unroll
  for (int st = 0; st < 8; ++st) {
    const int4 lo = *(const int4*)(sx + st * 128 + g * 16);
    const int4 hi = *(const int4*)(sx + st * 128 + 64 + g * 16);
    xb[st] = v8i_t{lo.x, lo.y, lo.z, lo.w, hi.x, hi.y, hi.z, hi.w};
  }
  f32x2_t acc2[8];
#pragma unroll
  for (int i = 0; i < 8; ++i) acc2[i] = f32x2_t{0.f, 0.f};
  int kq0, kq1;
  {
    const int2 ev = *(const int2*)(p.eidx + (size_t)t * 128 + lane * 2);
    kq0 = (ev.x << 7) | (lane * 2);
    kq1 = (ev.y << 7) | (lane * 2 + 1);
    sort128(kq0, kq1, lane);
  }
  const int ev0 = kq0 >> 7, ev1 = kq1 >> 7;
  const float sdv0 = p.ed_s[ev0], sdv1 = p.ed_s[ev1];
  const float suv0 = p.eu_s[ev0] * p.egate[(size_t)t * 128 + (kq0 & 127)], suv1 = p.eu_s[ev1] * p.egate[(size_t)t * 128 + (kq1 & 127)];
#pragma unroll 1
  for (int c = 0; c < 8; ++c) {
    const int lbase = c * 8;
    const int ea = __shfl(ev0, lbase + (li >> 1)), eb = __shfl(ev1, lbase + (li >> 1));
    const int e_lane = (li & 1) ? eb : ea;
    const unsigned char* arow = p.ed8 + (size_t)e_lane * 512 + g * 16;
    uint4 a[8];
#pragma unroll
    for (int st = 0; st < 8; ++st) a[st] = *(const uint4*)(arow + st * 64);
    urow_t u[16];
#pragma unroll
    for (int i = 0; i < 16; ++i) {
      const int ei_s = __builtin_amdgcn_readlane((i & 1) ? ev1 : ev0, lbase + (i >> 1));
      u[i] = *(const urow_t*)(p.eu8 + ((size_t)ei_s * 64 + lane) * UROW_BYTES);
    }
    const int mrow = 4 * g + (li & 3);
    const float sda = __shfl(sdv0, lbase + (mrow >> 1)), sdb = __shfl(sdv1, lbase + (mrow >> 1));
    const float sua = __shfl(suv0, lbase + (mrow >> 1)), sub = __shfl(suv1, lbase + (mrow >> 1));
    const float sd_m = (mrow & 1) ? sdb : sda, su_m = (mrow & 1) ? sub : sua;
    f32x4_t d4 = {0.f, 0.f, 0.f, 0.f};
#pragma unroll
    for (int st = 0; st < 8; ++st) {
      const v8i_t av = v8i_t{(int)a[st].x, (int)a[st].y, (int)a[st].z, (int)a[st].w, 0, 0, 0, 0};
      d4 = __builtin_amdgcn_mfma_scale_f32_16x16x128_f8f6f4(av, xb[st], d4, 4, 0, 0, 0x7f7f7f7f, 0, 0x7f7f7f7f);
    }
    const int rsel = li & 3;
    const float dsel = rsel == 0 ? d4[0] : rsel == 1 ? d4[1] : rsel == 2 ? d4[2] : d4[3];
    const float cvs = gelu_fast(dsel * sd_m * 0.0625f) * su_m;
#pragma unroll
    for (int i = 0; i < 16; ++i) {
      const float cf = __int_as_float(__builtin_amdgcn_readlane(__float_as_int(cvs), 16 * (i >> 2) + (i & 3)));
      const f32x2_t cf2 = {cf, cf};
      f32x2_t uu[8];
      DEC_U(u[i], uu);
#pragma unroll
      for (int k = 0; k < 8; ++k) acc2[k] = cf2 * uu[k] + acc2[k];
    }
  }
  float* orow = p.out + (size_t)t * DM + lane * 16;
#pragma unroll
  for (int i = 0; i < 4; ++i) {
    float4 hv = *(float4*)(orow + i * 4);
    hv.x += acc2[2 * i].x; hv.y += acc2[2 * i].y; hv.z += acc2[2 * i + 1].x; hv.w += acc2[2 * i + 1].y;
    *(float4*)(orow + i * 4) = hv;
  }
}
#define EX_TOK_PER_VB 4
#else
#define EX_TOK_PER_VB (4 * EX_NTOK)
__device__ __forceinline__ void k_peer_experts(const int VB, const Params& p, const ushort_t* __restrict__ hn) {
  const int lane = threadIdx.x & 63;
  const int wave = __builtin_amdgcn_readfirstlane(threadIdx.x >> 6);
  const int t0 = (VB * 4 + wave) * EX_NTOK;
  const int myex = ((lane >> 5) & 1) * 4 + ((lane >> 4) & 1) * 2 + ((lane >> 3) & 1);
  const bool b5 = (lane & 32) != 0, b4 = (lane & 16) != 0, b3 = (lane & 8) != 0;
  f32x2_t x2[EX_NTOK][8], acc2[EX_NTOK][8];
  int e0[EX_NTOK], e1[EX_NTOK];
  float g0[EX_NTOK], g1[EX_NTOK];
#pragma unroll
  for (int k = 0; k < EX_NTOK; ++k) {
    float f0[8], f1[8];
    unpack8(*(const uint4*)(hn + (size_t)(t0 + k) * DM + lane * 16), f0);
    unpack8(*(const uint4*)(hn + (size_t)(t0 + k) * DM + lane * 16 + 8), f1);
#pragma unroll
    for (int i = 0; i < 4; ++i) {
      x2[k][i] = f32x2_t{f0[2 * i], f0[2 * i + 1]};
      x2[k][4 + i] = f32x2_t{f1[2 * i], f1[2 * i + 1]};
    }
#pragma unroll
    for (int i = 0; i < 8; ++i) acc2[k][i] = f32x2_t{0.f, 0.f};
    e0[k] = p.eidx[(size_t)(t0 + k) * 128 + lane];
    e1[k] = p.eidx[(size_t)(t0 + k) * 128 + 64 + lane];
    g0[k] = p.egate[(size_t)(t0 + k) * 128 + lane];
    g1[k] = p.egate[(size_t)(t0 + k) * 128 + 64 + lane];
  }
#pragma unroll 1
  for (int s = 0; s < 16; ++s) {
#pragma unroll
    for (int k = 0; k < EX_NTOK; ++k) {
      unsigned long long m0 = __ballot((e0[k] >> 10) == s);
      unsigned long long m1 = __ballot((e1[k] >> 10) == s);
      while ((m0 | m1) != 0ull) {
        int ce[8];
        float cg[8];
#pragma unroll
        for (int i = 0; i < 8; ++i) {
          int ev = 0;
          float gv = 0.f;
          if (m0 != 0ull) {
            const int ln = __builtin_ctzll(m0);
            m0 &= m0 - 1ull;
            ev = __builtin_amdgcn_readlane(e0[k], ln);
            gv = __int_as_float(__builtin_amdgcn_readlane(__float_as_int(g0[k]), ln));
          } else if (m1 != 0ull) {
            const int ln = __builtin_ctzll(m1);
            m1 &= m1 - 1ull;
            ev = __builtin_amdgcn_readlane(e1[k], ln);
            gv = __int_as_float(__builtin_amdgcn_readlane(__float_as_int(g1[k]), ln));
          }
          ce[i] = ev;
          cg[i] = gv;
        }
        peer_chunk(p, lane, myex, b5, b4, b3, ce, cg, x2[k], acc2[k]);
      }
    }
  }
#pragma unroll
  for (int k = 0; k < EX_NTOK; ++k) {
    float* orow = p.out + (size_t)(t0 + k) * DM + lane * 16;
#pragma unroll
    for (int i = 0; i < 4; ++i) {
      float4 hv = *(float4*)(orow + i * 4);
      hv.x += acc2[k][2 * i].x; hv.y += acc2[k][2 * i].y; hv.z += acc2[k][2 * i + 1].x; hv.w += acc2[k][2 * i + 1].y;
      *(float4*)(orow + i * 4) = hv;
    }
  }
}

#endif

#define PHASE(NBLK, CALL) \
  for (int VB = blockIdx.x; VB < (NBLK); VB += gridDim.x) { CALL; __syncthreads(); }
#define PHASE_NS(NBLK, CALL) \
  for (int VB = blockIdx.x; VB < (NBLK); VB += gridDim.x) { CALL; }
#define PHASE_OFF(OFF, NBLK, CALL) \
  for (int VB = (int)((blockIdx.x + gridDim.x - ((OFF) % gridDim.x)) % gridDim.x); VB < (NBLK); VB += gridDim.x) { CALL; __syncthreads(); }

__global__ __launch_bounds__(256, 2) void fwd_megakernel(Params p) {
  __shared__ __attribute__((aligned(16))) char smem_raw[SMEM_BYTES];
  float* smem = (float*)smem_raw;
  volatile LAS unsigned* xb_st = (volatile LAS unsigned*)(smem_raw + 73728);
  if (threadIdx.x == 0) { xb_st[0] = 0u; xb_st[1] = 0u; xb_st[2] = 0u; xb_st[3] = 0u; }
  __syncthreads();
  const XcdBarrier xb = xcd_barrier_post(p.bar, xb_st);
  {
    for (int k = threadIdx.x; k < DM; k += 256) {
      const float* wr = p.w_in + (size_t)k * INC + 1536;
      const float4 a = *(const float4*)(wr), b = *(const float4*)(wr + 4);
      smem[0 * 1024 + k] = a.x; smem[1 * 1024 + k] = a.y; smem[2 * 1024 + k] = a.z; smem[3 * 1024 + k] = a.w;
      smem[4 * 1024 + k] = b.x; smem[5 * 1024 + k] = b.y; smem[6 * 1024 + k] = b.z; smem[7 * 1024 + k] = b.w;
    }
    __syncthreads();
    PHASE_NS(NT / 8, ph_rmsnorm_bf16(VB, p.x, p.mix_norm_w, p.xn_b, smem, p.dt_bias, p.dt));
    __syncthreads();
  }
  PHASE_NS(NB * MEM / 8, ph_rmsnorm_bf16(VB, p.mem, p.mem_norm_w, p.memn_b, nullptr, nullptr, nullptr));
  PHASE(16 * 40, ph_wtrans(VB, smem, p.w_in, INC, p.w_inT, 40, 8, nullptr));
  PHASE(16 * 16, ph_wtrans(VB, smem, p.w_out, DM, p.w_outT, 16, 0, nullptr));
  PHASE(16 * 16, ph_wtrans(VB, smem, p.w_query, DM, p.w_qT, 16, 0, p.ffn_norm_w));
  PHASE(16 * 8, ph_wtrans(VB, smem, p.w_mem_kv, 512, p.w_memT, 8, 0, nullptr));
  if (blockIdx.x == 0) p.bcnt[threadIdx.x] = 0;
  ph_subkeys(p);
  xcd_barrier(xb);
  PHASE_NS(NB * 64 * 8 / 4, ph_acs(VB, p));
  PHASE(20 * (NT / 128), ph_gemm_proj(VB, smem_raw, p));
  xcd_barrier(xb);
  PHASE(NB * 64 * 8, ph_ssd1(VB, smem_raw, p));
  PHASE(NB * 4 * 32, k_gate(VB, smem_raw, p));
  PHASE_OFF(256, 4 * (NB * MEM / 128), ph_gemm_mem(VB, smem_raw, p));
  xcd_barrier(xb);
  PHASE_NS(NB * 8 * 64 * 128 / 256, ph_ssd2(VB, p));
  {
    int* s_pref = (int*)(smem_raw + 72192);
    {
      const int tid = threadIdx.x;
      int v = (p.bcnt[tid] + 127) >> 7;
      const int lane = tid & 63;
#pragma unroll
      for (int o = 1; o < 64; o <<= 1) { int nb = __shfl_up(v, o); if (lane >= o) v += nb; }
      int* s_wt = s_pref + 256;
      if (lane == 63) s_wt[tid >> 6] = v;
      __syncthreads();
      int add = 0;
      for (int ww = 0; ww < (tid >> 6); ++ww) add += s_wt[ww];
      s_pref[tid] = v + add;
      __syncthreads();
    }
    const int Ug = s_pref[255];
    ph_attn_units(smem_raw, p, Ug, s_pref);
    __syncthreads();
  }
  xcd_barrier(xb);
  PHASE(NB * 64 * 2, ph_ssd3(VB, smem_raw, p));
  if (gridDim.x >= 512) {
    for (int VB = (int)blockIdx.x - 256; VB >= 0 && VB < NT * 4 * 8 / 256; VB += gridDim.x - 256) ph_attn_combine(VB, p);
  } else {
    PHASE_NS(NT * 4 * 8 / 256, ph_attn_combine(VB, p));
  }
  xcd_barrier(xb);
  PHASE(8 * (NT / 128), ph_gemm_f32(VB, smem_raw, p.mixed_b, p.w_outT, p.out, p.x, p.xn_b, p.hss));
  xcd_barrier(xb);
  ushort_t* hn_b = p.xn_b;
  {
    int cv = blockIdx.x;
    for (int VB = blockIdx.x; VB < 8 * (NT / 128); VB += gridDim.x) {
      ph_gemm_route(VB, smem_raw, p, hn_b);
      __syncthreads();
      for (int i = 0; i < 8 && cv < 8192; ++i, cv += gridDim.x) {
        if (cv < 4096) {
#if EX_FP4_DOWN
          ph_cvt4(cv, p.e_down, p.ed8, p.ed_s);
#else
          ph_cvt8(cv, p.e_down, p.ed8, p.ed_s);
#endif
        } else {
#if EX_FP4_UP
          ph_cvt4(cv - 4096, p.e_up, p.eu8, p.eu_s);
#else
          ph_cvt8(cv - 4096, p.e_up, p.eu8, p.eu_s);
#endif
        }
      }
    }
    for (; cv < 8192; cv += gridDim.x) {
      if (cv < 4096) {
#if EX_FP4_DOWN
        ph_cvt4(cv, p.e_down, p.ed8, p.ed_s);
#else
        ph_cvt8(cv, p.e_down, p.ed8, p.ed_s);
#endif
      } else {
#if EX_FP4_UP
        ph_cvt4(cv - 4096, p.e_up, p.eu8, p.eu_s);
#else
        ph_cvt8(cv - 4096, p.e_up, p.eu8, p.eu_s);
#endif
      }
    }
  }
  xcd_barrier(xb);
  PHASE_NS(NT / EX_TOK_PER_VB, k_peer_experts(VB, smem_raw, p, hn_b));
}
}

extern "C" void kernel_launch(void* const* d_in, const int* in_sizes, int n_in, void* d_out, int out_size, void* d_ws, size_t ws_size,
                              hipStream_t stream) {
  Params p{};
  p.x = (const float*)d_in[0]; p.mem = (const float*)d_in[1]; p.mix_norm_w = (const float*)d_in[2]; p.w_in = (const float*)d_in[3];
  p.conv_w = (const float*)d_in[4]; p.conv_b = (const float*)d_in[5]; p.dt_bias = (const float*)d_in[6]; p.a_log = (const float*)d_in[7];
  p.ssd_d = (const float*)d_in[8]; p.ssd_norm_w = (const float*)d_in[9]; p.mq_norm_w = (const float*)d_in[10]; p.mk_norm_w = (const float*)d_in[11];
  p.mem_norm_w = (const float*)d_in[12]; p.w_mem_kv = (const float*)d_in[13]; p.xq_norm_w = (const float*)d_in[14]; p.xk_norm_w = (const float*)d_in[15];
  p.w_out = (const float*)d_in[16]; p.ffn_norm_w = (const float*)d_in[17]; p.w_query = (const float*)d_in[18]; p.sk1 = (const float*)d_in[19];
  p.sk2 = (const float*)d_in[20]; p.e_down = (const float*)d_in[21]; p.e_up = (const float*)d_in[22];
  p.out = (float*)d_out;
  char* ws = (char*)d_ws;
  size_t o = 0;
  auto take = [&](size_t bytes) { char* q = ws + o; o += (bytes + 255) & ~(size_t)255; return q; };
  p.xn_b = (ushort_t*)take((size_t)NT * DM * 2);
  p.xc = p.xn_b;
  p.w_inT = (ushort_t*)take((size_t)NPROJ * DM * 2);
  p.w_outT = (ushort_t*)take((size_t)DM * DM * 2);
  p.w_qT = (ushort_t*)take((size_t)DM * DM * 2);
  p.w_memT = (ushort_t*)take((size_t)512 * DM * 2);
  p.memn_b = (ushort_t*)take((size_t)NB * MEM * DM * 2);
  p.memk_b = (ushort_t*)take((size_t)NB * MEM * 256 * 2);
  p.memvT = (ushort_t*)take((size_t)NB * MEM * 256 * 2);
  char* regQ = take((size_t)NT * 2560 * 2);
  p.zs = (ushort_t*)regQ;
  p.xbc_raw = (ushort_t*)(regQ + (size_t)NT * 512 * 2);
  p.mq = (ushort_t*)(regQ + (size_t)NT * 1536 * 2);
  p.mk = (ushort_t*)(regQ + (size_t)NT * 1792 * 2);
  p.vT = (ushort_t*)(regQ + (size_t)NT * 2048 * 2);
  p.xq = (ushort_t*)(regQ + (size_t)NT * 2304 * 2);
  p.q = (float*)regQ;
  p.dt = (float*)take((size_t)NT * 8 * 4);
  p.acs = (float*)take((size_t)NT * 8 * 4);
  p.wdec = (float*)take((size_t)NT * 8 * 4);
  p.cdec = (float*)take((size_t)NB * 64 * 8 * 4);
  p.states = (float*)d_out;
  p.sin_b = (ushort_t*)((char*)d_out + (size_t)NB * 64 * 8 * 8192 * 4);
  p.xT = (ushort_t*)((char*)d_out + (size_t)NB * 64 * 8 * 8192 * 6);
  p.mixed_b = (ushort_t*)take((size_t)NT * DM * 2);
  p.kpart = (float*)take((size_t)NB * 4 * 32 * 4 * 64 * 4);
  p.bcnt = (int*)take(256 * 4);
  p.blist = (int*)take((size_t)256 * 8192 * 4);
  p.pm = (float*)take((size_t)NT * 16 * 4);
  p.pl = (float*)take((size_t)NT * 16 * 4);
  p.pO = p.xbc_raw;
  p.eidx = (int*)take((size_t)NT * 128 * 4);
  p.egate = (float*)take((size_t)NT * 128 * 4);
  p.ed8 = (unsigned char*)take((size_t)16384 * DM);
  p.eu8 = (unsigned char*)take((size_t)16384 * DM);
  p.ed_s = (float*)take(16384 * 4);
  p.eu_s = (float*)take(16384 * 4);
  p.bar = (unsigned*)take(XCD_BAR_WORDS * 4);
  p.hss = (float*)take((size_t)NT * 16 * 4);
  p.skh = (ushort_t*)take(2 * 128 * 64 * 2);
  p.skl = (ushort_t*)take(2 * 128 * 64 * 2);
  if (o > ws_size) return;
  (void)hipMemsetAsync(p.bar, 0, XCD_BAR_WORDS * 4, stream);
  static int grid_blocks = 0;
  if (!grid_blocks) {
    int dev = 0, cus = 0, per_cu = 0;
    (void)hipGetDevice(&dev);
    (void)hipDeviceGetAttribute(&cus, hipDeviceAttributeMultiprocessorCount, dev);
    (void)hipOccupancyMaxActiveBlocksPerMultiprocessor(&per_cu, fwd_megakernel, 256, 0);
    if (per_cu > 2) per_cu = 2;
    if (per_cu < 1) per_cu = 1;
    grid_blocks = cus * per_cu;
  }
  void* args[] = {&p};
  hipError_t e = hipLaunchCooperativeKernel((void*)fwd_megakernel, dim3(grid_blocks), dim3(256), args, 0, stream);
  if (e != hipSuccess) fprintf(stderr, "cooperative launch failed: %s (grid %d)\n", hipGetErrorString(e), grid_blocks);
}
```

```cpp
#include <hip/hip_runtime.h>
#include <hip/hip_cooperative_groups.h>
#include <cstdio>
#include <math.h>
#include <stdint.h>
namespace cg = cooperative_groups;

#ifndef EX_FP4_DOWN
#define EX_FP4_DOWN 1
#endif
#ifndef EX_FP4_UP
#define EX_FP4_UP 1
#endif
namespace {
typedef unsigned short ushort_t;
typedef __attribute__((ext_vector_type(8))) short bf16x8;
typedef __attribute__((ext_vector_type(16))) float f32x16;

constexpr int DM = 1024;
constexpr int NB = 2;
constexpr int SL = 8192;
constexpr int NT = NB * SL;
constexpr int MEM = 256;
constexpr int INC = 2568;
constexpr int NPROJ = 2560;
constexpr float EPS = 1e-6f;
constexpr int SMEM_BYTES = 73728 + 256;

typedef __attribute__((ext_vector_type(4))) float f32x4_nt;
__device__ __forceinline__ float4 ld_nt4(const float* ptr) {
  const f32x4_nt v = __builtin_nontemporal_load((const f32x4_nt*)ptr);
  return make_float4(v.x, v.y, v.z, v.w);
}
__device__ __forceinline__ float silu_f(float x) { return x * __frcp_rn(1.f + __expf(-x)); }
__device__ __forceinline__ float softplus_f(float x) { return fmaxf(x, 0.f) + log1pf(expf(-fabsf(x))); }
__device__ __forceinline__ float gelu_f(float x) { return 0.5f * x * (1.f + erff(x * 0.70710678118654752f)); }
__device__ __forceinline__ float gelu_fast(float x) {
  const float z = fabsf(x) * 0.70710678118654752f;
  const float t = __frcp_rn(fmaf(0.3275911f, z, 1.f));
  float pl = fmaf(1.061405429f, t, -1.453152027f);
  pl = fmaf(pl, t, 1.421413741f);
  pl = fmaf(pl, t, -0.284496736f);
  pl = fmaf(pl, t, 0.254829592f);
  const float er = 1.f - pl * t * __expf(-z * z);
  return 0.5f * x * (1.f + copysignf(er, x));
}
typedef __attribute__((ext_vector_type(2))) __bf16 bf16x2_hw;
typedef __attribute__((ext_vector_type(2))) float f32x2_hw;
__device__ __forceinline__ unsigned pack2(float a, float b) {
  const f32x2_hw v = {a, b};
  return __builtin_bit_cast(unsigned, __builtin_convertvector(v, bf16x2_hw));
}
__device__ __forceinline__ ushort_t f2bf(float x) { return (ushort_t)(pack2(x, 0.f) & 0xffffu); }
__device__ __forceinline__ float bf2f(ushort_t h) { return __uint_as_float(((unsigned)h) << 16); }
__device__ __forceinline__ float bflo(unsigned w) { return __uint_as_float(w << 16); }
__device__ __forceinline__ float bfhi(unsigned w) { return __uint_as_float(w & 0xffff0000u); }

__device__ __forceinline__ void unpack8(const uint4 v, float (&f)[8]) {
  f[0] = bflo(v.x); f[1] = bfhi(v.x); f[2] = bflo(v.y); f[3] = bfhi(v.y);
  f[4] = bflo(v.z); f[5] = bfhi(v.z); f[6] = bflo(v.w); f[7] = bfhi(v.w);
}

__device__ __forceinline__ float wave_sum(float v) {
#pragma unroll
  for (int o = 32; o > 0; o >>= 1) v += __shfl_xor(v, o);
  return v;
}
__device__ __forceinline__ float wave_max(float v) {
#pragma unroll
  for (int o = 32; o > 0; o >>= 1) v = fmaxf(v, __shfl_xor(v, o));
  return v;
}


#define XB_TMO      128
#define XB_XCNT(j)  (256  + 64 * (j))
#define XB_XSUB(j)  (1280 + 64 * (j))
#define XB_XGEN(j)  (2304 + 64 * (j))
#define XB_TOP      3328
#define XB_TOPGEN   3392
#define XCD_BAR_WORDS 3456
#define XB_SPIN_CAP (1u << 20)
#define LAS __attribute__((address_space(3)))
__device__ __forceinline__ unsigned xb_ld(unsigned* p)              { return __hip_atomic_load(p, __ATOMIC_RELAXED, __HIP_MEMORY_SCOPE_AGENT); }
__device__ __forceinline__ unsigned xb_add(unsigned* p, unsigned v) { return __hip_atomic_fetch_add(p, v, __ATOMIC_RELAXED, __HIP_MEMORY_SCOPE_AGENT); }
__device__ __forceinline__ unsigned xb_xcc_id() { return (unsigned)__builtin_amdgcn_s_getreg((3 << 11) | 20) & 0xFu; }
#define XB_SPIN(cond, bar) do { unsigned _sp = 0; while (cond) { __builtin_amdgcn_s_sleep(1); \
    if ((++_sp & 255u) == 0u) { if (xb_ld(&(bar)[XB_TMO])) break; if (_sp > XB_SPIN_CAP) { atomicAdd(&(bar)[XB_TMO], 1u); break; } } } } while (0)
struct XcdBarrier { unsigned* bar; unsigned x; volatile LAS unsigned* st; };
__device__ __forceinline__ XcdBarrier xcd_barrier_post(unsigned* bar, volatile LAS unsigned* st) {
  XcdBarrier b; b.bar = bar; b.x = xb_xcc_id(); b.st = st;
  if (threadIdx.x == 0) (void)xb_add(&bar[XB_XCNT(b.x)], 1u);
  return b;
}
__device__ __forceinline__ void xcd_barrier_complete(unsigned* bar, unsigned x, unsigned& nloc, unsigned& nx) {
  const unsigned G = gridDim.x * gridDim.y * gridDim.z;
  unsigned sum, cnt, mine, sp = 0u;
  for (;;) {
    sum = 0u; cnt = 0u; mine = 0u;
#pragma unroll
    for (unsigned j = 0; j < 16; ++j) { const unsigned c = xb_ld(&bar[XB_XCNT(j)]); sum += c; cnt += (c > 0u) ? 1u : 0u; mine = (j == x) ? c : mine; }
    if (sum == G) break;
    __builtin_amdgcn_s_sleep(1);
    if ((++sp & 255u) == 0u) { if (xb_ld(&bar[XB_TMO])) break; if (sp > XB_SPIN_CAP) { atomicAdd(&bar[XB_TMO], 1u); break; } }
  }
  nloc = mine > 0u ? mine : 1u; nx = cnt > 0u ? cnt : 1u;
}
__device__ __forceinline__ void xcd_barrier(const XcdBarrier& b) {
  asm volatile("s_waitcnt vmcnt(0)" ::: "memory");
  __syncthreads();
  if (threadIdx.x == 0) {
    unsigned* bar = b.bar;
    __builtin_amdgcn_s_waitcnt(0);
    unsigned nloc = b.st[0], nx = b.st[1];
    if (nloc == 0u) { xcd_barrier_complete(bar, b.x, nloc, nx); b.st[0] = nloc; b.st[1] = nx; }
    const unsigned old = xb_add(&bar[XB_XSUB(b.x)], 1u);
    const unsigned gen = old / nloc;
    if (old + 1u == (gen + 1u) * nloc) {
      __builtin_amdgcn_fence(__ATOMIC_RELEASE, "agent");
      asm volatile("s_waitcnt vmcnt(0)" ::: "memory");
      const unsigned og = xb_add(&bar[XB_TOP], 1u);
      const unsigned tg = og / nx;
      if (og + 1u == (tg + 1u) * nx) xb_add(&bar[XB_TOPGEN], 1u);
      else XB_SPIN(xb_ld(&bar[XB_TOPGEN]) == tg, bar);
      __builtin_amdgcn_fence(__ATOMIC_ACQUIRE, "agent");
      xb_add(&bar[XB_XGEN(b.x)], 1u);
      asm volatile("s_waitcnt vmcnt(0)" ::: "memory");
    } else {
      XB_SPIN(xb_ld(&bar[XB_XGEN(b.x)]) == gen, bar);
      __builtin_amdgcn_fence(__ATOMIC_ACQUIRE, "agent");
      asm volatile("s_waitcnt vmcnt(0)" ::: "memory");
    }
  }
  __syncthreads();
}

struct Params {
  const float *x, *mem, *mix_norm_w, *w_in, *conv_w, *conv_b, *dt_bias, *a_log, *ssd_d, *ssd_norm_w, *mq_norm_w, *mk_norm_w,
      *mem_norm_w, *w_mem_kv, *xq_norm_w, *xk_norm_w, *w_out, *ffn_norm_w, *w_query, *sk1, *sk2, *e_down, *e_up;
  float* out;
  ushort_t *xn_b, *w_inT, *w_outT, *w_qT, *w_memT, *memn_b, *zs, *xbc_raw, *mq, *mk, *xq, *memk_b, *mixed_b;
  float *dt, *q, *egate, *acs, *cdec, *states, *wdec;
  ushort_t *xc, *xT, *sin_b;
  int *eidx, *bcnt, *blist;
  unsigned* bar;
  float* hss;
  ushort_t *skh, *skl;
  unsigned char *ed8, *eu8;
  float *ed_s, *eu_s;
  float *kpart, *pm, *pl;
  ushort_t *vT, *memvT, *pO;
};

__device__ __forceinline__ void ph_rmsnorm_bf16(const int vb, const float* __restrict__ x, const float* __restrict__ w,
                                                ushort_t* __restrict__ outb, const float* s_wdt  , const float* __restrict__ dt_bias,
                                                float* __restrict__ dt) {
  const int lane = threadIdx.x & 63;
  const int row0 = vb * 8 + (threadIdx.x >> 6) * 2;
  float4 v[2][4];
#pragma unroll
  for (int rr = 0; rr < 2; ++rr)
#pragma unroll
    for (int i = 0; i < 4; ++i) v[rr][i] = ld_nt4(x + (size_t)(row0 + rr) * DM + i * 256 + lane * 4);
  float4 ww[4];
#pragma unroll
  for (int i = 0; i < 4; ++i) ww[i] = *(const float4*)(w + i * 256 + lane * 4);
#pragma unroll
  for (int rr = 0; rr < 2; ++rr) {
    const int row = row0 + rr;
    float ss = 0.f;
#pragma unroll
    for (int i = 0; i < 4; ++i) ss += v[rr][i].x * v[rr][i].x + v[rr][i].y * v[rr][i].y + v[rr][i].z * v[rr][i].z + v[rr][i].w * v[rr][i].w;
    ss = wave_sum(ss);
    const float r = rsqrtf(ss / DM + EPS);
    float part[8];
#pragma unroll
    for (int hh = 0; hh < 8; ++hh) part[hh] = 0.f;
#pragma unroll
    for (int i = 0; i < 4; ++i) {
      const float o0 = v[rr][i].x * r * ww[i].x, o1 = v[rr][i].y * r * ww[i].y, o2 = v[rr][i].z * r * ww[i].z, o3 = v[rr][i].w * r * ww[i].w;
      *(uint2*)(outb + (size_t)row * DM + i * 256 + lane * 4) = make_uint2(pack2(o0, o1), pack2(o2, o3));
      if (dt) {
        const float xs[4] = {o0, o1, o2, o3};
#pragma unroll
        for (int hh = 0; hh < 8; ++hh) {
          const float4 wv = *(const float4*)(s_wdt + hh * 1024 + i * 256 + lane * 4);
          part[hh] = fmaf(xs[0], wv.x, part[hh]); part[hh] = fmaf(xs[1], wv.y, part[hh]);
          part[hh] = fmaf(xs[2], wv.z, part[hh]); part[hh] = fmaf(xs[3], wv.w, part[hh]);
        }
      }
    }
    if (dt) {
      float mine = 0.f;
#pragma unroll
      for (int hh = 0; hh < 8; ++hh) {
        const float sfull = wave_sum(part[hh]);
        if (lane == hh) mine = sfull;
      }
      if (lane < 8) dt[(size_t)row * 8 + lane] = softplus_f(mine + dt_bias[lane]);
    }
  }
}

__device__ __forceinline__ void ph_wtrans(const int vb, float* smem, const float* __restrict__ W, const int ldw, ushort_t* __restrict__ Wt,
                                          const int ntiles, const int skip, const float* __restrict__ rowscale) {
  float (*s)[65] = (float (*)[65])smem;
  const int tid = threadIdx.x;
  const int kt = vb / ntiles, nt = vb % ntiles;
  const int nd0 = nt * 64;
  const int ns0 = (nd0 < 1536) ? nd0 : nd0 + skip;
  {
    const int k = tid >> 2, nc = (tid & 3) * 16;
    const float* src = W + (size_t)(kt * 64 + k) * ldw + ns0 + nc;
    const float rsc = rowscale ? rowscale[kt * 64 + k] : 1.f;
#pragma unroll
    for (int j = 0; j < 4; ++j) {
      float4 v = *(const float4*)(src + j * 4);
      v.x *= rsc; v.y *= rsc; v.z *= rsc; v.w *= rsc;
      s[k][nc + j * 4 + 0] = v.x; s[k][nc + j * 4 + 1] = v.y; s[k][nc + j * 4 + 2] = v.z; s[k][nc + j * 4 + 3] = v.w;
    }
  }
  __syncthreads();
  {
    const int n = tid >> 2, kc = (tid & 3) * 16;
    unsigned pk[8];
#pragma unroll
    for (int j = 0; j < 8; ++j) pk[j] = pack2(s[kc + 2 * j][n], s[kc + 2 * j + 1][n]);
    ushort_t* dst = Wt + (size_t)(nd0 + n) * DM + kt * 64 + kc;
    *(uint4*)(dst) = make_uint4(pk[0], pk[1], pk[2], pk[3]);
    *(uint4*)(dst + 8) = make_uint4(pk[4], pk[5], pk[6], pk[7]);
  }
}

__device__ __forceinline__ void ph_cvt(const int vb, const float* __restrict__ src, ushort_t* __restrict__ dst) {
  const size_t base = (size_t)vb * 8192 + threadIdx.x * 8;
  float4 a[4], b[4];
#pragma unroll
  for (int i = 0; i < 4; ++i) {
    a[i] = *(const float4*)(src + base + i * 2048);
    b[i] = *(const float4*)(src + base + i * 2048 + 4);
  }
#pragma unroll
  for (int i = 0; i < 4; ++i)
    *(uint4*)(dst + base + i * 2048) = make_uint4(pack2(a[i].x, a[i].y), pack2(a[i].z, a[i].w), pack2(b[i].x, b[i].y), pack2(b[i].z, b[i].w));
}


typedef __attribute__((ext_vector_type(2))) float f32x2_t;
__device__ __forceinline__ void ph_cvt8(const int vb, const float* __restrict__ src, unsigned char* __restrict__ dst, float* __restrict__ inv_scale) {
  const int lane = threadIdx.x & 63;
  const int row = vb * 4 + (threadIdx.x >> 6);
  const float* sr = src + (size_t)row * DM + lane * 16;
  float4 v[4];
#pragma unroll
  for (int i = 0; i < 4; ++i) v[i] = ld_nt4(sr + i * 4);
  float am = 0.f;
#pragma unroll
  for (int i = 0; i < 4; ++i) am = fmaxf(fmaxf(fmaxf(am, fabsf(v[i].x)), fmaxf(fabsf(v[i].y), fabsf(v[i].z))), fabsf(v[i].w));
  am = wave_max(am);
  const float sc = (am > 0.f) ? 224.f / am : 1.f;
  unsigned w[4];
#pragma unroll
  for (int i = 0; i < 4; ++i) {
    int t = 0;
    t = __builtin_amdgcn_cvt_pk_fp8_f32(v[i].x * sc, v[i].y * sc, t, false);
    t = __builtin_amdgcn_cvt_pk_fp8_f32(v[i].z * sc, v[i].w * sc, t, true);
    w[i] = (unsigned)t;
  }
  *(uint4*)(dst + (size_t)row * DM + lane * 16) = make_uint4(w[0], w[1], w[2], w[3]);
  if (lane == 0) inv_scale[row] = (am > 0.f) ? am * (1.f / 224.f) : 1.f;
}

__device__ __forceinline__ void ph_cvt4(const int vb, const float* __restrict__ src, unsigned char* __restrict__ dst, float* __restrict__ inv_scale) {
  const int lane = threadIdx.x & 63;
  const int row = vb * 4 + (threadIdx.x >> 6);
  const float* sr = src + (size_t)row * DM + lane * 16;
  float4 v[4];
#pragma unroll
  for (int i = 0; i < 4; ++i) v[i] = ld_nt4(sr + i * 4);
  float am = 0.f;
#pragma unroll
  for (int i = 0; i < 4; ++i) am = fmaxf(fmaxf(fmaxf(am, fabsf(v[i].x)), fmaxf(fabsf(v[i].y), fabsf(v[i].z))), fabsf(v[i].w));
  am = wave_max(am);
  const float sc = (am > 0.f) ? 6.f / am : 1.f;
  unsigned w0 = 0u, w1 = 0u;
  w0 = __builtin_amdgcn_cvt_scalef32_pk_fp4_f32(w0, v[0].x * sc, v[0].y * sc, 1.0f, 0);
  w0 = __builtin_amdgcn_cvt_scalef32_pk_fp4_f32(w0, v[0].z * sc, v[0].w * sc, 1.0f, 1);
  w0 = __builtin_amdgcn_cvt_scalef32_pk_fp4_f32(w0, v[1].x * sc, v[1].y * sc, 1.0f, 2);
  w0 = __builtin_amdgcn_cvt_scalef32_pk_fp4_f32(w0, v[1].z * sc, v[1].w * sc, 1.0f, 3);
  w1 = __builtin_amdgcn_cvt_scalef32_pk_fp4_f32(w1, v[2].x * sc, v[2].y * sc, 1.0f, 0);
  w1 = __builtin_amdgcn_cvt_scalef32_pk_fp4_f32(w1, v[2].z * sc, v[2].w * sc, 1.0f, 1);
  w1 = __builtin_amdgcn_cvt_scalef32_pk_fp4_f32(w1, v[3].x * sc, v[3].y * sc, 1.0f, 2);
  w1 = __builtin_amdgcn_cvt_scalef32_pk_fp4_f32(w1, v[3].z * sc, v[3].w * sc, 1.0f, 3);
  *(uint2*)(dst + (size_t)row * (DM / 2) + lane * 8) = make_uint2(w0, w1);
  if (lane == 0) inv_scale[row] = (am > 0.f) ? am * (1.f / 6.f) : 1.f;
}
__device__ __forceinline__ void dec16_fp8(const uint4 d, f32x2_t (&o)[8]) {
  const unsigned w[4] = {d.x, d.y, d.z, d.w};
#pragma unroll
  for (int k = 0; k < 4; ++k) {
    o[2 * k] = __builtin_amdgcn_cvt_pk_f32_fp8((int)w[k], false);
    o[2 * k + 1] = __builtin_amdgcn_cvt_pk_f32_fp8((int)w[k], true);
  }
}
__device__ __forceinline__ void dec16_fp4(const uint2 d, f32x2_t (&o)[8]) {
  o[0] = __builtin_amdgcn_cvt_scalef32_pk_f32_fp4(d.x, 1.0f, 0); o[1] = __builtin_amdgcn_cvt_scalef32_pk_f32_fp4(d.x, 1.0f, 1);
  o[2] = __builtin_amdgcn_cvt_scalef32_pk_f32_fp4(d.x, 1.0f, 2); o[3] = __builtin_amdgcn_cvt_scalef32_pk_f32_fp4(d.x, 1.0f, 3);
  o[4] = __builtin_amdgcn_cvt_scalef32_pk_f32_fp4(d.y, 1.0f, 0); o[5] = __builtin_amdgcn_cvt_scalef32_pk_f32_fp4(d.y, 1.0f, 1);
  o[6] = __builtin_amdgcn_cvt_scalef32_pk_f32_fp4(d.y, 1.0f, 2); o[7] = __builtin_amdgcn_cvt_scalef32_pk_f32_fp4(d.y, 1.0f, 3);
}
#if EX_FP4_DOWN
typedef uint2 drow_t;
#define DROW_BYTES 8
#define DEC_D dec16_fp4
#else
typedef uint4 drow_t;
#define DROW_BYTES 16
#define DEC_D dec16_fp8
#endif
#if EX_FP4_UP
typedef uint2 urow_t;
#define UROW_BYTES 8
#define DEC_U dec16_fp4
#else
typedef uint4 urow_t;
#define UROW_BYTES 16
#define DEC_U dec16_fp8
#endif

__device__ __forceinline__ int swz(int row, int ch) { return row * 128 + ((ch ^ ((row >> 1) & 7)) << 4); }

__device__ __forceinline__ void gemm_compute(const char* cA, const char* cB, const int arow, const int brow, const int xr, const int h,
                                             f32x16 (&acc)[2][2]) {
#pragma unroll
  for (int ks = 0; ks < 4; ++ks) {
    const int co = ((ks * 2 + h) ^ xr) << 4;
    bf16x8 a0 = *(const bf16x8*)(cA + arow + co);
    bf16x8 a1 = *(const bf16x8*)(cA + arow + 32 * 128 + co);
    bf16x8 b0 = *(const bf16x8*)(cB + brow + co);
    bf16x8 b1 = *(const bf16x8*)(cB + brow + 32 * 128 + co);
    acc[0][0] = __builtin_amdgcn_mfma_f32_32x32x16_bf16(a0, b0, acc[0][0], 0, 0, 0);
    acc[0][1] = __builtin_amdgcn_mfma_f32_32x32x16_bf16(a0, b1, acc[0][1], 0, 0, 0);
    acc[1][0] = __builtin_amdgcn_mfma_f32_32x32x16_bf16(a1, b0, acc[1][0], 0, 0, 0);
    acc[1][1] = __builtin_amdgcn_mfma_f32_32x32x16_bf16(a1, b1, acc[1][1], 0, 0, 0);
  }
}

__device__ __forceinline__ void gemm_core(const ushort_t* __restrict__ A, const ushort_t* __restrict__ Bt, const int K, const int m0,
                                          const int n0, char* smem, f32x16 (&acc)[2][2]) {
  int tid = threadIdx.x;
  asm volatile("" : "+v"(tid));
  const int lane = tid & 63;
  const int wave = __builtin_amdgcn_readfirstlane(tid >> 6);
  const int wm = wave >> 1, wn = wave & 1;
  const int r = lane & 31, h = lane >> 5;
  const int srow = wave * 8 + (lane >> 3);
  const int schs = (lane & 7) ^ ((srow >> 1) & 7);
  const ushort_t* Ag = A + (size_t)(m0 + srow) * K + schs * 8;
  const ushort_t* Bg = Bt + (size_t)(n0 + srow) * K + schs * 8;
  const size_t rs = (size_t)32 * K;
  char* wbase = smem + wave * 1024;
#define GLDS_TILE(BUF, koff) { \
    __builtin_amdgcn_global_load_lds((const unsigned*)(Ag + (koff)), (unsigned*)(wbase + (BUF)), 16, 0, 0); \
    __builtin_amdgcn_global_load_lds((const unsigned*)(Ag + rs + (koff)), (unsigned*)(wbase + (BUF) + 4096), 16, 0, 0); \
    __builtin_amdgcn_global_load_lds((const unsigned*)(Ag + 2 * rs + (koff)), (unsigned*)(wbase + (BUF) + 8192), 16, 0, 0); \
    __builtin_amdgcn_global_load_lds((const unsigned*)(Ag + 3 * rs + (koff)), (unsigned*)(wbase + (BUF) + 12288), 16, 0, 0); \
    __builtin_amdgcn_global_load_lds((const unsigned*)(Bg + (koff)), (unsigned*)(wbase + (BUF) + 16384), 16, 0, 0); \
    __builtin_amdgcn_global_load_lds((const unsigned*)(Bg + rs + (koff)), (unsigned*)(wbase + (BUF) + 16384 + 4096), 16, 0, 0); \
    __builtin_amdgcn_global_load_lds((const unsigned*)(Bg + 2 * rs + (koff)), (unsigned*)(wbase + (BUF) + 16384 + 8192), 16, 0, 0); \
    __builtin_amdgcn_global_load_lds((const unsigned*)(Bg + 3 * rs + (koff)), (unsigned*)(wbase + (BUF) + 16384 + 12288), 16, 0, 0); }
  GLDS_TILE(0, 0)
#pragma unroll
  for (int i = 0; i < 2; ++i)
#pragma unroll
    for (int j = 0; j < 2; ++j)
#pragma unroll
      for (int e = 0; e < 16; ++e) acc[i][j][e] = 0.f;
  const int nk = K >> 6;
  const int xr = (r >> 1) & 7;
  const int arow = (wm * 64 + r) * 128, brow = (wn * 64 + r) * 128;
  asm volatile("s_waitcnt vmcnt(0)" ::: "memory");
  __syncthreads();
#pragma unroll 1
  for (int kt = 0; kt < nk; kt += 2) {
    GLDS_TILE(32768, (kt + 1) * 64)
    gemm_compute(smem, smem + 16384, arow, brow, xr, h, acc);
    asm volatile("s_waitcnt vmcnt(0)" ::: "memory");
    __syncthreads();
    if (kt + 2 < nk) { GLDS_TILE(0, (kt + 2) * 64) }
    gemm_compute(smem + 32768, smem + 32768 + 16384, arow, brow, xr, h, acc);
    asm volatile("s_waitcnt vmcnt(0)" ::: "memory");
    __syncthreads();
  }
#undef GLDS_TILE
}

enum { EP_SILU = 0, EP_PLAIN = 1, EP_HEADNORM = 2 };

__device__ __forceinline__ void stage_flush_bf16(const char* sw, ushort_t* __restrict__ dst, const size_t ld, const size_t row0, const int col0) {
  const int lane = threadIdx.x & 63;
  const int rr = lane >> 3, ch = lane & 7;
#pragma unroll
  for (int i = 0; i < 8; ++i) {
    const int row = i * 8 + rr;
    const uint4 v = *(const uint4*)(sw + row * 144 + ch * 16);
    *(uint4*)(dst + (row0 + row) * ld + col0 + ch * 8) = v;
  }
}

__device__ __forceinline__ void epi_bf16(char* smem, const f32x16 (&acc)[2][2], const int mode, ushort_t* __restrict__ dst, const int ld,
                                         const int row0, const int col0, const float* __restrict__ nw, float* __restrict__ kp) {
  const int lane = threadIdx.x & 63, r = lane & 31, h = lane >> 5;
  char* sw = smem + (threadIdx.x >> 6) * 9216;
  float w0 = 1.f, w1 = 1.f;
  if (mode == EP_HEADNORM) { w0 = nw[r]; w1 = nw[32 + r]; }
  float cs0 = 0.f, cs1 = 0.f;
#pragma unroll
  for (int mi = 0; mi < 2; ++mi) {
#pragma unroll
    for (int e = 0; e < 16; ++e) {
      const int row = mi * 32 + (e & 3) + 8 * (e >> 2) + 4 * h;
      float v0 = acc[mi][0][e], v1 = acc[mi][1][e];
      if (mode == EP_SILU) { v0 = silu_f(v0); v1 = silu_f(v1); }
      if (mode == EP_HEADNORM) {
        float ss = v0 * v0 + v1 * v1;
        ss += __shfl_xor(ss, 1); ss += __shfl_xor(ss, 2); ss += __shfl_xor(ss, 4); ss += __shfl_xor(ss, 8); ss += __shfl_xor(ss, 16);
        const float rs = rsqrtf(ss * (1.f / 64.f) + EPS);
        v0 = v0 * rs * w0; v1 = v1 * rs * w1;
        cs0 += v0; cs1 += v1;
      }
      *(ushort_t*)(sw + row * 144 + r * 2) = f2bf(v0);
      *(ushort_t*)(sw + row * 144 + 64 + r * 2) = f2bf(v1);
    }
  }
  if (kp) {
    cs0 += __shfl_xor(cs0, 32);
    cs1 += __shfl_xor(cs1, 32);
    if (h == 0) { kp[r] = cs0; kp[32 + r] = cs1; }
  }
  stage_flush_bf16(sw, dst, (size_t)ld, (size_t)row0, col0);
}

__device__ __forceinline__ void epi_bf16_T(char* smem, const f32x16 (&acc)[2][2], ushort_t* __restrict__ dstT, const size_t ldT, const int rowpos0) {
  const int lane = threadIdx.x & 63, r = lane & 31, h = lane >> 5;
  char* sw = smem + (threadIdx.x >> 6) * 9216;
#pragma unroll
  for (int ni = 0; ni < 2; ++ni) {
#pragma unroll
    for (int mi = 0; mi < 2; ++mi) {
#pragma unroll
      for (int q4 = 0; q4 < 4; ++q4) {
        const int rp = mi * 32 + 8 * q4 + 4 * h;
        *(uint2*)(sw + (ni * 32 + r) * 144 + rp * 2) = make_uint2(pack2(acc[mi][ni][4 * q4 + 0], acc[mi][ni][4 * q4 + 1]),
                                                                    pack2(acc[mi][ni][4 * q4 + 2], acc[mi][ni][4 * q4 + 3]));
      }
    }
  }
  stage_flush_bf16(sw, dstT, ldT, 0, rowpos0);
}

__device__ __forceinline__ void epi_f32(char* smem, const f32x16 (&acc)[2][2], float* __restrict__ dst, const int ld, const int row0, const int col0,
                                        const float* __restrict__ resid, ushort_t* __restrict__ dstb, float* __restrict__ hss) {
  const int lane = threadIdx.x & 63, r = lane & 31, h = lane >> 5;
  char* sw = smem + (threadIdx.x >> 6) * 17408;
#pragma unroll
  for (int mi = 0; mi < 2; ++mi) {
#pragma unroll
    for (int e = 0; e < 16; ++e) {
      const int row = mi * 32 + (e & 3) + 8 * (e >> 2) + 4 * h;
      *(float*)(sw + row * 272 + r * 4) = acc[mi][0][e];
      *(float*)(sw + row * 272 + 128 + r * 4) = acc[mi][1][e];
    }
  }
  const int rr = lane >> 4, ch = lane & 15;
#pragma unroll
  for (int hb = 0; hb < 2; ++hb) {
    float4 rv[8];
    if (resid) {
#pragma unroll
      for (int i = 0; i < 8; ++i) rv[i] = ld_nt4(resid + (size_t)(row0 + (hb * 8 + i) * 4 + rr) * ld + col0 + ch * 4);
    }
#pragma unroll
    for (int i = 0; i < 8; ++i) {
      const int row = (hb * 8 + i) * 4 + rr;
      float4 v = *(const float4*)(sw + row * 272 + ch * 16);
      if (resid) { v.x += rv[i].x; v.y += rv[i].y; v.z += rv[i].z; v.w += rv[i].w; }
      *(float4*)(dst + (size_t)(row0 + row) * ld + col0 + ch * 4) = v;
      if (dstb) {
        *(uint2*)(dstb + (size_t)(row0 + row) * ld + col0 + ch * 4) = make_uint2(pack2(v.x, v.y), pack2(v.z, v.w));
        float ss = v.x * v.x + v.y * v.y + v.z * v.z + v.w * v.w;
        ss += __shfl_xor(ss, 1); ss += __shfl_xor(ss, 2); ss += __shfl_xor(ss, 4); ss += __shfl_xor(ss, 8);
        if (ch == 0) hss[(size_t)(row0 + row) * 16 + (col0 >> 6)] = ss;
      }
    }
  }
}

__device__ __forceinline__ void ph_gemm_proj(const int vb, char* smem, const Params& p) {
  const int nt = vb % 20, mt = vb / 20;
  const int m0 = mt * 128, n0 = nt * 128;
  f32x16 acc[2][2];
  gemm_core(p.xn_b, p.w_inT, DM, m0, n0, smem, acc);
  const int wave = threadIdx.x >> 6, wm = wave >> 1, wn = wave & 1;
  const int row0 = m0 + wm * 64;
  const int c = n0 + wn * 64;
  if (c < 512) epi_bf16(smem, acc, EP_SILU, p.zs, 512, row0, c, nullptr, nullptr);
  else if (c < 1536) epi_bf16(smem, acc, EP_PLAIN, p.xbc_raw, 1024, row0, c - 512, nullptr, nullptr);
  else if (c < 1792) epi_bf16(smem, acc, EP_HEADNORM, p.mq, 256, row0, c - 1536, p.mq_norm_w, nullptr);
  else if (c < 2048) {
    const int hh = (c - 1792) >> 6, bb = row0 >> 13, lpos = row0 & (SL - 1);
    epi_bf16(smem, acc, EP_HEADNORM, p.mk, 256, row0, c - 1792, p.mk_norm_w, p.kpart + ((size_t)((bb * 4 + hh) * 32 + (lpos >> 8)) * 4 + ((lpos >> 6) & 3)) * 64);
  } else if (c < 2304) {
    const int hh = (c - 2048) >> 6, bb = row0 >> 13, lpos = row0 & (SL - 1);
    epi_bf16_T(smem, acc, p.vT + (size_t)(bb * 4 + hh) * 64 * SL, SL, lpos);
  }
  else epi_bf16(smem, acc, EP_HEADNORM, p.xq, 256, row0, c - 2304, p.xq_norm_w, nullptr);
}

__device__ __forceinline__ void ph_gemm_mem(const int vb, char* smem, const Params& p) {
  const int nt = vb % 4, mt = vb / 4;
  const int m0 = mt * 128, n0 = nt * 128;
  f32x16 acc[2][2];
  gemm_core(p.memn_b, p.w_memT, DM, m0, n0, smem, acc);
  const int wave = threadIdx.x >> 6, wm = wave >> 1, wn = wave & 1;
  const int row0 = m0 + wm * 64;
  const int c = n0 + wn * 64;
  if (c < 256) epi_bf16(smem, acc, EP_HEADNORM, p.memk_b, 256, row0, c, p.xk_norm_w, nullptr);
  else {
    const int hh = (c - 256) >> 6, bb = row0 >> 8, mpos = row0 & 255;
    epi_bf16_T(smem, acc, p.memvT + (size_t)(bb * 4 + hh) * 64 * MEM, MEM, mpos);
  }
}

__device__ __forceinline__ void ph_gemm_f32(const int vb, char* smem, const ushort_t* A, const ushort_t* Bt, float* dst, const float* resid, ushort_t* dstb, float* hss) {
  const int nt = vb % 8, mt = vb / 8;
  const int m0 = mt * 128, n0 = nt * 128;
  f32x16 acc[2][2];
  gemm_core(A, Bt, DM, m0, n0, smem, acc);
  const int wave = threadIdx.x >> 6, wm = wave >> 1, wn = wave & 1;
  epi_f32(smem, acc, dst, DM, m0 + wm * 64, n0 + wn * 64, resid, dstb, hss);
}

__device__ __forceinline__ int swz256(int row, int ch) { return row * 272 + (ch << 4); }
__device__ __forceinline__ int crow16(int e, int hl) { return (e & 3) + 8 * (e >> 2) + 4 * hl; }

__device__ __forceinline__ void ph_acs(const int vb, const Params& p) {
  const int lane = threadIdx.x & 63;
  const int item = vb * 4 + (threadIdx.x >> 6);
  const int h = item & 7, bc = item >> 3;
  const int t0 = bc * 128;
  const float a_coef = -expf(p.a_log[h]);
  const float d0 = p.dt[(size_t)(t0 + lane) * 8 + h], d1 = p.dt[(size_t)(t0 + 64 + lane) * 8 + h];
  float c0 = d0 * a_coef, c1 = d1 * a_coef;
#pragma unroll
  for (int o = 1; o < 64; o <<= 1) {
    const float n0 = __shfl_up(c0, o), n1 = __shfl_up(c1, o);
    if (lane >= o) { c0 += n0; c1 += n1; }
  }
  c1 += __shfl(c0, 63);
  const float tot = __shfl(c1, 63);
  p.acs[(size_t)(t0 + lane) * 8 + h] = c0;
  p.acs[(size_t)(t0 + 64 + lane) * 8 + h] = c1;
  p.wdec[(size_t)(t0 + lane) * 8 + h] = d0 * expf(tot - c0);
  p.wdec[(size_t)(t0 + 64 + lane) * 8 + h] = d1 * expf(tot - c1);
  if (lane == 0) p.cdec[item] = expf(tot);
}

__device__ __forceinline__ void ph_ssd1(const int vb, char* smem, const Params& p) {
  const int h = vb & 7, c = (vb >> 3) & 63, b = vb >> 9;
  const int g = h >> 2, hq = h & 3;
  int tid = threadIdx.x;
  asm volatile("" : "+v"(tid));
  const int lane = tid & 63, wave = tid >> 6;
  const int t0 = b * SL + c * 128;
  char* s_xw = smem;
  char* s_bt = smem + 17408;
  float* s_acs = (float*)(smem + 52224);
  float* s_w = s_acs + 128;
  float* s_red = s_w + 128;
  if (tid < 128) s_w[tid] = p.wdec[(size_t)(t0 + tid) * 8 + h];
  __syncthreads();
  if (tid < 224) {
    const int seg = tid / 28, cg = tid - seg * 28;
    const bool is_x = cg < 8, is_b = (cg >= 8) && (cg < 24);
    int ch0, trow;
    if (is_x) { ch0 = h * 64 + cg * 8; trow = cg * 8; }
    else if (is_b) { ch0 = 512 + g * 128 + (cg - 8) * 8; trow = (cg - 8) * 8; }
    else { ch0 = 768 + g * 128 + hq * 32 + (cg - 24) * 8; trow = 0; }
    const bool wr_nat = is_x || !is_b || (hq == 0);
    char* tbase = is_x ? s_xw : s_bt;
    const int l0 = seg * 16;
    float w0[8], w1[8], w2[8], w3[8], bias[8];
    {
      const float* cw = p.conv_w + ch0;
      float4 a, bq;
      a = *(const float4*)(cw); bq = *(const float4*)(cw + 4);
      w0[0] = a.x; w0[1] = a.y; w0[2] = a.z; w0[3] = a.w; w0[4] = bq.x; w0[5] = bq.y; w0[6] = bq.z; w0[7] = bq.w;
      a = *(const float4*)(cw + 1024); bq = *(const float4*)(cw + 1028);
      w1[0] = a.x; w1[1] = a.y; w1[2] = a.z; w1[3] = a.w; w1[4] = bq.x; w1[5] = bq.y; w1[6] = bq.z; w1[7] = bq.w;
      a = *(const float4*)(cw + 2048); bq = *(const float4*)(cw + 2052);
      w2[0] = a.x; w2[1] = a.y; w2[2] = a.z; w2[3] = a.w; w2[4] = bq.x; w2[5] = bq.y; w2[6] = bq.z; w2[7] = bq.w;
      a = *(const float4*)(cw + 3072); bq = *(const float4*)(cw + 3076);
      w3[0] = a.x; w3[1] = a.y; w3[2] = a.z; w3[3] = a.w; w3[4] = bq.x; w3[5] = bq.y; w3[6] = bq.z; w3[7] = bq.w;
      a = *(const float4*)(p.conv_b + ch0); bq = *(const float4*)(p.conv_b + ch0 + 4);
      bias[0] = a.x; bias[1] = a.y; bias[2] = a.z; bias[3] = a.w; bias[4] = bq.x; bias[5] = bq.y; bias[6] = bq.z; bias[7] = bq.w;
    }
    float r0[8], r1[8], r2[8];
    {
      const int lg = c * 128 + l0;
      const ushort_t* src = p.xbc_raw + (size_t)(t0 + l0) * 1024 + ch0;
      uint4 z4 = make_uint4(0u, 0u, 0u, 0u);
      uint4 u0 = (lg >= 3) ? *(const uint4*)(src - 3 * 1024) : z4;
      uint4 u1 = (lg >= 2) ? *(const uint4*)(src - 2 * 1024) : z4;
      uint4 u2 = (lg >= 1) ? *(const uint4*)(src - 1 * 1024) : z4;
      unpack8(u0, r0); unpack8(u1, r1); unpack8(u2, r2);
    }
    unsigned outp[8][8];
    float lo[8], los[8];
#pragma unroll
    for (int i = 0; i < 16; ++i) {
      float cur[8], val[8];
      unpack8(*(const uint4*)(p.xbc_raw + (size_t)(t0 + l0 + i) * 1024 + ch0), cur);
#pragma unroll
      for (int j = 0; j < 8; ++j) {
        float v = bias[j];
        v = fmaf(w0[j], r0[j], v); v = fmaf(w1[j], r1[j], v); v = fmaf(w2[j], r2[j], v); v = fmaf(w3[j], cur[j], v);
        val[j] = silu_f(v);
        r0[j] = r1[j]; r1[j] = r2[j]; r2[j] = cur[j];
      }
      if (wr_nat) {
        *(uint4*)(p.xc + (size_t)(t0 + l0 + i) * 1024 + ch0) =
            make_uint4(pack2(val[0], val[1]), pack2(val[2], val[3]), pack2(val[4], val[5]), pack2(val[6], val[7]));
      }
      const float scl = is_x ? s_w[l0 + i] : 1.f;
      if ((i & 1) == 0) {
#pragma unroll
        for (int j = 0; j < 8; ++j) { lo[j] = val[j]; los[j] = val[j] * scl; }
      } else {
        const int chunk = seg * 2 + (i >> 3);
#pragma unroll
        for (int j = 0; j < 8; ++j) {
          outp[j][i >> 1] = pack2(lo[j], val[j]);
          if (is_x || is_b) *(unsigned*)(tbase + swz256(trow + j, chunk) + ((i & 7) - 1) * 2) = pack2(los[j], val[j] * scl);
        }
      }
    }
    if (is_x) {
      ushort_t* dst = p.xT + ((size_t)((b * 64 + c) * 8 + h) * 64 + cg * 8) * 128 + l0;
#pragma unroll
      for (int j = 0; j < 8; ++j) {
        *(uint4*)(dst + (size_t)j * 128) = make_uint4(outp[j][0], outp[j][1], outp[j][2], outp[j][3]);
        *(uint4*)(dst + (size_t)j * 128 + 8) = make_uint4(outp[j][4], outp[j][5], outp[j][6], outp[j][7]);
      }
    }
  }
  __syncthreads();
  {
    const int r = lane & 31, hl = lane >> 5;
    f32x16 acc[2];
#pragma unroll
    for (int e = 0; e < 16; ++e) { acc[0][e] = 0.f; acc[1][e] = 0.f; }
#pragma unroll
    for (int ks = 0; ks < 8; ++ks) {
      const bf16x8 bfr = *(const bf16x8*)(s_bt + swz256(32 * wave + r, ks * 2 + hl));
      const bf16x8 a0 = *(const bf16x8*)(s_xw + swz256(r, ks * 2 + hl));
      const bf16x8 a1 = *(const bf16x8*)(s_xw + swz256(32 + r, ks * 2 + hl));
      acc[0] = __builtin_amdgcn_mfma_f32_32x32x16_bf16(a0, bfr, acc[0], 0, 0, 0);
      acc[1] = __builtin_amdgcn_mfma_f32_32x32x16_bf16(a1, bfr, acc[1], 0, 0, 0);
    }
    float* dst = p.states + (size_t)((b * 64 + c) * 8 + h) * 64 * 128;
#pragma unroll
    for (int pt = 0; pt < 2; ++pt)
#pragma unroll
      for (int e = 0; e < 16; ++e) dst[(size_t)(pt * 32 + crow16(e, hl)) * 128 + 32 * wave + r] = acc[pt][e];
  }
}

__device__ __forceinline__ void ph_ssd2(const int vb, const Params& p) {
  const int idx = vb * 256 + threadIdx.x;
  const int pn = idx & 8191, h = (idx >> 13) & 7, b = idx >> 16;
  float st = 0.f;
#pragma unroll 1
  for (int c0 = 0; c0 < 64; c0 += 8) {
    float sv[8], dv[8];
#pragma unroll
    for (int i = 0; i < 8; ++i) {
      const int cc = (b * 64 + c0 + i) * 8 + h;
      sv[i] = p.states[(size_t)cc * 8192 + pn];
      dv[i] = p.cdec[cc];
    }
#pragma unroll
    for (int i = 0; i < 8; ++i) {
      const int cc = (b * 64 + c0 + i) * 8 + h;
      p.sin_b[(size_t)cc * 8192 + pn] = f2bf(st);
      st = fmaf(st, dv[i], sv[i]);
    }
  }
}

__device__ __forceinline__ void ph_ssd3(const int vb, char* smem, const Params& p) {
  const int g = vb & 1, c = (vb >> 1) & 63, b = vb >> 7;
  int tid = threadIdx.x;
  asm volatile("" : "+v"(tid));
  const int lane = tid & 63;
  const int w = __builtin_amdgcn_readfirstlane(tid >> 6);
  const int r = lane & 31, hl = lane >> 5;
  const int t0 = b * SL + c * 128;
  char* s_C = smem;
  char* s_B = smem + 34816;
  char* s_xT = smem + 34816;
  char* s_S = smem + 34816 + 16896;
  float* s_acs = (float*)(smem + 69632);
  float* s_dt = s_acs + 512;
  {
    const int ch = tid & 15, r0 = tid >> 4;
#pragma unroll
    for (int i = 0; i < 8; ++i) {
      const int row = r0 + 16 * i;
      const ushort_t* src = p.xc + (size_t)(t0 + row) * 1024 + g * 128 + ch * 8;
      *(uint4*)(s_B + swz256(row, ch)) = *(const uint4*)(src + 512);
      *(uint4*)(s_C + swz256(row, ch)) = *(const uint4*)(src + 768);
    }
    if (tid < 128) {
#pragma unroll
      for (int hh = 0; hh < 4; ++hh) {
        s_acs[hh * 128 + tid] = p.acs[(size_t)(t0 + tid) * 8 + g * 4 + hh];
        s_dt[hh * 128 + tid] = p.dt[(size_t)(t0 + tid) * 8 + g * 4 + hh];
      }
    }
  }
  __syncthreads();
  bf16x8 cfr[8];
#pragma unroll
  for (int ks = 0; ks < 8; ++ks) cfr[ks] = *(const bf16x8*)(s_C + swz256(32 * w + r, ks * 2 + hl));
  f32x16 gt[4];
#pragma unroll
  for (int st = 0; st < 4; ++st) {
#pragma unroll
    for (int e = 0; e < 16; ++e) gt[st][e] = 0.f;
    if (st <= w) {
#pragma unroll
      for (int ks = 0; ks < 8; ++ks) {
        const bf16x8 a = *(const bf16x8*)(s_B + swz256(32 * st + r, ks * 2 + hl));
        gt[st] = __builtin_amdgcn_mfma_f32_32x32x16_bf16(a, cfr[ks], gt[st], 0, 0, 0);
      }
    }
  }
  __syncthreads();
  float ssq = 0.f;
  const int lane_c = lane;
  uint4 PX0, PX1, PX2, PX3, PS0, PS1, PS2, PS3;
  {
    const int ch = tid & 15, r0 = tid >> 4;
    const size_t base = (size_t)((b * 64 + c) * 8 + g * 4) * 8192 + (size_t)r0 * 128 + ch * 8;
    PX0 = *(const uint4*)(p.xT + base); PX1 = *(const uint4*)(p.xT + base + 16 * 128);
    PX2 = *(const uint4*)(p.xT + base + 32 * 128); PX3 = *(const uint4*)(p.xT + base + 48 * 128);
    PS0 = *(const uint4*)(p.sin_b + base); PS1 = *(const uint4*)(p.sin_b + base + 16 * 128);
    PS2 = *(const uint4*)(p.sin_b + base + 32 * 128); PS3 = *(const uint4*)(p.sin_b + base + 48 * 128);
  }
#pragma unroll 1
  for (int hh = 0; hh < 4; ++hh) {
    int lane_o = lane_c;
    asm volatile("" : "+v"(lane_o));
    const int r = lane_o & 31, hl = lane_o >> 5;
    const int l = 32 * w + r;
    const int hg = g * 4 + hh;
    {
      const int ch = tid & 15, r0 = tid >> 4;
      *(uint2*)(s_xT + (r0) * 264 + ch * 16) = make_uint2(PX0.x, PX0.y); *(uint2*)(s_xT + (r0) * 264 + ch * 16 + 8) = make_uint2(PX0.z, PX0.w);
      *(uint2*)(s_xT + (r0 + 16) * 264 + ch * 16) = make_uint2(PX1.x, PX1.y); *(uint2*)(s_xT + (r0 + 16) * 264 + ch * 16 + 8) = make_uint2(PX1.z, PX1.w);
      *(uint2*)(s_xT + (r0 + 32) * 264 + ch * 16) = make_uint2(PX2.x, PX2.y); *(uint2*)(s_xT + (r0 + 32) * 264 + ch * 16 + 8) = make_uint2(PX2.z, PX2.w);
      *(uint2*)(s_xT + (r0 + 48) * 264 + ch * 16) = make_uint2(PX3.x, PX3.y); *(uint2*)(s_xT + (r0 + 48) * 264 + ch * 16 + 8) = make_uint2(PX3.z, PX3.w);
      *(uint4*)(s_S + swz256(r0, ch)) = PS0; *(uint4*)(s_S + swz256(r0 + 16, ch)) = PS1;
      *(uint4*)(s_S + swz256(r0 + 32, ch)) = PS2; *(uint4*)(s_S + swz256(r0 + 48, ch)) = PS3;
      const int hn = (hh < 3) ? hg + 1 : hg;
      const size_t base = (size_t)((b * 64 + c) * 8 + hn) * 8192 + (size_t)r0 * 128 + ch * 8;
      PX0 = *(const uint4*)(p.xT + base); PX1 = *(const uint4*)(p.xT + base + 16 * 128);
      PX2 = *(const uint4*)(p.xT + base + 32 * 128); PX3 = *(const uint4*)(p.xT + base + 48 * 128);
      PS0 = *(const uint4*)(p.sin_b + base); PS1 = *(const uint4*)(p.sin_b + base + 16 * 128);
      PS2 = *(const uint4*)(p.sin_b + base + 32 * 128); PS3 = *(const uint4*)(p.sin_b + base + 48 * 128);
    }
    __syncthreads();
    const float acs_l = s_acs[hh * 128 + l];
    const float dsk = p.ssd_d[hg];
    f32x16 acc[2];
#pragma unroll
    for (int e = 0; e < 16; ++e) { acc[0][e] = 0.f; acc[1][e] = 0.f; }
#pragma unroll
    for (int ks = 0; ks < 8; ++ks) {
      const bf16x8 a0 = *(const bf16x8*)(s_S + swz256(r, ks * 2 + hl));
      const bf16x8 a1 = *(const bf16x8*)(s_S + swz256(32 + r, ks * 2 + hl));
      acc[0] = __builtin_amdgcn_mfma_f32_32x32x16_bf16(a0, cfr[ks], acc[0], 0, 0, 0);
      acc[1] = __builtin_amdgcn_mfma_f32_32x32x16_bf16(a1, cfr[ks], acc[1], 0, 0, 0);
    }
    {
      const float el = expf(acs_l);
#pragma unroll
      for (int e = 0; e < 16; ++e) { acc[0][e] *= el; acc[1][e] *= el; }
    }
#pragma unroll
    for (int st = 0; st < 4; ++st) {
      asm volatile("" ::: "memory");
      if (st <= w) {
        float m[16];
#pragma unroll
        for (int e = 0; e < 16; ++e) {
          const int sidx = 32 * st + crow16(e, hl);
          float v = gt[st][e] * __expf(acs_l - s_acs[hh * 128 + sidx]) * s_dt[hh * 128 + sidx];
          if (sidx > l) v = 0.f;
          if (sidx == l) v += dsk;
          m[e] = v;
        }
#pragma unroll
        for (int k2 = 0; k2 < 2; ++k2) {
          asm volatile("" ::: "memory");
          bf16x8 mf;
          {
            unsigned u0 = pack2(m[8 * k2 + 0], m[8 * k2 + 1]), u1 = pack2(m[8 * k2 + 2], m[8 * k2 + 3]);
            unsigned u2 = pack2(m[8 * k2 + 4], m[8 * k2 + 5]), u3 = pack2(m[8 * k2 + 6], m[8 * k2 + 7]);
            uint4 uu = make_uint4(u0, u1, u2, u3);
            mf = *(bf16x8*)&uu;
          }
          const int soff = (32 * st + 16 * k2 + 4 * hl) * 2;
#pragma unroll
          for (int pt = 0; pt < 2; ++pt) {
            const char* ap = s_xT + (pt * 32 + r) * 264 + soff;
            uint2 q0 = *(const uint2*)(ap);
            uint2 q1 = *(const uint2*)(ap + 16);
            uint4 qq = make_uint4(q0.x, q0.y, q1.x, q1.y);
            const bf16x8 af = *(bf16x8*)&qq;
            acc[pt] = __builtin_amdgcn_mfma_f32_32x32x16_bf16(af, mf, acc[pt], 0, 0, 0);
          }
        }
      }
    }
#pragma unroll
    for (int pt = 0; pt < 2; ++pt) {
#pragma unroll
      for (int q4 = 0; q4 < 4; ++q4) {
        asm volatile("" ::: "memory");
        const int p0 = pt * 32 + 8 * q4 + 4 * hl;
        const uint2 zz = *(const uint2*)(p.zs + (size_t)(t0 + l) * 512 + hg * 64 + p0);
        const float v0 = acc[pt][4 * q4 + 0] * bflo(zz.x), v1 = acc[pt][4 * q4 + 1] * bfhi(zz.x);
        const float v2 = acc[pt][4 * q4 + 2] * bflo(zz.y), v3 = acc[pt][4 * q4 + 3] * bfhi(zz.y);
        ssq += v0 * v0 + v1 * v1 + v2 * v2 + v3 * v3;
        *(uint2*)(p.mixed_b + (size_t)(t0 + l) * 1024 + hg * 64 + p0) = make_uint2(pack2(v0, v1), pack2(v2, v3));
      }
    }
    __syncthreads();
  }
  const int l = 32 * w + r;
  ssq += __shfl_xor(ssq, 32);
  const float rstd = rsqrtf(ssq * (1.f / 256.f) + EPS);
#pragma unroll 1
  for (int hh = 0; hh < 4; ++hh) {
#pragma unroll
    for (int pt = 0; pt < 2; ++pt) {
#pragma unroll
      for (int q4 = 0; q4 < 4; ++q4) {
        asm volatile("" ::: "memory");
        const int chn = (g * 4 + hh) * 64 + pt * 32 + 8 * q4 + 4 * hl;
        ushort_t* ptr = p.mixed_b + (size_t)(t0 + l) * 1024 + chn;
        const uint2 vv = *(const uint2*)ptr;
        const float4 nw = *(const float4*)(p.ssd_norm_w + chn);
        *(uint2*)ptr = make_uint2(pack2(bflo(vv.x) * rstd * nw.x, bfhi(vv.x) * rstd * nw.y),
                                  pack2(bflo(vv.y) * rstd * nw.z, bfhi(vv.y) * rstd * nw.w));
      }
    }
  }
}

__device__ __forceinline__ void k_gate(const int VB, char* smem, const Params& p) {
  const int own = VB & 31, bh = VB >> 5;
  if (own == 0) return;
  const int b = bh >> 2, h = bh & 3;
  const int tid = threadIdx.x;
  float* s_km = (float*)smem;
  int* s_cnt = (int*)(smem + 8192);
  int* s_base = s_cnt + 32;
  for (int i = tid; i < own * 64; i += 256) {
    const int n = i >> 6, d = i & 63;
    const float* kp = p.kpart + (size_t)(bh * 32 + n) * 256 + d;
    s_km[i] = (kp[0] + kp[64]) + (kp[128] + kp[192]);
  }
  if (tid < 32) s_cnt[tid] = 0;
  __syncthreads();
  const int l = own * 256 + tid;
  const int t = b * SL + l;
  float q[64];
  {
    const ushort_t* src = p.mq + (size_t)t * 256 + h * 64;
#pragma unroll
    for (int d = 0; d < 64; d += 8) {
      uint4 v = *(const uint4*)(src + d);
      q[d] = bflo(v.x); q[d + 1] = bfhi(v.x); q[d + 2] = bflo(v.y); q[d + 3] = bfhi(v.y);
      q[d + 4] = bflo(v.z); q[d + 5] = bfhi(v.z); q[d + 6] = bflo(v.w); q[d + 7] = bfhi(v.w);
    }
  }
  float v0 = -INFINITY, v1 = -INFINITY, v2 = -INFINITY;
  int i0 = 0, i1 = 1, i2 = 2;
  for (int n = 0; n < own; ++n) {
    const float* km = s_km + n * 64;
    float sa = 0.f, sb = 0.f;
#pragma unroll
    for (int d = 0; d < 64; d += 8) {
      const float4 a = *(const float4*)(km + d), c = *(const float4*)(km + d + 4);
      sa = fmaf(q[d], a.x, sa); sa = fmaf(q[d + 1], a.y, sa); sa = fmaf(q[d + 2], a.z, sa); sa = fmaf(q[d + 3], a.w, sa);
      sb = fmaf(q[d + 4], c.x, sb); sb = fmaf(q[d + 5], c.y, sb); sb = fmaf(q[d + 6], c.z, sb); sb = fmaf(q[d + 7], c.w, sb);
    }
    const float sv = sa + sb;
    if (sv > v0) { v2 = v1; i2 = i1; v1 = v0; i1 = i0; v0 = sv; i0 = n; }
    else if (sv > v1) { v2 = v1; i2 = i1; v1 = sv; i1 = n; }
    else if (sv > v2) { v2 = sv; i2 = n; }
  }
  const int nsel = own < 3 ? own : 3;
  int lp0 = 0, lp1 = 0, lp2 = 0;
  if (0 < nsel) lp0 = atomicAdd(s_cnt + i0, 1);
  if (1 < nsel) lp1 = atomicAdd(s_cnt + i1, 1);
  if (2 < nsel) lp2 = atomicAdd(s_cnt + i2, 1);
  __syncthreads();
  if (tid < own) s_base[tid] = s_cnt[tid] ? atomicAdd(p.bcnt + bh * 32 + tid, s_cnt[tid]) : 0;
  __syncthreads();
  if (0 < nsel) p.blist[(size_t)(bh * 32 + i0) * 8192 + s_base[i0] + lp0] = l | (0 << 13);
  if (1 < nsel) p.blist[(size_t)(bh * 32 + i1) * 8192 + s_base[i1] + lp1] = l | (1 << 13);
  if (2 < nsel) p.blist[(size_t)(bh * 32 + i2) * 8192 + s_base[i2] + lp2] = l | (2 << 13);
}

struct UnitDesc { const ushort_t* Kp; const ushort_t* VTp; int vstride; int kind; int a0; int a1; };
__device__ __forceinline__ UnitDesc unit_desc(const int u, const int Ug, const int* s_pref, const Params& p) {
  UnitDesc d;
  if (u >= Ug + NB * 4 * 32 * 2) {
    const int v = u - Ug - NB * 4 * 32 * 2;
    d.kind = 2; d.a0 = v >> 6; d.a1 = v & 63;
    const int bh = d.a0, b = bh >> 2, h = bh & 3;
    d.Kp = p.memk_b + (size_t)b * MEM * 256 + h * 64;
    d.VTp = p.memvT + (size_t)bh * 64 * MEM;
    d.vstride = MEM;
  } else {
    if (u < Ug) {
      int lo = 0, hi = 255;
      while (lo < hi) { const int mid = (lo + hi) >> 1; if (s_pref[mid] > u) hi = mid; else lo = mid + 1; }
      const int prev = lo ? s_pref[lo - 1] : 0;
      d.kind = 0; d.a0 = lo; d.a1 = u - prev;
    } else {
      const int v = u - Ug;
      d.kind = 1; d.a0 = v >> 1; d.a1 = v & 1;
    }
    const int bh = d.a0 >> 5, jblk = d.a0 & 31, b = bh >> 2, h = bh & 3;
    d.Kp = p.mk + (size_t)(b * SL + jblk * 256) * 256 + h * 64;
    d.VTp = p.vT + (size_t)bh * 64 * SL + jblk * 256;
    d.vstride = SL;
  }
  return d;
}

#define AU_LOAD(P, D, ST) { \
    const ushort_t* kp_ = (D).Kp + (size_t)((ST) * 128 + kr) * 256 + kc * 8; \
    P##k0 = *(const uint4*)(kp_); P##k1 = *(const uint4*)(kp_ + 32 * 256); P##k2 = *(const uint4*)(kp_ + 64 * 256); P##k3 = *(const uint4*)(kp_ + 96 * 256); \
    const ushort_t* vp_ = (D).VTp + (size_t)vr * (D).vstride + (ST) * 128 + vc * 8; \
    P##v0 = *(const uint4*)(vp_); P##v1 = *(const uint4*)(vp_ + (size_t)16 * (D).vstride); \
    P##v2 = *(const uint4*)(vp_ + (size_t)32 * (D).vstride); P##v3 = *(const uint4*)(vp_ + (size_t)48 * (D).vstride); }
#define AU_STORE(P, BUF) { \
    char* sk_ = (BUF) + kr * 144 + kc * 16; \
    *(uint4*)(sk_) = P##k0; *(uint4*)(sk_ + 32 * 144) = P##k1; *(uint4*)(sk_ + 64 * 144) = P##k2; *(uint4*)(sk_ + 96 * 144) = P##k3; \
    char* sv_ = (BUF) + 18432 + vr * 264 + vc * 16; \
    *(uint2*)(sv_) = make_uint2(P##v0.x, P##v0.y); *(uint2*)(sv_ + 8) = make_uint2(P##v0.z, P##v0.w); \
    *(uint2*)(sv_ + 16 * 264) = make_uint2(P##v1.x, P##v1.y); *(uint2*)(sv_ + 16 * 264 + 8) = make_uint2(P##v1.z, P##v1.w); \
    *(uint2*)(sv_ + 32 * 264) = make_uint2(P##v2.x, P##v2.y); *(uint2*)(sv_ + 32 * 264 + 8) = make_uint2(P##v2.z, P##v2.w); \
    *(uint2*)(sv_ + 48 * 264) = make_uint2(P##v3.x, P##v3.y); *(uint2*)(sv_ + 48 * 264 + 8) = make_uint2(P##v3.z, P##v3.w); }

__device__ __forceinline__ void attn_stage(const char* buf, const int st, const bf16x8 (&qf)[4], const float slope, const int qrel, const bool causal,
                                           const int r, const int hl, f32x16 (&o)[2], float& m, float& lsum) {
  const char* s_K = buf;
  const char* s_VT = buf + 18432;
  f32x16 sc[4];
#pragma unroll
  for (int kt = 0; kt < 4; ++kt) {
#pragma unroll
    for (int e = 0; e < 16; ++e) sc[kt][e] = 0.f;
#pragma unroll
    for (int ks = 0; ks < 4; ++ks) {
      const bf16x8 a = *(const bf16x8*)(s_K + (32 * kt + r) * 144 + (2 * ks + hl) * 16);
      sc[kt] = __builtin_amdgcn_mfma_f32_32x32x16_bf16(a, qf[ks], sc[kt], 0, 0, 0);
    }
  }
  float mx = -1e30f;
  const int qk0 = qrel - st * 128 - 4 * hl;
  const float slope2 = slope;
  const float bb = -slope2 * (float)qk0;
#pragma unroll
  for (int kt = 0; kt < 4; ++kt) {
#pragma unroll
    for (int e = 0; e < 16; ++e) {
      const int ce = 32 * kt + (e & 3) + 8 * (e >> 2);
      float v = fmaf(sc[kt][e], 0.18033688011112042f, fmaf(slope2, (float)ce, bb));
      if (causal && ce > qk0) v = -1e30f;
      sc[kt][e] = v;
      mx = fmaxf(mx, v);
    }
  }
  mx = fmaxf(mx, __shfl_xor(mx, 32));
  const float mnew = fmaxf(m, mx);
  const float alpha = __builtin_amdgcn_exp2f(m - mnew);
  m = mnew;
  lsum *= alpha;
#pragma unroll
  for (int e = 0; e < 16; ++e) { o[0][e] *= alpha; o[1][e] *= alpha; }
#pragma unroll
  for (int kt = 0; kt < 4; ++kt) {
#pragma unroll
    for (int e = 0; e < 16; ++e) {
      const float pe = __builtin_amdgcn_exp2f(sc[kt][e] - mnew);
      sc[kt][e] = pe;
      lsum += pe;
    }
  }
#pragma unroll
  for (int kt = 0; kt < 4; ++kt) {
#pragma unroll
    for (int k2 = 0; k2 < 2; ++k2) {
      uint4 pu = make_uint4(pack2(sc[kt][8 * k2 + 0], sc[kt][8 * k2 + 1]), pack2(sc[kt][8 * k2 + 2], sc[kt][8 * k2 + 3]),
                            pack2(sc[kt][8 * k2 + 4], sc[kt][8 * k2 + 5]), pack2(sc[kt][8 * k2 + 6], sc[kt][8 * k2 + 7]));
      const bf16x8 pf = *(bf16x8*)&pu;
      const int koff = (32 * kt + 16 * k2 + 4 * hl) * 2;
#pragma unroll
      for (int dt = 0; dt < 2; ++dt) {
        const char* ap = s_VT + (dt * 32 + r) * 264 + koff;
        const uint2 q0 = *(const uint2*)(ap);
        const uint2 q1 = *(const uint2*)(ap + 16);
        uint4 qq = make_uint4(q0.x, q0.y, q1.x, q1.y);
        const bf16x8 af = *(bf16x8*)&qq;
        o[dt] = __builtin_amdgcn_mfma_f32_32x32x16_bf16(af, pf, o[dt], 0, 0, 0);
      }
    }
  }
}

__device__ __forceinline__ void ph_attn_units(char* smem, const Params& p, const int Ug, const int* s_pref) {
  const int Utot = Ug + NB * 4 * 32 * 2 + NB * 4 * 64;
  int u = blockIdx.x;
  if (u >= Utot) return;
  int tid = threadIdx.x;
  asm volatile("" : "+v"(tid));
  const int lane = tid & 63, wave = tid >> 6, r = lane & 31, hl = lane >> 5;
  const int kr = tid >> 3, kc = tid & 7, vr = tid >> 4, vc = tid & 15;
  char* buf0 = smem;
  char* buf1 = smem + 35328;
  uint4 Ak0, Ak1, Ak2, Ak3, Av0, Av1, Av2, Av3, Bk0, Bk1, Bk2, Bk3, Bv0, Bv1, Bv2, Bv3;
  UnitDesc D = unit_desc(u, Ug, s_pref, p);
  AU_LOAD(A, D, 0)
  AU_LOAD(B, D, 1)
#pragma unroll 1
  for (; u < Utot; u += gridDim.x) {
    const int un = (u + (int)gridDim.x < Utot) ? u + (int)gridDim.x : u;
    const UnitDesc Dn = unit_desc(un, Ug, s_pref, p);
    int bh, l = 0, slot = 3, jblk = 0;
    bool valid = true, causal = false;
    const ushort_t* qrow;
    float slope = 0.f;
    int qrel = 1 << 20;
    int t;
    if (D.kind == 2) {
      bh = D.a0;
      t = (bh >> 2) * SL + D.a1 * 128 + wave * 32 + r;
      qrow = p.xq + (size_t)t * 256 + (bh & 3) * 64;
    } else {
      bh = D.a0 >> 5; jblk = D.a0 & 31;
      if (D.kind == 0) {
        const int cnt = p.bcnt[D.a0];
        int qi = D.a1 * 128 + wave * 32 + r;
        if (qi >= cnt) { valid = false; qi = 0; }
        const int ent = p.blist[(size_t)D.a0 * 8192 + qi];
        l = ent & 8191; slot = ent >> 13;
      } else {
        l = jblk * 256 + D.a1 * 128 + wave * 32 + r; slot = 3; causal = true;
      }
      t = (bh >> 2) * SL + l;
      qrow = p.mq + (size_t)t * 256 + (bh & 3) * 64;
      slope = exp2f(-2.f * (float)((bh & 3) + 1)) * 1.4426950408889634f;
      qrel = l - jblk * 256;
    }
    bf16x8 qf[4];
#pragma unroll
    for (int ks = 0; ks < 4; ++ks) qf[ks] = *(const bf16x8*)(qrow + ks * 16 + hl * 8);
    f32x16 o[2];
#pragma unroll
    for (int e = 0; e < 16; ++e) { o[0][e] = 0.f; o[1][e] = 0.f; }
    float m = -1e30f, lsum = 0.f;
    AU_STORE(A, buf0)
    AU_LOAD(A, Dn, 0)
    __syncthreads();
    attn_stage(buf0, 0, qf, slope, qrel, causal, r, hl, o, m, lsum);
    AU_STORE(B, buf1)
    AU_LOAD(B, Dn, 1)
    __syncthreads();
    attn_stage(buf1, 1, qf, slope, qrel, causal, r, hl, o, m, lsum);
    const float lt = lsum + __shfl_xor(lsum, 32);
    const float inv = 1.f / lt;
    const int h = bh & 3;
    if (D.kind == 2) {
#pragma unroll
      for (int dt = 0; dt < 2; ++dt)
#pragma unroll
        for (int q4 = 0; q4 < 4; ++q4) {
          const int d = dt * 32 + 8 * q4 + 4 * hl;
          *(uint2*)(p.mixed_b + (size_t)t * DM + 768 + h * 64 + d) =
              make_uint2(pack2(o[dt][4 * q4] * inv, o[dt][4 * q4 + 1] * inv), pack2(o[dt][4 * q4 + 2] * inv, o[dt][4 * q4 + 3] * inv));
        }
    } else if (valid) {
      const size_t pi = ((size_t)t * 4 + h) * 4 + slot;
#pragma unroll
      for (int dt = 0; dt < 2; ++dt)
#pragma unroll
        for (int q4 = 0; q4 < 4; ++q4) {
          const int d = dt * 32 + 8 * q4 + 4 * hl;
          *(uint2*)(p.pO + pi * 64 + d) =
              make_uint2(pack2(o[dt][4 * q4] * inv, o[dt][4 * q4 + 1] * inv), pack2(o[dt][4 * q4 + 2] * inv, o[dt][4 * q4 + 3] * inv));
        }
      if (hl == 0) { p.pm[pi] = m; p.pl[pi] = lt; }
    }
    D = Dn;
  }
}

__device__ __forceinline__ void ph_attn_combine(const int VB, const Params& p) {
  const int i = VB * 256 + threadIdx.x;
  const int dq = i & 7, th = i >> 3;
  const int t = th >> 2;
  const int own = (t & (SL - 1)) >> 8;
  const int nsel = own < 3 ? own : 3;
  float mv[4], wv[4];
  float M = p.pm[(size_t)th * 4 + 3];
  mv[3] = M;
#pragma unroll
  for (int sl = 0; sl < 3; ++sl) {
    mv[sl] = (sl < nsel) ? p.pm[(size_t)th * 4 + sl] : -1e30f;
    M = fmaxf(M, mv[sl]);
  }
  float W = 0.f;
#pragma unroll
  for (int sl = 0; sl < 4; ++sl) {
    const bool on = (sl == 3) || (sl < nsel);
    wv[sl] = on ? p.pl[(size_t)th * 4 + sl] * __builtin_amdgcn_exp2f(mv[sl] - M) : 0.f;
    W += wv[sl];
  }
  float acc[8];
#pragma unroll
  for (int k = 0; k < 8; ++k) acc[k] = 0.f;
#pragma unroll
  for (int sl = 0; sl < 4; ++sl) {
    const bool on = (sl == 3) || (sl < nsel);
    if (on) {
      float f[8];
      unpack8(*(const uint4*)(p.pO + ((size_t)th * 4 + sl) * 64 + dq * 8), f);
#pragma unroll
      for (int k = 0; k < 8; ++k) acc[k] = fmaf(wv[sl], f[k], acc[k]);
    }
  }
  const float inv = 1.f / W;
  const int h = th & 3;
  *(uint4*)(p.mixed_b + (size_t)t * DM + 512 + h * 64 + dq * 8) =
      make_uint4(pack2(acc[0] * inv, acc[1] * inv), pack2(acc[2] * inv, acc[3] * inv), pack2(acc[4] * inv, acc[5] * inv), pack2(acc[6] * inv, acc[7] * inv));
}


__device__ __forceinline__ int mkkey(const float f, const int idx, const int mask) {
  int b = __float_as_int(f);
  b = (b & ~mask) | idx;
  return b ^ ((b >> 31) & 0x7fffffff);
}
__device__ __forceinline__ int key2bits(const int k) { return k ^ ((k >> 31) & 0x7fffffff); }
#define CEI(a, b) { const int _mx = max(a, b), _mn = min(a, b); a = _mx; b = _mn; }
template <int N>
__device__ __forceinline__ void bitonic_sort_desc(int (&v)[N]) {
#pragma unroll
  for (int k = 2; k <= N; k <<= 1) {
#pragma unroll
    for (int j = k >> 1; j > 0; j >>= 1) {
#pragma unroll
      for (int i = 0; i < N; ++i) {
        const int l = i ^ j;
        if (l > i) {
          if ((i & k) == 0) { CEI(v[i], v[l]); } else { CEI(v[l], v[i]); }
        }
      }
    }
  }
}
__device__ __forceinline__ void merge16(int (&a)[16], const int (&b)[16]) {
#pragma unroll
  for (int i = 0; i < 16; ++i) a[i] = max(a[i], b[15 - i]);
#pragma unroll
  for (int j = 8; j > 0; j >>= 1) {
#pragma unroll
    for (int i = 0; i < 16; ++i) {
      const int l = i ^ j;
      if (l > i) { CEI(a[i], a[l]); }
    }
  }
}
__device__ __forceinline__ void merge_partner(int (&a)[16], const int xmask) {
  int o[16];
#pragma unroll
  for (int i = 0; i < 16; ++i) o[i] = __shfl_xor(a[i], xmask);
  merge16(a, o);
}
__device__ __forceinline__ bf16x8 pack_hi8(const float (&x)[8], float (&res)[8]) {
  unsigned u[4];
#pragma unroll
  for (int i = 0; i < 4; ++i) {
    const ushort_t h0 = f2bf(x[2 * i]), h1 = f2bf(x[2 * i + 1]);
    res[2 * i] = x[2 * i] - bf2f(h0);
    res[2 * i + 1] = x[2 * i + 1] - bf2f(h1);
    u[i] = (unsigned)h0 | ((unsigned)h1 << 16);
  }
  uint4 uu = make_uint4(u[0], u[1], u[2], u[3]);
  return *(bf16x8*)&uu;
}
__device__ __forceinline__ bf16x8 pack_8(const float (&x)[8]) {
  uint4 uu = make_uint4(pack2(x[0], x[1]), pack2(x[2], x[3]), pack2(x[4], x[5]), pack2(x[6], x[7]));
  return *(bf16x8*)&uu;
}

__device__ __forceinline__ void ph_gemm_route(const int vb, char* smem, const Params& p, const ushort_t* __restrict__ hn_b) {
  const int head = vb & 7, tt = vb >> 3;
  const int m0 = head * 128, n0 = tt * 128;
  f32x16 acc[2][2];
  gemm_core(p.w_qT, hn_b, DM, m0, n0, smem, acc);
  int tid = threadIdx.x;
  asm volatile("" : "+v"(tid));
  const int lane = tid & 63, r = lane & 31, hl = lane >> 5;
  const int wave = tid >> 6, wm = wave >> 1, wn = wave & 1;
  int* s_top = (int*)(smem + 34816);
  float rstd_tok[2];
#pragma unroll
  for (int ni = 0; ni < 2; ++ni) {
    const float4* hp = (const float4*)(p.hss + (size_t)(n0 + wn * 64 + ni * 32 + r) * 16);
    const float4 a = hp[0], b = hp[1], c = hp[2], d = hp[3];
    const float tot = ((a.x + a.y) + (a.z + a.w)) + ((b.x + b.y) + (b.z + b.w)) + ((c.x + c.y) + (c.z + c.w)) + ((d.x + d.y) + (d.z + d.w));
    rstd_tok[ni] = rsqrtf(tot * (1.f / DM) + EPS);
  }
  {
    const int row = tid >> 1, part = tid & 1;
#pragma unroll
    for (int hf = 0; hf < 2; ++hf) {
      const ushort_t* src = p.skh + (size_t)(hf * 128 + row) * 64 + part * 32;
      char* dst = smem + (hf * 128 + row) * 136 + part * 64;
#pragma unroll
      for (int c = 0; c < 4; ++c) {
        const uint4 v = *(const uint4*)(src + c * 8);
        *(uint2*)(dst + c * 16) = make_uint2(v.x, v.y);
        *(uint2*)(dst + c * 16 + 8) = make_uint2(v.z, v.w);
      }
    }
  }
  __syncthreads();
  const char* s_keys = smem + wm * 128 * 136;
#pragma unroll
  for (int ni = 0; ni < 2; ++ni) {
    asm volatile("" ::: "memory");
    bf16x8 qh[4], ql[4];
#pragma unroll
    for (int mi = 0; mi < 2; ++mi) {
#pragma unroll
      for (int k2 = 0; k2 < 2; ++k2) {
        float x[8], res[8];
#pragma unroll
        for (int j = 0; j < 8; ++j) x[j] = acc[mi][ni][8 * k2 + j] * rstd_tok[ni];
        qh[mi * 2 + k2] = pack_hi8(x, res);
        ql[mi * 2 + k2] = pack_8(res);
      }
    }
    int g0[16];
#pragma unroll
    for (int kh2 = 0; kh2 < 2; ++kh2) {
      int ga[16], gb[16];
#pragma unroll
      for (int kq = 0; kq < 2; ++kq) {
        const int kt = kh2 * 2 + kq;
        asm volatile("" ::: "memory");
        f32x16 sc;
#pragma unroll
        for (int e = 0; e < 16; ++e) sc[e] = 0.f;
#pragma unroll
        for (int st = 0; st < 4; ++st) {
          const int d0 = (st >> 1) * 32 + 16 * (st & 1) + 4 * hl;
          const char* kp = s_keys + (kt * 32 + r) * 136 + d0 * 2;
          const uint2 h0 = *(const uint2*)(kp), h1 = *(const uint2*)(kp + 16);
          uint4 hq = make_uint4(h0.x, h0.y, h1.x, h1.y);
          const bf16x8 ah = *(bf16x8*)&hq;
          sc = __builtin_amdgcn_mfma_f32_32x32x16_bf16(ah, qh[st], sc, 0, 0, 0);
          sc = __builtin_amdgcn_mfma_f32_32x32x16_bf16(ah, ql[st], sc, 0, 0, 0);
        }
        if (kq == 0) {
#pragma unroll
          for (int e = 0; e < 16; ++e) ga[e] = mkkey(sc[e], kt * 32 + (e & 3) + 8 * (e >> 2) + 4 * hl, 127);
          bitonic_sort_desc<16>(ga);
        } else {
#pragma unroll
          for (int e = 0; e < 16; ++e) gb[e] = mkkey(sc[e], kt * 32 + (e & 3) + 8 * (e >> 2) + 4 * hl, 127);
          bitonic_sort_desc<16>(gb);
        }
      }
      merge16(ga, gb);
      if (kh2 == 0) {
#pragma unroll
        for (int i = 0; i < 16; ++i) g0[i] = ga[i];
      } else {
        merge16(g0, ga);
      }
    }
    merge_partner(g0, 32);
    {
      int* dst = s_top + ((size_t)wm * 128 + wn * 64 + ni * 32 + r) * 16 + hl * 8;
      int4 w0, w1;
      int lo8[8], hi8[8];
#pragma unroll
      for (int i = 0; i < 8; ++i) { lo8[i] = g0[i]; hi8[i] = g0[8 + i]; asm volatile("" : "+v"(lo8[i]), "+v"(hi8[i])); }
      w0 = make_int4(hl ? hi8[0] : lo8[0], hl ? hi8[1] : lo8[1], hl ? hi8[2] : lo8[2], hl ? hi8[3] : lo8[3]);
      w1 = make_int4(hl ? hi8[4] : lo8[4], hl ? hi8[5] : lo8[5], hl ? hi8[6] : lo8[6], hl ? hi8[7] : lo8[7]);
      *(int4*)dst = w0; *(int4*)(dst + 4) = w1;
    }
  }
  __syncthreads();
  {
    const int tok = tid >> 1, sub = tid & 1;
    int k1[16], k2[16];
    {
      const int4* a = (const int4*)(s_top + (size_t)tok * 16);
      const int4* b = (const int4*)(s_top + (size_t)(128 + tok) * 16);
#pragma unroll
      for (int i = 0; i < 4; ++i) {
        const int4 x = a[i], y = b[i];
        k1[4 * i] = x.x; k1[4 * i + 1] = x.y; k1[4 * i + 2] = x.z; k1[4 * i + 3] = x.w;
        k2[4 * i] = y.x; k2[4 * i + 1] = y.y; k2[4 * i + 2] = y.z; k2[4 * i + 3] = y.w;
      }
    }
    float v1f[16], v2f[16];
#pragma unroll
    for (int i = 0; i < 16; ++i) { v1f[i] = __int_as_float(key2bits(k1[i])); v2f[i] = __int_as_float(key2bits(k2[i])); }
    int c[32];
    c[0] = sub ? mkkey(v1f[3] + v2f[3], 51, 255) : mkkey(v1f[0] + v2f[0], 0, 255);
    c[1] = sub ? mkkey(v1f[4] + v2f[0], 64, 255) : mkkey(v1f[0] + v2f[1], 1, 255);
    c[2] = sub ? mkkey(v1f[4] + v2f[1], 65, 255) : mkkey(v1f[0] + v2f[2], 2, 255);
    c[3] = sub ? mkkey(v1f[4] + v2f[2], 66, 255) : mkkey(v1f[0] + v2f[3], 3, 255);
    c[4] = sub ? mkkey(v1f[5] + v2f[0], 80, 255) : mkkey(v1f[0] + v2f[4], 4, 255);
    c[5] = sub ? mkkey(v1f[5] + v2f[1], 81, 255) : mkkey(v1f[0] + v2f[5], 5, 255);
    c[6] = sub ? mkkey(v1f[6] + v2f[0], 96, 255) : mkkey(v1f[0] + v2f[6], 6, 255);
    c[7] = sub ? mkkey(v1f[6] + v2f[1], 97, 255) : mkkey(v1f[0] + v2f[7], 7, 255);
    c[8] = sub ? mkkey(v1f[7] + v2f[0], 112, 255) : mkkey(v1f[0] + v2f[8], 8, 255);
    c[9] = sub ? mkkey(v1f[7] + v2f[1], 113, 255) : mkkey(v1f[0] + v2f[9], 9, 255);
    c[10] = sub ? mkkey(v1f[8] + v2f[0], 128, 255) : mkkey(v1f[0] + v2f[10], 10, 255);
    c[11] = sub ? mkkey(v1f[9] + v2f[0], 144, 255) : mkkey(v1f[0] + v2f[11], 11, 255);
    c[12] = sub ? mkkey(v1f[10] + v2f[0], 160, 255) : mkkey(v1f[0] + v2f[12], 12, 255);
    c[13] = sub ? mkkey(v1f[11] + v2f[0], 176, 255) : mkkey(v1f[0] + v2f[13], 13, 255);
    c[14] = sub ? mkkey(v1f[12] + v2f[0], 192, 255) : mkkey(v1f[0] + v2f[14], 14, 255);
    c[15] = sub ? mkkey(v1f[13] + v2f[0], 208, 255) : mkkey(v1f[0] + v2f[15], 15, 255);
    c[16] = sub ? mkkey(v1f[14] + v2f[0], 224, 255) : mkkey(v1f[1] + v2f[0], 16, 255);
    c[17] = sub ? mkkey(v1f[15] + v2f[0], 240, 255) : mkkey(v1f[1] + v2f[1], 17, 255);
    c[18] = sub ? (int)0x80000000 : mkkey(v1f[1] + v2f[2], 18, 255);
    c[19] = sub ? (int)0x80000000 : mkkey(v1f[1] + v2f[3], 19, 255);
    c[20] = sub ? (int)0x80000000 : mkkey(v1f[1] + v2f[4], 20, 255);
    c[21] = sub ? (int)0x80000000 : mkkey(v1f[1] + v2f[5], 21, 255);
    c[22] = sub ? (int)0x80000000 : mkkey(v1f[1] + v2f[6], 22, 255);
    c[23] = sub ? (int)0x80000000 : mkkey(v1f[1] + v2f[7], 23, 255);
    c[24] = sub ? (int)0x80000000 : mkkey(v1f[2] + v2f[0], 32, 255);
    c[25] = sub ? (int)0x80000000 : mkkey(v1f[2] + v2f[1], 33, 255);
    c[26] = sub ? (int)0x80000000 : mkkey(v1f[2] + v2f[2], 34, 255);
    c[27] = sub ? (int)0x80000000 : mkkey(v1f[2] + v2f[3], 35, 255);
    c[28] = sub ? (int)0x80000000 : mkkey(v1f[2] + v2f[4], 36, 255);
    c[29] = sub ? (int)0x80000000 : mkkey(v1f[3] + v2f[0], 48, 255);
    c[30] = sub ? (int)0x80000000 : mkkey(v1f[3] + v2f[1], 49, 255);
    c[31] = sub ? (int)0x80000000 : mkkey(v1f[3] + v2f[2], 50, 255);
    int h0[16], h1[16];
#pragma unroll
    for (int i = 0; i < 16; ++i) { h0[i] = c[i]; h1[i] = c[16 + i]; }
    bitonic_sort_desc<16>(h0); bitonic_sort_desc<16>(h1);
    merge16(h0, h1);
    merge_partner(h0, 1);
    float sv[16];
#pragma unroll
    for (int i = 0; i < 16; ++i) sv[i] = __int_as_float(key2bits(h0[i]));
    float den = 0.f;
#pragma unroll
    for (int i = 0; i < 16; ++i) den += __expf(sv[i] - sv[0]);
    const float inv = 1.f / den;
    int eo[8]; float go[8];
#pragma unroll
    for (int i = 0; i < 8; ++i) {
      int klo = h0[i], khi = h0[8 + i];
      asm volatile("" : "+v"(klo), "+v"(khi));
      const int kk = sub ? khi : klo;
      const int bits = key2bits(kk);
      const int code = bits & 255;
      const int ia = key2bits(s_top[(size_t)tok * 16 + (code >> 4)]) & 127;
      const int ib = key2bits(s_top[(size_t)(128 + tok) * 16 + (code & 15)]) & 127;
      eo[i] = ia * 128 + ib;
      go[i] = __expf(__int_as_float(bits) - sv[0]) * inv;
    }
    const size_t ob = ((size_t)(n0 + tok) * 8 + head) * 16 + sub * 8;
    *(int4*)(p.eidx + ob) = make_int4(eo[0], eo[1], eo[2], eo[3]);
    *(int4*)(p.eidx + ob + 4) = make_int4(eo[4], eo[5], eo[6], eo[7]);
    *(float4*)(p.egate + ob) = make_float4(go[0], go[1], go[2], go[3]);
    *(float4*)(p.egate + ob + 4) = make_float4(go[4], go[5], go[6], go[7]);
  }
}

__device__ __forceinline__ void ph_subkeys(const Params& p) {
  for (int i = blockIdx.x * 256 + threadIdx.x; i < 2 * 128 * 64; i += gridDim.x * 256) {
    const float v = (i < 8192) ? p.sk1[i] : p.sk2[i - 8192];
    const ushort_t hi = f2bf(v);
    p.skh[i] = hi;
    p.skl[i] = f2bf(v - bf2f(hi));
  }
}

__device__ __forceinline__ float dot16_fp8(const uint4 d, const float (&x)[16], float c) {
  const unsigned w[4] = {d.x, d.y, d.z, d.w};
#pragma unroll
  for (int i = 0; i < 4; ++i) {
    const f32x2_t lo = __builtin_amdgcn_cvt_pk_f32_fp8((int)w[i], false);
    const f32x2_t hi = __builtin_amdgcn_cvt_pk_f32_fp8((int)w[i], true);
    c = fmaf(lo.x, x[4 * i], c); c = fmaf(lo.y, x[4 * i + 1], c); c = fmaf(hi.x, x[4 * i + 2], c); c = fmaf(hi.y, x[4 * i + 3], c);
  }
  return c;
}
__device__ __forceinline__ void axpy16_fp8(const float cf, const uint4 u, float (&acc)[16]) {
  const unsigned w[4] = {u.x, u.y, u.z, u.w};
#pragma unroll
  for (int i = 0; i < 4; ++i) {
    const f32x2_t lo = __builtin_amdgcn_cvt_pk_f32_fp8((int)w[i], false);
    const f32x2_t hi = __builtin_amdgcn_cvt_pk_f32_fp8((int)w[i], true);
    acc[4 * i] = fmaf(cf, lo.x, acc[4 * i]); acc[4 * i + 1] = fmaf(cf, lo.y, acc[4 * i + 1]);
    acc[4 * i + 2] = fmaf(cf, hi.x, acc[4 * i + 2]); acc[4 * i + 3] = fmaf(cf, hi.y, acc[4 * i + 3]);
  }
}
constexpr int EX_NTOK = 4;
__device__ __forceinline__ void peer_chunk(const Params& p, const int lane, const int myex, const bool b5, const bool b4, const bool b3,
                                           const int (&ce)[8], const float (&cg)[8], const f32x2_t (&x2)[8], f32x2_t (&acc2)[8]) {
  drow_t d[8];
  urow_t u[8];
  float sd[8], su[8];
#pragma unroll
  for (int i = 0; i < 8; ++i) d[i] = *(const drow_t*)(p.ed8 + ((size_t)ce[i] * 64 + lane) * DROW_BYTES);
#pragma unroll
  for (int i = 0; i < 8; ++i) u[i] = *(const urow_t*)(p.eu8 + ((size_t)ce[i] * 64 + lane) * UROW_BYTES);
#pragma unroll
  for (int i = 0; i < 8; ++i) { sd[i] = p.ed_s[ce[i]]; su[i] = p.eu_s[ce[i]] * cg[i]; }
  float pr[8];
#pragma unroll
  for (int i = 0; i < 8; ++i) {
    f32x2_t dd[8];
    DEC_D(d[i], dd);
    f32x2_t a2 = {0.f, 0.f};
#pragma unroll
    for (int k = 0; k < 8; ++k) a2 = dd[k] * x2[k] + a2;
    pr[i] = (a2.x + a2.y) * sd[i];
  }
  float q4[4];
#pragma unroll
  for (int i = 0; i < 4; ++i) {
    const float snd = b5 ? pr[i] : pr[i + 4];
    const float kp = b5 ? pr[i + 4] : pr[i];
    q4[i] = kp + __shfl_xor(snd, 32);
  }
  float q2[2];
#pragma unroll
  for (int i = 0; i < 2; ++i) {
    const float snd = b4 ? q4[i] : q4[i + 2];
    const float kp = b4 ? q4[i + 2] : q4[i];
    q2[i] = kp + __shfl_xor(snd, 16);
  }
  float q1;
  {
    const float snd = b3 ? q2[0] : q2[1];
    const float kp = b3 ? q2[1] : q2[0];
    q1 = kp + __shfl_xor(snd, 8);
  }
  q1 += __shfl_xor(q1, 4);
  q1 += __shfl_xor(q1, 2);
  q1 += __shfl_xor(q1, 1);
  const float act = gelu_f(q1);
#pragma unroll
  for (int i = 0; i < 8; ++i) {
    const int src = ((i >> 2) & 1) * 32 + ((i >> 1) & 1) * 16 + (i & 1) * 8;
    const float cf = __int_as_float(__builtin_amdgcn_readlane(__float_as_int(act), src)) * su[i];
    const f32x2_t cf2 = {cf, cf};
    f32x2_t uu[8];
    DEC_U(u[i], uu);
#pragma unroll
    for (int k = 0; k < 8; ++k) acc2[k] = cf2 * uu[k] + acc2[k];
  }
}

#ifndef EX_SWEEP
#define EX_SWEEP 0
#endif
#if !EX_SWEEP
typedef __attribute__((ext_vector_type(8))) int v8i_t;
typedef __attribute__((ext_vector_type(4))) float f32x4_t;
__device__ __forceinline__ void sort128(int& v0, int& v1, const int lane) {
#pragma unroll
  for (int k = 2; k <= 128; k <<= 1) {
#pragma unroll
    for (int j = k >> 1; j > 0; j >>= 1) {
      if (j == 1) {
        const bool up = ((lane * 2) & k) == 0;
        const int mn = min(v0, v1), mx = max(v0, v1);
        v0 = up ? mn : mx;
        v1 = up ? mx : mn;
      } else {
        const int o0 = __shfl_xor(v0, j >> 1), o1 = __shfl_xor(v1, j >> 1);
        const bool up = ((lane * 2) & k) == 0;
        const bool lower = ((lane * 2) & j) == 0;
        const bool takemin = (up == lower);
        v0 = takemin ? min(v0, o0) : max(v0, o0);
        v1 = takemin ? min(v1, o1) : max(v1, o1);
      }
    }
  }
}
__device__ __forceinline__ void k_peer_experts(const int VB, char* smem, const Params& p, const ushort_t* __restrict__ hn) {
  const int lane = threadIdx.x & 63;
  const int wave = __builtin_amdgcn_readfirstlane(threadIdx.x >> 6);
  const int t = VB * 4 + wave;
  const int li = lane & 15, g = lane >> 4;
  char* sx = smem + wave * 1024;
  {
    const float* hrow = p.out + (size_t)t * DM + lane * 16;
    const float* wrow = p.ffn_norm_w + lane * 16;
    float4 hv[4], wv[4];
#pragma unroll
    for (int i = 0; i < 4; ++i) { hv[i] = *(const float4*)(hrow + i * 4); wv[i] = *(const float4*)(wrow + i * 4); }
    float ss = 0.f;
#pragma unroll
    for (int i = 0; i < 4; ++i) ss += hv[i].x * hv[i].x + hv[i].y * hv[i].y + hv[i].z * hv[i].z + hv[i].w * hv[i].w;
    ss = wave_sum(ss);
    const float rs = rsqrtf(ss * (1.f / DM) + EPS) * 16.f;
    int wq[4];
#pragma unroll
    for (int i = 0; i < 4; ++i) {
      int w = 0;
      w = __builtin_amdgcn_cvt_pk_fp8_f32(hv[i].x * rs * wv[i].x, hv[i].y * rs * wv[i].y, w, false);
      w = __builtin_amdgcn_cvt_pk_fp8_f32(hv[i].z * rs * wv[i].z, hv[i].w * rs * wv[i].w, w, true);
      wq[i] = w;
    }
    *(int4*)(sx + lane * 16) = make_int4(wq[0], wq[1], wq[2], wq[3]);
  }
  v8i_t xb[8];
#pragma unroll
  for (int st = 0; st < 8; ++st) {
    const int4 lo = *(const int4*)(sx + st * 128 + g * 16);
    const int4 hi = *(const int4*)(sx + st * 128 + 64 + g * 16);
    xb[st] = v8i_t{lo.x, lo.y, lo.z, lo.w, hi.x, hi.y, hi.z, hi.w};
  }
  f32x2_t acc2[8];
#pragma unroll
  for (int i = 0; i < 8; ++i) acc2[i] = f32x2_t{0.f, 0.f};
  int kq0, kq1;
  {
    const int2 ev = *(const int2*)(p.eidx + (size_t)t * 128 + lane * 2);
    kq0 = (ev.x << 7) | (lane * 2);
    kq1 = (ev.y << 7) | (lane * 2 + 1);
    sort128(kq0, kq1, lane);
  }
  const int ev0 = kq0 >> 7, ev1 = kq1 >> 7;
  const float sdv0 = p.ed_s[ev0], sdv1 = p.ed_s[ev1];
  const float suv0 = p.eu_s[ev0] * p.egate[(size_t)t * 128 + (kq0 & 127)], suv1 = p.eu_s[ev1] * p.egate[(size_t)t * 128 + (kq1 & 127)];
#pragma unroll 1
  for (int c = 0; c < 8; ++c) {
    const int lbase = c * 8;
    const int ea = __shfl(ev0, lbase + (li >> 1)), eb = __shfl(ev1, lbase + (li >> 1));
    const int e_lane = (li & 1) ? eb : ea;
    const unsigned char* arow = p.ed8 + (size_t)e_lane * 512 + g * 16;
    uint4 a[8];
#pragma unroll
    for (int st = 0; st < 8; ++st) a[st] = *(const uint4*)(arow + st * 64);
    urow_t u[16];
#pragma unroll
    for (int i = 0; i < 16; ++i) {
      const int ei_s = __builtin_amdgcn_readlane((i & 1) ? ev1 : ev0, lbase + (i >> 1));
      u[i] = *(const urow_t*)(p.eu8 + ((size_t)ei_s * 64 + lane) * UROW_BYTES);
    }
    const int mrow = 4 * g + (li & 3);
    const float sda = __shfl(sdv0, lbase + (mrow >> 1)), sdb = __shfl(sdv1, lbase + (mrow >> 1));
    const float sua = __shfl(suv0, lbase + (mrow >> 1)), sub = __shfl(suv1, lbase + (mrow >> 1));
    const float sd_m = (mrow & 1) ? sdb : sda, su_m = (mrow & 1) ? sub : sua;
    f32x4_t d4 = {0.f, 0.f, 0.f, 0.f};
#pragma unroll
    for (int st = 0; st < 8; ++st) {
      const v8i_t av = v8i_t{(int)a[st].x, (int)a[st].y, (int)a[st].z, (int)a[st].w, 0, 0, 0, 0};
      d4 = __builtin_amdgcn_mfma_scale_f32_16x16x128_f8f6f4(av, xb[st], d4, 4, 0, 0, 0x7f7f7f7f, 0, 0x7f7f7f7f);
    }
    const int rsel = li & 3;
    const float dsel = rsel == 0 ? d4[0] : rsel == 1 ? d4[1] : rsel == 2 ? d4[2] : d4[3];
    const float cvs = gelu_fast(dsel * sd_m * 0.0625f) * su_m;
#pragma unroll
    for (int i = 0; i < 16; ++i) {
      const float cf = __int_as_float(__builtin_amdgcn_readlane(__float_as_int(cvs), 16 * (i >> 2) + (i & 3)));
      const f32x2_t cf2 = {cf, cf};
      f32x2_t uu[8];
      DEC_U(u[i], uu);
#pragma unroll
      for (int k = 0; k < 8; ++k) acc2[k] = cf2 * uu[k] + acc2[k];
    }
  }
  float* orow = p.out + (size_t)t * DM + lane * 16;
#pragma unroll
  for (int i = 0; i < 4; ++i) {
    float4 hv = *(float4*)(orow + i * 4);
    hv.x += acc2[2 * i].x; hv.y += acc2[2 * i].y; hv.z += acc2[2 * i + 1].x; hv.w += acc2[2 * i + 1].y;
    *(float4*)(orow + i * 4) = hv;
  }
}

__device__ __forceinline__ void ex2_loadA(uint4 (&a)[8], const Params& p, const unsigned short* sidx, const int s, const int li, const int g) {
  const int c = s >> 3, k = s & 7;
  const int e0 = sidx[k * 128 + c * 16 + (li >> 1)], e1 = sidx[k * 128 + c * 16 + 8 + (li >> 1)];
  const unsigned char* r0 = p.ed8 + (size_t)e0 * 512 + (li & 1) * 64 + g * 16;
  const unsigned char* r1 = p.ed8 + (size_t)e1 * 512 + (li & 1) * 64 + g * 16;
#pragma unroll
  for (int q = 0; q < 4; ++q) { a[q] = *(const uint4*)(r0 + q * 128); a[4 + q] = *(const uint4*)(r1 + q * 128); }
}
__device__ __forceinline__ void ex2_down(const uint4 (&a)[8], const char* sx, float* scf, const float* ssd, const int s, const int li, const int g) {
  const int c = s >> 3, k = s & 7;
  const char* sxk = sx + k * 1024 + (li & 1) * 128 + g * 16;
  f32x4_t d0 = {0.f, 0.f, 0.f, 0.f}, d1 = {0.f, 0.f, 0.f, 0.f};
#pragma unroll
  for (int q = 0; q < 4; ++q) {
    const int4 lo = *(const int4*)(sxk + q * 256);
    const int4 hi = *(const int4*)(sxk + q * 256 + 64);
    const v8i_t xb = v8i_t{lo.x, lo.y, lo.z, lo.w, hi.x, hi.y, hi.z, hi.w};
    const v8i_t a0 = v8i_t{(int)a[q].x, (int)a[q].y, (int)a[q].z, (int)a[q].w, 0, 0, 0, 0};
    const v8i_t a1 = v8i_t{(int)a[4 + q].x, (int)a[4 + q].y, (int)a[4 + q].z, (int)a[4 + q].w, 0, 0, 0, 0};
    d0 = __builtin_amdgcn_mfma_scale_f32_16x16x128_f8f6f4(a0, xb, d0, 4, 0, 0, 0x7f7f7f7f, 0, 0x7f7f7f7f);
    d1 = __builtin_amdgcn_mfma_scale_f32_16x16x128_f8f6f4(a1, xb, d1, 4, 0, 0, 0x7f7f7f7f, 0, 0x7f7f7f7f);
  }
  const bool odd = (li & 1) != 0;
  float t00 = odd ? d0[1] : d0[0], t01 = odd ? d0[3] : d0[2], t10 = odd ? d1[1] : d1[0], t11 = odd ? d1[3] : d1[2];
  t00 += __shfl_xor(t00, 1); t01 += __shfl_xor(t01, 1); t10 += __shfl_xor(t10, 1); t11 += __shfl_xor(t11, 1);
  const bool eh = (li & 2) != 0, jj = (li & 4) != 0;
  const float dsel = eh ? (jj ? t11 : t10) : (jj ? t01 : t00);
  const int mexp = (eh ? 8 : 0) + 2 * g + (jj ? 1 : 0);
  const float sd_m = ssd[k * 128 + c * 16 + mexp], su_m = scf[k * 128 + c * 16 + mexp];
  const float cvs = gelu_fast(dsel * sd_m * 0.0625f) * su_m;
  if ((li & 9) == 0) scf[k * 128 + c * 16 + mexp] = cvs;
}
__device__ __forceinline__ void ex2_loadU(urow_t (&u)[16], float& cv, const Params& p, const unsigned short* sidx, const float* scf, const int k, const int c,
                                          const int li, const int lane) {
  const int iv = sidx[k * 128 + c * 16 + li];
  cv = scf[k * 128 + c * 16 + li];
#pragma unroll
  for (int i = 0; i < 16; ++i) {
    const int ei_s = __builtin_amdgcn_readlane(iv, i);
    u[i] = *(const urow_t*)(p.eu8 + ((size_t)ei_s * 64 + lane) * UROW_BYTES);
  }
}
__device__ __forceinline__ void ex2_up(const urow_t (&u)[16], const float cv, f32x2_t (&acc)[8]) {
#pragma unroll
  for (int i = 0; i < 16; ++i) {
    const float cf = __int_as_float(__builtin_amdgcn_readlane(__float_as_int(cv), i));
    const f32x2_t cf2 = {cf, cf};
    f32x2_t uu[8];
    DEC_U(u[i], uu);
#pragma unroll
    for (int q = 0; q < 8; ++q) acc[q] = cf2 * uu[q] + acc[q];
  }
}
__device__ __forceinline__ void k_peer_experts2(const int VB, char* smem, const Params& p) {
  const int lane = threadIdx.x & 63;
  const int wave = __builtin_amdgcn_readfirstlane(threadIdx.x >> 6);
  const int li = lane & 15, g = lane >> 4;
  char* sx = smem + wave * 18432;
  float* scf = (float*)(sx + 8192);
  float* ssd = (float*)(sx + 12288);
  unsigned short* sidx = (unsigned short*)(sx + 16384);
  const int tbase = VB * 4 + wave;
  {
    float4 wv[4];
    float4 hv[8][4];
    int2 evr[8];
#pragma unroll
    for (int i = 0; i < 4; ++i) wv[i] = *(const float4*)(p.ffn_norm_w + lane * 16 + i * 4);
#pragma unroll
    for (int k = 0; k < 8; ++k) {
      const int t = tbase + k * (NT / 8);
#pragma unroll
      for (int i = 0; i < 4; ++i) hv[k][i] = *(const float4*)(p.out + (size_t)t * DM + lane * 16 + i * 4);
      evr[k] = *(const int2*)(p.eidx + (size_t)t * 128 + lane * 2);
    }
    float gsd0[8], gsd1[8], gsu0[8], gsu1[8], gg0[8], gg1[8];
#pragma unroll
    for (int k = 0; k < 8; ++k) {
      const int t = tbase + k * (NT / 8);
      float ss = 0.f;
#pragma unroll
      for (int i = 0; i < 4; ++i) ss += hv[k][i].x * hv[k][i].x + hv[k][i].y * hv[k][i].y + hv[k][i].z * hv[k][i].z + hv[k][i].w * hv[k][i].w;
      ss = wave_sum(ss);
      const float rs = rsqrtf(ss * (1.f / DM) + EPS) * 16.f;
      int wq[4];
#pragma unroll
      for (int i = 0; i < 4; ++i) {
        int w = 0;
        w = __builtin_amdgcn_cvt_pk_fp8_f32(hv[k][i].x * rs * wv[i].x, hv[k][i].y * rs * wv[i].y, w, false);
        w = __builtin_amdgcn_cvt_pk_fp8_f32(hv[k][i].z * rs * wv[i].z, hv[k][i].w * rs * wv[i].w, w, true);
        wq[i] = w;
      }
      *(int4*)(sx + k * 1024 + lane * 16) = make_int4(wq[0], wq[1], wq[2], wq[3]);
      int kq0 = (evr[k].x << 7) | (lane * 2), kq1 = (evr[k].y << 7) | (lane * 2 + 1);
      sort128(kq0, kq1, lane);
      const int ev0 = kq0 >> 7, ev1 = kq1 >> 7;
      gsd0[k] = p.ed_s[ev0]; gsd1[k] = p.ed_s[ev1];
      gsu0[k] = p.eu_s[ev0]; gsu1[k] = p.eu_s[ev1];
      gg0[k] = p.egate[(size_t)t * 128 + (kq0 & 127)]; gg1[k] = p.egate[(size_t)t * 128 + (kq1 & 127)];
      *(unsigned*)(sidx + k * 128 + lane * 2) = (unsigned)ev0 | ((unsigned)ev1 << 16);
    }
#pragma unroll
    for (int k = 0; k < 8; ++k) {
      *(float2*)(ssd + k * 128 + lane * 2) = make_float2(gsd0[k], gsd1[k]);
      *(float2*)(scf + k * 128 + lane * 2) = make_float2(gsu0[k] * gg0[k], gsu1[k] * gg1[k]);
    }
  }
  asm volatile("s_waitcnt lgkmcnt(0)" ::: "memory");
  {
    uint4 aA[8], aB[8];
    ex2_loadA(aA, p, sidx, 0, li, g);
#pragma unroll 1
    for (int s2 = 0; s2 < 32; ++s2) {
      ex2_loadA(aB, p, sidx, 2 * s2 + 1, li, g);
      asm volatile("" ::: "memory");
      ex2_down(aA, sx, scf, ssd, 2 * s2, li, g);
      asm volatile("" ::: "memory");
      ex2_loadA(aA, p, sidx, min(2 * s2 + 2, 63), li, g);
      asm volatile("" ::: "memory");
      ex2_down(aB, sx, scf, ssd, 2 * s2 + 1, li, g);
      asm volatile("" ::: "memory");
    }
  }
  asm volatile("s_waitcnt lgkmcnt(0)" ::: "memory");
#pragma unroll 1
  for (int r = 0; r < 2; ++r) {
    f32x2_t acc2[4][8];
#pragma unroll
    for (int kk = 0; kk < 4; ++kk)
#pragma unroll
      for (int i = 0; i < 8; ++i) acc2[kk][i] = f32x2_t{0.f, 0.f};
    urow_t uA[16], uB[16];
    float cvA, cvB;
    ex2_loadU(uA, cvA, p, sidx, scf, r * 4, 0, li, lane);
#pragma unroll 1
    for (int c = 0; c < 8; ++c) {
      ex2_loadU(uB, cvB, p, sidx, scf, r * 4 + 1, c, li, lane);
      ex2_up(uA, cvA, acc2[0]);
      ex2_loadU(uA, cvA, p, sidx, scf, r * 4 + 2, c, li, lane);
      ex2_up(uB, cvB, acc2[1]);
      ex2_loadU(uB, cvB, p, sidx, scf, r * 4 + 3, c, li, lane);
      ex2_up(uA, cvA, acc2[2]);
      ex2_loadU(uA, cvA, p, sidx, scf, r * 4, min(c + 1, 7), li, lane);
      ex2_up(uB, cvB, acc2[3]);
    }
#pragma unroll
    for (int kk = 0; kk < 4; ++kk) {
      const int t = tbase + (r * 4 + kk) * (NT / 8);
      float* orow = p.out + (size_t)t * DM + lane * 16;
#pragma unroll
      for (int i = 0; i < 4; ++i) {
        float4 hv = *(float4*)(orow + i * 4);
        hv.x += acc2[kk][2 * i].x; hv.y += acc2[kk][2 * i].y; hv.z += acc2[kk][2 * i + 1].x; hv.w += acc2[kk][2 * i + 1].y;
        *(float4*)(orow + i * 4) = hv;
      }
    }
  }
}
#define EX_TOK_PER_VB 4
#else
#define EX_TOK_PER_VB (4 * EX_NTOK)
__device__ __forceinline__ void k_peer_experts(const int VB, const Params& p, const ushort_t* __restrict__ hn) {
  const int lane = threadIdx.x & 63;
  const int wave = __builtin_amdgcn_readfirstlane(threadIdx.x >> 6);
  const int t0 = (VB * 4 + wave) * EX_NTOK;
  const int myex = ((lane >> 5) & 1) * 4 + ((lane >> 4) & 1) * 2 + ((lane >> 3) & 1);
  const bool b5 = (lane & 32) != 0, b4 = (lane & 16) != 0, b3 = (lane & 8) != 0;
  f32x2_t x2[EX_NTOK][8], acc2[EX_NTOK][8];
  int e0[EX_NTOK], e1[EX_NTOK];
  float g0[EX_NTOK], g1[EX_NTOK];
#pragma unroll
  for (int k = 0; k < EX_NTOK; ++k) {
    float f0[8], f1[8];
    unpack8(*(const uint4*)(hn + (size_t)(t0 + k) * DM + lane * 16), f0);
    unpack8(*(const uint4*)(hn + (size_t)(t0 + k) * DM + lane * 16 + 8), f1);
#pragma unroll
    for (int i = 0; i < 4; ++i) {
      x2[k][i] = f32x2_t{f0[2 * i], f0[2 * i + 1]};
      x2[k][4 + i] = f32x2_t{f1[2 * i], f1[2 * i + 1]};
    }
#pragma unroll
    for (int i = 0; i < 8; ++i) acc2[k][i] = f32x2_t{0.f, 0.f};
    e0[k] = p.eidx[(size_t)(t0 + k) * 128 + lane];
    e1[k] = p.eidx[(size_t)(t0 + k) * 128 + 64 + lane];
    g0[k] = p.egate[(size_t)(t0 + k) * 128 + lane];
    g1[k] = p.egate[(size_t)(t0 + k) * 128 + 64 + lane];
  }
#pragma unroll 1
  for (int s = 0; s < 16; ++s) {
#pragma unroll
    for (int k = 0; k < EX_NTOK; ++k) {
      unsigned long long m0 = __ballot((e0[k] >> 10) == s);
      unsigned long long m1 = __ballot((e1[k] >> 10) == s);
      while ((m0 | m1) != 0ull) {
        int ce[8];
        float cg[8];
#pragma unroll
        for (int i = 0; i < 8; ++i) {
          int ev = 0;
          float gv = 0.f;
          if (m0 != 0ull) {
            const int ln = __builtin_ctzll(m0);
            m0 &= m0 - 1ull;
            ev = __builtin_amdgcn_readlane(e0[k], ln);
            gv = __int_as_float(__builtin_amdgcn_readlane(__float_as_int(g0[k]), ln));
          } else if (m1 != 0ull) {
            const int ln = __builtin_ctzll(m1);
            m1 &= m1 - 1ull;
            ev = __builtin_amdgcn_readlane(e1[k], ln);
            gv = __int_as_float(__builtin_amdgcn_readlane(__float_as_int(g1[k]), ln));
          }
          ce[i] = ev;
          cg[i] = gv;
        }
        peer_chunk(p, lane, myex, b5, b4, b3, ce, cg, x2[k], acc2[k]);
      }
    }
  }
#pragma unroll
  for (int k = 0; k < EX_NTOK; ++k) {
    float* orow = p.out + (size_t)(t0 + k) * DM + lane * 16;
#pragma unroll
    for (int i = 0; i < 4; ++i) {
      float4 hv = *(float4*)(orow + i * 4);
      hv.x += acc2[k][2 * i].x; hv.y += acc2[k][2 * i].y; hv.z += acc2[k][2 * i + 1].x; hv.w += acc2[k][2 * i + 1].y;
      *(float4*)(orow + i * 4) = hv;
    }
  }
}

#endif

#define PHASE(NBLK, CALL) \
  for (int VB = blockIdx.x; VB < (NBLK); VB += gridDim.x) { CALL; __syncthreads(); }
#define PHASE_NS(NBLK, CALL) \
  for (int VB = blockIdx.x; VB < (NBLK); VB += gridDim.x) { CALL; }
#define PHASE_OFF(OFF, NBLK, CALL) \
  for (int VB = (int)((blockIdx.x + gridDim.x - ((OFF) % gridDim.x)) % gridDim.x); VB < (NBLK); VB += gridDim.x) { CALL; __syncthreads(); }

__global__ __launch_bounds__(256, 2) void fwd_megakernel(Params p) {
  __shared__ __attribute__((aligned(16))) char smem_raw[SMEM_BYTES];
  float* smem = (float*)smem_raw;
  volatile LAS unsigned* xb_st = (volatile LAS unsigned*)(smem_raw + 73728);
  if (threadIdx.x == 0) { xb_st[0] = 0u; xb_st[1] = 0u; xb_st[2] = 0u; xb_st[3] = 0u; }
  __syncthreads();
  const XcdBarrier xb = xcd_barrier_post(p.bar, xb_st);
  {
    for (int k = threadIdx.x; k < DM; k += 256) {
      const float* wr = p.w_in + (size_t)k * INC + 1536;
      const float4 a = *(const float4*)(wr), b = *(const float4*)(wr + 4);
      smem[0 * 1024 + k] = a.x; smem[1 * 1024 + k] = a.y; smem[2 * 1024 + k] = a.z; smem[3 * 1024 + k] = a.w;
      smem[4 * 1024 + k] = b.x; smem[5 * 1024 + k] = b.y; smem[6 * 1024 + k] = b.z; smem[7 * 1024 + k] = b.w;
    }
    __syncthreads();
    PHASE_NS(NT / 8, ph_rmsnorm_bf16(VB, p.x, p.mix_norm_w, p.xn_b, smem, p.dt_bias, p.dt));
    __syncthreads();
  }
  PHASE_NS(NB * MEM / 8, ph_rmsnorm_bf16(VB, p.mem, p.mem_norm_w, p.memn_b, nullptr, nullptr, nullptr));
  PHASE(16 * 40, ph_wtrans(VB, smem, p.w_in, INC, p.w_inT, 40, 8, nullptr));
  PHASE(16 * 16, ph_wtrans(VB, smem, p.w_out, DM, p.w_outT, 16, 0, nullptr));
  PHASE(16 * 16, ph_wtrans(VB, smem, p.w_query, DM, p.w_qT, 16, 0, p.ffn_norm_w));
  PHASE(16 * 8, ph_wtrans(VB, smem, p.w_mem_kv, 512, p.w_memT, 8, 0, nullptr));
  if (blockIdx.x == 0) p.bcnt[threadIdx.x] = 0;
  ph_subkeys(p);
  xcd_barrier(xb);
  PHASE_NS(NB * 64 * 8 / 4, ph_acs(VB, p));
  PHASE(20 * (NT / 128), ph_gemm_proj(VB, smem_raw, p));
  xcd_barrier(xb);
  PHASE(NB * 64 * 8, ph_ssd1(VB, smem_raw, p));
  PHASE(NB * 4 * 32, k_gate(VB, smem_raw, p));
  PHASE_OFF(256, 4 * (NB * MEM / 128), ph_gemm_mem(VB, smem_raw, p));
  xcd_barrier(xb);
  PHASE_NS(NB * 8 * 64 * 128 / 256, ph_ssd2(VB, p));
  {
    int* s_pref = (int*)(smem_raw + 72192);
    {
      const int tid = threadIdx.x;
      int v = (p.bcnt[tid] + 127) >> 7;
      const int lane = tid & 63;
#pragma unroll
      for (int o = 1; o < 64; o <<= 1) { int nb = __shfl_up(v, o); if (lane >= o) v += nb; }
      int* s_wt = s_pref + 256;
      if (lane == 63) s_wt[tid >> 6] = v;
      __syncthreads();
      int add = 0;
      for (int ww = 0; ww < (tid >> 6); ++ww) add += s_wt[ww];
      s_pref[tid] = v + add;
      __syncthreads();
    }
    const int Ug = s_pref[255];
    ph_attn_units(smem_raw, p, Ug, s_pref);
    __syncthreads();
  }
  xcd_barrier(xb);
  PHASE(NB * 64 * 2, ph_ssd3(VB, smem_raw, p));
  if (gridDim.x >= 512) {
    for (int VB = (int)blockIdx.x - 256; VB >= 0 && VB < NT * 4 * 8 / 256; VB += gridDim.x - 256) ph_attn_combine(VB, p);
  } else {
    PHASE_NS(NT * 4 * 8 / 256, ph_attn_combine(VB, p));
  }
  xcd_barrier(xb);
  PHASE(8 * (NT / 128), ph_gemm_f32(VB, smem_raw, p.mixed_b, p.w_outT, p.out, p.x, p.xn_b, p.hss));
  xcd_barrier(xb);
  ushort_t* hn_b = p.xn_b;
  {
    int cv = blockIdx.x;
    for (int VB = blockIdx.x; VB < 8 * (NT / 128); VB += gridDim.x) {
      ph_gemm_route(VB, smem_raw, p, hn_b);
      __syncthreads();
      for (int i = 0; i < 8 && cv < 8192; ++i, cv += gridDim.x) {
        if (cv < 4096) {
#if EX_FP4_DOWN
          ph_cvt4(cv, p.e_down, p.ed8, p.ed_s);
#else
          ph_cvt8(cv, p.e_down, p.ed8, p.ed_s);
#endif
        } else {
#if EX_FP4_UP
          ph_cvt4(cv - 4096, p.e_up, p.eu8, p.eu_s);
#else
          ph_cvt8(cv - 4096, p.e_up, p.eu8, p.eu_s);
#endif
        }
      }
    }
    for (; cv < 8192; cv += gridDim.x) {
      if (cv < 4096) {
#if EX_FP4_DOWN
        ph_cvt4(cv, p.e_down, p.ed8, p.ed_s);
#else
        ph_cvt8(cv, p.e_down, p.ed8, p.ed_s);
#endif
      } else {
#if EX_FP4_UP
        ph_cvt4(cv - 4096, p.e_up, p.eu8, p.eu_s);
#else
        ph_cvt8(cv - 4096, p.e_up, p.eu8, p.eu_s);
#endif
      }
    }
  }
  xcd_barrier(xb);
  PHASE_NS(NT / 32, k_peer_experts2(VB, smem_raw, p));
}
}

extern "C" void kernel_launch(void* const* d_in, const int* in_sizes, int n_in, void* d_out, int out_size, void* d_ws, size_t ws_size,
                              hipStream_t stream) {
  Params p{};
  p.x = (const float*)d_in[0]; p.mem = (const float*)d_in[1]; p.mix_norm_w = (const float*)d_in[2]; p.w_in = (const float*)d_in[3];
  p.conv_w = (const float*)d_in[4]; p.conv_b = (const float*)d_in[5]; p.dt_bias = (const float*)d_in[6]; p.a_log = (const float*)d_in[7];
  p.ssd_d = (const float*)d_in[8]; p.ssd_norm_w = (const float*)d_in[9]; p.mq_norm_w = (const float*)d_in[10]; p.mk_norm_w = (const float*)d_in[11];
  p.mem_norm_w = (const float*)d_in[12]; p.w_mem_kv = (const float*)d_in[13]; p.xq_norm_w = (const float*)d_in[14]; p.xk_norm_w = (const float*)d_in[15];
  p.w_out = (const float*)d_in[16]; p.ffn_norm_w = (const float*)d_in[17]; p.w_query = (const float*)d_in[18]; p.sk1 = (const float*)d_in[19];
  p.sk2 = (const float*)d_in[20]; p.e_down = (const float*)d_in[21]; p.e_up = (const float*)d_in[22];
  p.out = (float*)d_out;
  char* ws = (char*)d_ws;
  size_t o = 0;
  auto take = [&](size_t bytes) { char* q = ws + o; o += (bytes + 255) & ~(size_t)255; return q; };
  p.xn_b = (ushort_t*)take((size_t)NT * DM * 2);
  p.xc = p.xn_b;
  p.w_inT = (ushort_t*)take((size_t)NPROJ * DM * 2);
  p.w_outT = (ushort_t*)take((size_t)DM * DM * 2);
  p.w_qT = (ushort_t*)take((size_t)DM * DM * 2);
  p.w_memT = (ushort_t*)take((size_t)512 * DM * 2);
  p.memn_b = (ushort_t*)take((size_t)NB * MEM * DM * 2);
  p.memk_b = (ushort_t*)take((size_t)NB * MEM * 256 * 2);
  p.memvT = (ushort_t*)take((size_t)NB * MEM * 256 * 2);
  char* regQ = take((size_t)NT * 2560 * 2);
  p.zs = (ushort_t*)regQ;
  p.xbc_raw = (ushort_t*)(regQ + (size_t)NT * 512 * 2);
  p.mq = (ushort_t*)(regQ + (size_t)NT * 1536 * 2);
  p.mk = (ushort_t*)(regQ + (size_t)NT * 1792 * 2);
  p.vT = (ushort_t*)(regQ + (size_t)NT * 2048 * 2);
  p.xq = (ushort_t*)(regQ + (size_t)NT * 2304 * 2);
  p.q = (float*)regQ;
  p.dt = (float*)take((size_t)NT * 8 * 4);
  p.acs = (float*)take((size_t)NT * 8 * 4);
  p.wdec = (float*)take((size_t)NT * 8 * 4);
  p.cdec = (float*)take((size_t)NB * 64 * 8 * 4);
  p.states = (float*)d_out;
  p.sin_b = (ushort_t*)((char*)d_out + (size_t)NB * 64 * 8 * 8192 * 4);
  p.xT = (ushort_t*)((char*)d_out + (size_t)NB * 64 * 8 * 8192 * 6);
  p.mixed_b = (ushort_t*)take((size_t)NT * DM * 2);
  p.kpart = (float*)take((size_t)NB * 4 * 32 * 4 * 64 * 4);
  p.bcnt = (int*)take(256 * 4);
  p.blist = (int*)take((size_t)256 * 8192 * 4);
  p.pm = (float*)take((size_t)NT * 16 * 4);
  p.pl = (float*)take((size_t)NT * 16 * 4);
  p.pO = p.xbc_raw;
  p.eidx = (int*)take((size_t)NT * 128 * 4);
  p.egate = (float*)take((size_t)NT * 128 * 4);
  p.ed8 = (unsigned char*)take((size_t)16384 * DM);
  p.eu8 = (unsigned char*)take((size_t)16384 * DM);
  p.ed_s = (float*)take(16384 * 4);
  p.eu_s = (float*)take(16384 * 4);
  p.bar = (unsigned*)take(XCD_BAR_WORDS * 4);
  p.hss = (float*)take((size_t)NT * 16 * 4);
  p.skh = (ushort_t*)take(2 * 128 * 64 * 2);
  p.skl = (ushort_t*)take(2 * 128 * 64 * 2);
  if (o > ws_size) return;
  (void)hipMemsetAsync(p.bar, 0, XCD_BAR_WORDS * 4, stream);
  static int grid_blocks = 0;
  if (!grid_blocks) {
    int dev = 0, cus = 0, per_cu = 0;
    (void)hipGetDevice(&dev);
    (void)hipDeviceGetAttribute(&cus, hipDeviceAttributeMultiprocessorCount, dev);
    (void)hipOccupancyMaxActiveBlocksPerMultiprocessor(&per_cu, fwd_megakernel, 256, 0);
    if (per_cu > 2) per_cu = 2;
    if (per_cu < 1) per_cu = 1;
    grid_blocks = cus * per_cu;
  }
  void* args[] = {&p};
  hipError_t e = hipLaunchCooperativeKernel((void*)fwd_megakernel, dim3(grid_blocks), dim3(256), args, 0, stream);
  if (e != hipSuccess) fprintf(stderr, "cooperative launch failed: %s (grid %d)\n", hipGetErrorString(e), grid_blocks);
}
```

```cpp
#include <hip/hip_runtime.h>
#include <hip/hip_cooperative_groups.h>
#include <cstdio>
#include <math.h>
#include <stdint.h>
namespace cg = cooperative_groups;

#ifndef EX_FP4_DOWN
#define EX_FP4_DOWN 1
#endif
#ifndef EX_FP4_UP
#define EX_FP4_UP 1
#endif
namespace {
typedef unsigned short ushort_t;
typedef __attribute__((ext_vector_type(8))) short bf16x8;
typedef __attribute__((ext_vector_type(16))) float f32x16;

constexpr int DM = 1024;
constexpr int NB = 2;
constexpr int SL = 8192;
constexpr int NT = NB * SL;
constexpr int MEM = 256;
constexpr int INC = 2568;
constexpr int NPROJ = 2560;
constexpr float EPS = 1e-6f;
constexpr int SMEM_BYTES = 73728 + 256;

typedef __attribute__((ext_vector_type(4))) float f32x4_nt;
__device__ __forceinline__ float4 ld_nt4(const float* ptr) {
  const f32x4_nt v = __builtin_nontemporal_load((const f32x4_nt*)ptr);
  return make_float4(v.x, v.y, v.z, v.w);
}
__device__ __forceinline__ float silu_f(float x) { return x * __frcp_rn(1.f + __expf(-x)); }
__device__ __forceinline__ float softplus_f(float x) { return fmaxf(x, 0.f) + log1pf(expf(-fabsf(x))); }
__device__ __forceinline__ float gelu_f(float x) { return 0.5f * x * (1.f + erff(x * 0.70710678118654752f)); }
__device__ __forceinline__ float gelu_fast(float x) {
  const float z = fabsf(x) * 0.70710678118654752f;
  const float t = __frcp_rn(fmaf(0.3275911f, z, 1.f));
  float pl = fmaf(1.061405429f, t, -1.453152027f);
  pl = fmaf(pl, t, 1.421413741f);
  pl = fmaf(pl, t, -0.284496736f);
  pl = fmaf(pl, t, 0.254829592f);
  const float er = 1.f - pl * t * __expf(-z * z);
  return 0.5f * x * (1.f + copysignf(er, x));
}
typedef __attribute__((ext_vector_type(2))) __bf16 bf16x2_hw;
typedef __attribute__((ext_vector_type(2))) float f32x2_hw;
__device__ __forceinline__ unsigned pack2(float a, float b) {
  const f32x2_hw v = {a, b};
  return __builtin_bit_cast(unsigned, __builtin_convertvector(v, bf16x2_hw));
}
__device__ __forceinline__ ushort_t f2bf(float x) { return (ushort_t)(pack2(x, 0.f) & 0xffffu); }
__device__ __forceinline__ float bf2f(ushort_t h) { return __uint_as_float(((unsigned)h) << 16); }
__device__ __forceinline__ float bflo(unsigned w) { return __uint_as_float(w << 16); }
__device__ __forceinline__ float bfhi(unsigned w) { return __uint_as_float(w & 0xffff0000u); }

__device__ __forceinline__ void unpack8(const uint4 v, float (&f)[8]) {
  f[0] = bflo(v.x); f[1] = bfhi(v.x); f[2] = bflo(v.y); f[3] = bfhi(v.y);
  f[4] = bflo(v.z); f[5] = bfhi(v.z); f[6] = bflo(v.w); f[7] = bfhi(v.w);
}

__device__ __forceinline__ float wave_sum(float v) {
#pragma unroll
  for (int o = 32; o > 0; o >>= 1) v += __shfl_xor(v, o);
  return v;
}
__device__ __forceinline__ float wave_max(float v) {
#pragma unroll
  for (int o = 32; o > 0; o >>= 1) v = fmaxf(v, __shfl_xor(v, o));
  return v;
}


#define XB_TMO      128
#define XB_XCNT(j)  (256  + 64 * (j))
#define XB_XSUB(j)  (1280 + 64 * (j))
#define XB_XGEN(j)  (2304 + 64 * (j))
#define XB_TOP      3328
#define XB_TOPGEN   3392
#define XCD_BAR_WORDS 3456
#define XB_SPIN_CAP (1u << 20)
#define LAS __attribute__((address_space(3)))
__device__ __forceinline__ unsigned xb_ld(unsigned* p)              { return __hip_atomic_load(p, __ATOMIC_RELAXED, __HIP_MEMORY_SCOPE_AGENT); }
__device__ __forceinline__ unsigned xb_add(unsigned* p, unsigned v) { return __hip_atomic_fetch_add(p, v, __ATOMIC_RELAXED, __HIP_MEMORY_SCOPE_AGENT); }
__device__ __forceinline__ unsigned xb_xcc_id() { return (unsigned)__builtin_amdgcn_s_getreg((3 << 11) | 20) & 0xFu; }
#define XB_SPIN(cond, bar) do { unsigned _sp = 0; while (cond) { __builtin_amdgcn_s_sleep(1); \
    if ((++_sp & 255u) == 0u) { if (xb_ld(&(bar)[XB_TMO])) break; if (_sp > XB_SPIN_CAP) { atomicAdd(&(bar)[XB_TMO], 1u); break; } } } } while (0)
struct XcdBarrier { unsigned* bar; unsigned x; volatile LAS unsigned* st; };
__device__ __forceinline__ XcdBarrier xcd_barrier_post(unsigned* bar, volatile LAS unsigned* st) {
  XcdBarrier b; b.bar = bar; b.x = xb_xcc_id(); b.st = st;
  if (threadIdx.x == 0) (void)xb_add(&bar[XB_XCNT(b.x)], 1u);
  return b;
}
__device__ __forceinline__ void xcd_barrier_complete(unsigned* bar, unsigned x, unsigned& nloc, unsigned& nx) {
  const unsigned G = gridDim.x * gridDim.y * gridDim.z;
  unsigned sum, cnt, mine, sp = 0u;
  for (;;) {
    sum = 0u; cnt = 0u; mine = 0u;
#pragma unroll
    for (unsigned j = 0; j < 16; ++j) { const unsigned c = xb_ld(&bar[XB_XCNT(j)]); sum += c; cnt += (c > 0u) ? 1u : 0u; mine = (j == x) ? c : mine; }
    if (sum == G) break;
    __builtin_amdgcn_s_sleep(1);
    if ((++sp & 255u) == 0u) { if (xb_ld(&bar[XB_TMO])) break; if (sp > XB_SPIN_CAP) { atomicAdd(&bar[XB_TMO], 1u); break; } }
  }
  nloc = mine > 0u ? mine : 1u; nx = cnt > 0u ? cnt : 1u;
}
__device__ __forceinline__ void xcd_barrier(const XcdBarrier& b) {
  asm volatile("s_waitcnt vmcnt(0)" ::: "memory");
  __syncthreads();
  if (threadIdx.x == 0) {
    unsigned* bar = b.bar;
    __builtin_amdgcn_s_waitcnt(0);
    unsigned nloc = b.st[0], nx = b.st[1];
    if (nloc == 0u) { xcd_barrier_complete(bar, b.x, nloc, nx); b.st[0] = nloc; b.st[1] = nx; }
    const unsigned old = xb_add(&bar[XB_XSUB(b.x)], 1u);
    const unsigned gen = old / nloc;
    if (old + 1u == (gen + 1u) * nloc) {
      __builtin_amdgcn_fence(__ATOMIC_RELEASE, "agent");
      asm volatile("s_waitcnt vmcnt(0)" ::: "memory");
      const unsigned og = xb_add(&bar[XB_TOP], 1u);
      const unsigned tg = og / nx;
      if (og + 1u == (tg + 1u) * nx) xb_add(&bar[XB_TOPGEN], 1u);
      else XB_SPIN(xb_ld(&bar[XB_TOPGEN]) == tg, bar);
      __builtin_amdgcn_fence(__ATOMIC_ACQUIRE, "agent");
      xb_add(&bar[XB_XGEN(b.x)], 1u);
      asm volatile("s_waitcnt vmcnt(0)" ::: "memory");
    } else {
      XB_SPIN(xb_ld(&bar[XB_XGEN(b.x)]) == gen, bar);
      __builtin_amdgcn_fence(__ATOMIC_ACQUIRE, "agent");
      asm volatile("s_waitcnt vmcnt(0)" ::: "memory");
    }
  }
  __syncthreads();
}

struct Params {
  const float *x, *mem, *mix_norm_w, *w_in, *conv_w, *conv_b, *dt_bias, *a_log, *ssd_d, *ssd_norm_w, *mq_norm_w, *mk_norm_w,
      *mem_norm_w, *w_mem_kv, *xq_norm_w, *xk_norm_w, *w_out, *ffn_norm_w, *w_query, *sk1, *sk2, *e_down, *e_up;
  float* out;
  ushort_t *xn_b, *w_inT, *w_outT, *w_qT, *w_memT, *memn_b, *zs, *xbc_raw, *mq, *mk, *xq, *memk_b, *mixed_b;
  float *dt, *q, *egate, *acs, *cdec, *states, *wdec;
  ushort_t *xc, *xT, *sin_b;
  int *eidx, *bcnt, *blist;
  unsigned* bar;
  float* hss;
  ushort_t *skh, *skl;
  unsigned char *ed8, *eu8;
  float *ed_s, *eu_s;
  float *kpart, *pm, *pl;
  ushort_t *vT, *memvT, *pO;
};

__device__ __forceinline__ void ph_rmsnorm_bf16(const int vb, const float* __restrict__ x, const float* __restrict__ w,
                                                ushort_t* __restrict__ outb, const float* s_wdt  , const float* __restrict__ dt_bias,
                                                float* __restrict__ dt) {
  const int lane = threadIdx.x & 63;
  const int row0 = vb * 8 + (threadIdx.x >> 6) * 2;
  float4 v[2][4];
#pragma unroll
  for (int rr = 0; rr < 2; ++rr)
#pragma unroll
    for (int i = 0; i < 4; ++i) v[rr][i] = ld_nt4(x + (size_t)(row0 + rr) * DM + i * 256 + lane * 4);
  float4 ww[4];
#pragma unroll
  for (int i = 0; i < 4; ++i) ww[i] = *(const float4*)(w + i * 256 + lane * 4);
#pragma unroll
  for (int rr = 0; rr < 2; ++rr) {
    const int row = row0 + rr;
    float ss = 0.f;
#pragma unroll
    for (int i = 0; i < 4; ++i) ss += v[rr][i].x * v[rr][i].x + v[rr][i].y * v[rr][i].y + v[rr][i].z * v[rr][i].z + v[rr][i].w * v[rr][i].w;
    ss = wave_sum(ss);
    const float r = rsqrtf(ss / DM + EPS);
    float part[8];
#pragma unroll
    for (int hh = 0; hh < 8; ++hh) part[hh] = 0.f;
#pragma unroll
    for (int i = 0; i < 4; ++i) {
      const float o0 = v[rr][i].x * r * ww[i].x, o1 = v[rr][i].y * r * ww[i].y, o2 = v[rr][i].z * r * ww[i].z, o3 = v[rr][i].w * r * ww[i].w;
      *(uint2*)(outb + (size_t)row * DM + i * 256 + lane * 4) = make_uint2(pack2(o0, o1), pack2(o2, o3));
      if (dt) {
        const float xs[4] = {o0, o1, o2, o3};
#pragma unroll
        for (int hh = 0; hh < 8; ++hh) {
          const float4 wv = *(const float4*)(s_wdt + hh * 1024 + i * 256 + lane * 4);
          part[hh] = fmaf(xs[0], wv.x, part[hh]); part[hh] = fmaf(xs[1], wv.y, part[hh]);
          part[hh] = fmaf(xs[2], wv.z, part[hh]); part[hh] = fmaf(xs[3], wv.w, part[hh]);
        }
      }
    }
    if (dt) {
      float mine = 0.f;
#pragma unroll
      for (int hh = 0; hh < 8; ++hh) {
        const float sfull = wave_sum(part[hh]);
        if (lane == hh) mine = sfull;
      }
      if (lane < 8) dt[(size_t)row * 8 + lane] = softplus_f(mine + dt_bias[lane]);
    }
  }
}

__device__ __forceinline__ void ph_wtrans(const int vb, float* smem, const float* __restrict__ W, const int ldw, ushort_t* __restrict__ Wt,
                                          const int ntiles, const int skip, const float* __restrict__ rowscale) {
  float (*s)[65] = (float (*)[65])smem;
  const int tid = threadIdx.x;
  const int kt = vb / ntiles, nt = vb % ntiles;
  const int nd0 = nt * 64;
  const int ns0 = (nd0 < 1536) ? nd0 : nd0 + skip;
  {
    const int k = tid >> 2, nc = (tid & 3) * 16;
    const float* src = W + (size_t)(kt * 64 + k) * ldw + ns0 + nc;
    const float rsc = rowscale ? rowscale[kt * 64 + k] : 1.f;
#pragma unroll
    for (int j = 0; j < 4; ++j) {
      float4 v = *(const float4*)(src + j * 4);
      v.x *= rsc; v.y *= rsc; v.z *= rsc; v.w *= rsc;
      s[k][nc + j * 4 + 0] = v.x; s[k][nc + j * 4 + 1] = v.y; s[k][nc + j * 4 + 2] = v.z; s[k][nc + j * 4 + 3] = v.w;
    }
  }
  __syncthreads();
  {
    const int n = tid >> 2, kc = (tid & 3) * 16;
    unsigned pk[8];
#pragma unroll
    for (int j = 0; j < 8; ++j) pk[j] = pack2(s[kc + 2 * j][n], s[kc + 2 * j + 1][n]);
    ushort_t* dst = Wt + (size_t)(nd0 + n) * DM + kt * 64 + kc;
    *(uint4*)(dst) = make_uint4(pk[0], pk[1], pk[2], pk[3]);
    *(uint4*)(dst + 8) = make_uint4(pk[4], pk[5], pk[6], pk[7]);
  }
}

__device__ __forceinline__ void ph_cvt(const int vb, const float* __restrict__ src, ushort_t* __restrict__ dst) {
  const size_t base = (size_t)vb * 8192 + threadIdx.x * 8;
  float4 a[4], b[4];
#pragma unroll
  for (int i = 0; i < 4; ++i) {
    a[i] = *(const float4*)(src + base + i * 2048);
    b[i] = *(const float4*)(src + base + i * 2048 + 4);
  }
#pragma unroll
  for (int i = 0; i < 4; ++i)
    *(uint4*)(dst + base + i * 2048) = make_uint4(pack2(a[i].x, a[i].y), pack2(a[i].z, a[i].w), pack2(b[i].x, b[i].y), pack2(b[i].z, b[i].w));
}


typedef __attribute__((ext_vector_type(2))) float f32x2_t;
__device__ __forceinline__ void ph_cvt8(const int vb, const float* __restrict__ src, unsigned char* __restrict__ dst, float* __restrict__ inv_scale) {
  const int lane = threadIdx.x & 63;
  const int row = vb * 4 + (threadIdx.x >> 6);
  const float* sr = src + (size_t)row * DM + lane * 16;
  float4 v[4];
#pragma unroll
  for (int i = 0; i < 4; ++i) v[i] = ld_nt4(sr + i * 4);
  float am = 0.f;
#pragma unroll
  for (int i = 0; i < 4; ++i) am = fmaxf(fmaxf(fmaxf(am, fabsf(v[i].x)), fmaxf(fabsf(v[i].y), fabsf(v[i].z))), fabsf(v[i].w));
  am = wave_max(am);
  const float sc = (am > 0.f) ? 224.f / am : 1.f;
  unsigned w[4];
#pragma unroll
  for (int i = 0; i < 4; ++i) {
    int t = 0;
    t = __builtin_amdgcn_cvt_pk_fp8_f32(v[i].x * sc, v[i].y * sc, t, false);
    t = __builtin_amdgcn_cvt_pk_fp8_f32(v[i].z * sc, v[i].w * sc, t, true);
    w[i] = (unsigned)t;
  }
  *(uint4*)(dst + (size_t)row * DM + lane * 16) = make_uint4(w[0], w[1], w[2], w[3]);
  if (lane == 0) inv_scale[row] = (am > 0.f) ? am * (1.f / 224.f) : 1.f;
}

__device__ __forceinline__ void ph_cvt4(const int vb, const float* __restrict__ src, unsigned char* __restrict__ dst, float* __restrict__ inv_scale) {
  const int lane = threadIdx.x & 63;
  const int row = vb * 4 + (threadIdx.x >> 6);
  const float* sr = src + (size_t)row * DM + lane * 16;
  float4 v[4];
#pragma unroll
  for (int i = 0; i < 4; ++i) v[i] = ld_nt4(sr + i * 4);
  float am = 0.f;
#pragma unroll
  for (int i = 0; i < 4; ++i) am = fmaxf(fmaxf(fmaxf(am, fabsf(v[i].x)), fmaxf(fabsf(v[i].y), fabsf(v[i].z))), fabsf(v[i].w));
  am = wave_max(am);
  const float sc = (am > 0.f) ? 6.f / am : 1.f;
  unsigned w0 = 0u, w1 = 0u;
  w0 = __builtin_amdgcn_cvt_scalef32_pk_fp4_f32(w0, v[0].x * sc, v[0].y * sc, 1.0f, 0);
  w0 = __builtin_amdgcn_cvt_scalef32_pk_fp4_f32(w0, v[0].z * sc, v[0].w * sc, 1.0f, 1);
  w0 = __builtin_amdgcn_cvt_scalef32_pk_fp4_f32(w0, v[1].x * sc, v[1].y * sc, 1.0f, 2);
  w0 = __builtin_amdgcn_cvt_scalef32_pk_fp4_f32(w0, v[1].z * sc, v[1].w * sc, 1.0f, 3);
  w1 = __builtin_amdgcn_cvt_scalef32_pk_fp4_f32(w1, v[2].x * sc, v[2].y * sc, 1.0f, 0);
  w1 = __builtin_amdgcn_cvt_scalef32_pk_fp4_f32(w1, v[2].z * sc, v[2].w * sc, 1.0f, 1);
  w1 = __builtin_amdgcn_cvt_scalef32_pk_fp4_f32(w1, v[3].x * sc, v[3].y * sc, 1.0f, 2);
  w1 = __builtin_amdgcn_cvt_scalef32_pk_fp4_f32(w1, v[3].z * sc, v[3].w * sc, 1.0f, 3);
  *(uint2*)(dst + (size_t)row * (DM / 2) + lane * 8) = make_uint2(w0, w1);
  if (lane == 0) inv_scale[row] = (am > 0.f) ? am * (1.f / 6.f) : 1.f;
}
__device__ __forceinline__ void dec16_fp8(const uint4 d, f32x2_t (&o)[8]) {
  const unsigned w[4] = {d.x, d.y, d.z, d.w};
#pragma unroll
  for (int k = 0; k < 4; ++k) {
    o[2 * k] = __builtin_amdgcn_cvt_pk_f32_fp8((int)w[k], false);
    o[2 * k + 1] = __builtin_amdgcn_cvt_pk_f32_fp8((int)w[k], true);
  }
}
__device__ __forceinline__ void dec16_fp4(const uint2 d, f32x2_t (&o)[8]) {
  o[0] = __builtin_amdgcn_cvt_scalef32_pk_f32_fp4(d.x, 1.0f, 0); o[1] = __builtin_amdgcn_cvt_scalef32_pk_f32_fp4(d.x, 1.0f, 1);
  o[2] = __builtin_amdgcn_cvt_scalef32_pk_f32_fp4(d.x, 1.0f, 2); o[3] = __builtin_amdgcn_cvt_scalef32_pk_f32_fp4(d.x, 1.0f, 3);
  o[4] = __builtin_amdgcn_cvt_scalef32_pk_f32_fp4(d.y, 1.0f, 0); o[5] = __builtin_amdgcn_cvt_scalef32_pk_f32_fp4(d.y, 1.0f, 1);
  o[6] = __builtin_amdgcn_cvt_scalef32_pk_f32_fp4(d.y, 1.0f, 2); o[7] = __builtin_amdgcn_cvt_scalef32_pk_f32_fp4(d.y, 1.0f, 3);
}
#if EX_FP4_DOWN
typedef uint2 drow_t;
#define DROW_BYTES 8
#define DEC_D dec16_fp4
#else
typedef uint4 drow_t;
#define DROW_BYTES 16
#define DEC_D dec16_fp8
#endif
#if EX_FP4_UP
typedef uint2 urow_t;
#define UROW_BYTES 8
#define DEC_U dec16_fp4
#else
typedef uint4 urow_t;
#define UROW_BYTES 16
#define DEC_U dec16_fp8
#endif

__device__ __forceinline__ int swz(int row, int ch) { return row * 128 + ((ch ^ ((row >> 1) & 7)) << 4); }

__device__ __forceinline__ void gemm_compute(const char* cA, const char* cB, const int arow, const int brow, const int xr, const int h,
                                             f32x16 (&acc)[2][2]) {
#pragma unroll
  for (int ks = 0; ks < 4; ++ks) {
    const int co = ((ks * 2 + h) ^ xr) << 4;
    bf16x8 a0 = *(const bf16x8*)(cA + arow + co);
    bf16x8 a1 = *(const bf16x8*)(cA + arow + 32 * 128 + co);
    bf16x8 b0 = *(const bf16x8*)(cB + brow + co);
    bf16x8 b1 = *(const bf16x8*)(cB + brow + 32 * 128 + co);
    acc[0][0] = __builtin_amdgcn_mfma_f32_32x32x16_bf16(a0, b0, acc[0][0], 0, 0, 0);
    acc[0][1] = __builtin_amdgcn_mfma_f32_32x32x16_bf16(a0, b1, acc[0][1], 0, 0, 0);
    acc[1][0] = __builtin_amdgcn_mfma_f32_32x32x16_bf16(a1, b0, acc[1][0], 0, 0, 0);
    acc[1][1] = __builtin_amdgcn_mfma_f32_32x32x16_bf16(a1, b1, acc[1][1], 0, 0, 0);
  }
}

__device__ __forceinline__ void gemm_core(const ushort_t* __restrict__ A, const ushort_t* __restrict__ Bt, const int K, const int m0,
                                          const int n0, char* smem, f32x16 (&acc)[2][2]) {
  int tid = threadIdx.x;
  asm volatile("" : "+v"(tid));
  const int lane = tid & 63;
  const int wave = __builtin_amdgcn_readfirstlane(tid >> 6);
  const int wm = wave >> 1, wn = wave & 1;
  const int r = lane & 31, h = lane >> 5;
  const int srow = wave * 8 + (lane >> 3);
  const int schs = (lane & 7) ^ ((srow >> 1) & 7);
  const ushort_t* Ag = A + (size_t)(m0 + srow) * K + schs * 8;
  const ushort_t* Bg = Bt + (size_t)(n0 + srow) * K + schs * 8;
  const size_t rs = (size_t)32 * K;
  char* wbase = smem + wave * 1024;
#define GLDS_TILE(BUF, koff) { \
    __builtin_amdgcn_global_load_lds((const unsigned*)(Ag + (koff)), (unsigned*)(wbase + (BUF)), 16, 0, 0); \
    __builtin_amdgcn_global_load_lds((const unsigned*)(Ag + rs + (koff)), (unsigned*)(wbase + (BUF) + 4096), 16, 0, 0); \
    __builtin_amdgcn_global_load_lds((const unsigned*)(Ag + 2 * rs + (koff)), (unsigned*)(wbase + (BUF) + 8192), 16, 0, 0); \
    __builtin_amdgcn_global_load_lds((const unsigned*)(Ag + 3 * rs + (koff)), (unsigned*)(wbase + (BUF) + 12288), 16, 0, 0); \
    __builtin_amdgcn_global_load_lds((const unsigned*)(Bg + (koff)), (unsigned*)(wbase + (BUF) + 16384), 16, 0, 0); \
    __builtin_amdgcn_global_load_lds((const unsigned*)(Bg + rs + (koff)), (unsigned*)(wbase + (BUF) + 16384 + 4096), 16, 0, 0); \
    __builtin_amdgcn_global_load_lds((const unsigned*)(Bg + 2 * rs + (koff)), (unsigned*)(wbase + (BUF) + 16384 + 8192), 16, 0, 0); \
    __builtin_amdgcn_global_load_lds((const unsigned*)(Bg + 3 * rs + (koff)), (unsigned*)(wbase + (BUF) + 16384 + 12288), 16, 0, 0); }
  GLDS_TILE(0, 0)
#pragma unroll
  for (int i = 0; i < 2; ++i)
#pragma unroll
    for (int j = 0; j < 2; ++j)
#pragma unroll
      for (int e = 0; e < 16; ++e) acc[i][j][e] = 0.f;
  const int nk = K >> 6;
  const int xr = (r >> 1) & 7;
  const int arow = (wm * 64 + r) * 128, brow = (wn * 64 + r) * 128;
  asm volatile("s_waitcnt vmcnt(0)" ::: "memory");
  __syncthreads();
#pragma unroll 1
  for (int kt = 0; kt < nk; kt += 2) {
    GLDS_TILE(32768, (kt + 1) * 64)
    gemm_compute(smem, smem + 16384, arow, brow, xr, h, acc);
    asm volatile("s_waitcnt vmcnt(0)" ::: "memory");
    __syncthreads();
    if (kt + 2 < nk) { GLDS_TILE(0, (kt + 2) * 64) }
    gemm_compute(smem + 32768, smem + 32768 + 16384, arow, brow, xr, h, acc);
    asm volatile("s_waitcnt vmcnt(0)" ::: "memory");
    __syncthreads();
  }
#undef GLDS_TILE
}

enum { EP_SILU = 0, EP_PLAIN = 1, EP_HEADNORM = 2 };

__device__ __forceinline__ void stage_flush_bf16(const char* sw, ushort_t* __restrict__ dst, const size_t ld, const size_t row0, const int col0) {
  const int lane = threadIdx.x & 63;
  const int rr = lane >> 3, ch = lane & 7;
#pragma unroll
  for (int i = 0; i < 8; ++i) {
    const int row = i * 8 + rr;
    const uint4 v = *(const uint4*)(sw + row * 144 + ch * 16);
    *(uint4*)(dst + (row0 + row) * ld + col0 + ch * 8) = v;
  }
}

__device__ __forceinline__ void epi_bf16(char* smem, const f32x16 (&acc)[2][2], const int mode, ushort_t* __restrict__ dst, const int ld,
                                         const int row0, const int col0, const float* __restrict__ nw, float* __restrict__ kp) {
  const int lane = threadIdx.x & 63, r = lane & 31, h = lane >> 5;
  char* sw = smem + (threadIdx.x >> 6) * 9216;
  float w0 = 1.f, w1 = 1.f;
  if (mode == EP_HEADNORM) { w0 = nw[r]; w1 = nw[32 + r]; }
  float cs0 = 0.f, cs1 = 0.f;
#pragma unroll
  for (int mi = 0; mi < 2; ++mi) {
#pragma unroll
    for (int e = 0; e < 16; ++e) {
      const int row = mi * 32 + (e & 3) + 8 * (e >> 2) + 4 * h;
      float v0 = acc[mi][0][e], v1 = acc[mi][1][e];
      if (mode == EP_SILU) { v0 = silu_f(v0); v1 = silu_f(v1); }
      if (mode == EP_HEADNORM) {
        float ss = v0 * v0 + v1 * v1;
        ss += __shfl_xor(ss, 1); ss += __shfl_xor(ss, 2); ss += __shfl_xor(ss, 4); ss += __shfl_xor(ss, 8); ss += __shfl_xor(ss, 16);
        const float rs = rsqrtf(ss * (1.f / 64.f) + EPS);
        v0 = v0 * rs * w0; v1 = v1 * rs * w1;
        cs0 += v0; cs1 += v1;
      }
      *(ushort_t*)(sw + row * 144 + r * 2) = f2bf(v0);
      *(ushort_t*)(sw + row * 144 + 64 + r * 2) = f2bf(v1);
    }
  }
  if (kp) {
    cs0 += __shfl_xor(cs0, 32);
    cs1 += __shfl_xor(cs1, 32);
    if (h == 0) { kp[r] = cs0; kp[32 + r] = cs1; }
  }
  stage_flush_bf16(sw, dst, (size_t)ld, (size_t)row0, col0);
}

__device__ __forceinline__ void epi_bf16_T(char* smem, const f32x16 (&acc)[2][2], ushort_t* __restrict__ dstT, const size_t ldT, const int rowpos0) {
  const int lane = threadIdx.x & 63, r = lane & 31, h = lane >> 5;
  char* sw = smem + (threadIdx.x >> 6) * 9216;
#pragma unroll
  for (int ni = 0; ni < 2; ++ni) {
#pragma unroll
    for (int mi = 0; mi < 2; ++mi) {
#pragma unroll
      for (int q4 = 0; q4 < 4; ++q4) {
        const int rp = mi * 32 + 8 * q4 + 4 * h;
        *(uint2*)(sw + (ni * 32 + r) * 144 + rp * 2) = make_uint2(pack2(acc[mi][ni][4 * q4 + 0], acc[mi][ni][4 * q4 + 1]),
                                                                    pack2(acc[mi][ni][4 * q4 + 2], acc[mi][ni][4 * q4 + 3]));
      }
    }
  }
  stage_flush_bf16(sw, dstT, ldT, 0, rowpos0);
}

__device__ __forceinline__ void epi_f32(char* smem, const f32x16 (&acc)[2][2], float* __restrict__ dst, const int ld, const int row0, const int col0,
                                        const float* __restrict__ resid, ushort_t* __restrict__ dstb, float* __restrict__ hss) {
  const int lane = threadIdx.x & 63, r = lane & 31, h = lane >> 5;
  char* sw = smem + (threadIdx.x >> 6) * 17408;
#pragma unroll
  for (int mi = 0; mi < 2; ++mi) {
#pragma unroll
    for (int e = 0; e < 16; ++e) {
      const int row = mi * 32 + (e & 3) + 8 * (e >> 2) + 4 * h;
      *(float*)(sw + row * 272 + r * 4) = acc[mi][0][e];
      *(float*)(sw + row * 272 + 128 + r * 4) = acc[mi][1][e];
    }
  }
  const int rr = lane >> 4, ch = lane & 15;
#pragma unroll
  for (int hb = 0; hb < 2; ++hb) {
    float4 rv[8];
    if (resid) {
#pragma unroll
      for (int i = 0; i < 8; ++i) rv[i] = ld_nt4(resid + (size_t)(row0 + (hb * 8 + i) * 4 + rr) * ld + col0 + ch * 4);
    }
#pragma unroll
    for (int i = 0; i < 8; ++i) {
      const int row = (hb * 8 + i) * 4 + rr;
      float4 v = *(const float4*)(sw + row * 272 + ch * 16);
      if (resid) { v.x += rv[i].x; v.y += rv[i].y; v.z += rv[i].z; v.w += rv[i].w; }
      *(float4*)(dst + (size_t)(row0 + row) * ld + col0 + ch * 4) = v;
      if (dstb) {
        *(uint2*)(dstb + (size_t)(row0 + row) * ld + col0 + ch * 4) = make_uint2(pack2(v.x, v.y), pack2(v.z, v.w));
        float ss = v.x * v.x + v.y * v.y + v.z * v.z + v.w * v.w;
        ss += __shfl_xor(ss, 1); ss += __shfl_xor(ss, 2); ss += __shfl_xor(ss, 4); ss += __shfl_xor(ss, 8);
        if (ch == 0) hss[(size_t)(row0 + row) * 16 + (col0 >> 6)] = ss;
      }
    }
  }
}

__device__ __forceinline__ void ph_gemm_proj(const int vb, char* smem, const Params& p) {
  const int nt = vb % 20, mt = vb / 20;
  const int m0 = mt * 128, n0 = nt * 128;
  f32x16 acc[2][2];
  gemm_core(p.xn_b, p.w_inT, DM, m0, n0, smem, acc);
  const int wave = threadIdx.x >> 6, wm = wave >> 1, wn = wave & 1;
  const int row0 = m0 + wm * 64;
  const int c = n0 + wn * 64;
  if (c < 512) epi_bf16(smem, acc, EP_SILU, p.zs, 512, row0, c, nullptr, nullptr);
  else if (c < 1536) epi_bf16(smem, acc, EP_PLAIN, p.xbc_raw, 1024, row0, c - 512, nullptr, nullptr);
  else if (c < 1792) epi_bf16(smem, acc, EP_HEADNORM, p.mq, 256, row0, c - 1536, p.mq_norm_w, nullptr);
  else if (c < 2048) {
    const int hh = (c - 1792) >> 6, bb = row0 >> 13, lpos = row0 & (SL - 1);
    epi_bf16(smem, acc, EP_HEADNORM, p.mk, 256, row0, c - 1792, p.mk_norm_w, p.kpart + ((size_t)((bb * 4 + hh) * 32 + (lpos >> 8)) * 4 + ((lpos >> 6) & 3)) * 64);
  } else if (c < 2304) {
    const int hh = (c - 2048) >> 6, bb = row0 >> 13, lpos = row0 & (SL - 1);
    epi_bf16_T(smem, acc, p.vT + (size_t)(bb * 4 + hh) * 64 * SL, SL, lpos);
  }
  else epi_bf16(smem, acc, EP_HEADNORM, p.xq, 256, row0, c - 2304, p.xq_norm_w, nullptr);
}

__device__ __forceinline__ void ph_gemm_mem(const int vb, char* smem, const Params& p) {
  const int nt = vb % 4, mt = vb / 4;
  const int m0 = mt * 128, n0 = nt * 128;
  f32x16 acc[2][2];
  gemm_core(p.memn_b, p.w_memT, DM, m0, n0, smem, acc);
  const int wave = threadIdx.x >> 6, wm = wave >> 1, wn = wave & 1;
  const int row0 = m0 + wm * 64;
  const int c = n0 + wn * 64;
  if (c < 256) epi_bf16(smem, acc, EP_HEADNORM, p.memk_b, 256, row0, c, p.xk_norm_w, nullptr);
  else {
    const int hh = (c - 256) >> 6, bb = row0 >> 8, mpos = row0 & 255;
    epi_bf16_T(smem, acc, p.memvT + (size_t)(bb * 4 + hh) * 64 * MEM, MEM, mpos);
  }
}

__device__ __forceinline__ void ph_gemm_f32(const int vb, char* smem, const ushort_t* A, const ushort_t* Bt, float* dst, const float* resid, ushort_t* dstb, float* hss) {
  const int nt = vb % 8, mt = vb / 8;
  const int m0 = mt * 128, n0 = nt * 128;
  f32x16 acc[2][2];
  gemm_core(A, Bt, DM, m0, n0, smem, acc);
  const int wave = threadIdx.x >> 6, wm = wave >> 1, wn = wave & 1;
  epi_f32(smem, acc, dst, DM, m0 + wm * 64, n0 + wn * 64, resid, dstb, hss);
}

__device__ __forceinline__ int swz256(int row, int ch) { return row * 272 + (ch << 4); }
__device__ __forceinline__ int crow16(int e, int hl) { return (e & 3) + 8 * (e >> 2) + 4 * hl; }

__device__ __forceinline__ void ph_acs(const int vb, const Params& p) {
  const int lane = threadIdx.x & 63;
  const int item = vb * 4 + (threadIdx.x >> 6);
  const int h = item & 7, bc = item >> 3;
  const int t0 = bc * 128;
  const float a_coef = -expf(p.a_log[h]);
  const float d0 = p.dt[(size_t)(t0 + lane) * 8 + h], d1 = p.dt[(size_t)(t0 + 64 + lane) * 8 + h];
  float c0 = d0 * a_coef, c1 = d1 * a_coef;
#pragma unroll
  for (int o = 1; o < 64; o <<= 1) {
    const float n0 = __shfl_up(c0, o), n1 = __shfl_up(c1, o);
    if (lane >= o) { c0 += n0; c1 += n1; }
  }
  c1 += __shfl(c0, 63);
  const float tot = __shfl(c1, 63);
  p.acs[(size_t)(t0 + lane) * 8 + h] = c0;
  p.acs[(size_t)(t0 + 64 + lane) * 8 + h] = c1;
  p.wdec[(size_t)(t0 + lane) * 8 + h] = d0 * expf(tot - c0);
  p.wdec[(size_t)(t0 + 64 + lane) * 8 + h] = d1 * expf(tot - c1);
  if (lane == 0) p.cdec[item] = expf(tot);
}

__device__ __forceinline__ void ph_ssd1(const int vb, char* smem, const Params& p) {
  const int h = vb & 7, c = (vb >> 3) & 63, b = vb >> 9;
  const int g = h >> 2, hq = h & 3;
  int tid = threadIdx.x;
  asm volatile("" : "+v"(tid));
  const int lane = tid & 63, wave = tid >> 6;
  const int t0 = b * SL + c * 128;
  char* s_xw = smem;
  char* s_bt = smem + 17408;
  float* s_acs = (float*)(smem + 52224);
  float* s_w = s_acs + 128;
  float* s_red = s_w + 128;
  if (tid < 128) s_w[tid] = p.wdec[(size_t)(t0 + tid) * 8 + h];
  __syncthreads();
  if (tid < 224) {
    const int seg = tid / 28, cg = tid - seg * 28;
    const bool is_x = cg < 8, is_b = (cg >= 8) && (cg < 24);
    int ch0, trow;
    if (is_x) { ch0 = h * 64 + cg * 8; trow = cg * 8; }
    else if (is_b) { ch0 = 512 + g * 128 + (cg - 8) * 8; trow = (cg - 8) * 8; }
    else { ch0 = 768 + g * 128 + hq * 32 + (cg - 24) * 8; trow = 0; }
    const bool wr_nat = is_x || !is_b || (hq == 0);
    char* tbase = is_x ? s_xw : s_bt;
    const int l0 = seg * 16;
    float w0[8], w1[8], w2[8], w3[8], bias[8];
    {
      const float* cw = p.conv_w + ch0;
      float4 a, bq;
      a = *(const float4*)(cw); bq = *(const float4*)(cw + 4);
      w0[0] = a.x; w0[1] = a.y; w0[2] = a.z; w0[3] = a.w; w0[4] = bq.x; w0[5] = bq.y; w0[6] = bq.z; w0[7] = bq.w;
      a = *(const float4*)(cw + 1024); bq = *(const float4*)(cw + 1028);
      w1[0] = a.x; w1[1] = a.y; w1[2] = a.z; w1[3] = a.w; w1[4] = bq.x; w1[5] = bq.y; w1[6] = bq.z; w1[7] = bq.w;
      a = *(const float4*)(cw + 2048); bq = *(const float4*)(cw + 2052);
      w2[0] = a.x; w2[1] = a.y; w2[2] = a.z; w2[3] = a.w; w2[4] = bq.x; w2[5] = bq.y; w2[6] = bq.z; w2[7] = bq.w;
      a = *(const float4*)(cw + 3072); bq = *(const float4*)(cw + 3076);
      w3[0] = a.x; w3[1] = a.y; w3[2] = a.z; w3[3] = a.w; w3[4] = bq.x; w3[5] = bq.y; w3[6] = bq.z; w3[7] = bq.w;
      a = *(const float4*)(p.conv_b + ch0); bq = *(const float4*)(p.conv_b + ch0 + 4);
      bias[0] = a.x; bias[1] = a.y; bias[2] = a.z; bias[3] = a.w; bias[4] = bq.x; bias[5] = bq.y; bias[6] = bq.z; bias[7] = bq.w;
    }
    float r0[8], r1[8], r2[8];
    {
      const int lg = c * 128 + l0;
      const ushort_t* src = p.xbc_raw + (size_t)(t0 + l0) * 1024 + ch0;
      uint4 z4 = make_uint4(0u, 0u, 0u, 0u);
      uint4 u0 = (lg >= 3) ? *(const uint4*)(src - 3 * 1024) : z4;
      uint4 u1 = (lg >= 2) ? *(const uint4*)(src - 2 * 1024) : z4;
      uint4 u2 = (lg >= 1) ? *(const uint4*)(src - 1 * 1024) : z4;
      unpack8(u0, r0); unpack8(u1, r1); unpack8(u2, r2);
    }
    unsigned outp[8][8];
    float lo[8], los[8];
#pragma unroll
    for (int i = 0; i < 16; ++i) {
      float cur[8], val[8];
      unpack8(*(const uint4*)(p.xbc_raw + (size_t)(t0 + l0 + i) * 1024 + ch0), cur);
#pragma unroll
      for (int j = 0; j < 8; ++j) {
        float v = bias[j];
        v = fmaf(w0[j], r0[j], v); v = fmaf(w1[j], r1[j], v); v = fmaf(w2[j], r2[j], v); v = fmaf(w3[j], cur[j], v);
        val[j] = silu_f(v);
        r0[j] = r1[j]; r1[j] = r2[j]; r2[j] = cur[j];
      }
      if (wr_nat) {
        *(uint4*)(p.xc + (size_t)(t0 + l0 + i) * 1024 + ch0) =
            make_uint4(pack2(val[0], val[1]), pack2(val[2], val[3]), pack2(val[4], val[5]), pack2(val[6], val[7]));
      }
      const float scl = is_x ? s_w[l0 + i] : 1.f;
      if ((i & 1) == 0) {
#pragma unroll
        for (int j = 0; j < 8; ++j) { lo[j] = val[j]; los[j] = val[j] * scl; }
      } else {
        const int chunk = seg * 2 + (i >> 3);
#pragma unroll
        for (int j = 0; j < 8; ++j) {
          outp[j][i >> 1] = pack2(lo[j], val[j]);
          if (is_x || is_b) *(unsigned*)(tbase + swz256(trow + j, chunk) + ((i & 7) - 1) * 2) = pack2(los[j], val[j] * scl);
        }
      }
    }
    if (is_x) {
      ushort_t* dst = p.xT + ((size_t)((b * 64 + c) * 8 + h) * 64 + cg * 8) * 128 + l0;
#pragma unroll
      for (int j = 0; j < 8; ++j) {
        *(uint4*)(dst + (size_t)j * 128) = make_uint4(outp[j][0], outp[j][1], outp[j][2], outp[j][3]);
        *(uint4*)(dst + (size_t)j * 128 + 8) = make_uint4(outp[j][4], outp[j][5], outp[j][6], outp[j][7]);
      }
    }
  }
  __syncthreads();
  {
    const int r = lane & 31, hl = lane >> 5;
    f32x16 acc[2];
#pragma unroll
    for (int e = 0; e < 16; ++e) { acc[0][e] = 0.f; acc[1][e] = 0.f; }
#pragma unroll
    for (int ks = 0; ks < 8; ++ks) {
      const bf16x8 bfr = *(const bf16x8*)(s_bt + swz256(32 * wave + r, ks * 2 + hl));
      const bf16x8 a0 = *(const bf16x8*)(s_xw + swz256(r, ks * 2 + hl));
      const bf16x8 a1 = *(const bf16x8*)(s_xw + swz256(32 + r, ks * 2 + hl));
      acc[0] = __builtin_amdgcn_mfma_f32_32x32x16_bf16(a0, bfr, acc[0], 0, 0, 0);
      acc[1] = __builtin_amdgcn_mfma_f32_32x32x16_bf16(a1, bfr, acc[1], 0, 0, 0);
    }
    float* dst = p.states + (size_t)((b * 64 + c) * 8 + h) * 64 * 128;
#pragma unroll
    for (int pt = 0; pt < 2; ++pt)
#pragma unroll
      for (int e = 0; e < 16; ++e) dst[(size_t)(pt * 32 + crow16(e, hl)) * 128 + 32 * wave + r] = acc[pt][e];
  }
}

__device__ __forceinline__ void ph_ssd2(const int vb, const Params& p) {
  const int idx = vb * 256 + threadIdx.x;
  const int pn = idx & 8191, h = (idx >> 13) & 7, b = idx >> 16;
  float st = 0.f;
#pragma unroll 1
  for (int c0 = 0; c0 < 64; c0 += 8) {
    float sv[8], dv[8];
#pragma unroll
    for (int i = 0; i < 8; ++i) {
      const int cc = (b * 64 + c0 + i) * 8 + h;
      sv[i] = p.states[(size_t)cc * 8192 + pn];
      dv[i] = p.cdec[cc];
    }
#pragma unroll
    for (int i = 0; i < 8; ++i) {
      const int cc = (b * 64 + c0 + i) * 8 + h;
      p.sin_b[(size_t)cc * 8192 + pn] = f2bf(st);
      st = fmaf(st, dv[i], sv[i]);
    }
  }
}

__device__ __forceinline__ void ph_ssd3(const int vb, char* smem, const Params& p) {
  const int g = vb & 1, c = (vb >> 1) & 63, b = vb >> 7;
  int tid = threadIdx.x;
  asm volatile("" : "+v"(tid));
  const int lane = tid & 63;
  const int w = __builtin_amdgcn_readfirstlane(tid >> 6);
  const int r = lane & 31, hl = lane >> 5;
  const int t0 = b * SL + c * 128;
  char* s_C = smem;
  char* s_B = smem + 34816;
  char* s_xT = smem + 34816;
  char* s_S = smem + 34816 + 16896;
  float* s_acs = (float*)(smem + 69632);
  float* s_dt = s_acs + 512;
  {
    const int ch = tid & 15, r0 = tid >> 4;
#pragma unroll
    for (int i = 0; i < 8; ++i) {
      const int row = r0 + 16 * i;
      const ushort_t* src = p.xc + (size_t)(t0 + row) * 1024 + g * 128 + ch * 8;
      *(uint4*)(s_B + swz256(row, ch)) = *(const uint4*)(src + 512);
      *(uint4*)(s_C + swz256(row, ch)) = *(const uint4*)(src + 768);
    }
    if (tid < 128) {
#pragma unroll
      for (int hh = 0; hh < 4; ++hh) {
        s_acs[hh * 128 + tid] = p.acs[(size_t)(t0 + tid) * 8 + g * 4 + hh];
        s_dt[hh * 128 + tid] = p.dt[(size_t)(t0 + tid) * 8 + g * 4 + hh];
      }
    }
  }
  __syncthreads();
  bf16x8 cfr[8];
#pragma unroll
  for (int ks = 0; ks < 8; ++ks) cfr[ks] = *(const bf16x8*)(s_C + swz256(32 * w + r, ks * 2 + hl));
  f32x16 gt[4];
#pragma unroll
  for (int st = 0; st < 4; ++st) {
#pragma unroll
    for (int e = 0; e < 16; ++e) gt[st][e] = 0.f;
    if (st <= w) {
#pragma unroll
      for (int ks = 0; ks < 8; ++ks) {
        const bf16x8 a = *(const bf16x8*)(s_B + swz256(32 * st + r, ks * 2 + hl));
        gt[st] = __builtin_amdgcn_mfma_f32_32x32x16_bf16(a, cfr[ks], gt[st], 0, 0, 0);
      }
    }
  }
  __syncthreads();
  float ssq = 0.f;
  const int lane_c = lane;
  uint4 PX0, PX1, PX2, PX3, PS0, PS1, PS2, PS3;
  {
    const int ch = tid & 15, r0 = tid >> 4;
    const size_t base = (size_t)((b * 64 + c) * 8 + g * 4) * 8192 + (size_t)r0 * 128 + ch * 8;
    PX0 = *(const uint4*)(p.xT + base); PX1 = *(const uint4*)(p.xT + base + 16 * 128);
    PX2 = *(const uint4*)(p.xT + base + 32 * 128); PX3 = *(const uint4*)(p.xT + base + 48 * 128);
    PS0 = *(const uint4*)(p.sin_b + base); PS1 = *(const uint4*)(p.sin_b + base + 16 * 128);
    PS2 = *(const uint4*)(p.sin_b + base + 32 * 128); PS3 = *(const uint4*)(p.sin_b + base + 48 * 128);
  }
#pragma unroll 1
  for (int hh = 0; hh < 4; ++hh) {
    int lane_o = lane_c;
    asm volatile("" : "+v"(lane_o));
    const int r = lane_o & 31, hl = lane_o >> 5;
    const int l = 32 * w + r;
    const int hg = g * 4 + hh;
    {
      const int ch = tid & 15, r0 = tid >> 4;
      *(uint2*)(s_xT + (r0) * 264 + ch * 16) = make_uint2(PX0.x, PX0.y); *(uint2*)(s_xT + (r0) * 264 + ch * 16 + 8) = make_uint2(PX0.z, PX0.w);
      *(uint2*)(s_xT + (r0 + 16) * 264 + ch * 16) = make_uint2(PX1.x, PX1.y); *(uint2*)(s_xT + (r0 + 16) * 264 + ch * 16 + 8) = make_uint2(PX1.z, PX1.w);
      *(uint2*)(s_xT + (r0 + 32) * 264 + ch * 16) = make_uint2(PX2.x, PX2.y); *(uint2*)(s_xT + (r0 + 32) * 264 + ch * 16 + 8) = make_uint2(PX2.z, PX2.w);
      *(uint2*)(s_xT + (r0 + 48) * 264 + ch * 16) = make_uint2(PX3.x, PX3.y); *(uint2*)(s_xT + (r0 + 48) * 264 + ch * 16 + 8) = make_uint2(PX3.z, PX3.w);
      *(uint4*)(s_S + swz256(r0, ch)) = PS0; *(uint4*)(s_S + swz256(r0 + 16, ch)) = PS1;
      *(uint4*)(s_S + swz256(r0 + 32, ch)) = PS2; *(uint4*)(s_S + swz256(r0 + 48, ch)) = PS3;
      const int hn = (hh < 3) ? hg + 1 : hg;
      const size_t base = (size_t)((b * 64 + c) * 8 + hn) * 8192 + (size_t)r0 * 128 + ch * 8;
      PX0 = *(const uint4*)(p.xT + base); PX1 = *(const uint4*)(p.xT + base + 16 * 128);
      PX2 = *(const uint4*)(p.xT + base + 32 * 128); PX3 = *(const uint4*)(p.xT + base + 48 * 128);
      PS0 = *(const uint4*)(p.sin_b + base); PS1 = *(const uint4*)(p.sin_b + base + 16 * 128);
      PS2 = *(const uint4*)(p.sin_b + base + 32 * 128); PS3 = *(const uint4*)(p.sin_b + base + 48 * 128);
    }
    __syncthreads();
    const float acs_l = s_acs[hh * 128 + l];
    const float dsk = p.ssd_d[hg];
    f32x16 acc[2];
#pragma unroll
    for (int e = 0; e < 16; ++e) { acc[0][e] = 0.f; acc[1][e] = 0.f; }
#pragma unroll
    for (int ks = 0; ks < 8; ++ks) {
      const bf16x8 a0 = *(const bf16x8*)(s_S + swz256(r, ks * 2 + hl));
      const bf16x8 a1 = *(const bf16x8*)(s_S + swz256(32 + r, ks * 2 + hl));
      acc[0] = __builtin_amdgcn_mfma_f32_32x32x16_bf16(a0, cfr[ks], acc[0], 0, 0, 0);
      acc[1] = __builtin_amdgcn_mfma_f32_32x32x16_bf16(a1, cfr[ks], acc[1], 0, 0, 0);
    }
    {
      const float el = expf(acs_l);
#pragma unroll
      for (int e = 0; e < 16; ++e) { acc[0][e] *= el; acc[1][e] *= el; }
    }
#pragma unroll
    for (int st = 0; st < 4; ++st) {
      asm volatile("" ::: "memory");
      if (st <= w) {
        float m[16];
#pragma unroll
        for (int e = 0; e < 16; ++e) {
          const int sidx = 32 * st + crow16(e, hl);
          float v = gt[st][e] * __expf(acs_l - s_acs[hh * 128 + sidx]) * s_dt[hh * 128 + sidx];
          if (sidx > l) v = 0.f;
          if (sidx == l) v += dsk;
          m[e] = v;
        }
#pragma unroll
        for (int k2 = 0; k2 < 2; ++k2) {
          asm volatile("" ::: "memory");
          bf16x8 mf;
          {
            unsigned u0 = pack2(m[8 * k2 + 0], m[8 * k2 + 1]), u1 = pack2(m[8 * k2 + 2], m[8 * k2 + 3]);
            unsigned u2 = pack2(m[8 * k2 + 4], m[8 * k2 + 5]), u3 = pack2(m[8 * k2 + 6], m[8 * k2 + 7]);
            uint4 uu = make_uint4(u0, u1, u2, u3);
            mf = *(bf16x8*)&uu;
          }
          const int soff = (32 * st + 16 * k2 + 4 * hl) * 2;
#pragma unroll
          for (int pt = 0; pt < 2; ++pt) {
            const char* ap = s_xT + (pt * 32 + r) * 264 + soff;
            uint2 q0 = *(const uint2*)(ap);
            uint2 q1 = *(const uint2*)(ap + 16);
            uint4 qq = make_uint4(q0.x, q0.y, q1.x, q1.y);
            const bf16x8 af = *(bf16x8*)&qq;
            acc[pt] = __builtin_amdgcn_mfma_f32_32x32x16_bf16(af, mf, acc[pt], 0, 0, 0);
          }
        }
      }
    }
#pragma unroll
    for (int pt = 0; pt < 2; ++pt) {
#pragma unroll
      for (int q4 = 0; q4 < 4; ++q4) {
        asm volatile("" ::: "memory");
        const int p0 = pt * 32 + 8 * q4 + 4 * hl;
        const uint2 zz = *(const uint2*)(p.zs + (size_t)(t0 + l) * 512 + hg * 64 + p0);
        const float v0 = acc[pt][4 * q4 + 0] * bflo(zz.x), v1 = acc[pt][4 * q4 + 1] * bfhi(zz.x);
        const float v2 = acc[pt][4 * q4 + 2] * bflo(zz.y), v3 = acc[pt][4 * q4 + 3] * bfhi(zz.y);
        ssq += v0 * v0 + v1 * v1 + v2 * v2 + v3 * v3;
        *(uint2*)(p.mixed_b + (size_t)(t0 + l) * 1024 + hg * 64 + p0) = make_uint2(pack2(v0, v1), pack2(v2, v3));
      }
    }
    __syncthreads();
  }
  const int l = 32 * w + r;
  ssq += __shfl_xor(ssq, 32);
  const float rstd = rsqrtf(ssq * (1.f / 256.f) + EPS);
#pragma unroll 1
  for (int hh = 0; hh < 4; ++hh) {
#pragma unroll
    for (int pt = 0; pt < 2; ++pt) {
#pragma unroll
      for (int q4 = 0; q4 < 4; ++q4) {
        asm volatile("" ::: "memory");
        const int chn = (g * 4 + hh) * 64 + pt * 32 + 8 * q4 + 4 * hl;
        ushort_t* ptr = p.mixed_b + (size_t)(t0 + l) * 1024 + chn;
        const uint2 vv = *(const uint2*)ptr;
        const float4 nw = *(const float4*)(p.ssd_norm_w + chn);
        *(uint2*)ptr = make_uint2(pack2(bflo(vv.x) * rstd * nw.x, bfhi(vv.x) * rstd * nw.y),
                                  pack2(bflo(vv.y) * rstd * nw.z, bfhi(vv.y) * rstd * nw.w));
      }
    }
  }
}

__device__ __forceinline__ void k_gate(const int VB, char* smem, const Params& p) {
  const int own = VB & 31, bh = VB >> 5;
  if (own == 0) return;
  const int b = bh >> 2, h = bh & 3;
  const int tid = threadIdx.x;
  float* s_km = (float*)smem;
  int* s_cnt = (int*)(smem + 8192);
  int* s_base = s_cnt + 32;
  for (int i = tid; i < own * 64; i += 256) {
    const int n = i >> 6, d = i & 63;
    const float* kp = p.kpart + (size_t)(bh * 32 + n) * 256 + d;
    s_km[i] = (kp[0] + kp[64]) + (kp[128] + kp[192]);
  }
  if (tid < 32) s_cnt[tid] = 0;
  __syncthreads();
  const int l = own * 256 + tid;
  const int t = b * SL + l;
  float q[64];
  {
    const ushort_t* src = p.mq + (size_t)t * 256 + h * 64;
#pragma unroll
    for (int d = 0; d < 64; d += 8) {
      uint4 v = *(const uint4*)(src + d);
      q[d] = bflo(v.x); q[d + 1] = bfhi(v.x); q[d + 2] = bflo(v.y); q[d + 3] = bfhi(v.y);
      q[d + 4] = bflo(v.z); q[d + 5] = bfhi(v.z); q[d + 6] = bflo(v.w); q[d + 7] = bfhi(v.w);
    }
  }
  float v0 = -INFINITY, v1 = -INFINITY, v2 = -INFINITY;
  int i0 = 0, i1 = 1, i2 = 2;
  for (int n = 0; n < own; ++n) {
    const float* km = s_km + n * 64;
    float sa = 0.f, sb = 0.f;
#pragma unroll
    for (int d = 0; d < 64; d += 8) {
      const float4 a = *(const float4*)(km + d), c = *(const float4*)(km + d + 4);
      sa = fmaf(q[d], a.x, sa); sa = fmaf(q[d + 1], a.y, sa); sa = fmaf(q[d + 2], a.z, sa); sa = fmaf(q[d + 3], a.w, sa);
      sb = fmaf(q[d + 4], c.x, sb); sb = fmaf(q[d + 5], c.y, sb); sb = fmaf(q[d + 6], c.z, sb); sb = fmaf(q[d + 7], c.w, sb);
    }
    const float sv = sa + sb;
    if (sv > v0) { v2 = v1; i2 = i1; v1 = v0; i1 = i0; v0 = sv; i0 = n; }
    else if (sv > v1) { v2 = v1; i2 = i1; v1 = sv; i1 = n; }
    else if (sv > v2) { v2 = sv; i2 = n; }
  }
  const int nsel = own < 3 ? own : 3;
  int lp0 = 0, lp1 = 0, lp2 = 0;
  if (0 < nsel) lp0 = atomicAdd(s_cnt + i0, 1);
  if (1 < nsel) lp1 = atomicAdd(s_cnt + i1, 1);
  if (2 < nsel) lp2 = atomicAdd(s_cnt + i2, 1);
  __syncthreads();
  if (tid < own) s_base[tid] = s_cnt[tid] ? atomicAdd(p.bcnt + bh * 32 + tid, s_cnt[tid]) : 0;
  __syncthreads();
  if (0 < nsel) p.blist[(size_t)(bh * 32 + i0) * 8192 + s_base[i0] + lp0] = l | (0 << 13);
  if (1 < nsel) p.blist[(size_t)(bh * 32 + i1) * 8192 + s_base[i1] + lp1] = l | (1 << 13);
  if (2 < nsel) p.blist[(size_t)(bh * 32 + i2) * 8192 + s_base[i2] + lp2] = l | (2 << 13);
}

struct UnitDesc { const ushort_t* Kp; const ushort_t* VTp; int vstride; int kind; int a0; int a1; };
__device__ __forceinline__ UnitDesc unit_desc(const int u, const int Ug, const int* s_pref, const Params& p) {
  UnitDesc d;
  if (u >= Ug + NB * 4 * 32 * 2) {
    const int v = u - Ug - NB * 4 * 32 * 2;
    d.kind = 2; d.a0 = v >> 6; d.a1 = v & 63;
    const int bh = d.a0, b = bh >> 2, h = bh & 3;
    d.Kp = p.memk_b + (size_t)b * MEM * 256 + h * 64;
    d.VTp = p.memvT + (size_t)bh * 64 * MEM;
    d.vstride = MEM;
  } else {
    if (u < Ug) {
      int lo = 0, hi = 255;
      while (lo < hi) { const int mid = (lo + hi) >> 1; if (s_pref[mid] > u) hi = mid; else lo = mid + 1; }
      const int prev = lo ? s_pref[lo - 1] : 0;
      d.kind = 0; d.a0 = lo; d.a1 = u - prev;
    } else {
      const int v = u - Ug;
      d.kind = 1; d.a0 = v >> 1; d.a1 = v & 1;
    }
    const int bh = d.a0 >> 5, jblk = d.a0 & 31, b = bh >> 2, h = bh & 3;
    d.Kp = p.mk + (size_t)(b * SL + jblk * 256) * 256 + h * 64;
    d.VTp = p.vT + (size_t)bh * 64 * SL + jblk * 256;
    d.vstride = SL;
  }
  return d;
}

#define AU_LOAD(P, D, ST) { \
    const ushort_t* kp_ = (D).Kp + (size_t)((ST) * 128 + kr) * 256 + kc * 8; \
    P##k0 = *(const uint4*)(kp_); P##k1 = *(const uint4*)(kp_ + 32 * 256); P##k2 = *(const uint4*)(kp_ + 64 * 256); P##k3 = *(const uint4*)(kp_ + 96 * 256); \
    const ushort_t* vp_ = (D).VTp + (size_t)vr * (D).vstride + (ST) * 128 + vc * 8; \
    P##v0 = *(const uint4*)(vp_); P##v1 = *(const uint4*)(vp_ + (size_t)16 * (D).vstride); \
    P##v2 = *(const uint4*)(vp_ + (size_t)32 * (D).vstride); P##v3 = *(const uint4*)(vp_ + (size_t)48 * (D).vstride); }
#define AU_STORE(P, BUF) { \
    char* sk_ = (BUF) + kr * 144 + kc * 16; \
    *(uint4*)(sk_) = P##k0; *(uint4*)(sk_ + 32 * 144) = P##k1; *(uint4*)(sk_ + 64 * 144) = P##k2; *(uint4*)(sk_ + 96 * 144) = P##k3; \
    char* sv_ = (BUF) + 18432 + vr * 264 + vc * 16; \
    *(uint2*)(sv_) = make_uint2(P##v0.x, P##v0.y); *(uint2*)(sv_ + 8) = make_uint2(P##v0.z, P##v0.w); \
    *(uint2*)(sv_ + 16 * 264) = make_uint2(P##v1.x, P##v1.y); *(uint2*)(sv_ + 16 * 264 + 8) = make_uint2(P##v1.z, P##v1.w); \
    *(uint2*)(sv_ + 32 * 264) = make_uint2(P##v2.x, P##v2.y); *(uint2*)(sv_ + 32 * 264 + 8) = make_uint2(P##v2.z, P##v2.w); \
    *(uint2*)(sv_ + 48 * 264) = make_uint2(P##v3.x, P##v3.y); *(uint2*)(sv_ + 48 * 264 + 8) = make_uint2(P##v3.z, P##v3.w); }

__device__ __forceinline__ void attn_stage(const char* buf, const int st, const bf16x8 (&qf)[4], const float slope, const int qrel, const bool causal,
                                           const int r, const int hl, f32x16 (&o)[2], float& m, float& lsum) {
  const char* s_K = buf;
  const char* s_VT = buf + 18432;
  f32x16 sc[4];
#pragma unroll
  for (int kt = 0; kt < 4; ++kt) {
#pragma unroll
    for (int e = 0; e < 16; ++e) sc[kt][e] = 0.f;
#pragma unroll
    for (int ks = 0; ks < 4; ++ks) {
      const bf16x8 a = *(const bf16x8*)(s_K + (32 * kt + r) * 144 + (2 * ks + hl) * 16);
      sc[kt] = __builtin_amdgcn_mfma_f32_32x32x16_bf16(a, qf[ks], sc[kt], 0, 0, 0);
    }
  }
  float mx = -1e30f;
  const int qk0 = qrel - st * 128 - 4 * hl;
  const float slope2 = slope;
  const float bb = -slope2 * (float)qk0;
#pragma unroll
  for (int kt = 0; kt < 4; ++kt) {
#pragma unroll
    for (int e = 0; e < 16; ++e) {
      const int ce = 32 * kt + (e & 3) + 8 * (e >> 2);
      float v = fmaf(sc[kt][e], 0.18033688011112042f, fmaf(slope2, (float)ce, bb));
      if (causal && ce > qk0) v = -1e30f;
      sc[kt][e] = v;
      mx = fmaxf(mx, v);
    }
  }
  mx = fmaxf(mx, __shfl_xor(mx, 32));
  const float mnew = fmaxf(m, mx);
  const float alpha = __builtin_amdgcn_exp2f(m - mnew);
  m = mnew;
  lsum *= alpha;
#pragma unroll
  for (int e = 0; e < 16; ++e) { o[0][e] *= alpha; o[1][e] *= alpha; }
#pragma unroll
  for (int kt = 0; kt < 4; ++kt) {
#pragma unroll
    for (int e = 0; e < 16; ++e) {
      const float pe = __builtin_amdgcn_exp2f(sc[kt][e] - mnew);
      sc[kt][e] = pe;
      lsum += pe;
    }
  }
#pragma unroll
  for (int kt = 0; kt < 4; ++kt) {
#pragma unroll
    for (int k2 = 0; k2 < 2; ++k2) {
      uint4 pu = make_uint4(pack2(sc[kt][8 * k2 + 0], sc[kt][8 * k2 + 1]), pack2(sc[kt][8 * k2 + 2], sc[kt][8 * k2 + 3]),
                            pack2(sc[kt][8 * k2 + 4], sc[kt][8 * k2 + 5]), pack2(sc[kt][8 * k2 + 6], sc[kt][8 * k2 + 7]));
      const bf16x8 pf = *(bf16x8*)&pu;
      const int koff = (32 * kt + 16 * k2 + 4 * hl) * 2;
#pragma unroll
      for (int dt = 0; dt < 2; ++dt) {
        const char* ap = s_VT + (dt * 32 + r) * 264 + koff;
        const uint2 q0 = *(const uint2*)(ap);
        const uint2 q1 = *(const uint2*)(ap + 16);
        uint4 qq = make_uint4(q0.x, q0.y, q1.x, q1.y);
        const bf16x8 af = *(bf16x8*)&qq;
        o[dt] = __builtin_amdgcn_mfma_f32_32x32x16_bf16(af, pf, o[dt], 0, 0, 0);
      }
    }
  }
}

__device__ __forceinline__ void ph_attn_units(char* smem, const Params& p, const int Ug, const int* s_pref) {
  const int Utot = Ug + NB * 4 * 32 * 2 + NB * 4 * 64;
  int u = blockIdx.x;
  if (u >= Utot) return;
  int tid = threadIdx.x;
  asm volatile("" : "+v"(tid));
  const int lane = tid & 63, wave = tid >> 6, r = lane & 31, hl = lane >> 5;
  const int kr = tid >> 3, kc = tid & 7, vr = tid >> 4, vc = tid & 15;
  char* buf0 = smem;
  char* buf1 = smem + 35328;
  uint4 Ak0, Ak1, Ak2, Ak3, Av0, Av1, Av2, Av3, Bk0, Bk1, Bk2, Bk3, Bv0, Bv1, Bv2, Bv3;
  UnitDesc D = unit_desc(u, Ug, s_pref, p);
  AU_LOAD(A, D, 0)
  AU_LOAD(B, D, 1)
#pragma unroll 1
  for (; u < Utot; u += gridDim.x) {
    const int un = (u + (int)gridDim.x < Utot) ? u + (int)gridDim.x : u;
    const UnitDesc Dn = unit_desc(un, Ug, s_pref, p);
    int bh, l = 0, slot = 3, jblk = 0;
    bool valid = true, causal = false;
    const ushort_t* qrow;
    float slope = 0.f;
    int qrel = 1 << 20;
    int t;
    if (D.kind == 2) {
      bh = D.a0;
      t = (bh >> 2) * SL + D.a1 * 128 + wave * 32 + r;
      qrow = p.xq + (size_t)t * 256 + (bh & 3) * 64;
    } else {
      bh = D.a0 >> 5; jblk = D.a0 & 31;
      if (D.kind == 0) {
        const int cnt = p.bcnt[D.a0];
        int qi = D.a1 * 128 + wave * 32 + r;
        if (qi >= cnt) { valid = false; qi = 0; }
        const int ent = p.blist[(size_t)D.a0 * 8192 + qi];
        l = ent & 8191; slot = ent >> 13;
      } else {
        l = jblk * 256 + D.a1 * 128 + wave * 32 + r; slot = 3; causal = true;
      }
      t = (bh >> 2) * SL + l;
      qrow = p.mq + (size_t)t * 256 + (bh & 3) * 64;
      slope = exp2f(-2.f * (float)((bh & 3) + 1)) * 1.4426950408889634f;
      qrel = l - jblk * 256;
    }
    bf16x8 qf[4];
#pragma unroll
    for (int ks = 0; ks < 4; ++ks) qf[ks] = *(const bf16x8*)(qrow + ks * 16 + hl * 8);
    f32x16 o[2];
#pragma unroll
    for (int e = 0; e < 16; ++e) { o[0][e] = 0.f; o[1][e] = 0.f; }
    float m = -1e30f, lsum = 0.f;
    AU_STORE(A, buf0)
    AU_LOAD(A, Dn, 0)
    __syncthreads();
    attn_stage(buf0, 0, qf, slope, qrel, causal, r, hl, o, m, lsum);
    AU_STORE(B, buf1)
    AU_LOAD(B, Dn, 1)
    __syncthreads();
    attn_stage(buf1, 1, qf, slope, qrel, causal, r, hl, o, m, lsum);
    const float lt = lsum + __shfl_xor(lsum, 32);
    const float inv = 1.f / lt;
    const int h = bh & 3;
    if (D.kind == 2) {
#pragma unroll
      for (int dt = 0; dt < 2; ++dt)
#pragma unroll
        for (int q4 = 0; q4 < 4; ++q4) {
          const int d = dt * 32 + 8 * q4 + 4 * hl;
          *(uint2*)(p.mixed_b + (size_t)t * DM + 768 + h * 64 + d) =
              make_uint2(pack2(o[dt][4 * q4] * inv, o[dt][4 * q4 + 1] * inv), pack2(o[dt][4 * q4 + 2] * inv, o[dt][4 * q4 + 3] * inv));
        }
    } else if (valid) {
      const size_t pi = ((size_t)t * 4 + h) * 4 + slot;
#pragma unroll
      for (int dt = 0; dt < 2; ++dt)
#pragma unroll
        for (int q4 = 0; q4 < 4; ++q4) {
          const int d = dt * 32 + 8 * q4 + 4 * hl;
          *(uint2*)(p.pO + pi * 64 + d) =
              make_uint2(pack2(o[dt][4 * q4] * inv, o[dt][4 * q4 + 1] * inv), pack2(o[dt][4 * q4 + 2] * inv, o[dt][4 * q4 + 3] * inv));
        }
      if (hl == 0) { p.pm[pi] = m; p.pl[pi] = lt; }
    }
    D = Dn;
  }
}

__device__ __forceinline__ void ph_attn_combine(const int VB, const Params& p) {
  const int i = VB * 256 + threadIdx.x;
  const int dq = i & 7, th = i >> 3;
  const int t = th >> 2;
  const int own = (t & (SL - 1)) >> 8;
  const int nsel = own < 3 ? own : 3;
  float mv[4], wv[4];
  float M = p.pm[(size_t)th * 4 + 3];
  mv[3] = M;
#pragma unroll
  for (int sl = 0; sl < 3; ++sl) {
    mv[sl] = (sl < nsel) ? p.pm[(size_t)th * 4 + sl] : -1e30f;
    M = fmaxf(M, mv[sl]);
  }
  float W = 0.f;
#pragma unroll
  for (int sl = 0; sl < 4; ++sl) {
    const bool on = (sl == 3) || (sl < nsel);
    wv[sl] = on ? p.pl[(size_t)th * 4 + sl] * __builtin_amdgcn_exp2f(mv[sl] - M) : 0.f;
    W += wv[sl];
  }
  float acc[8];
#pragma unroll
  for (int k = 0; k < 8; ++k) acc[k] = 0.f;
#pragma unroll
  for (int sl = 0; sl < 4; ++sl) {
    const bool on = (sl == 3) || (sl < nsel);
    if (on) {
      float f[8];
      unpack8(*(const uint4*)(p.pO + ((size_t)th * 4 + sl) * 64 + dq * 8), f);
#pragma unroll
      for (int k = 0; k < 8; ++k) acc[k] = fmaf(wv[sl], f[k], acc[k]);
    }
  }
  const float inv = 1.f / W;
  const int h = th & 3;
  *(uint4*)(p.mixed_b + (size_t)t * DM + 512 + h * 64 + dq * 8) =
      make_uint4(pack2(acc[0] * inv, acc[1] * inv), pack2(acc[2] * inv, acc[3] * inv), pack2(acc[4] * inv, acc[5] * inv), pack2(acc[6] * inv, acc[7] * inv));
}


__device__ __forceinline__ int mkkey(const float f, const int idx, const int mask) {
  int b = __float_as_int(f);
  b = (b & ~mask) | idx;
  return b ^ ((b >> 31) & 0x7fffffff);
}
__device__ __forceinline__ int key2bits(const int k) { return k ^ ((k >> 31) & 0x7fffffff); }
#define CEI(a, b) { const int _mx = max(a, b), _mn = min(a, b); a = _mx; b = _mn; }
template <int N>
__device__ __forceinline__ void bitonic_sort_desc(int (&v)[N]) {
#pragma unroll
  for (int k = 2; k <= N; k <<= 1) {
#pragma unroll
    for (int j = k >> 1; j > 0; j >>= 1) {
#pragma unroll
      for (int i = 0; i < N; ++i) {
        const int l = i ^ j;
        if (l > i) {
          if ((i & k) == 0) { CEI(v[i], v[l]); } else { CEI(v[l], v[i]); }
        }
      }
    }
  }
}
__device__ __forceinline__ void merge16(int (&a)[16], const int (&b)[16]) {
#pragma unroll
  for (int i = 0; i < 16; ++i) a[i] = max(a[i], b[15 - i]);
#pragma unroll
  for (int j = 8; j > 0; j >>= 1) {
#pragma unroll
    for (int i = 0; i < 16; ++i) {
      const int l = i ^ j;
      if (l > i) { CEI(a[i], a[l]); }
    }
  }
}
__device__ __forceinline__ void merge_partner(int (&a)[16], const int xmask) {
  int o[16];
#pragma unroll
  for (int i = 0; i < 16; ++i) o[i] = __shfl_xor(a[i], xmask);
  merge16(a, o);
}
__device__ __forceinline__ bf16x8 pack_hi8(const float (&x)[8], float (&res)[8]) {
  unsigned u[4];
#pragma unroll
  for (int i = 0; i < 4; ++i) {
    const ushort_t h0 = f2bf(x[2 * i]), h1 = f2bf(x[2 * i + 1]);
    res[2 * i] = x[2 * i] - bf2f(h0);
    res[2 * i + 1] = x[2 * i + 1] - bf2f(h1);
    u[i] = (unsigned)h0 | ((unsigned)h1 << 16);
  }
  uint4 uu = make_uint4(u[0], u[1], u[2], u[3]);
  return *(bf16x8*)&uu;
}
__device__ __forceinline__ bf16x8 pack_8(const float (&x)[8]) {
  uint4 uu = make_uint4(pack2(x[0], x[1]), pack2(x[2], x[3]), pack2(x[4], x[5]), pack2(x[6], x[7]));
  return *(bf16x8*)&uu;
}

__device__ __forceinline__ void ph_gemm_route(const int vb, char* smem, const Params& p, const ushort_t* __restrict__ hn_b) {
  const int head = vb & 7, tt = vb >> 3;
  const int m0 = head * 128, n0 = tt * 128;
  f32x16 acc[2][2];
  gemm_core(p.w_qT, hn_b, DM, m0, n0, smem, acc);
  int tid = threadIdx.x;
  asm volatile("" : "+v"(tid));
  const int lane = tid & 63, r = lane & 31, hl = lane >> 5;
  const int wave = tid >> 6, wm = wave >> 1, wn = wave & 1;
  int* s_top = (int*)(smem + 34816);
  float rstd_tok[2];
#pragma unroll
  for (int ni = 0; ni < 2; ++ni) {
    const float4* hp = (const float4*)(p.hss + (size_t)(n0 + wn * 64 + ni * 32 + r) * 16);
    const float4 a = hp[0], b = hp[1], c = hp[2], d = hp[3];
    const float tot = ((a.x + a.y) + (a.z + a.w)) + ((b.x + b.y) + (b.z + b.w)) + ((c.x + c.y) + (c.z + c.w)) + ((d.x + d.y) + (d.z + d.w));
    rstd_tok[ni] = rsqrtf(tot * (1.f / DM) + EPS);
  }
  {
    const int row = tid >> 1, part = tid & 1;
#pragma unroll
    for (int hf = 0; hf < 2; ++hf) {
      const ushort_t* src = p.skh + (size_t)(hf * 128 + row) * 64 + part * 32;
      char* dst = smem + (hf * 128 + row) * 136 + part * 64;
#pragma unroll
      for (int c = 0; c < 4; ++c) {
        const uint4 v = *(const uint4*)(src + c * 8);
        *(uint2*)(dst + c * 16) = make_uint2(v.x, v.y);
        *(uint2*)(dst + c * 16 + 8) = make_uint2(v.z, v.w);
      }
    }
  }
  __syncthreads();
  const char* s_keys = smem + wm * 128 * 136;
#pragma unroll
  for (int ni = 0; ni < 2; ++ni) {
    asm volatile("" ::: "memory");
    bf16x8 qh[4], ql[4];
#pragma unroll
    for (int mi = 0; mi < 2; ++mi) {
#pragma unroll
      for (int k2 = 0; k2 < 2; ++k2) {
        float x[8], res[8];
#pragma unroll
        for (int j = 0; j < 8; ++j) x[j] = acc[mi][ni][8 * k2 + j] * rstd_tok[ni];
        qh[mi * 2 + k2] = pack_hi8(x, res);
        ql[mi * 2 + k2] = pack_8(res);
      }
    }
    int g0[16];
#pragma unroll
    for (int kh2 = 0; kh2 < 2; ++kh2) {
      int ga[16], gb[16];
#pragma unroll
      for (int kq = 0; kq < 2; ++kq) {
        const int kt = kh2 * 2 + kq;
        asm volatile("" ::: "memory");
        f32x16 sc;
#pragma unroll
        for (int e = 0; e < 16; ++e) sc[e] = 0.f;
#pragma unroll
        for (int st = 0; st < 4; ++st) {
          const int d0 = (st >> 1) * 32 + 16 * (st & 1) + 4 * hl;
          const char* kp = s_keys + (kt * 32 + r) * 136 + d0 * 2;
          const uint2 h0 = *(const uint2*)(kp), h1 = *(const uint2*)(kp + 16);
          uint4 hq = make_uint4(h0.x, h0.y, h1.x, h1.y);
          const bf16x8 ah = *(bf16x8*)&hq;
          sc = __builtin_amdgcn_mfma_f32_32x32x16_bf16(ah, qh[st], sc, 0, 0, 0);
          sc = __builtin_amdgcn_mfma_f32_32x32x16_bf16(ah, ql[st], sc, 0, 0, 0);
        }
        if (kq == 0) {
#pragma unroll
          for (int e = 0; e < 16; ++e) ga[e] = mkkey(sc[e], kt * 32 + (e & 3) + 8 * (e >> 2) + 4 * hl, 127);
          bitonic_sort_desc<16>(ga);
        } else {
#pragma unroll
          for (int e = 0; e < 16; ++e) gb[e] = mkkey(sc[e], kt * 32 + (e & 3) + 8 * (e >> 2) + 4 * hl, 127);
          bitonic_sort_desc<16>(gb);
        }
      }
      merge16(ga, gb);
      if (kh2 == 0) {
#pragma unroll
        for (int i = 0; i < 16; ++i) g0[i] = ga[i];
      } else {
        merge16(g0, ga);
      }
    }
    merge_partner(g0, 32);
    {
      int* dst = s_top + ((size_t)wm * 128 + wn * 64 + ni * 32 + r) * 16 + hl * 8;
      int4 w0, w1;
      int lo8[8], hi8[8];
#pragma unroll
      for (int i = 0; i < 8; ++i) { lo8[i] = g0[i]; hi8[i] = g0[8 + i]; asm volatile("" : "+v"(lo8[i]), "+v"(hi8[i])); }
      w0 = make_int4(hl ? hi8[0] : lo8[0], hl ? hi8[1] : lo8[1], hl ? hi8[2] : lo8[2], hl ? hi8[3] : lo8[3]);
      w1 = make_int4(hl ? hi8[4] : lo8[4], hl ? hi8[5] : lo8[5], hl ? hi8[6] : lo8[6], hl ? hi8[7] : lo8[7]);
      *(int4*)dst = w0; *(int4*)(dst + 4) = w1;
    }
  }
  __syncthreads();
  {
    const int tok = tid >> 1, sub = tid & 1;
    int k1[16], k2[16];
    {
      const int4* a = (const int4*)(s_top + (size_t)tok * 16);
      const int4* b = (const int4*)(s_top + (size_t)(128 + tok) * 16);
#pragma unroll
      for (int i = 0; i < 4; ++i) {
        const int4 x = a[i], y = b[i];
        k1[4 * i] = x.x; k1[4 * i + 1] = x.y; k1[4 * i + 2] = x.z; k1[4 * i + 3] = x.w;
        k2[4 * i] = y.x; k2[4 * i + 1] = y.y; k2[4 * i + 2] = y.z; k2[4 * i + 3] = y.w;
      }
    }
    float v1f[16], v2f[16];
#pragma unroll
    for (int i = 0; i < 16; ++i) { v1f[i] = __int_as_float(key2bits(k1[i])); v2f[i] = __int_as_float(key2bits(k2[i])); }
    int c[32];
    c[0] = sub ? mkkey(v1f[3] + v2f[3], 51, 255) : mkkey(v1f[0] + v2f[0], 0, 255);
    c[1] = sub ? mkkey(v1f[4] + v2f[0], 64, 255) : mkkey(v1f[0] + v2f[1], 1, 255);
    c[2] = sub ? mkkey(v1f[4] + v2f[1], 65, 255) : mkkey(v1f[0] + v2f[2], 2, 255);
    c[3] = sub ? mkkey(v1f[4] + v2f[2], 66, 255) : mkkey(v1f[0] + v2f[3], 3, 255);
    c[4] = sub ? mkkey(v1f[5] + v2f[0], 80, 255) : mkkey(v1f[0] + v2f[4], 4, 255);
    c[5] = sub ? mkkey(v1f[5] + v2f[1], 81, 255) : mkkey(v1f[0] + v2f[5], 5, 255);
    c[6] = sub ? mkkey(v1f[6] + v2f[0], 96, 255) : mkkey(v1f[0] + v2f[6], 6, 255);
    c[7] = sub ? mkkey(v1f[6] + v2f[1], 97, 255) : mkkey(v1f[0] + v2f[7], 7, 255);
    c[8] = sub ? mkkey(v1f[7] + v2f[0], 112, 255) : mkkey(v1f[0] + v2f[8], 8, 255);
    c[9] = sub ? mkkey(v1f[7] + v2f[1], 113, 255) : mkkey(v1f[0] + v2f[9], 9, 255);
    c[10] = sub ? mkkey(v1f[8] + v2f[0], 128, 255) : mkkey(v1f[0] + v2f[10], 10, 255);
    c[11] = sub ? mkkey(v1f[9] + v2f[0], 144, 255) : mkkey(v1f[0] + v2f[11], 11, 255);
    c[12] = sub ? mkkey(v1f[10] + v2f[0], 160, 255) : mkkey(v1f[0] + v2f[12], 12, 255);
    c[13] = sub ? mkkey(v1f[11] + v2f[0], 176, 255) : mkkey(v1f[0] + v2f[13], 13, 255);
    c[14] = sub ? mkkey(v1f[12] + v2f[0], 192, 255) : mkkey(v1f[0] + v2f[14], 14, 255);
    c[15] = sub ? mkkey(v1f[13] + v2f[0], 208, 255) : mkkey(v1f[0] + v2f[15], 15, 255);
    c[16] = sub ? mkkey(v1f[14] + v2f[0], 224, 255) : mkkey(v1f[1] + v2f[0], 16, 255);
    c[17] = sub ? mkkey(v1f[15] + v2f[0], 240, 255) : mkkey(v1f[1] + v2f[1], 17, 255);
    c[18] = sub ? (int)0x80000000 : mkkey(v1f[1] + v2f[2], 18, 255);
    c[19] = sub ? (int)0x80000000 : mkkey(v1f[1] + v2f[3], 19, 255);
    c[20] = sub ? (int)0x80000000 : mkkey(v1f[1] + v2f[4], 20, 255);
    c[21] = sub ? (int)0x80000000 : mkkey(v1f[1] + v2f[5], 21, 255);
    c[22] = sub ? (int)0x80000000 : mkkey(v1f[1] + v2f[6], 22, 255);
    c[23] = sub ? (int)0x80000000 : mkkey(v1f[1] + v2f[7], 23, 255);
    c[24] = sub ? (int)0x80000000 : mkkey(v1f[2] + v2f[0], 32, 255);
    c[25] = sub ? (int)0x80000000 : mkkey(v1f[2] + v2f[1], 33, 255);
    c[26] = sub ? (int)0x80000000 : mkkey(v1f[2] + v2f[2], 34, 255);
    c[27] = sub ? (int)0x80000000 : mkkey(v1f[2] + v2f[3], 35, 255);
    c[28] = sub ? (int)0x80000000 : mkkey(v1f[2] + v2f[4], 36, 255);
    c[29] = sub ? (int)0x80000000 : mkkey(v1f[3] + v2f[0], 48, 255);
    c[30] = sub ? (int)0x80000000 : mkkey(v1f[3] + v2f[1], 49, 255);
    c[31] = sub ? (int)0x80000000 : mkkey(v1f[3] + v2f[2], 50, 255);
    int h0[16], h1[16];
#pragma unroll
    for (int i = 0; i < 16; ++i) { h0[i] = c[i]; h1[i] = c[16 + i]; }
    bitonic_sort_desc<16>(h0); bitonic_sort_desc<16>(h1);
    merge16(h0, h1);
    merge_partner(h0, 1);
    float sv[16];
#pragma unroll
    for (int i = 0; i < 16; ++i) sv[i] = __int_as_float(key2bits(h0[i]));
    float den = 0.f;
#pragma unroll
    for (int i = 0; i < 16; ++i) den += __expf(sv[i] - sv[0]);
    const float inv = 1.f / den;
    int eo[8]; float go[8];
#pragma unroll
    for (int i = 0; i < 8; ++i) {
      int klo = h0[i], khi = h0[8 + i];
      asm volatile("" : "+v"(klo), "+v"(khi));
      const int kk = sub ? khi : klo;
      const int bits = key2bits(kk);
      const int code = bits & 255;
      const int ia = key2bits(s_top[(size_t)tok * 16 + (code >> 4)]) & 127;
      const int ib = key2bits(s_top[(size_t)(128 + tok) * 16 + (code & 15)]) & 127;
      eo[i] = ia * 128 + ib;
      go[i] = __expf(__int_as_float(bits) - sv[0]) * inv;
    }
    const size_t ob = ((size_t)(n0 + tok) * 8 + head) * 16 + sub * 8;
    *(int4*)(p.eidx + ob) = make_int4(eo[0], eo[1], eo[2], eo[3]);
    *(int4*)(p.eidx + ob + 4) = make_int4(eo[4], eo[5], eo[6], eo[7]);
    *(float4*)(p.egate + ob) = make_float4(go[0], go[1], go[2], go[3]);
    *(float4*)(p.egate + ob + 4) = make_float4(go[4], go[5], go[6], go[7]);
  }
}

__device__ __forceinline__ void ph_subkeys(const Params& p) {
  for (int i = blockIdx.x * 256 + threadIdx.x; i < 2 * 128 * 64; i += gridDim.x * 256) {
    const float v = (i < 8192) ? p.sk1[i] : p.sk2[i - 8192];
    const ushort_t hi = f2bf(v);
    p.skh[i] = hi;
    p.skl[i] = f2bf(v - bf2f(hi));
  }
}

__device__ __forceinline__ float dot16_fp8(const uint4 d, const float (&x)[16], float c) {
  const unsigned w[4] = {d.x, d.y, d.z, d.w};
#pragma unroll
  for (int i = 0; i < 4; ++i) {
    const f32x2_t lo = __builtin_amdgcn_cvt_pk_f32_fp8((int)w[i], false);
    const f32x2_t hi = __builtin_amdgcn_cvt_pk_f32_fp8((int)w[i], true);
    c = fmaf(lo.x, x[4 * i], c); c = fmaf(lo.y, x[4 * i + 1], c); c = fmaf(hi.x, x[4 * i + 2], c); c = fmaf(hi.y, x[4 * i + 3], c);
  }
  return c;
}
__device__ __forceinline__ void axpy16_fp8(const float cf, const uint4 u, float (&acc)[16]) {
  const unsigned w[4] = {u.x, u.y, u.z, u.w};
#pragma unroll
  for (int i = 0; i < 4; ++i) {
    const f32x2_t lo = __builtin_amdgcn_cvt_pk_f32_fp8((int)w[i], false);
    const f32x2_t hi = __builtin_amdgcn_cvt_pk_f32_fp8((int)w[i], true);
    acc[4 * i] = fmaf(cf, lo.x, acc[4 * i]); acc[4 * i + 1] = fmaf(cf, lo.y, acc[4 * i + 1]);
    acc[4 * i + 2] = fmaf(cf, hi.x, acc[4 * i + 2]); acc[4 * i + 3] = fmaf(cf, hi.y, acc[4 * i + 3]);
  }
}
constexpr int EX_NTOK = 4;
__device__ __forceinline__ void peer_chunk(const Params& p, const int lane, const int myex, const bool b5, const bool b4, const bool b3,
                                           const int (&ce)[8], const float (&cg)[8], const f32x2_t (&x2)[8], f32x2_t (&acc2)[8]) {
  drow_t d[8];
  urow_t u[8];
  float sd[8], su[8];
#pragma unroll
  for (int i = 0; i < 8; ++i) d[i] = *(const drow_t*)(p.ed8 + ((size_t)ce[i] * 64 + lane) * DROW_BYTES);
#pragma unroll
  for (int i = 0; i < 8; ++i) u[i] = *(const urow_t*)(p.eu8 + ((size_t)ce[i] * 64 + lane) * UROW_BYTES);
#pragma unroll
  for (int i = 0; i < 8; ++i) { sd[i] = p.ed_s[ce[i]]; su[i] = p.eu_s[ce[i]] * cg[i]; }
  float pr[8];
#pragma unroll
  for (int i = 0; i < 8; ++i) {
    f32x2_t dd[8];
    DEC_D(d[i], dd);
    f32x2_t a2 = {0.f, 0.f};
#pragma unroll
    for (int k = 0; k < 8; ++k) a2 = dd[k] * x2[k] + a2;
    pr[i] = (a2.x + a2.y) * sd[i];
  }
  float q4[4];
#pragma unroll
  for (int i = 0; i < 4; ++i) {
    const float snd = b5 ? pr[i] : pr[i + 4];
    const float kp = b5 ? pr[i + 4] : pr[i];
    q4[i] = kp + __shfl_xor(snd, 32);
  }
  float q2[2];
#pragma unroll
  for (int i = 0; i < 2; ++i) {
    const float snd = b4 ? q4[i] : q4[i + 2];
    const float kp = b4 ? q4[i + 2] : q4[i];
    q2[i] = kp + __shfl_xor(snd, 16);
  }
  float q1;
  {
    const float snd = b3 ? q2[0] : q2[1];
    const float kp = b3 ? q2[1] : q2[0];
    q1 = kp + __shfl_xor(snd, 8);
  }
  q1 += __shfl_xor(q1, 4);
  q1 += __shfl_xor(q1, 2);
  q1 += __shfl_xor(q1, 1);
  const float act = gelu_f(q1);
#pragma unroll
  for (int i = 0; i < 8; ++i) {
    const int src = ((i >> 2) & 1) * 32 + ((i >> 1) & 1) * 16 + (i & 1) * 8;
    const float cf = __int_as_float(__builtin_amdgcn_readlane(__float_as_int(act), src)) * su[i];
    const f32x2_t cf2 = {cf, cf};
    f32x2_t uu[8];
    DEC_U(u[i], uu);
#pragma unroll
    for (int k = 0; k < 8; ++k) acc2[k] = cf2 * uu[k] + acc2[k];
  }
}

#ifndef EX_SWEEP
#define EX_SWEEP 0
#endif
#if !EX_SWEEP
typedef __attribute__((ext_vector_type(8))) int v8i_t;
typedef __attribute__((ext_vector_type(2))) int v2i_t;
typedef __attribute__((ext_vector_type(4))) float f32x4_t;
__device__ __forceinline__ void sort128(int& v0, int& v1, const int lane) {
#pragma unroll
  for (int k = 2; k <= 128; k <<= 1) {
#pragma unroll
    for (int j = k >> 1; j > 0; j >>= 1) {
      if (j == 1) {
        const bool up = ((lane * 2) & k) == 0;
        const int mn = min(v0, v1), mx = max(v0, v1);
        v0 = up ? mn : mx;
        v1 = up ? mx : mn;
      } else {
        const int o0 = __shfl_xor(v0, j >> 1), o1 = __shfl_xor(v1, j >> 1);
        const bool up = ((lane * 2) & k) == 0;
        const bool lower = ((lane * 2) & j) == 0;
        const bool takemin = (up == lower);
        v0 = takemin ? min(v0, o0) : max(v0, o0);
        v1 = takemin ? min(v1, o1) : max(v1, o1);
      }
    }
  }
}
__device__ __forceinline__ void k_peer_experts(const int VB, char* smem, const Params& p, const ushort_t* __restrict__ hn) {
  const int lane = threadIdx.x & 63;
  const int wave = __builtin_amdgcn_readfirstlane(threadIdx.x >> 6);
  const int t = VB * 4 + wave;
  const int li = lane & 15, g = lane >> 4;
  char* sx = smem + wave * 1024;
  {
    const float* hrow = p.out + (size_t)t * DM + lane * 16;
    const float* wrow = p.ffn_norm_w + lane * 16;
    float4 hv[4], wv[4];
#pragma unroll
    for (int i = 0; i < 4; ++i) { hv[i] = *(const float4*)(hrow + i * 4); wv[i] = *(const float4*)(wrow + i * 4); }
    float ss = 0.f;
#pragma unroll
    for (int i = 0; i < 4; ++i) ss += hv[i].x * hv[i].x + hv[i].y * hv[i].y + hv[i].z * hv[i].z + hv[i].w * hv[i].w;
    ss = wave_sum(ss);
    const float rs = rsqrtf(ss * (1.f / DM) + EPS) * 16.f;
    int wq[4];
#pragma unroll
    for (int i = 0; i < 4; ++i) {
      int w = 0;
      w = __builtin_amdgcn_cvt_pk_fp8_f32(hv[i].x * rs * wv[i].x, hv[i].y * rs * wv[i].y, w, false);
      w = __builtin_amdgcn_cvt_pk_fp8_f32(hv[i].z * rs * wv[i].z, hv[i].w * rs * wv[i].w, w, true);
      wq[i] = w;
    }
    *(int4*)(sx + lane * 16) = make_int4(wq[0], wq[1], wq[2], wq[3]);
  }
  v8i_t xb[8];
#pragma unroll
  for (int st = 0; st < 8; ++st) {
    const int4 lo = *(const int4*)(sx + st * 128 + g * 16);
    const int4 hi = *(const int4*)(sx + st * 128 + 64 + g * 16);
    xb[st] = v8i_t{lo.x, lo.y, lo.z, lo.w, hi.x, hi.y, hi.z, hi.w};
  }
  f32x2_t acc2[8];
#pragma unroll
  for (int i = 0; i < 8; ++i) acc2[i] = f32x2_t{0.f, 0.f};
  int kq0, kq1;
  {
    const int2 ev = *(const int2*)(p.eidx + (size_t)t * 128 + lane * 2);
    kq0 = (ev.x << 7) | (lane * 2);
    kq1 = (ev.y << 7) | (lane * 2 + 1);
    sort128(kq0, kq1, lane);
  }
  const int ev0 = kq0 >> 7, ev1 = kq1 >> 7;
  const float sdv0 = p.ed_s[ev0], sdv1 = p.ed_s[ev1];
  const float suv0 = p.eu_s[ev0] * p.egate[(size_t)t * 128 + (kq0 & 127)], suv1 = p.eu_s[ev1] * p.egate[(size_t)t * 128 + (kq1 & 127)];
#pragma unroll 1
  for (int c = 0; c < 8; ++c) {
    const int lbase = c * 8;
    const int ea = __shfl(ev0, lbase + (li >> 1)), eb = __shfl(ev1, lbase + (li >> 1));
    const int e_lane = (li & 1) ? eb : ea;
    const unsigned char* arow = p.ed8 + (size_t)e_lane * 512 + g * 16;
    uint4 a[8];
#pragma unroll
    for (int st = 0; st < 8; ++st) a[st] = *(const uint4*)(arow + st * 64);
    urow_t u[16];
#pragma unroll
    for (int i = 0; i < 16; ++i) {
      const int ei_s = __builtin_amdgcn_readlane((i & 1) ? ev1 : ev0, lbase + (i >> 1));
      u[i] = *(const urow_t*)(p.eu8 + ((size_t)ei_s * 64 + lane) * UROW_BYTES);
    }
    const int mrow = 4 * g + (li & 3);
    const float sda = __shfl(sdv0, lbase + (mrow >> 1)), sdb = __shfl(sdv1, lbase + (mrow >> 1));
    const float sua = __shfl(suv0, lbase + (mrow >> 1)), sub = __shfl(suv1, lbase + (mrow >> 1));
    const float sd_m = (mrow & 1) ? sdb : sda, su_m = (mrow & 1) ? sub : sua;
    f32x4_t d4 = {0.f, 0.f, 0.f, 0.f};
#pragma unroll
    for (int st = 0; st < 8; ++st) {
      const v8i_t av = v8i_t{(int)a[st].x, (int)a[st].y, (int)a[st].z, (int)a[st].w, 0, 0, 0, 0};
      d4 = __builtin_amdgcn_mfma_scale_f32_16x16x128_f8f6f4(av, xb[st], d4, 4, 0, 0, 0x7f7f7f7f, 0, 0x7f7f7f7f);
    }
    const int rsel = li & 3;
    const float dsel = rsel == 0 ? d4[0] : rsel == 1 ? d4[1] : rsel == 2 ? d4[2] : d4[3];
    const float cvs = gelu_fast(dsel * sd_m * 0.0625f) * su_m;
#pragma unroll
    for (int i = 0; i < 16; ++i) {
      const float cf = __int_as_float(__builtin_amdgcn_readlane(__float_as_int(cvs), 16 * (i >> 2) + (i & 3)));
      const f32x2_t cf2 = {cf, cf};
      f32x2_t uu[8];
      DEC_U(u[i], uu);
#pragma unroll
      for (int k = 0; k < 8; ++k) acc2[k] = cf2 * uu[k] + acc2[k];
    }
  }
  float* orow = p.out + (size_t)t * DM + lane * 16;
#pragma unroll
  for (int i = 0; i < 4; ++i) {
    float4 hv = *(float4*)(orow + i * 4);
    hv.x += acc2[2 * i].x; hv.y += acc2[2 * i].y; hv.z += acc2[2 * i + 1].x; hv.w += acc2[2 * i + 1].y;
    *(float4*)(orow + i * 4) = hv;
  }
}

__device__ __forceinline__ void ex2_loadA(uint4 (&a)[8], const Params& p, const unsigned short* sidx, const int s, const int li, const int g) {
  const int c = s >> 3, k = s & 7;
  const int e0 = sidx[k * 128 + c * 16 + (li >> 1)], e1 = sidx[k * 128 + c * 16 + 8 + (li >> 1)];
  const unsigned char* r0 = p.ed8 + (size_t)e0 * 512 + (li & 1) * 64 + g * 16;
  const unsigned char* r1 = p.ed8 + (size_t)e1 * 512 + (li & 1) * 64 + g * 16;
#pragma unroll
  for (int q = 0; q < 4; ++q) { a[q] = *(const uint4*)(r0 + q * 128); a[4 + q] = *(const uint4*)(r1 + q * 128); }
}
__device__ __forceinline__ void ex2_down(const uint4 (&a)[8], const char* sx, float* scf, const float* ssd, const int s, const int li, const int g) {
  const int c = s >> 3, k = s & 7;
  const char* sxk = sx + k * 1024 + (li & 1) * 128 + g * 16;
  f32x4_t d0 = {0.f, 0.f, 0.f, 0.f}, d1 = {0.f, 0.f, 0.f, 0.f};
#pragma unroll
  for (int q = 0; q < 4; ++q) {
    const int4 lo = *(const int4*)(sxk + q * 256);
    const int4 hi = *(const int4*)(sxk + q * 256 + 64);
    const v8i_t xb = v8i_t{lo.x, lo.y, lo.z, lo.w, hi.x, hi.y, hi.z, hi.w};
    const v8i_t a0 = v8i_t{(int)a[q].x, (int)a[q].y, (int)a[q].z, (int)a[q].w, 0, 0, 0, 0};
    const v8i_t a1 = v8i_t{(int)a[4 + q].x, (int)a[4 + q].y, (int)a[4 + q].z, (int)a[4 + q].w, 0, 0, 0, 0};
    d0 = __builtin_amdgcn_mfma_scale_f32_16x16x128_f8f6f4(a0, xb, d0, 4, 0, 0, 0x7f7f7f7f, 0, 0x7f7f7f7f);
    d1 = __builtin_amdgcn_mfma_scale_f32_16x16x128_f8f6f4(a1, xb, d1, 4, 0, 0, 0x7f7f7f7f, 0, 0x7f7f7f7f);
  }
  const bool odd = (li & 1) != 0;
  float t00 = odd ? d0[1] : d0[0], t01 = odd ? d0[3] : d0[2], t10 = odd ? d1[1] : d1[0], t11 = odd ? d1[3] : d1[2];
  t00 += __shfl_xor(t00, 1); t01 += __shfl_xor(t01, 1); t10 += __shfl_xor(t10, 1); t11 += __shfl_xor(t11, 1);
  const bool eh = (li & 2) != 0, jj = (li & 4) != 0;
  const float dsel = eh ? (jj ? t11 : t10) : (jj ? t01 : t00);
  const int mexp = (eh ? 8 : 0) + 2 * g + (jj ? 1 : 0);
  const float sd_m = ssd[k * 128 + c * 16 + mexp], su_m = scf[k * 128 + c * 16 + mexp];
  const float cvs = gelu_fast(dsel * sd_m * 0.0625f) * su_m;
  if ((li & 9) == 0) scf[k * 128 + c * 16 + mexp] = cvs;
}
__device__ __forceinline__ void ex2_loadU(urow_t (&u)[16], float& cv, const Params& p, const unsigned short* sidx, const float* scf, const int k, const int c,
                                          const int li, const int lane) {
  const int iv = sidx[k * 128 + c * 16 + li];
  cv = scf[k * 128 + c * 16 + li];
  const __amdgpu_buffer_rsrc_t rs = __builtin_amdgcn_make_buffer_rsrc((void*)p.eu8, 0, 16384 * 64 * UROW_BYTES, 0x00020000);
  const int loff = lane * UROW_BYTES;
#pragma unroll
  for (int i = 0; i < 16; ++i) {
    const int ei_s = __builtin_amdgcn_readlane(iv, i);
    const v2i_t v = __builtin_amdgcn_raw_buffer_load_b64(rs, loff, ei_s * (64 * UROW_BYTES), 0);
    u[i] = make_uint2((unsigned)v.x, (unsigned)v.y);
  }
}
__device__ __forceinline__ void ex2_up(const urow_t (&u)[16], const float cv, f32x2_t (&acc)[8]) {
#pragma unroll
  for (int i = 0; i < 16; ++i) {
    const float cf = __int_as_float(__builtin_amdgcn_readlane(__float_as_int(cv), i));
    const f32x2_t cf2 = {cf, cf};
    f32x2_t uu[8];
    DEC_U(u[i], uu);
#pragma unroll
    for (int q = 0; q < 8; ++q) acc[q] = cf2 * uu[q] + acc[q];
  }
}
__device__ __forceinline__ void k_peer_experts2(const int VB, char* smem, const Params& p) {
  const int lane = threadIdx.x & 63;
  const int wave = __builtin_amdgcn_readfirstlane(threadIdx.x >> 6);
  const int li = lane & 15, g = lane >> 4;
  char* sx = smem + wave * 18432;
  float* scf = (float*)(sx + 8192);
  float* ssd = (float*)(sx + 12288);
  unsigned short* sidx = (unsigned short*)(sx + 16384);
  const int tbase = VB * 4 + wave;
  {
    float4 wv[4];
    float4 hv[8][4];
    int2 evr[8];
#pragma unroll
    for (int i = 0; i < 4; ++i) wv[i] = *(const float4*)(p.ffn_norm_w + lane * 16 + i * 4);
#pragma unroll
    for (int k = 0; k < 8; ++k) {
      const int t = tbase + k * (NT / 8);
#pragma unroll
      for (int i = 0; i < 4; ++i) hv[k][i] = *(const float4*)(p.out + (size_t)t * DM + lane * 16 + i * 4);
      evr[k] = *(const int2*)(p.eidx + (size_t)t * 128 + lane * 2);
    }
    float gsd0[8], gsd1[8], gsu0[8], gsu1[8], gg0[8], gg1[8];
#pragma unroll
    for (int k = 0; k < 8; ++k) {
      const int t = tbase + k * (NT / 8);
      float ss = 0.f;
#pragma unroll
      for (int i = 0; i < 4; ++i) ss += hv[k][i].x * hv[k][i].x + hv[k][i].y * hv[k][i].y + hv[k][i].z * hv[k][i].z + hv[k][i].w * hv[k][i].w;
      ss = wave_sum(ss);
      const float rs = rsqrtf(ss * (1.f / DM) + EPS) * 16.f;
      int wq[4];
#pragma unroll
      for (int i = 0; i < 4; ++i) {
        int w = 0;
        w = __builtin_amdgcn_cvt_pk_fp8_f32(hv[k][i].x * rs * wv[i].x, hv[k][i].y * rs * wv[i].y, w, false);
        w = __builtin_amdgcn_cvt_pk_fp8_f32(hv[k][i].z * rs * wv[i].z, hv[k][i].w * rs * wv[i].w, w, true);
        wq[i] = w;
      }
      *(int4*)(sx + k * 1024 + lane * 16) = make_int4(wq[0], wq[1], wq[2], wq[3]);
      int kq0 = (evr[k].x << 7) | (lane * 2), kq1 = (evr[k].y << 7) | (lane * 2 + 1);
      sort128(kq0, kq1, lane);
      const int ev0 = kq0 >> 7, ev1 = kq1 >> 7;
      gsd0[k] = p.ed_s[ev0]; gsd1[k] = p.ed_s[ev1];
      gsu0[k] = p.eu_s[ev0]; gsu1[k] = p.eu_s[ev1];
      gg0[k] = p.egate[(size_t)t * 128 + (kq0 & 127)]; gg1[k] = p.egate[(size_t)t * 128 + (kq1 & 127)];
      *(unsigned*)(sidx + k * 128 + lane * 2) = (unsigned)ev0 | ((unsigned)ev1 << 16);
    }
#pragma unroll
    for (int k = 0; k < 8; ++k) {
      *(float2*)(ssd + k * 128 + lane * 2) = make_float2(gsd0[k], gsd1[k]);
      *(float2*)(scf + k * 128 + lane * 2) = make_float2(gsu0[k] * gg0[k], gsu1[k] * gg1[k]);
    }
  }
  asm volatile("s_waitcnt lgkmcnt(0)" ::: "memory");
  {
    uint4 aA[8], aB[8];
    ex2_loadA(aA, p, sidx, 0, li, g);
#pragma unroll 1
    for (int s2 = 0; s2 < 32; ++s2) {
      ex2_loadA(aB, p, sidx, 2 * s2 + 1, li, g);
      asm volatile("" ::: "memory");
      ex2_down(aA, sx, scf, ssd, 2 * s2, li, g);
      asm volatile("" ::: "memory");
      ex2_loadA(aA, p, sidx, min(2 * s2 + 2, 63), li, g);
      asm volatile("" ::: "memory");
      ex2_down(aB, sx, scf, ssd, 2 * s2 + 1, li, g);
      asm volatile("" ::: "memory");
    }
  }
  asm volatile("s_waitcnt lgkmcnt(0)" ::: "memory");
#pragma unroll 1
  for (int r = 0; r < 2; ++r) {
    f32x2_t acc2[4][8];
#pragma unroll
    for (int kk = 0; kk < 4; ++kk)
#pragma unroll
      for (int i = 0; i < 8; ++i) acc2[kk][i] = f32x2_t{0.f, 0.f};
    urow_t uA[16], uB[16];
    float cvA, cvB;
    ex2_loadU(uA, cvA, p, sidx, scf, r * 4, 0, li, lane);
#pragma unroll 1
    for (int c = 0; c < 8; ++c) {
      ex2_loadU(uB, cvB, p, sidx, scf, r * 4 + 1, c, li, lane);
      ex2_up(uA, cvA, acc2[0]);
      ex2_loadU(uA, cvA, p, sidx, scf, r * 4 + 2, c, li, lane);
      ex2_up(uB, cvB, acc2[1]);
      ex2_loadU(uB, cvB, p, sidx, scf, r * 4 + 3, c, li, lane);
      ex2_up(uA, cvA, acc2[2]);
      ex2_loadU(uA, cvA, p, sidx, scf, r * 4, min(c + 1, 7), li, lane);
      ex2_up(uB, cvB, acc2[3]);
    }
#pragma unroll
    for (int kk = 0; kk < 4; ++kk) {
      const int t = tbase + (r * 4 + kk) * (NT / 8);
      float* orow = p.out + (size_t)t * DM + lane * 16;
#pragma unroll
      for (int i = 0; i < 4; ++i) {
        float4 hv = *(float4*)(orow + i * 4);
        hv.x += acc2[kk][2 * i].x; hv.y += acc2[kk][2 * i].y; hv.z += acc2[kk][2 * i + 1].x; hv.w += acc2[kk][2 * i + 1].y;
        *(float4*)(orow + i * 4) = hv;
      }
    }
  }
}
#define EX_TOK_PER_VB 4
#else
#define EX_TOK_PER_VB (4 * EX_NTOK)
__device__ __forceinline__ void k_peer_experts(const int VB, const Params& p, const ushort_t* __restrict__ hn) {
  const int lane = threadIdx.x & 63;
  const int wave = __builtin_amdgcn_readfirstlane(threadIdx.x >> 6);
  const int t0 = (VB * 4 + wave) * EX_NTOK;
  const int myex = ((lane >> 5) & 1) * 4 + ((lane >> 4) & 1) * 2 + ((lane >> 3) & 1);
  const bool b5 = (lane & 32) != 0, b4 = (lane & 16) != 0, b3 = (lane & 8) != 0;
  f32x2_t x2[EX_NTOK][8], acc2[EX_NTOK][8];
  int e0[EX_NTOK], e1[EX_NTOK];
  float g0[EX_NTOK], g1[EX_NTOK];
#pragma unroll
  for (int k = 0; k < EX_NTOK; ++k) {
    float f0[8], f1[8];
    unpack8(*(const uint4*)(hn + (size_t)(t0 + k) * DM + lane * 16), f0);
    unpack8(*(const uint4*)(hn + (size_t)(t0 + k) * DM + lane * 16 + 8), f1);
#pragma unroll
    for (int i = 0; i < 4; ++i) {
      x2[k][i] = f32x2_t{f0[2 * i], f0[2 * i + 1]};
      x2[k][4 + i] = f32x2_t{f1[2 * i], f1[2 * i + 1]};
    }
#pragma unroll
    for (int i = 0; i < 8; ++i) acc2[k][i] = f32x2_t{0.f, 0.f};
    e0[k] = p.eidx[(size_t)(t0 + k) * 128 + lane];
    e1[k] = p.eidx[(size_t)(t0 + k) * 128 + 64 + lane];
    g0[k] = p.egate[(size_t)(t0 + k) * 128 + lane];
    g1[k] = p.egate[(size_t)(t0 + k) * 128 + 64 + lane];
  }
#pragma unroll 1
  for (int s = 0; s < 16; ++s) {
#pragma unroll
    for (int k = 0; k < EX_NTOK; ++k) {
      unsigned long long m0 = __ballot((e0[k] >> 10) == s);
      unsigned long long m1 = __ballot((e1[k] >> 10) == s);
      while ((m0 | m1) != 0ull) {
        int ce[8];
        float cg[8];
#pragma unroll
        for (int i = 0; i < 8; ++i) {
          int ev = 0;
          float gv = 0.f;
          if (m0 != 0ull) {
            const int ln = __builtin_ctzll(m0);
            m0 &= m0 - 1ull;
            ev = __builtin_amdgcn_readlane(e0[k], ln);
            gv = __int_as_float(__builtin_amdgcn_readlane(__float_as_int(g0[k]), ln));
          } else if (m1 != 0ull) {
            const int ln = __builtin_ctzll(m1);
            m1 &= m1 - 1ull;
            ev = __builtin_amdgcn_readlane(e1[k], ln);
            gv = __int_as_float(__builtin_amdgcn_readlane(__float_as_int(g1[k]), ln));
          }
          ce[i] = ev;
          cg[i] = gv;
        }
        peer_chunk(p, lane, myex, b5, b4, b3, ce, cg, x2[k], acc2[k]);
      }
    }
  }
#pragma unroll
  for (int k = 0; k < EX_NTOK; ++k) {
    float* orow = p.out + (size_t)(t0 + k) * DM + lane * 16;
#pragma unroll
    for (int i = 0; i < 4; ++i) {
      float4 hv = *(float4*)(orow + i * 4);
      hv.x += acc2[k][2 * i].x; hv.y += acc2[k][2 * i].y; hv.z += acc2[k][2 * i + 1].x; hv.w += acc2[k][2 * i + 1].y;
      *(float4*)(orow + i * 4) = hv;
    }
  }
}

#endif

#define PHASE(NBLK, CALL) \
  for (int VB = blockIdx.x; VB < (NBLK); VB += gridDim.x) { CALL; __syncthreads(); }
#define PHASE_NS(NBLK, CALL) \
  for (int VB = blockIdx.x; VB < (NBLK); VB += gridDim.x) { CALL; }
#define PHASE_OFF(OFF, NBLK, CALL) \
  for (int VB = (int)((blockIdx.x + gridDim.x - ((OFF) % gridDim.x)) % gridDim.x); VB < (NBLK); VB += gridDim.x) { CALL; __syncthreads(); }

__global__ __launch_bounds__(256, 2) void fwd_megakernel(Params p) {
  __shared__ __attribute__((aligned(16))) char smem_raw[SMEM_BYTES];
  float* smem = (float*)smem_raw;
  volatile LAS unsigned* xb_st = (volatile LAS unsigned*)(smem_raw + 73728);
  if (threadIdx.x == 0) { xb_st[0] = 0u; xb_st[1] = 0u; xb_st[2] = 0u; xb_st[3] = 0u; }
  __syncthreads();
  const XcdBarrier xb = xcd_barrier_post(p.bar, xb_st);
  {
    for (int k = threadIdx.x; k < DM; k += 256) {
      const float* wr = p.w_in + (size_t)k * INC + 1536;
      const float4 a = *(const float4*)(wr), b = *(const float4*)(wr + 4);
      smem[0 * 1024 + k] = a.x; smem[1 * 1024 + k] = a.y; smem[2 * 1024 + k] = a.z; smem[3 * 1024 + k] = a.w;
      smem[4 * 1024 + k] = b.x; smem[5 * 1024 + k] = b.y; smem[6 * 1024 + k] = b.z; smem[7 * 1024 + k] = b.w;
    }
    __syncthreads();
    PHASE_NS(NT / 8, ph_rmsnorm_bf16(VB, p.x, p.mix_norm_w, p.xn_b, smem, p.dt_bias, p.dt));
    __syncthreads();
  }
  PHASE_NS(NB * MEM / 8, ph_rmsnorm_bf16(VB, p.mem, p.mem_norm_w, p.memn_b, nullptr, nullptr, nullptr));
  PHASE(16 * 40, ph_wtrans(VB, smem, p.w_in, INC, p.w_inT, 40, 8, nullptr));
  PHASE(16 * 16, ph_wtrans(VB, smem, p.w_out, DM, p.w_outT, 16, 0, nullptr));
  PHASE(16 * 16, ph_wtrans(VB, smem, p.w_query, DM, p.w_qT, 16, 0, p.ffn_norm_w));
  PHASE(16 * 8, ph_wtrans(VB, smem, p.w_mem_kv, 512, p.w_memT, 8, 0, nullptr));
  if (blockIdx.x == 0) p.bcnt[threadIdx.x] = 0;
  ph_subkeys(p);
  xcd_barrier(xb);
  PHASE_NS(NB * 64 * 8 / 4, ph_acs(VB, p));
  PHASE(20 * (NT / 128), ph_gemm_proj(VB, smem_raw, p));
  xcd_barrier(xb);
  PHASE(NB * 64 * 8, ph_ssd1(VB, smem_raw, p));
  PHASE(NB * 4 * 32, k_gate(VB, smem_raw, p));
  PHASE_OFF(256, 4 * (NB * MEM / 128), ph_gemm_mem(VB, smem_raw, p));
  xcd_barrier(xb);
  PHASE_NS(NB * 8 * 64 * 128 / 256, ph_ssd2(VB, p));
  {
    int* s_pref = (int*)(smem_raw + 72192);
    {
      const int tid = threadIdx.x;
      int v = (p.bcnt[tid] + 127) >> 7;
      const int lane = tid & 63;
#pragma unroll
      for (int o = 1; o < 64; o <<= 1) { int nb = __shfl_up(v, o); if (lane >= o) v += nb; }
      int* s_wt = s_pref + 256;
      if (lane == 63) s_wt[tid >> 6] = v;
      __syncthreads();
      int add = 0;
      for (int ww = 0; ww < (tid >> 6); ++ww) add += s_wt[ww];
      s_pref[tid] = v + add;
      __syncthreads();
    }
    const int Ug = s_pref[255];
    ph_attn_units(smem_raw, p, Ug, s_pref);
    __syncthreads();
  }
  xcd_barrier(xb);
  PHASE(NB * 64 * 2, ph_ssd3(VB, smem_raw, p));
  if (gridDim.x >= 512) {
    for (int VB = (int)blockIdx.x - 256; VB >= 0 && VB < NT * 4 * 8 / 256; VB += gridDim.x - 256) ph_attn_combine(VB, p);
  } else {
    PHASE_NS(NT * 4 * 8 / 256, ph_attn_combine(VB, p));
  }
  xcd_barrier(xb);
  PHASE(8 * (NT / 128), ph_gemm_f32(VB, smem_raw, p.mixed_b, p.w_outT, p.out, p.x, p.xn_b, p.hss));
  xcd_barrier(xb);
  ushort_t* hn_b = p.xn_b;
  {
    int cv = blockIdx.x;
    for (int VB = blockIdx.x; VB < 8 * (NT / 128); VB += gridDim.x) {
      ph_gemm_route(VB, smem_raw, p, hn_b);
      __syncthreads();
      for (int i = 0; i < 8 && cv < 8192; ++i, cv += gridDim.x) {
        if (cv < 4096) {
#if EX_FP4_DOWN
          ph_cvt4(cv, p.e_down, p.ed8, p.ed_s);
#else
          ph_cvt8(cv, p.e_down, p.ed8, p.ed_s);
#endif
        } else {
#if EX_FP4_UP
          ph_cvt4(cv - 4096, p.e_up, p.eu8, p.eu_s);
#else
          ph_cvt8(cv - 4096, p.e_up, p.eu8, p.eu_s);
#endif
        }
      }
    }
    for (; cv < 8192; cv += gridDim.x) {
      if (cv < 4096) {
#if EX_FP4_DOWN
        ph_cvt4(cv, p.e_down, p.ed8, p.ed_s);
#else
        ph_cvt8(cv, p.e_down, p.ed8, p.ed_s);
#endif
      } else {
#if EX_FP4_UP
        ph_cvt4(cv - 4096, p.e_up, p.eu8, p.eu_s);
#else
        ph_cvt8(cv - 4096, p.e_up, p.eu8, p.eu_s);
#endif
      }
    }
  }
  xcd_barrier(xb);
  PHASE_NS(NT / 32, k_peer_experts2(VB, smem_raw, p));
}
}

extern "C" void kernel_launch(void* const* d_in, const int* in_sizes, int n_in, void* d_out, int out_size, void* d_ws, size_t ws_size,
                              hipStream_t stream) {
  Params p{};
  p.x = (const float*)d_in[0]; p.mem = (const float*)d_in[1]; p.mix_norm_w = (const float*)d_in[2]; p.w_in = (const float*)d_in[3];
  p.conv_w = (const float*)d_in[4]; p.conv_b = (const float*)d_in[5]; p.dt_bias = (const float*)d_in[6]; p.a_log = (const float*)d_in[7];
  p.ssd_d = (const float*)d_in[8]; p.ssd_norm_w = (const float*)d_in[9]; p.mq_norm_w = (const float*)d_in[10]; p.mk_norm_w = (const float*)d_in[11];
  p.mem_norm_w = (const float*)d_in[12]; p.w_mem_kv = (const float*)d_in[13]; p.xq_norm_w = (const float*)d_in[14]; p.xk_norm_w = (const float*)d_in[15];
  p.w_out = (const float*)d_in[16]; p.ffn_norm_w = (const float*)d_in[17]; p.w_query = (const float*)d_in[18]; p.sk1 = (const float*)d_in[19];
  p.sk2 = (const float*)d_in[20]; p.e_down = (const float*)d_in[21]; p.e_up = (const float*)d_in[22];
  p.out = (float*)d_out;
  char* ws = (char*)d_ws;
  size_t o = 0;
  auto take = [&](size_t bytes) { char* q = ws + o; o += (bytes + 255) & ~(size_t)255; return q; };
  p.xn_b = (ushort_t*)take((size_t)NT * DM * 2);
  p.xc = p.xn_b;
  p.w_inT = (ushort_t*)take((size_t)NPROJ * DM * 2);
  p.w_outT = (ushort_t*)take((size_t)DM * DM * 2);
  p.w_qT = (ushort_t*)take((size_t)DM * DM * 2);
  p.w_memT = (ushort_t*)take((size_t)512 * DM * 2);
  p.memn_b = (ushort_t*)take((size_t)NB * MEM * DM * 2);
  p.memk_b = (ushort_t*)take((size_t)NB * MEM * 256 * 2);
  p.memvT = (ushort_t*)take((size_t)NB * MEM * 256 * 2);
  char* regQ = take((size_t)NT * 2560 * 2);
  p.zs = (ushort_t*)regQ;
  p.xbc_raw = (ushort_t*)(regQ + (size_t)NT * 512 * 2);
  p.mq = (ushort_t*)(regQ + (size_t)NT * 1536 * 2);
  p.mk = (ushort_t*)(regQ + (size_t)NT * 1792 * 2);
  p.vT = (ushort_t*)(regQ + (size_t)NT * 2048 * 2);
  p.xq = (ushort_t*)(regQ + (size_t)NT * 2304 * 2);
  p.q = (float*)regQ;
  p.dt = (float*)take((size_t)NT * 8 * 4);
  p.acs = (float*)take((size_t)NT * 8 * 4);
  p.wdec = (float*)take((size_t)NT * 8 * 4);
  p.cdec = (float*)take((size_t)NB * 64 * 8 * 4);
  p.states = (float*)d_out;
  p.sin_b = (ushort_t*)((char*)d_out + (size_t)NB * 64 * 8 * 8192 * 4);
  p.xT = (ushort_t*)((char*)d_out + (size_t)NB * 64 * 8 * 8192 * 6);
  p.mixed_b = (ushort_t*)take((size_t)NT * DM * 2);
  p.kpart = (float*)take((size_t)NB * 4 * 32 * 4 * 64 * 4);
  p.bcnt = (int*)take(256 * 4);
  p.blist = (int*)take((size_t)256 * 8192 * 4);
  p.pm = (float*)take((size_t)NT * 16 * 4);
  p.pl = (float*)take((size_t)NT * 16 * 4);
  p.pO = p.xbc_raw;
  p.eidx = (int*)take((size_t)NT * 128 * 4);
  p.egate = (float*)take((size_t)NT * 128 * 4);
  p.ed8 = (unsigned char*)take((size_t)16384 * DM);
  p.eu8 = (unsigned char*)take((size_t)16384 * DM);
  p.ed_s = (float*)take(16384 * 4);
  p.eu_s = (float*)take(16384 * 4);
  p.bar = (unsigned*)take(XCD_BAR_WORDS * 4);
  p.hss = (float*)take((size_t)NT * 16 * 4);
  p.skh = (ushort_t*)take(2 * 128 * 64 * 2);
  p.skl = (ushort_t*)take(2 * 128 * 64 * 2);
  if (o > ws_size) return;
  (void)hipMemsetAsync(p.bar, 0, XCD_BAR_WORDS * 4, stream);
  static int grid_blocks = 0;
  if (!grid_blocks) {
    int dev = 0, cus = 0, per_cu = 0;
    (void)hipGetDevice(&dev);
    (void)hipDeviceGetAttribute(&cus, hipDeviceAttributeMultiprocessorCount, dev);
    (void)hipOccupancyMaxActiveBlocksPerMultiprocessor(&per_cu, fwd_megakernel, 256, 0);
    if (per_cu > 2) per_cu = 2;
    if (per_cu < 1) per_cu = 1;
    grid_blocks = cus * per_cu;
  }
  void* args[] = {&p};
  hipError_t e = hipLaunchCooperativeKernel((void*)fwd_megakernel, dim3(grid_blocks), dim3(256), args, 0, stream);
  if (e != hipSuccess) fprintf(stderr, "cooperative launch failed: %s (grid %d)\n", hipGetErrorString(e), grid_blocks);
}
```
